# Optimizing an MI355X kernel written in HIP

```python
import math
import jax, jax.numpy as jnp
from jax import lax
import numpy as np

D_MODEL = 4096
BATCH = 1
SEQ = 8192
DEPTH = 4

GRID_W = 64
CTX_LEN = 256
CHUNK = 128
BRANCH_WIDTH = 1024
N_BRANCH = 3
A_GROUPS = 8
A_GDIM = BRANCH_WIDTH // A_GROUPS
B_HEADS = 4
B_DQK = 128
B_DV = BRANCH_WIDTH // B_HEADS
C_HEADS = 4
C_DH = 128
C_DV = 2 * C_DH
FFN_DIM = 4096
ADA_RANK = 256
N_SUB = 3
ROPE_THETA = 10000.0
EPS = 1e-6
SPLIT_SIZES = (2 * BRANCH_WIDTH,
               B_HEADS * B_DQK,
               B_HEADS * B_DQK,
               B_HEADS * B_DV,
               B_HEADS * B_DV,
               4 * B_HEADS,
               2 * C_HEADS * C_DH,
               2 * C_HEADS * C_DH,
               C_HEADS * C_DV,
               N_BRANCH * D_MODEL)
SPLIT_POINTS = tuple(sum(SPLIT_SIZES[:i + 1]) for i in range(len(SPLIT_SIZES) - 1))
IN_COLS = sum(SPLIT_SIZES)

kernel_name = 'hybrid_gated_mixer_dit'


def rmsnorm(x, g):
    xf = x.astype(jnp.float32)
    y = xf * lax.rsqrt(jnp.mean(xf * xf, axis=-1, keepdims=True) + EPS)
    return (y * g.astype(jnp.float32)).astype(x.dtype)


def layernorm(x, g):
    xf = x.astype(jnp.float32)
    xc = xf - jnp.mean(xf, axis=-1, keepdims=True)
    y = xc * lax.rsqrt(jnp.mean(xc * xc, axis=-1, keepdims=True) + EPS)
    return (y * g.astype(jnp.float32)).astype(x.dtype)


def modulation(cvec, w_down, w_up, b_up):
    m = (jax.nn.silu(cvec) @ w_down) @ w_up + b_up
    return m.reshape(m.shape[:-1] + (N_SUB, 3, D_MODEL))


def modulate(x, g, shift, scale):
    return rmsnorm(x, g) * (1 + scale) + shift


def swiglu(h, w13, w2):
    a, b = jnp.split(h @ w13, 2, axis=-1)
    return (jax.nn.silu(a) * b) @ w2


def ffn_sublayer(x, g, mod, w13, w2):
    h = modulate(x, g, mod[:, :, 0], mod[:, :, 1])
    return x + 0.5 * mod[:, :, 2] * swiglu(h, w13, w2)


def axial_rope(rows, dim):
    r = jnp.repeat(jnp.arange(rows, dtype=jnp.float32), GRID_W)
    col = jnp.tile(jnp.arange(GRID_W, dtype=jnp.float32), rows)
    n_freq = dim // 4
    inv = ROPE_THETA ** (-jnp.arange(n_freq, dtype=jnp.float32) / n_freq)
    ang = jnp.concatenate([r[:, None] * inv, col[:, None] * inv], axis=-1)
    return jnp.cos(ang), jnp.sin(ang)


def apply_rope(x, cos, sin):
    shp = (cos.shape[0],) + (1,) * (x.ndim - 3) + (cos.shape[1],)
    c = cos.reshape(shp)
    s = sin.reshape(shp)
    xp = x.astype(jnp.float32).reshape(x.shape[:-1] + (x.shape[-1] // 2, 2))
    x1, x2 = xp[..., 0], xp[..., 1]
    out = jnp.stack([x1 * c - x2 * s, x1 * s + x2 * c], axis=-1)
    return out.reshape(x.shape).astype(x.dtype)


def gmlp_branch(uv, norm_g, ws, bs):
    u, v = jnp.split(jax.nn.gelu(uv), 2, axis=-1)
    v = layernorm(v, norm_g)
    Bn, T, _ = v.shape
    v = v.reshape(Bn, T // CHUNK, CHUNK, A_GROUPS, A_GDIM)
    mixed = jnp.einsum('gpq,bnqgc->bnpgc', ws, v) + bs.T[:, :, None]
    return u * mixed.reshape(Bn, T, BRANCH_WIDTH)


def mlstm_scan(q, k, v, i_pre, f_pre, state):
    Bn, H, T, _ = q.shape
    nc = T // CHUNK

    def chunks(a):
        a = a.astype(jnp.float32)
        return jnp.moveaxis(a.reshape((Bn, H, nc, CHUNK) + a.shape[3:]), 2, 0)

    tri = jnp.tril(jnp.ones((CHUNK, CHUNK), dtype=bool))

    def step(carry, inp):
        C, n, m = carry
        qc, kc, vc, ic, fc = inp
        b = jnp.cumsum(jax.nn.log_sigmoid(fc), axis=-1)
        a = b + m[..., None]
        dmat = jnp.where(tri, b[..., :, None] - b[..., None, :] + ic[..., None, :], -jnp.inf)
        m_t = jnp.maximum(a, jnp.max(dmat, axis=-1))
        wa = jnp.exp(a - m_t)
        s = jnp.einsum('bhtd,bhsd->bhts', qc, kc) * jnp.exp(dmat - m_t[..., None])
        num = wa[..., None] * jnp.einsum('bhtd,bhde->bhte', qc, C) + jnp.einsum('bhts,bhse->bhte', s, vc)
        den = wa * jnp.einsum('bhtd,bhd->bht', qc, n) + jnp.sum(s, axis=-1)
        h = num / jnp.maximum(jnp.abs(den), jnp.exp(-m_t))[..., None]
        b_last = b[..., -1]
        g = b_last[..., None] - b + ic
        m_new = jnp.maximum(b_last + m, jnp.max(g, axis=-1))
        decay = jnp.exp(b_last + m - m_new)
        wg = jnp.exp(g - m_new[..., None])
        C_new = decay[..., None, None] * C + jnp.einsum('bhs,bhsd,bhse->bhde', wg, kc, vc)
        n_new = decay[..., None] * n + jnp.einsum('bhs,bhsd->bhd', wg, kc)
        return (C_new, n_new, m_new), h

    state, h = lax.scan(step, state, (chunks(q), chunks(k), chunks(v), chunks(i_pre), chunks(f_pre)))
    h = jnp.moveaxis(h, 0, 2).reshape(Bn, H, T, -1)
    return state, h.astype(v.dtype)


def diff_attention(q, k, v, lam):
    s = jnp.einsum('bqhmd,bkhmd->bhmqk', q, k).astype(jnp.float32) * (C_DH ** -0.5)
    p = jax.nn.softmax(s, axis=-1)
    w = p[:, :, 0] - lam * p[:, :, 1]
    return jnp.einsum('bhqk,bkhe->bqhe', w.astype(v.dtype), v)


def token_mixer(h_lat, h_ctx, rows, w_in, gmlp_norm_g, gmlp_ws, gmlp_bs, mlstm_gate_b, mlstm_norm_g,
                diff_lambda, diff_norm_g, w_branch, w_out, lambda_init, ctx_out):
    Bn, S, _ = h_lat.shape
    Tc = h_ctx.shape[1]
    zl = jnp.split(h_lat @ w_in, SPLIT_POINTS, axis=-1)
    zc = jnp.split(h_ctx @ w_in, SPLIT_POINTS, axis=-1)

    def mlstm_inputs(z, T):
        q = z[1].reshape(Bn, T, B_HEADS, B_DQK).transpose(0, 2, 1, 3) * (B_DQK ** -0.5)
        k = z[2].reshape(Bn, T, B_HEADS, B_DQK).transpose(0, 2, 1, 3)
        v = z[3].reshape(Bn, T, B_HEADS, B_DV).transpose(0, 2, 1, 3)
        g = (z[5].astype(jnp.float32).reshape(Bn, T, 2, 2, B_HEADS) + mlstm_gate_b).transpose(2, 3, 0, 4, 1)
        return q, k, v, g

    def flip(a):
        return jnp.flip(a, axis=2)

    qc, kc, vc, gc = mlstm_inputs(zc, Tc)
    ql, kl, vl, gl = mlstm_inputs(zl, S)
    zero = (jnp.zeros((Bn, B_HEADS, B_DQK, B_DV), jnp.float32),
            jnp.zeros((Bn, B_HEADS, B_DQK), jnp.float32),
            jnp.zeros((Bn, B_HEADS), jnp.float32))
    st_f, hc_f = mlstm_scan(qc, kc, vc, gc[0, 0], gc[0, 1], zero)
    _, hl_f = mlstm_scan(ql, kl, vl, gl[0, 0], gl[0, 1], st_f)
    st_b, hc_b = mlstm_scan(flip(qc), flip(kc), flip(vc), flip(gc[1, 0]), flip(gc[1, 1]), zero)
    _, hl_b = mlstm_scan(flip(ql), flip(kl), flip(vl), flip(gl[1, 0]), flip(gl[1, 1]), st_b)

    def mlstm_out(h, o, T):
        h = rmsnorm(h.transpose(0, 2, 1, 3), mlstm_norm_g.reshape(B_HEADS, B_DV))
        return jax.nn.sigmoid(o) * h.reshape(Bn, T, BRANCH_WIDTH)

    lam_p = diff_lambda.astype(jnp.float32)
    lam = jnp.exp(jnp.sum(lam_p[0] * lam_p[1])) - jnp.exp(jnp.sum(lam_p[2] * lam_p[3])) + lambda_init
    cos, sin = axial_rope(rows, C_DH)
    q_l = apply_rope(zl[6].reshape(Bn, S, C_HEADS, 2, C_DH), cos, sin)
    k_l = apply_rope(zl[7].reshape(Bn, S, C_HEADS, 2, C_DH), cos, sin)
    v_l = zl[8].reshape(Bn, S, C_HEADS, C_DV)
    k_c = zc[7].reshape(Bn, Tc, C_HEADS, 2, C_DH)
    v_c = zc[8].reshape(Bn, Tc, C_HEADS, C_DV)
    k_all = jnp.concatenate([k_c, k_l], axis=1)
    v_all = jnp.concatenate([v_c, v_l], axis=1)
    qb = jnp.moveaxis(q_l.reshape(Bn, S // CHUNK, CHUNK, C_HEADS, 2, C_DH), 1, 0)
    o_l = lax.map(lambda qi: diff_attention(qi, k_all, v_all, lam), qb)
    o_l = jnp.moveaxis(o_l, 0, 1).reshape(Bn, S, C_HEADS, C_DV)

    def diff_out(o, T):
        return (rmsnorm(o, diff_norm_g) * (1.0 - lambda_init)).reshape(Bn, T, BRANCH_WIDTH)

    def merge(ya, yb, yc, gate_pre):
        g = jax.nn.sigmoid(gate_pre.reshape(gate_pre.shape[:-1] + (N_BRANCH, D_MODEL)))
        y = (g[..., 0, :] * (ya @ w_branch[0]) + g[..., 1, :] * (yb @ w_branch[1])
             + g[..., 2, :] * (yc @ w_branch[2]))
        return y @ w_out

    y_lat = merge(gmlp_branch(zl[0], gmlp_norm_g, gmlp_ws, gmlp_bs),
                  mlstm_out(hl_f + flip(hl_b), zl[4], S),
                  diff_out(o_l, S), zl[9])
    if not ctx_out:
        return y_lat, None
    q_c = zc[6].reshape(Bn, Tc, C_HEADS, 2, C_DH)
    o_c = diff_attention(q_c, k_c, v_c, lam)
    y_ctx = merge(gmlp_branch(zc[0], gmlp_norm_g, gmlp_ws, gmlp_bs),
                  mlstm_out(hc_f + flip(hc_b), zc[4], Tc),
                  diff_out(o_c, Tc), zc[9])
    return y_lat, y_ctx


def setup_inputs(seed: int = 0) -> dict:
    key = jax.random.key(seed)
    ks = jax.random.split(key, 24)
    D = D_MODEL

    def nrm(k, shape, scale):
        return jax.random.normal(k, shape, jnp.float32) * scale

    i_bias = nrm(ks[14], (DEPTH, 2, 1, B_HEADS), 0.1)
    f_bias = jnp.linspace(3.0, 6.0, B_HEADS, dtype=jnp.float32) + nrm(ks[15], (DEPTH, 2, 1, B_HEADS), 0.1)
    return {
        'x': nrm(ks[0], (BATCH, SEQ, D), 1.0),
        'c': nrm(ks[1], (BATCH, D), 1.0),
        'ctx': nrm(ks[2], (BATCH, CTX_LEN, D), 1.0),
        'c_ctx': nrm(ks[3], (D,), 1.0),
        'ada_down': nrm(ks[4], (DEPTH, D, ADA_RANK), D ** -0.5),
        'ada_up': nrm(ks[5], (DEPTH, ADA_RANK, N_SUB * 3 * D), 0.3 * ADA_RANK ** -0.5),
        'ada_bias': nrm(ks[6], (DEPTH, N_SUB * 3 * D), 0.02),
        'norm_g': 1.0 + nrm(ks[7], (DEPTH, N_SUB, D), 0.02),
        'ffn_w13': nrm(ks[8], (DEPTH, 2, D, 2 * FFN_DIM), D ** -0.5),
        'ffn_w2': nrm(ks[9], (DEPTH, 2, FFN_DIM, D), FFN_DIM ** -0.5),
        'w_in': nrm(ks[10], (DEPTH, D, IN_COLS), D ** -0.5),
        'gmlp_norm_g': 1.0 + nrm(ks[11], (DEPTH, BRANCH_WIDTH), 0.02),
        'gmlp_ws': nrm(ks[12], (DEPTH, A_GROUPS, CHUNK, CHUNK), CHUNK ** -0.5),
        'gmlp_bs': 1.0 + nrm(ks[13], (DEPTH, A_GROUPS, CHUNK), 0.02),
        'mlstm_gate_b': jnp.concatenate([i_bias, f_bias], axis=2),
        'mlstm_norm_g': 1.0 + nrm(ks[16], (DEPTH, BRANCH_WIDTH), 0.02),
        'diff_lambda': nrm(ks[17], (DEPTH, 4, C_DH), 0.1),
        'diff_norm_g': 1.0 + nrm(ks[18], (DEPTH, C_DV), 0.02),
        'w_branch': nrm(ks[19], (DEPTH, N_BRANCH, BRANCH_WIDTH, D), BRANCH_WIDTH ** -0.5),
        'w_out': nrm(ks[20], (DEPTH, D, D), D ** -0.5),
        'final_g': 1.0 + nrm(ks[21], (D,), 0.02),
    }


def reference(x, c, ctx, c_ctx, ada_down, ada_up, ada_bias, norm_g, ffn_w13, ffn_w2, w_in,
              gmlp_norm_g, gmlp_ws, gmlp_bs, mlstm_gate_b, mlstm_norm_g, diff_lambda, diff_norm_g,
              w_branch, w_out, final_g):
    rows = x.shape[1] // GRID_W
    for l in range(DEPTH):
        last = l == DEPTH - 1
        lambda_init = 0.8 - 0.6 * math.exp(-0.3 * l)
        ml = modulation(c, ada_down[l], ada_up[l], ada_bias[l])[:, None]
        mc = modulation(c_ctx, ada_down[l], ada_up[l], ada_bias[l])[None, None]
        x = ffn_sublayer(x, norm_g[l, 0], ml[:, :, 0], ffn_w13[l, 0], ffn_w2[l, 0])
        ctx = ffn_sublayer(ctx, norm_g[l, 0], mc[:, :, 0], ffn_w13[l, 0], ffn_w2[l, 0])
        h_lat = modulate(x, norm_g[l, 1], ml[:, :, 1, 0], ml[:, :, 1, 1])
        h_ctx = modulate(ctx, norm_g[l, 1], mc[:, :, 1, 0], mc[:, :, 1, 1])
        y_lat, y_ctx = token_mixer(h_lat, h_ctx, rows, w_in[l], gmlp_norm_g[l], gmlp_ws[l], gmlp_bs[l],
                                   mlstm_gate_b[l], mlstm_norm_g[l], diff_lambda[l], diff_norm_g[l],
                                   w_branch[l], w_out[l], lambda_init, not last)
        x = x + ml[:, :, 1, 2] * y_lat
        x = ffn_sublayer(x, norm_g[l, 2], ml[:, :, 2], ffn_w13[l, 1], ffn_w2[l, 1])
        if not last:
            ctx = ctx + mc[:, :, 1, 2] * y_ctx
            ctx = ffn_sublayer(ctx, norm_g[l, 2], mc[:, :, 2], ffn_w13[l, 1], ffn_w2[l, 1])
    return rmsnorm(x, final_g)
```

```cpp
#include <hip/hip_runtime.h>
#include <hip/hip_bf16.h>
#include <cstdio>
#include <cstdint>
#include <cmath>
namespace pg8 {
#define PG8_LAS __attribute__((address_space(3)))
typedef unsigned short bf16_t;
typedef short bf16x8 __attribute__((ext_vector_type(8)));
typedef float f32x4 __attribute__((ext_vector_type(4)));
typedef unsigned u32x4 __attribute__((ext_vector_type(4)));
constexpr int BM = 256, BK = 64, HALF = 128, HTB = HALF * BK * 2  , STAGE_BYTES = 8 * HTB, NXCD = 8, WGM = 8;

__host__ __device__ __forceinline__ int lds_byte(int r, int c) { const int st = (r >> 4) * 2 + (c >> 5), rr = r & 15, cc = c & 31, ob = rr * 64 + cc * 2; return st * 1024 + (ob ^ (((ob >> 9) & 1) << 5)); }
__host__ __device__ __forceinline__ void stage_rc(int b, int& R, int& C) { const int st = b / 1024, sb = b % 1024, swz = sb ^ (((sb >> 9) & 1) << 5); R = (st >> 1) * 16 + swz / 64; C = (st & 1) * 32 + (swz % 64) / 2; }
__host__ __device__ __forceinline__ int perm32(int rho) { const int n = rho >> 4, i = rho & 15; return 8 * (i >> 2) + 4 * n + (i & 3); }

struct Unit { int pm, pn; };
struct Gemm { const bf16_t* A; const bf16_t* Bt; int M, N, K; };

struct StaticOrder {
    int nM, nN, nwg, G, c;
    __host__ __device__ void init(int M, int N, int G_, int c_) { nM = M / BM; nN = N / BM; nwg = nM * nN; G = G_; c = c_; }
    __host__ __device__ bool next(int i, Unit& u) const {
        const long L = (long)i * G + c; if (L >= nwg) return false;
        int wgid = (int)L; { const int q = nwg / NXCD, r = nwg % NXCD, xcd = wgid % NXCD, off = wgid / NXCD; wgid = (xcd < r ? xcd * (q + 1) : r * (q + 1) + (xcd - r) * q) + off; }
        const int nig = WGM * nN, gid = wgid / nig, fm = gid * WGM, gsz = (nM - fm) < WGM ? (nM - fm) : WGM;
        u.pm = fm + ((wgid % nig) % gsz); u.pn = (wgid % nig) / gsz; return true;
    }
    __device__ __forceinline__ void a_ready(const Unit&) const {}
    __device__ __forceinline__ void done(const Unit&) const {}
};

__device__ __forceinline__ unsigned cvt_pk_bf16(float lo, float hi) { unsigned r; asm volatile("v_cvt_pk_bf16_f32 %0, %1, %2" : "=v"(r) : "v"(lo), "v"(hi)); return r; }
typedef float f32x2 __attribute__((ext_vector_type(2)));
__device__ __forceinline__ f32x2 gelu_pk(f32x2 v) {
    const f32x2 av = __builtin_elementwise_abs(v), d = av * 0.2316418882f + 1.0f;
    f32x2 t; t.x = __builtin_amdgcn_rcpf(d.x); t.y = __builtin_amdgcn_rcpf(d.y);
    f32x2 q = t * 0.5307027145f + (-0.7265760135f); q = q * t + 0.7107068705f; q = q * t + (-0.142248368f); q = q * t + 0.127414796f; q = q * t;
    const f32x2 s = (v * v) * (-0.72134752044f);
    f32x2 e; e.x = __builtin_amdgcn_exp2f(s.x); e.y = __builtin_amdgcn_exp2f(s.y);
    const f32x2 m = v * (q * e), r = v - m;
    f32x2 o; o.x = v.x < 0.f ? m.x : r.x; o.y = v.y < 0.f ? m.y : r.y; return o;
}

template <int ACT  > struct EpiBf16 {
    static constexpr bool PERM = true, AFTER_DRAIN = false; static_assert(ACT == 0 || ACT == 1, "EpiBf16: ACT is 0 (none) or 1 (gelu_pk)");
    bf16_t* O; int ldc; const float* bias; int split_cols; size_t split_stride; float scale0;
    __device__ __forceinline__ void operator()(const f32x4 (&acc)[2][2][4][2], const Unit& u, int wr, int wc, int fr, int fq) const {
        const int row0 = u.pm * BM + wr * 64 + fr; int colt = u.pn * BM; bf16_t* base = O;
        float sc = 1.f; if (split_cols) { const int t = colt / split_cols; base += (size_t)t * split_stride; colt -= t * split_cols; if (t == 0) sc = scale0; }
        const int col0 = colt + wc * 32 + 8 * fq, bcol0 = u.pn * BM + wc * 32 + 8 * fq;
        f32x4 bv[2][2];
#pragma unroll
        for (int bj = 0; bj < 2; ++bj)
#pragma unroll
            for (int n = 0; n < 2; ++n) bv[bj][n] = bias ? *(const f32x4*)(bias + bcol0 + bj * HALF + 4 * n) : (f32x4){0.f, 0.f, 0.f, 0.f};
#pragma unroll
        for (int ai = 0; ai < 2; ++ai)
#pragma unroll
            for (int m = 0; m < 4; ++m) { bf16_t* rowp = base + (size_t)(row0 + ai * HALF + m * 16) * ldc + col0;
#pragma unroll
                for (int bj = 0; bj < 2; ++bj) { f32x4 v0 = acc[ai][bj][m][0] + bv[bj][0], v1 = acc[ai][bj][m][1] + bv[bj][1];
                    if (ACT == 1) { f32x2 a = gelu_pk((f32x2){v0[0], v0[1]}), b = gelu_pk((f32x2){v0[2], v0[3]}), c = gelu_pk((f32x2){v1[0], v1[1]}), d = gelu_pk((f32x2){v1[2], v1[3]});
                        v0 = (f32x4){a.x, a.y, b.x, b.y}; v1 = (f32x4){c.x, c.y, d.x, d.y}; }
                    v0 = v0 * sc; v1 = v1 * sc; u32x4 w; w.x = cvt_pk_bf16(v0[0], v0[1]); w.y = cvt_pk_bf16(v0[2], v0[3]); w.z = cvt_pk_bf16(v1[0], v1[1]); w.w = cvt_pk_bf16(v1[2], v1[3]);
                    *(u32x4*)(rowp + bj * HALF) = w; } }
    }
};

struct PanelStats {
    unsigned* xbuf;
    unsigned* cnt;
    unsigned* tmo;
    int ntn; float eps;
    unsigned code;
    __device__ __forceinline__ bool run(const f32x4 (&v)[2][2][4][2], const Unit& u, int wr, int wc, int fr, int fq, PG8_LAS unsigned char* lds, int wid, int lane) const {
        typedef float f32x2v __attribute__((ext_vector_type(2)));
        PG8_LAS f32x2v* P = (PG8_LAS f32x2v*)lds;
        PG8_LAS f32x2v* S = (PG8_LAS f32x2v*)(lds + 8192);
        PG8_LAS unsigned* flag = (PG8_LAS unsigned*)(lds + 8192 + 2048);
#pragma unroll
        for (int ai = 0; ai < 2; ++ai)
#pragma unroll
            for (int m = 0; m < 4; ++m) {
                float s = 0.f;
#pragma unroll
                for (int bj = 0; bj < 2; ++bj)
#pragma unroll
                    for (int n = 0; n < 2; ++n) { const f32x4 x = v[ai][bj][m][n]; s += (x[0] + x[1]) + (x[2] + x[3]); }
                s += __shfl_xor(s, 16); s += __shfl_xor(s, 32);
                const float mw = s * (1.0f / 64.0f); float q = 0.f;
#pragma unroll
                for (int bj = 0; bj < 2; ++bj)
#pragma unroll
                    for (int n = 0; n < 2; ++n) { const f32x4 d = v[ai][bj][m][n] - mw; q += (d[0] * d[0] + d[1] * d[1]) + (d[2] * d[2] + d[3] * d[3]); }
                q += __shfl_xor(q, 16); q += __shfl_xor(q, 32);
                if (fq == 0) P[(ai * HALF + wr * 64 + m * 16 + fr) * 4 + wc] = (f32x2v){mw, q};
            }
        asm volatile("s_waitcnt lgkmcnt(0)" ::: "memory"); __builtin_amdgcn_s_barrier(); asm volatile("" ::: "memory");
#if defined(BROKEN_EXCHANGE_NO_WAIT)
#warning BROKEN CONTROL BUILD: the row-statistics exchange does not wait; results are wrong by design
        if (blockIdx.x >= 64) { const long long t0_ = clock64(); while (clock64() - t0_ < 60000) __builtin_amdgcn_s_sleep(8); }
#endif
        const int row = wid * 32 + (lane & 31);
        if (lane < 32) {
            const f32x2v a = P[row * 4 + 0], b = P[row * 4 + 1], c = P[row * 4 + 2], d = P[row * 4 + 3];
            const float mt = (a.x + b.x + c.x + d.x) * 0.25f;
            const float da = a.x - mt, db = b.x - mt, dc = c.x - mt, dd = d.x - mt;
            const float m2 = (a.y + b.y) + (c.y + d.y) + 64.0f * ((da * da + db * db) + (dc * dc + dd * dd));
            unsigned long long* slot = (unsigned long long*)xbuf + ((size_t)(u.pm * BM + row) * 4 + u.pn);
            __hip_atomic_store(slot, ((unsigned long long)__float_as_uint(m2) << 32) | __float_as_uint(mt), __ATOMIC_RELAXED, __HIP_MEMORY_SCOPE_AGENT);
        }
        asm volatile("s_waitcnt vmcnt(0)" ::: "memory");
        if (lane == 0) __hip_atomic_fetch_add(cnt + 64 * u.pm, 1u, __ATOMIC_RELAXED, __HIP_MEMORY_SCOPE_AGENT);
        if (wid == 0) {
            bool dead = false; const unsigned long long t0 = __builtin_amdgcn_s_memrealtime(); const unsigned want = 8u * (unsigned)ntn;
            for (;;) {
#if defined(BROKEN_EXCHANGE_NO_WAIT)
                break;
#endif
                if ((unsigned)__builtin_amdgcn_readfirstlane(__hip_atomic_load(cnt + 64 * u.pm, __ATOMIC_RELAXED, __HIP_MEMORY_SCOPE_AGENT)) >= want) break;
                if (__builtin_amdgcn_s_memrealtime() - t0 > 2000000ull) {
                    if (lane == 0) { unsigned expect = 0u; __hip_atomic_compare_exchange_strong(tmo + 1, &expect, code | (unsigned)(u.pm & 0xff), __ATOMIC_RELAXED, __ATOMIC_RELAXED, __HIP_MEMORY_SCOPE_AGENT);
                                     __hip_atomic_store(tmo, 1u, __ATOMIC_RELAXED, __HIP_MEMORY_SCOPE_AGENT); }
                    dead = true; break; }
                __builtin_amdgcn_s_sleep(2);
            }
            __builtin_amdgcn_fence(__ATOMIC_ACQUIRE, "agent");
            if (lane == 0) flag[0] = dead ? 1u : 0u;
        }
        asm volatile("s_waitcnt vmcnt(0) lgkmcnt(0)" ::: "memory"); __builtin_amdgcn_s_barrier(); asm volatile("" ::: "memory");
        const bool bad = flag[0] != 0u;
        if (lane < 32) {
            const unsigned long long* slot = (const unsigned long long*)xbuf + (size_t)(u.pm * BM + row) * 4; float mt[4], m2[4]; float ms = 0.f;
#pragma unroll
            for (int t = 0; t < 4; ++t) { if (t < ntn) { const unsigned long long w = __hip_atomic_load(slot + t, __ATOMIC_RELAXED, __HIP_MEMORY_SCOPE_AGENT); mt[t] = __uint_as_float((unsigned)w); m2[t] = __uint_as_float((unsigned)(w >> 32)); } else { mt[t] = 0.f; m2[t] = 0.f; } ms += mt[t]; }
            const float mean = ms / (float)ntn; float q = 0.f;
#pragma unroll
            for (int t = 0; t < 4; ++t) if (t < ntn) { const float dm = mt[t] - mean; q += m2[t] + 256.0f * dm * dm; }
            S[row] = (f32x2v){mean, 1.0f / sqrtf(q / (256.0f * (float)ntn) + eps)};
        }
        asm volatile("s_waitcnt lgkmcnt(0)" ::: "memory"); __builtin_amdgcn_s_barrier(); asm volatile("" ::: "memory");
        return bad;
    }
};
struct EpiLnRes {
    static constexpr bool PERM = false, AFTER_DRAIN = true;
    const float* base; float* out; int ldc; const float* bias; PanelStats st; unsigned poison;
    __device__ __forceinline__ void fused(f32x4 (&acc)[2][2][4][2], const Unit& u, int wr, int wc, int fr, int fq, PG8_LAS unsigned char* lds, int wid, int lane) const {
        typedef float f32x2v __attribute__((ext_vector_type(2)));
        const PG8_LAS f32x2v* S = (const PG8_LAS f32x2v*)(lds + 8192);
        const int col0 = u.pn * BM + wc * 32 + 4 * fq;
#pragma unroll
        for (int bj = 0; bj < 2; ++bj)
#pragma unroll
            for (int n = 0; n < 2; ++n) { const f32x4 bv = bias ? *(const f32x4*)(bias + col0 + bj * HALF + n * 16) : (f32x4){0.f, 0.f, 0.f, 0.f};
#pragma unroll
                for (int ai = 0; ai < 2; ++ai)
#pragma unroll
                    for (int m = 0; m < 4; ++m) acc[ai][bj][m][n] += bv; }
        f32x4 pre[4][2][2];
#pragma unroll
        for (int m = 0; m < 4; ++m) { const size_t off = (size_t)(u.pm * BM + wr * 64 + m * 16 + fr) * ldc + col0;
#pragma unroll
            for (int bj = 0; bj < 2; ++bj)
#pragma unroll
                for (int n = 0; n < 2; ++n) pre[m][bj][n] = *(const f32x4*)(base + off + bj * HALF + n * 16); }
        const bool bad = st.run(acc, u, wr, wc, fr, fq, lds, wid, lane) || poison != 0u;
        const float qnan = __builtin_nanf("");
#pragma unroll
        for (int ai = 0; ai < 2; ++ai)
#pragma unroll
            for (int m = 0; m < 4; ++m) { const int r = ai * HALF + wr * 64 + m * 16 + fr; const f32x2v sr = S[r]; const size_t off = (size_t)(u.pm * BM + r) * ldc + col0;
#pragma unroll
                for (int bj = 0; bj < 2; ++bj)
#pragma unroll
                    for (int n = 0; n < 2; ++n) { const f32x4 bs = ai == 0 ? pre[m][bj][n] : *(const f32x4*)(base + off + bj * HALF + n * 16); f32x4 o = bs + (acc[ai][bj][m][n] - sr.x) * sr.y;
                        if (bad) o = (f32x4){qnan, qnan, qnan, qnan}; *(f32x4*)(out + off + bj * HALF + n * 16) = o; }
                if (m & 1) asm volatile("" ::: "memory"); }
    }
};
struct EpiLnResLn {
    static constexpr bool PERM = false, AFTER_DRAIN = true;
    const float* base; float* out; bf16_t* xn; int ldc; const float* bias; PanelStats st1, st2; unsigned poison;
    __device__ __forceinline__ void fused(f32x4 (&acc)[2][2][4][2], const Unit& u, int wr, int wc, int fr, int fq, PG8_LAS unsigned char* lds, int wid, int lane) const {
        typedef float f32x2v __attribute__((ext_vector_type(2))); typedef unsigned u32x2v __attribute__((ext_vector_type(2)));
        const PG8_LAS f32x2v* S = (const PG8_LAS f32x2v*)(lds + 8192);
        const int col0 = u.pn * BM + wc * 32 + 4 * fq;
#pragma unroll
        for (int bj = 0; bj < 2; ++bj)
#pragma unroll
            for (int n = 0; n < 2; ++n) { const f32x4 bv = bias ? *(const f32x4*)(bias + col0 + bj * HALF + n * 16) : (f32x4){0.f, 0.f, 0.f, 0.f};
#pragma unroll
                for (int ai = 0; ai < 2; ++ai)
#pragma unroll
                    for (int m = 0; m < 4; ++m) acc[ai][bj][m][n] += bv; }
        bool bad = st1.run(acc, u, wr, wc, fr, fq, lds, wid, lane) || poison != 0u;
        const float qnan = __builtin_nanf("");
#pragma unroll
        for (int ai = 0; ai < 2; ++ai)
#pragma unroll
            for (int m = 0; m < 4; ++m) { const int r = ai * HALF + wr * 64 + m * 16 + fr; const f32x2v sr = S[r]; const size_t off = (size_t)(u.pm * BM + r) * ldc + col0;
#pragma unroll
                for (int bj = 0; bj < 2; ++bj)
#pragma unroll
                    for (int n = 0; n < 2; ++n) { const f32x4 bs = *(const f32x4*)(base + off + bj * HALF + n * 16); acc[ai][bj][m][n] = bs + (acc[ai][bj][m][n] - sr.x) * sr.y; }
                asm volatile("" : "+v"(acc[ai][0][m][0]), "+v"(acc[ai][0][m][1]), "+v"(acc[ai][1][m][0]), "+v"(acc[ai][1][m][1]));
                if (m & 1) asm volatile("" ::: "memory"); }
        const bool bad1 = bad;
        bad = st2.run(acc, u, wr, wc, fr, fq, lds, wid, lane) || bad;
#pragma unroll
        for (int ai = 0; ai < 2; ++ai)
#pragma unroll
            for (int m = 0; m < 4; ++m) { const int r = ai * HALF + wr * 64 + m * 16 + fr; const f32x2v sr = S[r]; const size_t off = (size_t)(u.pm * BM + r) * ldc + col0;
#pragma unroll
                for (int bj = 0; bj < 2; ++bj)
#pragma unroll
                    for (int n = 0; n < 2; ++n) { const f32x4 x1 = acc[ai][bj][m][n]; *(f32x4*)(out + off + bj * HALF + n * 16) = bad1 ? (f32x4){qnan, qnan, qnan, qnan} : x1;
                        const f32x4 o = (x1 - sr.x) * sr.y; u32x2v w; w.x = cvt_pk_bf16(o[0], o[1]); w.y = cvt_pk_bf16(o[2], o[3]);
                        if (bad) { w.x = 0x7fc07fc0u; w.y = 0x7fc07fc0u; } *(u32x2v*)(xn + off + bj * HALF + n * 16) = w; }
                asm volatile("" ::: "memory"); }
    }
};

template <class Epi, class Sched, bool ALIGN_EPI = false, bool SP2 = false>
__device__ __forceinline__ void gemm_phase(PG8_LAS unsigned char* lds, const Gemm g, const Sched& S, const Epi& E) {
    const int tid = threadIdx.x, wid = __builtin_amdgcn_readfirstlane(tid >> 6), lane = tid & 63, wr = wid >> 2, wc = wid & 3, fr = lane & 15, fq = lane >> 4;
    const int K = g.K, nt = K / BK;
    unsigned voffA[2], voffB[2];
#pragma unroll
    for (int i = 0; i < 2; ++i) { int R, C; stage_rc(tid * 16 + i * 8192, R, C); const int Rb = Epi::PERM ? ((R & ~31) + perm32(R & 31)) : R;
        voffA[i] = (unsigned)(R * K + C) * 2u; voffB[i] = (unsigned)(Rb * K + C) * 2u; }
    const size_t kstep = (size_t)(BK * 2);
    const size_t hstep = (size_t)HALF * K * 2;
    const size_t tstep = 2 * hstep;
    const unsigned ldsw = (unsigned)wid * 1024u;
    const int aoff = lds_byte(wr * 64 + fr, fq * 8), boff = lds_byte(wc * 32 + fr, fq * 8);
#define PG8_SA(b, h) (((b) * 2 + (h)) * HTB)
#define PG8_SB(b, h) ((4 + (b) * 2 + (h)) * HTB)
#define PG8_STAGE(bufoff, gbase, voff) do { _Pragma("unroll") for (int _i = 0; _i < 2; ++_i) \
        __builtin_amdgcn_global_load_lds((const unsigned*)((const char*)(gbase) + (voff)[_i]), (PG8_LAS unsigned*)(lds + (bufoff) + ldsw + _i * 8192), 16, 0, 0); } while (0)
#define PG8_LDA(dst, b, h) do { _Pragma("unroll") for (int m = 0; m < 4; ++m) _Pragma("unroll") for (int k = 0; k < 2; ++k) dst[m][k] = *(const PG8_LAS bf16x8*)(lds + PG8_SA(b, h) + aoff + m * 2048 + k * 1024); } while (0)
#define PG8_LDB(dst, b, h) do { _Pragma("unroll") for (int n = 0; n < 2; ++n) _Pragma("unroll") for (int k = 0; k < 2; ++k) dst[n][k] = *(const PG8_LAS bf16x8*)(lds + PG8_SB(b, h) + boff + n * 2048 + k * 1024); } while (0)
#define PG8_MMA(ai, bj, At, Bt) do { __builtin_amdgcn_s_setprio(1); _Pragma("unroll") for (int m = 0; m < 4; ++m) _Pragma("unroll") for (int n = 0; n < 2; ++n) _Pragma("unroll") for (int k = 0; k < 2; ++k) \
        acc[ai][bj][m][n] = __builtin_amdgcn_mfma_f32_16x16x32_bf16(Bt[n][k], At[m][k], acc[ai][bj][m][n], 0, 0, 0); __builtin_amdgcn_s_setprio(0); } while (0)
#define PG8_WAIT_V(n) asm volatile("s_waitcnt vmcnt(" #n ")" ::: "memory")
#define PG8_WAIT_L(n) asm volatile("s_waitcnt lgkmcnt(" #n ")" ::: "memory")
#define PG8_BAR __builtin_amdgcn_s_barrier()
#define PG8_SCHED __builtin_amdgcn_sched_barrier(0)
    Unit cur, nxt; int ui = 0;
    if (!S.next(0, cur)) return;
    f32x4 acc[2][2][4][2];
#pragma unroll
    for (int a = 0; a < 2; ++a)
#pragma unroll
        for (int b = 0; b < 2; ++b)
#pragma unroll
            for (int m = 0; m < 4; ++m)
#pragma unroll
                for (int n = 0; n < 2; ++n) acc[a][b][m][n] = (f32x4){0.f, 0.f, 0.f, 0.f};
    bf16x8 At[4][2], B0[2][2], B1[2][2];
    const char* cA = (const char*)g.A + (size_t)cur.pm * tstep; const char* cB = (const char*)g.Bt + (size_t)cur.pn * tstep;
    S.a_ready(cur);
    if constexpr (SP2) {
        PG8_STAGE(PG8_SB(0, 0), cB, voffB); PG8_STAGE(PG8_SB(0, 1), cB + hstep, voffB); PG8_STAGE(PG8_SA(0, 0), cA, voffA); PG8_STAGE(PG8_SA(0, 1), cA + hstep, voffA);
        if (wr == 1) PG8_BAR;
        PG8_WAIT_V(2); PG8_BAR;
        PG8_STAGE(PG8_SB(1, 0), cB + kstep, voffB); PG8_STAGE(PG8_SA(1, 0), cA + kstep, voffA); PG8_STAGE(PG8_SB(1, 1), cB + hstep + kstep, voffB);
        PG8_WAIT_V(6); PG8_BAR;
    } else {
        PG8_STAGE(PG8_SB(0, 0), cB, voffB); PG8_STAGE(PG8_SA(0, 0), cA, voffA); PG8_STAGE(PG8_SB(0, 1), cB + hstep, voffB); PG8_STAGE(PG8_SA(0, 1), cA + hstep, voffA);
        if (wr == 1) PG8_BAR;
        PG8_WAIT_V(4); PG8_BAR;
        PG8_STAGE(PG8_SB(1, 0), cB + kstep, voffB); PG8_STAGE(PG8_SA(1, 0), cA + kstep, voffA); PG8_STAGE(PG8_SB(1, 1), cB + hstep + kstep, voffB);
        PG8_WAIT_V(6); PG8_BAR;
    }
    for (;;) {
        const bool has_next = S.next(ui + 1, nxt);
        const char* nA = has_next ? (const char*)g.A + (size_t)nxt.pm * tstep : cA; const char* nB = has_next ? (const char*)g.Bt + (size_t)nxt.pn * tstep : cB;
        for (int t = 0; t < nt; t += 2) {
            const bool last = (t == nt - 2);
            const char* a1 = cA + (size_t)(t + 1) * kstep;
            const char* a2 = last ? nA : cA + (size_t)(t + 2) * kstep; const char* b2 = last ? nB : cB + (size_t)(t + 2) * kstep;
            const char* a3 = a2 + kstep; const char* b3 = b2 + kstep;
            if (last && has_next) S.a_ready(nxt);
            if constexpr (SP2) {
            PG8_LDB(B0, 0, 0); PG8_LDB(B1, 0, 1); PG8_SCHED; PG8_LDA(At, 0, 0); PG8_STAGE(PG8_SA(1, 1), a1 + hstep, voffA);
            PG8_WAIT_V(8); PG8_WAIT_L(0); PG8_BAR; PG8_MMA(0, 0, At, B0); PG8_MMA(0, 1, At, B1); PG8_BAR; PG8_SCHED;
            PG8_LDA(At, 0, 1); PG8_STAGE(PG8_SB(0, 0), b2, voffB); PG8_STAGE(PG8_SB(0, 1), b2 + hstep, voffB); PG8_STAGE(PG8_SA(0, 0), a2, voffA);
            PG8_WAIT_V(8); PG8_WAIT_L(0); PG8_BAR; PG8_MMA(1, 0, At, B0); PG8_MMA(1, 1, At, B1); PG8_BAR; PG8_SCHED;
            PG8_LDB(B0, 1, 0); PG8_LDB(B1, 1, 1); PG8_SCHED; PG8_LDA(At, 1, 0); PG8_STAGE(PG8_SA(0, 1), a2 + hstep, voffA);
            PG8_WAIT_V(8); PG8_WAIT_L(0); PG8_BAR; PG8_MMA(0, 0, At, B0); PG8_MMA(0, 1, At, B1); PG8_BAR; PG8_SCHED;
            PG8_LDA(At, 1, 1); PG8_STAGE(PG8_SB(1, 0), b3, voffB); PG8_STAGE(PG8_SB(1, 1), b3 + hstep, voffB); PG8_STAGE(PG8_SA(1, 0), a3, voffA);
            PG8_WAIT_V(8); PG8_WAIT_L(0); PG8_BAR; PG8_MMA(1, 0, At, B0); PG8_MMA(1, 1, At, B1); PG8_BAR; PG8_SCHED;
            } else {
            PG8_LDB(B0, 0, 0); PG8_SCHED; PG8_LDA(At, 0, 0); PG8_STAGE(PG8_SA(1, 1), a1 + hstep, voffA);
            PG8_WAIT_L(8); PG8_BAR; PG8_WAIT_L(0); PG8_MMA(0, 0, At, B0); PG8_BAR; PG8_SCHED;
            PG8_LDB(B1, 0, 1); PG8_STAGE(PG8_SB(0, 0), b2, voffB);
            PG8_BAR; PG8_WAIT_L(0); PG8_MMA(0, 1, At, B1); PG8_BAR;
            PG8_LDA(At, 0, 1); PG8_STAGE(PG8_SA(0, 0), a2, voffA);
            PG8_BAR; PG8_WAIT_L(0); PG8_MMA(1, 0, At, B0); PG8_BAR; PG8_SCHED;
            PG8_STAGE(PG8_SB(0, 1), b2 + hstep, voffB);
            PG8_WAIT_V(6); PG8_BAR; PG8_MMA(1, 1, At, B1); PG8_BAR;
            PG8_LDB(B0, 1, 0); PG8_SCHED; PG8_LDA(At, 1, 0); PG8_STAGE(PG8_SA(0, 1), a2 + hstep, voffA);
            PG8_WAIT_L(8); PG8_BAR; PG8_WAIT_L(0); PG8_MMA(0, 0, At, B0); PG8_BAR; PG8_SCHED;
            PG8_LDB(B1, 1, 1); PG8_STAGE(PG8_SB(1, 0), b3, voffB);
            PG8_BAR; PG8_WAIT_L(0); PG8_MMA(0, 1, At, B1); PG8_BAR;
            PG8_LDA(At, 1, 1); PG8_STAGE(PG8_SA(1, 0), a3, voffA);
            PG8_BAR; PG8_WAIT_L(0); PG8_MMA(1, 0, At, B0); PG8_BAR; PG8_SCHED;
            PG8_STAGE(PG8_SB(1, 1), b3 + hstep, voffB);
            PG8_WAIT_V(6); PG8_BAR; PG8_MMA(1, 1, At, B1); PG8_BAR;
            }
        }
        if constexpr (ALIGN_EPI) { if (wr == 0) PG8_BAR; }
        if constexpr (!Epi::AFTER_DRAIN) { E(acc, cur, wr, wc, fr, fq); S.done(cur); }
        if (!has_next) break;
#pragma unroll
        for (int a = 0; a < 2; ++a)
#pragma unroll
            for (int b = 0; b < 2; ++b)
#pragma unroll
                for (int m = 0; m < 4; ++m)
#pragma unroll
                    for (int n = 0; n < 2; ++n) acc[a][b][m][n] = (f32x4){0.f, 0.f, 0.f, 0.f};
        cur = nxt; cA = nA; cB = nB; ++ui;
        if constexpr (ALIGN_EPI) { if (wr == 1) PG8_BAR; }
    }
    PG8_WAIT_V(0);
    if constexpr (!ALIGN_EPI) { if (wr == 0) PG8_BAR; }
    PG8_BAR;
    if constexpr (Epi::AFTER_DRAIN) { E.fused(acc, cur, wr, wc, fr, fq, lds, wid, lane); S.done(cur); }
#undef PG8_SA
#undef PG8_SB
#undef PG8_STAGE
#undef PG8_LDA
#undef PG8_LDB
#undef PG8_MMA
#undef PG8_WAIT_V
#undef PG8_WAIT_L
#undef PG8_BAR
#undef PG8_SCHED
}
}

namespace attn128 {
using bf16 = __hip_bfloat16;
constexpr int D = 128, NW = 8, QBLK = 32, KVBLK = 64;
constexpr float SCALE = 0.088388347648318440f;
constexpr float THR = 8.f;
constexpr int SDEPTH = 2;
constexpr int LDQ = 20480, LDK = 20480, LDO = 1024;
constexpr size_t SHM_V = KVBLK * D * 2, SHM_K = KVBLK * D * 2, SHM_ATTN = 2 * SHM_V + 2 * SHM_K + NW * 64 * 4;
using bf16x8 = __attribute__((ext_vector_type(8))) short;
using s16x4  = __attribute__((ext_vector_type(4))) short;
using f32x16 = __attribute__((ext_vector_type(16))) float;
using f32x8  = __attribute__((ext_vector_type(8))) float;
using u32x4  = __attribute__((ext_vector_type(4))) unsigned;
#define KSWZ(row, colB) ((row) * 256 + ((colB) ^ (((row) & 7) << 4)))
#define SBAR() __builtin_amdgcn_sched_barrier(0)
__device__ __forceinline__ int crow(int r, int hi) { return (r & 3) + 8 * (r >> 2) + 4 * hi; }
__device__ __forceinline__ unsigned cvtpk(float lo, float hi) {
  unsigned r; asm volatile("v_cvt_pk_bf16_f32 %0, %1, %2" : "=v"(r) : "v"(lo), "v"(hi)); return r;
}
template <typename TIn> struct Stage;
template <> struct Stage<bf16>  { using T = bf16x8;
  __device__ static __forceinline__ T ld8(const bf16* p) { return *reinterpret_cast<const bf16x8*>(p); }
  __device__ static __forceinline__ bf16x8 tobf(T x) { return x; } };
template <> struct Stage<float> { using T = f32x8;
  __device__ static __forceinline__ T ld8(const float* p) { return *reinterpret_cast<const f32x8*>(p); }
  __device__ static __forceinline__ bf16x8 tobf(T x) {
    u32x4 w = {cvtpk(x[0], x[1]), cvtpk(x[2], x[3]), cvtpk(x[4], x[5]), cvtpk(x[6], x[7])}; return *reinterpret_cast<bf16x8*>(&w); } };

__device__ __forceinline__ void partialSM(f32x16& p0, f32x16& p1, float& m_reg, float& mn, float& alpha) {
  constexpr float C = SCALE * 1.4426950408889634f;
  float pmax = p0[0]; for (int r = 1; r < 16; ++r) pmax = fmaxf(pmax, p0[r]); for (int r = 0; r < 16; ++r) pmax = fmaxf(pmax, p1[r]);
  { auto rr = __builtin_amdgcn_permlane32_swap(__float_as_uint(pmax), __float_as_uint(pmax), false, false);
    pmax = fmaxf(__uint_as_float(rr[0]), __uint_as_float(rr[1])); }
  if (__builtin_expect(__all(pmax - m_reg <= THR / SCALE), 1)) { mn = m_reg; alpha = 1.f; }
  else { mn = fmaxf(m_reg, pmax); alpha = __builtin_amdgcn_exp2f((m_reg - mn) * C); m_reg = mn; }
  float mnC = -mn * C;
  for (int r = 0; r < 16; ++r) p0[r] = fmaf(p0[r], C, mnC); for (int r = 0; r < 16; ++r) p1[r] = fmaf(p1[r], C, mnC);
  for (int r = 0; r < 16; ++r) p0[r] = __builtin_amdgcn_exp2f(p0[r]);
}
__device__ __forceinline__ void finishSM(f32x16& p0, f32x16& p1, float alpha, float& l_reg, bf16x8& pa0, bf16x8& pa1, bf16x8& pa2, bf16x8& pa3) {
  for (int r = 0; r < 16; ++r) p1[r] = __builtin_amdgcn_exp2f(p1[r]);
  float ps = 0; for (int r = 0; r < 16; ++r) ps += p0[r]; for (int r = 0; r < 16; ++r) ps += p1[r];
  { auto rr = __builtin_amdgcn_permlane32_swap(__float_as_uint(ps), __float_as_uint(ps), false, false);
    ps = __uint_as_float(rr[0]) + __uint_as_float(rr[1]); }
  l_reg = l_reg * alpha + ps;
#define PK4(P, BASE, OUT) do { unsigned a0 = cvtpk(P[BASE + 0], P[BASE + 1]), a1 = cvtpk(P[BASE + 2], P[BASE + 3]);   \
    unsigned b0 = cvtpk(P[BASE + 4], P[BASE + 5]), b1 = cvtpk(P[BASE + 6], P[BASE + 7]);                              \
    auto r0 = __builtin_amdgcn_permlane32_swap(a0, b0, false, false); auto r1 = __builtin_amdgcn_permlane32_swap(a1, b1, false, false); \
    u32x4 w = {r0[0], r1[0], r0[1], r1[1]}; OUT = *reinterpret_cast<bf16x8*>(&w); } while (0)
  PK4(p0, 0, pa0); PK4(p0, 8, pa1); PK4(p1, 0, pa2); PK4(p1, 8, pa3);
#undef PK4
}
__device__ __forceinline__ void qkt(f32x16& p0, f32x16& p1, const bf16* Ks, const bf16x8* qr, int r32, int hi) {
  p0 = f32x16{}; p1 = f32x16{};
  for (int d0 = 0; d0 < 8; ++d0) { int cb = (d0 * 16 + hi * 8) * 2;
    bf16x8 b0 = *reinterpret_cast<const bf16x8*>((const char*)Ks + KSWZ(r32, cb));
    bf16x8 b1 = *reinterpret_cast<const bf16x8*>((const char*)Ks + KSWZ(32 + r32, cb));
    p0 = __builtin_amdgcn_mfma_f32_32x32x16_bf16(b0, qr[d0], p0, 0, 0, 0);
    p1 = __builtin_amdgcn_mfma_f32_32x32x16_bf16(b1, qr[d0], p1, 0, 0, 0); }
}
__device__ __forceinline__ int v_st(int k, int c) { const int kk = (k & ~0xC) | ((k & 4) << 1) | ((k & 8) >> 1); return ((kk >> 3) * 4 + (c >> 5)) * 512 + ((kk & 7) * 32 + (c & 31)) * 2; }
__device__ __forceinline__ int v_rd_base(int lane) { return ((lane & 3) << 3) | (((lane >> 2) & 3) << 6) | (((lane >> 4) & 1) << 5) | (((lane >> 5) & 1) << 8); }
constexpr int v_rd_off(int d0, int ks, int half) { return d0 * 512 + ks * 4096 + half * 2048; }
template <int OFF> __device__ __forceinline__ s16x4 tr_read(int vb) {
  s16x4 r; asm volatile("ds_read_b64_tr_b16 %0, %1 offset:%2" : "=&v"(r) : "v"(vb), "i"(OFF) : "memory"); return r;
}
template <int D0> __device__ __forceinline__ void pv_one(f32x16& od, int vb, bf16x8 pa0, bf16x8 pa1, bf16x8 pa2, bf16x8 pa3) {
  const s16x4 l0 = tr_read<v_rd_off(D0, 0, 0)>(vb), h0 = tr_read<v_rd_off(D0, 0, 1)>(vb), l1 = tr_read<v_rd_off(D0, 1, 0)>(vb), h1 = tr_read<v_rd_off(D0, 1, 1)>(vb);
  const s16x4 l2 = tr_read<v_rd_off(D0, 2, 0)>(vb), h2 = tr_read<v_rd_off(D0, 2, 1)>(vb), l3 = tr_read<v_rd_off(D0, 3, 0)>(vb), h3 = tr_read<v_rd_off(D0, 3, 1)>(vb);
  asm volatile("s_waitcnt lgkmcnt(0)" ::: "memory"); SBAR();
#define PK(L, H) (bf16x8){L[0], L[1], L[2], L[3], H[0], H[1], H[2], H[3]}
  od = __builtin_amdgcn_mfma_f32_32x32x16_bf16(pa0, PK(l0, h0), od, 0, 0, 0);
  od = __builtin_amdgcn_mfma_f32_32x32x16_bf16(pa1, PK(l1, h1), od, 0, 0, 0);
  od = __builtin_amdgcn_mfma_f32_32x32x16_bf16(pa2, PK(l2, h2), od, 0, 0, 0);
  od = __builtin_amdgcn_mfma_f32_32x32x16_bf16(pa3, PK(l3, h3), od, 0, 0, 0);
#undef PK
}
__device__ __forceinline__ void pv_d0(f32x16* o, int vb, bf16x8 pa0, bf16x8 pa1, bf16x8 pa2, bf16x8 pa3) {
  pv_one<0>(o[0], vb, pa0, pa1, pa2, pa3); pv_one<1>(o[1], vb, pa0, pa1, pa2, pa3); pv_one<2>(o[2], vb, pa0, pa1, pa2, pa3); pv_one<3>(o[3], vb, pa0, pa1, pa2, pa3);
}

template <typename TQ>
__device__ __forceinline__ void attn_dense_body(const TQ* __restrict__ Qb, const bf16* __restrict__ Kh, const bf16* __restrict__ Vh,
                                                float* __restrict__ Ob, int seq, char* lds) {
  using St = Stage<bf16>; using SQ = Stage<TQ>;
  const int tid = threadIdx.x, wid = tid >> 6, lane = tid & 63, r32 = lane & 31, hi = lane >> 5;
  bf16* V_lds = (bf16*)lds; bf16* K_lds = (bf16*)(lds + 2 * SHM_V);
  float* ws = (float*)(lds + 2 * SHM_V + 2 * SHM_K) + wid * 64; float* li_l = ws; float* al_l = ws + 32;
  float m_reg = -1e30f, l_reg = 0; f32x16 o[4] = {}; bf16x8 qr[8];
  const TQ* Qw = Qb + (long)(wid * QBLK + r32) * LDQ + hi * 8;
#pragma unroll
  for (int d0 = 0; d0 < 8; ++d0) qr[d0] = SQ::tobf(SQ::ld8(Qw + d0 * 16));
  const int sr = tid >> 4, sc = (tid & 15) * 8, vst0 = v_st(sr, sc), vst1 = v_st(32 + sr, sc);
  const int vb0 = (int)(uintptr_t)V_lds + v_rd_base(lane);
  struct { typename St::T vs0, vs1, ks0, ks1; } sr_[SDEPTH];
#define SLOAD(i, k0) do { sr_[i].vs0 = St::ld8(&Vh[(long)((k0) + sr) * LDK + sc]); sr_[i].vs1 = St::ld8(&Vh[(long)((k0) + 32 + sr) * LDK + sc]); \
    sr_[i].ks0 = St::ld8(&Kh[(long)((k0) + sr) * LDK + sc]); sr_[i].ks1 = St::ld8(&Kh[(long)((k0) + 32 + sr) * LDK + sc]); } while (0)
#define SWRITE(b, i) do { *(bf16x8*)((char*)V_lds + (b) * SHM_V + vst0) = St::tobf(sr_[i].vs0);          \
    *(bf16x8*)((char*)V_lds + (b) * SHM_V + vst1) = St::tobf(sr_[i].vs1); int kc = sc * 2;               \
    *(bf16x8*)((char*)K_lds + (b) * SHM_K + KSWZ(sr, kc)) = St::tobf(sr_[i].ks0);                       \
    *(bf16x8*)((char*)K_lds + (b) * SHM_K + KSWZ(32 + sr, kc)) = St::tobf(sr_[i].ks1); } while (0)
#define SWAIT() do { if constexpr (SDEPTH == 2) asm volatile("s_waitcnt vmcnt(4)" ::: "memory"); else asm volatile("s_waitcnt vmcnt(0)" ::: "memory"); } while (0)
#define RESC(a) do { if (__any((a) < 1.f)) { if (hi == 0) al_l[r32] = (a); asm volatile("s_waitcnt lgkmcnt(0)" ::: "memory"); \
    for (int d = 0; d < 4; ++d) for (int r = 0; r < 16; ++r) o[d][r] *= al_l[crow(r, hi)]; } } while (0)
  f32x16 pA0, pA1, pB0, pB1; float mnA, mnB, alA, alB; bf16x8 pa0, pa1, pa2, pa3; const int NT = seq / KVBLK;
  constexpr int SE = 0, SO = SDEPTH - 1;
  SLOAD(SE, 0); asm volatile("s_waitcnt vmcnt(0)" ::: "memory"); SWRITE(0, SE); __syncthreads();
  qkt(pA0, pA1, K_lds, qr, r32, hi); partialSM(pA0, pA1, m_reg, mnA, alA);
  SLOAD(SO, KVBLK); if constexpr (SDEPTH == 2) { if (2 < NT) SLOAD(SE, 2 * KVBLK); }
  SWAIT(); SWRITE(1, SO); __syncthreads();
  for (int j = 1; j + 1 < NT; j += 2) {
    SBAR(); qkt(pB0, pB1, (bf16*)((char*)K_lds + SHM_K), qr, r32, hi);
    finishSM(pA0, pA1, alA, l_reg, pa0, pa1, pa2, pa3); SBAR();
    SLOAD(SO, (j + SDEPTH) * KVBLK); SBAR();
    pv_d0(o, vb0, pa0, pa1, pa2, pa3); partialSM(pB0, pB1, m_reg, mnB, alB);
    __syncthreads(); SWAIT(); SWRITE(0, SE);
    RESC(alB); __syncthreads();
    SBAR(); qkt(pA0, pA1, K_lds, qr, r32, hi);
    finishSM(pB0, pB1, alB, l_reg, pa0, pa1, pa2, pa3); SBAR();
    if (SDEPTH == 1 || j + 3 < NT) SLOAD(SE, (j + 1 + SDEPTH) * KVBLK); SBAR();
    pv_d0(o, vb0 + (int)SHM_V, pa0, pa1, pa2, pa3); partialSM(pA0, pA1, m_reg, mnA, alA);
    __syncthreads(); SWAIT(); SWRITE(1, SO);
    RESC(alA); __syncthreads();
  }
  SBAR(); qkt(pB0, pB1, (bf16*)((char*)K_lds + SHM_K), qr, r32, hi);
  finishSM(pA0, pA1, alA, l_reg, pa0, pa1, pa2, pa3); SBAR();
  pv_d0(o, vb0, pa0, pa1, pa2, pa3); partialSM(pB0, pB1, m_reg, mnB, alB);
  __syncthreads(); RESC(alB);
  finishSM(pB0, pB1, alB, l_reg, pa0, pa1, pa2, pa3); SBAR();
  pv_d0(o, vb0 + (int)SHM_V, pa0, pa1, pa2, pa3);
  if (hi == 0) li_l[r32] = l_reg; asm volatile("s_waitcnt lgkmcnt(0)" ::: "memory");
  float rli[16];
#pragma unroll
  for (int r = 0; r < 16; ++r) rli[r] = __builtin_amdgcn_rcpf(li_l[crow(r, hi)]);
  float* Ow = Ob + (long)(wid * QBLK) * LDO;
#pragma unroll
  for (int r = 0; r < 16; ++r) { int orow = crow(r, hi);
    for (int d0 = 0; d0 < 4; ++d0) Ow[(long)orow * LDO + d0 * 32 + r32] = o[d0][r] * rli[r]; }
#undef SLOAD
#undef SWRITE
#undef SWAIT
#undef RESC
}

}

#define GAS __attribute__((address_space(1)))
#define LAS __attribute__((address_space(3)))
typedef unsigned short bf16;
typedef unsigned v4u __attribute__((ext_vector_type(4)));
typedef float f32x4 __attribute__((ext_vector_type(4)));
typedef short bf16x8 __attribute__((ext_vector_type(8)));
typedef GAS unsigned gu32;
typedef GAS unsigned long long gu64;
#define RLX_AGENT __ATOMIC_RELAXED, __HIP_MEMORY_SCOPE_AGENT
#define LDS_WAIT() asm volatile("s_waitcnt lgkmcnt(0)" ::: "memory")
#define VM_WAIT() asm volatile("s_waitcnt vmcnt(0)" ::: "memory")
__device__ __forceinline__ unsigned long long rt() { return __builtin_amdgcn_s_memrealtime(); }
__device__ __forceinline__ unsigned f2bf(float f) { unsigned u = __builtin_bit_cast(unsigned, f); return (u + 0x7fffu + ((u >> 16) & 1u)) >> 16; }
__device__ __forceinline__ unsigned pk2(float lo, float hi) { return f2bf(lo) | (f2bf(hi) << 16); }

#define XB_TMO      128
#define XB_XCNT(j)  (256  + 64 * (j))
#define XB_XSUB(j)  (1280 + 64 * (j))
#define XB_XGEN(j)  (2304 + 64 * (j))
#define XB_TOP      3328
#define XB_TOPGEN   3392
#define XCD_BAR_WORDS 3456
#define XB_SPIN_CAP (1u << 18)

__device__ __forceinline__ unsigned xb_ld(unsigned* p)              { return __hip_atomic_load(p, __ATOMIC_RELAXED, __HIP_MEMORY_SCOPE_AGENT); }
__device__ __forceinline__ unsigned xb_add(unsigned* p, unsigned v) { return __hip_atomic_fetch_add(p, v, __ATOMIC_RELAXED, __HIP_MEMORY_SCOPE_AGENT); }
__device__ __forceinline__ unsigned xb_xcc_id() { return (unsigned)__builtin_amdgcn_s_getreg((3 << 11) | 20) & 0xFu; }
#define XB_SPIN(cond, bar) do { unsigned _sp = 0; while (cond) { __builtin_amdgcn_s_sleep(1); \
    if ((++_sp & 255u) == 0u) { if (xb_ld(&(bar)[XB_TMO])) break; if (_sp > XB_SPIN_CAP) { atomicAdd(&(bar)[XB_TMO], 1u); break; } } } } while (0)

struct XcdBarrier {
    unsigned* bar; unsigned x;
    volatile LAS unsigned* st;
};

__device__ __forceinline__ XcdBarrier xcd_barrier_post(unsigned* bar, volatile LAS unsigned* st) {
    XcdBarrier b; b.bar = bar; b.x = xb_xcc_id(); b.st = st;
    if (threadIdx.x == 0) (void)xb_add(&bar[XB_XCNT(b.x)], 1u);
    return b;
}
__device__ __forceinline__ void xcd_barrier_complete(unsigned* bar, unsigned x, unsigned& nloc, unsigned& nx) {
    const unsigned G = gridDim.x * gridDim.y * gridDim.z;
    unsigned sum, cnt, mine, sp = 0u;
    for (;;) {
        sum = 0u; cnt = 0u; mine = 0u;
#pragma unroll
        for (unsigned j = 0; j < 16; ++j) { const unsigned c = xb_ld(&bar[XB_XCNT(j)]); sum += c; cnt += (c > 0u) ? 1u : 0u; mine = (j == x) ? c : mine; }
        if (sum == G) break;
        __builtin_amdgcn_s_sleep(1);
        if ((++sp & 255u) == 0u) { if (xb_ld(&bar[XB_TMO])) break; if (sp > XB_SPIN_CAP) { atomicAdd(&bar[XB_TMO], 1u); break; } }
    }
    nloc = mine > 0u ? mine : 1u; nx = cnt > 0u ? cnt : 1u;
}

__device__ __forceinline__ void xcd_barrier(const XcdBarrier& b) {
    asm volatile("s_waitcnt vmcnt(0)" ::: "memory");
    __syncthreads();
    if (threadIdx.x == 0) {
        unsigned* bar = b.bar;
        __builtin_amdgcn_s_waitcnt(0);
        unsigned nloc = b.st[0], nx = b.st[1];
        if (nloc == 0u) { xcd_barrier_complete(bar, b.x, nloc, nx); b.st[0] = nloc; b.st[1] = nx; }
        const unsigned old = xb_add(&bar[XB_XSUB(b.x)], 1u);
        const unsigned gen = old / nloc;
        if (old + 1u == (gen + 1u) * nloc) {
            __builtin_amdgcn_fence(__ATOMIC_RELEASE, "agent");
            asm volatile("s_waitcnt vmcnt(0)" ::: "memory");
            const unsigned og = xb_add(&bar[XB_TOP], 1u);
            const unsigned tg = og / nx;
            if (og + 1u == (tg + 1u) * nx) xb_add(&bar[XB_TOPGEN], 1u);
            else XB_SPIN(xb_ld(&bar[XB_TOPGEN]) == tg, bar);
            __builtin_amdgcn_fence(__ATOMIC_ACQUIRE, "agent");
            xb_add(&bar[XB_XGEN(b.x)], 1u);
            asm volatile("s_waitcnt vmcnt(0)" ::: "memory");
        } else {
            XB_SPIN(xb_ld(&bar[XB_XGEN(b.x)]) == gen, bar);
            __builtin_amdgcn_fence(__ATOMIC_ACQUIRE, "agent");
            asm volatile("s_waitcnt vmcnt(0)" ::: "memory");
        }
    }
    __syncthreads();
}

constexpr int DM = 4096, SEQ = 8192, CTXL = 256, MT = SEQ + CTXL, DEPTH = 4, FFND = 4096;
constexpr int NZ = 20480, INC = 20496, ADAR = 256, NMOD = 9 * DM;
constexpr int ZC_UV = 0, ZC_MQ = 2048, ZC_MK = 2560, ZC_MV = 3072, ZC_MO = 4096, ZC_AQ = 5120, ZC_AK = 6144, ZC_AV = 7168, ZC_MG = 8192;
constexpr float EPS = 1e-6f;
constexpr int NWAVES = 8, NTHR = 512;

constexpr size_t MiB = 1ull << 20;
constexpr size_t WS_CTL = 0, CTL_ZERO_BYTES = 1 * MiB;
constexpr size_t WS_MODTP = 1 * MiB;
constexpr size_t WS_MOD = WS_MODTP + 256 * 1024;
constexpr size_t WS_LAM = WS_MOD + (size_t)DEPTH * 2 * NMOD * 4;
constexpr size_t WS_WG16 = WS_LAM + 256;
constexpr size_t WS_ROPE = WS_WG16 + (size_t)DEPTH * 16 * DM * 4;
constexpr size_t WS_G16 = WS_ROPE + (size_t)2 * SEQ * 64 * 4;
constexpr size_t WS_XR = 8 * MiB;
constexpr size_t SZ_ROWS_F32 = (size_t)MT * DM * 4, SZ_ROWS_BF = (size_t)MT * DM * 2;
constexpr size_t WS_H = WS_XR + SZ_ROWS_F32;
constexpr size_t WS_GB = WS_H + SZ_ROWS_BF;
constexpr size_t WS_Z = WS_GB + SZ_ROWS_BF;
constexpr size_t WS_ATTO = WS_Z + (size_t)MT * NZ * 2;
constexpr size_t WS_MLH = WS_ATTO + (size_t)2 * MT * 1024 * 4;
constexpr size_t WS_YA = WS_MLH + (size_t)2 * MT * 1024 * 4;
constexpr size_t WS_YB = WS_YA + (size_t)MT * 1024 * 2;
constexpr size_t WS_YC = WS_YB + (size_t)MT * 1024 * 2;
constexpr size_t WS_YACC = WS_YC + (size_t)MT * 1024 * 2;
constexpr size_t WS_Y = WS_YACC + SZ_ROWS_F32;
constexpr size_t WS_W13T = WS_Y + SZ_ROWS_BF;
constexpr size_t WS_W2T = WS_W13T + (size_t)DEPTH * 2 * 8192 * 4096 * 2;
constexpr size_t WS_WINT = WS_W2T + (size_t)DEPTH * 2 * 4096 * 4096 * 2;
constexpr size_t WS_WBT = WS_WINT + (size_t)DEPTH * NZ * 4096 * 2;
constexpr size_t WS_WOT = WS_WBT + (size_t)DEPTH * 3 * 4096 * 1024 * 2;
constexpr size_t WS_END = WS_WOT + (size_t)DEPTH * 4096 * 4096 * 2;
static_assert(WS_G16 + (size_t)MT * 16 * 4 <= WS_XR, "small buffers fit below XR");
static_assert(WS_XR % 256 == 0 && WS_H % 256 == 0 && WS_Z % 256 == 0 && WS_W13T % 256 == 0, "alignment");

constexpr int CW_BAR = 4096;

constexpr int RING_OFF = 0, RING_BYTES = 131072;
constexpr int LDSCTL_OFF = RING_BYTES, MISC_OFF = LDSCTL_OFF + 320;
constexpr int LDS_BYTES = 147456;

constexpr int P_PRO0 = 0, P_PRO1 = 1, P_LAYER0 = 2;
constexpr int L_N1 = 0, L_W13A = 1, L_W2A = 2, L_N2 = 3, L_WIN = 4, L_ROPE = 5, L_MLSTM = 6, L_ATTN = 7, L_GMLP = 8, L_POST = 9, L_MERGE0 = 10, L_MERGE1 = 11, L_MERGE2 = 12, L_WOUT = 13, L_N3 = 14, L_W13B = 15, L_W2B = 16, NPL = 17;
constexpr int P_FINAL = P_LAYER0 + DEPTH * NPL, NPH = P_FINAL + 1;

__device__ __forceinline__ float wave_sum(float v) {
#pragma unroll
    for (int o = 1; o < 64; o <<= 1) v += __shfl_xor(v, o);
    return v;
}
__device__ __forceinline__ float bf2f(unsigned short b) { return __uint_as_float((unsigned)b << 16); }
__device__ __forceinline__ float bflo(unsigned w) { return __uint_as_float(w << 16); }
__device__ __forceinline__ float bfhi(unsigned w) { return __uint_as_float(w & 0xffff0000u); }
__device__ __forceinline__ float sigmoid_f(float x) { return 1.f / (1.f + __expf(-x)); }
__device__ __forceinline__ float silu_f(float x) { return x / (1.f + __expf(-x)); }
__device__ __forceinline__ float gelu_tanh_f(float x) { const float u = 0.7978845608028654f * (x + 0.044715f * x * x * x); return x / (1.f + __expf(-2.f * u)); }
__device__ __forceinline__ float lambda_init_f(int l) { return 0.8f - 0.6f * expf(-0.3f * (float)l); }

namespace pg8 {
struct EpiSwiglu {
    static constexpr bool PERM = true, AFTER_DRAIN = false;
    bf16_t* O; int ldc;
    __device__ __forceinline__ void operator()(const f32x4 (&acc)[2][2][4][2], const Unit& u, int wr, int wc, int fr, int fq) const {
        const int row0 = u.pm * BM + wr * 64 + fr, col0 = u.pn * HALF + wc * 32 + 8 * fq;
#pragma unroll
        for (int ai = 0; ai < 2; ++ai)
#pragma unroll
            for (int m = 0; m < 4; ++m) {
                bf16_t* rowp = O + (size_t)(row0 + ai * HALF + m * 16) * ldc + col0;
                float v[8];
#pragma unroll
                for (int n = 0; n < 2; ++n)
#pragma unroll
                    for (int i = 0; i < 4; ++i) { const float a = acc[ai][0][m][n][i], b = acc[ai][1][m][n][i]; v[n * 4 + i] = a / (1.f + __expf(-a)) * b; }
                u32x4 w; w.x = cvt_pk_bf16(v[0], v[1]); w.y = cvt_pk_bf16(v[2], v[3]); w.z = cvt_pk_bf16(v[4], v[5]); w.w = cvt_pk_bf16(v[6], v[7]);
                *(u32x4*)rowp = w;
            }
    }
};
struct EpiResid {
    static constexpr bool PERM = false, AFTER_DRAIN = false;
    float* X; const float* gate_lat; const float* gate_ctx; float f;
    __device__ __forceinline__ void operator()(const f32x4 (&acc)[2][2][4][2], const Unit& u, int wr, int wc, int fr, int fq) const {
        const int col0 = u.pn * BM + wc * 32 + 4 * fq;
        const float* gate = (u.pm == 0) ? gate_ctx : gate_lat;
        f32x4 gv[2][2];
#pragma unroll
        for (int bj = 0; bj < 2; ++bj)
#pragma unroll
            for (int n = 0; n < 2; ++n) gv[bj][n] = *(const f32x4*)(gate + col0 + bj * HALF + n * 16) * f;
#pragma unroll
        for (int ai = 0; ai < 2; ++ai)
#pragma unroll
            for (int m = 0; m < 4; ++m) {
                float* p = X + (size_t)(u.pm * BM + ai * HALF + wr * 64 + m * 16 + fr) * DM + col0;
#pragma unroll
                for (int bj = 0; bj < 2; ++bj)
#pragma unroll
                    for (int n = 0; n < 2; ++n) { f32x4 x = *(const f32x4*)(p + bj * HALF + n * 16); x += gv[bj][n] * acc[ai][bj][m][n]; *(f32x4*)(p + bj * HALF + n * 16) = x; }
            }
    }
};
template <int I> struct EpiMerge {
    static constexpr bool PERM = true, AFTER_DRAIN = false;
    const bf16_t* Zg; float* YACC; bf16_t* Y;
    __device__ __forceinline__ void operator()(const f32x4 (&acc)[2][2][4][2], const Unit& u, int wr, int wc, int fr, int fq) const {
#pragma unroll
        for (int ai = 0; ai < 2; ++ai)
#pragma unroll
            for (int m = 0; m < 4; ++m) {
                const size_t row = (size_t)(u.pm * BM + ai * HALF + wr * 64 + m * 16 + fr);
#pragma unroll
                for (int bj = 0; bj < 2; ++bj) {
                    const int col = u.pn * BM + bj * HALF + wc * 32 + 8 * fq;
                    const u32x4 gw = *(const u32x4*)(Zg + row * NZ + ZC_MG + I * 4096 + col);
                    float g[8];
                    g[0] = __uint_as_float(gw.x << 16); g[1] = __uint_as_float(gw.x & 0xffff0000u); g[2] = __uint_as_float(gw.y << 16); g[3] = __uint_as_float(gw.y & 0xffff0000u);
                    g[4] = __uint_as_float(gw.z << 16); g[5] = __uint_as_float(gw.z & 0xffff0000u); g[6] = __uint_as_float(gw.w << 16); g[7] = __uint_as_float(gw.w & 0xffff0000u);
                    float v[8];
#pragma unroll
                    for (int n = 0; n < 2; ++n)
#pragma unroll
                        for (int i = 0; i < 4; ++i) v[n * 4 + i] = acc[ai][bj][m][n][i] / (1.f + __expf(-g[n * 4 + i]));
                    float* ya = YACC + row * DM + col;
                    if (I >= 1) { const f32x4 p0 = *(const f32x4*)ya, p1 = *(const f32x4*)(ya + 4);
                        v[0] += p0[0]; v[1] += p0[1]; v[2] += p0[2]; v[3] += p0[3]; v[4] += p1[0]; v[5] += p1[1]; v[6] += p1[2]; v[7] += p1[3]; }
                    if (I <= 1) { *(f32x4*)ya = (f32x4){v[0], v[1], v[2], v[3]}; *(f32x4*)(ya + 4) = (f32x4){v[4], v[5], v[6], v[7]}; }
                    else { u32x4 w; w.x = cvt_pk_bf16(v[0], v[1]); w.y = cvt_pk_bf16(v[2], v[3]); w.z = cvt_pk_bf16(v[4], v[5]); w.w = cvt_pk_bf16(v[6], v[7]);
                        *(u32x4*)(Y + row * DM + col) = w; }
                    asm volatile("" ::: "memory");
                }
            }
    }
};
}

__device__ __forceinline__ void transpose_item(const float* __restrict__ W, size_t ldw, int K, int k0, int srccol0, bf16* WT, int dstrow0, LAS float* scr, int lane) {
#pragma unroll 8
    for (int i = 0; i < 32; ++i) { const int kk = 2 * i + (lane >> 5); scr[kk * 33 + (lane & 31)] = W[(size_t)(k0 + kk) * ldw + srccol0 + (lane & 31)]; }
    LDS_WAIT(); asm volatile("" ::: "memory");
    const int c = lane & 7;
#pragma unroll
    for (int j = 0; j < 4; ++j) { const int n = (lane >> 3) + 8 * j; const LAS float* s = scr + (8 * c) * 33 + n;
        v4u o; o.x = pk2(s[0 * 33], s[1 * 33]); o.y = pk2(s[2 * 33], s[3 * 33]); o.z = pk2(s[4 * 33], s[5 * 33]); o.w = pk2(s[6 * 33], s[7 * 33]);
        *(GAS v4u*)(WT + (size_t)(dstrow0 + n) * K + k0 + 8 * c) = o; }
    LDS_WAIT(); asm volatile("" ::: "memory");
}

struct Ptrs {
    const float *x, *c, *ctx, *c_ctx, *ada_down, *ada_up, *ada_bias, *norm_g, *w13, *w2, *w_in, *gmlp_norm_g, *gmlp_ws, *gmlp_bs, *gate_b, *mlstm_norm_g, *diff_lambda, *diff_norm_g, *w_branch, *w_out, *final_g;
    float* out; unsigned char* ws;
};

constexpr int IT_W13 = 2 * 64 * 256, IT_W2 = 2 * 64 * 128, IT_WIN = 64 * 640, IT_WB = 3 * 16 * 128, IT_WO = 64 * 128, IT_LAYER = IT_W13 + IT_W2 + IT_WIN + IT_WB + IT_WO;

__device__ __forceinline__ void pro0(const Ptrs& P, LAS unsigned char* lds, int bid, int G, int tid) {
    const int wave = tid >> 6, lane = tid & 63;
    LAS float* scr = (LAS float*)(lds + RING_OFF + wave * 16384);
    const int gw = bid * NWAVES + wave, NGW = G * NWAVES;
    unsigned char* ws = P.ws;
    for (int it = gw; it < DEPTH * IT_LAYER; it += NGW) {
        const int l = it / IT_LAYER; int r = it % IT_LAYER;
        if (r < IT_W13) { const int s = r / (64 * 256), q = r % (64 * 256), kb = q / 256, nb = q % 256, dr = nb * 32, tile = dr >> 8, within = dr & 255;
            const int src = within < 128 ? tile * 128 + within : 4096 + tile * 128 + (within - 128);
            transpose_item(P.w13 + (size_t)(l * 2 + s) * 4096 * 8192, 8192, 4096, kb * 64, src, (bf16*)(ws + WS_W13T) + (size_t)(l * 2 + s) * 8192 * 4096, dr, scr, lane); continue; }
        r -= IT_W13;
        if (r < IT_W2) { const int s = r / (64 * 128), q = r % (64 * 128), kb = q / 128, nb = q % 128;
            transpose_item(P.w2 + (size_t)(l * 2 + s) * 4096 * 4096, 4096, 4096, kb * 64, nb * 32, (bf16*)(ws + WS_W2T) + (size_t)(l * 2 + s) * 4096 * 4096, nb * 32, scr, lane); continue; }
        r -= IT_W2;
        if (r < IT_WIN) { const int kb = r / 640, nb = r % 640, dr = nb * 32, src = dr < 5120 ? dr : dr + 16;
            transpose_item(P.w_in + (size_t)l * 4096 * INC, INC, 4096, kb * 64, src, (bf16*)(ws + WS_WINT) + (size_t)l * NZ * 4096, dr, scr, lane); continue; }
        r -= IT_WIN;
        if (r < IT_WB) { const int i = r / (16 * 128), q = r % (16 * 128), kb = q / 128, nb = q % 128;
            transpose_item(P.w_branch + (size_t)(l * 3 + i) * 1024 * 4096, 4096, 1024, kb * 64, nb * 32, (bf16*)(ws + WS_WBT) + (size_t)(l * 3 + i) * 4096 * 1024, nb * 32, scr, lane); continue; }
        r -= IT_WB;
        { const int kb = r / 128, nb = r % 128;
            transpose_item(P.w_out + (size_t)l * 4096 * 4096, 4096, 4096, kb * 64, nb * 32, (bf16*)(ws + WS_WOT) + (size_t)l * 4096 * 4096, nb * 32, scr, lane); }
    }
    const int gt = bid * NTHR + tid, NGT = G * NTHR;
    { f32x4* XR = (f32x4*)(ws + WS_XR); const f32x4* xc = (const f32x4*)P.ctx; const f32x4* xl = (const f32x4*)P.x;
      const int nctx = CTXL * DM / 4, ntot = MT * DM / 4;
      for (int i = gt; i < ntot; i += NGT) XR[i] = i < nctx ? xc[i] : xl[i - nctx]; }
    { float* rc = (float*)(ws + WS_ROPE); float* rs = rc + SEQ * 64;
      for (int i = gt; i < SEQ * 64; i += NGT) { const int t = i >> 6, j = i & 63; const float inv = powf(10000.f, -(float)(j & 31) / 32.f);
          const float pos = (float)(j < 32 ? (t >> 6) : (t & 63)); const float ang = pos * inv; rc[i] = cosf(ang); rs[i] = sinf(ang); } }
    { float* tp = (float*)(ws + WS_MODTP);
      for (int task = gw; task < DEPTH * 2 * 4 * 16; task += NGW) { const int dc = task & 15, rg = (task >> 4) & 3, w = (task >> 6) & 1, l = task >> 7;
          const float* cv = w ? P.c_ctx : P.c; const float* dn = P.ada_down + (size_t)l * DM * ADAR; const int r = rg * 64 + lane; float acc = 0.f;
          for (int d = dc * 256; d < dc * 256 + 256; ++d) { const float cvd = cv[d]; acc += (cvd / (1.f + expf(-cvd))) * dn[(size_t)d * ADAR + r]; }
          tp[((l * 2 + w) * 16 + dc) * 256 + r] = acc; } }
    if (bid == 0 && tid < DEPTH) { const float* dl = P.diff_lambda + tid * 4 * 128; float s1 = 0.f, s2 = 0.f;
        for (int i = 0; i < 128; ++i) { s1 += dl[i] * dl[128 + i]; s2 += dl[256 + i] * dl[384 + i]; }
        ((float*)(ws + WS_LAM))[tid] = expf(s1) - expf(s2) + lambda_init_f(tid); }
    { float* wg = (float*)(ws + WS_WG16);
      for (int i = gt; i < DEPTH * DM * 16; i += NGT) { const int j = i & 15, d = (i >> 4) & (DM - 1), l = i >> 16;
          wg[((size_t)l * 16 + j) * DM + d] = P.w_in[((size_t)l * DM + d) * INC + 5120 + j]; } }
}

__device__ __forceinline__ void pro1(const Ptrs& P, LAS unsigned char* lds, int bid, int G, int tid) {
    LAS float* T = (LAS float*)(lds + RING_OFF);
    const float* tp = (const float*)(P.ws + WS_MODTP);
    for (int i = tid; i < DEPTH * 2 * 256; i += NTHR) { const int r = i & 255, lw = i >> 8; float s = 0.f;
        for (int dc = 0; dc < 16; ++dc) s += tp[(lw * 16 + dc) * 256 + r];
        T[i] = s; }
    __syncthreads();
    float* MOD = (float*)(P.ws + WS_MOD);
    for (int i = bid * NTHR + tid; i < DEPTH * NMOD; i += G * NTHR) { const int l = i / NMOD, n = i % NMOD;
        const float* up = P.ada_up + (size_t)l * ADAR * NMOD + n; const float b = P.ada_bias[(size_t)l * NMOD + n]; float a0 = b, a1 = b;
        for (int r = 0; r < ADAR; ++r) { const float u = up[(size_t)r * NMOD]; a0 += T[(l * 2 + 0) * 256 + r] * u; a1 += T[(l * 2 + 1) * 256 + r] * u; }
        MOD[(size_t)(l * 2 + 0) * NMOD + n] = a0; MOD[(size_t)(l * 2 + 1) * NMOD + n] = a1; }
    __syncthreads();
}

template <bool GATES>
__device__ __forceinline__ void phase_norm(const float* XR, const float* g, const float* modl, const float* modc, bf16* H, const float* wg16, float* G16, int bid, int G, int tid) {
    const int wave = tid >> 6, lane = tid & 63;
    for (int row = bid * NWAVES + wave; row < MT; row += G * NWAVES) {
        const f32x4* xr = (const f32x4*)(XR + (size_t)row * DM) + lane;
        f32x4 v[16]; float ss = 0.f;
#pragma unroll
        for (int j = 0; j < 16; ++j) { v[j] = xr[64 * j]; ss += (v[j].x * v[j].x + v[j].y * v[j].y) + (v[j].z * v[j].z + v[j].w * v[j].w); }
        const float rstd = 1.f / sqrtf(wave_sum(ss) * (1.f / DM) + EPS);
        const float* mod = row < CTXL ? modc : modl;
        uint2* hr = (uint2*)(H + (size_t)row * DM) + lane;
#pragma unroll
        for (int j = 0; j < 16; ++j) { const int d = 4 * lane + 256 * j;
            const f32x4 gg = *(const f32x4*)(g + d), sh = *(const f32x4*)(mod + d), sc = *(const f32x4*)(mod + DM + d);
            const f32x4 hv = v[j] * rstd * gg * (sc + 1.f) + sh; v[j] = hv;
            uint2 o; o.x = pk2(hv.x, hv.y); o.y = pk2(hv.z, hv.w); hr[64 * j] = o; }
        if (GATES) {
            float mine = 0.f;
            for (int jj = 0; jj < 16; ++jj) { const f32x4* w = (const f32x4*)(wg16 + (size_t)jj * DM) + lane; float a = 0.f;
#pragma unroll
                for (int j = 0; j < 16; ++j) { const f32x4 ww = w[64 * j]; a += (v[j].x * ww.x + v[j].y * ww.y) + (v[j].z * ww.z + v[j].w * ww.w); }
                a = wave_sum(a); if (lane == jj) mine = a; }
            if (lane < 16) G16[(size_t)row * 16 + lane] = mine;
        }
    }
}

__device__ __forceinline__ void phase_final(const float* XR, const float* g, float* out, int bid, int G, int tid) {
    const int wave = tid >> 6, lane = tid & 63;
    for (int t = bid * NWAVES + wave; t < SEQ; t += G * NWAVES) {
        const f32x4* xr = (const f32x4*)(XR + (size_t)(CTXL + t) * DM) + lane;
        f32x4 v[16]; float ss = 0.f;
#pragma unroll
        for (int j = 0; j < 16; ++j) { v[j] = xr[64 * j]; ss += (v[j].x * v[j].x + v[j].y * v[j].y) + (v[j].z * v[j].z + v[j].w * v[j].w); }
        const float rstd = 1.f / sqrtf(wave_sum(ss) * (1.f / DM) + EPS);
        f32x4* o = (f32x4*)(out + (size_t)t * DM) + lane;
#pragma unroll
        for (int j = 0; j < 16; ++j) { const f32x4 gg = *(const f32x4*)(g + 4 * lane + 256 * j); o[64 * j] = v[j] * rstd * gg; }
    }
}

__device__ __forceinline__ void phase_rope(bf16* Z, const float* rc, const float* rs, int bid, int G, int tid) {
    for (int i = bid * NTHR + tid; i < SEQ * 1024; i += G * NTHR) { const int t = i >> 10, p = i & 1023, blk = p >> 9, within = p & 511, vec = within >> 6, j = within & 63;
        unsigned* zp = (unsigned*)(Z + (size_t)(CTXL + t) * NZ + (blk ? ZC_AK : ZC_AQ) + vec * 128 + 2 * j);
        const unsigned w = *zp; const float x1 = bflo(w), x2 = bfhi(w), c = rc[t * 64 + j], s = rs[t * 64 + j];
        *zp = pk2(x1 * c - x2 * s, x1 * s + x2 * c); }
}

__device__ __forceinline__ void gmlp_unit(const bf16* Z, const float* gng, const float* wsg  , const float* bsg  , bf16* YA, int j, int g, LAS unsigned char* lds, int tid) {
    const int wave = tid >> 6, lane = tid & 63;
    LAS float* VN = (LAS float*)(lds);
    LAS float* WS = (LAS float*)(lds + 65536);
    LAS float* ST = (LAS float*)(lds + 133120);
    const size_t row0 = (size_t)j * 128;
    for (int rr = 0; rr < 16; ++rr) { const int q = wave * 16 + rr;
        const v4u* zp = (const v4u*)(Z + (row0 + q) * NZ + ZC_UV + 1024 + lane * 16); const v4u w0 = zp[0], w1 = zp[1];
        float x[16]; const unsigned ww[8] = {w0.x, w0.y, w0.z, w0.w, w1.x, w1.y, w1.z, w1.w};
        float s = 0.f;
#pragma unroll
        for (int k = 0; k < 8; ++k) { x[2 * k] = gelu_tanh_f(bflo(ww[k])); x[2 * k + 1] = gelu_tanh_f(bfhi(ww[k])); s += x[2 * k] + x[2 * k + 1]; }
        const float mean = wave_sum(s) * (1.f / 1024.f); float s2 = 0.f;
#pragma unroll
        for (int k = 0; k < 16; ++k) { const float d = x[k] - mean; s2 += d * d; }
        const float rstd = 1.f / sqrtf(wave_sum(s2) * (1.f / 1024.f) + EPS);
        if (lane == 0) { ST[2 * q] = mean; ST[2 * q + 1] = rstd; } }
    for (int i = tid; i < 128 * 128; i += NTHR) WS[i] = wsg[i];
    __syncthreads();
    for (int i = tid; i < 128 * 128; i += NTHR) { const int q = i >> 7, c = i & 127;
        const float x = gelu_tanh_f(bf2f(Z[(row0 + q) * NZ + ZC_UV + 1024 + g * 128 + c]));
        VN[i] = (x - ST[2 * q]) * ST[2 * q + 1] * gng[g * 128 + c]; }
    __syncthreads();
    const int c = tid & 127, p0 = (tid >> 7) * 32;
    float acc[32];
#pragma unroll
    for (int i = 0; i < 32; ++i) acc[i] = 0.f;
    for (int q = 0; q < 128; q += 4) {
        const float v0 = VN[(q + 0) * 128 + c], v1 = VN[(q + 1) * 128 + c], v2 = VN[(q + 2) * 128 + c], v3 = VN[(q + 3) * 128 + c];
#pragma unroll
        for (int i = 0; i < 32; ++i) { const f32x4 w = *(const LAS f32x4*)(WS + (p0 + i) * 128 + q); acc[i] += (w.x * v0 + w.y * v1) + (w.z * v2 + w.w * v3); }
    }
#pragma unroll
    for (int i = 0; i < 32; ++i) { const int p = p0 + i; const float uu = gelu_tanh_f(bf2f(Z[(row0 + p) * NZ + ZC_UV + g * 128 + c]));
        YA[(row0 + p) * 1024 + g * 128 + c] = (bf16)f2bf(uu * (acc[i] + bsg[p])); }
    __syncthreads();
}

__device__ __forceinline__ void mlstm_chain_naive(const bf16* Z, const float* G16, const float* gate_b  , float* MLH, int chain, LAS unsigned char* lds, int tid) {
    constexpr int RB = 8, ROWF = 520;
    const int dir = chain >> 2, h = chain & 3, lane = tid & 63, e = tid & 255, half = tid >> 8;
    LAS float* RBUF = (LAS float*)lds;
    LAS float* NUMP = RBUF + 2 * RB * ROWF;
    LAS float* DENP = NUMP + 512;
    const float bi = gate_b[dir * 8 + 0 * 4 + h], bfv = gate_b[dir * 8 + 1 * 4 + h];
    float C[64];
#pragma unroll
    for (int i = 0; i < 64; ++i) C[i] = 0.f;
    float nreg = 0.f, m = 0.f;
    const int colq = tid < 128 ? ZC_MQ + h * 128 + tid : (tid < 256 ? ZC_MK + h * 128 + (tid - 128) : ZC_MV + h * 256 + (tid - 256));
    const float qs = tid < 128 ? 0.08838834764831845f : 1.f;
    float pre[RB]; float preg = 0.f;
#define rowof(t) (dir ? ((t) < CTXL ? (CTXL - 1 - (t)) : (MT + CTXL - 1 - (t))) : (t))
#pragma unroll
    for (int s = 0; s < RB; ++s) { const int r = rowof(s); RBUF[s * ROWF + tid] = bf2f(Z[(size_t)r * NZ + colq]) * qs; }
    if (tid < 2 * RB) { const int s = tid >> 1, w = tid & 1, r = rowof(s); RBUF[s * ROWF + 512 + w] = G16[(size_t)r * 16 + dir * 8 + w * 4 + h] + (w ? bfv : bi); }
    __syncthreads();
    const int NBLK = MT / RB;
    for (int blk = 0; blk < NBLK; ++blk) {
        const int cur = blk & 1;
        if (blk + 1 < NBLK) {
#pragma unroll
            for (int s = 0; s < RB; ++s) { const int r = rowof((blk + 1) * RB + s); pre[s] = bf2f(Z[(size_t)r * NZ + colq]) * qs; }
            if (tid < 2 * RB) { const int s = tid >> 1, w = tid & 1, r = rowof((blk + 1) * RB + s); preg = G16[(size_t)r * 16 + dir * 8 + w * 4 + h] + (w ? bfv : bi); }
        }
#pragma unroll 1
        for (int s = 0; s < RB; ++s) {
            const int t = blk * RB + s, buf = t & 1;
            const LAS float* rb = RBUF + (cur * RB + s) * ROWF;
            const float ip = rb[512], fp = rb[513];
            const float lf = fminf(fp, 0.f) - log1pf(expf(-fabsf(fp)));
            const float mn = fmaxf(lf + m, ip), fw = expf(lf + m - mn), iw = expf(ip - mn), em = expf(-mn); m = mn;
            const float ve = rb[256 + e]; float part = 0.f;
#pragma unroll
            for (int dd = 0; dd < 64; dd += 4) {
                const f32x4 q4 = *(const LAS f32x4*)(rb + 64 * half + dd), k4 = *(const LAS f32x4*)(rb + 128 + 64 * half + dd);
                C[dd + 0] = fw * C[dd + 0] + (iw * k4.x) * ve; part += q4.x * C[dd + 0];
                C[dd + 1] = fw * C[dd + 1] + (iw * k4.y) * ve; part += q4.y * C[dd + 1];
                C[dd + 2] = fw * C[dd + 2] + (iw * k4.z) * ve; part += q4.z * C[dd + 2];
                C[dd + 3] = fw * C[dd + 3] + (iw * k4.w) * ve; part += q4.w * C[dd + 3];
            }
            if (e < 64) { const int d = 64 * half + e; nreg = fw * nreg + iw * rb[128 + d]; const float dp = wave_sum(rb[d] * nreg); if (lane == 0) DENP[buf * 2 + half] = dp; }
            if (half) NUMP[buf * 256 + e] = part;
            __syncthreads();
            if (!half) { const float num = part + NUMP[buf * 256 + e], den = DENP[buf * 2] + DENP[buf * 2 + 1];
                const int r = rowof(t); MLH[((size_t)dir * MT + r) * 1024 + h * 256 + e] = num / fmaxf(fabsf(den), em); }
        }
        if (blk + 1 < NBLK) {
#pragma unroll
            for (int s = 0; s < RB; ++s) RBUF[((cur ^ 1) * RB + s) * ROWF + tid] = pre[s];
            if (tid < 2 * RB) RBUF[((cur ^ 1) * RB + (tid >> 1)) * ROWF + 512 + (tid & 1)] = preg;
        }
        __syncthreads();
    }
}

__device__ __forceinline__ void phase_post(const float* ATTO, const float* MLH, const bf16* Z, const float* dng, const float* mng, float lam, float linit, bf16* YB, bf16* YC, int bid, int G, int tid) {
    const int wave = tid >> 6, lane = tid & 63, head = lane >> 4, e0 = (lane & 15) * 16;
    for (int row = bid * NWAVES + wave; row < MT; row += G * NWAVES) {
        const size_t off = (size_t)row * 1024 + head * 256 + e0;
        {
            const f32x4* a0 = (const f32x4*)(ATTO + off); const f32x4* a1 = (const f32x4*)(ATTO + (size_t)MT * 1024 + off);
            float o[16]; float ss = 0.f;
#pragma unroll
            for (int k = 0; k < 4; ++k) { const f32x4 p = a0[k], q = a1[k];
                o[4 * k + 0] = p.x - lam * q.x; o[4 * k + 1] = p.y - lam * q.y; o[4 * k + 2] = p.z - lam * q.z; o[4 * k + 3] = p.w - lam * q.w; }
#pragma unroll
            for (int k = 0; k < 16; ++k) ss += o[k] * o[k];
            ss += __shfl_xor(ss, 1); ss += __shfl_xor(ss, 2); ss += __shfl_xor(ss, 4); ss += __shfl_xor(ss, 8);
            const float rstd = 1.f / sqrtf(ss * (1.f / 256.f) + EPS) * (1.f - linit);
            v4u w0, w1;
            w0.x = pk2(o[0] * rstd * dng[e0 + 0], o[1] * rstd * dng[e0 + 1]); w0.y = pk2(o[2] * rstd * dng[e0 + 2], o[3] * rstd * dng[e0 + 3]);
            w0.z = pk2(o[4] * rstd * dng[e0 + 4], o[5] * rstd * dng[e0 + 5]); w0.w = pk2(o[6] * rstd * dng[e0 + 6], o[7] * rstd * dng[e0 + 7]);
            w1.x = pk2(o[8] * rstd * dng[e0 + 8], o[9] * rstd * dng[e0 + 9]); w1.y = pk2(o[10] * rstd * dng[e0 + 10], o[11] * rstd * dng[e0 + 11]);
            w1.z = pk2(o[12] * rstd * dng[e0 + 12], o[13] * rstd * dng[e0 + 13]); w1.w = pk2(o[14] * rstd * dng[e0 + 14], o[15] * rstd * dng[e0 + 15]);
            v4u* yp = (v4u*)(YC + off); yp[0] = w0; yp[1] = w1;
        }
        {
            const f32x4* a0 = (const f32x4*)(MLH + off); const f32x4* a1 = (const f32x4*)(MLH + (size_t)MT * 1024 + off);
            float o[16]; float ss = 0.f;
#pragma unroll
            for (int k = 0; k < 4; ++k) { const f32x4 p = a0[k], q = a1[k]; o[4 * k + 0] = p.x + q.x; o[4 * k + 1] = p.y + q.y; o[4 * k + 2] = p.z + q.z; o[4 * k + 3] = p.w + q.w; }
#pragma unroll
            for (int k = 0; k < 16; ++k) ss += o[k] * o[k];
            ss += __shfl_xor(ss, 1); ss += __shfl_xor(ss, 2); ss += __shfl_xor(ss, 4); ss += __shfl_xor(ss, 8);
            const float rstd = 1.f / sqrtf(ss * (1.f / 256.f) + EPS);
            const v4u* zp = (const v4u*)(Z + (size_t)row * NZ + ZC_MO + head * 256 + e0); const v4u g0 = zp[0], g1 = zp[1];
            const unsigned gw[8] = {g0.x, g0.y, g0.z, g0.w, g1.x, g1.y, g1.z, g1.w};
            unsigned ow[8];
#pragma unroll
            for (int k = 0; k < 8; ++k) { const float y0 = sigmoid_f(bflo(gw[k])) * o[2 * k] * rstd * mng[head * 256 + e0 + 2 * k], y1 = sigmoid_f(bfhi(gw[k])) * o[2 * k + 1] * rstd * mng[head * 256 + e0 + 2 * k + 1];
                ow[k] = pk2(y0, y1); }
            v4u* yp = (v4u*)(YB + off); yp[0] = (v4u){ow[0], ow[1], ow[2], ow[3]}; yp[1] = (v4u){ow[4], ow[5], ow[6], ow[7]};
        }
    }
}

#ifndef MK_ONE_LAUNCH
#define MK_ONE_LAUNCH 0
#endif
struct Args { const float* in[21]; float* out; unsigned char* ws; int ph_lo, ph_hi; };
static_assert(sizeof(Args) == 21 * 8 + 8 + 8 + 8, "Args has no padding");

constexpr int T_ALL = -1, T_PRO0 = 0, T_PRO1 = 1, T_NORM = 2, T_W13 = 3, T_W2 = 4, T_N2 = 5, T_WIN = 6, T_ROPE = 7, T_MLSTM = 8, T_POST = 9, T_MERGE0 = 10, T_WOUT = 11, T_FINAL = 12, T_ATTN = 13, T_GMLP = 14, T_MERGE1 = 15, T_MERGE2 = 16, NTYPES = 17;
#define SELD(t) (SEL == T_ALL || SEL == (t))
template <int SEL> __global__ void __launch_bounds__(NTHR, 2) mk_fwd(Args args) {
    extern __shared__ __attribute__((aligned(16))) unsigned char lds_raw[];
    LAS unsigned char* lds = (LAS unsigned char*)lds_raw;
    volatile LAS unsigned* MISC = (volatile LAS unsigned*)(lds + MISC_OFF);
    const int tid = threadIdx.x, bid = blockIdx.x, G = gridDim.x;
    Ptrs P;
    P.x = args.in[0]; P.c = args.in[1]; P.ctx = args.in[2]; P.c_ctx = args.in[3]; P.ada_down = args.in[4]; P.ada_up = args.in[5]; P.ada_bias = args.in[6]; P.norm_g = args.in[7];
    P.w13 = args.in[8]; P.w2 = args.in[9]; P.w_in = args.in[10]; P.gmlp_norm_g = args.in[11]; P.gmlp_ws = args.in[12]; P.gmlp_bs = args.in[13]; P.gate_b = args.in[14];
    P.mlstm_norm_g = args.in[15]; P.diff_lambda = args.in[16]; P.diff_norm_g = args.in[17]; P.w_branch = args.in[18]; P.w_out = args.in[19]; P.final_g = args.in[20];
    P.out = args.out; P.ws = args.ws;
    unsigned char* ws = args.ws;
    gu32* ctl = (gu32*)(ws + WS_CTL);
    for (int u = tid; u < (LDS_BYTES - LDSCTL_OFF) / 4; u += NTHR) ((LAS unsigned*)(lds + LDSCTL_OFF))[u] = 0u;
    __syncthreads();
#if MK_ONE_LAUNCH
    XcdBarrier bar = xcd_barrier_post((unsigned*)(ctl + CW_BAR), MISC + 8);
#define GRID_BAR() xcd_barrier(bar)
#else
#define GRID_BAR() do {} while (0)
#endif
    const int lo = args.ph_lo, hi = args.ph_hi;
#define IN(k) (lo <= (k) && (k) < hi)
#define SEAM(k) do { if (IN(k) && IN((k) + 1)) GRID_BAR(); } while (0)

    float* XR = (float*)(ws + WS_XR); bf16* H = (bf16*)(ws + WS_H); bf16* GB = (bf16*)(ws + WS_GB); bf16* Z = (bf16*)(ws + WS_Z);
    float* ATTO = (float*)(ws + WS_ATTO); float* MLH = (float*)(ws + WS_MLH); bf16* YA = (bf16*)(ws + WS_YA); bf16* YB = (bf16*)(ws + WS_YB); bf16* YC = (bf16*)(ws + WS_YC);
    float* YACC = (float*)(ws + WS_YACC); bf16* Y = (bf16*)(ws + WS_Y); float* G16 = (float*)(ws + WS_G16);
    const float* MOD = (const float*)(ws + WS_MOD);

    if constexpr (SELD(T_PRO0)) if (IN(P_PRO0)) { pro0(P, lds, bid, G, tid); SEAM(P_PRO0); }
    if constexpr (SELD(T_PRO1)) if (IN(P_PRO1)) { pro1(P, lds, bid, G, tid); SEAM(P_PRO1); }

    for (int l = 0; l < DEPTH; ++l) {
        const int pb = P_LAYER0 + l * NPL;
        if (hi <= pb || lo >= pb + NPL) continue;
        const float* modl = MOD + (size_t)(l * 2 + 0) * NMOD; const float* modc = MOD + (size_t)(l * 2 + 1) * NMOD;
        const bf16* W13T0 = (const bf16*)(ws + WS_W13T) + (size_t)(l * 2 + 0) * 8192 * 4096; const bf16* W13T1 = W13T0 + (size_t)8192 * 4096;
        const bf16* W2T0 = (const bf16*)(ws + WS_W2T) + (size_t)(l * 2 + 0) * 4096 * 4096; const bf16* W2T1 = W2T0 + (size_t)4096 * 4096;
        const bf16* WINT = (const bf16*)(ws + WS_WINT) + (size_t)l * NZ * 4096;
        const bf16* WBT = (const bf16*)(ws + WS_WBT) + (size_t)(l * 3) * 4096 * 1024;
        const bf16* WOT = (const bf16*)(ws + WS_WOT) + (size_t)l * 4096 * 4096;

        if constexpr (SELD(T_NORM)) if (IN(pb + L_N1)) { phase_norm<false>(XR, P.norm_g + (size_t)(l * 3 + 0) * DM, modl + 0 * 3 * DM, modc + 0 * 3 * DM, H, nullptr, nullptr, bid, G, tid); SEAM(pb + L_N1); }
        if constexpr (SELD(T_W13)) if (IN(pb + L_W13A)) { pg8::Gemm g{H, W13T0, MT, 8192, DM}; pg8::StaticOrder S; S.init(MT, 8192, G, bid); pg8::EpiSwiglu E{GB, FFND};
            pg8::gemm_phase<pg8::EpiSwiglu, pg8::StaticOrder, true, true>(lds + RING_OFF, g, S, E); SEAM(pb + L_W13A); }
        if constexpr (SELD(T_W2)) if (IN(pb + L_W2A)) { pg8::Gemm g{GB, W2T0, MT, DM, FFND}; pg8::StaticOrder S; S.init(MT, DM, G, bid); pg8::EpiResid E{XR, modl + 0 * 3 * DM + 2 * DM, modc + 0 * 3 * DM + 2 * DM, 0.5f};
            pg8::gemm_phase<pg8::EpiResid, pg8::StaticOrder, true, true>(lds + RING_OFF, g, S, E); SEAM(pb + L_W2A); }
        if constexpr (SELD(T_N2)) if (IN(pb + L_N2)) { phase_norm<true>(XR, P.norm_g + (size_t)(l * 3 + 1) * DM, modl + 1 * 3 * DM, modc + 1 * 3 * DM, H, (const float*)(ws + WS_WG16) + (size_t)l * 16 * DM, G16, bid, G, tid); SEAM(pb + L_N2); }
        if constexpr (SELD(T_WIN)) if (IN(pb + L_WIN)) { pg8::Gemm g{H, WINT, MT, NZ, DM}; pg8::StaticOrder S; S.init(MT, NZ, G, bid); pg8::EpiBf16<0> E{Z, NZ, nullptr, 0, 0, 1.f};
            pg8::gemm_phase<pg8::EpiBf16<0>, pg8::StaticOrder, true, true>(lds + RING_OFF, g, S, E); SEAM(pb + L_WIN); }
        if constexpr (SELD(T_ROPE)) if (IN(pb + L_ROPE)) { phase_rope(Z, (const float*)(ws + WS_ROPE), (const float*)(ws + WS_ROPE) + SEQ * 64, bid, G, tid); SEAM(pb + L_ROPE); }
        if constexpr (SELD(T_MLSTM)) if (IN(pb + L_MLSTM)) {
            if (bid >= G - 8) mlstm_chain_naive(Z, G16, P.gate_b + (size_t)l * 16, MLH, bid - (G - 8), lds, tid);
            __syncthreads();
            SEAM(pb + L_MLSTM);
        }
        if constexpr (SELD(T_ATTN)) if (IN(pb + L_ATTN)) {
            for (int u = bid; u < 528; u += G) {
                int ph, qb, seq; if (u < 512) { ph = u >> 5; qb = 1 + (u & 31); seq = MT; } else { ph = u - 512; qb = 0; seq = CTXL; }
                const int h = ph >> 2, mm = (ph >> 1) & 1, half = ph & 1;
                const attn128::bf16* Zb = (const attn128::bf16*)Z;
                attn128::attn_dense_body<attn128::bf16>(Zb + (size_t)(qb * 256) * NZ + ZC_AQ + h * 256 + mm * 128, Zb + ZC_AK + h * 256 + mm * 128, Zb + ZC_AV + h * 256 + half * 128,
                                                        ATTO + (size_t)mm * MT * 1024 + (size_t)(qb * 256) * 1024 + h * 256 + half * 128, seq, (char*)lds_raw);
                __syncthreads();
            }
            SEAM(pb + L_ATTN);
        }
        if constexpr (SELD(T_GMLP)) if (IN(pb + L_GMLP)) {
            for (int u = bid; u < 528; u += G) { const int j = u >> 3, g = u & 7;
                gmlp_unit(Z, P.gmlp_norm_g + (size_t)l * 1024, P.gmlp_ws + ((size_t)l * 8 + g) * 128 * 128, P.gmlp_bs + ((size_t)l * 8 + g) * 128, YA, j, g, lds, tid); }
            SEAM(pb + L_GMLP);
        }
        if constexpr (SELD(T_POST)) if (IN(pb + L_POST)) { phase_post(ATTO, MLH, Z, P.diff_norm_g + (size_t)l * 256, P.mlstm_norm_g + (size_t)l * 1024, ((const float*)(ws + WS_LAM))[l], lambda_init_f(l), YB, YC, bid, G, tid); SEAM(pb + L_POST); }
        if constexpr (SELD(T_MERGE0)) if (IN(pb + L_MERGE0)) {
            pg8::Gemm g{YA, WBT, MT, DM, 1024}; pg8::StaticOrder S; S.init(MT, DM, G, bid); pg8::EpiMerge<0> E{Z, YACC, Y};
            pg8::gemm_phase<pg8::EpiMerge<0>, pg8::StaticOrder, true, true>(lds + RING_OFF, g, S, E); SEAM(pb + L_MERGE0); }
        if constexpr (SELD(T_MERGE1)) if (IN(pb + L_MERGE1)) {
            pg8::Gemm g{YB, WBT + (size_t)4096 * 1024, MT, DM, 1024}; pg8::StaticOrder S; S.init(MT, DM, G, bid); pg8::EpiMerge<1> E{Z, YACC, Y};
            pg8::gemm_phase<pg8::EpiMerge<1>, pg8::StaticOrder, true, true>(lds + RING_OFF, g, S, E); SEAM(pb + L_MERGE1); }
        if constexpr (SELD(T_MERGE2)) if (IN(pb + L_MERGE2)) {
            pg8::Gemm g{YC, WBT + (size_t)2 * 4096 * 1024, MT, DM, 1024}; pg8::StaticOrder S; S.init(MT, DM, G, bid); pg8::EpiMerge<2> E{Z, YACC, Y};
            pg8::gemm_phase<pg8::EpiMerge<2>, pg8::StaticOrder, true, true>(lds + RING_OFF, g, S, E); SEAM(pb + L_MERGE2); }
        if constexpr (SELD(T_WOUT)) if (IN(pb + L_WOUT)) { pg8::Gemm g{Y, WOT, MT, DM, DM}; pg8::StaticOrder S; S.init(MT, DM, G, bid); pg8::EpiResid E{XR, modl + 1 * 3 * DM + 2 * DM, modc + 1 * 3 * DM + 2 * DM, 1.f};
            pg8::gemm_phase<pg8::EpiResid, pg8::StaticOrder, true, true>(lds + RING_OFF, g, S, E); SEAM(pb + L_WOUT); }
        if constexpr (SELD(T_NORM)) if (IN(pb + L_N3)) { phase_norm<false>(XR, P.norm_g + (size_t)(l * 3 + 2) * DM, modl + 2 * 3 * DM, modc + 2 * 3 * DM, H, nullptr, nullptr, bid, G, tid); SEAM(pb + L_N3); }
        if constexpr (SELD(T_W13)) if (IN(pb + L_W13B)) { pg8::Gemm g{H, W13T1, MT, 8192, DM}; pg8::StaticOrder S; S.init(MT, 8192, G, bid); pg8::EpiSwiglu E{GB, FFND};
            pg8::gemm_phase<pg8::EpiSwiglu, pg8::StaticOrder, true, true>(lds + RING_OFF, g, S, E); SEAM(pb + L_W13B); }
        if constexpr (SELD(T_W2)) if (IN(pb + L_W2B)) { pg8::Gemm g{GB, W2T1, MT, DM, FFND}; pg8::StaticOrder S; S.init(MT, DM, G, bid); pg8::EpiResid E{XR, modl + 2 * 3 * DM + 2 * DM, modc + 2 * 3 * DM + 2 * DM, 0.5f};
            pg8::gemm_phase<pg8::EpiResid, pg8::StaticOrder, true, true>(lds + RING_OFF, g, S, E); SEAM(pb + L_W2B); }
    }
    if constexpr (SELD(T_FINAL)) if (IN(P_FINAL)) phase_final(XR, P.final_g, P.out, bid, G, tid);
#undef IN
#undef SEAM
}

__host__ inline int phase_type(int p) {
    if (p == P_PRO0) return T_PRO0; if (p == P_PRO1) return T_PRO1; if (p == P_FINAL) return T_FINAL;
    const int q = (p - P_LAYER0) % NPL;
    const int map[NPL] = {T_NORM, T_W13, T_W2, T_N2, T_WIN, T_ROPE, T_MLSTM, T_ATTN, T_GMLP, T_POST, T_MERGE0, T_MERGE1, T_MERGE2, T_WOUT, T_NORM, T_W13, T_W2};
    return map[q];
}
typedef void (*kern_t)(Args);
template <int T> struct KTab { static void fill(kern_t* t) { t[T] = mk_fwd<T>; KTab<T - 1>::fill(t); } };
template <> struct KTab<-1> { static void fill(kern_t*) {} };

extern "C" void kernel_launch(void* const* d_in, const int* in_sizes, int n_in, void* d_out, int out_size, void* d_ws, size_t ws_size, hipStream_t stream) {
    static int grid = 0;
    static kern_t ktab[NTYPES];
    if (grid == 0) {
        if (n_in != 21 || in_sizes[0] != SEQ * DM || out_size != SEQ * DM || ws_size < WS_END) {
            fprintf(stderr, "kernel_launch: unexpected shapes: n_in %d in0 %d out %d ws %zu (need %zu)\n", n_in, n_in > 0 ? in_sizes[0] : -1, out_size, ws_size, (size_t)WS_END); grid = -1; return; }
        int dev = 0, cus = 0;
        if (hipGetDevice(&dev) != hipSuccess || hipDeviceGetAttribute(&cus, hipDeviceAttributeMultiprocessorCount, dev) != hipSuccess) { grid = -1; return; }
#if MK_ONE_LAUNCH
        if (hipFuncSetAttribute((const void*)mk_fwd<T_ALL>, hipFuncAttributeMaxDynamicSharedMemorySize, LDS_BYTES) != hipSuccess) { fprintf(stderr, "kernel_launch: hipFuncSetAttribute failed\n"); grid = -1; return; }
#else
        KTab<NTYPES - 1>::fill(ktab);
        for (int t = 0; t < NTYPES; ++t) if (hipFuncSetAttribute((const void*)ktab[t], hipFuncAttributeMaxDynamicSharedMemorySize, LDS_BYTES) != hipSuccess) { fprintf(stderr, "kernel_launch: hipFuncSetAttribute failed\n"); grid = -1; return; }
#endif
        (void)hipGetLastError();
        grid = cus;
    }
    if (grid < 0) return;
    (void)hipMemsetAsync((char*)d_ws + WS_CTL, 0, CTL_ZERO_BYTES, stream);
    Args a{};
    for (int i = 0; i < 21; ++i) a.in[i] = (const float*)d_in[i];
    a.out = (float*)d_out; a.ws = (unsigned char*)d_ws;
#if MK_ONE_LAUNCH
    a.ph_lo = 0; a.ph_hi = NPH;
    hipLaunchKernelGGL(mk_fwd<T_ALL>, dim3(grid), dim3(NTHR), LDS_BYTES, stream, a);
#else
    for (int p = 0; p < NPH; ++p) { a.ph_lo = p; a.ph_hi = p + 1; hipLaunchKernelGGL(ktab[phase_type(p)], dim3(grid), dim3(NTHR), LDS_BYTES, stream, a); }
#endif
    const hipError_t le = hipPeekAtLastError();
    if (le != hipSuccess) fprintf(stderr, "kernel_launch: launch failed: %s\n", hipGetErrorName(le));
}
```

```cpp
#include <hip/hip_runtime.h>
#include <hip/hip_bf16.h>
#include <cstdio>
#include <cstdint>
#include <cmath>
#ifndef MLSTM_CHUNKWISE
#define MLSTM_CHUNKWISE 1
#endif
#ifndef MK_ONE_LAUNCH
#define MK_ONE_LAUNCH 1
#endif
#ifndef DBL_ATTN
#define DBL_ATTN 1
#endif
#ifndef DBL_PRO
#define DBL_PRO 1
#endif
#ifndef DBL_M1
#define DBL_M1 1
#endif
#ifndef DBL_GMLP
#define DBL_GMLP 1
#endif
#ifndef DBL_POST
#define DBL_POST 1
#endif
#ifndef DBL_M3
#define DBL_M3 1
#endif
#ifndef DBL_NORM
#define DBL_NORM 1
#endif
__device__ __forceinline__ int mk_lane_id() { int l_; asm volatile("v_mbcnt_lo_u32_b32 %0, -1, 0\n\tv_mbcnt_hi_u32_b32 %0, -1, %0" : "=v"(l_)); return l_; }
#define MK_TID(wave_s_) (((wave_s_) << 6) | mk_lane_id())
namespace pg8 {
#define PG8_LAS __attribute__((address_space(3)))
typedef unsigned short bf16_t;
typedef short bf16x8 __attribute__((ext_vector_type(8)));
typedef float f32x4 __attribute__((ext_vector_type(4)));
typedef unsigned u32x4 __attribute__((ext_vector_type(4)));
constexpr int BM = 256, BK = 64, HALF = 128, HTB = HALF * BK * 2  , STAGE_BYTES = 8 * HTB, NXCD = 8, WGM = 8;

__host__ __device__ __forceinline__ int lds_byte(int r, int c) { const int st = (r >> 4) * 2 + (c >> 5), rr = r & 15, cc = c & 31, ob = rr * 64 + cc * 2; return st * 1024 + (ob ^ (((ob >> 9) & 1) << 5)); }
__host__ __device__ __forceinline__ void stage_rc(int b, int& R, int& C) { const int st = b / 1024, sb = b % 1024, swz = sb ^ (((sb >> 9) & 1) << 5); R = (st >> 1) * 16 + swz / 64; C = (st & 1) * 32 + (swz % 64) / 2; }
__host__ __device__ __forceinline__ int perm32(int rho) { const int n = rho >> 4, i = rho & 15; return 8 * (i >> 2) + 4 * n + (i & 3); }

struct Unit { int pm, pn, koff, boff, fl;
    __device__ __forceinline__ int seg() const { return fl & 3; } __device__ __forceinline__ bool carry() const { return (fl & 4) != 0; } __device__ __forceinline__ int ntile() const { return fl >> 8; } };
struct Gemm { const bf16_t* A; const bf16_t* Bt; int M, N, K, ld; };

struct StaticOrder {
    int nM, nN, nwg, G, c;
    __host__ __device__ void init(int M, int N, int G_, int c_) { nM = M / BM; nN = N / BM; nwg = nM * nN; G = G_; c = c_; }
    __host__ __device__ bool next(int i, Unit& u) const {
        const long L = (long)i * G + c; if (L >= nwg) return false;
        int wgid = (int)L; { const int q = nwg / NXCD, r = nwg % NXCD, xcd = wgid % NXCD, off = wgid / NXCD; wgid = (xcd < r ? xcd * (q + 1) : r * (q + 1) + (xcd - r) * q) + off; }
        const int nig = WGM * nN, gid = wgid / nig, fm = gid * WGM, gsz = (nM - fm) < WGM ? (nM - fm) : WGM;
        u.pm = fm + ((wgid % nig) % gsz); u.pn = (wgid % nig) / gsz; u.koff = 0; u.boff = 0; u.fl = 0; return true;
    }
    __device__ __forceinline__ void a_ready(const Unit&) const {}
    __device__ __forceinline__ void done(const Unit&) const {}
};

__device__ __forceinline__ unsigned cvt_pk_bf16(float lo, float hi) { unsigned r; asm volatile("v_cvt_pk_bf16_f32 %0, %1, %2" : "=v"(r) : "v"(lo), "v"(hi)); return r; }
typedef float f32x2 __attribute__((ext_vector_type(2)));
__device__ __forceinline__ f32x2 gelu_pk(f32x2 v) {
    const f32x2 av = __builtin_elementwise_abs(v), d = av * 0.2316418882f + 1.0f;
    f32x2 t; t.x = __builtin_amdgcn_rcpf(d.x); t.y = __builtin_amdgcn_rcpf(d.y);
    f32x2 q = t * 0.5307027145f + (-0.7265760135f); q = q * t + 0.7107068705f; q = q * t + (-0.142248368f); q = q * t + 0.127414796f; q = q * t;
    const f32x2 s = (v * v) * (-0.72134752044f);
    f32x2 e; e.x = __builtin_amdgcn_exp2f(s.x); e.y = __builtin_amdgcn_exp2f(s.y);
    const f32x2 m = v * (q * e), r = v - m;
    f32x2 o; o.x = v.x < 0.f ? m.x : r.x; o.y = v.y < 0.f ? m.y : r.y; return o;
}

template <int ACT  > struct EpiBf16 {
    static constexpr bool PERM = true, AFTER_DRAIN = false; static_assert(ACT == 0 || ACT == 1, "EpiBf16: ACT is 0 (none) or 1 (gelu_pk)");
    bf16_t* O; int ldc; const float* bias; int split_cols; size_t split_stride; float scale0;
    __device__ __forceinline__ void operator()(const f32x4 (&acc)[2][2][4][2], const Unit& u, int wr, int wc, int fr, int fq) const {
        const int row0 = u.pm * BM + wr * 64 + fr; int colt = u.pn * BM; bf16_t* base = O;
        float sc = 1.f; if (split_cols) { const int t = colt / split_cols; base += (size_t)t * split_stride; colt -= t * split_cols; if (t == 0) sc = scale0; }
        const int col0 = colt + wc * 32 + 8 * fq, bcol0 = u.pn * BM + wc * 32 + 8 * fq;
        f32x4 bv[2][2];
#pragma unroll
        for (int bj = 0; bj < 2; ++bj)
#pragma unroll
            for (int n = 0; n < 2; ++n) bv[bj][n] = bias ? *(const f32x4*)(bias + bcol0 + bj * HALF + 4 * n) : (f32x4){0.f, 0.f, 0.f, 0.f};
#pragma unroll
        for (int ai = 0; ai < 2; ++ai)
#pragma unroll
            for (int m = 0; m < 4; ++m) { bf16_t* rowp = base + (size_t)(row0 + ai * HALF + m * 16) * ldc + col0;
#pragma unroll
                for (int bj = 0; bj < 2; ++bj) { f32x4 v0 = acc[ai][bj][m][0] + bv[bj][0], v1 = acc[ai][bj][m][1] + bv[bj][1];
                    if (ACT == 1) { f32x2 a = gelu_pk((f32x2){v0[0], v0[1]}), b = gelu_pk((f32x2){v0[2], v0[3]}), c = gelu_pk((f32x2){v1[0], v1[1]}), d = gelu_pk((f32x2){v1[2], v1[3]});
                        v0 = (f32x4){a.x, a.y, b.x, b.y}; v1 = (f32x4){c.x, c.y, d.x, d.y}; }
                    v0 = v0 * sc; v1 = v1 * sc; u32x4 w; w.x = cvt_pk_bf16(v0[0], v0[1]); w.y = cvt_pk_bf16(v0[2], v0[3]); w.z = cvt_pk_bf16(v1[0], v1[1]); w.w = cvt_pk_bf16(v1[2], v1[3]);
                    *(u32x4*)(rowp + bj * HALF) = w; } }
    }
};

struct PanelStats {
    unsigned* xbuf;
    unsigned* cnt;
    unsigned* tmo;
    int ntn; float eps;
    unsigned code;
    __device__ __forceinline__ bool run(const f32x4 (&v)[2][2][4][2], const Unit& u, int wr, int wc, int fr, int fq, PG8_LAS unsigned char* lds, int wid, int lane) const {
        typedef float f32x2v __attribute__((ext_vector_type(2)));
        PG8_LAS f32x2v* P = (PG8_LAS f32x2v*)lds;
        PG8_LAS f32x2v* S = (PG8_LAS f32x2v*)(lds + 8192);
        PG8_LAS unsigned* flag = (PG8_LAS unsigned*)(lds + 8192 + 2048);
#pragma unroll
        for (int ai = 0; ai < 2; ++ai)
#pragma unroll
            for (int m = 0; m < 4; ++m) {
                float s = 0.f;
#pragma unroll
                for (int bj = 0; bj < 2; ++bj)
#pragma unroll
                    for (int n = 0; n < 2; ++n) { const f32x4 x = v[ai][bj][m][n]; s += (x[0] + x[1]) + (x[2] + x[3]); }
                s += __shfl_xor(s, 16); s += __shfl_xor(s, 32);
                const float mw = s * (1.0f / 64.0f); float q = 0.f;
#pragma unroll
                for (int bj = 0; bj < 2; ++bj)
#pragma unroll
                    for (int n = 0; n < 2; ++n) { const f32x4 d = v[ai][bj][m][n] - mw; q += (d[0] * d[0] + d[1] * d[1]) + (d[2] * d[2] + d[3] * d[3]); }
                q += __shfl_xor(q, 16); q += __shfl_xor(q, 32);
                if (fq == 0) P[(ai * HALF + wr * 64 + m * 16 + fr) * 4 + wc] = (f32x2v){mw, q};
            }
        asm volatile("s_waitcnt lgkmcnt(0)" ::: "memory"); __builtin_amdgcn_s_barrier(); asm volatile("" ::: "memory");
#if defined(BROKEN_EXCHANGE_NO_WAIT)
#warning BROKEN CONTROL BUILD: the row-statistics exchange does not wait; results are wrong by design
        if (blockIdx.x >= 64) { const long long t0_ = clock64(); while (clock64() - t0_ < 60000) __builtin_amdgcn_s_sleep(8); }
#endif
        const int row = wid * 32 + (lane & 31);
        if (lane < 32) {
            const f32x2v a = P[row * 4 + 0], b = P[row * 4 + 1], c = P[row * 4 + 2], d = P[row * 4 + 3];
            const float mt = (a.x + b.x + c.x + d.x) * 0.25f;
            const float da = a.x - mt, db = b.x - mt, dc = c.x - mt, dd = d.x - mt;
            const float m2 = (a.y + b.y) + (c.y + d.y) + 64.0f * ((da * da + db * db) + (dc * dc + dd * dd));
            unsigned long long* slot = (unsigned long long*)xbuf + ((size_t)(u.pm * BM + row) * 4 + u.pn);
            __hip_atomic_store(slot, ((unsigned long long)__float_as_uint(m2) << 32) | __float_as_uint(mt), __ATOMIC_RELAXED, __HIP_MEMORY_SCOPE_AGENT);
        }
        asm volatile("s_waitcnt vmcnt(0)" ::: "memory");
        if (lane == 0) __hip_atomic_fetch_add(cnt + 64 * u.pm, 1u, __ATOMIC_RELAXED, __HIP_MEMORY_SCOPE_AGENT);
        if (wid == 0) {
            bool dead = false; const unsigned long long t0 = __builtin_amdgcn_s_memrealtime(); const unsigned want = 8u * (unsigned)ntn;
            for (;;) {
#if defined(BROKEN_EXCHANGE_NO_WAIT)
                break;
#endif
                if ((unsigned)__builtin_amdgcn_readfirstlane(__hip_atomic_load(cnt + 64 * u.pm, __ATOMIC_RELAXED, __HIP_MEMORY_SCOPE_AGENT)) >= want) break;
                if (__builtin_amdgcn_s_memrealtime() - t0 > 2000000ull) {
                    if (lane == 0) { unsigned expect = 0u; __hip_atomic_compare_exchange_strong(tmo + 1, &expect, code | (unsigned)(u.pm & 0xff), __ATOMIC_RELAXED, __ATOMIC_RELAXED, __HIP_MEMORY_SCOPE_AGENT);
                                     __hip_atomic_store(tmo, 1u, __ATOMIC_RELAXED, __HIP_MEMORY_SCOPE_AGENT); }
                    dead = true; break; }
                __builtin_amdgcn_s_sleep(2);
            }
            __builtin_amdgcn_fence(__ATOMIC_ACQUIRE, "agent");
            if (lane == 0) flag[0] = dead ? 1u : 0u;
        }
        asm volatile("s_waitcnt vmcnt(0) lgkmcnt(0)" ::: "memory"); __builtin_amdgcn_s_barrier(); asm volatile("" ::: "memory");
        const bool bad = flag[0] != 0u;
        if (lane < 32) {
            const unsigned long long* slot = (const unsigned long long*)xbuf + (size_t)(u.pm * BM + row) * 4; float mt[4], m2[4]; float ms = 0.f;
#pragma unroll
            for (int t = 0; t < 4; ++t) { if (t < ntn) { const unsigned long long w = __hip_atomic_load(slot + t, __ATOMIC_RELAXED, __HIP_MEMORY_SCOPE_AGENT); mt[t] = __uint_as_float((unsigned)w); m2[t] = __uint_as_float((unsigned)(w >> 32)); } else { mt[t] = 0.f; m2[t] = 0.f; } ms += mt[t]; }
            const float mean = ms / (float)ntn; float q = 0.f;
#pragma unroll
            for (int t = 0; t < 4; ++t) if (t < ntn) { const float dm = mt[t] - mean; q += m2[t] + 256.0f * dm * dm; }
            S[row] = (f32x2v){mean, 1.0f / sqrtf(q / (256.0f * (float)ntn) + eps)};
        }
        asm volatile("s_waitcnt lgkmcnt(0)" ::: "memory"); __builtin_amdgcn_s_barrier(); asm volatile("" ::: "memory");
        return bad;
    }
};
struct EpiLnRes {
    static constexpr bool PERM = false, AFTER_DRAIN = true;
    const float* base; float* out; int ldc; const float* bias; PanelStats st; unsigned poison;
    __device__ __forceinline__ void fused(f32x4 (&acc)[2][2][4][2], const Unit& u, int wr, int wc, int fr, int fq, PG8_LAS unsigned char* lds, int wid, int lane) const {
        typedef float f32x2v __attribute__((ext_vector_type(2)));
        const PG8_LAS f32x2v* S = (const PG8_LAS f32x2v*)(lds + 8192);
        const int col0 = u.pn * BM + wc * 32 + 4 * fq;
#pragma unroll
        for (int bj = 0; bj < 2; ++bj)
#pragma unroll
            for (int n = 0; n < 2; ++n) { const f32x4 bv = bias ? *(const f32x4*)(bias + col0 + bj * HALF + n * 16) : (f32x4){0.f, 0.f, 0.f, 0.f};
#pragma unroll
                for (int ai = 0; ai < 2; ++ai)
#pragma unroll
                    for (int m = 0; m < 4; ++m) acc[ai][bj][m][n] += bv; }
        f32x4 pre[4][2][2];
#pragma unroll
        for (int m = 0; m < 4; ++m) { const size_t off = (size_t)(u.pm * BM + wr * 64 + m * 16 + fr) * ldc + col0;
#pragma unroll
            for (int bj = 0; bj < 2; ++bj)
#pragma unroll
                for (int n = 0; n < 2; ++n) pre[m][bj][n] = *(const f32x4*)(base + off + bj * HALF + n * 16); }
        const bool bad = st.run(acc, u, wr, wc, fr, fq, lds, wid, lane) || poison != 0u;
        const float qnan = __builtin_nanf("");
#pragma unroll
        for (int ai = 0; ai < 2; ++ai)
#pragma unroll
            for (int m = 0; m < 4; ++m) { const int r = ai * HALF + wr * 64 + m * 16 + fr; const f32x2v sr = S[r]; const size_t off = (size_t)(u.pm * BM + r) * ldc + col0;
#pragma unroll
                for (int bj = 0; bj < 2; ++bj)
#pragma unroll
                    for (int n = 0; n < 2; ++n) { const f32x4 bs = ai == 0 ? pre[m][bj][n] : *(const f32x4*)(base + off + bj * HALF + n * 16); f32x4 o = bs + (acc[ai][bj][m][n] - sr.x) * sr.y;
                        if (bad) o = (f32x4){qnan, qnan, qnan, qnan}; *(f32x4*)(out + off + bj * HALF + n * 16) = o; }
                if (m & 1) asm volatile("" ::: "memory"); }
    }
};
struct EpiLnResLn {
    static constexpr bool PERM = false, AFTER_DRAIN = true;
    const float* base; float* out; bf16_t* xn; int ldc; const float* bias; PanelStats st1, st2; unsigned poison;
    __device__ __forceinline__ void fused(f32x4 (&acc)[2][2][4][2], const Unit& u, int wr, int wc, int fr, int fq, PG8_LAS unsigned char* lds, int wid, int lane) const {
        typedef float f32x2v __attribute__((ext_vector_type(2))); typedef unsigned u32x2v __attribute__((ext_vector_type(2)));
        const PG8_LAS f32x2v* S = (const PG8_LAS f32x2v*)(lds + 8192);
        const int col0 = u.pn * BM + wc * 32 + 4 * fq;
#pragma unroll
        for (int bj = 0; bj < 2; ++bj)
#pragma unroll
            for (int n = 0; n < 2; ++n) { const f32x4 bv = bias ? *(const f32x4*)(bias + col0 + bj * HALF + n * 16) : (f32x4){0.f, 0.f, 0.f, 0.f};
#pragma unroll
                for (int ai = 0; ai < 2; ++ai)
#pragma unroll
                    for (int m = 0; m < 4; ++m) acc[ai][bj][m][n] += bv; }
        bool bad = st1.run(acc, u, wr, wc, fr, fq, lds, wid, lane) || poison != 0u;
        const float qnan = __builtin_nanf("");
#pragma unroll
        for (int ai = 0; ai < 2; ++ai)
#pragma unroll
            for (int m = 0; m < 4; ++m) { const int r = ai * HALF + wr * 64 + m * 16 + fr; const f32x2v sr = S[r]; const size_t off = (size_t)(u.pm * BM + r) * ldc + col0;
#pragma unroll
                for (int bj = 0; bj < 2; ++bj)
#pragma unroll
                    for (int n = 0; n < 2; ++n) { const f32x4 bs = *(const f32x4*)(base + off + bj * HALF + n * 16); acc[ai][bj][m][n] = bs + (acc[ai][bj][m][n] - sr.x) * sr.y; }
                asm volatile("" : "+v"(acc[ai][0][m][0]), "+v"(acc[ai][0][m][1]), "+v"(acc[ai][1][m][0]), "+v"(acc[ai][1][m][1]));
                if (m & 1) asm volatile("" ::: "memory"); }
        const bool bad1 = bad;
        bad = st2.run(acc, u, wr, wc, fr, fq, lds, wid, lane) || bad;
#pragma unroll
        for (int ai = 0; ai < 2; ++ai)
#pragma unroll
            for (int m = 0; m < 4; ++m) { const int r = ai * HALF + wr * 64 + m * 16 + fr; const f32x2v sr = S[r]; const size_t off = (size_t)(u.pm * BM + r) * ldc + col0;
#pragma unroll
                for (int bj = 0; bj < 2; ++bj)
#pragma unroll
                    for (int n = 0; n < 2; ++n) { const f32x4 x1 = acc[ai][bj][m][n]; *(f32x4*)(out + off + bj * HALF + n * 16) = bad1 ? (f32x4){qnan, qnan, qnan, qnan} : x1;
                        const f32x4 o = (x1 - sr.x) * sr.y; u32x2v w; w.x = cvt_pk_bf16(o[0], o[1]); w.y = cvt_pk_bf16(o[2], o[3]);
                        if (bad) { w.x = 0x7fc07fc0u; w.y = 0x7fc07fc0u; } *(u32x2v*)(xn + off + bj * HALF + n * 16) = w; }
                asm volatile("" ::: "memory"); }
    }
};

template <class Epi, class Sched, bool ALIGN_EPI = false, bool SP2 = false>
__device__ __forceinline__ void gemm_phase(PG8_LAS unsigned char* lds, const Gemm g, const Sched& S, const Epi& E, int wave_s_) {
    int tid = MK_TID(wave_s_); asm volatile("" : "+v"(tid));
    const int wid = __builtin_amdgcn_readfirstlane(tid >> 6), lane = tid & 63, wr = wid >> 2, wc = wid & 3, fr = lane & 15, fq = lane >> 4;
    const int K = g.K, nt_def = K / BK;
    unsigned voffA[2], voffB[2];
#pragma unroll
    for (int i = 0; i < 2; ++i) { int R, C; stage_rc(tid * 16 + i * 8192, R, C); const int Rb = Epi::PERM ? ((R & ~31) + perm32(R & 31)) : R;
        voffA[i] = (unsigned)(R * g.ld + C) * 2u; voffB[i] = (unsigned)(Rb * g.ld + C) * 2u; }
    const size_t kstep = (size_t)(BK * 2);
    const size_t hstep = (size_t)HALF * g.ld * 2;
    const size_t tstep = 2 * hstep;
    const unsigned ldsw = (unsigned)wid * 1024u;
    const int aoff = lds_byte(wr * 64 + fr, fq * 8), boff = lds_byte(wc * 32 + fr, fq * 8);
#define PG8_SA(b, h) (((b) * 2 + (h)) * HTB)
#define PG8_SB(b, h) ((4 + (b) * 2 + (h)) * HTB)
#define PG8_STAGE(bufoff, gbase, voff) do { _Pragma("unroll") for (int _i = 0; _i < 2; ++_i) \
        __builtin_amdgcn_global_load_lds((const unsigned*)((const char*)(gbase) + (voff)[_i]), (PG8_LAS unsigned*)(lds + (bufoff) + ldsw + _i * 8192), 16, 0, 0); } while (0)
#define PG8_LDA(dst, b, h) do { _Pragma("unroll") for (int m = 0; m < 4; ++m) _Pragma("unroll") for (int k = 0; k < 2; ++k) dst[m][k] = *(const PG8_LAS bf16x8*)(lds + PG8_SA(b, h) + aoff + m * 2048 + k * 1024); } while (0)
#define PG8_LDB(dst, b, h) do { _Pragma("unroll") for (int n = 0; n < 2; ++n) _Pragma("unroll") for (int k = 0; k < 2; ++k) dst[n][k] = *(const PG8_LAS bf16x8*)(lds + PG8_SB(b, h) + boff + n * 2048 + k * 1024); } while (0)
#define PG8_MMA(ai, bj, At, Bt) do { __builtin_amdgcn_s_setprio(1); _Pragma("unroll") for (int m = 0; m < 4; ++m) _Pragma("unroll") for (int n = 0; n < 2; ++n) _Pragma("unroll") for (int k = 0; k < 2; ++k) \
        acc[ai][bj][m][n] = __builtin_amdgcn_mfma_f32_16x16x32_bf16(Bt[n][k], At[m][k], acc[ai][bj][m][n], 0, 0, 0); __builtin_amdgcn_s_setprio(0); } while (0)
#define PG8_WAIT_V(n) asm volatile("s_waitcnt vmcnt(" #n ")" ::: "memory")
#define PG8_WAIT_L(n) asm volatile("s_waitcnt lgkmcnt(" #n ")" ::: "memory")
#define PG8_BAR __builtin_amdgcn_s_barrier()
#define PG8_SCHED __builtin_amdgcn_sched_barrier(0)
    Unit cur, nxt; int ui = 0;
    if (!S.next(0, cur)) return;
    f32x4 acc[2][2][4][2];
#pragma unroll
    for (int a = 0; a < 2; ++a)
#pragma unroll
        for (int b = 0; b < 2; ++b)
#pragma unroll
            for (int m = 0; m < 4; ++m)
#pragma unroll
                for (int n = 0; n < 2; ++n) acc[a][b][m][n] = (f32x4){0.f, 0.f, 0.f, 0.f};
    bf16x8 At[4][2], B0[2][2], B1[2][2];
    const char* cA = (const char*)g.A + (size_t)cur.pm * tstep + (size_t)cur.koff * 2; const char* cB = (const char*)g.Bt + (size_t)cur.pn * tstep + (size_t)cur.boff * 2;
    S.a_ready(cur);
    if constexpr (SP2) {
        PG8_STAGE(PG8_SB(0, 0), cB, voffB); PG8_STAGE(PG8_SB(0, 1), cB + hstep, voffB); PG8_STAGE(PG8_SA(0, 0), cA, voffA); PG8_STAGE(PG8_SA(0, 1), cA + hstep, voffA);
        if (wr == 1) PG8_BAR;
        PG8_WAIT_V(2); PG8_BAR;
        PG8_STAGE(PG8_SB(1, 0), cB + kstep, voffB); PG8_STAGE(PG8_SA(1, 0), cA + kstep, voffA); PG8_STAGE(PG8_SB(1, 1), cB + hstep + kstep, voffB);
        PG8_WAIT_V(6); PG8_BAR;
    } else {
        PG8_STAGE(PG8_SB(0, 0), cB, voffB); PG8_STAGE(PG8_SA(0, 0), cA, voffA); PG8_STAGE(PG8_SB(0, 1), cB + hstep, voffB); PG8_STAGE(PG8_SA(0, 1), cA + hstep, voffA);
        if (wr == 1) PG8_BAR;
        PG8_WAIT_V(4); PG8_BAR;
        PG8_STAGE(PG8_SB(1, 0), cB + kstep, voffB); PG8_STAGE(PG8_SA(1, 0), cA + kstep, voffA); PG8_STAGE(PG8_SB(1, 1), cB + hstep + kstep, voffB);
        PG8_WAIT_V(6); PG8_BAR;
    }
    for (;;) {
        const bool has_next = S.next(ui + 1, nxt);
        const char* nA = has_next ? (const char*)g.A + (size_t)nxt.pm * tstep + (size_t)nxt.koff * 2 : cA; const char* nB = has_next ? (const char*)g.Bt + (size_t)nxt.pn * tstep + (size_t)nxt.boff * 2 : cB;
        const int nt = cur.ntile() ? cur.ntile() : nt_def;
        for (int t = 0; t < nt; t += 2) {
            const bool last = (t == nt - 2);
            const char* a1 = cA + (size_t)(t + 1) * kstep;
            const char* a2 = last ? nA : cA + (size_t)(t + 2) * kstep; const char* b2 = last ? nB : cB + (size_t)(t + 2) * kstep;
            const char* a3 = a2 + kstep; const char* b3 = b2 + kstep;
            if (last && has_next) S.a_ready(nxt);
            if constexpr (SP2) {
            PG8_LDB(B0, 0, 0); PG8_LDB(B1, 0, 1); PG8_SCHED; PG8_LDA(At, 0, 0); PG8_STAGE(PG8_SA(1, 1), a1 + hstep, voffA);
            PG8_WAIT_V(8); PG8_WAIT_L(0); PG8_BAR; PG8_MMA(0, 0, At, B0); PG8_MMA(0, 1, At, B1); PG8_BAR; PG8_SCHED;
            PG8_LDA(At, 0, 1); PG8_STAGE(PG8_SB(0, 0), b2, voffB); PG8_STAGE(PG8_SB(0, 1), b2 + hstep, voffB); PG8_STAGE(PG8_SA(0, 0), a2, voffA);
            PG8_WAIT_V(8); PG8_WAIT_L(0); PG8_BAR; PG8_MMA(1, 0, At, B0); PG8_MMA(1, 1, At, B1); PG8_BAR; PG8_SCHED;
            PG8_LDB(B0, 1, 0); PG8_LDB(B1, 1, 1); PG8_SCHED; PG8_LDA(At, 1, 0); PG8_STAGE(PG8_SA(0, 1), a2 + hstep, voffA);
            PG8_WAIT_V(8); PG8_WAIT_L(0); PG8_BAR; PG8_MMA(0, 0, At, B0); PG8_MMA(0, 1, At, B1); PG8_BAR; PG8_SCHED;
            PG8_LDA(At, 1, 1); PG8_STAGE(PG8_SB(1, 0), b3, voffB); PG8_STAGE(PG8_SB(1, 1), b3 + hstep, voffB); PG8_STAGE(PG8_SA(1, 0), a3, voffA);
            PG8_WAIT_V(8); PG8_WAIT_L(0); PG8_BAR; PG8_MMA(1, 0, At, B0); PG8_MMA(1, 1, At, B1); PG8_BAR; PG8_SCHED;
            } else {
            PG8_LDB(B0, 0, 0); PG8_SCHED; PG8_LDA(At, 0, 0); PG8_STAGE(PG8_SA(1, 1), a1 + hstep, voffA);
            PG8_WAIT_L(8); PG8_BAR; PG8_WAIT_L(0); PG8_MMA(0, 0, At, B0); PG8_BAR; PG8_SCHED;
            PG8_LDB(B1, 0, 1); PG8_STAGE(PG8_SB(0, 0), b2, voffB);
            PG8_BAR; PG8_WAIT_L(0); PG8_MMA(0, 1, At, B1); PG8_BAR;
            PG8_LDA(At, 0, 1); PG8_STAGE(PG8_SA(0, 0), a2, voffA);
            PG8_BAR; PG8_WAIT_L(0); PG8_MMA(1, 0, At, B0); PG8_BAR; PG8_SCHED;
            PG8_STAGE(PG8_SB(0, 1), b2 + hstep, voffB);
            PG8_WAIT_V(6); PG8_BAR; PG8_MMA(1, 1, At, B1); PG8_BAR;
            PG8_LDB(B0, 1, 0); PG8_SCHED; PG8_LDA(At, 1, 0); PG8_STAGE(PG8_SA(0, 1), a2 + hstep, voffA);
            PG8_WAIT_L(8); PG8_BAR; PG8_WAIT_L(0); PG8_MMA(0, 0, At, B0); PG8_BAR; PG8_SCHED;
            PG8_LDB(B1, 1, 1); PG8_STAGE(PG8_SB(1, 0), b3, voffB);
            PG8_BAR; PG8_WAIT_L(0); PG8_MMA(0, 1, At, B1); PG8_BAR;
            PG8_LDA(At, 1, 1); PG8_STAGE(PG8_SA(1, 0), a3, voffA);
            PG8_BAR; PG8_WAIT_L(0); PG8_MMA(1, 0, At, B0); PG8_BAR; PG8_SCHED;
            PG8_STAGE(PG8_SB(1, 1), b3 + hstep, voffB);
            PG8_WAIT_V(6); PG8_BAR; PG8_MMA(1, 1, At, B1); PG8_BAR;
            }
        }
        if constexpr (ALIGN_EPI) { if (wr == 0) PG8_BAR; }
        if constexpr (!Epi::AFTER_DRAIN) { E(acc, cur, wr, wc, fr, fq); S.done(cur); }
        if (!has_next) break;
        if (!nxt.carry()) {
#pragma unroll
        for (int a = 0; a < 2; ++a)
#pragma unroll
            for (int b = 0; b < 2; ++b)
#pragma unroll
                for (int m = 0; m < 4; ++m)
#pragma unroll
                    for (int n = 0; n < 2; ++n) acc[a][b][m][n] = (f32x4){0.f, 0.f, 0.f, 0.f};
        }
        cur = nxt; cA = nA; cB = nB; ++ui;
        if constexpr (ALIGN_EPI) { if (wr == 1) PG8_BAR; }
    }
    PG8_WAIT_V(0);
    if constexpr (!ALIGN_EPI) { if (wr == 0) PG8_BAR; }
    PG8_BAR;
    if constexpr (Epi::AFTER_DRAIN) { E.fused(acc, cur, wr, wc, fr, fq, lds, wid, lane); S.done(cur); }
#undef PG8_SA
#undef PG8_SB
#undef PG8_STAGE
#undef PG8_LDA
#undef PG8_LDB
#undef PG8_MMA
#undef PG8_WAIT_V
#undef PG8_WAIT_L
#undef PG8_BAR
#undef PG8_SCHED
}
}

__device__ __forceinline__ float shfl_xor_f(float v, int o) { return __uint_as_float((unsigned)__builtin_amdgcn_ds_bpermute((mk_lane_id() ^ o) << 2, (int)__float_as_uint(v))); }
namespace attn128 {
using bf16 = __hip_bfloat16;
constexpr int D = 128, NW = 8, QBLK = 32, KVBLK = 64;
constexpr float SCALE = 0.088388347648318440f;
constexpr float THR = 8.f;
constexpr int SDEPTH = 2;
constexpr int LDQ = 1024, LDK = 1024, LDO = 1024;
constexpr size_t SHM_V = KVBLK * D * 2, SHM_K = KVBLK * D * 2, SHM_ATTN = 2 * SHM_V + 2 * SHM_K + NW * 64 * 4;
using bf16x8 = __attribute__((ext_vector_type(8))) short;
using s16x4  = __attribute__((ext_vector_type(4))) short;
using f32x16 = __attribute__((ext_vector_type(16))) float;
using f32x8  = __attribute__((ext_vector_type(8))) float;
using u32x4  = __attribute__((ext_vector_type(4))) unsigned;
#define KSWZ(row, colB) ((row) * 256 + ((colB) ^ (((row) & 7) << 4)))
#define SBAR() __builtin_amdgcn_sched_barrier(0)
__device__ __forceinline__ int crow(int r, int hi) { return (r & 3) + 8 * (r >> 2) + 4 * hi; }
__device__ __forceinline__ unsigned cvtpk(float lo, float hi) {
  unsigned r; asm volatile("v_cvt_pk_bf16_f32 %0, %1, %2" : "=v"(r) : "v"(lo), "v"(hi)); return r;
}
template <typename TIn> struct Stage;
template <> struct Stage<bf16>  { using T = bf16x8;
  __device__ static __forceinline__ T ld8(const bf16* p) { return *reinterpret_cast<const bf16x8*>(p); }
  __device__ static __forceinline__ bf16x8 tobf(T x) { return x; } };
template <> struct Stage<float> { using T = f32x8;
  __device__ static __forceinline__ T ld8(const float* p) { return *reinterpret_cast<const f32x8*>(p); }
  __device__ static __forceinline__ bf16x8 tobf(T x) {
    u32x4 w = {cvtpk(x[0], x[1]), cvtpk(x[2], x[3]), cvtpk(x[4], x[5]), cvtpk(x[6], x[7])}; return *reinterpret_cast<bf16x8*>(&w); } };

__device__ __forceinline__ void partialSM(f32x16& p0, f32x16& p1, float& m_reg, float& mn, float& alpha) {
  constexpr float C = SCALE * 1.4426950408889634f;
  float pmax = p0[0]; for (int r = 1; r < 16; ++r) pmax = fmaxf(pmax, p0[r]); for (int r = 0; r < 16; ++r) pmax = fmaxf(pmax, p1[r]);
  { auto rr = __builtin_amdgcn_permlane32_swap(__float_as_uint(pmax), __float_as_uint(pmax), false, false);
    pmax = fmaxf(__uint_as_float(rr[0]), __uint_as_float(rr[1])); }
  if (__builtin_expect(__all(pmax - m_reg <= THR / SCALE), 1)) { mn = m_reg; alpha = 1.f; }
  else { mn = fmaxf(m_reg, pmax); alpha = __builtin_amdgcn_exp2f((m_reg - mn) * C); m_reg = mn; }
  float mnC = -mn * C;
  for (int r = 0; r < 16; ++r) p0[r] = fmaf(p0[r], C, mnC); for (int r = 0; r < 16; ++r) p1[r] = fmaf(p1[r], C, mnC);
  for (int r = 0; r < 16; ++r) p0[r] = __builtin_amdgcn_exp2f(p0[r]);
}
__device__ __forceinline__ void finishSM(f32x16& p0, f32x16& p1, float alpha, float& l_reg, bf16x8& pa0, bf16x8& pa1, bf16x8& pa2, bf16x8& pa3) {
  for (int r = 0; r < 16; ++r) p1[r] = __builtin_amdgcn_exp2f(p1[r]);
  float ps = 0; for (int r = 0; r < 16; ++r) ps += p0[r]; for (int r = 0; r < 16; ++r) ps += p1[r];
  { auto rr = __builtin_amdgcn_permlane32_swap(__float_as_uint(ps), __float_as_uint(ps), false, false);
    ps = __uint_as_float(rr[0]) + __uint_as_float(rr[1]); }
  l_reg = l_reg * alpha + ps;
#define PK4(P, BASE, OUT) do { unsigned a0 = cvtpk(P[BASE + 0], P[BASE + 1]), a1 = cvtpk(P[BASE + 2], P[BASE + 3]);   \
    unsigned b0 = cvtpk(P[BASE + 4], P[BASE + 5]), b1 = cvtpk(P[BASE + 6], P[BASE + 7]);                              \
    auto r0 = __builtin_amdgcn_permlane32_swap(a0, b0, false, false); auto r1 = __builtin_amdgcn_permlane32_swap(a1, b1, false, false); \
    u32x4 w = {r0[0], r1[0], r0[1], r1[1]}; OUT = *reinterpret_cast<bf16x8*>(&w); } while (0)
  PK4(p0, 0, pa0); PK4(p0, 8, pa1); PK4(p1, 0, pa2); PK4(p1, 8, pa3);
#undef PK4
}
__device__ __forceinline__ void qkt(f32x16& p0, f32x16& p1, const bf16* Ks, const bf16x8* qr, int r32, int hi) {
  p0 = f32x16{}; p1 = f32x16{};
  for (int d0 = 0; d0 < 8; ++d0) { int cb = (d0 * 16 + hi * 8) * 2;
    bf16x8 b0 = *reinterpret_cast<const bf16x8*>((const char*)Ks + KSWZ(r32, cb));
    bf16x8 b1 = *reinterpret_cast<const bf16x8*>((const char*)Ks + KSWZ(32 + r32, cb));
    p0 = __builtin_amdgcn_mfma_f32_32x32x16_bf16(b0, qr[d0], p0, 0, 0, 0);
    p1 = __builtin_amdgcn_mfma_f32_32x32x16_bf16(b1, qr[d0], p1, 0, 0, 0); }
}
__device__ __forceinline__ int v_st(int k, int c) { const int kk = (k & ~0xC) | ((k & 4) << 1) | ((k & 8) >> 1); return ((kk >> 3) * 4 + (c >> 5)) * 512 + ((kk & 7) * 32 + (c & 31)) * 2; }
__device__ __forceinline__ int v_rd_base(int lane) { return ((lane & 3) << 3) | (((lane >> 2) & 3) << 6) | (((lane >> 4) & 1) << 5) | (((lane >> 5) & 1) << 8); }
constexpr int v_rd_off(int d0, int ks, int half) { return d0 * 512 + ks * 4096 + half * 2048; }
template <int OFF> __device__ __forceinline__ s16x4 tr_read(int vb) {
  s16x4 r; asm volatile("ds_read_b64_tr_b16 %0, %1 offset:%2" : "=&v"(r) : "v"(vb), "i"(OFF) : "memory"); return r;
}
template <int D0> __device__ __forceinline__ void pv_one(f32x16& od, int vb, bf16x8 pa0, bf16x8 pa1, bf16x8 pa2, bf16x8 pa3) {
  const s16x4 l0 = tr_read<v_rd_off(D0, 0, 0)>(vb), h0 = tr_read<v_rd_off(D0, 0, 1)>(vb), l1 = tr_read<v_rd_off(D0, 1, 0)>(vb), h1 = tr_read<v_rd_off(D0, 1, 1)>(vb);
  const s16x4 l2 = tr_read<v_rd_off(D0, 2, 0)>(vb), h2 = tr_read<v_rd_off(D0, 2, 1)>(vb), l3 = tr_read<v_rd_off(D0, 3, 0)>(vb), h3 = tr_read<v_rd_off(D0, 3, 1)>(vb);
  asm volatile("s_waitcnt lgkmcnt(0)" ::: "memory"); SBAR();
#define PK(L, H) (bf16x8){L[0], L[1], L[2], L[3], H[0], H[1], H[2], H[3]}
  od = __builtin_amdgcn_mfma_f32_32x32x16_bf16(pa0, PK(l0, h0), od, 0, 0, 0);
  od = __builtin_amdgcn_mfma_f32_32x32x16_bf16(pa1, PK(l1, h1), od, 0, 0, 0);
  od = __builtin_amdgcn_mfma_f32_32x32x16_bf16(pa2, PK(l2, h2), od, 0, 0, 0);
  od = __builtin_amdgcn_mfma_f32_32x32x16_bf16(pa3, PK(l3, h3), od, 0, 0, 0);
#undef PK
}
__device__ __forceinline__ void pv_d0(f32x16* o, int vb, bf16x8 pa0, bf16x8 pa1, bf16x8 pa2, bf16x8 pa3) {
  pv_one<0>(o[0], vb, pa0, pa1, pa2, pa3); pv_one<1>(o[1], vb, pa0, pa1, pa2, pa3); pv_one<2>(o[2], vb, pa0, pa1, pa2, pa3); pv_one<3>(o[3], vb, pa0, pa1, pa2, pa3);
}

template <typename TQ>
__device__ __forceinline__ void attn_dense_body(const TQ* __restrict__ Qb, const bf16* __restrict__ Kh, const bf16* __restrict__ Vh,
                                                float* __restrict__ Ob, int seq, char* lds, int wave_s_) {
  using St = Stage<bf16>; using SQ = Stage<TQ>;
  int tid = MK_TID(wave_s_); asm volatile("" : "+v"(tid));
  const int wid = tid >> 6, lane = tid & 63, r32 = lane & 31, hi = lane >> 5;
  bf16* V_lds = (bf16*)lds; bf16* K_lds = (bf16*)(lds + 2 * SHM_V);
  float* ws = (float*)(lds + 2 * SHM_V + 2 * SHM_K) + wid * 64; float* li_l = ws; float* al_l = ws + 32;
  float m_reg = -1e30f, l_reg = 0; f32x16 o[4] = {}; bf16x8 qr[8];
  const TQ* Qw = Qb + (long)(wid * QBLK + r32) * LDQ + hi * 8;
#pragma unroll
  for (int d0 = 0; d0 < 8; ++d0) qr[d0] = SQ::tobf(SQ::ld8(Qw + d0 * 16));
  const int sr = tid >> 4, sc = (tid & 15) * 8, vst0 = v_st(sr, sc), vst1 = v_st(32 + sr, sc);
  const int vb0 = (int)(uintptr_t)V_lds + v_rd_base(lane);
  struct { typename St::T vs0, vs1, ks0, ks1; } sr_[SDEPTH];
#define SLOAD(i, k0) do { sr_[i].vs0 = St::ld8(&Vh[(long)((k0) + sr) * LDK + sc]); sr_[i].vs1 = St::ld8(&Vh[(long)((k0) + 32 + sr) * LDK + sc]); \
    sr_[i].ks0 = St::ld8(&Kh[(long)((k0) + sr) * LDK + sc]); sr_[i].ks1 = St::ld8(&Kh[(long)((k0) + 32 + sr) * LDK + sc]); } while (0)
#define SWRITE(b, i) do { *(bf16x8*)((char*)V_lds + (b) * SHM_V + vst0) = St::tobf(sr_[i].vs0);          \
    *(bf16x8*)((char*)V_lds + (b) * SHM_V + vst1) = St::tobf(sr_[i].vs1); int kc = sc * 2;               \
    *(bf16x8*)((char*)K_lds + (b) * SHM_K + KSWZ(sr, kc)) = St::tobf(sr_[i].ks0);                       \
    *(bf16x8*)((char*)K_lds + (b) * SHM_K + KSWZ(32 + sr, kc)) = St::tobf(sr_[i].ks1); } while (0)
#define SWAIT() do { if constexpr (SDEPTH == 2) asm volatile("s_waitcnt vmcnt(4)" ::: "memory"); else asm volatile("s_waitcnt vmcnt(0)" ::: "memory"); } while (0)
#define RESC(a) do { if (__any((a) < 1.f)) { if (hi == 0) al_l[r32] = (a); asm volatile("s_waitcnt lgkmcnt(0)" ::: "memory"); \
    for (int d = 0; d < 4; ++d) for (int r = 0; r < 16; ++r) o[d][r] *= al_l[crow(r, hi)]; } } while (0)
  f32x16 pA0, pA1, pB0, pB1; float mnA, mnB, alA, alB; bf16x8 pa0, pa1, pa2, pa3; const int NT = seq / KVBLK;
  constexpr int SE = 0, SO = SDEPTH - 1;
  SLOAD(SE, 0); asm volatile("s_waitcnt vmcnt(0)" ::: "memory"); SWRITE(0, SE); __syncthreads();
  qkt(pA0, pA1, K_lds, qr, r32, hi); partialSM(pA0, pA1, m_reg, mnA, alA);
  SLOAD(SO, KVBLK); if constexpr (SDEPTH == 2) { if (2 < NT) SLOAD(SE, 2 * KVBLK); }
  SWAIT(); SWRITE(1, SO); __syncthreads();
  for (int j = 1; j + 1 < NT; j += 2) {
    SBAR(); qkt(pB0, pB1, (bf16*)((char*)K_lds + SHM_K), qr, r32, hi);
    finishSM(pA0, pA1, alA, l_reg, pa0, pa1, pa2, pa3); SBAR();
    SLOAD(SO, (j + SDEPTH) * KVBLK); SBAR();
    pv_d0(o, vb0, pa0, pa1, pa2, pa3); partialSM(pB0, pB1, m_reg, mnB, alB);
    __syncthreads(); SWAIT(); SWRITE(0, SE);
    RESC(alB); __syncthreads();
    SBAR(); qkt(pA0, pA1, K_lds, qr, r32, hi);
    finishSM(pB0, pB1, alB, l_reg, pa0, pa1, pa2, pa3); SBAR();
    if (SDEPTH == 1 || j + 3 < NT) SLOAD(SE, (j + 1 + SDEPTH) * KVBLK); SBAR();
    pv_d0(o, vb0 + (int)SHM_V, pa0, pa1, pa2, pa3); partialSM(pA0, pA1, m_reg, mnA, alA);
    __syncthreads(); SWAIT(); SWRITE(1, SO);
    RESC(alA); __syncthreads();
  }
  SBAR(); qkt(pB0, pB1, (bf16*)((char*)K_lds + SHM_K), qr, r32, hi);
  finishSM(pA0, pA1, alA, l_reg, pa0, pa1, pa2, pa3); SBAR();
  pv_d0(o, vb0, pa0, pa1, pa2, pa3); partialSM(pB0, pB1, m_reg, mnB, alB);
  __syncthreads(); RESC(alB);
  finishSM(pB0, pB1, alB, l_reg, pa0, pa1, pa2, pa3); SBAR();
  pv_d0(o, vb0 + (int)SHM_V, pa0, pa1, pa2, pa3);
  if (hi == 0) li_l[r32] = l_reg; asm volatile("s_waitcnt lgkmcnt(0)" ::: "memory");
  float rli[16];
#pragma unroll
  for (int r = 0; r < 16; ++r) rli[r] = __builtin_amdgcn_rcpf(li_l[crow(r, hi)]);
  float* Ow = Ob + (long)(wid * QBLK) * LDO;
#pragma unroll
  for (int r = 0; r < 16; ++r) { int orow = crow(r, hi);
    for (int d0 = 0; d0 < 4; ++d0) Ow[(long)orow * LDO + d0 * 32 + r32] = o[d0][r] * rli[r]; }
#undef SLOAD
#undef SWRITE
#undef SWAIT
#undef RESC
}

}

namespace attn256 {
using namespace attn128;
constexpr size_t SHM_V2 = KVBLK * 256 * 2, SHM_K2 = KVBLK * D * 2;
constexpr int LDV = 1024;
__device__ __forceinline__ int v_st2(int k, int c) { const int kk = (k & ~0xC) | ((k & 4) << 1) | ((k & 8) >> 1); return ((kk >> 3) * 8 + (c >> 5)) * 512 + ((kk & 7) * 32 + (c & 31)) * 2; }
constexpr int v_rd_off2(int d0, int ks, int half) { return d0 * 512 + ks * 8192 + half * 4096; }
template <int D0> __device__ __forceinline__ void pv_one2(f32x16& od, int vb, bf16x8 pa0, bf16x8 pa1, bf16x8 pa2, bf16x8 pa3) {
  const s16x4 l0 = tr_read<v_rd_off2(D0, 0, 0)>(vb), h0 = tr_read<v_rd_off2(D0, 0, 1)>(vb), l1 = tr_read<v_rd_off2(D0, 1, 0)>(vb), h1 = tr_read<v_rd_off2(D0, 1, 1)>(vb);
  const s16x4 l2 = tr_read<v_rd_off2(D0, 2, 0)>(vb), h2 = tr_read<v_rd_off2(D0, 2, 1)>(vb), l3 = tr_read<v_rd_off2(D0, 3, 0)>(vb), h3 = tr_read<v_rd_off2(D0, 3, 1)>(vb);
  asm volatile("s_waitcnt lgkmcnt(0)" ::: "memory"); SBAR();
#define PK(L, H) (bf16x8){L[0], L[1], L[2], L[3], H[0], H[1], H[2], H[3]}
  od = __builtin_amdgcn_mfma_f32_32x32x16_bf16(pa0, PK(l0, h0), od, 0, 0, 0);
  od = __builtin_amdgcn_mfma_f32_32x32x16_bf16(pa1, PK(l1, h1), od, 0, 0, 0);
  od = __builtin_amdgcn_mfma_f32_32x32x16_bf16(pa2, PK(l2, h2), od, 0, 0, 0);
  od = __builtin_amdgcn_mfma_f32_32x32x16_bf16(pa3, PK(l3, h3), od, 0, 0, 0);
#undef PK
}
__device__ __forceinline__ void attn_o256_body(const bf16* __restrict__ Qb, const bf16* __restrict__ Kh, const bf16* __restrict__ Vh, float* __restrict__ Ob, int seq, char* lds, int wave_s_) {
  using St = Stage<bf16>;
  int tid = MK_TID(wave_s_); asm volatile("" : "+v"(tid));
  const int wid = tid >> 6, lane = tid & 63, r32 = lane & 31, hi = lane >> 5;
  bf16* V_lds = (bf16*)lds; bf16* K_lds = (bf16*)(lds + 2 * SHM_V2);
  float* ws = (float*)(lds + 2 * SHM_V2 + 2 * SHM_K2) + wid * 64; float* li_l = ws; float* al_l = ws + 32;
  float m_reg = -1e30f, l_reg = 0; f32x16 o[8] = {}; bf16x8 qr[8];
  const bf16* Qw = Qb + (long)(wid * QBLK + r32) * LDQ + hi * 8;
#pragma unroll
  for (int d0 = 0; d0 < 8; ++d0) qr[d0] = St::ld8(Qw + d0 * 16);
  const int vb0 = (int)(uintptr_t)V_lds + v_rd_base(lane);
  bf16x8 sv00, sv01, sv10, sv11, sk0, sk1;
#define SLOAD2(k0) do { const int t_ = MK_TID(wave_s_), sr = t_ >> 4, sc = (t_ & 15) * 8; const bf16* vp = Vh + (long)((k0) + sr) * LDV + sc; const bf16* kp = Kh + (long)((k0) + sr) * LDK + sc; \
    sv00 = St::ld8(vp); sv01 = St::ld8(vp + 128); sv10 = St::ld8(vp + 32 * LDV); sv11 = St::ld8(vp + 32 * LDV + 128); sk0 = St::ld8(kp); sk1 = St::ld8(kp + 32 * LDK); } while (0)
#define SWRITE2(b) do { const int t_ = MK_TID(wave_s_), sr = t_ >> 4, sc = (t_ & 15) * 8; char* vbuf = (char*)V_lds + (b) * SHM_V2 + v_st2(sr, sc); \
    *(bf16x8*)(vbuf) = sv00; *(bf16x8*)(vbuf + 2048) = sv01; *(bf16x8*)(vbuf + 16384) = sv10; *(bf16x8*)(vbuf + 18432) = sv11; \
    char* kbuf = (char*)K_lds + (b) * SHM_K2 + KSWZ(sr, sc * 2); *(bf16x8*)(kbuf) = sk0; *(bf16x8*)(kbuf + 8192) = sk1; } while (0)
  const int NT = seq / KVBLK;
  SLOAD2(0); asm volatile("s_waitcnt vmcnt(0)" ::: "memory"); SWRITE2(0); __syncthreads();
  for (int j = 0; j < NT; ++j) {
    const int b = j & 1;
    f32x16 p0, p1; float mn, al; bf16x8 pa0, pa1, pa2, pa3;
    SBAR(); qkt(p0, p1, (bf16*)((char*)K_lds + b * SHM_K2), qr, r32, hi);
    partialSM(p0, p1, m_reg, mn, al);
    finishSM(p0, p1, al, l_reg, pa0, pa1, pa2, pa3); SBAR();
    if (__any(al < 1.f)) { if (hi == 0) al_l[r32] = al; asm volatile("s_waitcnt lgkmcnt(0)" ::: "memory");
#pragma unroll
      for (int d = 0; d < 8; ++d)
#pragma unroll
        for (int r = 0; r < 16; ++r) o[d][r] *= al_l[crow(r, hi)]; }
    if (j + 1 < NT) SLOAD2((j + 1) * KVBLK);
    SBAR();
    { const int vb = vb0 + b * (int)SHM_V2;
      pv_one2<0>(o[0], vb, pa0, pa1, pa2, pa3); pv_one2<1>(o[1], vb, pa0, pa1, pa2, pa3); pv_one2<2>(o[2], vb, pa0, pa1, pa2, pa3); pv_one2<3>(o[3], vb, pa0, pa1, pa2, pa3);
      pv_one2<4>(o[4], vb, pa0, pa1, pa2, pa3); pv_one2<5>(o[5], vb, pa0, pa1, pa2, pa3); pv_one2<6>(o[6], vb, pa0, pa1, pa2, pa3); pv_one2<7>(o[7], vb, pa0, pa1, pa2, pa3); }
    if (j + 1 < NT) { asm volatile("s_waitcnt vmcnt(0)" ::: "memory"); SWRITE2(b ^ 1); }
    __syncthreads();
  }
  if (hi == 0) li_l[r32] = l_reg; asm volatile("s_waitcnt lgkmcnt(0)" ::: "memory");
  float rli[16];
#pragma unroll
  for (int r = 0; r < 16; ++r) rli[r] = __builtin_amdgcn_rcpf(li_l[crow(r, hi)]);
  float* Ow = Ob + (long)(wid * QBLK) * LDO;
#pragma unroll
  for (int r = 0; r < 16; ++r) { const int orow = crow(r, hi);
#pragma unroll
    for (int d0 = 0; d0 < 8; ++d0) Ow[(long)orow * LDO + d0 * 32 + r32] = o[d0][r] * rli[r]; }
#undef SLOAD2
#undef SWRITE2
}
}

#define GAS __attribute__((address_space(1)))
#define LAS __attribute__((address_space(3)))
typedef unsigned short bf16;
typedef unsigned v4u __attribute__((ext_vector_type(4)));
typedef float f32x4 __attribute__((ext_vector_type(4)));
typedef short bf16x8 __attribute__((ext_vector_type(8)));
typedef GAS unsigned gu32;
typedef GAS unsigned long long gu64;
#define RLX_AGENT __ATOMIC_RELAXED, __HIP_MEMORY_SCOPE_AGENT
#define LDS_WAIT() asm volatile("s_waitcnt lgkmcnt(0)" ::: "memory")
#define VM_WAIT() asm volatile("s_waitcnt vmcnt(0)" ::: "memory")
__device__ __forceinline__ unsigned long long rt() { return __builtin_amdgcn_s_memrealtime(); }
__device__ __forceinline__ unsigned f2bf(float f) { unsigned u = __builtin_bit_cast(unsigned, f); return (u + 0x7fffu + ((u >> 16) & 1u)) >> 16; }
__device__ __forceinline__ unsigned pk2(float lo, float hi) { return f2bf(lo) | (f2bf(hi) << 16); }

#define XB_TMO      128
#define XB_XCNT(j)  (256  + 64 * (j))
#define XB_XSUB(j)  (1280 + 64 * (j))
#define XB_XGEN(j)  (2304 + 64 * (j))
#define XB_TOP      3328
#define XB_TOPGEN   3392
#define XCD_BAR_WORDS 3456
#define XB_SPIN_CAP (1u << 22)

__device__ __forceinline__ unsigned xb_ld(unsigned* p)              { return __hip_atomic_load(p, __ATOMIC_RELAXED, __HIP_MEMORY_SCOPE_AGENT); }
__device__ __forceinline__ unsigned xb_add(unsigned* p, unsigned v) { return __hip_atomic_fetch_add(p, v, __ATOMIC_RELAXED, __HIP_MEMORY_SCOPE_AGENT); }
__device__ __forceinline__ unsigned xb_xcc_id() { return (unsigned)__builtin_amdgcn_s_getreg((3 << 11) | 20) & 0xFu; }
#define XB_SPIN(cond, bar) do { unsigned _sp = 0; while (cond) { __builtin_amdgcn_s_sleep(1); \
    if ((++_sp & 255u) == 0u) { if (xb_ld(&(bar)[XB_TMO])) break; if (_sp > XB_SPIN_CAP) { atomicAdd(&(bar)[XB_TMO], 1u); break; } } } } while (0)

struct XcdBarrier {
    unsigned* bar; unsigned x;
    volatile LAS unsigned* st;
};

__device__ __forceinline__ XcdBarrier xcd_barrier_post(unsigned* bar, volatile LAS unsigned* st, int tid_) {
    XcdBarrier b; b.bar = bar; b.x = xb_xcc_id(); b.st = st;
    if (tid_ == 0) (void)xb_add(&bar[XB_XCNT(b.x)], 1u);
    return b;
}
__device__ __forceinline__ void xcd_barrier_complete(unsigned* bar, unsigned x, unsigned& nloc, unsigned& nx) {
    const unsigned G = gridDim.x * gridDim.y * gridDim.z;
    unsigned sum, cnt, mine, sp = 0u;
    for (;;) {
        sum = 0u; cnt = 0u; mine = 0u;
#pragma unroll
        for (unsigned j = 0; j < 16; ++j) { const unsigned c = xb_ld(&bar[XB_XCNT(j)]); sum += c; cnt += (c > 0u) ? 1u : 0u; mine = (j == x) ? c : mine; }
        if (sum == G) break;
        __builtin_amdgcn_s_sleep(1);
        if ((++sp & 255u) == 0u) { if (xb_ld(&bar[XB_TMO])) break; if (sp > XB_SPIN_CAP) { atomicAdd(&bar[XB_TMO], 1u); break; } }
    }
    nloc = mine > 0u ? mine : 1u; nx = cnt > 0u ? cnt : 1u;
}

__device__ __forceinline__ void xcd_barrier(const XcdBarrier& b, int tid_) {
    asm volatile("s_waitcnt vmcnt(0)" ::: "memory");
    __syncthreads();
    if (tid_ == 0) {
        unsigned* bar = b.bar;
        __builtin_amdgcn_s_waitcnt(0);
        unsigned nloc = b.st[0], nx = b.st[1];
        if (nloc == 0u) { xcd_barrier_complete(bar, b.x, nloc, nx); b.st[0] = nloc; b.st[1] = nx; }
        const unsigned old = xb_add(&bar[XB_XSUB(b.x)], 1u);
        const unsigned gen = old / nloc;
        if (old + 1u == (gen + 1u) * nloc) {
            __builtin_amdgcn_fence(__ATOMIC_RELEASE, "agent");
            asm volatile("s_waitcnt vmcnt(0)" ::: "memory");
            const unsigned og = xb_add(&bar[XB_TOP], 1u);
            const unsigned tg = og / nx;
            if (og + 1u == (tg + 1u) * nx) xb_add(&bar[XB_TOPGEN], 1u);
            else XB_SPIN(xb_ld(&bar[XB_TOPGEN]) == tg, bar);
            __builtin_amdgcn_fence(__ATOMIC_ACQUIRE, "agent");
            xb_add(&bar[XB_XGEN(b.x)], 1u);
            asm volatile("s_waitcnt vmcnt(0)" ::: "memory");
        } else {
            XB_SPIN(xb_ld(&bar[XB_XGEN(b.x)]) == gen, bar);
            __builtin_amdgcn_fence(__ATOMIC_ACQUIRE, "agent");
            asm volatile("s_waitcnt vmcnt(0)" ::: "memory");
        }
    }
    __syncthreads();
}

constexpr int DM = 4096, SEQ = 8192, CTXL = 256, MT = SEQ + CTXL, DEPTH = 4, FFND = 4096;
constexpr int NZ = 20480, INC = 20496, ADAR = 256, NMOD = 9 * DM;
constexpr int ZC_UV = 0, ZC_MQ = 2048, ZC_MK = 2560, ZC_MV = 3072, ZC_MO = 4096, ZC_AQ = 5120, ZC_AK = 6144, ZC_AV = 7168, ZC_MG = 8192;
constexpr float EPS = 1e-6f;
constexpr int NWAVES = 8, NTHR = 512;

constexpr size_t MiB = 1ull << 20;
constexpr size_t WS_CTL = 0, CTL_ZERO_BYTES = 1 * MiB;
constexpr size_t WS_MODTP = 1 * MiB;
constexpr size_t WS_MOD = WS_MODTP + 512 * 1024;
constexpr size_t WS_LAM = WS_MOD + (size_t)DEPTH * 2 * NMOD * 4;
constexpr size_t WS_WG16 = WS_LAM + 256;
constexpr size_t WS_ROPE = WS_WG16 + (size_t)DEPTH * 16 * DM * 4;
constexpr size_t WS_G16 = WS_ROPE + (size_t)2 * SEQ * 64 * 4;
constexpr size_t WS_XR = 9 * MiB;
constexpr size_t SZ_ROWS_F32 = (size_t)MT * DM * 4, SZ_ROWS_BF = (size_t)MT * DM * 2;
constexpr size_t WS_H = WS_XR + SZ_ROWS_F32;
constexpr size_t WS_GB = WS_H + SZ_ROWS_BF;
constexpr size_t WS_Z = WS_GB + SZ_ROWS_BF;
constexpr size_t WS_ATTO = WS_Z + (size_t)MT * NZ * 2;
constexpr size_t WS_MLH = WS_ATTO + (size_t)2 * MT * 1024 * 4;
constexpr size_t WS_YA = WS_MLH + (size_t)2 * MT * 1024 * 4;
constexpr size_t WS_YB = WS_YA + (size_t)MT * 1024 * 2;
constexpr size_t WS_YC = WS_YB + (size_t)MT * 1024 * 2;
constexpr size_t WS_YACC = WS_YC + (size_t)MT * 1024 * 2;
constexpr size_t WS_Y = WS_YACC + SZ_ROWS_F32;
constexpr size_t WS_W13T = WS_Y + SZ_ROWS_BF;
constexpr size_t WS_W2T = WS_W13T + (size_t)DEPTH * 2 * 8192 * 4096 * 2;
constexpr size_t WS_WINT = WS_W2T + (size_t)DEPTH * 2 * 4096 * 4096 * 2;
constexpr size_t WS_WBT = WS_WINT + (size_t)DEPTH * NZ * 4096 * 2;
constexpr size_t WS_WOT = WS_WBT + (size_t)DEPTH * 3 * 4096 * 1024 * 2;
constexpr size_t WS_CT = WS_WOT + (size_t)DEPTH * 4096 * 4096 * 2;
constexpr size_t WS_MSM = WS_CT + (size_t)8 * 66 * 32768 * 2;
constexpr size_t WS_SLAB = WS_MSM + 1 * MiB;
constexpr size_t WS_GWSB = WS_SLAB + (size_t)16 * 256 * DM * 4;
constexpr size_t WS_MS3 = WS_GWSB + (size_t)DEPTH * 8 * 128 * 128 * 2;
constexpr size_t WS_END = WS_MS3 + (size_t)3 * 256 * DM * 4;
static_assert(WS_G16 + (size_t)MT * 16 * 4 <= WS_XR, "small buffers fit below XR");
static_assert(WS_XR % 256 == 0 && WS_H % 256 == 0 && WS_Z % 256 == 0 && WS_W13T % 256 == 0, "alignment");

constexpr int CW_BAR = 4096;

constexpr int RING_OFF = 0, RING_BYTES = 131072;
constexpr int LDSCTL_OFF = 143360, MISC_OFF = LDSCTL_OFF + 320;
constexpr int LDS_BYTES = 147456;

constexpr int P_PRO0 = 0, P_PRO1 = 1, P_LAYER0 = 2;
constexpr int L_N1 = 0, L_W13A = 1, L_W2A = 2, L_N2 = 3, L_WIN = 4, L_MIX1 = 5, L_POST = 6, L_M3 = 7, L_MERGE = 8, L_WOUT = 9, L_N3 = 10, L_W13B = 11, L_W2B = 12, NPL = 13;
constexpr int P_FINAL = P_LAYER0 + DEPTH * NPL, NPH = P_FINAL + 1;

__device__ __forceinline__ float wave_sum(float v) {
#pragma unroll
    for (int o = 1; o < 64; o <<= 1) v += shfl_xor_f(v, o);
    return v;
}
__device__ __forceinline__ float bf2f(unsigned short b) { return __uint_as_float((unsigned)b << 16); }
__device__ __forceinline__ float bflo(unsigned w) { return __uint_as_float(w << 16); }
__device__ __forceinline__ float bfhi(unsigned w) { return __uint_as_float(w & 0xffff0000u); }
__device__ __forceinline__ float sigmoid_f(float x) { return 1.f / (1.f + __expf(-x)); }
__device__ __forceinline__ float silu_f(float x) { return x / (1.f + __expf(-x)); }
__device__ __forceinline__ float gelu_tanh_f(float x) { const float u = 0.7978845608028654f * (x + 0.044715f * x * x * x); return x / (1.f + __expf(-2.f * u)); }
__device__ __forceinline__ float lambda_init_f(int l) { return 0.8f - 0.6f * __expf(-0.3f * (float)l); }

namespace pg8 {
struct CtxSplitOrder {
    int c, G, n;
    const float* MS3; bf16_t* Yc; int wave_s_;
    __device__ __forceinline__ bool next(int i, Unit& u) const { const int L = i * G + c; if (L >= n) return false; u.pm = 0; u.pn = L >> 4; u.koff = (L & 15) * 256; u.boff = u.koff; u.fl = 0; return true; }
    __device__ __forceinline__ void a_ready(const Unit& u) const {
        if (MS3) {
            int t_ = MK_TID(wave_s_); asm volatile("" : "+v"(t_));
            const int r = t_ >> 1, c0 = u.koff + (t_ & 1) * 128;
            const float* p0 = MS3 + (size_t)r * DM + c0; bf16_t* yo = Yc + (size_t)r * DM + c0;
#pragma unroll 1
            for (int ib = 0; ib < 16; ib += 4) { f32x4 q[4][3][2];
#pragma unroll
                for (int i = 0; i < 4; ++i)
#pragma unroll
                    for (int sgm = 0; sgm < 3; ++sgm) { q[i][sgm][0] = *(const f32x4*)(p0 + (size_t)sgm * 256 * DM + 8 * (ib + i)); q[i][sgm][1] = *(const f32x4*)(p0 + (size_t)sgm * 256 * DM + 8 * (ib + i) + 4); }
                asm volatile("" ::: "memory");
#pragma unroll
                for (int i = 0; i < 4; ++i) { const f32x4 a0 = q[i][0][0] + q[i][1][0] + q[i][2][0], a1 = q[i][0][1] + q[i][1][1] + q[i][2][1];
                    u32x4 w; w.x = cvt_pk_bf16(a0[0], a0[1]); w.y = cvt_pk_bf16(a0[2], a0[3]); w.z = cvt_pk_bf16(a1[0], a1[1]); w.w = cvt_pk_bf16(a1[2], a1[3]); *(u32x4*)(yo + 8 * (ib + i)) = w; }
                asm volatile("" ::: "memory"); }
            asm volatile("s_waitcnt vmcnt(0)" ::: "memory");
            asm volatile("" ::: "memory"); __builtin_amdgcn_s_barrier(); asm volatile("" ::: "memory");
        }
    }
    __device__ __forceinline__ void done(const Unit&) const {}
};
struct ResidOrder {
    StaticOrder lat; int c, G, n;
    __device__ __forceinline__ bool next(int i, Unit& u) const {
        const int nl = lat.c < lat.nwg ? (lat.nwg - lat.c + lat.G - 1) / lat.G : 0;
        if (i < nl) { lat.next(i, u); u.pm += 1; return true; }
        const int L = (i - nl) * G + c; if (L >= n) return false;
        u.pm = 0; u.pn = L >> 4; u.koff = (L & 15) * 256; u.boff = u.koff; u.fl = 4 << 8; return true;
    }
    __device__ __forceinline__ void a_ready(const Unit&) const {}
    __device__ __forceinline__ void done(const Unit&) const {}
};
struct MergeOrder {
    StaticOrder lat; int c, G, nctx;
    __device__ __forceinline__ bool next(int i, Unit& u) const {
        const int nl = lat.c < lat.nwg ? (lat.nwg - lat.c + lat.G - 1) / lat.G : 0;
        if (i < 3 * nl) { lat.next(i / 3, u); u.pm += 1; const int sg = i % 3; u.fl = sg | (sg != 0 ? 4 : 0); u.koff = sg * (MT * 1024); u.boff = sg * (4096 * 1024); return true; }
        const int L = (i - 3 * nl) * G + c; if (L >= nctx) return false;
        u.pm = 0; u.pn = L / 3; const int sg = L % 3; u.fl = sg; u.koff = sg * (MT * 1024); u.boff = sg * (4096 * 1024); return true;
    }
    __device__ __forceinline__ void a_ready(const Unit&) const {}
    __device__ __forceinline__ void done(const Unit&) const {}
};
struct EpiSlab {
    static constexpr bool PERM = false, AFTER_DRAIN = false;
    float* S;
    __device__ __forceinline__ void operator()(const f32x4 (&acc)[2][2][4][2], const Unit& u, int wr, int wc, int fr, int fq) const {
        { const int l_ = mk_lane_id(); fr = l_ & 15; fq = l_ >> 4; }
        const int col0 = u.pn * BM + wc * 32 + 4 * fq; float* base = S + (size_t)(u.koff >> 8) * 256 * DM;
#pragma unroll
        for (int ai = 0; ai < 2; ++ai)
#pragma unroll
            for (int m = 0; m < 4; ++m) { float* p = base + (size_t)(ai * HALF + wr * 64 + m * 16 + fr) * DM + col0;
#pragma unroll
                for (int bj = 0; bj < 2; ++bj)
#pragma unroll
                    for (int n = 0; n < 2; ++n) *(f32x4*)(p + bj * HALF + n * 16) = acc[ai][bj][m][n]; }
    }
};
struct EpiWin {
    static constexpr bool PERM = true, AFTER_DRAIN = false;
    bf16_t* ZB; const float* rc; const float* rs;
    __device__ __forceinline__ void operator()(const f32x4 (&acc)[2][2][4][2], const Unit& u, int wr, int wc, int fr, int fq) const {
        { const int l_ = mk_lane_id(); fr = l_ & 15; fq = l_ >> 4; }
        const int pn = u.pn; int kind = 0, ld = 1024, c0 = 0;
        if (pn < 8) { kind = 1; ld = 2048; c0 = 0; } else if (pn < 10) { ld = 512; c0 = 2048; } else if (pn < 12) { ld = 512; c0 = 2560; } else if (pn < 16) { c0 = 3072; }
        else if (pn < 20) { kind = 2; c0 = 4096; } else if (pn < 24) { kind = 3; c0 = 5120; } else if (pn < 28) { kind = 3; c0 = 6144; } else if (pn < 32) { c0 = 7168; } else { kind = 2; ld = 12288; c0 = 8192; }
        if (kind == 3 && u.pm == 0) kind = 0;
        bf16_t* base = ZB + (size_t)MT * c0; const int colt = pn * BM - c0 + wc * 32 + 8 * fq; const int row0 = u.pm * BM + wr * 64 + fr;
#define EPIWIN_LOOP(...) _Pragma("unroll") for (int ai = 0; ai < 2; ++ai) _Pragma("unroll") for (int m = 0; m < 4; ++m) { const int row = row0 + ai * HALF + m * 16; _Pragma("unroll") for (int bj = 0; bj < 2; ++bj) { \
            const int col = colt + bj * HALF; float v[8]; _Pragma("unroll") for (int n = 0; n < 2; ++n) _Pragma("unroll") for (int i = 0; i < 4; ++i) v[n * 4 + i] = acc[ai][bj][m][n][i]; \
            __VA_ARGS__ \
            u32x4 w; w.x = cvt_pk_bf16(v[0], v[1]); w.y = cvt_pk_bf16(v[2], v[3]); w.z = cvt_pk_bf16(v[4], v[5]); w.w = cvt_pk_bf16(v[6], v[7]); *(u32x4*)(base + (size_t)row * ld + col) = w; } }
        if (kind == 0) { EPIWIN_LOOP(;) }
        else if (kind == 1) { EPIWIN_LOOP(_Pragma("unroll") for (int i = 0; i < 8; ++i) { const float x = v[i], uu = 0.7978845608028654f * (x + 0.044715f * x * x * x); v[i] = x / (1.f + __expf(-2.f * uu)); }) }
        else if (kind == 2) { EPIWIN_LOOP(_Pragma("unroll") for (int i = 0; i < 8; ++i) v[i] = 1.f / (1.f + __expf(-v[i]));) }
        else {
#pragma unroll
            for (int ai = 0; ai < 2; ++ai) { f32x4 c4[4][2], s4[4][2];
#pragma unroll
                for (int m = 0; m < 4; ++m)
#pragma unroll
                    for (int bj = 0; bj < 2; ++bj) { const int t = row0 + ai * HALF + m * 16 - CTXL, j0 = ((colt + bj * HALF) & 127) >> 1; c4[m][bj] = *(const f32x4*)(rc + t * 64 + j0); s4[m][bj] = *(const f32x4*)(rs + t * 64 + j0); }
                asm volatile("" ::: "memory");
#pragma unroll
                for (int m = 0; m < 4; ++m)
#pragma unroll
                    for (int bj = 0; bj < 2; ++bj) { const int row = row0 + ai * HALF + m * 16, col = colt + bj * HALF; float v[8];
#pragma unroll
                        for (int n = 0; n < 2; ++n)
#pragma unroll
                            for (int i = 0; i < 4; ++i) v[n * 4 + i] = acc[ai][bj][m][n][i];
#pragma unroll
                        for (int i = 0; i < 4; ++i) { const float x1 = v[2 * i], x2 = v[2 * i + 1]; v[2 * i] = x1 * c4[m][bj][i] - x2 * s4[m][bj][i]; v[2 * i + 1] = x1 * s4[m][bj][i] + x2 * c4[m][bj][i]; }
                        u32x4 w; w.x = cvt_pk_bf16(v[0], v[1]); w.y = cvt_pk_bf16(v[2], v[3]); w.z = cvt_pk_bf16(v[4], v[5]); w.w = cvt_pk_bf16(v[6], v[7]); *(u32x4*)(base + (size_t)row * ld + col) = w; }
                asm volatile("" ::: "memory"); } }
#undef EPIWIN_LOOP
    }
};
struct EpiSwiglu {
    static constexpr bool PERM = true, AFTER_DRAIN = false;
    bf16_t* O; int ldc;
    __device__ __forceinline__ void operator()(const f32x4 (&acc)[2][2][4][2], const Unit& u, int wr, int wc, int fr, int fq) const {
        { const int l_ = mk_lane_id(); fr = l_ & 15; fq = l_ >> 4; }
        const int row0 = u.pm * BM + wr * 64 + fr, col0 = u.pn * HALF + wc * 32 + 8 * fq;
#pragma unroll
        for (int ai = 0; ai < 2; ++ai)
#pragma unroll
            for (int m = 0; m < 4; ++m) {
                bf16_t* rowp = O + (size_t)(row0 + ai * HALF + m * 16) * ldc + col0;
                float v[8];
#pragma unroll
                for (int n = 0; n < 2; ++n)
#pragma unroll
                    for (int i = 0; i < 4; ++i) { const float a = acc[ai][0][m][n][i], b = acc[ai][1][m][n][i]; v[n * 4 + i] = a / (1.f + __expf(-a)) * b; }
                u32x4 w; w.x = cvt_pk_bf16(v[0], v[1]); w.y = cvt_pk_bf16(v[2], v[3]); w.z = cvt_pk_bf16(v[4], v[5]); w.w = cvt_pk_bf16(v[6], v[7]);
                *(u32x4*)rowp = w;
            }
    }
};
struct EpiResid {
    static constexpr bool PERM = false, AFTER_DRAIN = false;
    float* X; const float* gate_lat; const float* gate_ctx; float f;
    __device__ __forceinline__ void operator()(const f32x4 (&acc)[2][2][4][2], const Unit& u, int wr, int wc, int fr, int fq) const {
        { const int l_ = mk_lane_id(); fr = l_ & 15; fq = l_ >> 4; }
        const int col0 = u.pn * BM + wc * 32 + 4 * fq;
        const float* gate = (u.pm == 0) ? gate_ctx : gate_lat;
        f32x4 gv[2][2];
#pragma unroll
        for (int bj = 0; bj < 2; ++bj)
#pragma unroll
            for (int n = 0; n < 2; ++n) gv[bj][n] = *(const f32x4*)(gate + col0 + bj * HALF + n * 16) * f;
#pragma unroll
        for (int ai = 0; ai < 2; ++ai) {
            f32x4 x[4][2][2];
            float* p0 = X + (size_t)(u.pm * BM + ai * HALF + wr * 64 + fr) * DM + col0;
#pragma unroll
            for (int m = 0; m < 4; ++m)
#pragma unroll
                for (int bj = 0; bj < 2; ++bj)
#pragma unroll
                    for (int n = 0; n < 2; ++n) x[m][bj][n] = *(const f32x4*)(p0 + (size_t)(m * 16) * DM + bj * HALF + n * 16);
            asm volatile("" ::: "memory");
#pragma unroll
            for (int m = 0; m < 4; ++m)
#pragma unroll
                for (int bj = 0; bj < 2; ++bj)
#pragma unroll
                    for (int n = 0; n < 2; ++n) *(f32x4*)(p0 + (size_t)(m * 16) * DM + bj * HALF + n * 16) = x[m][bj][n] + gv[bj][n] * acc[ai][bj][m][n];
            asm volatile("" ::: "memory");
        }
    }
};
struct EpiResidSlab {
    static constexpr bool PERM = false, AFTER_DRAIN = false;
    float* X; const float* gate_lat; float f; float* S;
    __device__ __forceinline__ void operator()(const f32x4 (&acc)[2][2][4][2], const Unit& u, int wr, int wc, int fr, int fq) const {
        if (u.pm == 0) { EpiSlab E{S}; E(acc, u, wr, wc, fr, fq); }
        else { EpiResid E{X, gate_lat, gate_lat, f}; E(acc, u, wr, wc, fr, fq); }
    }
};
struct EpiMergeSeg {
    static constexpr bool PERM = true, AFTER_DRAIN = false;
    const bf16_t* Zg; bf16_t* Y; float* MS3;
    __device__ __forceinline__ void operator()(f32x4 (&acc)[2][2][4][2], const Unit& u, int wr, int wc, int fr, int fq) const {
        { const int l_ = mk_lane_id(); fr = l_ & 15; fq = l_ >> 4; }
        const int seg = u.seg(); const bool ctxp = (u.pm == 0);
        const int col0 = u.pn * BM + wc * 32 + 8 * fq;
#pragma unroll
        for (int ai = 0; ai < 2; ++ai) {
            u32x4 ga[4][2], gb[4][2];
#pragma unroll
            for (int m = 0; m < 4; ++m)
#pragma unroll
                for (int bj = 0; bj < 2; ++bj) { const bf16_t* gp = Zg + (size_t)MT * ZC_MG + (size_t)(u.pm * BM + ai * HALF + wr * 64 + m * 16 + fr) * 12288 + seg * 4096 + col0 + bj * HALF;
                    ga[m][bj] = *(const u32x4*)gp; if (!ctxp && seg < 2) gb[m][bj] = *(const u32x4*)(gp + 4096); }
            asm volatile("" ::: "memory");
#pragma unroll
            for (int m = 0; m < 4; ++m)
#pragma unroll
                for (int bj = 0; bj < 2; ++bj) { const size_t row = (size_t)(u.pm * BM + ai * HALF + wr * 64 + m * 16 + fr); const int col = col0 + bj * HALF;
                    const unsigned aw[4] = {ga[m][bj].x, ga[m][bj].y, ga[m][bj].z, ga[m][bj].w};
                    float g[8];
#pragma unroll
                    for (int k = 0; k < 4; ++k) { g[2 * k] = fmaxf(__uint_as_float(aw[k] << 16), 1e-20f); g[2 * k + 1] = fmaxf(__uint_as_float(aw[k] & 0xffff0000u), 1e-20f); }
                    if (!ctxp && seg < 2) { const unsigned bw[4] = {gb[m][bj].x, gb[m][bj].y, gb[m][bj].z, gb[m][bj].w};
#pragma unroll
                        for (int k = 0; k < 4; ++k) { g[2 * k] = g[2 * k] * __builtin_amdgcn_rcpf(fmaxf(__uint_as_float(bw[k] << 16), 1e-20f)); g[2 * k + 1] = g[2 * k + 1] * __builtin_amdgcn_rcpf(fmaxf(__uint_as_float(bw[k] & 0xffff0000u), 1e-20f)); } }
                    float v[8];
#pragma unroll
                    for (int n = 0; n < 2; ++n)
#pragma unroll
                        for (int i = 0; i < 4; ++i) v[n * 4 + i] = acc[ai][bj][m][n][i] * g[n * 4 + i];
                    if (ctxp) { float* ms = MS3 + ((size_t)seg * 256 + row) * DM + col; *(f32x4*)ms = (f32x4){v[0], v[1], v[2], v[3]}; *(f32x4*)(ms + 4) = (f32x4){v[4], v[5], v[6], v[7]}; }
                    else if (seg < 2) { acc[ai][bj][m][0] = (f32x4){v[0], v[1], v[2], v[3]}; acc[ai][bj][m][1] = (f32x4){v[4], v[5], v[6], v[7]}; }
                    else { u32x4 w; w.x = cvt_pk_bf16(v[0], v[1]); w.y = cvt_pk_bf16(v[2], v[3]); w.z = cvt_pk_bf16(v[4], v[5]); w.w = cvt_pk_bf16(v[6], v[7]); *(u32x4*)(Y + row * DM + col) = w; } }
            asm volatile("" ::: "memory");
        }
    }
};
}

constexpr int TSTR = 68, TSCR_BYTES = 64 * TSTR * 4;
__device__ __forceinline__ void transpose_item(const float* __restrict__ W, size_t ldw, int K, int k0, int srccol0, bf16* WT, int dstrow0, LAS float* scr, int lane) {
    const int r4 = lane >> 4, c16 = lane & 15;
    f32x4 v[16];
#pragma unroll
    for (int i = 0; i < 16; ++i) v[i] = *(const f32x4*)(W + (size_t)(k0 + 4 * i + r4) * ldw + srccol0 + 4 * c16);
#pragma unroll
    for (int i = 0; i < 16; ++i) *(LAS f32x4*)(scr + (4 * i + r4) * TSTR + 4 * c16) = v[i];
    LDS_WAIT(); asm volatile("" ::: "memory");
    const int c = lane & 7;
#pragma unroll
    for (int j = 0; j < 8; ++j) { const int n = (lane >> 3) + 8 * j; const LAS float* sp = scr + (8 * c) * TSTR + n;
        v4u o; o.x = pk2(sp[0 * TSTR], sp[1 * TSTR]); o.y = pk2(sp[2 * TSTR], sp[3 * TSTR]); o.z = pk2(sp[4 * TSTR], sp[5 * TSTR]); o.w = pk2(sp[6 * TSTR], sp[7 * TSTR]);
        *(GAS v4u*)(WT + (size_t)(dstrow0 + n) * K + k0 + 8 * c) = o; }
    LDS_WAIT(); asm volatile("" ::: "memory");
}

struct Ptrs {
    const float *x, *c, *ctx, *c_ctx, *ada_down, *ada_up, *ada_bias, *norm_g, *w13, *w2, *w_in, *gmlp_norm_g, *gmlp_ws, *gmlp_bs, *gate_b, *mlstm_norm_g, *diff_lambda, *diff_norm_g, *w_branch, *w_out, *final_g;
    float* out; unsigned char* ws;
};

constexpr int IT_W13 = 2 * 64 * 128, IT_W2 = 2 * 64 * 64, IT_WIN = 64 * 320, IT_WB = 3 * 16 * 64, IT_WO = 64 * 64, IT_LAYER = IT_W13 + IT_W2 + IT_WIN + IT_WB + IT_WO;

__device__ __forceinline__ void convert_range(const Ptrs& P, int l, int it_lo, int it_hi, int widx, int nw, LAS float* scr, int lane) {
    unsigned char* ws = P.ws;
    for (int it = it_lo + widx; it < it_hi; it += nw) {
        int r = it;
        if (r < IT_W13) { const int s = r / (64 * 128), q = r % (64 * 128), kb = q / 128, nb = q % 128, dr = nb * 64, tile = dr >> 8, within = dr & 255;
            const int src = within < 128 ? tile * 128 + within : 4096 + tile * 128 + (within - 128);
            transpose_item(P.w13 + (size_t)(l * 2 + s) * 4096 * 8192, 8192, 4096, kb * 64, src, (bf16*)(ws + WS_W13T) + (size_t)(l * 2 + s) * 8192 * 4096, dr, scr, lane); continue; }
        r -= IT_W13;
        if (r < IT_W2) { const int s = r / (64 * 64), q = r % (64 * 64), kb = q / 64, nb = q % 64;
            transpose_item(P.w2 + (size_t)(l * 2 + s) * 4096 * 4096, 4096, 4096, kb * 64, nb * 64, (bf16*)(ws + WS_W2T) + (size_t)(l * 2 + s) * 4096 * 4096, nb * 64, scr, lane); continue; }
        r -= IT_W2;
        if (r < IT_WIN) { const int kb = r / 320, nb = r % 320, dr = nb * 64, src = dr < 5120 ? dr : dr + 16;
            transpose_item(P.w_in + (size_t)l * 4096 * INC, INC, 4096, kb * 64, src, (bf16*)(ws + WS_WINT) + (size_t)l * NZ * 4096, dr, scr, lane); continue; }
        r -= IT_WIN;
        if (r < IT_WB) { const int i = r / (16 * 64), q = r % (16 * 64), kb = q / 64, nb = q % 64;
            transpose_item(P.w_branch + (size_t)(l * 3 + i) * 1024 * 4096, 4096, 1024, kb * 64, nb * 64, (bf16*)(ws + WS_WBT) + (size_t)(l * 3 + i) * 4096 * 1024, nb * 64, scr, lane); continue; }
        r -= IT_WB;
        { const int kb = r / 64, nb = r % 64;
            transpose_item(P.w_out + (size_t)l * 4096 * 4096, 4096, 4096, kb * 64, nb * 64, (bf16*)(ws + WS_WOT) + (size_t)l * 4096 * 4096, nb * 64, scr, lane); }
    }
}
constexpr int CV_FRAC_NUM = 2, CV_FRAC_DEN = 10;
constexpr int CV_TOT = IT_LAYER * CV_FRAC_NUM / CV_FRAC_DEN, CV_A = CV_TOT * 2 / 5, CV_W = CV_TOT / 5;
__device__ __forceinline__ void convert_idle(const Ptrs& P, int lnext, int it_lo, int it_hi, int first_idle, LAS unsigned char* lds, int bid, int G, int tid) {
    asm volatile("" : "+v"(tid));
    if (G < first_idle + 16) first_idle = 0;
    if (lnext >= DEPTH || bid < first_idle) return;
    const int wave = tid >> 6, lane = tid & 63;
    convert_range(P, lnext, it_lo, it_hi, (bid - first_idle) * NWAVES + wave, (G - first_idle) * NWAVES, (LAS float*)(lds + RING_OFF + wave * TSCR_BYTES), lane);
}
__device__ __forceinline__ void pro0(const Ptrs& P, LAS unsigned char* lds, int bid, int G, int tid) {
    asm volatile("" : "+v"(tid));
    const int wave = tid >> 6, lane = tid & 63;
    LAS float* scr = (LAS float*)(lds + RING_OFF + wave * TSCR_BYTES);
    const int gw = bid * NWAVES + wave, NGW = G * NWAVES;
    unsigned char* ws = P.ws;
    convert_range(P, 0, 0, IT_LAYER, gw, NGW, scr, lane);
    for (int l = 1; l < DEPTH; ++l) convert_range(P, l, CV_TOT, IT_LAYER, gw, NGW, scr, lane);
    const int gt = bid * NTHR + tid, NGT = G * NTHR;
    { f32x4* XR = (f32x4*)(ws + WS_XR); const f32x4* xc = (const f32x4*)P.ctx; const f32x4* xl = (const f32x4*)P.x;
      const int nctx = CTXL * DM / 4, ntot = MT * DM / 4;
      for (int i0 = gt; i0 < ntot; i0 += 4 * NGT) { f32x4 t[4];
#pragma unroll
          for (int k = 0; k < 4; ++k) { const int i = i0 + k * NGT; if (i < ntot) t[k] = *(i < nctx ? xc + i : xl + (i - nctx)); }
          asm volatile("" ::: "memory");
#pragma unroll
          for (int k = 0; k < 4; ++k) { const int i = i0 + k * NGT; if (i < ntot) XR[i] = t[k]; } } }
    { float* rc = (float*)(ws + WS_ROPE); float* rs = rc + SEQ * 64;
      for (int i = gt; i < SEQ * 64; i += NGT) { const int t = i >> 6, j = i & 63; const float inv = powf(10000.f, -(float)(j & 31) / 32.f);
          const float pos = (float)(j < 32 ? (t >> 6) : (t & 63)); const float ang = pos * inv; rc[i] = cosf(ang); rs[i] = sinf(ang); } }
    { float* tp = (float*)(ws + WS_MODTP);
      for (int task = gw; task < DEPTH * 2 * 4 * 64; task += NGW) { const int dc = task & 63, rg = (task >> 6) & 3, w = (task >> 8) & 1, l = task >> 9;
          const float* cv = w ? P.c_ctx : P.c; const float* dn = P.ada_down + (size_t)l * DM * ADAR + (size_t)(dc * 64) * ADAR + rg * 64 + lane;
          float wv[64]; const float cmine = cv[dc * 64 + lane], smine = cmine / (1.f + expf(-cmine));
#pragma unroll
          for (int d = 0; d < 64; ++d) wv[d] = dn[(size_t)d * ADAR];
          asm volatile("" ::: "memory");
          float acc = 0.f;
#pragma unroll
          for (int d = 0; d < 64; ++d) acc += __int_as_float(__builtin_amdgcn_readlane(__float_as_int(smine), d)) * wv[d];
          tp[((l * 2 + w) * 64 + dc) * 256 + rg * 64 + lane] = acc; } }
    if (bid == 0 && tid < DEPTH) { const float* dl = P.diff_lambda + tid * 4 * 128; float s1 = 0.f, s2 = 0.f;
        for (int i = 0; i < 128; ++i) { s1 += dl[i] * dl[128 + i]; s2 += dl[256 + i] * dl[384 + i]; }
        ((float*)(ws + WS_LAM))[tid] = expf(s1) - expf(s2) + lambda_init_f(tid); }
    { bf16* wb = (bf16*)(ws + WS_GWSB); for (int i = gt; i < DEPTH * 8 * 128 * 128; i += NGT) wb[i] = (bf16)f2bf(P.gmlp_ws[i]); }
    { bf16* wg = (bf16*)(ws + WS_WG16);
      for (int i = gt; i < DEPTH * DM * 16; i += NGT) { const int j = i & 15, d = (i >> 4) & (DM - 1), l = i >> 16;
          wg[((size_t)l * 16 + j) * DM + d] = (bf16)f2bf(P.w_in[((size_t)l * DM + d) * INC + 5120 + j]); } }
}

__device__ __forceinline__ void pro1(const Ptrs& P, LAS unsigned char* lds, int bid, int G, int tid) {
    asm volatile("" : "+v"(tid));
    LAS float* T = (LAS float*)(lds + RING_OFF);
    const float* tp = (const float*)(P.ws + WS_MODTP);
    for (int i = tid; i < DEPTH * 2 * 256; i += NTHR) { const int r = i & 255, lw = i >> 8; float s = 0.f;
        for (int dc = 0; dc < 64; ++dc) s += tp[(lw * 64 + dc) * 256 + r];
        T[i] = s; }
    __syncthreads();
    float* MOD = (float*)(P.ws + WS_MOD);
    for (int i = bid * NTHR + tid; i < DEPTH * NMOD; i += G * NTHR) { const int l = i / NMOD, n = i % NMOD;
        const float* up = P.ada_up + (size_t)l * ADAR * NMOD + n; const float b = P.ada_bias[(size_t)l * NMOD + n]; float a0 = b, a1 = b;
#pragma unroll 1
        for (int r0 = 0; r0 < ADAR; r0 += 32) { float uu[32];
#pragma unroll
            for (int k = 0; k < 32; ++k) uu[k] = up[(size_t)(r0 + k) * NMOD];
            asm volatile("" ::: "memory");
#pragma unroll
            for (int k = 0; k < 32; ++k) { a0 += T[(l * 2 + 0) * 256 + r0 + k] * uu[k]; a1 += T[(l * 2 + 1) * 256 + r0 + k] * uu[k]; } }
        MOD[(size_t)(l * 2 + 0) * NMOD + n] = a0; MOD[(size_t)(l * 2 + 1) * NMOD + n] = a1; }
    __syncthreads();
}

__device__ __forceinline__ void phase_norm(float* XR, const float* g, const float* modl, const float* modc, bf16* H, const float* slab, const float* cgate, float cf, LAS unsigned char* lds, int bid, int G, int tid) {
    asm volatile("" : "+v"(tid));
    const int wave = tid >> 6, lane = tid & 63;
    LAS f32x4* AL = (LAS f32x4*)lds; LAS f32x4* SL = AL + 1024; LAS f32x4* AC = AL + 2048; LAS f32x4* SC = AL + 3072;
    { f32x4 q[2][5];
#pragma unroll
      for (int k = 0; k < 2; ++k) { const int i = tid + k * NTHR; q[k][0] = ((const f32x4*)g)[i]; q[k][1] = ((const f32x4*)(modl + DM))[i]; q[k][2] = ((const f32x4*)modl)[i]; q[k][3] = ((const f32x4*)(modc + DM))[i]; q[k][4] = ((const f32x4*)modc)[i]; }
      asm volatile("" ::: "memory");
#pragma unroll
      for (int k = 0; k < 2; ++k) { const int i = tid + k * NTHR; AL[i] = q[k][0] * (q[k][1] + 1.f); SL[i] = q[k][2]; AC[i] = q[k][0] * (q[k][3] + 1.f); SC[i] = q[k][4]; } }
    const int row0 = bid * NWAVES + wave, stride = G * NWAVES;
    if (slab && row0 < CTXL) {
        f32x4* xw = (f32x4*)(XR + (size_t)row0 * DM) + lane; const f32x4* sp = (const f32x4*)(slab + (size_t)row0 * DM) + lane; const f32x4* gp = (const f32x4*)cgate + lane;
#pragma unroll 1
        for (int j = 0; j < 16; j += 2) { f32x4 q[2][16], xo[2];
#pragma unroll
            for (int jj = 0; jj < 2; ++jj) { xo[jj] = xw[64 * (j + jj)];
#pragma unroll
                for (int kc = 0; kc < 16; ++kc) q[jj][kc] = sp[(size_t)kc * 256 * (DM / 4) + 64 * (j + jj)]; }
            asm volatile("" ::: "memory");
#pragma unroll
            for (int jj = 0; jj < 2; ++jj) { f32x4 a = (f32x4){0.f, 0.f, 0.f, 0.f};
#pragma unroll
                for (int kc = 0; kc < 16; ++kc) a += q[jj][kc];
                xw[64 * (j + jj)] = xo[jj] + a * gp[64 * (j + jj)] * cf; }
            asm volatile("" ::: "memory"); }
        asm volatile("s_waitcnt vmcnt(0)" ::: "memory");
    }
    __syncthreads();
    f32x4 v[16];
    if (row0 < MT) { const f32x4* xr = (const f32x4*)(XR + (size_t)row0 * DM) + lane;
#pragma unroll
        for (int j = 0; j < 16; ++j) v[j] = xr[64 * j]; }
    for (int row = row0; row < MT; row += stride) {
        f32x4 vn[16];
        if (row + stride < MT) { const f32x4* xr = (const f32x4*)(XR + (size_t)(row + stride) * DM) + lane;
#pragma unroll
            for (int j = 0; j < 16; ++j) vn[j] = xr[64 * j]; }
        float ss = 0.f;
#pragma unroll
        for (int j = 0; j < 16; ++j) ss += (v[j].x * v[j].x + v[j].y * v[j].y) + (v[j].z * v[j].z + v[j].w * v[j].w);
        const float rstd = 1.f / sqrtf(wave_sum(ss) * (1.f / DM) + EPS);
        const LAS f32x4* Ap = row < CTXL ? AC : AL; const LAS f32x4* Sp = row < CTXL ? SC : SL;
        uint2* hr = (uint2*)(H + (size_t)row * DM) + lane;
#pragma unroll
        for (int j = 0; j < 16; ++j) { const f32x4 hv = v[j] * rstd * Ap[lane + 64 * j] + Sp[lane + 64 * j];
            uint2 o; o.x = pk2(hv.x, hv.y); o.y = pk2(hv.z, hv.w); hr[64 * j] = o; }
#pragma unroll
        for (int j = 0; j < 16; ++j) v[j] = vn[j];
    }
    __syncthreads();
}
typedef float f32x4g __attribute__((ext_vector_type(4)));
__device__ __forceinline__ void gates_unit(const bf16* H, const bf16* WGb, float* G16, int jb, int tid) {
    asm volatile("" : "+v"(tid));
    const int wave = tid >> 6, lane = tid & 63, fr = lane & 15, fq = lane >> 4;
    const bf16* ap = H + (size_t)(jb * 128 + wave * 16 + fr) * DM + 8 * fq; const bf16* bp = WGb + (size_t)fr * DM + 8 * fq;
    f32x4g acc[4];
#pragma unroll
    for (int i = 0; i < 4; ++i) acc[i] = (f32x4g){0.f, 0.f, 0.f, 0.f};
#pragma unroll 1
    for (int k = 0; k < DM; k += 512) { bf16x8 af[16], bfv[16];
#pragma unroll
        for (int i = 0; i < 16; ++i) { af[i] = *(const bf16x8*)(ap + k + 32 * i); bfv[i] = *(const bf16x8*)(bp + k + 32 * i); }
        asm volatile("" ::: "memory");
#pragma unroll
        for (int i = 0; i < 16; ++i) acc[i & 3] = __builtin_amdgcn_mfma_f32_16x16x32_bf16(af[i], bfv[i], acc[i & 3], 0, 0, 0);
    }
    const f32x4g sres = (acc[0] + acc[1]) + (acc[2] + acc[3]);
#pragma unroll
    for (int r = 0; r < 4; ++r) G16[(size_t)(jb * 128 + wave * 16 + 4 * fq + r) * 16 + fr] = sres[r];
}

__device__ __forceinline__ void phase_final(const float* XR, const float* g, float* out, int bid, int G, int tid) {
    asm volatile("" : "+v"(tid));
    const int wave = tid >> 6, lane = tid & 63;
    f32x4 gg[16];
#pragma unroll
    for (int j = 0; j < 16; ++j) gg[j] = *(const f32x4*)(g + 4 * lane + 256 * j);
    for (int t = bid * NWAVES + wave; t < SEQ; t += G * NWAVES) {
        const f32x4* xr = (const f32x4*)(XR + (size_t)(CTXL + t) * DM) + lane;
        f32x4 v[16]; float ss = 0.f;
#pragma unroll
        for (int j = 0; j < 16; ++j) { v[j] = xr[64 * j]; ss += (v[j].x * v[j].x + v[j].y * v[j].y) + (v[j].z * v[j].z + v[j].w * v[j].w); }
        const float rstd = 1.f / sqrtf(wave_sum(ss) * (1.f / DM) + EPS);
        f32x4* o = (f32x4*)(out + (size_t)t * DM) + lane;
#pragma unroll
        for (int j = 0; j < 16; ++j) o[64 * j] = v[j] * rstd * gg[j];
    }
}

typedef short s16x4 __attribute__((ext_vector_type(4)));
typedef float f32x16 __attribute__((ext_vector_type(16)));
typedef short v4i16_t __attribute__((ext_vector_type(4)));
__device__ __forceinline__ int crow16(int r, int hi) { return (r & 3) + 8 * (r >> 2) + 4 * hi; }
__device__ __forceinline__ int chain_cidx(int dir, int jb) { return dir ? (jb < 2 ? 1 - jb : 67 - jb) : jb; }
__device__ __forceinline__ s16x4 trr(LAS const unsigned char* p) { return __builtin_bit_cast(s16x4, __builtin_amdgcn_ds_read_tr16_b64_v4i16((LAS v4i16_t*)p)); }
__device__ __forceinline__ bf16x8 trfrag(LAS const unsigned char* im, int RS, int rowA, int rowB, int n0, int lane) {
    const int i = lane & 15, q = i >> 2, p = i & 3, cb = n0 + 16 * ((lane >> 4) & 1) + 4 * p;
    const s16x4 lo = trr(im + (rowA + q) * RS + cb * 2), hi = trr(im + (rowB + q) * RS + cb * 2);
    return (bf16x8){lo[0], lo[1], lo[2], lo[3], hi[0], hi[1], hi[2], hi[3]};
}
constexpr int VSTR = 528, KW_OFF = 67584;
constexpr int SM_OFF = 133120;
__device__ __forceinline__ void gate_scan(const float* G16, const float* gate_b, int jb, int h, LAS float* SM, int tid) {
    LAS float* SC = SM + 768;
    const int dir = (tid >> 7) & 1, c = tid & 127, o = dir ? 127 - c : c; const bool act = tid < 256;
    float ip = 0.f, x = 0.f;
    if (act) { const size_t row = (size_t)jb * 128 + o; ip = G16[row * 16 + dir * 8 + h] + gate_b[dir * 8 + h]; const float fp = G16[row * 16 + dir * 8 + 4 + h] + gate_b[dir * 8 + 4 + h];
        x = fminf(fp, 0.f) - __logf(1.f + __expf(-fabsf(fp))); }
    for (int s = 1; s < 128; s <<= 1) { if (act) SC[dir * 128 + c] = x; __syncthreads(); if (act && c >= s) x += SC[dir * 128 + c - s]; __syncthreads(); }
    const float b = x, u = ip - b; float y = u;
    for (int s = 1; s < 128; s <<= 1) { if (act) SC[dir * 128 + c] = y; __syncthreads(); if (act && c >= s) y = fmaxf(y, SC[dir * 128 + c - s]); __syncthreads(); }
    if (act) { SM[dir * 128 + o] = u; SM[256 + dir * 128 + o] = y; SM[512 + dir * 128 + o] = b; if (c == 127) { SM[1024 + dir] = b; SM[1026 + dir] = y; } }
    __syncthreads();
}
__device__ __forceinline__ void stage_v(const bf16* Z, size_t row0, int h, LAS unsigned char* VL, int tid) {
    v4u t[8];
#pragma unroll
    for (int k = 0; k < 8; ++k) { const int i = tid + k * NTHR, sr = i >> 5, ch = i & 31; t[k] = *(const v4u*)(Z + (size_t)MT * ZC_MV + (row0 + sr) * 1024 + h * 256 + ch * 8); }
    asm volatile("" ::: "memory");
#pragma unroll
    for (int k = 0; k < 8; ++k) { const int i = tid + k * NTHR, sr = i >> 5, ch = i & 31; *(LAS v4u*)(VL + sr * VSTR + ch * 16) = t[k]; }
}
__device__ __forceinline__ void mlstm_m1_unit(const bf16* Z, const float* G16, const float* gate_b, float* DCT, float* DN, float* CH, int jb, int h, LAS unsigned char* lds, int tid) {
    asm volatile("" : "+v"(tid));
    const int wave = tid >> 6, lane = tid & 63, hh = lane >> 5;
    LAS unsigned char* VL = lds; LAS unsigned char* KW = lds + KW_OFF; LAS float* SM = (LAS float*)(lds + SM_OFF);
    gate_scan(G16, gate_b, jb, h, SM, tid);
    const size_t row0 = (size_t)jb * 128;
    stage_v(Z, row0, h, VL, tid);
    { v4u kq[4];
#pragma unroll
      for (int k = 0; k < 4; ++k) { const int i = tid + k * NTHR, sr = i >> 4, ch = i & 15; kq[k] = *(const v4u*)(Z + (size_t)MT * ZC_MK + (row0 + sr) * 512 + h * 128 + ch * 8); }
      asm volatile("" ::: "memory");
#pragma unroll
      for (int k = 0; k < 4; ++k) { const int i = tid + k * NTHR, sr = i >> 4, ch = i & 15; const v4u kw = kq[k];
#pragma unroll
        for (int dir = 0; dir < 2; ++dir) { const float wg = __expf(SM[dir * 128 + sr] - SM[1026 + dir]); v4u o;
            o.x = pk2(bflo(kw.x) * wg, bfhi(kw.x) * wg); o.y = pk2(bflo(kw.y) * wg, bfhi(kw.y) * wg); o.z = pk2(bflo(kw.z) * wg, bfhi(kw.z) * wg); o.w = pk2(bflo(kw.w) * wg, bfhi(kw.w) * wg);
            *(LAS v4u*)(KW + dir * 32768 + sr * 256 + ch * 16) = o; } } }
    __syncthreads();
    const int dir = wave >> 2, ebp = wave & 3;
    f32x16 acc[2][4];
#pragma unroll
    for (int a = 0; a < 2; ++a)
#pragma unroll
        for (int b = 0; b < 4; ++b)
#pragma unroll
            for (int r = 0; r < 16; ++r) acc[a][b][r] = 0.f;
#pragma unroll 2
    for (int ks = 0; ks < 8; ++ks) {
        bf16x8 af[2], bfr[4];
#pragma unroll
        for (int eb = 0; eb < 2; ++eb) af[eb] = trfrag(VL, VSTR, 16 * ks + 8 * hh, 16 * ks + 8 * hh + 4, 32 * (2 * ebp + eb), lane);
#pragma unroll
        for (int db = 0; db < 4; ++db) bfr[db] = trfrag(KW + dir * 32768, 256, 16 * ks + 8 * hh, 16 * ks + 8 * hh + 4, 32 * db, lane);
#pragma unroll
        for (int eb = 0; eb < 2; ++eb)
#pragma unroll
            for (int db = 0; db < 4; ++db) acc[eb][db] = __builtin_amdgcn_mfma_f32_32x32x16_bf16(af[eb], bfr[db], acc[eb][db], 0, 0, 0);
    }
    { const int cidx = chain_cidx(dir, jb); float* dst = DCT + (size_t)((dir * 4 + h) * 66 + cidx) * 32768;
#pragma unroll
      for (int eb = 0; eb < 2; ++eb)
#pragma unroll
          for (int db = 0; db < 4; ++db)
#pragma unroll
              for (int r = 0; r < 16; ++r) dst[(32 * (2 * ebp + eb) + crow16(r, hh)) * 128 + 32 * db + (lane & 31)] = acc[eb][db][r]; }
    if (tid < 256) { const int dd = tid >> 7, d = tid & 127; float s = 0.f;
        for (int sg = 0; sg < 128; ++sg) s += bf2f(*(LAS const unsigned short*)(KW + dd * 32768 + sg * 256 + d * 2));
        DN[(size_t)((dd * 4 + h) * 66 + chain_cidx(dd, jb)) * 128 + d] = s; }
    if (tid < 2) { float* c = CH + (size_t)((tid * 4 + h) * 66 + chain_cidx(tid, jb)) * 2; c[0] = SM[1024 + tid]; c[1] = SM[1026 + tid]; }
    __syncthreads();
}
__device__ __forceinline__ void mlstm_m2_scalars(const float* CH, int chain, LAS float* SC, int tid) {
    if (tid < 66) { SC[256 + 2 * tid] = CH[(size_t)(chain * 66 + tid) * 2]; SC[256 + 2 * tid + 1] = CH[(size_t)(chain * 66 + tid) * 2 + 1]; }
    __syncthreads();
    if (tid == 0) { float m = 0.f;
        for (int j = 0; j < 66; ++j) { const float Bj = SC[256 + 2 * j], cm = SC[256 + 2 * j + 1], Mx = fmaxf(m, cm); SC[3 * j] = __expf(m - Mx); SC[3 * j + 1] = __expf(cm - Mx); SC[3 * j + 2] = m; m = Bj + Mx; } }
    __syncthreads();
}
__device__ __forceinline__ void mlstm_m2(const float* DCT, const float* DN, const float* CH, bf16* CT, float* NS, float* MS, LAS unsigned char* lds, int bid, int G, int tid) {
    asm volatile("" : "+v"(tid));
    LAS float* SC = (LAS float*)lds;
    for (int base = bid * NTHR; base < 8 * 16384; base += G * NTHR) {
        const int chain = base >> 14, p = (base & 16383) + tid;
        mlstm_m2_scalars(CH, chain, SC, tid);
        if ((base & 16383) == 0 && tid < 66) MS[chain * 66 + tid] = SC[3 * tid + 2];
        const float* dl = DCT + (size_t)chain * 66 * 32768 + 2 * p; unsigned* ct = (unsigned*)(CT + (size_t)chain * 66 * 32768 + 2 * p);
        float c0 = 0.f, c1 = 0.f;
#pragma unroll 1
        for (int jb = 0; jb < 66; jb += 11) { float2 d[11];
#pragma unroll
            for (int k = 0; k < 11; ++k) d[k] = *(const float2*)(dl + (size_t)(jb + k) * 32768);
            asm volatile("" ::: "memory");
#pragma unroll
            for (int k = 0; k < 11; ++k) { const float dec = SC[3 * (jb + k)], sc = SC[3 * (jb + k) + 1]; ct[(size_t)(jb + k) * 16384] = pk2(c0, c1); c0 = dec * c0 + sc * d[k].x; c1 = dec * c1 + sc * d[k].y; }
            asm volatile("" ::: "memory"); }
        __syncthreads();
    }
    for (int chain = bid; chain < 8; chain += G) {
        mlstm_m2_scalars(CH, chain, SC, tid);
        if (tid < 128) { float c0 = 0.f;
#pragma unroll 1
            for (int jb = 0; jb < 66; jb += 11) { float d[11];
#pragma unroll
                for (int k = 0; k < 11; ++k) d[k] = DN[(size_t)(chain * 66 + jb + k) * 128 + tid];
                asm volatile("" ::: "memory");
#pragma unroll
                for (int k = 0; k < 11; ++k) { NS[(size_t)(chain * 66 + jb + k) * 128 + tid] = c0; c0 = SC[3 * (jb + k)] * c0 + SC[3 * (jb + k) + 1] * d[k]; }
                asm volatile("" ::: "memory"); } }
        __syncthreads();
    }
}
__device__ __forceinline__ void mlstm_m3_unit(const bf16* Z, const float* G16, const float* gate_b, const bf16* CT, const float* NS, const float* MS, const float* mng, bf16* YB, int jb, int h, LAS unsigned char* lds, int tid) {
    asm volatile("" : "+v"(tid));
    const int wave = tid >> 6, lane = tid & 63, hh = lane >> 5, l31 = lane & 31;
    LAS unsigned char* VL = lds; LAS float* XCH = (LAS float*)lds; LAS float* SM = (LAS float*)(lds + SM_OFF);
    gate_scan(G16, gate_b, jb, h, SM, tid);
    const size_t row0 = (size_t)jb * 128;
    if (tid < 256) { const int dd = tid >> 7, d = tid & 127; SM[1040 + dd * 128 + d] = NS[(size_t)((dd * 4 + h) * 66 + chain_cidx(dd, jb)) * 128 + d]; }
    if (tid < 2) SM[1028 + tid] = MS[(tid * 4 + h) * 66 + chain_cidx(tid, jb)];
    stage_v(Z, row0, h, VL, tid);
    __syncthreads();
    const int tb = wave & 3, dir = wave >> 2, tau = 32 * tb + l31;
    float SCL = 0.08838834764831845f; asm volatile("" : "+v"(SCL));
    const float m = SM[1028 + dir], cmT = SM[256 + dir * 128 + tau], bT = SM[512 + dir * 128 + tau];
    const float Mt = fmaxf(m, cmT), wa = __expf(m - Mt), em = __expf(-(bT + Mt)), fa = wa * SCL;
    bf16x8 qf[8];
#pragma unroll
    for (int ks = 0; ks < 8; ++ks) qf[ks] = *(const bf16x8*)(Z + (size_t)MT * ZC_MQ + (row0 + tau) * 512 + h * 128 + 16 * ks + 8 * hh);
    f32x16 acc[8];
#pragma unroll
    for (int eb = 0; eb < 8; ++eb)
#pragma unroll
        for (int r = 0; r < 16; ++r) acc[eb][r] = 0.f;
    { const bf16* ct = CT + (size_t)((dir * 4 + h) * 66 + chain_cidx(dir, jb)) * 32768;
#pragma unroll
      for (int e2 = 0; e2 < 8; e2 += 2) { bf16x8 af[2][8];
#pragma unroll
          for (int eb = 0; eb < 2; ++eb)
#pragma unroll
              for (int ks = 0; ks < 8; ++ks) af[eb][ks] = *(const bf16x8*)(ct + (size_t)(32 * (e2 + eb) + l31) * 128 + 16 * ks + 8 * hh);
          asm volatile("" ::: "memory");
#pragma unroll
          for (int ks = 0; ks < 8; ++ks) { acc[e2] = __builtin_amdgcn_mfma_f32_32x32x16_bf16(af[0][ks], qf[ks], acc[e2], 0, 0, 0); acc[e2 + 1] = __builtin_amdgcn_mfma_f32_32x32x16_bf16(af[1][ks], qf[ks], acc[e2 + 1], 0, 0, 0); } } }
    asm volatile("" ::: "memory");
    float den = 0.f;
#pragma unroll
    for (int ks = 0; ks < 8; ++ks)
#pragma unroll
        for (int j = 0; j < 8; ++j) den += bf2f((unsigned short)qf[ks][j]) * SM[1040 + dir * 128 + 16 * ks + 8 * hh + j];
    den *= fa;
#pragma unroll
    for (int eb = 0; eb < 8; ++eb)
#pragma unroll
        for (int r = 0; r < 16; ++r) acc[eb][r] *= fa;
    asm volatile("" ::: "memory");
#pragma unroll 1
    for (int sb = 0; sb < 4; ++sb) {
        if (dir == 0 ? sb > tb : sb < tb) continue;
        asm volatile("" ::: "memory");
        f32x16 p;
#pragma unroll
        for (int r = 0; r < 16; ++r) p[r] = 0.f;
#pragma unroll
        for (int kh = 0; kh < 2; ++kh) { bf16x8 kf[4];
#pragma unroll
          for (int ks = 0; ks < 4; ++ks) kf[ks] = *(const bf16x8*)(Z + (size_t)MT * ZC_MK + (row0 + 32 * sb + l31) * 512 + h * 128 + 16 * (4 * kh + ks) + 8 * hh);
          asm volatile("" ::: "memory");
#pragma unroll
          for (int ks = 0; ks < 4; ++ks) p = __builtin_amdgcn_mfma_f32_32x32x16_bf16(kf[ks], qf[4 * kh + ks], p, 0, 0, 0); }
#pragma unroll
        for (int r = 0; r < 16; ++r) { const int sg = 32 * sb + crow16(r, hh); const bool keep = dir == 0 ? (sg <= tau) : (sg >= tau);
            const float w = keep ? __expf(SM[dir * 128 + sg] - Mt) * SCL : 0.f; p[r] *= w; den += p[r]; }
#pragma unroll
        for (int s = 0; s < 2; ++s) {
            v4u w4; w4.x = pk2(p[8 * s + 0], p[8 * s + 1]); w4.y = pk2(p[8 * s + 2], p[8 * s + 3]); w4.z = pk2(p[8 * s + 4], p[8 * s + 5]); w4.w = pk2(p[8 * s + 6], p[8 * s + 7]);
            const bf16x8 bfrag = __builtin_bit_cast(bf16x8, w4);
#pragma unroll
            for (int eb = 0; eb < 8; ++eb) { const bf16x8 a = trfrag(VL, VSTR, 32 * sb + 16 * s + 4 * hh, 32 * sb + 16 * s + 8 + 4 * hh, 32 * eb, lane);
                acc[eb] = __builtin_amdgcn_mfma_f32_32x32x16_bf16(a, bfrag, acc[eb], 0, 0, 0);
                if (eb & 1) { asm volatile("" ::: "memory"); } }
        }
    }
    den += shfl_xor_f(den, 32);
    { const float inv = 1.f / fmaxf(fabsf(den), em);
#pragma unroll
      for (int eb = 0; eb < 8; ++eb)
#pragma unroll
          for (int r = 0; r < 16; ++r) acc[eb][r] *= inv; }
    __syncthreads();
    LAS float* HS = (LAS float*)lds;
    if (dir == 1) {
#pragma unroll
        for (int eb = 0; eb < 8; ++eb)
#pragma unroll
            for (int r = 0; r < 16; ++r) HS[tau * 257 + 32 * eb + crow16(r, hh)] = acc[eb][r];
    }
    __syncthreads();
    if (dir == 0) {
#pragma unroll
        for (int eb = 0; eb < 8; ++eb)
#pragma unroll
            for (int r = 0; r < 16; ++r) HS[tau * 257 + 32 * eb + crow16(r, hh)] += acc[eb][r];
    }
    __syncthreads();
    {
        unsigned short og[16][4]; float gn[4];
#pragma unroll
        for (int rr = 0; rr < 16; ++rr)
#pragma unroll
            for (int k = 0; k < 4; ++k) og[rr][k] = Z[(size_t)MT * ZC_MO + (row0 + wave * 16 + rr) * 1024 + h * 256 + 64 * k + lane];
#pragma unroll
        for (int k = 0; k < 4; ++k) gn[k] = mng[h * 256 + 64 * k + lane];
#pragma unroll
        for (int rr = 0; rr < 16; ++rr) { const int t2 = wave * 16 + rr; float v[4]; float ss = 0.f;
#pragma unroll
            for (int k = 0; k < 4; ++k) { v[k] = HS[t2 * 257 + 64 * k + lane]; ss += v[k] * v[k]; }
            const float rstd = 1.f / sqrtf(wave_sum(ss) * (1.f / 256.f) + EPS); const size_t row = row0 + t2;
#pragma unroll
            for (int k = 0; k < 4; ++k) YB[row * 1024 + h * 256 + 64 * k + lane] = (bf16)f2bf(bf2f(og[rr][k]) * v[k] * rstd * gn[k]); }
    }
    __syncthreads();
}
__device__ __forceinline__ void gmlp_unit_mfma(const bf16* Z, const float* gng, const bf16* wsb  , const float* bs  , bf16* YA, int j, LAS unsigned char* lds, int tid) {
    asm volatile("" : "+v"(tid));
    const int wave = tid >> 6, lane = tid & 63, g = wave;
    LAS float* ST = (LAS float*)(lds + SM_OFF);
    LAS float* BSL = ST + 256;
    BSL[tid] = bs[tid]; BSL[tid + NTHR] = bs[tid + NTHR];
    LAS unsigned char* VN = lds + wave * 16384;
    const size_t row0 = (size_t)j * 128;
#pragma unroll 1
    for (int rb = 0; rb < 16; rb += 4) { v4u wq[4][2];
#pragma unroll
        for (int r4 = 0; r4 < 4; ++r4) { const v4u* zp = (const v4u*)(Z + (row0 + wave * 16 + rb + r4) * 2048 + 1024 + lane * 16); wq[r4][0] = zp[0]; wq[r4][1] = zp[1]; }
        asm volatile("" ::: "memory");
#pragma unroll
        for (int r4 = 0; r4 < 4; ++r4) { const int q = wave * 16 + rb + r4; const v4u w0 = wq[r4][0], w1 = wq[r4][1];
            float x[16]; const unsigned ww[8] = {w0.x, w0.y, w0.z, w0.w, w1.x, w1.y, w1.z, w1.w};
            float s = 0.f;
#pragma unroll
            for (int k = 0; k < 8; ++k) { x[2 * k] = bflo(ww[k]); x[2 * k + 1] = bfhi(ww[k]); s += x[2 * k] + x[2 * k + 1]; }
            const float mean = wave_sum(s) * (1.f / 1024.f); float s2 = 0.f;
#pragma unroll
            for (int k = 0; k < 16; ++k) { const float d = x[k] - mean; s2 += d * d; }
            const float rstd = 1.f / sqrtf(wave_sum(s2) * (1.f / 1024.f) + EPS);
            if (lane == 0) { ST[2 * q] = mean; ST[2 * q + 1] = rstd; } } }
    __syncthreads();
#pragma unroll 1
    for (int h = 0; h < 2; ++h) {
        const int ln = mk_lane_id(), hh = ln >> 5, l31 = ln & 31;
        const int cbase = g * 128 + 64 * h, c8 = (ln & 7) * 8;
        { const f32x4 g0 = *(const f32x4*)(gng + cbase + c8), g1 = *(const f32x4*)(gng + cbase + c8 + 4);
#pragma unroll 1
          for (int ib = 0; ib < 16; ib += 4) { v4u wv[4];
#pragma unroll
            for (int i4 = 0; i4 < 4; ++i4) wv[i4] = *(const v4u*)(Z + (row0 + (ib + i4) * 8 + (ln >> 3)) * 2048 + 1024 + cbase + c8);
            asm volatile("" ::: "memory");
#pragma unroll
            for (int i4 = 0; i4 < 4; ++i4) { const int q = (ib + i4) * 8 + (ln >> 3); const float mean = ST[2 * q], rstd = ST[2 * q + 1]; const v4u w = wv[i4]; v4u o;
              o.x = pk2((bflo(w.x) - mean) * rstd * g0.x, (bfhi(w.x) - mean) * rstd * g0.y); o.y = pk2((bflo(w.y) - mean) * rstd * g0.z, (bfhi(w.y) - mean) * rstd * g0.w);
              o.z = pk2((bflo(w.z) - mean) * rstd * g1.x, (bfhi(w.z) - mean) * rstd * g1.y); o.w = pk2((bflo(w.w) - mean) * rstd * g1.z, (bfhi(w.w) - mean) * rstd * g1.w);
              *(LAS v4u*)(VN + q * 128 + (ln & 7) * 16) = o; } } }
        LDS_WAIT(); asm volatile("" ::: "memory");
        bf16x8 bfr[8][2];
#pragma unroll
        for (int ks = 0; ks < 8; ++ks)
#pragma unroll
            for (int cb = 0; cb < 2; ++cb) bfr[ks][cb] = trfrag(VN, 128, 16 * ks + 8 * hh, 16 * ks + 8 * hh + 4, 32 * cb, ln);
        f32x16 acc[4][2];
#pragma unroll
        for (int pb = 0; pb < 4; ++pb)
#pragma unroll
            for (int cb = 0; cb < 2; ++cb)
#pragma unroll
                for (int r = 0; r < 16; ++r) acc[pb][cb][r] = 0.f;
#pragma unroll
        for (int pb = 0; pb < 4; ++pb) {
            bf16x8 af[8];
#pragma unroll
            for (int ks = 0; ks < 8; ++ks) af[ks] = *(const bf16x8*)(wsb + (size_t)(g * 128 + 32 * pb + l31) * 128 + 16 * ks + 8 * hh);
            asm volatile("" ::: "memory");
#pragma unroll
            for (int ks = 0; ks < 8; ++ks) { acc[pb][0] = __builtin_amdgcn_mfma_f32_32x32x16_bf16(af[ks], bfr[ks][0], acc[pb][0], 0, 0, 0); acc[pb][1] = __builtin_amdgcn_mfma_f32_32x32x16_bf16(af[ks], bfr[ks][1], acc[pb][1], 0, 0, 0); }
            asm volatile("" ::: "memory");
        }
        LDS_WAIT(); asm volatile("" ::: "memory");
#pragma unroll
        for (int pb = 0; pb < 4; ++pb)
#pragma unroll
            for (int q4 = 0; q4 < 4; ++q4) { const f32x4 b4 = *(const LAS f32x4*)(BSL + g * 128 + 32 * pb + 8 * q4 + 4 * hh);
#pragma unroll
                for (int i = 0; i < 4; ++i) { const int r = 4 * q4 + i, p = 32 * pb + 8 * q4 + 4 * hh + i;
#pragma unroll
                    for (int cb = 0; cb < 2; ++cb) *(LAS unsigned short*)(VN + p * 128 + (32 * cb + l31) * 2) = (unsigned short)f2bf(acc[pb][cb][r] + b4[i]); } }
        LDS_WAIT(); asm volatile("" ::: "memory");
#pragma unroll 1
        for (int ib = 0; ib < 16; ib += 4) { v4u uq[4];
#pragma unroll
            for (int i4 = 0; i4 < 4; ++i4) uq[i4] = *(const v4u*)(Z + (row0 + (ib + i4) * 8 + (ln >> 3)) * 2048 + cbase + c8);
            asm volatile("" ::: "memory");
#pragma unroll
            for (int i4 = 0; i4 < 4; ++i4) { const int p = (ib + i4) * 8 + (ln >> 3); const v4u m = *(const LAS v4u*)(VN + p * 128 + (ln & 7) * 16); const v4u u = uq[i4]; v4u o;
                o.x = pk2(bflo(u.x) * bflo(m.x), bfhi(u.x) * bfhi(m.x)); o.y = pk2(bflo(u.y) * bflo(m.y), bfhi(u.y) * bfhi(m.y));
                o.z = pk2(bflo(u.z) * bflo(m.z), bfhi(u.z) * bfhi(m.z)); o.w = pk2(bflo(u.w) * bflo(m.w), bfhi(u.w) * bfhi(m.w));
                *(v4u*)(YA + (row0 + p) * 1024 + cbase + c8) = o; } }
        LDS_WAIT(); asm volatile("" ::: "memory");
    }
    __syncthreads();
}

__device__ __forceinline__ void phase_post(const float* ATTO, const float* MLH, const bf16* Z, const float* dng, const float* mng, float lam, float linit, bf16* YB, bf16* YC, int bid, int G, int tid) {
    asm volatile("" : "+v"(tid));
    const int wave = tid >> 6, lane = tid & 63, head = lane >> 4, e0 = (lane & 15) * 16;
    for (int row = bid * NWAVES + wave; row < MT; row += G * NWAVES) {
        const size_t off = (size_t)row * 1024 + head * 256 + e0;
        {
            const f32x4* a0 = (const f32x4*)(ATTO + off); const f32x4* a1 = (const f32x4*)(ATTO + (size_t)MT * 1024 + off);
            float o[16]; float ss = 0.f;
#pragma unroll
            for (int k = 0; k < 4; ++k) { const f32x4 p = a0[k], q = a1[k];
                o[4 * k + 0] = p.x - lam * q.x; o[4 * k + 1] = p.y - lam * q.y; o[4 * k + 2] = p.z - lam * q.z; o[4 * k + 3] = p.w - lam * q.w; }
#pragma unroll
            for (int k = 0; k < 16; ++k) ss += o[k] * o[k];
            ss += shfl_xor_f(ss, 1); ss += shfl_xor_f(ss, 2); ss += shfl_xor_f(ss, 4); ss += shfl_xor_f(ss, 8);
            const float rstd = 1.f / sqrtf(ss * (1.f / 256.f) + EPS) * (1.f - linit);
            v4u w0, w1;
            w0.x = pk2(o[0] * rstd * dng[e0 + 0], o[1] * rstd * dng[e0 + 1]); w0.y = pk2(o[2] * rstd * dng[e0 + 2], o[3] * rstd * dng[e0 + 3]);
            w0.z = pk2(o[4] * rstd * dng[e0 + 4], o[5] * rstd * dng[e0 + 5]); w0.w = pk2(o[6] * rstd * dng[e0 + 6], o[7] * rstd * dng[e0 + 7]);
            w1.x = pk2(o[8] * rstd * dng[e0 + 8], o[9] * rstd * dng[e0 + 9]); w1.y = pk2(o[10] * rstd * dng[e0 + 10], o[11] * rstd * dng[e0 + 11]);
            w1.z = pk2(o[12] * rstd * dng[e0 + 12], o[13] * rstd * dng[e0 + 13]); w1.w = pk2(o[14] * rstd * dng[e0 + 14], o[15] * rstd * dng[e0 + 15]);
            v4u* yp = (v4u*)(YC + off); yp[0] = w0; yp[1] = w1;
        }
    }
}

struct Args { const float* in[21]; float* out; unsigned char* ws; int ph_lo, ph_hi; };
static_assert(sizeof(Args) == 21 * 8 + 8 + 8 + 8, "Args has no padding");

constexpr int T_ALL = -1, T_PRO0 = 0, T_PRO1 = 1, T_NORM = 2, T_W13 = 3, T_W2 = 4, T_N2 = 5, T_WIN = 6, T_ROPE = 7, T_MLSTM = 8, T_POST = 9, T_MERGE0 = 10, T_WOUT = 11, T_FINAL = 12, T_ATTN = 13, T_GMLP = 14, T_MERGE1 = 15, T_MERGE2 = 16, T_M3 = 17, NTYPES = 18;
#define SELD(t) (SEL == T_ALL || SEL == (t))
template <int SEL> __global__ void __launch_bounds__(NTHR, 2) mk_fwd(Args args) {
    extern __shared__ __attribute__((aligned(16))) unsigned char lds_raw[];
    LAS unsigned char* lds = (LAS unsigned char*)lds_raw;
    volatile LAS unsigned* MISC = (volatile LAS unsigned*)(lds + MISC_OFF);
    const int wave_s = __builtin_amdgcn_readfirstlane((int)threadIdx.x >> 6), bid_k = blockIdx.x, G = gridDim.x;
#define tid MK_TID(wave_s)
#define KARGS ((const __attribute__((address_space(4))) Args*)ka_)
#define PHASE_BEGIN const __attribute__((address_space(4))) void* ka_ = (const __attribute__((address_space(4))) void*)__builtin_amdgcn_kernarg_segment_ptr(); asm volatile("" : "+s"(ka_)); unsigned char* const ws = KARGS->ws; (void)ws; int bid = bid_k; asm volatile("" : "+s"(bid))
#define PIN(i) (KARGS->in[i])
#define XR ((float*)(ws + WS_XR))
#define H ((bf16*)(ws + WS_H))
#define GB ((bf16*)(ws + WS_GB))
#define Z ((bf16*)(ws + WS_Z))
#define ATTO ((float*)(ws + WS_ATTO))
#define MLH ((float*)(ws + WS_MLH))
#define DCT ((float*)(ws + WS_MLH))
#define YA ((bf16*)(ws + WS_YA))
#define YB ((bf16*)(ws + WS_YB))
#define YC ((bf16*)(ws + WS_YC))
#define SLAB ((float*)(ws + WS_SLAB))
#define YACC ((float*)(ws + WS_YACC))
#define Y ((bf16*)(ws + WS_Y))
#define G16 ((float*)(ws + WS_G16))
#define MOD ((const float*)(ws + WS_MOD))
#define CTS ((bf16*)(ws + WS_CT))
#define DNS ((float*)(ws + WS_MSM))
#define NSS (DNS + 8 * 66 * 128)
#define CHS (NSS + 8 * 66 * 128)
#define MSS (CHS + 8 * 66 * 2)
#define modl (MOD + (size_t)(l * 2 + 0) * NMOD)
#define modc (MOD + (size_t)(l * 2 + 1) * NMOD)
#define W13T0 ((const bf16*)(ws + WS_W13T) + (size_t)(l * 2 + 0) * 8192 * 4096)
#define W13T1 (W13T0 + (size_t)8192 * 4096)
#define W2T0 ((const bf16*)(ws + WS_W2T) + (size_t)(l * 2 + 0) * 4096 * 4096)
#define W2T1 (W2T0 + (size_t)4096 * 4096)
#define WINT ((const bf16*)(ws + WS_WINT) + (size_t)l * NZ * 4096)
#define WBT ((const bf16*)(ws + WS_WBT) + (size_t)(l * 3) * 4096 * 1024)
#define WOT ((const bf16*)(ws + WS_WOT) + (size_t)l * 4096 * 4096)
#define MKP() Ptrs P; P.x = PIN(0); P.c = PIN(1); P.ctx = PIN(2); P.c_ctx = PIN(3); P.ada_down = PIN(4); P.ada_up = PIN(5); P.ada_bias = PIN(6); P.norm_g = PIN(7); \
    P.w13 = PIN(8); P.w2 = PIN(9); P.w_in = PIN(10); P.gmlp_norm_g = PIN(11); P.gmlp_ws = PIN(12); P.gmlp_bs = PIN(13); P.gate_b = PIN(14); \
    P.mlstm_norm_g = PIN(15); P.diff_lambda = PIN(16); P.diff_norm_g = PIN(17); P.w_branch = PIN(18); P.w_out = PIN(19); P.final_g = PIN(20); P.out = KARGS->out; P.ws = KARGS->ws
    for (int u = tid; u < (LDS_BYTES - LDSCTL_OFF) / 4; u += NTHR) ((LAS unsigned*)(lds + LDSCTL_OFF))[u] = 0u;
    __syncthreads();
#if MK_ONE_LAUNCH
    XcdBarrier bar = xcd_barrier_post((unsigned*)((gu32*)(args.ws + WS_CTL) + CW_BAR), MISC + 8, tid);
#define GRID_BAR() do { XcdBarrier b2_ = bar; asm volatile("" : "+s"(b2_.bar)); xcd_barrier(b2_, tid); } while (0)
#else
#define GRID_BAR() do {} while (0)
#endif
    const int lo = args.ph_lo, hi = args.ph_hi;
#define IN(k) (lo <= (k) && (k) < hi)
#define SEAM(k) do { if (IN(k) && IN((k) + 1)) GRID_BAR(); } while (0)

    if (IN(P_PRO0)) { PHASE_BEGIN; MKP(); for (int rep_ = 0; rep_ < DBL_PRO; ++rep_) pro0(P, lds, bid, G, tid); SEAM(P_PRO0); }
    if (IN(P_PRO1)) { PHASE_BEGIN; MKP(); pro1(P, lds, bid, G, tid); SEAM(P_PRO1); }

    for (int l = 0; l < DEPTH; ++l) {
        const int pb = P_LAYER0 + l * NPL;
        if (hi <= pb || lo >= pb + NPL) continue;
#define GEMM_RESID_SPLIT2(Aptr, Bptr, gate_l, fac, ms3, yc, nctx_) do { \
            { pg8::Gemm g{(Aptr) + (size_t)CTXL * DM, (Bptr), SEQ, DM, DM, DM}; pg8::StaticOrder S; S.init(SEQ, DM, G, bid); pg8::EpiResid E{XR + (size_t)CTXL * DM, (gate_l), (gate_l), (fac)}; \
              pg8::gemm_phase<pg8::EpiResid, pg8::StaticOrder, true, true>(lds + RING_OFF, g, S, E, wave_s); } \
            { pg8::Gemm g{(Aptr), (Bptr), CTXL, DM, 256, DM}; pg8::CtxSplitOrder S{bid, G, (nctx_), (ms3), (yc), wave_s}; pg8::EpiSlab E{SLAB}; \
              pg8::gemm_phase<pg8::EpiSlab, pg8::CtxSplitOrder, true, true>(lds + RING_OFF, g, S, E, wave_s); } } while (0)
#define GEMM_RESID_SPLIT(Aptr, Bptr, gate_l, fac, ms3, yc, nctx_) do { \
            pg8::Gemm g{(Aptr), (Bptr), MT, DM, DM, DM}; pg8::ResidOrder S; S.lat.init(SEQ, DM, G, bid); S.c = bid; S.G = G; S.n = (nctx_); \
            pg8::EpiResidSlab E{XR, (gate_l), (fac), SLAB}; \
            pg8::gemm_phase<pg8::EpiResidSlab, pg8::ResidOrder, true, true>(lds + RING_OFF, g, S, E, wave_s); } while (0)
#define GEMM_LAT(EPI, Aptr, Bptr, Ncols, Kdim, ...) do { pg8::Gemm g{(Aptr), (Bptr), MT, (Ncols), (Kdim), (Kdim)}; pg8::StaticOrder S; S.init(MT, (Ncols), G, bid); EPI E{__VA_ARGS__}; \
            pg8::gemm_phase<EPI, pg8::StaticOrder, true, true>(lds + RING_OFF, g, S, E, wave_s); } while (0)

        if (IN(pb + L_N1)) { PHASE_BEGIN; MKP(); phase_norm(XR, P.norm_g + (size_t)(l * 3 + 0) * DM, modl + 0 * 3 * DM, modc + 0 * 3 * DM, H, l > 0 ? SLAB : nullptr, modc - (size_t)2 * NMOD + 2 * 3 * DM + 2 * DM, 0.5f, lds, bid, G, tid); SEAM(pb + L_N1); }
        if (IN(pb + L_W13A)) { PHASE_BEGIN; MKP();
            GEMM_LAT(pg8::EpiSwiglu, H, W13T0, 8192, DM, GB, FFND);
            convert_idle(P, l + 1, 0, CV_A, 32, lds, bid, G, tid);
            SEAM(pb + L_W13A); }
        if (IN(pb + L_W2A)) { PHASE_BEGIN; MKP();
            GEMM_RESID_SPLIT(GB, W2T0, modl + 0 * 3 * DM + 2 * DM, 0.5f, (const float*)nullptr, (bf16*)nullptr, 256);
            SEAM(pb + L_W2A); }
        if (IN(pb + L_N2)) { PHASE_BEGIN; MKP(); phase_norm(XR, P.norm_g + (size_t)(l * 3 + 1) * DM, modl + 1 * 3 * DM, modc + 1 * 3 * DM, H, SLAB, modc + 0 * 3 * DM + 2 * DM, 0.5f, lds, bid, G, tid); SEAM(pb + L_N2); }
        if (IN(pb + L_WIN)) { PHASE_BEGIN; MKP();
            GEMM_LAT(pg8::EpiWin, H, WINT, NZ, DM, Z, (const float*)(ws + WS_ROPE), (const float*)(ws + WS_ROPE) + SEQ * 64);
            convert_idle(P, l + 1, CV_A, CV_A + CV_W, 146, lds, bid, G, tid);
            for (int u = ((bid - 80) % G + G) % G; u < 66; u += G) gates_unit(H, (const bf16*)(ws + WS_WG16) + (size_t)l * 16 * DM, G16, u, tid);
            SEAM(pb + L_WIN); }
        if (IN(pb + L_MIX1)) { PHASE_BEGIN; MKP();
            for (int rep_ = 0; rep_ < DBL_M1; ++rep_) for (int u = (bid + G - (100 % G)) % G; u < 264; u += G) mlstm_m1_unit(Z, G16, P.gate_b + (size_t)l * 16, DCT, DNS, CHS, u >> 2, u & 3, lds, tid);
            for (int rep_ = 0; rep_ < DBL_ATTN; ++rep_) for (int u = bid; u < (l < DEPTH - 1 ? 264 : 256); u += G) {
                int hm, qb, seq; if (u < 256) { hm = u & 7; qb = 1 + (u >> 3); seq = MT; } else { hm = u - 256; qb = 0; seq = CTXL; }
                const int h = hm >> 1, mm = hm & 1;
                const attn128::bf16* Zb = (const attn128::bf16*)Z;
                attn256::attn_o256_body(Zb + (size_t)MT * ZC_AQ + (size_t)(qb * 256) * 1024 + h * 256 + mm * 128, Zb + (size_t)MT * ZC_AK + h * 256 + mm * 128, Zb + (size_t)MT * ZC_AV + h * 256,
                                        ATTO + (size_t)mm * MT * 1024 + (size_t)(qb * 256) * 1024 + h * 256, seq, (char*)lds_raw, wave_s);
                __syncthreads();
            }
            SEAM(pb + L_MIX1);
        }
        if (IN(pb + L_POST)) { PHASE_BEGIN; MKP();
            for (int rep_ = 0; rep_ < DBL_POST; ++rep_) { mlstm_m2(DCT, DNS, CHS, CTS, NSS, MSS, lds, bid, G, tid); } SEAM(pb + L_POST); }
        if (IN(pb + L_M3)) { PHASE_BEGIN; MKP();
            { const int u0 = (l < DEPTH - 1) ? 0 : 8, nsec = (l < DEPTH - 1) ? (264 - G > 0 ? 264 - G : 0) : 0;
              for (int rep_ = 0; rep_ < DBL_M3; ++rep_) for (int u = u0 + bid; u < 264; u += G) mlstm_m3_unit(Z, G16, P.gate_b + (size_t)l * 16, CTS, NSS, MSS, P.mlstm_norm_g + (size_t)l * 1024, YB, u >> 2, u & 3, lds, tid);
              const int ngm = (G >= 66 + nsec + 8) ? 66 : 0;
              for (int rep_ = 0; rep_ < DBL_GMLP; ++rep_) for (int u = G - 1 - bid; u < 66; u += G) gmlp_unit_mfma(Z, P.gmlp_norm_g + (size_t)l * 1024, (const bf16*)(ws + WS_GWSB) + (size_t)l * 8 * 128 * 128, P.gmlp_bs + (size_t)l * 8 * 128, YA, u, lds, tid);
              if (bid >= nsec && bid < G - ngm) phase_post(ATTO, MLH, Z, P.diff_norm_g + (size_t)l * 256, P.mlstm_norm_g + (size_t)l * 1024, ((const float*)(ws + WS_LAM))[l], lambda_init_f(l), YB, YC, bid - nsec, G - ngm - nsec, tid); }
            SEAM(pb + L_M3); }
        if (IN(pb + L_MERGE)) { PHASE_BEGIN; MKP();
            { pg8::Gemm g{YA, WBT, MT, DM, 1024, 1024}; pg8::MergeOrder S; S.lat.init(SEQ, DM, G, bid); S.c = bid; S.G = G; S.nctx = (l < DEPTH - 1) ? 48 : 0; pg8::EpiMergeSeg E{Z, Y, (float*)(ws + WS_MS3)};
              pg8::gemm_phase<pg8::EpiMergeSeg, pg8::MergeOrder, true, true>(lds + RING_OFF, g, S, E, wave_s); }
            SEAM(pb + L_MERGE); }
        if (IN(pb + L_WOUT)) { PHASE_BEGIN; MKP();
            GEMM_RESID_SPLIT2(Y, WOT, modl + 1 * 3 * DM + 2 * DM, 1.f, (const float*)(ws + WS_MS3), Y, (l < DEPTH - 1) ? 256 : 0);
            SEAM(pb + L_WOUT); }
        if (IN(pb + L_N3)) { PHASE_BEGIN; MKP(); phase_norm(XR, P.norm_g + (size_t)(l * 3 + 2) * DM, modl + 2 * 3 * DM, modc + 2 * 3 * DM, H, SLAB, modc + 1 * 3 * DM + 2 * DM, 1.f, lds, bid, G, tid); SEAM(pb + L_N3); }
        if (IN(pb + L_W13B)) { PHASE_BEGIN; MKP();
            { const int skip = (l < DEPTH - 1) ? 0 : CTXL;
              pg8::Gemm g{H + (size_t)skip * DM, W13T1, MT - skip, 8192, DM, DM}; pg8::StaticOrder S; S.init(MT - skip, 8192, G, bid); pg8::EpiSwiglu E{GB + (size_t)skip * FFND, FFND};
              pg8::gemm_phase<pg8::EpiSwiglu, pg8::StaticOrder, true, true>(lds + RING_OFF, g, S, E, wave_s); }
            convert_idle(P, l + 1, CV_A + CV_W, CV_TOT, 32, lds, bid, G, tid);
            SEAM(pb + L_W13B); }
        if (IN(pb + L_W2B)) { PHASE_BEGIN; MKP();
            GEMM_RESID_SPLIT(GB, W2T1, modl + 2 * 3 * DM + 2 * DM, 0.5f, (const float*)nullptr, (bf16*)nullptr, (l < DEPTH - 1) ? 256 : 0);
            SEAM(pb + L_W2B); }
#undef GEMM_LAT
#undef GEMM_RESID_SPLIT
#undef GEMM_RESID_SPLIT2
    }
    if (IN(P_FINAL)) { PHASE_BEGIN; MKP(); phase_final(XR, P.final_g, P.out, bid, G, tid); }
#undef IN
#undef SEAM
#undef tid
#undef XR
#undef H
#undef GB
#undef Z
#undef ATTO
#undef MLH
#undef DCT
#undef YA
#undef YB
#undef YC
#undef SLAB
#undef YACC
#undef Y
#undef G16
#undef MOD
#undef CTS
#undef DNS
#undef NSS
#undef CHS
#undef MSS
#undef modl
#undef modc
#undef W13T0
#undef W13T1
#undef W2T0
#undef W2T1
#undef WINT
#undef WBT
#undef WOT
}

extern "C" void kernel_launch(void* const* d_in, const int* in_sizes, int n_in, void* d_out, int out_size, void* d_ws, size_t ws_size, hipStream_t stream) {
    static int grid = 0;
    if (grid == 0) {
        if (n_in != 21 || in_sizes[0] != SEQ * DM || out_size != SEQ * DM || ws_size < WS_END) {
            fprintf(stderr, "kernel_launch: unexpected shapes: n_in %d in0 %d out %d ws %zu (need %zu)\n", n_in, n_in > 0 ? in_sizes[0] : -1, out_size, ws_size, (size_t)WS_END); grid = -1; return; }
        int dev = 0, cus = 0;
        if (hipGetDevice(&dev) != hipSuccess || hipDeviceGetAttribute(&cus, hipDeviceAttributeMultiprocessorCount, dev) != hipSuccess) { grid = -1; return; }
        if (hipFuncSetAttribute((const void*)mk_fwd<T_ALL>, hipFuncAttributeMaxDynamicSharedMemorySize, LDS_BYTES) != hipSuccess) { fprintf(stderr, "kernel_launch: hipFuncSetAttribute failed\n"); grid = -1; return; }
        (void)hipGetLastError();
        grid = cus;
    }
    if (grid < 0) return;
    (void)hipMemsetAsync((char*)d_ws + WS_CTL, 0, CTL_ZERO_BYTES, stream);
    Args a{};
    for (int i = 0; i < 21; ++i) a.in[i] = (const float*)d_in[i];
    a.out = (float*)d_out; a.ws = (unsigned char*)d_ws;
#if MK_ONE_LAUNCH
    a.ph_lo = 0; a.ph_hi = NPH;
    hipLaunchKernelGGL(mk_fwd<T_ALL>, dim3(grid), dim3(NTHR), LDS_BYTES, stream, a);
#else
    for (int p = 0; p < NPH; ++p) { a.ph_lo = p; a.ph_hi = p + 1; hipLaunchKernelGGL(mk_fwd<T_ALL>, dim3(grid), dim3(NTHR), LDS_BYTES, stream, a); }
#endif
    const hipError_t le = hipPeekAtLastError();
    if (le != hipSuccess) fprintf(stderr, "kernel_launch: launch failed: %s\n", hipGetErrorName(le));
}
```

```cpp
#include <hip/hip_runtime.h>
#include <hip/hip_bf16.h>
#include <cstdio>
#include <cstdint>
#include <cmath>
#ifndef MLSTM_CHUNKWISE
#define MLSTM_CHUNKWISE 1
#endif
#ifndef MK_ONE_LAUNCH
#define MK_ONE_LAUNCH 1
#endif
#ifndef DBL_ATTN
#define DBL_ATTN 1
#endif
#ifndef DBL_PRO
#define DBL_PRO 1
#endif
#ifndef DBL_M1
#define DBL_M1 1
#endif
#ifndef DBL_GMLP
#define DBL_GMLP 1
#endif
#ifndef DBL_POST
#define DBL_POST 1
#endif
#ifndef DBL_M3
#define DBL_M3 1
#endif
#ifndef DBL_NORM
#define DBL_NORM 1
#endif
__device__ __forceinline__ int mk_lane_id() { int l_; asm volatile("v_mbcnt_lo_u32_b32 %0, -1, 0\n\tv_mbcnt_hi_u32_b32 %0, -1, %0" : "=v"(l_)); return l_; }
#define MK_TID(wave_s_) (((wave_s_) << 6) | mk_lane_id())
namespace pg8 {
#define PG8_LAS __attribute__((address_space(3)))
typedef unsigned short bf16_t;
typedef short bf16x8 __attribute__((ext_vector_type(8)));
typedef float f32x4 __attribute__((ext_vector_type(4)));
typedef unsigned u32x4 __attribute__((ext_vector_type(4)));
constexpr int BM = 256, BK = 64, HALF = 128, HTB = HALF * BK * 2  , STAGE_BYTES = 8 * HTB, NXCD = 8, WGM = 8;

__host__ __device__ __forceinline__ int lds_byte(int r, int c) { const int st = (r >> 4) * 2 + (c >> 5), rr = r & 15, cc = c & 31, ob = rr * 64 + cc * 2; return st * 1024 + (ob ^ (((ob >> 9) & 1) << 5)); }
__host__ __device__ __forceinline__ void stage_rc(int b, int& R, int& C) { const int st = b / 1024, sb = b % 1024, swz = sb ^ (((sb >> 9) & 1) << 5); R = (st >> 1) * 16 + swz / 64; C = (st & 1) * 32 + (swz % 64) / 2; }
__host__ __device__ __forceinline__ int perm32(int rho) { const int n = rho >> 4, i = rho & 15; return 8 * (i >> 2) + 4 * n + (i & 3); }

struct Unit { int pm, pn, koff, boff, fl;
    __device__ __forceinline__ int seg() const { return fl & 3; } __device__ __forceinline__ bool carry() const { return (fl & 4) != 0; } __device__ __forceinline__ int ntile() const { return fl >> 8; } };
struct Gemm { const bf16_t* A; const bf16_t* Bt; int M, N, K, ld; };

struct StaticOrder {
    int nM, nN, nwg, G, c;
    __host__ __device__ void init(int M, int N, int G_, int c_) { nM = M / BM; nN = N / BM; nwg = nM * nN; G = G_; c = c_; }
    __host__ __device__ bool next(int i, Unit& u) const {
        const long L = (long)i * G + c; if (L >= nwg) return false;
        int wgid = (int)L; { const int q = nwg / NXCD, r = nwg % NXCD, xcd = wgid % NXCD, off = wgid / NXCD; wgid = (xcd < r ? xcd * (q + 1) : r * (q + 1) + (xcd - r) * q) + off; }
        const int nig = WGM * nN, gid = wgid / nig, fm = gid * WGM, gsz = (nM - fm) < WGM ? (nM - fm) : WGM;
        u.pm = fm + ((wgid % nig) % gsz); u.pn = (wgid % nig) / gsz; u.koff = 0; u.boff = 0; u.fl = 0; return true;
    }
    __device__ __forceinline__ void a_ready(const Unit&) const {}
    __device__ __forceinline__ void done(const Unit&) const {}
};

__device__ __forceinline__ unsigned cvt_pk_bf16(float lo, float hi) { unsigned r; asm volatile("v_cvt_pk_bf16_f32 %0, %1, %2" : "=v"(r) : "v"(lo), "v"(hi)); return r; }
typedef float f32x2 __attribute__((ext_vector_type(2)));
__device__ __forceinline__ f32x2 gelu_pk(f32x2 v) {
    const f32x2 av = __builtin_elementwise_abs(v), d = av * 0.2316418882f + 1.0f;
    f32x2 t; t.x = __builtin_amdgcn_rcpf(d.x); t.y = __builtin_amdgcn_rcpf(d.y);
    f32x2 q = t * 0.5307027145f + (-0.7265760135f); q = q * t + 0.7107068705f; q = q * t + (-0.142248368f); q = q * t + 0.127414796f; q = q * t;
    const f32x2 s = (v * v) * (-0.72134752044f);
    f32x2 e; e.x = __builtin_amdgcn_exp2f(s.x); e.y = __builtin_amdgcn_exp2f(s.y);
    const f32x2 m = v * (q * e), r = v - m;
    f32x2 o; o.x = v.x < 0.f ? m.x : r.x; o.y = v.y < 0.f ? m.y : r.y; return o;
}

template <int ACT  > struct EpiBf16 {
    static constexpr bool PERM = true, AFTER_DRAIN = false; static_assert(ACT == 0 || ACT == 1, "EpiBf16: ACT is 0 (none) or 1 (gelu_pk)");
    bf16_t* O; int ldc; const float* bias; int split_cols; size_t split_stride; float scale0;
    __device__ __forceinline__ void operator()(const f32x4 (&acc)[2][2][4][2], const Unit& u, int wr, int wc, int fr, int fq) const {
        const int row0 = u.pm * BM + wr * 64 + fr; int colt = u.pn * BM; bf16_t* base = O;
        float sc = 1.f; if (split_cols) { const int t = colt / split_cols; base += (size_t)t * split_stride; colt -= t * split_cols; if (t == 0) sc = scale0; }
        const int col0 = colt + wc * 32 + 8 * fq, bcol0 = u.pn * BM + wc * 32 + 8 * fq;
        f32x4 bv[2][2];
#pragma unroll
        for (int bj = 0; bj < 2; ++bj)
#pragma unroll
            for (int n = 0; n < 2; ++n) bv[bj][n] = bias ? *(const f32x4*)(bias + bcol0 + bj * HALF + 4 * n) : (f32x4){0.f, 0.f, 0.f, 0.f};
#pragma unroll
        for (int ai = 0; ai < 2; ++ai)
#pragma unroll
            for (int m = 0; m < 4; ++m) { bf16_t* rowp = base + (size_t)(row0 + ai * HALF + m * 16) * ldc + col0;
#pragma unroll
                for (int bj = 0; bj < 2; ++bj) { f32x4 v0 = acc[ai][bj][m][0] + bv[bj][0], v1 = acc[ai][bj][m][1] + bv[bj][1];
                    if (ACT == 1) { f32x2 a = gelu_pk((f32x2){v0[0], v0[1]}), b = gelu_pk((f32x2){v0[2], v0[3]}), c = gelu_pk((f32x2){v1[0], v1[1]}), d = gelu_pk((f32x2){v1[2], v1[3]});
                        v0 = (f32x4){a.x, a.y, b.x, b.y}; v1 = (f32x4){c.x, c.y, d.x, d.y}; }
                    v0 = v0 * sc; v1 = v1 * sc; u32x4 w; w.x = cvt_pk_bf16(v0[0], v0[1]); w.y = cvt_pk_bf16(v0[2], v0[3]); w.z = cvt_pk_bf16(v1[0], v1[1]); w.w = cvt_pk_bf16(v1[2], v1[3]);
                    *(u32x4*)(rowp + bj * HALF) = w; } }
    }
};

struct PanelStats {
    unsigned* xbuf;
    unsigned* cnt;
    unsigned* tmo;
    int ntn; float eps;
    unsigned code;
    __device__ __forceinline__ bool run(const f32x4 (&v)[2][2][4][2], const Unit& u, int wr, int wc, int fr, int fq, PG8_LAS unsigned char* lds, int wid, int lane) const {
        typedef float f32x2v __attribute__((ext_vector_type(2)));
        PG8_LAS f32x2v* P = (PG8_LAS f32x2v*)lds;
        PG8_LAS f32x2v* S = (PG8_LAS f32x2v*)(lds + 8192);
        PG8_LAS unsigned* flag = (PG8_LAS unsigned*)(lds + 8192 + 2048);
#pragma unroll
        for (int ai = 0; ai < 2; ++ai)
#pragma unroll
            for (int m = 0; m < 4; ++m) {
                float s = 0.f;
#pragma unroll
                for (int bj = 0; bj < 2; ++bj)
#pragma unroll
                    for (int n = 0; n < 2; ++n) { const f32x4 x = v[ai][bj][m][n]; s += (x[0] + x[1]) + (x[2] + x[3]); }
                s += __shfl_xor(s, 16); s += __shfl_xor(s, 32);
                const float mw = s * (1.0f / 64.0f); float q = 0.f;
#pragma unroll
                for (int bj = 0; bj < 2; ++bj)
#pragma unroll
                    for (int n = 0; n < 2; ++n) { const f32x4 d = v[ai][bj][m][n] - mw; q += (d[0] * d[0] + d[1] * d[1]) + (d[2] * d[2] + d[3] * d[3]); }
                q += __shfl_xor(q, 16); q += __shfl_xor(q, 32);
                if (fq == 0) P[(ai * HALF + wr * 64 + m * 16 + fr) * 4 + wc] = (f32x2v){mw, q};
            }
        asm volatile("s_waitcnt lgkmcnt(0)" ::: "memory"); __builtin_amdgcn_s_barrier(); asm volatile("" ::: "memory");
#if defined(BROKEN_EXCHANGE_NO_WAIT)
#warning BROKEN CONTROL BUILD: the row-statistics exchange does not wait; results are wrong by design
        if (blockIdx.x >= 64) { const long long t0_ = clock64(); while (clock64() - t0_ < 60000) __builtin_amdgcn_s_sleep(8); }
#endif
        const int row = wid * 32 + (lane & 31);
        if (lane < 32) {
            const f32x2v a = P[row * 4 + 0], b = P[row * 4 + 1], c = P[row * 4 + 2], d = P[row * 4 + 3];
            const float mt = (a.x + b.x + c.x + d.x) * 0.25f;
            const float da = a.x - mt, db = b.x - mt, dc = c.x - mt, dd = d.x - mt;
            const float m2 = (a.y + b.y) + (c.y + d.y) + 64.0f * ((da * da + db * db) + (dc * dc + dd * dd));
            unsigned long long* slot = (unsigned long long*)xbuf + ((size_t)(u.pm * BM + row) * 4 + u.pn);
            __hip_atomic_store(slot, ((unsigned long long)__float_as_uint(m2) << 32) | __float_as_uint(mt), __ATOMIC_RELAXED, __HIP_MEMORY_SCOPE_AGENT);
        }
        asm volatile("s_waitcnt vmcnt(0)" ::: "memory");
        if (lane == 0) __hip_atomic_fetch_add(cnt + 64 * u.pm, 1u, __ATOMIC_RELAXED, __HIP_MEMORY_SCOPE_AGENT);
        if (wid == 0) {
            bool dead = false; const unsigned long long t0 = __builtin_amdgcn_s_memrealtime(); const unsigned want = 8u * (unsigned)ntn;
            for (;;) {
#if defined(BROKEN_EXCHANGE_NO_WAIT)
                break;
#endif
                if ((unsigned)__builtin_amdgcn_readfirstlane(__hip_atomic_load(cnt + 64 * u.pm, __ATOMIC_RELAXED, __HIP_MEMORY_SCOPE_AGENT)) >= want) break;
                if (__builtin_amdgcn_s_memrealtime() - t0 > 2000000ull) {
                    if (lane == 0) { unsigned expect = 0u; __hip_atomic_compare_exchange_strong(tmo + 1, &expect, code | (unsigned)(u.pm & 0xff), __ATOMIC_RELAXED, __ATOMIC_RELAXED, __HIP_MEMORY_SCOPE_AGENT);
                                     __hip_atomic_store(tmo, 1u, __ATOMIC_RELAXED, __HIP_MEMORY_SCOPE_AGENT); }
                    dead = true; break; }
                __builtin_amdgcn_s_sleep(2);
            }
            __builtin_amdgcn_fence(__ATOMIC_ACQUIRE, "agent");
            if (lane == 0) flag[0] = dead ? 1u : 0u;
        }
        asm volatile("s_waitcnt vmcnt(0) lgkmcnt(0)" ::: "memory"); __builtin_amdgcn_s_barrier(); asm volatile("" ::: "memory");
        const bool bad = flag[0] != 0u;
        if (lane < 32) {
            const unsigned long long* slot = (const unsigned long long*)xbuf + (size_t)(u.pm * BM + row) * 4; float mt[4], m2[4]; float ms = 0.f;
#pragma unroll
            for (int t = 0; t < 4; ++t) { if (t < ntn) { const unsigned long long w = __hip_atomic_load(slot + t, __ATOMIC_RELAXED, __HIP_MEMORY_SCOPE_AGENT); mt[t] = __uint_as_float((unsigned)w); m2[t] = __uint_as_float((unsigned)(w >> 32)); } else { mt[t] = 0.f; m2[t] = 0.f; } ms += mt[t]; }
            const float mean = ms / (float)ntn; float q = 0.f;
#pragma unroll
            for (int t = 0; t < 4; ++t) if (t < ntn) { const float dm = mt[t] - mean; q += m2[t] + 256.0f * dm * dm; }
            S[row] = (f32x2v){mean, 1.0f / sqrtf(q / (256.0f * (float)ntn) + eps)};
        }
        asm volatile("s_waitcnt lgkmcnt(0)" ::: "memory"); __builtin_amdgcn_s_barrier(); asm volatile("" ::: "memory");
        return bad;
    }
};
struct EpiLnRes {
    static constexpr bool PERM = false, AFTER_DRAIN = true;
    const float* base; float* out; int ldc; const float* bias; PanelStats st; unsigned poison;
    __device__ __forceinline__ void fused(f32x4 (&acc)[2][2][4][2], const Unit& u, int wr, int wc, int fr, int fq, PG8_LAS unsigned char* lds, int wid, int lane) const {
        typedef float f32x2v __attribute__((ext_vector_type(2)));
        const PG8_LAS f32x2v* S = (const PG8_LAS f32x2v*)(lds + 8192);
        const int col0 = u.pn * BM + wc * 32 + 4 * fq;
#pragma unroll
        for (int bj = 0; bj < 2; ++bj)
#pragma unroll
            for (int n = 0; n < 2; ++n) { const f32x4 bv = bias ? *(const f32x4*)(bias + col0 + bj * HALF + n * 16) : (f32x4){0.f, 0.f, 0.f, 0.f};
#pragma unroll
                for (int ai = 0; ai < 2; ++ai)
#pragma unroll
                    for (int m = 0; m < 4; ++m) acc[ai][bj][m][n] += bv; }
        f32x4 pre[4][2][2];
#pragma unroll
        for (int m = 0; m < 4; ++m) { const size_t off = (size_t)(u.pm * BM + wr * 64 + m * 16 + fr) * ldc + col0;
#pragma unroll
            for (int bj = 0; bj < 2; ++bj)
#pragma unroll
                for (int n = 0; n < 2; ++n) pre[m][bj][n] = *(const f32x4*)(base + off + bj * HALF + n * 16); }
        const bool bad = st.run(acc, u, wr, wc, fr, fq, lds, wid, lane) || poison != 0u;
        const float qnan = __builtin_nanf("");
#pragma unroll
        for (int ai = 0; ai < 2; ++ai)
#pragma unroll
            for (int m = 0; m < 4; ++m) { const int r = ai * HALF + wr * 64 + m * 16 + fr; const f32x2v sr = S[r]; const size_t off = (size_t)(u.pm * BM + r) * ldc + col0;
#pragma unroll
                for (int bj = 0; bj < 2; ++bj)
#pragma unroll
                    for (int n = 0; n < 2; ++n) { const f32x4 bs = ai == 0 ? pre[m][bj][n] : *(const f32x4*)(base + off + bj * HALF + n * 16); f32x4 o = bs + (acc[ai][bj][m][n] - sr.x) * sr.y;
                        if (bad) o = (f32x4){qnan, qnan, qnan, qnan}; *(f32x4*)(out + off + bj * HALF + n * 16) = o; }
                if (m & 1) asm volatile("" ::: "memory"); }
    }
};
struct EpiLnResLn {
    static constexpr bool PERM = false, AFTER_DRAIN = true;
    const float* base; float* out; bf16_t* xn; int ldc; const float* bias; PanelStats st1, st2; unsigned poison;
    __device__ __forceinline__ void fused(f32x4 (&acc)[2][2][4][2], const Unit& u, int wr, int wc, int fr, int fq, PG8_LAS unsigned char* lds, int wid, int lane) const {
        typedef float f32x2v __attribute__((ext_vector_type(2))); typedef unsigned u32x2v __attribute__((ext_vector_type(2)));
        const PG8_LAS f32x2v* S = (const PG8_LAS f32x2v*)(lds + 8192);
        const int col0 = u.pn * BM + wc * 32 + 4 * fq;
#pragma unroll
        for (int bj = 0; bj < 2; ++bj)
#pragma unroll
            for (int n = 0; n < 2; ++n) { const f32x4 bv = bias ? *(const f32x4*)(bias + col0 + bj * HALF + n * 16) : (f32x4){0.f, 0.f, 0.f, 0.f};
#pragma unroll
                for (int ai = 0; ai < 2; ++ai)
#pragma unroll
                    for (int m = 0; m < 4; ++m) acc[ai][bj][m][n] += bv; }
        bool bad = st1.run(acc, u, wr, wc, fr, fq, lds, wid, lane) || poison != 0u;
        const float qnan = __builtin_nanf("");
#pragma unroll
        for (int ai = 0; ai < 2; ++ai)
#pragma unroll
            for (int m = 0; m < 4; ++m) { const int r = ai * HALF + wr * 64 + m * 16 + fr; const f32x2v sr = S[r]; const size_t off = (size_t)(u.pm * BM + r) * ldc + col0;
#pragma unroll
                for (int bj = 0; bj < 2; ++bj)
#pragma unroll
                    for (int n = 0; n < 2; ++n) { const f32x4 bs = *(const f32x4*)(base + off + bj * HALF + n * 16); acc[ai][bj][m][n] = bs + (acc[ai][bj][m][n] - sr.x) * sr.y; }
                asm volatile("" : "+v"(acc[ai][0][m][0]), "+v"(acc[ai][0][m][1]), "+v"(acc[ai][1][m][0]), "+v"(acc[ai][1][m][1]));
                if (m & 1) asm volatile("" ::: "memory"); }
        const bool bad1 = bad;
        bad = st2.run(acc, u, wr, wc, fr, fq, lds, wid, lane) || bad;
#pragma unroll
        for (int ai = 0; ai < 2; ++ai)
#pragma unroll
            for (int m = 0; m < 4; ++m) { const int r = ai * HALF + wr * 64 + m * 16 + fr; const f32x2v sr = S[r]; const size_t off = (size_t)(u.pm * BM + r) * ldc + col0;
#pragma unroll
                for (int bj = 0; bj < 2; ++bj)
#pragma unroll
                    for (int n = 0; n < 2; ++n) { const f32x4 x1 = acc[ai][bj][m][n]; *(f32x4*)(out + off + bj * HALF + n * 16) = bad1 ? (f32x4){qnan, qnan, qnan, qnan} : x1;
                        const f32x4 o = (x1 - sr.x) * sr.y; u32x2v w; w.x = cvt_pk_bf16(o[0], o[1]); w.y = cvt_pk_bf16(o[2], o[3]);
                        if (bad) { w.x = 0x7fc07fc0u; w.y = 0x7fc07fc0u; } *(u32x2v*)(xn + off + bj * HALF + n * 16) = w; }
                asm volatile("" ::: "memory"); }
    }
};

template <class Epi, class Sched, bool ALIGN_EPI = false, bool SP2 = false>
__device__ __forceinline__ void gemm_phase(PG8_LAS unsigned char* lds, const Gemm g, const Sched& S, const Epi& E, int wave_s_) {
    int tid = MK_TID(wave_s_); asm volatile("" : "+v"(tid));
    const int wid = __builtin_amdgcn_readfirstlane(tid >> 6), lane = tid & 63, wr = wid >> 2, wc = wid & 3, fr = lane & 15, fq = lane >> 4;
    const int K = g.K, nt_def = K / BK;
    unsigned voffA[2], voffB[2];
#pragma unroll
    for (int i = 0; i < 2; ++i) { int R, C; stage_rc(tid * 16 + i * 8192, R, C); const int Rb = Epi::PERM ? ((R & ~31) + perm32(R & 31)) : R;
        voffA[i] = (unsigned)(R * g.ld + C) * 2u; voffB[i] = (unsigned)(Rb * g.ld + C) * 2u; }
    const size_t kstep = (size_t)(BK * 2);
    const size_t hstep = (size_t)HALF * g.ld * 2;
    const size_t tstep = 2 * hstep;
    const unsigned ldsw = (unsigned)wid * 1024u;
    const int aoff = lds_byte(wr * 64 + fr, fq * 8), boff = lds_byte(wc * 32 + fr, fq * 8);
#define PG8_SA(b, h) (((b) * 2 + (h)) * HTB)
#define PG8_SB(b, h) ((4 + (b) * 2 + (h)) * HTB)
#define PG8_STAGE(bufoff, gbase, voff) do { _Pragma("unroll") for (int _i = 0; _i < 2; ++_i) \
        __builtin_amdgcn_global_load_lds((const unsigned*)((const char*)(gbase) + (voff)[_i]), (PG8_LAS unsigned*)(lds + (bufoff) + ldsw + _i * 8192), 16, 0, 0); } while (0)
#define PG8_LDA(dst, b, h) do { _Pragma("unroll") for (int m = 0; m < 4; ++m) _Pragma("unroll") for (int k = 0; k < 2; ++k) dst[m][k] = *(const PG8_LAS bf16x8*)(lds + PG8_SA(b, h) + aoff + m * 2048 + k * 1024); } while (0)
#define PG8_LDB(dst, b, h) do { _Pragma("unroll") for (int n = 0; n < 2; ++n) _Pragma("unroll") for (int k = 0; k < 2; ++k) dst[n][k] = *(const PG8_LAS bf16x8*)(lds + PG8_SB(b, h) + boff + n * 2048 + k * 1024); } while (0)
#define PG8_MMA(ai, bj, At, Bt) do { __builtin_amdgcn_s_setprio(1); _Pragma("unroll") for (int m = 0; m < 4; ++m) _Pragma("unroll") for (int n = 0; n < 2; ++n) _Pragma("unroll") for (int k = 0; k < 2; ++k) \
        acc[ai][bj][m][n] = __builtin_amdgcn_mfma_f32_16x16x32_bf16(Bt[n][k], At[m][k], acc[ai][bj][m][n], 0, 0, 0); __builtin_amdgcn_s_setprio(0); } while (0)
#define PG8_WAIT_V(n) asm volatile("s_waitcnt vmcnt(" #n ")" ::: "memory")
#define PG8_WAIT_L(n) asm volatile("s_waitcnt lgkmcnt(" #n ")" ::: "memory")
#define PG8_BAR __builtin_amdgcn_s_barrier()
#define PG8_SCHED __builtin_amdgcn_sched_barrier(0)
    Unit cur, nxt; int ui = 0;
    if (!S.next(0, cur)) return;
    f32x4 acc[2][2][4][2];
#pragma unroll
    for (int a = 0; a < 2; ++a)
#pragma unroll
        for (int b = 0; b < 2; ++b)
#pragma unroll
            for (int m = 0; m < 4; ++m)
#pragma unroll
                for (int n = 0; n < 2; ++n) acc[a][b][m][n] = (f32x4){0.f, 0.f, 0.f, 0.f};
    bf16x8 At[4][2], B0[2][2], B1[2][2];
    const char* cA = (const char*)g.A + (size_t)cur.pm * tstep + (size_t)cur.koff * 2; const char* cB = (const char*)g.Bt + (size_t)cur.pn * tstep + (size_t)cur.boff * 2;
    S.a_ready(cur);
    if constexpr (SP2) {
        PG8_STAGE(PG8_SB(0, 0), cB, voffB); PG8_STAGE(PG8_SB(0, 1), cB + hstep, voffB); PG8_STAGE(PG8_SA(0, 0), cA, voffA); PG8_STAGE(PG8_SA(0, 1), cA + hstep, voffA);
        if (wr == 1) PG8_BAR;
        PG8_WAIT_V(2); PG8_BAR;
        PG8_STAGE(PG8_SB(1, 0), cB + kstep, voffB); PG8_STAGE(PG8_SA(1, 0), cA + kstep, voffA); PG8_STAGE(PG8_SB(1, 1), cB + hstep + kstep, voffB);
        PG8_WAIT_V(6); PG8_BAR;
    } else {
        PG8_STAGE(PG8_SB(0, 0), cB, voffB); PG8_STAGE(PG8_SA(0, 0), cA, voffA); PG8_STAGE(PG8_SB(0, 1), cB + hstep, voffB); PG8_STAGE(PG8_SA(0, 1), cA + hstep, voffA);
        if (wr == 1) PG8_BAR;
        PG8_WAIT_V(4); PG8_BAR;
        PG8_STAGE(PG8_SB(1, 0), cB + kstep, voffB); PG8_STAGE(PG8_SA(1, 0), cA + kstep, voffA); PG8_STAGE(PG8_SB(1, 1), cB + hstep + kstep, voffB);
        PG8_WAIT_V(6); PG8_BAR;
    }
    for (;;) {
        const bool has_next = S.next(ui + 1, nxt);
        const char* nA = has_next ? (const char*)g.A + (size_t)nxt.pm * tstep + (size_t)nxt.koff * 2 : cA; const char* nB = has_next ? (const char*)g.Bt + (size_t)nxt.pn * tstep + (size_t)nxt.boff * 2 : cB;
        const int nt = cur.ntile() ? cur.ntile() : nt_def;
        for (int t = 0; t < nt; t += 2) {
            const bool last = (t == nt - 2);
            const char* a1 = cA + (size_t)(t + 1) * kstep;
            const char* a2 = last ? nA : cA + (size_t)(t + 2) * kstep; const char* b2 = last ? nB : cB + (size_t)(t + 2) * kstep;
            const char* a3 = a2 + kstep; const char* b3 = b2 + kstep;
            if (last && has_next) S.a_ready(nxt);
            if constexpr (SP2) {
            PG8_LDB(B0, 0, 0); PG8_LDB(B1, 0, 1); PG8_SCHED; PG8_LDA(At, 0, 0); PG8_STAGE(PG8_SA(1, 1), a1 + hstep, voffA);
            PG8_WAIT_V(8); PG8_WAIT_L(0); PG8_BAR; PG8_MMA(0, 0, At, B0); PG8_MMA(0, 1, At, B1); PG8_BAR; PG8_SCHED;
            PG8_LDA(At, 0, 1); PG8_STAGE(PG8_SB(0, 0), b2, voffB); PG8_STAGE(PG8_SB(0, 1), b2 + hstep, voffB); PG8_STAGE(PG8_SA(0, 0), a2, voffA);
            PG8_WAIT_V(8); PG8_WAIT_L(0); PG8_BAR; PG8_MMA(1, 0, At, B0); PG8_MMA(1, 1, At, B1); PG8_BAR; PG8_SCHED;
            PG8_LDB(B0, 1, 0); PG8_LDB(B1, 1, 1); PG8_SCHED; PG8_LDA(At, 1, 0); PG8_STAGE(PG8_SA(0, 1), a2 + hstep, voffA);
            PG8_WAIT_V(8); PG8_WAIT_L(0); PG8_BAR; PG8_MMA(0, 0, At, B0); PG8_MMA(0, 1, At, B1); PG8_BAR; PG8_SCHED;
            PG8_LDA(At, 1, 1); PG8_STAGE(PG8_SB(1, 0), b3, voffB); PG8_STAGE(PG8_SB(1, 1), b3 + hstep, voffB); PG8_STAGE(PG8_SA(1, 0), a3, voffA);
            PG8_WAIT_V(8); PG8_WAIT_L(0); PG8_BAR; PG8_MMA(1, 0, At, B0); PG8_MMA(1, 1, At, B1); PG8_BAR; PG8_SCHED;
            } else {
            PG8_LDB(B0, 0, 0); PG8_SCHED; PG8_LDA(At, 0, 0); PG8_STAGE(PG8_SA(1, 1), a1 + hstep, voffA);
            PG8_WAIT_L(8); PG8_BAR; PG8_WAIT_L(0); PG8_MMA(0, 0, At, B0); PG8_BAR; PG8_SCHED;
            PG8_LDB(B1, 0, 1); PG8_STAGE(PG8_SB(0, 0), b2, voffB);
            PG8_BAR; PG8_WAIT_L(0); PG8_MMA(0, 1, At, B1); PG8_BAR;
            PG8_LDA(At, 0, 1); PG8_STAGE(PG8_SA(0, 0), a2, voffA);
            PG8_BAR; PG8_WAIT_L(0); PG8_MMA(1, 0, At, B0); PG8_BAR; PG8_SCHED;
            PG8_STAGE(PG8_SB(0, 1), b2 + hstep, voffB);
            PG8_WAIT_V(6); PG8_BAR; PG8_MMA(1, 1, At, B1); PG8_BAR;
            PG8_LDB(B0, 1, 0); PG8_SCHED; PG8_LDA(At, 1, 0); PG8_STAGE(PG8_SA(0, 1), a2 + hstep, voffA);
            PG8_WAIT_L(8); PG8_BAR; PG8_WAIT_L(0); PG8_MMA(0, 0, At, B0); PG8_BAR; PG8_SCHED;
            PG8_LDB(B1, 1, 1); PG8_STAGE(PG8_SB(1, 0), b3, voffB);
            PG8_BAR; PG8_WAIT_L(0); PG8_MMA(0, 1, At, B1); PG8_BAR;
            PG8_LDA(At, 1, 1); PG8_STAGE(PG8_SA(1, 0), a3, voffA);
            PG8_BAR; PG8_WAIT_L(0); PG8_MMA(1, 0, At, B0); PG8_BAR; PG8_SCHED;
            PG8_STAGE(PG8_SB(1, 1), b3 + hstep, voffB);
            PG8_WAIT_V(6); PG8_BAR; PG8_MMA(1, 1, At, B1); PG8_BAR;
            }
        }
        if constexpr (ALIGN_EPI) { if (wr == 0) PG8_BAR; }
        if constexpr (!Epi::AFTER_DRAIN) { E(acc, cur, wr, wc, fr, fq); S.done(cur); }
        if (!has_next) break;
        if (!nxt.carry()) {
#pragma unroll
        for (int a = 0; a < 2; ++a)
#pragma unroll
            for (int b = 0; b < 2; ++b)
#pragma unroll
                for (int m = 0; m < 4; ++m)
#pragma unroll
                    for (int n = 0; n < 2; ++n) acc[a][b][m][n] = (f32x4){0.f, 0.f, 0.f, 0.f};
        }
        cur = nxt; cA = nA; cB = nB; ++ui;
        if constexpr (ALIGN_EPI) { if (wr == 1) PG8_BAR; }
    }
    PG8_WAIT_V(0);
    if constexpr (!ALIGN_EPI) { if (wr == 0) PG8_BAR; }
    PG8_BAR;
    if constexpr (Epi::AFTER_DRAIN) { E.fused(acc, cur, wr, wc, fr, fq, lds, wid, lane); S.done(cur); }
#undef PG8_SA
#undef PG8_SB
#undef PG8_STAGE
#undef PG8_LDA
#undef PG8_LDB
#undef PG8_MMA
#undef PG8_WAIT_V
#undef PG8_WAIT_L
#undef PG8_BAR
#undef PG8_SCHED
}
}

__device__ __forceinline__ float shfl_xor_f(float v, int o) { return __uint_as_float((unsigned)__builtin_amdgcn_ds_bpermute((mk_lane_id() ^ o) << 2, (int)__float_as_uint(v))); }
namespace attn128 {
using bf16 = __hip_bfloat16;
constexpr int D = 128, NW = 8, QBLK = 32, KVBLK = 64;
constexpr float SCALE = 0.088388347648318440f;
constexpr float THR = 8.f;
constexpr int SDEPTH = 2;
constexpr int LDQ = 1024, LDK = 1024, LDO = 1024;
constexpr size_t SHM_V = KVBLK * D * 2, SHM_K = KVBLK * D * 2, SHM_ATTN = 2 * SHM_V + 2 * SHM_K + NW * 64 * 4;
using bf16x8 = __attribute__((ext_vector_type(8))) short;
using s16x4  = __attribute__((ext_vector_type(4))) short;
using f32x16 = __attribute__((ext_vector_type(16))) float;
using f32x8  = __attribute__((ext_vector_type(8))) float;
using u32x4  = __attribute__((ext_vector_type(4))) unsigned;
#define KSWZ(row, colB) ((row) * 256 + ((colB) ^ (((row) & 7) << 4)))
#define SBAR() __builtin_amdgcn_sched_barrier(0)
__device__ __forceinline__ int crow(int r, int hi) { return (r & 3) + 8 * (r >> 2) + 4 * hi; }
__device__ __forceinline__ unsigned cvtpk(float lo, float hi) {
  unsigned r; asm volatile("v_cvt_pk_bf16_f32 %0, %1, %2" : "=v"(r) : "v"(lo), "v"(hi)); return r;
}
template <typename TIn> struct Stage;
template <> struct Stage<bf16>  { using T = bf16x8;
  __device__ static __forceinline__ T ld8(const bf16* p) { return *reinterpret_cast<const bf16x8*>(p); }
  __device__ static __forceinline__ bf16x8 tobf(T x) { return x; } };
template <> struct Stage<float> { using T = f32x8;
  __device__ static __forceinline__ T ld8(const float* p) { return *reinterpret_cast<const f32x8*>(p); }
  __device__ static __forceinline__ bf16x8 tobf(T x) {
    u32x4 w = {cvtpk(x[0], x[1]), cvtpk(x[2], x[3]), cvtpk(x[4], x[5]), cvtpk(x[6], x[7])}; return *reinterpret_cast<bf16x8*>(&w); } };

__device__ __forceinline__ void partialSM(f32x16& p0, f32x16& p1, float& m_reg, float& mn, float& alpha) {
  constexpr float C = SCALE * 1.4426950408889634f;
  float pmax = p0[0]; for (int r = 1; r < 16; ++r) pmax = fmaxf(pmax, p0[r]); for (int r = 0; r < 16; ++r) pmax = fmaxf(pmax, p1[r]);
  { auto rr = __builtin_amdgcn_permlane32_swap(__float_as_uint(pmax), __float_as_uint(pmax), false, false);
    pmax = fmaxf(__uint_as_float(rr[0]), __uint_as_float(rr[1])); }
  if (__builtin_expect(__all(pmax - m_reg <= THR / SCALE), 1)) { mn = m_reg; alpha = 1.f; }
  else { mn = fmaxf(m_reg, pmax); alpha = __builtin_amdgcn_exp2f((m_reg - mn) * C); m_reg = mn; }
  float mnC = -mn * C;
  for (int r = 0; r < 16; ++r) p0[r] = fmaf(p0[r], C, mnC); for (int r = 0; r < 16; ++r) p1[r] = fmaf(p1[r], C, mnC);
  for (int r = 0; r < 16; ++r) p0[r] = __builtin_amdgcn_exp2f(p0[r]);
}
__device__ __forceinline__ void finishSM(f32x16& p0, f32x16& p1, float alpha, float& l_reg, bf16x8& pa0, bf16x8& pa1, bf16x8& pa2, bf16x8& pa3) {
  for (int r = 0; r < 16; ++r) p1[r] = __builtin_amdgcn_exp2f(p1[r]);
  float ps = 0; for (int r = 0; r < 16; ++r) ps += p0[r]; for (int r = 0; r < 16; ++r) ps += p1[r];
  { auto rr = __builtin_amdgcn_permlane32_swap(__float_as_uint(ps), __float_as_uint(ps), false, false);
    ps = __uint_as_float(rr[0]) + __uint_as_float(rr[1]); }
  l_reg = l_reg * alpha + ps;
#define PK4(P, BASE, OUT) do { unsigned a0 = cvtpk(P[BASE + 0], P[BASE + 1]), a1 = cvtpk(P[BASE + 2], P[BASE + 3]);   \
    unsigned b0 = cvtpk(P[BASE + 4], P[BASE + 5]), b1 = cvtpk(P[BASE + 6], P[BASE + 7]);                              \
    auto r0 = __builtin_amdgcn_permlane32_swap(a0, b0, false, false); auto r1 = __builtin_amdgcn_permlane32_swap(a1, b1, false, false); \
    u32x4 w = {r0[0], r1[0], r0[1], r1[1]}; OUT = *reinterpret_cast<bf16x8*>(&w); } while (0)
  PK4(p0, 0, pa0); PK4(p0, 8, pa1); PK4(p1, 0, pa2); PK4(p1, 8, pa3);
#undef PK4
}
__device__ __forceinline__ void qkt(f32x16& p0, f32x16& p1, const bf16* Ks, const bf16x8* qr, int r32, int hi) {
  p0 = f32x16{}; p1 = f32x16{};
  for (int d0 = 0; d0 < 8; ++d0) { int cb = (d0 * 16 + hi * 8) * 2;
    bf16x8 b0 = *reinterpret_cast<const bf16x8*>((const char*)Ks + KSWZ(r32, cb));
    bf16x8 b1 = *reinterpret_cast<const bf16x8*>((const char*)Ks + KSWZ(32 + r32, cb));
    p0 = __builtin_amdgcn_mfma_f32_32x32x16_bf16(b0, qr[d0], p0, 0, 0, 0);
    p1 = __builtin_amdgcn_mfma_f32_32x32x16_bf16(b1, qr[d0], p1, 0, 0, 0); }
}
__device__ __forceinline__ int v_st(int k, int c) { const int kk = (k & ~0xC) | ((k & 4) << 1) | ((k & 8) >> 1); return ((kk >> 3) * 4 + (c >> 5)) * 512 + ((kk & 7) * 32 + (c & 31)) * 2; }
__device__ __forceinline__ int v_rd_base(int lane) { return ((lane & 3) << 3) | (((lane >> 2) & 3) << 6) | (((lane >> 4) & 1) << 5) | (((lane >> 5) & 1) << 8); }
constexpr int v_rd_off(int d0, int ks, int half) { return d0 * 512 + ks * 4096 + half * 2048; }
template <int OFF> __device__ __forceinline__ s16x4 tr_read(int vb) {
  s16x4 r; asm volatile("ds_read_b64_tr_b16 %0, %1 offset:%2" : "=&v"(r) : "v"(vb), "i"(OFF) : "memory"); return r;
}
template <int D0> __device__ __forceinline__ void pv_one(f32x16& od, int vb, bf16x8 pa0, bf16x8 pa1, bf16x8 pa2, bf16x8 pa3) {
  const s16x4 l0 = tr_read<v_rd_off(D0, 0, 0)>(vb), h0 = tr_read<v_rd_off(D0, 0, 1)>(vb), l1 = tr_read<v_rd_off(D0, 1, 0)>(vb), h1 = tr_read<v_rd_off(D0, 1, 1)>(vb);
  const s16x4 l2 = tr_read<v_rd_off(D0, 2, 0)>(vb), h2 = tr_read<v_rd_off(D0, 2, 1)>(vb), l3 = tr_read<v_rd_off(D0, 3, 0)>(vb), h3 = tr_read<v_rd_off(D0, 3, 1)>(vb);
  asm volatile("s_waitcnt lgkmcnt(0)" ::: "memory"); SBAR();
#define PK(L, H) (bf16x8){L[0], L[1], L[2], L[3], H[0], H[1], H[2], H[3]}
  od = __builtin_amdgcn_mfma_f32_32x32x16_bf16(pa0, PK(l0, h0), od, 0, 0, 0);
  od = __builtin_amdgcn_mfma_f32_32x32x16_bf16(pa1, PK(l1, h1), od, 0, 0, 0);
  od = __builtin_amdgcn_mfma_f32_32x32x16_bf16(pa2, PK(l2, h2), od, 0, 0, 0);
  od = __builtin_amdgcn_mfma_f32_32x32x16_bf16(pa3, PK(l3, h3), od, 0, 0, 0);
#undef PK
}
__device__ __forceinline__ void pv_d0(f32x16* o, int vb, bf16x8 pa0, bf16x8 pa1, bf16x8 pa2, bf16x8 pa3) {
  pv_one<0>(o[0], vb, pa0, pa1, pa2, pa3); pv_one<1>(o[1], vb, pa0, pa1, pa2, pa3); pv_one<2>(o[2], vb, pa0, pa1, pa2, pa3); pv_one<3>(o[3], vb, pa0, pa1, pa2, pa3);
}

template <typename TQ>
__device__ __forceinline__ void attn_dense_body(const TQ* __restrict__ Qb, const bf16* __restrict__ Kh, const bf16* __restrict__ Vh,
                                                float* __restrict__ Ob, int seq, char* lds, int wave_s_) {
  using St = Stage<bf16>; using SQ = Stage<TQ>;
  int tid = MK_TID(wave_s_); asm volatile("" : "+v"(tid));
  const int wid = tid >> 6, lane = tid & 63, r32 = lane & 31, hi = lane >> 5;
  bf16* V_lds = (bf16*)lds; bf16* K_lds = (bf16*)(lds + 2 * SHM_V);
  float* ws = (float*)(lds + 2 * SHM_V + 2 * SHM_K) + wid * 64; float* li_l = ws; float* al_l = ws + 32;
  float m_reg = -1e30f, l_reg = 0; f32x16 o[4] = {}; bf16x8 qr[8];
  const TQ* Qw = Qb + (long)(wid * QBLK + r32) * LDQ + hi * 8;
#pragma unroll
  for (int d0 = 0; d0 < 8; ++d0) qr[d0] = SQ::tobf(SQ::ld8(Qw + d0 * 16));
  const int sr = tid >> 4, sc = (tid & 15) * 8, vst0 = v_st(sr, sc), vst1 = v_st(32 + sr, sc);
  const int vb0 = (int)(uintptr_t)V_lds + v_rd_base(lane);
  struct { typename St::T vs0, vs1, ks0, ks1; } sr_[SDEPTH];
#define SLOAD(i, k0) do { sr_[i].vs0 = St::ld8(&Vh[(long)((k0) + sr) * LDK + sc]); sr_[i].vs1 = St::ld8(&Vh[(long)((k0) + 32 + sr) * LDK + sc]); \
    sr_[i].ks0 = St::ld8(&Kh[(long)((k0) + sr) * LDK + sc]); sr_[i].ks1 = St::ld8(&Kh[(long)((k0) + 32 + sr) * LDK + sc]); } while (0)
#define SWRITE(b, i) do { *(bf16x8*)((char*)V_lds + (b) * SHM_V + vst0) = St::tobf(sr_[i].vs0);          \
    *(bf16x8*)((char*)V_lds + (b) * SHM_V + vst1) = St::tobf(sr_[i].vs1); int kc = sc * 2;               \
    *(bf16x8*)((char*)K_lds + (b) * SHM_K + KSWZ(sr, kc)) = St::tobf(sr_[i].ks0);                       \
    *(bf16x8*)((char*)K_lds + (b) * SHM_K + KSWZ(32 + sr, kc)) = St::tobf(sr_[i].ks1); } while (0)
#define SWAIT() do { if constexpr (SDEPTH == 2) asm volatile("s_waitcnt vmcnt(4)" ::: "memory"); else asm volatile("s_waitcnt vmcnt(0)" ::: "memory"); } while (0)
#define RESC(a) do { if (__any((a) < 1.f)) { if (hi == 0) al_l[r32] = (a); asm volatile("s_waitcnt lgkmcnt(0)" ::: "memory"); \
    for (int d = 0; d < 4; ++d) for (int r = 0; r < 16; ++r) o[d][r] *= al_l[crow(r, hi)]; } } while (0)
  f32x16 pA0, pA1, pB0, pB1; float mnA, mnB, alA, alB; bf16x8 pa0, pa1, pa2, pa3; const int NT = seq / KVBLK;
  constexpr int SE = 0, SO = SDEPTH - 1;
  SLOAD(SE, 0); asm volatile("s_waitcnt vmcnt(0)" ::: "memory"); SWRITE(0, SE); __syncthreads();
  qkt(pA0, pA1, K_lds, qr, r32, hi); partialSM(pA0, pA1, m_reg, mnA, alA);
  SLOAD(SO, KVBLK); if constexpr (SDEPTH == 2) { if (2 < NT) SLOAD(SE, 2 * KVBLK); }
  SWAIT(); SWRITE(1, SO); __syncthreads();
  for (int j = 1; j + 1 < NT; j += 2) {
    SBAR(); qkt(pB0, pB1, (bf16*)((char*)K_lds + SHM_K), qr, r32, hi);
    finishSM(pA0, pA1, alA, l_reg, pa0, pa1, pa2, pa3); SBAR();
    SLOAD(SO, (j + SDEPTH) * KVBLK); SBAR();
    pv_d0(o, vb0, pa0, pa1, pa2, pa3); partialSM(pB0, pB1, m_reg, mnB, alB);
    __syncthreads(); SWAIT(); SWRITE(0, SE);
    RESC(alB); __syncthreads();
    SBAR(); qkt(pA0, pA1, K_lds, qr, r32, hi);
    finishSM(pB0, pB1, alB, l_reg, pa0, pa1, pa2, pa3); SBAR();
    if (SDEPTH == 1 || j + 3 < NT) SLOAD(SE, (j + 1 + SDEPTH) * KVBLK); SBAR();
    pv_d0(o, vb0 + (int)SHM_V, pa0, pa1, pa2, pa3); partialSM(pA0, pA1, m_reg, mnA, alA);
    __syncthreads(); SWAIT(); SWRITE(1, SO);
    RESC(alA); __syncthreads();
  }
  SBAR(); qkt(pB0, pB1, (bf16*)((char*)K_lds + SHM_K), qr, r32, hi);
  finishSM(pA0, pA1, alA, l_reg, pa0, pa1, pa2, pa3); SBAR();
  pv_d0(o, vb0, pa0, pa1, pa2, pa3); partialSM(pB0, pB1, m_reg, mnB, alB);
  __syncthreads(); RESC(alB);
  finishSM(pB0, pB1, alB, l_reg, pa0, pa1, pa2, pa3); SBAR();
  pv_d0(o, vb0 + (int)SHM_V, pa0, pa1, pa2, pa3);
  if (hi == 0) li_l[r32] = l_reg; asm volatile("s_waitcnt lgkmcnt(0)" ::: "memory");
  float rli[16];
#pragma unroll
  for (int r = 0; r < 16; ++r) rli[r] = __builtin_amdgcn_rcpf(li_l[crow(r, hi)]);
  float* Ow = Ob + (long)(wid * QBLK) * LDO;
#pragma unroll
  for (int r = 0; r < 16; ++r) { int orow = crow(r, hi);
    for (int d0 = 0; d0 < 4; ++d0) Ow[(long)orow * LDO + d0 * 32 + r32] = o[d0][r] * rli[r]; }
#undef SLOAD
#undef SWRITE
#undef SWAIT
#undef RESC
}

}

namespace attn256 {
using namespace attn128;
constexpr size_t SHM_V2 = KVBLK * 256 * 2, SHM_K2 = KVBLK * D * 2;
constexpr int LDV = 1024;
__device__ __forceinline__ int v_st2(int k, int c) { const int kk = (k & ~0xC) | ((k & 4) << 1) | ((k & 8) >> 1); return ((kk >> 3) * 8 + (c >> 5)) * 512 + ((kk & 7) * 32 + (c & 31)) * 2; }
constexpr int v_rd_off2(int d0, int ks, int half) { return d0 * 512 + ks * 8192 + half * 4096; }
template <int D0> __device__ __forceinline__ void pv_one2(f32x16& od, int vb, bf16x8 pa0, bf16x8 pa1, bf16x8 pa2, bf16x8 pa3) {
  const s16x4 l0 = tr_read<v_rd_off2(D0, 0, 0)>(vb), h0 = tr_read<v_rd_off2(D0, 0, 1)>(vb), l1 = tr_read<v_rd_off2(D0, 1, 0)>(vb), h1 = tr_read<v_rd_off2(D0, 1, 1)>(vb);
  const s16x4 l2 = tr_read<v_rd_off2(D0, 2, 0)>(vb), h2 = tr_read<v_rd_off2(D0, 2, 1)>(vb), l3 = tr_read<v_rd_off2(D0, 3, 0)>(vb), h3 = tr_read<v_rd_off2(D0, 3, 1)>(vb);
  asm volatile("s_waitcnt lgkmcnt(0)" ::: "memory"); SBAR();
#define PK(L, H) (bf16x8){L[0], L[1], L[2], L[3], H[0], H[1], H[2], H[3]}
  od = __builtin_amdgcn_mfma_f32_32x32x16_bf16(pa0, PK(l0, h0), od, 0, 0, 0);
  od = __builtin_amdgcn_mfma_f32_32x32x16_bf16(pa1, PK(l1, h1), od, 0, 0, 0);
  od = __builtin_amdgcn_mfma_f32_32x32x16_bf16(pa2, PK(l2, h2), od, 0, 0, 0);
  od = __builtin_amdgcn_mfma_f32_32x32x16_bf16(pa3, PK(l3, h3), od, 0, 0, 0);
#undef PK
}
__device__ __forceinline__ void attn_o256_body(const bf16* __restrict__ Qb, const bf16* __restrict__ Kh, const bf16* __restrict__ Vh, float* __restrict__ Ob, int seq, char* lds, int wave_s_) {
  using St = Stage<bf16>;
  int tid = MK_TID(wave_s_); asm volatile("" : "+v"(tid));
  const int wid = tid >> 6, lane = tid & 63, r32 = lane & 31, hi = lane >> 5;
  bf16* V_lds = (bf16*)lds; bf16* K_lds = (bf16*)(lds + 2 * SHM_V2);
  float* ws = (float*)(lds + 2 * SHM_V2 + 2 * SHM_K2) + wid * 64; float* li_l = ws; float* al_l = ws + 32;
  float m_reg = -1e30f, l_reg = 0; f32x16 o[8] = {}; bf16x8 qr[8];
  const bf16* Qw = Qb + (long)(wid * QBLK + r32) * LDQ + hi * 8;
#pragma unroll
  for (int d0 = 0; d0 < 8; ++d0) qr[d0] = St::ld8(Qw + d0 * 16);
  const int vb0 = (int)(uintptr_t)V_lds + v_rd_base(lane);
  bf16x8 sv00, sv01, sv10, sv11, sk0, sk1;
#define SLOAD2(k0) do { const int t_ = MK_TID(wave_s_), sr = t_ >> 4, sc = (t_ & 15) * 8; const bf16* vp = Vh + (long)((k0) + sr) * LDV + sc; const bf16* kp = Kh + (long)((k0) + sr) * LDK + sc; \
    sv00 = St::ld8(vp); sv01 = St::ld8(vp + 128); sv10 = St::ld8(vp + 32 * LDV); sv11 = St::ld8(vp + 32 * LDV + 128); sk0 = St::ld8(kp); sk1 = St::ld8(kp + 32 * LDK); } while (0)
#define SWRITE2(b) do { const int t_ = MK_TID(wave_s_), sr = t_ >> 4, sc = (t_ & 15) * 8; char* vbuf = (char*)V_lds + (b) * SHM_V2 + v_st2(sr, sc); \
    *(bf16x8*)(vbuf) = sv00; *(bf16x8*)(vbuf + 2048) = sv01; *(bf16x8*)(vbuf + 16384) = sv10; *(bf16x8*)(vbuf + 18432) = sv11; \
    char* kbuf = (char*)K_lds + (b) * SHM_K2 + KSWZ(sr, sc * 2); *(bf16x8*)(kbuf) = sk0; *(bf16x8*)(kbuf + 8192) = sk1; } while (0)
  const int NT = seq / KVBLK;
  SLOAD2(0); asm volatile("s_waitcnt vmcnt(0)" ::: "memory"); SWRITE2(0); __syncthreads();
  for (int j = 0; j < NT; ++j) {
    const int b = j & 1;
    f32x16 p0, p1; float mn, al; bf16x8 pa0, pa1, pa2, pa3;
    SBAR(); qkt(p0, p1, (bf16*)((char*)K_lds + b * SHM_K2), qr, r32, hi);
    partialSM(p0, p1, m_reg, mn, al);
    finishSM(p0, p1, al, l_reg, pa0, pa1, pa2, pa3); SBAR();
    if (__any(al < 1.f)) { if (hi == 0) al_l[r32] = al; asm volatile("s_waitcnt lgkmcnt(0)" ::: "memory");
#pragma unroll
      for (int d = 0; d < 8; ++d)
#pragma unroll
        for (int r = 0; r < 16; ++r) o[d][r] *= al_l[crow(r, hi)]; }
    if (j + 1 < NT) SLOAD2((j + 1) * KVBLK);
    SBAR();
    { const int vb = vb0 + b * (int)SHM_V2;
      pv_one2<0>(o[0], vb, pa0, pa1, pa2, pa3); pv_one2<1>(o[1], vb, pa0, pa1, pa2, pa3); pv_one2<2>(o[2], vb, pa0, pa1, pa2, pa3); pv_one2<3>(o[3], vb, pa0, pa1, pa2, pa3);
      pv_one2<4>(o[4], vb, pa0, pa1, pa2, pa3); pv_one2<5>(o[5], vb, pa0, pa1, pa2, pa3); pv_one2<6>(o[6], vb, pa0, pa1, pa2, pa3); pv_one2<7>(o[7], vb, pa0, pa1, pa2, pa3); }
    if (j + 1 < NT) { asm volatile("s_waitcnt vmcnt(0)" ::: "memory"); SWRITE2(b ^ 1); }
    __syncthreads();
  }
  if (hi == 0) li_l[r32] = l_reg; asm volatile("s_waitcnt lgkmcnt(0)" ::: "memory");
  float rli[16];
#pragma unroll
  for (int r = 0; r < 16; ++r) rli[r] = __builtin_amdgcn_rcpf(li_l[crow(r, hi)]);
  float* Ow = Ob + (long)(wid * QBLK) * LDO;
#pragma unroll
  for (int r = 0; r < 16; ++r) { const int orow = crow(r, hi);
#pragma unroll
    for (int d0 = 0; d0 < 8; ++d0) Ow[(long)orow * LDO + d0 * 32 + r32] = o[d0][r] * rli[r]; }
#undef SLOAD2
#undef SWRITE2
}
}

#define GAS __attribute__((address_space(1)))
#define LAS __attribute__((address_space(3)))
typedef unsigned short bf16;
typedef unsigned v4u __attribute__((ext_vector_type(4)));
typedef float f32x4 __attribute__((ext_vector_type(4)));
typedef short bf16x8 __attribute__((ext_vector_type(8)));
typedef GAS unsigned gu32;
typedef GAS unsigned long long gu64;
#define RLX_AGENT __ATOMIC_RELAXED, __HIP_MEMORY_SCOPE_AGENT
#define LDS_WAIT() asm volatile("s_waitcnt lgkmcnt(0)" ::: "memory")
#define VM_WAIT() asm volatile("s_waitcnt vmcnt(0)" ::: "memory")
__device__ __forceinline__ unsigned long long rt() { return __builtin_amdgcn_s_memrealtime(); }
__device__ __forceinline__ unsigned f2bf(float f) { unsigned u = __builtin_bit_cast(unsigned, f); return (u + 0x7fffu + ((u >> 16) & 1u)) >> 16; }
__device__ __forceinline__ unsigned pk2(float lo, float hi) { return f2bf(lo) | (f2bf(hi) << 16); }

#define XB_TMO      128
#define XB_XCNT(j)  (256  + 64 * (j))
#define XB_XSUB(j)  (1280 + 64 * (j))
#define XB_XGEN(j)  (2304 + 64 * (j))
#define XB_TOP      3328
#define XB_TOPGEN   3392
#define XCD_BAR_WORDS 3456
#define XB_SPIN_CAP (1u << 22)

__device__ __forceinline__ unsigned xb_ld(unsigned* p)              { return __hip_atomic_load(p, __ATOMIC_RELAXED, __HIP_MEMORY_SCOPE_AGENT); }
__device__ __forceinline__ unsigned xb_add(unsigned* p, unsigned v) { return __hip_atomic_fetch_add(p, v, __ATOMIC_RELAXED, __HIP_MEMORY_SCOPE_AGENT); }
__device__ __forceinline__ unsigned xb_xcc_id() { return (unsigned)__builtin_amdgcn_s_getreg((3 << 11) | 20) & 0xFu; }
#define XB_SPIN(cond, bar) do { unsigned _sp = 0; while (cond) { __builtin_amdgcn_s_sleep(1); \
    if ((++_sp & 255u) == 0u) { if (xb_ld(&(bar)[XB_TMO])) break; if (_sp > XB_SPIN_CAP) { atomicAdd(&(bar)[XB_TMO], 1u); break; } } } } while (0)

struct XcdBarrier {
    unsigned* bar; unsigned x;
    volatile LAS unsigned* st;
};

__device__ __forceinline__ XcdBarrier xcd_barrier_post(unsigned* bar, volatile LAS unsigned* st, int tid_) {
    XcdBarrier b; b.bar = bar; b.x = xb_xcc_id(); b.st = st;
    if (tid_ == 0) (void)xb_add(&bar[XB_XCNT(b.x)], 1u);
    return b;
}
__device__ __forceinline__ void xcd_barrier_complete(unsigned* bar, unsigned x, unsigned& nloc, unsigned& nx) {
    const unsigned G = gridDim.x * gridDim.y * gridDim.z;
    unsigned sum, cnt, mine, sp = 0u;
    for (;;) {
        sum = 0u; cnt = 0u; mine = 0u;
#pragma unroll
        for (unsigned j = 0; j < 16; ++j) { const unsigned c = xb_ld(&bar[XB_XCNT(j)]); sum += c; cnt += (c > 0u) ? 1u : 0u; mine = (j == x) ? c : mine; }
        if (sum == G) break;
        __builtin_amdgcn_s_sleep(1);
        if ((++sp & 255u) == 0u) { if (xb_ld(&bar[XB_TMO])) break; if (sp > XB_SPIN_CAP) { atomicAdd(&bar[XB_TMO], 1u); break; } }
    }
    nloc = mine > 0u ? mine : 1u; nx = cnt > 0u ? cnt : 1u;
}

__device__ __forceinline__ void xcd_barrier(const XcdBarrier& b, int tid_) {
    asm volatile("s_waitcnt vmcnt(0)" ::: "memory");
    __syncthreads();
    if (tid_ == 0) {
        unsigned* bar = b.bar;
        __builtin_amdgcn_s_waitcnt(0);
        unsigned nloc = b.st[0], nx = b.st[1];
        if (nloc == 0u) { xcd_barrier_complete(bar, b.x, nloc, nx); b.st[0] = nloc; b.st[1] = nx; }
        const unsigned old = xb_add(&bar[XB_XSUB(b.x)], 1u);
        const unsigned gen = old / nloc;
        if (old + 1u == (gen + 1u) * nloc) {
            __builtin_amdgcn_fence(__ATOMIC_RELEASE, "agent");
            asm volatile("s_waitcnt vmcnt(0)" ::: "memory");
            const unsigned og = xb_add(&bar[XB_TOP], 1u);
            const unsigned tg = og / nx;
            if (og + 1u == (tg + 1u) * nx) xb_add(&bar[XB_TOPGEN], 1u);
            else XB_SPIN(xb_ld(&bar[XB_TOPGEN]) == tg, bar);
            __builtin_amdgcn_fence(__ATOMIC_ACQUIRE, "agent");
            xb_add(&bar[XB_XGEN(b.x)], 1u);
            asm volatile("s_waitcnt vmcnt(0)" ::: "memory");
        } else {
            XB_SPIN(xb_ld(&bar[XB_XGEN(b.x)]) == gen, bar);
            __builtin_amdgcn_fence(__ATOMIC_ACQUIRE, "agent");
            asm volatile("s_waitcnt vmcnt(0)" ::: "memory");
        }
    }
    __syncthreads();
}

constexpr int DM = 4096, SEQ = 8192, CTXL = 256, MT = SEQ + CTXL, DEPTH = 4, FFND = 4096;
constexpr int NZ = 20480, INC = 20496, ADAR = 256, NMOD = 9 * DM;
constexpr int ZC_UV = 0, ZC_MQ = 2048, ZC_MK = 2560, ZC_MV = 3072, ZC_MO = 4096, ZC_AQ = 5120, ZC_AK = 6144, ZC_AV = 7168, ZC_MG = 8192;
constexpr float EPS = 1e-6f;
constexpr int NWAVES = 8, NTHR = 512;

constexpr size_t MiB = 1ull << 20;
constexpr size_t WS_CTL = 0, CTL_ZERO_BYTES = 1 * MiB;
constexpr size_t WS_MODTP = 1 * MiB;
constexpr size_t WS_MOD = WS_MODTP + 512 * 1024;
constexpr size_t WS_LAM = WS_MOD + (size_t)DEPTH * 2 * NMOD * 4;
constexpr size_t WS_WG16 = WS_LAM + 256;
constexpr size_t WS_ROPE = WS_WG16 + (size_t)DEPTH * 16 * DM * 4;
constexpr size_t WS_G16 = WS_ROPE + (size_t)2 * SEQ * 64 * 4;
constexpr size_t WS_XR = 9 * MiB;
constexpr size_t SZ_ROWS_F32 = (size_t)MT * DM * 4, SZ_ROWS_BF = (size_t)MT * DM * 2;
constexpr size_t WS_H = WS_XR + SZ_ROWS_F32;
constexpr size_t WS_GB = WS_H + SZ_ROWS_BF;
constexpr size_t WS_Z = WS_GB + SZ_ROWS_BF;
constexpr size_t WS_ATTO = WS_Z + (size_t)MT * NZ * 2;
constexpr size_t WS_MLH = WS_ATTO + (size_t)2 * MT * 1024 * 4;
constexpr size_t WS_YA = WS_MLH + (size_t)2 * MT * 1024 * 4;
constexpr size_t WS_YB = WS_YA + (size_t)MT * 1024 * 2;
constexpr size_t WS_YC = WS_YB + (size_t)MT * 1024 * 2;
constexpr size_t WS_YACC = WS_YC + (size_t)MT * 1024 * 2;
constexpr size_t WS_Y = WS_YACC + SZ_ROWS_F32;
constexpr size_t WS_W13T = WS_Y + SZ_ROWS_BF;
constexpr size_t WS_W2T = WS_W13T + (size_t)DEPTH * 2 * 8192 * 4096 * 2;
constexpr size_t WS_WINT = WS_W2T + (size_t)DEPTH * 2 * 4096 * 4096 * 2;
constexpr size_t WS_WBT = WS_WINT + (size_t)DEPTH * NZ * 4096 * 2;
constexpr size_t WS_WOT = WS_WBT + (size_t)DEPTH * 3 * 4096 * 1024 * 2;
constexpr size_t WS_CT = WS_WOT + (size_t)DEPTH * 4096 * 4096 * 2;
constexpr size_t WS_MSM = WS_CT + (size_t)8 * 66 * 32768 * 2;
constexpr size_t WS_SLAB = WS_MSM + 1 * MiB;
constexpr size_t WS_GWSB = WS_SLAB + (size_t)16 * 256 * DM * 4;
constexpr size_t WS_MS3 = WS_GWSB + (size_t)DEPTH * 8 * 128 * 128 * 2;
constexpr size_t WS_END = WS_MS3 + (size_t)3 * 256 * DM * 4;
static_assert(WS_G16 + (size_t)MT * 16 * 4 <= WS_XR, "small buffers fit below XR");
static_assert(WS_XR % 256 == 0 && WS_H % 256 == 0 && WS_Z % 256 == 0 && WS_W13T % 256 == 0, "alignment");

constexpr int CW_BAR = 4096;

constexpr int RING_OFF = 0, RING_BYTES = 131072;
constexpr int LDSCTL_OFF = 143360, MISC_OFF = LDSCTL_OFF + 320;
constexpr int LDS_BYTES = 147456;

constexpr int P_PRO0 = 0, P_PRO1 = 1, P_LAYER0 = 2;
constexpr int L_N1 = 0, L_W13A = 1, L_W2A = 2, L_N2 = 3, L_WIN = 4, L_MIX1 = 5, L_POST = 6, L_M3 = 7, L_MERGE = 8, L_WOUT = 9, L_N3 = 10, L_W13B = 11, L_W2B = 12, NPL = 13;
constexpr int P_FINAL = P_LAYER0 + DEPTH * NPL, NPH = P_FINAL + 1;

__device__ __forceinline__ float wave_sum(float v) {
#pragma unroll
    for (int o = 1; o < 64; o <<= 1) v += shfl_xor_f(v, o);
    return v;
}
__device__ __forceinline__ float bf2f(unsigned short b) { return __uint_as_float((unsigned)b << 16); }
__device__ __forceinline__ float bflo(unsigned w) { return __uint_as_float(w << 16); }
__device__ __forceinline__ float bfhi(unsigned w) { return __uint_as_float(w & 0xffff0000u); }
__device__ __forceinline__ float sigmoid_f(float x) { return 1.f / (1.f + __expf(-x)); }
__device__ __forceinline__ float silu_f(float x) { return x / (1.f + __expf(-x)); }
__device__ __forceinline__ float gelu_tanh_f(float x) { const float u = 0.7978845608028654f * (x + 0.044715f * x * x * x); return x / (1.f + __expf(-2.f * u)); }
__device__ __forceinline__ float lambda_init_f(int l) { return 0.8f - 0.6f * __expf(-0.3f * (float)l); }

namespace pg8 {
struct CtxSplitOrder {
    int c, G, n;
    const float* MS3; bf16_t* Yc; int wave_s_;
    __device__ __forceinline__ bool next(int i, Unit& u) const { const int L = i * G + c; if (L >= n) return false; u.pm = 0; u.pn = L >> 4; u.koff = (L & 15) * 256; u.boff = u.koff; u.fl = 0; return true; }
    __device__ __forceinline__ void a_ready(const Unit& u) const {
        if (MS3) {
            int t_ = MK_TID(wave_s_); asm volatile("" : "+v"(t_));
            const int r = t_ >> 1, c0 = u.koff + (t_ & 1) * 128;
            const float* p0 = MS3 + (size_t)r * DM + c0; bf16_t* yo = Yc + (size_t)r * DM + c0;
#pragma unroll 1
            for (int ib = 0; ib < 16; ib += 4) { f32x4 q[4][3][2];
#pragma unroll
                for (int i = 0; i < 4; ++i)
#pragma unroll
                    for (int sgm = 0; sgm < 3; ++sgm) { q[i][sgm][0] = *(const f32x4*)(p0 + (size_t)sgm * 256 * DM + 8 * (ib + i)); q[i][sgm][1] = *(const f32x4*)(p0 + (size_t)sgm * 256 * DM + 8 * (ib + i) + 4); }
                asm volatile("" ::: "memory");
#pragma unroll
                for (int i = 0; i < 4; ++i) { const f32x4 a0 = q[i][0][0] + q[i][1][0] + q[i][2][0], a1 = q[i][0][1] + q[i][1][1] + q[i][2][1];
                    u32x4 w; w.x = cvt_pk_bf16(a0[0], a0[1]); w.y = cvt_pk_bf16(a0[2], a0[3]); w.z = cvt_pk_bf16(a1[0], a1[1]); w.w = cvt_pk_bf16(a1[2], a1[3]); *(u32x4*)(yo + 8 * (ib + i)) = w; }
                asm volatile("" ::: "memory"); }
            asm volatile("s_waitcnt vmcnt(0)" ::: "memory");
            asm volatile("" ::: "memory"); __builtin_amdgcn_s_barrier(); asm volatile("" ::: "memory");
        }
    }
    __device__ __forceinline__ void done(const Unit&) const {}
};
struct ResidOrder {
    StaticOrder lat; int c, G, n;
    __device__ __forceinline__ bool next(int i, Unit& u) const {
        const int nl = lat.c < lat.nwg ? (lat.nwg - lat.c + lat.G - 1) / lat.G : 0;
        if (i < nl) { lat.next(i, u); u.pm += 1; return true; }
        const int L = (i - nl) * G + c; if (L >= n) return false;
        u.pm = 0; u.pn = L >> 4; u.koff = (L & 15) * 256; u.boff = u.koff; u.fl = 4 << 8; return true;
    }
    __device__ __forceinline__ void a_ready(const Unit&) const {}
    __device__ __forceinline__ void done(const Unit&) const {}
};
struct MergeOrder {
    StaticOrder lat; int c, G, nctx;
    __device__ __forceinline__ bool next(int i, Unit& u) const {
        const int nl = lat.c < lat.nwg ? (lat.nwg - lat.c + lat.G - 1) / lat.G : 0;
        if (i < 3 * nl) { lat.next(i / 3, u); u.pm += 1; const int sg = i % 3; u.fl = sg | (sg != 0 ? 4 : 0); u.koff = sg * (MT * 1024); u.boff = sg * (4096 * 1024); return true; }
        const int L = (i - 3 * nl) * G + c; if (L >= nctx) return false;
        u.pm = 0; u.pn = L / 3; const int sg = L % 3; u.fl = sg; u.koff = sg * (MT * 1024); u.boff = sg * (4096 * 1024); return true;
    }
    __device__ __forceinline__ void a_ready(const Unit&) const {}
    __device__ __forceinline__ void done(const Unit&) const {}
};
struct EpiSlab {
    static constexpr bool PERM = false, AFTER_DRAIN = false;
    float* S;
    __device__ __forceinline__ void operator()(const f32x4 (&acc)[2][2][4][2], const Unit& u, int wr, int wc, int fr, int fq) const {
        { const int l_ = mk_lane_id(); fr = l_ & 15; fq = l_ >> 4; }
        const int col0 = u.pn * BM + wc * 32 + 4 * fq; float* base = S + (size_t)(u.koff >> 8) * 256 * DM;
#pragma unroll
        for (int ai = 0; ai < 2; ++ai)
#pragma unroll
            for (int m = 0; m < 4; ++m) { float* p = base + (size_t)(ai * HALF + wr * 64 + m * 16 + fr) * DM + col0;
#pragma unroll
                for (int bj = 0; bj < 2; ++bj)
#pragma unroll
                    for (int n = 0; n < 2; ++n) *(f32x4*)(p + bj * HALF + n * 16) = acc[ai][bj][m][n]; }
    }
};
struct EpiWin {
    static constexpr bool PERM = true, AFTER_DRAIN = false;
    bf16_t* ZB; const float* rc; const float* rs;
    __device__ __forceinline__ void operator()(const f32x4 (&acc)[2][2][4][2], const Unit& u, int wr, int wc, int fr, int fq) const {
        { const int l_ = mk_lane_id(); fr = l_ & 15; fq = l_ >> 4; }
        const int pn = u.pn; int kind = 0, ld = 1024, c0 = 0;
        if (pn < 8) { kind = 1; ld = 2048; c0 = 0; } else if (pn < 10) { ld = 512; c0 = 2048; } else if (pn < 12) { ld = 512; c0 = 2560; } else if (pn < 16) { c0 = 3072; }
        else if (pn < 20) { kind = 2; c0 = 4096; } else if (pn < 24) { kind = 3; c0 = 5120; } else if (pn < 28) { kind = 3; c0 = 6144; } else if (pn < 32) { c0 = 7168; } else { kind = 2; ld = 12288; c0 = 8192; }
        if (kind == 3 && u.pm == 0) kind = 0;
        bf16_t* base = ZB + (size_t)MT * c0; const int colt = pn * BM - c0 + wc * 32 + 8 * fq; const int row0 = u.pm * BM + wr * 64 + fr;
#define EPIWIN_LOOP(...) _Pragma("unroll") for (int ai = 0; ai < 2; ++ai) _Pragma("unroll") for (int m = 0; m < 4; ++m) { const int row = row0 + ai * HALF + m * 16; _Pragma("unroll") for (int bj = 0; bj < 2; ++bj) { \
            const int col = colt + bj * HALF; float v[8]; _Pragma("unroll") for (int n = 0; n < 2; ++n) _Pragma("unroll") for (int i = 0; i < 4; ++i) v[n * 4 + i] = acc[ai][bj][m][n][i]; \
            __VA_ARGS__ \
            u32x4 w; w.x = cvt_pk_bf16(v[0], v[1]); w.y = cvt_pk_bf16(v[2], v[3]); w.z = cvt_pk_bf16(v[4], v[5]); w.w = cvt_pk_bf16(v[6], v[7]); *(u32x4*)(base + (size_t)row * ld + col) = w; } }
        if (kind == 0) { EPIWIN_LOOP(;) }
        else if (kind == 1) { EPIWIN_LOOP(_Pragma("unroll") for (int i = 0; i < 8; ++i) { const float x = v[i], uu = 0.7978845608028654f * (x + 0.044715f * x * x * x); v[i] = x / (1.f + __expf(-2.f * uu)); }) }
        else if (kind == 2) { EPIWIN_LOOP(_Pragma("unroll") for (int i = 0; i < 8; ++i) v[i] = 1.f / (1.f + __expf(-v[i]));) }
        else {
#pragma unroll
            for (int ai = 0; ai < 2; ++ai) { f32x4 c4[4][2], s4[4][2];
#pragma unroll
                for (int m = 0; m < 4; ++m)
#pragma unroll
                    for (int bj = 0; bj < 2; ++bj) { const int t = row0 + ai * HALF + m * 16 - CTXL, j0 = ((colt + bj * HALF) & 127) >> 1; c4[m][bj] = *(const f32x4*)(rc + t * 64 + j0); s4[m][bj] = *(const f32x4*)(rs + t * 64 + j0); }
                asm volatile("" ::: "memory");
#pragma unroll
                for (int m = 0; m < 4; ++m)
#pragma unroll
                    for (int bj = 0; bj < 2; ++bj) { const int row = row0 + ai * HALF + m * 16, col = colt + bj * HALF; float v[8];
#pragma unroll
                        for (int n = 0; n < 2; ++n)
#pragma unroll
                            for (int i = 0; i < 4; ++i) v[n * 4 + i] = acc[ai][bj][m][n][i];
#pragma unroll
                        for (int i = 0; i < 4; ++i) { const float x1 = v[2 * i], x2 = v[2 * i + 1]; v[2 * i] = x1 * c4[m][bj][i] - x2 * s4[m][bj][i]; v[2 * i + 1] = x1 * s4[m][bj][i] + x2 * c4[m][bj][i]; }
                        u32x4 w; w.x = cvt_pk_bf16(v[0], v[1]); w.y = cvt_pk_bf16(v[2], v[3]); w.z = cvt_pk_bf16(v[4], v[5]); w.w = cvt_pk_bf16(v[6], v[7]); *(u32x4*)(base + (size_t)row * ld + col) = w; }
                asm volatile("" ::: "memory"); } }
#undef EPIWIN_LOOP
    }
};
struct EpiSwiglu {
    static constexpr bool PERM = true, AFTER_DRAIN = false;
    bf16_t* O; int ldc;
    __device__ __forceinline__ void operator()(const f32x4 (&acc)[2][2][4][2], const Unit& u, int wr, int wc, int fr, int fq) const {
        { const int l_ = mk_lane_id(); fr = l_ & 15; fq = l_ >> 4; }
        const int row0 = u.pm * BM + wr * 64 + fr, col0 = u.pn * HALF + wc * 32 + 8 * fq;
#pragma unroll
        for (int ai = 0; ai < 2; ++ai)
#pragma unroll
            for (int m = 0; m < 4; ++m) {
                bf16_t* rowp = O + (size_t)(row0 + ai * HALF + m * 16) * ldc + col0;
                float v[8];
#pragma unroll
                for (int n = 0; n < 2; ++n)
#pragma unroll
                    for (int i = 0; i < 4; ++i) { const float a = acc[ai][0][m][n][i], b = acc[ai][1][m][n][i]; v[n * 4 + i] = a / (1.f + __expf(-a)) * b; }
                u32x4 w; w.x = cvt_pk_bf16(v[0], v[1]); w.y = cvt_pk_bf16(v[2], v[3]); w.z = cvt_pk_bf16(v[4], v[5]); w.w = cvt_pk_bf16(v[6], v[7]);
                *(u32x4*)rowp = w;
            }
    }
};
struct EpiResid {
    static constexpr bool PERM = false, AFTER_DRAIN = false;
    float* X; const float* gate_lat; const float* gate_ctx; const float* XB; float f;
    __device__ __forceinline__ void operator()(const f32x4 (&acc)[2][2][4][2], const Unit& u, int wr, int wc, int fr, int fq) const {
        { const int l_ = mk_lane_id(); fr = l_ & 15; fq = l_ >> 4; }
        const int col0 = u.pn * BM + wc * 32 + 4 * fq;
        const float* gate = (u.pm == 0) ? gate_ctx : gate_lat;
        f32x4 gv[2][2];
#pragma unroll
        for (int bj = 0; bj < 2; ++bj)
#pragma unroll
            for (int n = 0; n < 2; ++n) gv[bj][n] = *(const f32x4*)(gate + col0 + bj * HALF + n * 16) * f;
#pragma unroll
        for (int ai = 0; ai < 2; ++ai) {
            f32x4 x[4][2][2];
            const size_t o0 = (size_t)(u.pm * BM + ai * HALF + wr * 64 + fr) * DM + col0; float* p0 = X + o0; const float* r0 = XB + o0;
#pragma unroll
            for (int m = 0; m < 4; ++m)
#pragma unroll
                for (int bj = 0; bj < 2; ++bj)
#pragma unroll
                    for (int n = 0; n < 2; ++n) x[m][bj][n] = *(const f32x4*)(r0 + (size_t)(m * 16) * DM + bj * HALF + n * 16);
            asm volatile("" ::: "memory");
#pragma unroll
            for (int m = 0; m < 4; ++m)
#pragma unroll
                for (int bj = 0; bj < 2; ++bj)
#pragma unroll
                    for (int n = 0; n < 2; ++n) *(f32x4*)(p0 + (size_t)(m * 16) * DM + bj * HALF + n * 16) = x[m][bj][n] + gv[bj][n] * acc[ai][bj][m][n];
            asm volatile("" ::: "memory");
        }
    }
};
struct EpiResidSlab {
    static constexpr bool PERM = false, AFTER_DRAIN = false;
    unsigned char* wsb; const float* gate_lat; const float* XB; float f;
    __device__ __forceinline__ void operator()(const f32x4 (&acc)[2][2][4][2], const Unit& u, int wr, int wc, int fr, int fq) const {
        if (u.pm == 0) { EpiSlab E{(float*)(wsb + WS_SLAB)}; E(acc, u, wr, wc, fr, fq); }
        else { EpiResid E{(float*)(wsb + WS_XR), gate_lat, gate_lat, XB, f}; E(acc, u, wr, wc, fr, fq); }
    }
};
struct EpiMergeSeg {
    static constexpr bool PERM = true, AFTER_DRAIN = false;
    const bf16_t* Zg; bf16_t* Y; float* MS3;
    __device__ __forceinline__ void operator()(f32x4 (&acc)[2][2][4][2], const Unit& u, int wr, int wc, int fr, int fq) const {
        { const int l_ = mk_lane_id(); fr = l_ & 15; fq = l_ >> 4; }
        const int seg = u.seg(); const bool ctxp = (u.pm == 0);
        const int col0 = u.pn * BM + wc * 32 + 8 * fq;
#pragma unroll
        for (int ai = 0; ai < 2; ++ai) {
            u32x4 ga[4][2], gb[4][2];
#pragma unroll
            for (int m = 0; m < 4; ++m)
#pragma unroll
                for (int bj = 0; bj < 2; ++bj) { const bf16_t* gp = Zg + (size_t)MT * ZC_MG + (size_t)(u.pm * BM + ai * HALF + wr * 64 + m * 16 + fr) * 12288 + seg * 4096 + col0 + bj * HALF;
                    ga[m][bj] = *(const u32x4*)gp; if (!ctxp && seg < 2) gb[m][bj] = *(const u32x4*)(gp + 4096); }
            asm volatile("" ::: "memory");
#pragma unroll
            for (int m = 0; m < 4; ++m)
#pragma unroll
                for (int bj = 0; bj < 2; ++bj) { const size_t row = (size_t)(u.pm * BM + ai * HALF + wr * 64 + m * 16 + fr); const int col = col0 + bj * HALF;
                    const unsigned aw[4] = {ga[m][bj].x, ga[m][bj].y, ga[m][bj].z, ga[m][bj].w};
                    float g[8];
#pragma unroll
                    for (int k = 0; k < 4; ++k) { g[2 * k] = fmaxf(__uint_as_float(aw[k] << 16), 1e-20f); g[2 * k + 1] = fmaxf(__uint_as_float(aw[k] & 0xffff0000u), 1e-20f); }
                    if (!ctxp && seg < 2) { const unsigned bw[4] = {gb[m][bj].x, gb[m][bj].y, gb[m][bj].z, gb[m][bj].w};
#pragma unroll
                        for (int k = 0; k < 4; ++k) { g[2 * k] = g[2 * k] * __builtin_amdgcn_rcpf(fmaxf(__uint_as_float(bw[k] << 16), 1e-20f)); g[2 * k + 1] = g[2 * k + 1] * __builtin_amdgcn_rcpf(fmaxf(__uint_as_float(bw[k] & 0xffff0000u), 1e-20f)); } }
                    float v[8];
#pragma unroll
                    for (int n = 0; n < 2; ++n)
#pragma unroll
                        for (int i = 0; i < 4; ++i) v[n * 4 + i] = acc[ai][bj][m][n][i] * g[n * 4 + i];
                    if (ctxp) { float* ms = MS3 + ((size_t)seg * 256 + row) * DM + col; *(f32x4*)ms = (f32x4){v[0], v[1], v[2], v[3]}; *(f32x4*)(ms + 4) = (f32x4){v[4], v[5], v[6], v[7]}; }
                    else if (seg < 2) { acc[ai][bj][m][0] = (f32x4){v[0], v[1], v[2], v[3]}; acc[ai][bj][m][1] = (f32x4){v[4], v[5], v[6], v[7]}; }
                    else { u32x4 w; w.x = cvt_pk_bf16(v[0], v[1]); w.y = cvt_pk_bf16(v[2], v[3]); w.z = cvt_pk_bf16(v[4], v[5]); w.w = cvt_pk_bf16(v[6], v[7]); *(u32x4*)(Y + row * DM + col) = w; } }
            asm volatile("" ::: "memory");
        }
    }
};
}

constexpr int TSTR = 68, TSCR_BYTES = 64 * TSTR * 4;
__device__ __forceinline__ void transpose_item(const float* __restrict__ W, size_t ldw, int K, int k0, int srccol0, bf16* WT, int dstrow0, LAS float* scr, int lane) {
    const int r4 = lane >> 4, c16 = lane & 15;
    f32x4 v[16];
#pragma unroll
    for (int i = 0; i < 16; ++i) v[i] = __builtin_nontemporal_load((const f32x4*)(W + (size_t)(k0 + 4 * i + r4) * ldw + srccol0 + 4 * c16));
#pragma unroll
    for (int i = 0; i < 16; ++i) *(LAS f32x4*)(scr + (4 * i + r4) * TSTR + 4 * c16) = v[i];
    LDS_WAIT(); asm volatile("" ::: "memory");
    const int c = lane & 7;
#pragma unroll
    for (int j = 0; j < 8; ++j) { const int n = (lane >> 3) + 8 * j; const LAS float* sp = scr + (8 * c) * TSTR + n;
        v4u o; o.x = pk2(sp[0 * TSTR], sp[1 * TSTR]); o.y = pk2(sp[2 * TSTR], sp[3 * TSTR]); o.z = pk2(sp[4 * TSTR], sp[5 * TSTR]); o.w = pk2(sp[6 * TSTR], sp[7 * TSTR]);
        __builtin_nontemporal_store(o, (GAS v4u*)(WT + (size_t)(dstrow0 + n) * K + k0 + 8 * c)); }
    LDS_WAIT(); asm volatile("" ::: "memory");
}

struct Ptrs {
    const float *x, *c, *ctx, *c_ctx, *ada_down, *ada_up, *ada_bias, *norm_g, *w13, *w2, *w_in, *gmlp_norm_g, *gmlp_ws, *gmlp_bs, *gate_b, *mlstm_norm_g, *diff_lambda, *diff_norm_g, *w_branch, *w_out, *final_g;
    float* out; unsigned char* ws;
};

constexpr int IT_W13 = 2 * 64 * 128, IT_W2 = 2 * 64 * 64, IT_WIN = 64 * 320, IT_WB = 3 * 16 * 64, IT_WO = 64 * 64, IT_LAYER = IT_W13 + IT_W2 + IT_WIN + IT_WB + IT_WO;

__device__ __forceinline__ void convert_range(const Ptrs& P, int l, int it_lo, int it_hi, int widx, int nw, LAS float* scr, int lane) {
    unsigned char* ws = P.ws;
    for (int it = it_lo + widx; it < it_hi; it += nw) {
        int r = it;
        if (r < IT_W13) { const int s = r / (64 * 128), q = r % (64 * 128), kb = q / 128, nb = q % 128, dr = nb * 64, tile = dr >> 8, within = dr & 255;
            const int src = within < 128 ? tile * 128 + within : 4096 + tile * 128 + (within - 128);
            transpose_item(P.w13 + (size_t)(l * 2 + s) * 4096 * 8192, 8192, 4096, kb * 64, src, (bf16*)(ws + WS_W13T) + (size_t)(l * 2 + s) * 8192 * 4096, dr, scr, lane); continue; }
        r -= IT_W13;
        if (r < IT_W2) { const int s = r / (64 * 64), q = r % (64 * 64), kb = q / 64, nb = q % 64;
            transpose_item(P.w2 + (size_t)(l * 2 + s) * 4096 * 4096, 4096, 4096, kb * 64, nb * 64, (bf16*)(ws + WS_W2T) + (size_t)(l * 2 + s) * 4096 * 4096, nb * 64, scr, lane); continue; }
        r -= IT_W2;
        if (r < IT_WIN) { const int kb = r / 320, nb = r % 320, dr = nb * 64, src = dr < 5120 ? dr : dr + 16;
            transpose_item(P.w_in + (size_t)l * 4096 * INC, INC, 4096, kb * 64, src, (bf16*)(ws + WS_WINT) + (size_t)l * NZ * 4096, dr, scr, lane); continue; }
        r -= IT_WIN;
        if (r < IT_WB) { const int i = r / (16 * 64), q = r % (16 * 64), kb = q / 64, nb = q % 64;
            transpose_item(P.w_branch + (size_t)(l * 3 + i) * 1024 * 4096, 4096, 1024, kb * 64, nb * 64, (bf16*)(ws + WS_WBT) + (size_t)(l * 3 + i) * 4096 * 1024, nb * 64, scr, lane); continue; }
        r -= IT_WB;
        { const int kb = r / 64, nb = r % 64;
            transpose_item(P.w_out + (size_t)l * 4096 * 4096, 4096, 4096, kb * 64, nb * 64, (bf16*)(ws + WS_WOT) + (size_t)l * 4096 * 4096, nb * 64, scr, lane); }
    }
}
constexpr int CV_FRAC_NUM = 2, CV_FRAC_DEN = 10;
constexpr int CV_TOT = IT_LAYER * CV_FRAC_NUM / CV_FRAC_DEN, CV_A = CV_TOT * 2 / 5, CV_W = CV_TOT / 5;
__device__ __forceinline__ void convert_idle(const Ptrs& P, int lnext, int it_lo, int it_hi, int first_idle, LAS unsigned char* lds, int bid, int G, int tid) {
    asm volatile("" : "+v"(tid));
    if (G < first_idle + 16) first_idle = 0;
    if (lnext >= DEPTH || bid < first_idle) return;
    const int wave = tid >> 6, lane = tid & 63;
    convert_range(P, lnext, it_lo, it_hi, (bid - first_idle) * NWAVES + wave, (G - first_idle) * NWAVES, (LAS float*)(lds + RING_OFF + wave * TSCR_BYTES), lane);
}
__device__ __forceinline__ void pro0(const Ptrs& P, LAS unsigned char* lds, int bid, int G, int tid) {
    asm volatile("" : "+v"(tid));
    const int wave = tid >> 6, lane = tid & 63;
    LAS float* scr = (LAS float*)(lds + RING_OFF + wave * TSCR_BYTES);
    const int gw = bid * NWAVES + wave, NGW = G * NWAVES;
    unsigned char* ws = P.ws;
    convert_range(P, 0, 0, IT_LAYER, gw, NGW, scr, lane);
    for (int l = 1; l < DEPTH; ++l) convert_range(P, l, CV_TOT, IT_LAYER, gw, NGW, scr, lane);
    const int gt = bid * NTHR + tid, NGT = G * NTHR;
    { float* rc = (float*)(ws + WS_ROPE); float* rs = rc + SEQ * 64;
      for (int i = gt; i < SEQ * 64; i += NGT) { const int t = i >> 6, j = i & 63; const float inv = powf(10000.f, -(float)(j & 31) / 32.f);
          const float pos = (float)(j < 32 ? (t >> 6) : (t & 63)); const float ang = pos * inv; rc[i] = cosf(ang); rs[i] = sinf(ang); } }
    { float* tp = (float*)(ws + WS_MODTP);
      for (int task = gw; task < DEPTH * 2 * 4 * 64; task += NGW) { const int dc = task & 63, rg = (task >> 6) & 3, w = (task >> 8) & 1, l = task >> 9;
          const float* cv = w ? P.c_ctx : P.c; const float* dn = P.ada_down + (size_t)l * DM * ADAR + (size_t)(dc * 64) * ADAR + rg * 64 + lane;
          float wv[64]; const float cmine = cv[dc * 64 + lane], smine = cmine / (1.f + expf(-cmine));
#pragma unroll
          for (int d = 0; d < 64; ++d) wv[d] = dn[(size_t)d * ADAR];
          asm volatile("" ::: "memory");
          float acc = 0.f;
#pragma unroll
          for (int d = 0; d < 64; ++d) acc += __int_as_float(__builtin_amdgcn_readlane(__float_as_int(smine), d)) * wv[d];
          tp[((l * 2 + w) * 64 + dc) * 256 + rg * 64 + lane] = acc; } }
    if (bid == 0 && tid < DEPTH) { const float* dl = P.diff_lambda + tid * 4 * 128; float s1 = 0.f, s2 = 0.f;
        for (int i = 0; i < 128; ++i) { s1 += dl[i] * dl[128 + i]; s2 += dl[256 + i] * dl[384 + i]; }
        ((float*)(ws + WS_LAM))[tid] = expf(s1) - expf(s2) + lambda_init_f(tid); }
    { bf16* wb = (bf16*)(ws + WS_GWSB); for (int i = gt; i < DEPTH * 8 * 128 * 128; i += NGT) wb[i] = (bf16)f2bf(P.gmlp_ws[i]); }
    { bf16* wg = (bf16*)(ws + WS_WG16);
      for (int i = gt; i < DEPTH * DM * 16; i += NGT) { const int j = i & 15, d = (i >> 4) & (DM - 1), l = i >> 16;
          wg[((size_t)l * 16 + j) * DM + d] = (bf16)f2bf(P.w_in[((size_t)l * DM + d) * INC + 5120 + j]); } }
}

__device__ __forceinline__ void pro1(const Ptrs& P, LAS unsigned char* lds, int bid, int G, int tid) {
    asm volatile("" : "+v"(tid));
    LAS float* T = (LAS float*)(lds + RING_OFF);
    const float* tp = (const float*)(P.ws + WS_MODTP);
    for (int i = tid; i < DEPTH * 2 * 256; i += NTHR) { const int r = i & 255, lw = i >> 8; float s = 0.f;
        for (int dc = 0; dc < 64; ++dc) s += tp[(lw * 64 + dc) * 256 + r];
        T[i] = s; }
    __syncthreads();
    float* MOD = (float*)(P.ws + WS_MOD);
    for (int i = bid * NTHR + tid; i < DEPTH * NMOD; i += G * NTHR) { const int l = i / NMOD, n = i % NMOD;
        const float* up = P.ada_up + (size_t)l * ADAR * NMOD + n; const float b = P.ada_bias[(size_t)l * NMOD + n]; float a0 = b, a1 = b;
#pragma unroll 1
        for (int r0 = 0; r0 < ADAR; r0 += 32) { float uu[32];
#pragma unroll
            for (int k = 0; k < 32; ++k) uu[k] = up[(size_t)(r0 + k) * NMOD];
            asm volatile("" ::: "memory");
#pragma unroll
            for (int k = 0; k < 32; ++k) { a0 += T[(l * 2 + 0) * 256 + r0 + k] * uu[k]; a1 += T[(l * 2 + 1) * 256 + r0 + k] * uu[k]; } }
        MOD[(size_t)(l * 2 + 0) * NMOD + n] = a0; MOD[(size_t)(l * 2 + 1) * NMOD + n] = a1; }
    __syncthreads();
}

__device__ __forceinline__ void phase_norm(float* XR, const float* rdl, const float* rdc, const float* prec, const float* g, const float* modl, const float* modc, bf16* H, const float* slab, const float* cgate, float cf, LAS unsigned char* lds, int bid, int G, int tid) {
    asm volatile("" : "+v"(tid));
    const int wave = tid >> 6, lane = tid & 63;
    LAS f32x4* AL = (LAS f32x4*)lds; LAS f32x4* SL = AL + 1024; LAS f32x4* AC = AL + 2048; LAS f32x4* SC = AL + 3072;
    { f32x4 q[2][5];
#pragma unroll
      for (int k = 0; k < 2; ++k) { const int i = tid + k * NTHR; q[k][0] = ((const f32x4*)g)[i]; q[k][1] = ((const f32x4*)(modl + DM))[i]; q[k][2] = ((const f32x4*)modl)[i]; q[k][3] = ((const f32x4*)(modc + DM))[i]; q[k][4] = ((const f32x4*)modc)[i]; }
      asm volatile("" ::: "memory");
#pragma unroll
      for (int k = 0; k < 2; ++k) { const int i = tid + k * NTHR; AL[i] = q[k][0] * (q[k][1] + 1.f); SL[i] = q[k][2]; AC[i] = q[k][0] * (q[k][3] + 1.f); SC[i] = q[k][4]; } }
    const int row0 = bid * NWAVES + wave, stride = G * NWAVES;
    if (slab && row0 < CTXL) {
        f32x4* xw = (f32x4*)(XR + (size_t)row0 * DM) + lane; const f32x4* xpre = (const f32x4*)(prec + (size_t)row0 * DM) + lane; const f32x4* sp = (const f32x4*)(slab + (size_t)row0 * DM) + lane; const f32x4* gp = (const f32x4*)cgate + lane;
#pragma unroll 1
        for (int j = 0; j < 16; j += 2) { f32x4 q[2][16], xo[2];
#pragma unroll
            for (int jj = 0; jj < 2; ++jj) { xo[jj] = xpre[64 * (j + jj)];
#pragma unroll
                for (int kc = 0; kc < 16; ++kc) q[jj][kc] = sp[(size_t)kc * 256 * (DM / 4) + 64 * (j + jj)]; }
            asm volatile("" ::: "memory");
#pragma unroll
            for (int jj = 0; jj < 2; ++jj) { f32x4 a = (f32x4){0.f, 0.f, 0.f, 0.f};
#pragma unroll
                for (int kc = 0; kc < 16; ++kc) a += q[jj][kc];
                xw[64 * (j + jj)] = xo[jj] + a * gp[64 * (j + jj)] * cf; }
            asm volatile("" ::: "memory"); }
        asm volatile("s_waitcnt vmcnt(0)" ::: "memory");
    }
    __syncthreads();
    f32x4 v[16];
    if (row0 < MT) { const f32x4* xr = (const f32x4*)((row0 < CTXL ? rdc : rdl) + (size_t)row0 * DM) + lane;
#pragma unroll
        for (int j = 0; j < 16; ++j) v[j] = xr[64 * j]; }
    for (int row = row0; row < MT; row += stride) {
        f32x4 vn[16];
        if (row + stride < MT) { const f32x4* xr = (const f32x4*)(rdl + (size_t)(row + stride) * DM) + lane;
#pragma unroll
            for (int j = 0; j < 16; ++j) vn[j] = xr[64 * j]; }
        float ss = 0.f;
#pragma unroll
        for (int j = 0; j < 16; ++j) ss += (v[j].x * v[j].x + v[j].y * v[j].y) + (v[j].z * v[j].z + v[j].w * v[j].w);
        const float rstd = 1.f / sqrtf(wave_sum(ss) * (1.f / DM) + EPS);
        const LAS f32x4* Ap = row < CTXL ? AC : AL; const LAS f32x4* Sp = row < CTXL ? SC : SL;
        uint2* hr = (uint2*)(H + (size_t)row * DM) + lane;
#pragma unroll
        for (int j = 0; j < 16; ++j) { const f32x4 hv = v[j] * rstd * Ap[lane + 64 * j] + Sp[lane + 64 * j];
            uint2 o; o.x = pk2(hv.x, hv.y); o.y = pk2(hv.z, hv.w); hr[64 * j] = o; }
#pragma unroll
        for (int j = 0; j < 16; ++j) v[j] = vn[j];
    }
    __syncthreads();
}
typedef float f32x4g __attribute__((ext_vector_type(4)));
__device__ __forceinline__ void gates_unit(const bf16* H, const bf16* WGb, float* G16, int jb, int tid) {
    asm volatile("" : "+v"(tid));
    const int wave = tid >> 6, lane = tid & 63, fr = lane & 15, fq = lane >> 4;
    const bf16* ap = H + (size_t)(jb * 128 + wave * 16 + fr) * DM + 8 * fq; const bf16* bp = WGb + (size_t)fr * DM + 8 * fq;
    f32x4g acc[4];
#pragma unroll
    for (int i = 0; i < 4; ++i) acc[i] = (f32x4g){0.f, 0.f, 0.f, 0.f};
#pragma unroll 1
    for (int k = 0; k < DM; k += 512) { bf16x8 af[16], bfv[16];
#pragma unroll
        for (int i = 0; i < 16; ++i) { af[i] = *(const bf16x8*)(ap + k + 32 * i); bfv[i] = *(const bf16x8*)(bp + k + 32 * i); }
        asm volatile("" ::: "memory");
#pragma unroll
        for (int i = 0; i < 16; ++i) acc[i & 3] = __builtin_amdgcn_mfma_f32_16x16x32_bf16(af[i], bfv[i], acc[i & 3], 0, 0, 0);
    }
    const f32x4g sres = (acc[0] + acc[1]) + (acc[2] + acc[3]);
#pragma unroll
    for (int r = 0; r < 4; ++r) G16[(size_t)(jb * 128 + wave * 16 + 4 * fq + r) * 16 + fr] = sres[r];
}

__device__ __forceinline__ void phase_final(const float* XR, const float* g, float* out, int bid, int G, int tid) {
    asm volatile("" : "+v"(tid));
    const int wave = tid >> 6, lane = tid & 63;
    f32x4 gg[16];
#pragma unroll
    for (int j = 0; j < 16; ++j) gg[j] = *(const f32x4*)(g + 4 * lane + 256 * j);
    for (int t = bid * NWAVES + wave; t < SEQ; t += G * NWAVES) {
        const f32x4* xr = (const f32x4*)(XR + (size_t)(CTXL + t) * DM) + lane;
        f32x4 v[16]; float ss = 0.f;
#pragma unroll
        for (int j = 0; j < 16; ++j) { v[j] = xr[64 * j]; ss += (v[j].x * v[j].x + v[j].y * v[j].y) + (v[j].z * v[j].z + v[j].w * v[j].w); }
        const float rstd = 1.f / sqrtf(wave_sum(ss) * (1.f / DM) + EPS);
        f32x4* o = (f32x4*)(out + (size_t)t * DM) + lane;
#pragma unroll
        for (int j = 0; j < 16; ++j) o[64 * j] = v[j] * rstd * gg[j];
    }
}

typedef short s16x4 __attribute__((ext_vector_type(4)));
typedef float f32x16 __attribute__((ext_vector_type(16)));
typedef short v4i16_t __attribute__((ext_vector_type(4)));
__device__ __forceinline__ int crow16(int r, int hi) { return (r & 3) + 8 * (r >> 2) + 4 * hi; }
__device__ __forceinline__ int chain_cidx(int dir, int jb) { return dir ? (jb < 2 ? 1 - jb : 67 - jb) : jb; }
__device__ __forceinline__ s16x4 trr(LAS const unsigned char* p) { return __builtin_bit_cast(s16x4, __builtin_amdgcn_ds_read_tr16_b64_v4i16((LAS v4i16_t*)p)); }
__device__ __forceinline__ bf16x8 trfrag(LAS const unsigned char* im, int RS, int rowA, int rowB, int n0, int lane) {
    const int i = lane & 15, q = i >> 2, p = i & 3, cb = n0 + 16 * ((lane >> 4) & 1) + 4 * p;
    const s16x4 lo = trr(im + (rowA + q) * RS + cb * 2), hi = trr(im + (rowB + q) * RS + cb * 2);
    return (bf16x8){lo[0], lo[1], lo[2], lo[3], hi[0], hi[1], hi[2], hi[3]};
}
constexpr int VSTR = 528, KW_OFF = 67584;
constexpr int SM_OFF = 133120;
__device__ __forceinline__ void gate_scan(const float* G16, const float* gate_b, int jb, int h, LAS float* SM, int tid) {
    LAS float* SC = SM + 768;
    const int dir = (tid >> 7) & 1, c = tid & 127, o = dir ? 127 - c : c; const bool act = tid < 256;
    float ip = 0.f, x = 0.f;
    if (act) { const size_t row = (size_t)jb * 128 + o; ip = G16[row * 16 + dir * 8 + h] + gate_b[dir * 8 + h]; const float fp = G16[row * 16 + dir * 8 + 4 + h] + gate_b[dir * 8 + 4 + h];
        x = fminf(fp, 0.f) - __logf(1.f + __expf(-fabsf(fp))); }
    for (int s = 1; s < 128; s <<= 1) { if (act) SC[dir * 128 + c] = x; __syncthreads(); if (act && c >= s) x += SC[dir * 128 + c - s]; __syncthreads(); }
    const float b = x, u = ip - b; float y = u;
    for (int s = 1; s < 128; s <<= 1) { if (act) SC[dir * 128 + c] = y; __syncthreads(); if (act && c >= s) y = fmaxf(y, SC[dir * 128 + c - s]); __syncthreads(); }
    if (act) { SM[dir * 128 + o] = u; SM[256 + dir * 128 + o] = y; SM[512 + dir * 128 + o] = b; if (c == 127) { SM[1024 + dir] = b; SM[1026 + dir] = y; } }
    __syncthreads();
}
__device__ __forceinline__ void stage_v(const bf16* Z, size_t row0, int h, LAS unsigned char* VL, int tid) {
    v4u t[8];
#pragma unroll
    for (int k = 0; k < 8; ++k) { const int i = tid + k * NTHR, sr = i >> 5, ch = i & 31; t[k] = *(const v4u*)(Z + (size_t)MT * ZC_MV + (row0 + sr) * 1024 + h * 256 + ch * 8); }
    asm volatile("" ::: "memory");
#pragma unroll
    for (int k = 0; k < 8; ++k) { const int i = tid + k * NTHR, sr = i >> 5, ch = i & 31; *(LAS v4u*)(VL + sr * VSTR + ch * 16) = t[k]; }
}
__device__ __forceinline__ void mlstm_m1_unit(const bf16* Z, const float* G16, const float* gate_b, float* DCT, float* DN, float* CH, int jb, int h, LAS unsigned char* lds, int tid) {
    asm volatile("" : "+v"(tid));
    const int wave = tid >> 6, lane = tid & 63, hh = lane >> 5;
    LAS unsigned char* VL = lds; LAS unsigned char* KW = lds + KW_OFF; LAS float* SM = (LAS float*)(lds + SM_OFF);
    gate_scan(G16, gate_b, jb, h, SM, tid);
    const size_t row0 = (size_t)jb * 128;
    stage_v(Z, row0, h, VL, tid);
    { v4u kq[4];
#pragma unroll
      for (int k = 0; k < 4; ++k) { const int i = tid + k * NTHR, sr = i >> 4, ch = i & 15; kq[k] = *(const v4u*)(Z + (size_t)MT * ZC_MK + (row0 + sr) * 512 + h * 128 + ch * 8); }
      asm volatile("" ::: "memory");
#pragma unroll
      for (int k = 0; k < 4; ++k) { const int i = tid + k * NTHR, sr = i >> 4, ch = i & 15; const v4u kw = kq[k];
#pragma unroll
        for (int dir = 0; dir < 2; ++dir) { const float wg = __expf(SM[dir * 128 + sr] - SM[1026 + dir]); v4u o;
            o.x = pk2(bflo(kw.x) * wg, bfhi(kw.x) * wg); o.y = pk2(bflo(kw.y) * wg, bfhi(kw.y) * wg); o.z = pk2(bflo(kw.z) * wg, bfhi(kw.z) * wg); o.w = pk2(bflo(kw.w) * wg, bfhi(kw.w) * wg);
            *(LAS v4u*)(KW + dir * 32768 + sr * 256 + ch * 16) = o; } } }
    __syncthreads();
    const int dir = wave >> 2, ebp = wave & 3;
    f32x16 acc[2][4];
#pragma unroll
    for (int a = 0; a < 2; ++a)
#pragma unroll
        for (int b = 0; b < 4; ++b)
#pragma unroll
            for (int r = 0; r < 16; ++r) acc[a][b][r] = 0.f;
#pragma unroll 2
    for (int ks = 0; ks < 8; ++ks) {
        bf16x8 af[2], bfr[4];
#pragma unroll
        for (int eb = 0; eb < 2; ++eb) af[eb] = trfrag(VL, VSTR, 16 * ks + 8 * hh, 16 * ks + 8 * hh + 4, 32 * (2 * ebp + eb), lane);
#pragma unroll
        for (int db = 0; db < 4; ++db) bfr[db] = trfrag(KW + dir * 32768, 256, 16 * ks + 8 * hh, 16 * ks + 8 * hh + 4, 32 * db, lane);
#pragma unroll
        for (int eb = 0; eb < 2; ++eb)
#pragma unroll
            for (int db = 0; db < 4; ++db) acc[eb][db] = __builtin_amdgcn_mfma_f32_32x32x16_bf16(af[eb], bfr[db], acc[eb][db], 0, 0, 0);
    }
    { const int cidx = chain_cidx(dir, jb); float* dst = DCT + (size_t)((dir * 4 + h) * 66 + cidx) * 32768;
#pragma unroll
      for (int eb = 0; eb < 2; ++eb)
#pragma unroll
          for (int db = 0; db < 4; ++db)
#pragma unroll
              for (int r = 0; r < 16; ++r) dst[(32 * (2 * ebp + eb) + crow16(r, hh)) * 128 + 32 * db + (lane & 31)] = acc[eb][db][r]; }
    if (tid < 256) { const int dd = tid >> 7, d = tid & 127; float s = 0.f;
        for (int sg = 0; sg < 128; ++sg) s += bf2f(*(LAS const unsigned short*)(KW + dd * 32768 + sg * 256 + d * 2));
        DN[(size_t)((dd * 4 + h) * 66 + chain_cidx(dd, jb)) * 128 + d] = s; }
    if (tid < 2) { float* c = CH + (size_t)((tid * 4 + h) * 66 + chain_cidx(tid, jb)) * 2; c[0] = SM[1024 + tid]; c[1] = SM[1026 + tid]; }
    __syncthreads();
}
__device__ __forceinline__ void mlstm_m2_scalars(const float* CH, int chain, LAS float* SC, int tid) {
    if (tid < 66) { SC[256 + 2 * tid] = CH[(size_t)(chain * 66 + tid) * 2]; SC[256 + 2 * tid + 1] = CH[(size_t)(chain * 66 + tid) * 2 + 1]; }
    __syncthreads();
    if (tid == 0) { float m = 0.f;
        for (int j = 0; j < 66; ++j) { const float Bj = SC[256 + 2 * j], cm = SC[256 + 2 * j + 1], Mx = fmaxf(m, cm); SC[3 * j] = __expf(m - Mx); SC[3 * j + 1] = __expf(cm - Mx); SC[3 * j + 2] = m; m = Bj + Mx; } }
    __syncthreads();
}
__device__ __forceinline__ void mlstm_m2(const float* DCT, const float* DN, const float* CH, bf16* CT, float* NS, float* MS, LAS unsigned char* lds, int bid, int G, int tid) {
    asm volatile("" : "+v"(tid));
    LAS float* SC = (LAS float*)lds;
    for (int base = bid * NTHR; base < 8 * 16384; base += G * NTHR) {
        const int chain = base >> 14, p = (base & 16383) + tid;
        mlstm_m2_scalars(CH, chain, SC, tid);
        if ((base & 16383) == 0 && tid < 66) MS[chain * 66 + tid] = SC[3 * tid + 2];
        const float* dl = DCT + (size_t)chain * 66 * 32768 + 2 * p; unsigned* ct = (unsigned*)(CT + (size_t)chain * 66 * 32768 + 2 * p);
        float c0 = 0.f, c1 = 0.f;
#pragma unroll 1
        for (int jb = 0; jb < 66; jb += 11) { float2 d[11];
#pragma unroll
            for (int k = 0; k < 11; ++k) d[k] = *(const float2*)(dl + (size_t)(jb + k) * 32768);
            asm volatile("" ::: "memory");
#pragma unroll
            for (int k = 0; k < 11; ++k) { const float dec = SC[3 * (jb + k)], sc = SC[3 * (jb + k) + 1]; ct[(size_t)(jb + k) * 16384] = pk2(c0, c1); c0 = dec * c0 + sc * d[k].x; c1 = dec * c1 + sc * d[k].y; }
            asm volatile("" ::: "memory"); }
        __syncthreads();
    }
    for (int chain = bid; chain < 8; chain += G) {
        mlstm_m2_scalars(CH, chain, SC, tid);
        if (tid < 128) { float c0 = 0.f;
#pragma unroll 1
            for (int jb = 0; jb < 66; jb += 11) { float d[11];
#pragma unroll
                for (int k = 0; k < 11; ++k) d[k] = DN[(size_t)(chain * 66 + jb + k) * 128 + tid];
                asm volatile("" ::: "memory");
#pragma unroll
                for (int k = 0; k < 11; ++k) { NS[(size_t)(chain * 66 + jb + k) * 128 + tid] = c0; c0 = SC[3 * (jb + k)] * c0 + SC[3 * (jb + k) + 1] * d[k]; }
                asm volatile("" ::: "memory"); } }
        __syncthreads();
    }
}
__device__ __forceinline__ void mlstm_m3_unit(const bf16* Z, const float* G16, const float* gate_b, const bf16* CT, const float* NS, const float* MS, const float* mng, bf16* YB, int jb, int h, LAS unsigned char* lds, int tid) {
    asm volatile("" : "+v"(tid));
    const int wave = tid >> 6, lane = tid & 63, hh = lane >> 5, l31 = lane & 31;
    LAS unsigned char* VL = lds; LAS float* XCH = (LAS float*)lds; LAS float* SM = (LAS float*)(lds + SM_OFF);
    gate_scan(G16, gate_b, jb, h, SM, tid);
    const size_t row0 = (size_t)jb * 128;
    if (tid < 256) { const int dd = tid >> 7, d = tid & 127; SM[1040 + dd * 128 + d] = NS[(size_t)((dd * 4 + h) * 66 + chain_cidx(dd, jb)) * 128 + d]; }
    if (tid < 2) SM[1028 + tid] = MS[(tid * 4 + h) * 66 + chain_cidx(tid, jb)];
    stage_v(Z, row0, h, VL, tid);
    __syncthreads();
    const int tb = wave & 3, dir = wave >> 2, tau = 32 * tb + l31;
    float SCL = 0.08838834764831845f; asm volatile("" : "+v"(SCL));
    const float m = SM[1028 + dir], cmT = SM[256 + dir * 128 + tau], bT = SM[512 + dir * 128 + tau];
    const float Mt = fmaxf(m, cmT), wa = __expf(m - Mt), em = __expf(-(bT + Mt)), fa = wa * SCL;
    bf16x8 qf[8];
#pragma unroll
    for (int ks = 0; ks < 8; ++ks) qf[ks] = *(const bf16x8*)(Z + (size_t)MT * ZC_MQ + (row0 + tau) * 512 + h * 128 + 16 * ks + 8 * hh);
    f32x16 acc[8];
#pragma unroll
    for (int eb = 0; eb < 8; ++eb)
#pragma unroll
        for (int r = 0; r < 16; ++r) acc[eb][r] = 0.f;
    { const bf16* ct = CT + (size_t)((dir * 4 + h) * 66 + chain_cidx(dir, jb)) * 32768;
#pragma unroll
      for (int e2 = 0; e2 < 8; e2 += 2) { bf16x8 af[2][8];
#pragma unroll
          for (int eb = 0; eb < 2; ++eb)
#pragma unroll
              for (int ks = 0; ks < 8; ++ks) af[eb][ks] = *(const bf16x8*)(ct + (size_t)(32 * (e2 + eb) + l31) * 128 + 16 * ks + 8 * hh);
          asm volatile("" ::: "memory");
#pragma unroll
          for (int ks = 0; ks < 8; ++ks) { acc[e2] = __builtin_amdgcn_mfma_f32_32x32x16_bf16(af[0][ks], qf[ks], acc[e2], 0, 0, 0); acc[e2 + 1] = __builtin_amdgcn_mfma_f32_32x32x16_bf16(af[1][ks], qf[ks], acc[e2 + 1], 0, 0, 0); } } }
    asm volatile("" ::: "memory");
    float den = 0.f;
#pragma unroll
    for (int ks = 0; ks < 8; ++ks)
#pragma unroll
        for (int j = 0; j < 8; ++j) den += bf2f((unsigned short)qf[ks][j]) * SM[1040 + dir * 128 + 16 * ks + 8 * hh + j];
    den *= fa;
#pragma unroll
    for (int eb = 0; eb < 8; ++eb)
#pragma unroll
        for (int r = 0; r < 16; ++r) acc[eb][r] *= fa;
    asm volatile("" ::: "memory");
#pragma unroll 1
    for (int sb = 0; sb < 4; ++sb) {
        if (dir == 0 ? sb > tb : sb < tb) continue;
        asm volatile("" ::: "memory");
        f32x16 p;
#pragma unroll
        for (int r = 0; r < 16; ++r) p[r] = 0.f;
#pragma unroll
        for (int kh = 0; kh < 2; ++kh) { bf16x8 kf[4];
#pragma unroll
          for (int ks = 0; ks < 4; ++ks) kf[ks] = *(const bf16x8*)(Z + (size_t)MT * ZC_MK + (row0 + 32 * sb + l31) * 512 + h * 128 + 16 * (4 * kh + ks) + 8 * hh);
          asm volatile("" ::: "memory");
#pragma unroll
          for (int ks = 0; ks < 4; ++ks) p = __builtin_amdgcn_mfma_f32_32x32x16_bf16(kf[ks], qf[4 * kh + ks], p, 0, 0, 0); }
#pragma unroll
        for (int r = 0; r < 16; ++r) { const int sg = 32 * sb + crow16(r, hh); const bool keep = dir == 0 ? (sg <= tau) : (sg >= tau);
            const float w = keep ? __expf(SM[dir * 128 + sg] - Mt) * SCL : 0.f; p[r] *= w; den += p[r]; }
#pragma unroll
        for (int s = 0; s < 2; ++s) {
            v4u w4; w4.x = pk2(p[8 * s + 0], p[8 * s + 1]); w4.y = pk2(p[8 * s + 2], p[8 * s + 3]); w4.z = pk2(p[8 * s + 4], p[8 * s + 5]); w4.w = pk2(p[8 * s + 6], p[8 * s + 7]);
            const bf16x8 bfrag = __builtin_bit_cast(bf16x8, w4);
#pragma unroll
            for (int eb = 0; eb < 8; ++eb) { const bf16x8 a = trfrag(VL, VSTR, 32 * sb + 16 * s + 4 * hh, 32 * sb + 16 * s + 8 + 4 * hh, 32 * eb, lane);
                acc[eb] = __builtin_amdgcn_mfma_f32_32x32x16_bf16(a, bfrag, acc[eb], 0, 0, 0);
                if (eb & 1) { asm volatile("" ::: "memory"); } }
        }
    }
    den += shfl_xor_f(den, 32);
    { const float inv = 1.f / fmaxf(fabsf(den), em);
#pragma unroll
      for (int eb = 0; eb < 8; ++eb)
#pragma unroll
          for (int r = 0; r < 16; ++r) acc[eb][r] *= inv; }
    __syncthreads();
    LAS float* HS = (LAS float*)lds;
    if (dir == 1) {
#pragma unroll
        for (int eb = 0; eb < 8; ++eb)
#pragma unroll
            for (int r = 0; r < 16; ++r) HS[tau * 257 + 32 * eb + crow16(r, hh)] = acc[eb][r];
    }
    __syncthreads();
    if (dir == 0) {
#pragma unroll
        for (int eb = 0; eb < 8; ++eb)
#pragma unroll
            for (int r = 0; r < 16; ++r) HS[tau * 257 + 32 * eb + crow16(r, hh)] += acc[eb][r];
    }
    __syncthreads();
    {
        unsigned short og[16][4]; float gn[4];
#pragma unroll
        for (int rr = 0; rr < 16; ++rr)
#pragma unroll
            for (int k = 0; k < 4; ++k) og[rr][k] = Z[(size_t)MT * ZC_MO + (row0 + wave * 16 + rr) * 1024 + h * 256 + 64 * k + lane];
#pragma unroll
        for (int k = 0; k < 4; ++k) gn[k] = mng[h * 256 + 64 * k + lane];
#pragma unroll
        for (int rr = 0; rr < 16; ++rr) { const int t2 = wave * 16 + rr; float v[4]; float ss = 0.f;
#pragma unroll
            for (int k = 0; k < 4; ++k) { v[k] = HS[t2 * 257 + 64 * k + lane]; ss += v[k] * v[k]; }
            const float rstd = 1.f / sqrtf(wave_sum(ss) * (1.f / 256.f) + EPS); const size_t row = row0 + t2;
#pragma unroll
            for (int k = 0; k < 4; ++k) YB[row * 1024 + h * 256 + 64 * k + lane] = (bf16)f2bf(bf2f(og[rr][k]) * v[k] * rstd * gn[k]); }
    }
    __syncthreads();
}
__device__ __forceinline__ void gmlp_unit_mfma(const bf16* Z, const float* gng, const bf16* wsb  , const float* bs  , bf16* YA, int j, LAS unsigned char* lds, int tid) {
    asm volatile("" : "+v"(tid));
    const int wave = tid >> 6, lane = tid & 63, g = wave;
    LAS float* ST = (LAS float*)(lds + SM_OFF);
    LAS float* BSL = ST + 256;
    BSL[tid] = bs[tid]; BSL[tid + NTHR] = bs[tid + NTHR];
    LAS unsigned char* VN = lds + wave * 16384;
    const size_t row0 = (size_t)j * 128;
#pragma unroll 1
    for (int rb = 0; rb < 16; rb += 4) { v4u wq[4][2];
#pragma unroll
        for (int r4 = 0; r4 < 4; ++r4) { const v4u* zp = (const v4u*)(Z + (row0 + wave * 16 + rb + r4) * 2048 + 1024 + lane * 16); wq[r4][0] = zp[0]; wq[r4][1] = zp[1]; }
        asm volatile("" ::: "memory");
#pragma unroll
        for (int r4 = 0; r4 < 4; ++r4) { const int q = wave * 16 + rb + r4; const v4u w0 = wq[r4][0], w1 = wq[r4][1];
            float x[16]; const unsigned ww[8] = {w0.x, w0.y, w0.z, w0.w, w1.x, w1.y, w1.z, w1.w};
            float s = 0.f;
#pragma unroll
            for (int k = 0; k < 8; ++k) { x[2 * k] = bflo(ww[k]); x[2 * k + 1] = bfhi(ww[k]); s += x[2 * k] + x[2 * k + 1]; }
            const float mean = wave_sum(s) * (1.f / 1024.f); float s2 = 0.f;
#pragma unroll
            for (int k = 0; k < 16; ++k) { const float d = x[k] - mean; s2 += d * d; }
            const float rstd = 1.f / sqrtf(wave_sum(s2) * (1.f / 1024.f) + EPS);
            if (lane == 0) { ST[2 * q] = mean; ST[2 * q + 1] = rstd; } } }
    __syncthreads();
#pragma unroll 1
    for (int h = 0; h < 2; ++h) {
        const int ln = mk_lane_id(), hh = ln >> 5, l31 = ln & 31;
        const int cbase = g * 128 + 64 * h, c8 = (ln & 7) * 8;
        { const f32x4 g0 = *(const f32x4*)(gng + cbase + c8), g1 = *(const f32x4*)(gng + cbase + c8 + 4);
#pragma unroll 1
          for (int ib = 0; ib < 16; ib += 4) { v4u wv[4];
#pragma unroll
            for (int i4 = 0; i4 < 4; ++i4) wv[i4] = *(const v4u*)(Z + (row0 + (ib + i4) * 8 + (ln >> 3)) * 2048 + 1024 + cbase + c8);
            asm volatile("" ::: "memory");
#pragma unroll
            for (int i4 = 0; i4 < 4; ++i4) { const int q = (ib + i4) * 8 + (ln >> 3); const float mean = ST[2 * q], rstd = ST[2 * q + 1]; const v4u w = wv[i4]; v4u o;
              o.x = pk2((bflo(w.x) - mean) * rstd * g0.x, (bfhi(w.x) - mean) * rstd * g0.y); o.y = pk2((bflo(w.y) - mean) * rstd * g0.z, (bfhi(w.y) - mean) * rstd * g0.w);
              o.z = pk2((bflo(w.z) - mean) * rstd * g1.x, (bfhi(w.z) - mean) * rstd * g1.y); o.w = pk2((bflo(w.w) - mean) * rstd * g1.z, (bfhi(w.w) - mean) * rstd * g1.w);
              *(LAS v4u*)(VN + q * 128 + (ln & 7) * 16) = o; } } }
        LDS_WAIT(); asm volatile("" ::: "memory");
        bf16x8 bfr[8][2];
#pragma unroll
        for (int ks = 0; ks < 8; ++ks)
#pragma unroll
            for (int cb = 0; cb < 2; ++cb) bfr[ks][cb] = trfrag(VN, 128, 16 * ks + 8 * hh, 16 * ks + 8 * hh + 4, 32 * cb, ln);
        f32x16 acc[4][2];
#pragma unroll
        for (int pb = 0; pb < 4; ++pb)
#pragma unroll
            for (int cb = 0; cb < 2; ++cb)
#pragma unroll
                for (int r = 0; r < 16; ++r) acc[pb][cb][r] = 0.f;
#pragma unroll
        for (int pb = 0; pb < 4; ++pb) {
            bf16x8 af[8];
#pragma unroll
            for (int ks = 0; ks < 8; ++ks) af[ks] = *(const bf16x8*)(wsb + (size_t)(g * 128 + 32 * pb + l31) * 128 + 16 * ks + 8 * hh);
            asm volatile("" ::: "memory");
#pragma unroll
            for (int ks = 0; ks < 8; ++ks) { acc[pb][0] = __builtin_amdgcn_mfma_f32_32x32x16_bf16(af[ks], bfr[ks][0], acc[pb][0], 0, 0, 0); acc[pb][1] = __builtin_amdgcn_mfma_f32_32x32x16_bf16(af[ks], bfr[ks][1], acc[pb][1], 0, 0, 0); }
            asm volatile("" ::: "memory");
        }
        LDS_WAIT(); asm volatile("" ::: "memory");
#pragma unroll
        for (int pb = 0; pb < 4; ++pb)
#pragma unroll
            for (int q4 = 0; q4 < 4; ++q4) { const f32x4 b4 = *(const LAS f32x4*)(BSL + g * 128 + 32 * pb + 8 * q4 + 4 * hh);
#pragma unroll
                for (int i = 0; i < 4; ++i) { const int r = 4 * q4 + i, p = 32 * pb + 8 * q4 + 4 * hh + i;
#pragma unroll
                    for (int cb = 0; cb < 2; ++cb) *(LAS unsigned short*)(VN + p * 128 + (32 * cb + l31) * 2) = (unsigned short)f2bf(acc[pb][cb][r] + b4[i]); } }
        LDS_WAIT(); asm volatile("" ::: "memory");
#pragma unroll 1
        for (int ib = 0; ib < 16; ib += 4) { v4u uq[4];
#pragma unroll
            for (int i4 = 0; i4 < 4; ++i4) uq[i4] = *(const v4u*)(Z + (row0 + (ib + i4) * 8 + (ln >> 3)) * 2048 + cbase + c8);
            asm volatile("" ::: "memory");
#pragma unroll
            for (int i4 = 0; i4 < 4; ++i4) { const int p = (ib + i4) * 8 + (ln >> 3); const v4u m = *(const LAS v4u*)(VN + p * 128 + (ln & 7) * 16); const v4u u = uq[i4]; v4u o;
                o.x = pk2(bflo(u.x) * bflo(m.x), bfhi(u.x) * bfhi(m.x)); o.y = pk2(bflo(u.y) * bflo(m.y), bfhi(u.y) * bfhi(m.y));
                o.z = pk2(bflo(u.z) * bflo(m.z), bfhi(u.z) * bfhi(m.z)); o.w = pk2(bflo(u.w) * bflo(m.w), bfhi(u.w) * bfhi(m.w));
                *(v4u*)(YA + (row0 + p) * 1024 + cbase + c8) = o; } }
        LDS_WAIT(); asm volatile("" ::: "memory");
    }
    __syncthreads();
}

__device__ __forceinline__ void phase_post(const float* ATTO, const float* MLH, const bf16* Z, const float* dng, const float* mng, float lam, float linit, bf16* YB, bf16* YC, int bid, int G, int tid) {
    asm volatile("" : "+v"(tid));
    const int wave = tid >> 6, lane = tid & 63, head = lane >> 4, e0 = (lane & 15) * 16;
    for (int row = bid * NWAVES + wave; row < MT; row += G * NWAVES) {
        const size_t off = (size_t)row * 1024 + head * 256 + e0;
        {
            const f32x4* a0 = (const f32x4*)(ATTO + off); const f32x4* a1 = (const f32x4*)(ATTO + (size_t)MT * 1024 + off);
            float o[16]; float ss = 0.f;
#pragma unroll
            for (int k = 0; k < 4; ++k) { const f32x4 p = a0[k], q = a1[k];
                o[4 * k + 0] = p.x - lam * q.x; o[4 * k + 1] = p.y - lam * q.y; o[4 * k + 2] = p.z - lam * q.z; o[4 * k + 3] = p.w - lam * q.w; }
#pragma unroll
            for (int k = 0; k < 16; ++k) ss += o[k] * o[k];
            ss += shfl_xor_f(ss, 1); ss += shfl_xor_f(ss, 2); ss += shfl_xor_f(ss, 4); ss += shfl_xor_f(ss, 8);
            const float rstd = 1.f / sqrtf(ss * (1.f / 256.f) + EPS) * (1.f - linit);
            v4u w0, w1;
            w0.x = pk2(o[0] * rstd * dng[e0 + 0], o[1] * rstd * dng[e0 + 1]); w0.y = pk2(o[2] * rstd * dng[e0 + 2], o[3] * rstd * dng[e0 + 3]);
            w0.z = pk2(o[4] * rstd * dng[e0 + 4], o[5] * rstd * dng[e0 + 5]); w0.w = pk2(o[6] * rstd * dng[e0 + 6], o[7] * rstd * dng[e0 + 7]);
            w1.x = pk2(o[8] * rstd * dng[e0 + 8], o[9] * rstd * dng[e0 + 9]); w1.y = pk2(o[10] * rstd * dng[e0 + 10], o[11] * rstd * dng[e0 + 11]);
            w1.z = pk2(o[12] * rstd * dng[e0 + 12], o[13] * rstd * dng[e0 + 13]); w1.w = pk2(o[14] * rstd * dng[e0 + 14], o[15] * rstd * dng[e0 + 15]);
            v4u* yp = (v4u*)(YC + off); yp[0] = w0; yp[1] = w1;
        }
    }
}

struct Args { const float* in[21]; float* out; unsigned char* ws; int ph_lo, ph_hi; };
static_assert(sizeof(Args) == 21 * 8 + 8 + 8 + 8, "Args has no padding");

constexpr int T_ALL = -1, T_PRO0 = 0, T_PRO1 = 1, T_NORM = 2, T_W13 = 3, T_W2 = 4, T_N2 = 5, T_WIN = 6, T_ROPE = 7, T_MLSTM = 8, T_POST = 9, T_MERGE0 = 10, T_WOUT = 11, T_FINAL = 12, T_ATTN = 13, T_GMLP = 14, T_MERGE1 = 15, T_MERGE2 = 16, T_M3 = 17, NTYPES = 18;
#define SELD(t) (SEL == T_ALL || SEL == (t))
template <int SEL> __global__ void __launch_bounds__(NTHR, 2) mk_fwd(Args args) {
    extern __shared__ __attribute__((aligned(16))) unsigned char lds_raw[];
    LAS unsigned char* lds = (LAS unsigned char*)lds_raw;
    volatile LAS unsigned* MISC = (volatile LAS unsigned*)(lds + MISC_OFF);
    const int wave_s = __builtin_amdgcn_readfirstlane((int)threadIdx.x >> 6), bid_k = blockIdx.x, G = gridDim.x;
#define tid MK_TID(wave_s)
#define KARGS ((const __attribute__((address_space(4))) Args*)ka_)
#define PHASE_BEGIN const __attribute__((address_space(4))) void* ka_ = (const __attribute__((address_space(4))) void*)__builtin_amdgcn_kernarg_segment_ptr(); asm volatile("" : "+s"(ka_)); unsigned char* const ws = KARGS->ws; (void)ws; int bid = bid_k; asm volatile("" : "+s"(bid))
#define PIN(i) (KARGS->in[i])
#define XR ((float*)(ws + WS_XR))
#define H ((bf16*)(ws + WS_H))
#define GB ((bf16*)(ws + WS_GB))
#define Z ((bf16*)(ws + WS_Z))
#define ATTO ((float*)(ws + WS_ATTO))
#define MLH ((float*)(ws + WS_MLH))
#define DCT ((float*)(ws + WS_MLH))
#define YA ((bf16*)(ws + WS_YA))
#define YB ((bf16*)(ws + WS_YB))
#define YC ((bf16*)(ws + WS_YC))
#define SLAB ((float*)(ws + WS_SLAB))
#define YACC ((float*)(ws + WS_YACC))
#define Y ((bf16*)(ws + WS_Y))
#define G16 ((float*)(ws + WS_G16))
#define MOD ((const float*)(ws + WS_MOD))
#define CTS ((bf16*)(ws + WS_CT))
#define DNS ((float*)(ws + WS_MSM))
#define NSS (DNS + 8 * 66 * 128)
#define CHS (NSS + 8 * 66 * 128)
#define MSS (CHS + 8 * 66 * 2)
#define modl (MOD + (size_t)(l * 2 + 0) * NMOD)
#define modc (MOD + (size_t)(l * 2 + 1) * NMOD)
#define W13T0 ((const bf16*)(ws + WS_W13T) + (size_t)(l * 2 + 0) * 8192 * 4096)
#define W13T1 (W13T0 + (size_t)8192 * 4096)
#define W2T0 ((const bf16*)(ws + WS_W2T) + (size_t)(l * 2 + 0) * 4096 * 4096)
#define W2T1 (W2T0 + (size_t)4096 * 4096)
#define WINT ((const bf16*)(ws + WS_WINT) + (size_t)l * NZ * 4096)
#define WBT ((const bf16*)(ws + WS_WBT) + (size_t)(l * 3) * 4096 * 1024)
#define WOT ((const bf16*)(ws + WS_WOT) + (size_t)l * 4096 * 4096)
#define MKP() Ptrs P; P.x = PIN(0); P.c = PIN(1); P.ctx = PIN(2); P.c_ctx = PIN(3); P.ada_down = PIN(4); P.ada_up = PIN(5); P.ada_bias = PIN(6); P.norm_g = PIN(7); \
    P.w13 = PIN(8); P.w2 = PIN(9); P.w_in = PIN(10); P.gmlp_norm_g = PIN(11); P.gmlp_ws = PIN(12); P.gmlp_bs = PIN(13); P.gate_b = PIN(14); \
    P.mlstm_norm_g = PIN(15); P.diff_lambda = PIN(16); P.diff_norm_g = PIN(17); P.w_branch = PIN(18); P.w_out = PIN(19); P.final_g = PIN(20); P.out = KARGS->out; P.ws = KARGS->ws
    for (int u = tid; u < (LDS_BYTES - LDSCTL_OFF) / 4; u += NTHR) ((LAS unsigned*)(lds + LDSCTL_OFF))[u] = 0u;
    __syncthreads();
#if MK_ONE_LAUNCH
    XcdBarrier bar = xcd_barrier_post((unsigned*)((gu32*)(args.ws + WS_CTL) + CW_BAR), MISC + 8, tid);
#define GRID_BAR() do { XcdBarrier b2_ = bar; asm volatile("" : "+s"(b2_.bar)); xcd_barrier(b2_, tid); } while (0)
#else
#define GRID_BAR() do {} while (0)
#endif
    const int lo = args.ph_lo, hi = args.ph_hi;
#define IN(k) (lo <= (k) && (k) < hi)
#define SEAM(k) do { if (IN(k) && IN((k) + 1)) GRID_BAR(); } while (0)

    if (IN(P_PRO0)) { PHASE_BEGIN; MKP(); for (int rep_ = 0; rep_ < DBL_PRO; ++rep_) pro0(P, lds, bid, G, tid); SEAM(P_PRO0); }
    if (IN(P_PRO1)) { PHASE_BEGIN; MKP(); pro1(P, lds, bid, G, tid); SEAM(P_PRO1); }

    for (int l = 0; l < DEPTH; ++l) {
        const int pb = P_LAYER0 + l * NPL;
        if (hi <= pb || lo >= pb + NPL) continue;
#define GEMM_RESID_SPLIT2(Aptr, Bptr, gate_l, fac, ms3, yc, nctx_) do { \
            { pg8::Gemm g{(Aptr) + (size_t)CTXL * DM, (Bptr), SEQ, DM, DM, DM}; pg8::StaticOrder S; S.init(SEQ, DM, G, bid); pg8::EpiResid E{XR + (size_t)CTXL * DM, (gate_l), (gate_l), XR + (size_t)CTXL * DM, (fac)}; \
              pg8::gemm_phase<pg8::EpiResid, pg8::StaticOrder, true, true>(lds + RING_OFF, g, S, E, wave_s); } \
            { pg8::Gemm g{(Aptr), (Bptr), CTXL, DM, 256, DM}; pg8::CtxSplitOrder S{bid, G, (nctx_), (ms3), (yc), wave_s}; pg8::EpiSlab E{SLAB}; \
              pg8::gemm_phase<pg8::EpiSlab, pg8::CtxSplitOrder, true, true>(lds + RING_OFF, g, S, E, wave_s); } } while (0)
#define GEMM_RESID_SPLIT(Aptr, Bptr, gate_l, fac, ms3, yc, nctx_, xb_) do { \
            pg8::Gemm g{(Aptr), (Bptr), MT, DM, DM, DM}; pg8::ResidOrder S; S.lat.init(SEQ, DM, G, bid); S.c = bid; S.G = G; S.n = (nctx_); \
            pg8::EpiResidSlab E{ws, (gate_l), (xb_), (fac)}; \
            pg8::gemm_phase<pg8::EpiResidSlab, pg8::ResidOrder, true, true>(lds + RING_OFF, g, S, E, wave_s); } while (0)
#define GEMM_LAT(EPI, Aptr, Bptr, Ncols, Kdim, ...) do { pg8::Gemm g{(Aptr), (Bptr), MT, (Ncols), (Kdim), (Kdim)}; pg8::StaticOrder S; S.init(MT, (Ncols), G, bid); EPI E{__VA_ARGS__}; \
            pg8::gemm_phase<EPI, pg8::StaticOrder, true, true>(lds + RING_OFF, g, S, E, wave_s); } while (0)

        if (IN(pb + L_N1)) { PHASE_BEGIN; MKP(); phase_norm(XR, l == 0 ? P.x - (size_t)CTXL * DM : (const float*)XR, l == 0 ? P.ctx : (const float*)XR, XR, P.norm_g + (size_t)(l * 3 + 0) * DM, modl + 0 * 3 * DM, modc + 0 * 3 * DM, H, l > 0 ? SLAB : nullptr, modc - (size_t)2 * NMOD + 2 * 3 * DM + 2 * DM, 0.5f, lds, bid, G, tid); SEAM(pb + L_N1); }
        if (IN(pb + L_W13A)) { PHASE_BEGIN; MKP();
            GEMM_LAT(pg8::EpiSwiglu, H, W13T0, 8192, DM, GB, FFND);
            convert_idle(P, l + 1, 0, CV_A, 32, lds, bid, G, tid);
            SEAM(pb + L_W13A); }
        if (IN(pb + L_W2A)) { PHASE_BEGIN; MKP();
            GEMM_RESID_SPLIT(GB, W2T0, modl + 0 * 3 * DM + 2 * DM, 0.5f, (const float*)nullptr, (bf16*)nullptr, 256, l == 0 ? P.x - (size_t)CTXL * DM : (const float*)XR);
            SEAM(pb + L_W2A); }
        if (IN(pb + L_N2)) { PHASE_BEGIN; MKP(); phase_norm(XR, XR, XR, l == 0 ? P.ctx : (const float*)XR, P.norm_g + (size_t)(l * 3 + 1) * DM, modl + 1 * 3 * DM, modc + 1 * 3 * DM, H, SLAB, modc + 0 * 3 * DM + 2 * DM, 0.5f, lds, bid, G, tid); SEAM(pb + L_N2); }
        if (IN(pb + L_WIN)) { PHASE_BEGIN; MKP();
            GEMM_LAT(pg8::EpiWin, H, WINT, NZ, DM, Z, (const float*)(ws + WS_ROPE), (const float*)(ws + WS_ROPE) + SEQ * 64);
            convert_idle(P, l + 1, CV_A, CV_A + CV_W, 146, lds, bid, G, tid);
            for (int u = ((bid - 80) % G + G) % G; u < 66; u += G) gates_unit(H, (const bf16*)(ws + WS_WG16) + (size_t)l * 16 * DM, G16, u, tid);
            SEAM(pb + L_WIN); }
        if (IN(pb + L_MIX1)) { PHASE_BEGIN; MKP();
            for (int rep_ = 0; rep_ < DBL_M1; ++rep_) for (int u = (bid + G - (100 % G)) % G; u < 264; u += G) mlstm_m1_unit(Z, G16, P.gate_b + (size_t)l * 16, DCT, DNS, CHS, u >> 2, u & 3, lds, tid);
            for (int rep_ = 0; rep_ < DBL_ATTN; ++rep_) for (int u = bid; u < (l < DEPTH - 1 ? 264 : 256); u += G) {
                int hm, qb, seq; if (u < 256) { hm = u & 7; qb = 1 + (u >> 3); seq = MT; } else { hm = u - 256; qb = 0; seq = CTXL; }
                const int h = hm >> 1, mm = hm & 1;
                const attn128::bf16* Zb = (const attn128::bf16*)Z;
                attn256::attn_o256_body(Zb + (size_t)MT * ZC_AQ + (size_t)(qb * 256) * 1024 + h * 256 + mm * 128, Zb + (size_t)MT * ZC_AK + h * 256 + mm * 128, Zb + (size_t)MT * ZC_AV + h * 256,
                                        ATTO + (size_t)mm * MT * 1024 + (size_t)(qb * 256) * 1024 + h * 256, seq, (char*)lds_raw, wave_s);
                __syncthreads();
            }
            SEAM(pb + L_MIX1);
        }
        if (IN(pb + L_POST)) { PHASE_BEGIN; MKP();
            for (int rep_ = 0; rep_ < DBL_POST; ++rep_) { mlstm_m2(DCT, DNS, CHS, CTS, NSS, MSS, lds, bid, G, tid); } SEAM(pb + L_POST); }
        if (IN(pb + L_M3)) { PHASE_BEGIN; MKP();
            { const int u0 = (l < DEPTH - 1) ? 0 : 8, nsec = (l < DEPTH - 1) ? (264 - G > 0 ? 264 - G : 0) : 0;
              for (int rep_ = 0; rep_ < DBL_M3; ++rep_) for (int u = u0 + bid; u < 264; u += G) mlstm_m3_unit(Z, G16, P.gate_b + (size_t)l * 16, CTS, NSS, MSS, P.mlstm_norm_g + (size_t)l * 1024, YB, u >> 2, u & 3, lds, tid);
              const int ngm = (G >= 66 + nsec + 8) ? 66 : 0;
              for (int rep_ = 0; rep_ < DBL_GMLP; ++rep_) for (int u = G - 1 - bid; u < 66; u += G) gmlp_unit_mfma(Z, P.gmlp_norm_g + (size_t)l * 1024, (const bf16*)(ws + WS_GWSB) + (size_t)l * 8 * 128 * 128, P.gmlp_bs + (size_t)l * 8 * 128, YA, u, lds, tid);
              if (bid >= nsec && bid < G - ngm) phase_post(ATTO, MLH, Z, P.diff_norm_g + (size_t)l * 256, P.mlstm_norm_g + (size_t)l * 1024, ((const float*)(ws + WS_LAM))[l], lambda_init_f(l), YB, YC, bid - nsec, G - ngm - nsec, tid); }
            SEAM(pb + L_M3); }
        if (IN(pb + L_MERGE)) { PHASE_BEGIN; MKP();
            { pg8::Gemm g{YA, WBT, MT, DM, 1024, 1024}; pg8::MergeOrder S; S.lat.init(SEQ, DM, G, bid); S.c = bid; S.G = G; S.nctx = (l < DEPTH - 1) ? 48 : 0; pg8::EpiMergeSeg E{Z, Y, (float*)(ws + WS_MS3)};
              pg8::gemm_phase<pg8::EpiMergeSeg, pg8::MergeOrder, true, true>(lds + RING_OFF, g, S, E, wave_s); }
            SEAM(pb + L_MERGE); }
        if (IN(pb + L_WOUT)) { PHASE_BEGIN; MKP();
            GEMM_RESID_SPLIT2(Y, WOT, modl + 1 * 3 * DM + 2 * DM, 1.f, (const float*)(ws + WS_MS3), Y, (l < DEPTH - 1) ? 256 : 0);
            SEAM(pb + L_WOUT); }
        if (IN(pb + L_N3)) { PHASE_BEGIN; MKP(); phase_norm(XR, XR, XR, XR, P.norm_g + (size_t)(l * 3 + 2) * DM, modl + 2 * 3 * DM, modc + 2 * 3 * DM, H, SLAB, modc + 1 * 3 * DM + 2 * DM, 1.f, lds, bid, G, tid); SEAM(pb + L_N3); }
        if (IN(pb + L_W13B)) { PHASE_BEGIN; MKP();
            { const int skip = (l < DEPTH - 1) ? 0 : CTXL;
              pg8::Gemm g{H + (size_t)skip * DM, W13T1, MT - skip, 8192, DM, DM}; pg8::StaticOrder S; S.init(MT - skip, 8192, G, bid); pg8::EpiSwiglu E{GB + (size_t)skip * FFND, FFND};
              pg8::gemm_phase<pg8::EpiSwiglu, pg8::StaticOrder, true, true>(lds + RING_OFF, g, S, E, wave_s); }
            convert_idle(P, l + 1, CV_A + CV_W, CV_TOT, 32, lds, bid, G, tid);
            SEAM(pb + L_W13B); }
        if (IN(pb + L_W2B)) { PHASE_BEGIN; MKP();
            GEMM_RESID_SPLIT(GB, W2T1, modl + 2 * 3 * DM + 2 * DM, 0.5f, (const float*)nullptr, (bf16*)nullptr, (l < DEPTH - 1) ? 256 : 0, (const float*)XR);
            SEAM(pb + L_W2B); }
#undef GEMM_LAT
#undef GEMM_RESID_SPLIT
#undef GEMM_RESID_SPLIT2
    }
    if (IN(P_FINAL)) { PHASE_BEGIN; MKP(); phase_final(XR, P.final_g, P.out, bid, G, tid); }
#undef IN
#undef SEAM
#undef tid
#undef XR
#undef H
#undef GB
#undef Z
#undef ATTO
#undef MLH
#undef DCT
#undef YA
#undef YB
#undef YC
#undef SLAB
#undef YACC
#undef Y
#undef G16
#undef MOD
#undef CTS
#undef DNS
#undef NSS
#undef CHS
#undef MSS
#undef modl
#undef modc
#undef W13T0
#undef W13T1
#undef W2T0
#undef W2T1
#undef WINT
#undef WBT
#undef WOT
}

extern "C" void kernel_launch(void* const* d_in, const int* in_sizes, int n_in, void* d_out, int out_size, void* d_ws, size_t ws_size, hipStream_t stream) {
    static int grid = 0;
    if (grid == 0) {
        if (n_in != 21 || in_sizes[0] != SEQ * DM || out_size != SEQ * DM || ws_size < WS_END) {
            fprintf(stderr, "kernel_launch: unexpected shapes: n_in %d in0 %d out %d ws %zu (need %zu)\n", n_in, n_in > 0 ? in_sizes[0] : -1, out_size, ws_size, (size_t)WS_END); grid = -1; return; }
        int dev = 0, cus = 0;
        if (hipGetDevice(&dev) != hipSuccess || hipDeviceGetAttribute(&cus, hipDeviceAttributeMultiprocessorCount, dev) != hipSuccess) { grid = -1; return; }
        if (hipFuncSetAttribute((const void*)mk_fwd<T_ALL>, hipFuncAttributeMaxDynamicSharedMemorySize, LDS_BYTES) != hipSuccess) { fprintf(stderr, "kernel_launch: hipFuncSetAttribute failed\n"); grid = -1; return; }
        (void)hipGetLastError();
        grid = cus;
    }
    if (grid < 0) return;
    (void)hipMemsetAsync((char*)d_ws + WS_CTL, 0, CTL_ZERO_BYTES, stream);
    Args a{};
    for (int i = 0; i < 21; ++i) a.in[i] = (const float*)d_in[i];
    a.out = (float*)d_out; a.ws = (unsigned char*)d_ws;
#if MK_ONE_LAUNCH
    a.ph_lo = 0; a.ph_hi = NPH;
    hipLaunchKernelGGL(mk_fwd<T_ALL>, dim3(grid), dim3(NTHR), LDS_BYTES, stream, a);
#else
    for (int p = 0; p < NPH; ++p) { a.ph_lo = p; a.ph_hi = p + 1; hipLaunchKernelGGL(mk_fwd<T_ALL>, dim3(grid), dim3(NTHR), LDS_BYTES, stream, a); }
#endif
    const hipError_t le = hipPeekAtLastError();
    if (le != hipSuccess) fprintf(stderr, "kernel_launch: launch failed: %s\n", hipGetErrorName(le));
}
```

```cpp
#include <hip/hip_runtime.h>
#include <hip/hip_bf16.h>
#include <cstdio>
#include <cstdint>
#include <cmath>
#ifndef MLSTM_CHUNKWISE
#define MLSTM_CHUNKWISE 1
#endif
#ifndef MK_ONE_LAUNCH
#define MK_ONE_LAUNCH 1
#endif
#ifndef DBL_ATTN
#define DBL_ATTN 1
#endif
#ifndef DBL_PRO
#define DBL_PRO 1
#endif
#ifndef DBL_M1
#define DBL_M1 1
#endif
#ifndef DBL_GMLP
#define DBL_GMLP 1
#endif
#ifndef DBL_POST
#define DBL_POST 1
#endif
#ifndef DBL_M3
#define DBL_M3 1
#endif
#ifndef DBL_NORM
#define DBL_NORM 1
#endif
__device__ __forceinline__ int mk_lane_id() { int l_; asm volatile("v_mbcnt_lo_u32_b32 %0, -1, 0\n\tv_mbcnt_hi_u32_b32 %0, -1, %0" : "=v"(l_)); return l_; }
#define MK_TID(wave_s_) (((wave_s_) << 6) | mk_lane_id())
namespace pg8 {
#define PG8_LAS __attribute__((address_space(3)))
typedef unsigned short bf16_t;
typedef short bf16x8 __attribute__((ext_vector_type(8)));
typedef float f32x4 __attribute__((ext_vector_type(4)));
typedef unsigned u32x4 __attribute__((ext_vector_type(4)));
constexpr int BM = 256, BK = 64, HALF = 128, HTB = HALF * BK * 2  , STAGE_BYTES = 8 * HTB, NXCD = 8, WGM = 8;

__host__ __device__ __forceinline__ int lds_byte(int r, int c) { const int st = (r >> 4) * 2 + (c >> 5), rr = r & 15, cc = c & 31, ob = rr * 64 + cc * 2; return st * 1024 + (ob ^ (((ob >> 9) & 1) << 5)); }
__host__ __device__ __forceinline__ void stage_rc(int b, int& R, int& C) { const int st = b / 1024, sb = b % 1024, swz = sb ^ (((sb >> 9) & 1) << 5); R = (st >> 1) * 16 + swz / 64; C = (st & 1) * 32 + (swz % 64) / 2; }
__host__ __device__ __forceinline__ int perm32(int rho) { const int n = rho >> 4, i = rho & 15; return 8 * (i >> 2) + 4 * n + (i & 3); }

struct Unit { int pm, pn, koff, boff, fl;
    __device__ __forceinline__ int seg() const { return fl & 3; } __device__ __forceinline__ bool carry() const { return (fl & 4) != 0; } __device__ __forceinline__ int ntile() const { return fl >> 8; } };
struct Gemm { const bf16_t* A; const bf16_t* Bt; int M, N, K, ld; };

struct StaticOrder {
    int nM, nN, nwg, G, c;
    __host__ __device__ void init(int M, int N, int G_, int c_) { nM = M / BM; nN = N / BM; nwg = nM * nN; G = G_; c = c_; }
    __host__ __device__ bool next(int i, Unit& u) const {
        const long L = (long)i * G + c; if (L >= nwg) return false;
        int wgid = (int)L; { const int q = nwg / NXCD, r = nwg % NXCD, xcd = wgid % NXCD, off = wgid / NXCD; wgid = (xcd < r ? xcd * (q + 1) : r * (q + 1) + (xcd - r) * q) + off; }
        const int nig = WGM * nN, gid = wgid / nig, fm = gid * WGM, gsz = (nM - fm) < WGM ? (nM - fm) : WGM;
        u.pm = fm + ((wgid % nig) % gsz); u.pn = (wgid % nig) / gsz; u.koff = 0; u.boff = 0; u.fl = 0; return true;
    }
    __device__ __forceinline__ void a_ready(const Unit&) const {}
    __device__ __forceinline__ void done(const Unit&) const {}
};

__device__ __forceinline__ unsigned cvt_pk_bf16(float lo, float hi) { unsigned r; asm volatile("v_cvt_pk_bf16_f32 %0, %1, %2" : "=v"(r) : "v"(lo), "v"(hi)); return r; }
typedef float f32x2 __attribute__((ext_vector_type(2)));
__device__ __forceinline__ f32x2 gelu_pk(f32x2 v) {
    const f32x2 av = __builtin_elementwise_abs(v), d = av * 0.2316418882f + 1.0f;
    f32x2 t; t.x = __builtin_amdgcn_rcpf(d.x); t.y = __builtin_amdgcn_rcpf(d.y);
    f32x2 q = t * 0.5307027145f + (-0.7265760135f); q = q * t + 0.7107068705f; q = q * t + (-0.142248368f); q = q * t + 0.127414796f; q = q * t;
    const f32x2 s = (v * v) * (-0.72134752044f);
    f32x2 e; e.x = __builtin_amdgcn_exp2f(s.x); e.y = __builtin_amdgcn_exp2f(s.y);
    const f32x2 m = v * (q * e), r = v - m;
    f32x2 o; o.x = v.x < 0.f ? m.x : r.x; o.y = v.y < 0.f ? m.y : r.y; return o;
}

template <int ACT  > struct EpiBf16 {
    static constexpr bool PERM = true, AFTER_DRAIN = false; static_assert(ACT == 0 || ACT == 1, "EpiBf16: ACT is 0 (none) or 1 (gelu_pk)");
    bf16_t* O; int ldc; const float* bias; int split_cols; size_t split_stride; float scale0;
    __device__ __forceinline__ void operator()(const f32x4 (&acc)[2][2][4][2], const Unit& u, int wr, int wc, int fr, int fq) const {
        const int row0 = u.pm * BM + wr * 64 + fr; int colt = u.pn * BM; bf16_t* base = O;
        float sc = 1.f; if (split_cols) { const int t = colt / split_cols; base += (size_t)t * split_stride; colt -= t * split_cols; if (t == 0) sc = scale0; }
        const int col0 = colt + wc * 32 + 8 * fq, bcol0 = u.pn * BM + wc * 32 + 8 * fq;
        f32x4 bv[2][2];
#pragma unroll
        for (int bj = 0; bj < 2; ++bj)
#pragma unroll
            for (int n = 0; n < 2; ++n) bv[bj][n] = bias ? *(const f32x4*)(bias + bcol0 + bj * HALF + 4 * n) : (f32x4){0.f, 0.f, 0.f, 0.f};
#pragma unroll
        for (int ai = 0; ai < 2; ++ai)
#pragma unroll
            for (int m = 0; m < 4; ++m) { bf16_t* rowp = base + (size_t)(row0 + ai * HALF + m * 16) * ldc + col0;
#pragma unroll
                for (int bj = 0; bj < 2; ++bj) { f32x4 v0 = acc[ai][bj][m][0] + bv[bj][0], v1 = acc[ai][bj][m][1] + bv[bj][1];
                    if (ACT == 1) { f32x2 a = gelu_pk((f32x2){v0[0], v0[1]}), b = gelu_pk((f32x2){v0[2], v0[3]}), c = gelu_pk((f32x2){v1[0], v1[1]}), d = gelu_pk((f32x2){v1[2], v1[3]});
                        v0 = (f32x4){a.x, a.y, b.x, b.y}; v1 = (f32x4){c.x, c.y, d.x, d.y}; }
                    v0 = v0 * sc; v1 = v1 * sc; u32x4 w; w.x = cvt_pk_bf16(v0[0], v0[1]); w.y = cvt_pk_bf16(v0[2], v0[3]); w.z = cvt_pk_bf16(v1[0], v1[1]); w.w = cvt_pk_bf16(v1[2], v1[3]);
                    *(u32x4*)(rowp + bj * HALF) = w; } }
    }
};

struct PanelStats {
    unsigned* xbuf;
    unsigned* cnt;
    unsigned* tmo;
    int ntn; float eps;
    unsigned code;
    __device__ __forceinline__ bool run(const f32x4 (&v)[2][2][4][2], const Unit& u, int wr, int wc, int fr, int fq, PG8_LAS unsigned char* lds, int wid, int lane) const {
        typedef float f32x2v __attribute__((ext_vector_type(2)));
        PG8_LAS f32x2v* P = (PG8_LAS f32x2v*)lds;
        PG8_LAS f32x2v* S = (PG8_LAS f32x2v*)(lds + 8192);
        PG8_LAS unsigned* flag = (PG8_LAS unsigned*)(lds + 8192 + 2048);
#pragma unroll
        for (int ai = 0; ai < 2; ++ai)
#pragma unroll
            for (int m = 0; m < 4; ++m) {
                float s = 0.f;
#pragma unroll
                for (int bj = 0; bj < 2; ++bj)
#pragma unroll
                    for (int n = 0; n < 2; ++n) { const f32x4 x = v[ai][bj][m][n]; s += (x[0] + x[1]) + (x[2] + x[3]); }
                s += __shfl_xor(s, 16); s += __shfl_xor(s, 32);
                const float mw = s * (1.0f / 64.0f); float q = 0.f;
#pragma unroll
                for (int bj = 0; bj < 2; ++bj)
#pragma unroll
                    for (int n = 0; n < 2; ++n) { const f32x4 d = v[ai][bj][m][n] - mw; q += (d[0] * d[0] + d[1] * d[1]) + (d[2] * d[2] + d[3] * d[3]); }
                q += __shfl_xor(q, 16); q += __shfl_xor(q, 32);
                if (fq == 0) P[(ai * HALF + wr * 64 + m * 16 + fr) * 4 + wc] = (f32x2v){mw, q};
            }
        asm volatile("s_waitcnt lgkmcnt(0)" ::: "memory"); __builtin_amdgcn_s_barrier(); asm volatile("" ::: "memory");
#if defined(BROKEN_EXCHANGE_NO_WAIT)
#warning BROKEN CONTROL BUILD: the row-statistics exchange does not wait; results are wrong by design
        if (blockIdx.x >= 64) { const long long t0_ = clock64(); while (clock64() - t0_ < 60000) __builtin_amdgcn_s_sleep(8); }
#endif
        const int row = wid * 32 + (lane & 31);
        if (lane < 32) {
            const f32x2v a = P[row * 4 + 0], b = P[row * 4 + 1], c = P[row * 4 + 2], d = P[row * 4 + 3];
            const float mt = (a.x + b.x + c.x + d.x) * 0.25f;
            const float da = a.x - mt, db = b.x - mt, dc = c.x - mt, dd = d.x - mt;
            const float m2 = (a.y + b.y) + (c.y + d.y) + 64.0f * ((da * da + db * db) + (dc * dc + dd * dd));
            unsigned long long* slot = (unsigned long long*)xbuf + ((size_t)(u.pm * BM + row) * 4 + u.pn);
            __hip_atomic_store(slot, ((unsigned long long)__float_as_uint(m2) << 32) | __float_as_uint(mt), __ATOMIC_RELAXED, __HIP_MEMORY_SCOPE_AGENT);
        }
        asm volatile("s_waitcnt vmcnt(0)" ::: "memory");
        if (lane == 0) __hip_atomic_fetch_add(cnt + 64 * u.pm, 1u, __ATOMIC_RELAXED, __HIP_MEMORY_SCOPE_AGENT);
        if (wid == 0) {
            bool dead = false; const unsigned long long t0 = __builtin_amdgcn_s_memrealtime(); const unsigned want = 8u * (unsigned)ntn;
            for (;;) {
#if defined(BROKEN_EXCHANGE_NO_WAIT)
                break;
#endif
                if ((unsigned)__builtin_amdgcn_readfirstlane(__hip_atomic_load(cnt + 64 * u.pm, __ATOMIC_RELAXED, __HIP_MEMORY_SCOPE_AGENT)) >= want) break;
                if (__builtin_amdgcn_s_memrealtime() - t0 > 2000000ull) {
                    if (lane == 0) { unsigned expect = 0u; __hip_atomic_compare_exchange_strong(tmo + 1, &expect, code | (unsigned)(u.pm & 0xff), __ATOMIC_RELAXED, __ATOMIC_RELAXED, __HIP_MEMORY_SCOPE_AGENT);
                                     __hip_atomic_store(tmo, 1u, __ATOMIC_RELAXED, __HIP_MEMORY_SCOPE_AGENT); }
                    dead = true; break; }
                __builtin_amdgcn_s_sleep(2);
            }
            __builtin_amdgcn_fence(__ATOMIC_ACQUIRE, "agent");
            if (lane == 0) flag[0] = dead ? 1u : 0u;
        }
        asm volatile("s_waitcnt vmcnt(0) lgkmcnt(0)" ::: "memory"); __builtin_amdgcn_s_barrier(); asm volatile("" ::: "memory");
        const bool bad = flag[0] != 0u;
        if (lane < 32) {
            const unsigned long long* slot = (const unsigned long long*)xbuf + (size_t)(u.pm * BM + row) * 4; float mt[4], m2[4]; float ms = 0.f;
#pragma unroll
            for (int t = 0; t < 4; ++t) { if (t < ntn) { const unsigned long long w = __hip_atomic_load(slot + t, __ATOMIC_RELAXED, __HIP_MEMORY_SCOPE_AGENT); mt[t] = __uint_as_float((unsigned)w); m2[t] = __uint_as_float((unsigned)(w >> 32)); } else { mt[t] = 0.f; m2[t] = 0.f; } ms += mt[t]; }
            const float mean = ms / (float)ntn; float q = 0.f;
#pragma unroll
            for (int t = 0; t < 4; ++t) if (t < ntn) { const float dm = mt[t] - mean; q += m2[t] + 256.0f * dm * dm; }
            S[row] = (f32x2v){mean, 1.0f / sqrtf(q / (256.0f * (float)ntn) + eps)};
        }
        asm volatile("s_waitcnt lgkmcnt(0)" ::: "memory"); __builtin_amdgcn_s_barrier(); asm volatile("" ::: "memory");
        return bad;
    }
};
struct EpiLnRes {
    static constexpr bool PERM = false, AFTER_DRAIN = true;
    const float* base; float* out; int ldc; const float* bias; PanelStats st; unsigned poison;
    __device__ __forceinline__ void fused(f32x4 (&acc)[2][2][4][2], const Unit& u, int wr, int wc, int fr, int fq, PG8_LAS unsigned char* lds, int wid, int lane) const {
        typedef float f32x2v __attribute__((ext_vector_type(2)));
        const PG8_LAS f32x2v* S = (const PG8_LAS f32x2v*)(lds + 8192);
        const int col0 = u.pn * BM + wc * 32 + 4 * fq;
#pragma unroll
        for (int bj = 0; bj < 2; ++bj)
#pragma unroll
            for (int n = 0; n < 2; ++n) { const f32x4 bv = bias ? *(const f32x4*)(bias + col0 + bj * HALF + n * 16) : (f32x4){0.f, 0.f, 0.f, 0.f};
#pragma unroll
                for (int ai = 0; ai < 2; ++ai)
#pragma unroll
                    for (int m = 0; m < 4; ++m) acc[ai][bj][m][n] += bv; }
        f32x4 pre[4][2][2];
#pragma unroll
        for (int m = 0; m < 4; ++m) { const size_t off = (size_t)(u.pm * BM + wr * 64 + m * 16 + fr) * ldc + col0;
#pragma unroll
            for (int bj = 0; bj < 2; ++bj)
#pragma unroll
                for (int n = 0; n < 2; ++n) pre[m][bj][n] = *(const f32x4*)(base + off + bj * HALF + n * 16); }
        const bool bad = st.run(acc, u, wr, wc, fr, fq, lds, wid, lane) || poison != 0u;
        const float qnan = __builtin_nanf("");
#pragma unroll
        for (int ai = 0; ai < 2; ++ai)
#pragma unroll
            for (int m = 0; m < 4; ++m) { const int r = ai * HALF + wr * 64 + m * 16 + fr; const f32x2v sr = S[r]; const size_t off = (size_t)(u.pm * BM + r) * ldc + col0;
#pragma unroll
                for (int bj = 0; bj < 2; ++bj)
#pragma unroll
                    for (int n = 0; n < 2; ++n) { const f32x4 bs = ai == 0 ? pre[m][bj][n] : *(const f32x4*)(base + off + bj * HALF + n * 16); f32x4 o = bs + (acc[ai][bj][m][n] - sr.x) * sr.y;
                        if (bad) o = (f32x4){qnan, qnan, qnan, qnan}; *(f32x4*)(out + off + bj * HALF + n * 16) = o; }
                if (m & 1) asm volatile("" ::: "memory"); }
    }
};
struct EpiLnResLn {
    static constexpr bool PERM = false, AFTER_DRAIN = true;
    const float* base; float* out; bf16_t* xn; int ldc; const float* bias; PanelStats st1, st2; unsigned poison;
    __device__ __forceinline__ void fused(f32x4 (&acc)[2][2][4][2], const Unit& u, int wr, int wc, int fr, int fq, PG8_LAS unsigned char* lds, int wid, int lane) const {
        typedef float f32x2v __attribute__((ext_vector_type(2))); typedef unsigned u32x2v __attribute__((ext_vector_type(2)));
        const PG8_LAS f32x2v* S = (const PG8_LAS f32x2v*)(lds + 8192);
        const int col0 = u.pn * BM + wc * 32 + 4 * fq;
#pragma unroll
        for (int bj = 0; bj < 2; ++bj)
#pragma unroll
            for (int n = 0; n < 2; ++n) { const f32x4 bv = bias ? *(const f32x4*)(bias + col0 + bj * HALF + n * 16) : (f32x4){0.f, 0.f, 0.f, 0.f};
#pragma unroll
                for (int ai = 0; ai < 2; ++ai)
#pragma unroll
                    for (int m = 0; m < 4; ++m) acc[ai][bj][m][n] += bv; }
        bool bad = st1.run(acc, u, wr, wc, fr, fq, lds, wid, lane) || poison != 0u;
        const float qnan = __builtin_nanf("");
#pragma unroll
        for (int ai = 0; ai < 2; ++ai)
#pragma unroll
            for (int m = 0; m < 4; ++m) { const int r = ai * HALF + wr * 64 + m * 16 + fr; const f32x2v sr = S[r]; const size_t off = (size_t)(u.pm * BM + r) * ldc + col0;
#pragma unroll
                for (int bj = 0; bj < 2; ++bj)
#pragma unroll
                    for (int n = 0; n < 2; ++n) { const f32x4 bs = *(const f32x4*)(base + off + bj * HALF + n * 16); acc[ai][bj][m][n] = bs + (acc[ai][bj][m][n] - sr.x) * sr.y; }
                asm volatile("" : "+v"(acc[ai][0][m][0]), "+v"(acc[ai][0][m][1]), "+v"(acc[ai][1][m][0]), "+v"(acc[ai][1][m][1]));
                if (m & 1) asm volatile("" ::: "memory"); }
        const bool bad1 = bad;
        bad = st2.run(acc, u, wr, wc, fr, fq, lds, wid, lane) || bad;
#pragma unroll
        for (int ai = 0; ai < 2; ++ai)
#pragma unroll
            for (int m = 0; m < 4; ++m) { const int r = ai * HALF + wr * 64 + m * 16 + fr; const f32x2v sr = S[r]; const size_t off = (size_t)(u.pm * BM + r) * ldc + col0;
#pragma unroll
                for (int bj = 0; bj < 2; ++bj)
#pragma unroll
                    for (int n = 0; n < 2; ++n) { const f32x4 x1 = acc[ai][bj][m][n]; *(f32x4*)(out + off + bj * HALF + n * 16) = bad1 ? (f32x4){qnan, qnan, qnan, qnan} : x1;
                        const f32x4 o = (x1 - sr.x) * sr.y; u32x2v w; w.x = cvt_pk_bf16(o[0], o[1]); w.y = cvt_pk_bf16(o[2], o[3]);
                        if (bad) { w.x = 0x7fc07fc0u; w.y = 0x7fc07fc0u; } *(u32x2v*)(xn + off + bj * HALF + n * 16) = w; }
                asm volatile("" ::: "memory"); }
    }
};

template <class Epi, class Sched, bool ALIGN_EPI = false, bool SP2 = false>
__device__ __forceinline__ void gemm_phase(PG8_LAS unsigned char* lds, const Gemm g, const Sched& S, const Epi& E, int wave_s_) {
    int tid = MK_TID(wave_s_); asm volatile("" : "+v"(tid));
    const int wid = __builtin_amdgcn_readfirstlane(tid >> 6), lane = tid & 63, wr = wid >> 2, wc = wid & 3, fr = lane & 15, fq = lane >> 4;
    const int K = g.K, nt_def = K / BK;
    unsigned voffA[2], voffB[2];
#pragma unroll
    for (int i = 0; i < 2; ++i) { int R, C; stage_rc(tid * 16 + i * 8192, R, C); const int Rb = Epi::PERM ? ((R & ~31) + perm32(R & 31)) : R;
        voffA[i] = (unsigned)(R * g.ld + C) * 2u; voffB[i] = (unsigned)(Rb * g.ld + C) * 2u; }
    const size_t kstep = (size_t)(BK * 2);
    const size_t hstep = (size_t)HALF * g.ld * 2;
    const size_t tstep = 2 * hstep;
    const unsigned ldsw = (unsigned)wid * 1024u;
    const int aoff = lds_byte(wr * 64 + fr, fq * 8), boff = lds_byte(wc * 32 + fr, fq * 8);
#define PG8_SA(b, h) (((b) * 2 + (h)) * HTB)
#define PG8_SB(b, h) ((4 + (b) * 2 + (h)) * HTB)
#define PG8_STAGE(bufoff, gbase, voff) do { _Pragma("unroll") for (int _i = 0; _i < 2; ++_i) \
        __builtin_amdgcn_global_load_lds((const unsigned*)((const char*)(gbase) + (voff)[_i]), (PG8_LAS unsigned*)(lds + (bufoff) + ldsw + _i * 8192), 16, 0, 0); } while (0)
#define PG8_LDA(dst, b, h) do { _Pragma("unroll") for (int m = 0; m < 4; ++m) _Pragma("unroll") for (int k = 0; k < 2; ++k) dst[m][k] = *(const PG8_LAS bf16x8*)(lds + PG8_SA(b, h) + aoff + m * 2048 + k * 1024); } while (0)
#define PG8_LDB(dst, b, h) do { _Pragma("unroll") for (int n = 0; n < 2; ++n) _Pragma("unroll") for (int k = 0; k < 2; ++k) dst[n][k] = *(const PG8_LAS bf16x8*)(lds + PG8_SB(b, h) + boff + n * 2048 + k * 1024); } while (0)
#define PG8_MMA(ai, bj, At, Bt) do { __builtin_amdgcn_s_setprio(1); _Pragma("unroll") for (int m = 0; m < 4; ++m) _Pragma("unroll") for (int n = 0; n < 2; ++n) _Pragma("unroll") for (int k = 0; k < 2; ++k) \
        acc[ai][bj][m][n] = __builtin_amdgcn_mfma_f32_16x16x32_bf16(Bt[n][k], At[m][k], acc[ai][bj][m][n], 0, 0, 0); __builtin_amdgcn_s_setprio(0); } while (0)
#define PG8_WAIT_V(n) asm volatile("s_waitcnt vmcnt(" #n ")" ::: "memory")
#define PG8_WAIT_L(n) asm volatile("s_waitcnt lgkmcnt(" #n ")" ::: "memory")
#define PG8_BAR __builtin_amdgcn_s_barrier()
#define PG8_SCHED __builtin_amdgcn_sched_barrier(0)
    Unit cur, nxt; int ui = 0;
    if (!S.next(0, cur)) return;
    f32x4 acc[2][2][4][2];
#pragma unroll
    for (int a = 0; a < 2; ++a)
#pragma unroll
        for (int b = 0; b < 2; ++b)
#pragma unroll
            for (int m = 0; m < 4; ++m)
#pragma unroll
                for (int n = 0; n < 2; ++n) acc[a][b][m][n] = (f32x4){0.f, 0.f, 0.f, 0.f};
    bf16x8 At[4][2], B0[2][2], B1[2][2];
    const char* cA = (const char*)g.A + (size_t)cur.pm * tstep + (size_t)cur.koff * 2; const char* cB = (const char*)g.Bt + (size_t)cur.pn * tstep + (size_t)cur.boff * 2;
    S.a_ready(cur);
    if constexpr (SP2) {
        PG8_STAGE(PG8_SB(0, 0), cB, voffB); PG8_STAGE(PG8_SB(0, 1), cB + hstep, voffB); PG8_STAGE(PG8_SA(0, 0), cA, voffA); PG8_STAGE(PG8_SA(0, 1), cA + hstep, voffA);
        if (wr == 1) PG8_BAR;
        PG8_WAIT_V(2); PG8_BAR;
        PG8_STAGE(PG8_SB(1, 0), cB + kstep, voffB); PG8_STAGE(PG8_SA(1, 0), cA + kstep, voffA); PG8_STAGE(PG8_SB(1, 1), cB + hstep + kstep, voffB);
        PG8_WAIT_V(6); PG8_BAR;
    } else {
        PG8_STAGE(PG8_SB(0, 0), cB, voffB); PG8_STAGE(PG8_SA(0, 0), cA, voffA); PG8_STAGE(PG8_SB(0, 1), cB + hstep, voffB); PG8_STAGE(PG8_SA(0, 1), cA + hstep, voffA);
        if (wr == 1) PG8_BAR;
        PG8_WAIT_V(4); PG8_BAR;
        PG8_STAGE(PG8_SB(1, 0), cB + kstep, voffB); PG8_STAGE(PG8_SA(1, 0), cA + kstep, voffA); PG8_STAGE(PG8_SB(1, 1), cB + hstep + kstep, voffB);
        PG8_WAIT_V(6); PG8_BAR;
    }
    for (;;) {
        const bool has_next = S.next(ui + 1, nxt);
        const char* nA = has_next ? (const char*)g.A + (size_t)nxt.pm * tstep + (size_t)nxt.koff * 2 : cA; const char* nB = has_next ? (const char*)g.Bt + (size_t)nxt.pn * tstep + (size_t)nxt.boff * 2 : cB;
        const int nt = cur.ntile() ? cur.ntile() : nt_def;
        for (int t = 0; t < nt; t += 2) {
            const bool last = (t == nt - 2);
            const char* a1 = cA + (size_t)(t + 1) * kstep;
            const char* a2 = last ? nA : cA + (size_t)(t + 2) * kstep; const char* b2 = last ? nB : cB + (size_t)(t + 2) * kstep;
            const char* a3 = a2 + kstep; const char* b3 = b2 + kstep;
            if (last && has_next) S.a_ready(nxt);
            if constexpr (SP2) {
            PG8_LDB(B0, 0, 0); PG8_LDB(B1, 0, 1); PG8_SCHED; PG8_LDA(At, 0, 0); PG8_STAGE(PG8_SA(1, 1), a1 + hstep, voffA);
            PG8_WAIT_V(8); PG8_WAIT_L(0); PG8_BAR; PG8_MMA(0, 0, At, B0); PG8_MMA(0, 1, At, B1); PG8_BAR; PG8_SCHED;
            PG8_LDA(At, 0, 1); PG8_STAGE(PG8_SB(0, 0), b2, voffB); PG8_STAGE(PG8_SB(0, 1), b2 + hstep, voffB); PG8_STAGE(PG8_SA(0, 0), a2, voffA);
            PG8_WAIT_V(8); PG8_WAIT_L(0); PG8_BAR; PG8_MMA(1, 0, At, B0); PG8_MMA(1, 1, At, B1); PG8_BAR; PG8_SCHED;
            PG8_LDB(B0, 1, 0); PG8_LDB(B1, 1, 1); PG8_SCHED; PG8_LDA(At, 1, 0); PG8_STAGE(PG8_SA(0, 1), a2 + hstep, voffA);
            PG8_WAIT_V(8); PG8_WAIT_L(0); PG8_BAR; PG8_MMA(0, 0, At, B0); PG8_MMA(0, 1, At, B1); PG8_BAR; PG8_SCHED;
            PG8_LDA(At, 1, 1); PG8_STAGE(PG8_SB(1, 0), b3, voffB); PG8_STAGE(PG8_SB(1, 1), b3 + hstep, voffB); PG8_STAGE(PG8_SA(1, 0), a3, voffA);
            PG8_WAIT_V(8); PG8_WAIT_L(0); PG8_BAR; PG8_MMA(1, 0, At, B0); PG8_MMA(1, 1, At, B1); PG8_BAR; PG8_SCHED;
            } else {
            PG8_LDB(B0, 0, 0); PG8_SCHED; PG8_LDA(At, 0, 0); PG8_STAGE(PG8_SA(1, 1), a1 + hstep, voffA);
            PG8_WAIT_L(8); PG8_BAR; PG8_WAIT_L(0); PG8_MMA(0, 0, At, B0); PG8_BAR; PG8_SCHED;
            PG8_LDB(B1, 0, 1); PG8_STAGE(PG8_SB(0, 0), b2, voffB);
            PG8_BAR; PG8_WAIT_L(0); PG8_MMA(0, 1, At, B1); PG8_BAR;
            PG8_LDA(At, 0, 1); PG8_STAGE(PG8_SA(0, 0), a2, voffA);
            PG8_BAR; PG8_WAIT_L(0); PG8_MMA(1, 0, At, B0); PG8_BAR; PG8_SCHED;
            PG8_STAGE(PG8_SB(0, 1), b2 + hstep, voffB);
            PG8_WAIT_V(6); PG8_BAR; PG8_MMA(1, 1, At, B1); PG8_BAR;
            PG8_LDB(B0, 1, 0); PG8_SCHED; PG8_LDA(At, 1, 0); PG8_STAGE(PG8_SA(0, 1), a2 + hstep, voffA);
            PG8_WAIT_L(8); PG8_BAR; PG8_WAIT_L(0); PG8_MMA(0, 0, At, B0); PG8_BAR; PG8_SCHED;
            PG8_LDB(B1, 1, 1); PG8_STAGE(PG8_SB(1, 0), b3, voffB);
            PG8_BAR; PG8_WAIT_L(0); PG8_MMA(0, 1, At, B1); PG8_BAR;
            PG8_LDA(At, 1, 1); PG8_STAGE(PG8_SA(1, 0), a3, voffA);
            PG8_BAR; PG8_WAIT_L(0); PG8_MMA(1, 0, At, B0); PG8_BAR; PG8_SCHED;
            PG8_STAGE(PG8_SB(1, 1), b3 + hstep, voffB);
            PG8_WAIT_V(6); PG8_BAR; PG8_MMA(1, 1, At, B1); PG8_BAR;
            }
        }
        if constexpr (ALIGN_EPI) { if (wr == 0) PG8_BAR; }
        if constexpr (!Epi::AFTER_DRAIN) { E(acc, cur, wr, wc, fr, fq); S.done(cur); }
        if (!has_next) break;
        if (!nxt.carry()) {
#pragma unroll
        for (int a = 0; a < 2; ++a)
#pragma unroll
            for (int b = 0; b < 2; ++b)
#pragma unroll
                for (int m = 0; m < 4; ++m)
#pragma unroll
                    for (int n = 0; n < 2; ++n) acc[a][b][m][n] = (f32x4){0.f, 0.f, 0.f, 0.f};
        }
        cur = nxt; cA = nA; cB = nB; ++ui;
        if constexpr (ALIGN_EPI) { if (wr == 1) PG8_BAR; }
    }
    PG8_WAIT_V(0);
    if constexpr (!ALIGN_EPI) { if (wr == 0) PG8_BAR; }
    PG8_BAR;
    if constexpr (Epi::AFTER_DRAIN) { E.fused(acc, cur, wr, wc, fr, fq, lds, wid, lane); S.done(cur); }
#undef PG8_SA
#undef PG8_SB
#undef PG8_STAGE
#undef PG8_LDA
#undef PG8_LDB
#undef PG8_MMA
#undef PG8_WAIT_V
#undef PG8_WAIT_L
#undef PG8_BAR
#undef PG8_SCHED
}
}

__device__ __forceinline__ float shfl_xor_f(float v, int o) { return __uint_as_float((unsigned)__builtin_amdgcn_ds_bpermute((mk_lane_id() ^ o) << 2, (int)__float_as_uint(v))); }
namespace attn128 {
using bf16 = __hip_bfloat16;
constexpr int D = 128, NW = 8, QBLK = 32, KVBLK = 64;
constexpr float SCALE = 0.088388347648318440f;
constexpr float THR = 8.f;
constexpr int SDEPTH = 2;
constexpr int LDQ = 1024, LDK = 1024, LDO = 1024;
constexpr size_t SHM_V = KVBLK * D * 2, SHM_K = KVBLK * D * 2, SHM_ATTN = 2 * SHM_V + 2 * SHM_K + NW * 64 * 4;
using bf16x8 = __attribute__((ext_vector_type(8))) short;
using s16x4  = __attribute__((ext_vector_type(4))) short;
using f32x16 = __attribute__((ext_vector_type(16))) float;
using f32x8  = __attribute__((ext_vector_type(8))) float;
using u32x4  = __attribute__((ext_vector_type(4))) unsigned;
#define KSWZ(row, colB) ((row) * 256 + ((colB) ^ (((row) & 7) << 4)))
#define SBAR() __builtin_amdgcn_sched_barrier(0)
__device__ __forceinline__ int crow(int r, int hi) { return (r & 3) + 8 * (r >> 2) + 4 * hi; }
__device__ __forceinline__ unsigned cvtpk(float lo, float hi) {
  unsigned r; asm volatile("v_cvt_pk_bf16_f32 %0, %1, %2" : "=v"(r) : "v"(lo), "v"(hi)); return r;
}
template <typename TIn> struct Stage;
template <> struct Stage<bf16>  { using T = bf16x8;
  __device__ static __forceinline__ T ld8(const bf16* p) { return *reinterpret_cast<const bf16x8*>(p); }
  __device__ static __forceinline__ bf16x8 tobf(T x) { return x; } };
template <> struct Stage<float> { using T = f32x8;
  __device__ static __forceinline__ T ld8(const float* p) { return *reinterpret_cast<const f32x8*>(p); }
  __device__ static __forceinline__ bf16x8 tobf(T x) {
    u32x4 w = {cvtpk(x[0], x[1]), cvtpk(x[2], x[3]), cvtpk(x[4], x[5]), cvtpk(x[6], x[7])}; return *reinterpret_cast<bf16x8*>(&w); } };

__device__ __forceinline__ void partialSM(f32x16& p0, f32x16& p1, float& m_reg, float& mn, float& alpha) {
  constexpr float C = SCALE * 1.4426950408889634f;
  float pmax = p0[0]; for (int r = 1; r < 16; ++r) pmax = fmaxf(pmax, p0[r]); for (int r = 0; r < 16; ++r) pmax = fmaxf(pmax, p1[r]);
  { auto rr = __builtin_amdgcn_permlane32_swap(__float_as_uint(pmax), __float_as_uint(pmax), false, false);
    pmax = fmaxf(__uint_as_float(rr[0]), __uint_as_float(rr[1])); }
  if (__builtin_expect(__all(pmax - m_reg <= THR / SCALE), 1)) { mn = m_reg; alpha = 1.f; }
  else { mn = fmaxf(m_reg, pmax); alpha = __builtin_amdgcn_exp2f((m_reg - mn) * C); m_reg = mn; }
  float mnC = -mn * C;
  for (int r = 0; r < 16; ++r) p0[r] = fmaf(p0[r], C, mnC); for (int r = 0; r < 16; ++r) p1[r] = fmaf(p1[r], C, mnC);
  for (int r = 0; r < 16; ++r) p0[r] = __builtin_amdgcn_exp2f(p0[r]);
}
__device__ __forceinline__ void finishSM(f32x16& p0, f32x16& p1, float alpha, float& l_reg, bf16x8& pa0, bf16x8& pa1, bf16x8& pa2, bf16x8& pa3) {
  for (int r = 0; r < 16; ++r) p1[r] = __builtin_amdgcn_exp2f(p1[r]);
  float ps = 0; for (int r = 0; r < 16; ++r) ps += p0[r]; for (int r = 0; r < 16; ++r) ps += p1[r];
  { auto rr = __builtin_amdgcn_permlane32_swap(__float_as_uint(ps), __float_as_uint(ps), false, false);
    ps = __uint_as_float(rr[0]) + __uint_as_float(rr[1]); }
  l_reg = l_reg * alpha + ps;
#define PK4(P, BASE, OUT) do { unsigned a0 = cvtpk(P[BASE + 0], P[BASE + 1]), a1 = cvtpk(P[BASE + 2], P[BASE + 3]);   \
    unsigned b0 = cvtpk(P[BASE + 4], P[BASE + 5]), b1 = cvtpk(P[BASE + 6], P[BASE + 7]);                              \
    auto r0 = __builtin_amdgcn_permlane32_swap(a0, b0, false, false); auto r1 = __builtin_amdgcn_permlane32_swap(a1, b1, false, false); \
    u32x4 w = {r0[0], r1[0], r0[1], r1[1]}; OUT = *reinterpret_cast<bf16x8*>(&w); } while (0)
  PK4(p0, 0, pa0); PK4(p0, 8, pa1); PK4(p1, 0, pa2); PK4(p1, 8, pa3);
#undef PK4
}
__device__ __forceinline__ void qkt(f32x16& p0, f32x16& p1, const bf16* Ks, const bf16x8* qr, int r32, int hi) {
  p0 = f32x16{}; p1 = f32x16{};
  for (int d0 = 0; d0 < 8; ++d0) { int cb = (d0 * 16 + hi * 8) * 2;
    bf16x8 b0 = *reinterpret_cast<const bf16x8*>((const char*)Ks + KSWZ(r32, cb));
    bf16x8 b1 = *reinterpret_cast<const bf16x8*>((const char*)Ks + KSWZ(32 + r32, cb));
    p0 = __builtin_amdgcn_mfma_f32_32x32x16_bf16(b0, qr[d0], p0, 0, 0, 0);
    p1 = __builtin_amdgcn_mfma_f32_32x32x16_bf16(b1, qr[d0], p1, 0, 0, 0); }
}
__device__ __forceinline__ int v_st(int k, int c) { const int kk = (k & ~0xC) | ((k & 4) << 1) | ((k & 8) >> 1); return ((kk >> 3) * 4 + (c >> 5)) * 512 + ((kk & 7) * 32 + (c & 31)) * 2; }
__device__ __forceinline__ int v_rd_base(int lane) { return ((lane & 3) << 3) | (((lane >> 2) & 3) << 6) | (((lane >> 4) & 1) << 5) | (((lane >> 5) & 1) << 8); }
constexpr int v_rd_off(int d0, int ks, int half) { return d0 * 512 + ks * 4096 + half * 2048; }
template <int OFF> __device__ __forceinline__ s16x4 tr_read(int vb) {
  s16x4 r; asm volatile("ds_read_b64_tr_b16 %0, %1 offset:%2" : "=&v"(r) : "v"(vb), "i"(OFF) : "memory"); return r;
}
template <int D0> __device__ __forceinline__ void pv_one(f32x16& od, int vb, bf16x8 pa0, bf16x8 pa1, bf16x8 pa2, bf16x8 pa3) {
  const s16x4 l0 = tr_read<v_rd_off(D0, 0, 0)>(vb), h0 = tr_read<v_rd_off(D0, 0, 1)>(vb), l1 = tr_read<v_rd_off(D0, 1, 0)>(vb), h1 = tr_read<v_rd_off(D0, 1, 1)>(vb);
  const s16x4 l2 = tr_read<v_rd_off(D0, 2, 0)>(vb), h2 = tr_read<v_rd_off(D0, 2, 1)>(vb), l3 = tr_read<v_rd_off(D0, 3, 0)>(vb), h3 = tr_read<v_rd_off(D0, 3, 1)>(vb);
  asm volatile("s_waitcnt lgkmcnt(0)" ::: "memory"); SBAR();
#define PK(L, H) (bf16x8){L[0], L[1], L[2], L[3], H[0], H[1], H[2], H[3]}
  od = __builtin_amdgcn_mfma_f32_32x32x16_bf16(pa0, PK(l0, h0), od, 0, 0, 0);
  od = __builtin_amdgcn_mfma_f32_32x32x16_bf16(pa1, PK(l1, h1), od, 0, 0, 0);
  od = __builtin_amdgcn_mfma_f32_32x32x16_bf16(pa2, PK(l2, h2), od, 0, 0, 0);
  od = __builtin_amdgcn_mfma_f32_32x32x16_bf16(pa3, PK(l3, h3), od, 0, 0, 0);
#undef PK
}
__device__ __forceinline__ void pv_d0(f32x16* o, int vb, bf16x8 pa0, bf16x8 pa1, bf16x8 pa2, bf16x8 pa3) {
  pv_one<0>(o[0], vb, pa0, pa1, pa2, pa3); pv_one<1>(o[1], vb, pa0, pa1, pa2, pa3); pv_one<2>(o[2], vb, pa0, pa1, pa2, pa3); pv_one<3>(o[3], vb, pa0, pa1, pa2, pa3);
}

template <typename TQ>
__device__ __forceinline__ void attn_dense_body(const TQ* __restrict__ Qb, const bf16* __restrict__ Kh, const bf16* __restrict__ Vh,
                                                float* __restrict__ Ob, int seq, char* lds, int wave_s_) {
  using St = Stage<bf16>; using SQ = Stage<TQ>;
  int tid = MK_TID(wave_s_); asm volatile("" : "+v"(tid));
  const int wid = tid >> 6, lane = tid & 63, r32 = lane & 31, hi = lane >> 5;
  bf16* V_lds = (bf16*)lds; bf16* K_lds = (bf16*)(lds + 2 * SHM_V);
  float* ws = (float*)(lds + 2 * SHM_V + 2 * SHM_K) + wid * 64; float* li_l = ws; float* al_l = ws + 32;
  float m_reg = -1e30f, l_reg = 0; f32x16 o[4] = {}; bf16x8 qr[8];
  const TQ* Qw = Qb + (long)(wid * QBLK + r32) * LDQ + hi * 8;
#pragma unroll
  for (int d0 = 0; d0 < 8; ++d0) qr[d0] = SQ::tobf(SQ::ld8(Qw + d0 * 16));
  const int sr = tid >> 4, sc = (tid & 15) * 8, vst0 = v_st(sr, sc), vst1 = v_st(32 + sr, sc);
  const int vb0 = (int)(uintptr_t)V_lds + v_rd_base(lane);
  struct { typename St::T vs0, vs1, ks0, ks1; } sr_[SDEPTH];
#define SLOAD(i, k0) do { sr_[i].vs0 = St::ld8(&Vh[(long)((k0) + sr) * LDK + sc]); sr_[i].vs1 = St::ld8(&Vh[(long)((k0) + 32 + sr) * LDK + sc]); \
    sr_[i].ks0 = St::ld8(&Kh[(long)((k0) + sr) * LDK + sc]); sr_[i].ks1 = St::ld8(&Kh[(long)((k0) + 32 + sr) * LDK + sc]); } while (0)
#define SWRITE(b, i) do { *(bf16x8*)((char*)V_lds + (b) * SHM_V + vst0) = St::tobf(sr_[i].vs0);          \
    *(bf16x8*)((char*)V_lds + (b) * SHM_V + vst1) = St::tobf(sr_[i].vs1); int kc = sc * 2;               \
    *(bf16x8*)((char*)K_lds + (b) * SHM_K + KSWZ(sr, kc)) = St::tobf(sr_[i].ks0);                       \
    *(bf16x8*)((char*)K_lds + (b) * SHM_K + KSWZ(32 + sr, kc)) = St::tobf(sr_[i].ks1); } while (0)
#define SWAIT() do { if constexpr (SDEPTH == 2) asm volatile("s_waitcnt vmcnt(4)" ::: "memory"); else asm volatile("s_waitcnt vmcnt(0)" ::: "memory"); } while (0)
#define RESC(a) do { if (__any((a) < 1.f)) { if (hi == 0) al_l[r32] = (a); asm volatile("s_waitcnt lgkmcnt(0)" ::: "memory"); \
    for (int d = 0; d < 4; ++d) for (int r = 0; r < 16; ++r) o[d][r] *= al_l[crow(r, hi)]; } } while (0)
  f32x16 pA0, pA1, pB0, pB1; float mnA, mnB, alA, alB; bf16x8 pa0, pa1, pa2, pa3; const int NT = seq / KVBLK;
  constexpr int SE = 0, SO = SDEPTH - 1;
  SLOAD(SE, 0); asm volatile("s_waitcnt vmcnt(0)" ::: "memory"); SWRITE(0, SE); __syncthreads();
  qkt(pA0, pA1, K_lds, qr, r32, hi); partialSM(pA0, pA1, m_reg, mnA, alA);
  SLOAD(SO, KVBLK); if constexpr (SDEPTH == 2) { if (2 < NT) SLOAD(SE, 2 * KVBLK); }
  SWAIT(); SWRITE(1, SO); __syncthreads();
  for (int j = 1; j + 1 < NT; j += 2) {
    SBAR(); qkt(pB0, pB1, (bf16*)((char*)K_lds + SHM_K), qr, r32, hi);
    finishSM(pA0, pA1, alA, l_reg, pa0, pa1, pa2, pa3); SBAR();
    SLOAD(SO, (j + SDEPTH) * KVBLK); SBAR();
    pv_d0(o, vb0, pa0, pa1, pa2, pa3); partialSM(pB0, pB1, m_reg, mnB, alB);
    __syncthreads(); SWAIT(); SWRITE(0, SE);
    RESC(alB); __syncthreads();
    SBAR(); qkt(pA0, pA1, K_lds, qr, r32, hi);
    finishSM(pB0, pB1, alB, l_reg, pa0, pa1, pa2, pa3); SBAR();
    if (SDEPTH == 1 || j + 3 < NT) SLOAD(SE, (j + 1 + SDEPTH) * KVBLK); SBAR();
    pv_d0(o, vb0 + (int)SHM_V, pa0, pa1, pa2, pa3); partialSM(pA0, pA1, m_reg, mnA, alA);
    __syncthreads(); SWAIT(); SWRITE(1, SO);
    RESC(alA); __syncthreads();
  }
  SBAR(); qkt(pB0, pB1, (bf16*)((char*)K_lds + SHM_K), qr, r32, hi);
  finishSM(pA0, pA1, alA, l_reg, pa0, pa1, pa2, pa3); SBAR();
  pv_d0(o, vb0, pa0, pa1, pa2, pa3); partialSM(pB0, pB1, m_reg, mnB, alB);
  __syncthreads(); RESC(alB);
  finishSM(pB0, pB1, alB, l_reg, pa0, pa1, pa2, pa3); SBAR();
  pv_d0(o, vb0 + (int)SHM_V, pa0, pa1, pa2, pa3);
  if (hi == 0) li_l[r32] = l_reg; asm volatile("s_waitcnt lgkmcnt(0)" ::: "memory");
  float rli[16];
#pragma unroll
  for (int r = 0; r < 16; ++r) rli[r] = __builtin_amdgcn_rcpf(li_l[crow(r, hi)]);
  float* Ow = Ob + (long)(wid * QBLK) * LDO;
#pragma unroll
  for (int r = 0; r < 16; ++r) { int orow = crow(r, hi);
    for (int d0 = 0; d0 < 4; ++d0) Ow[(long)orow * LDO + d0 * 32 + r32] = o[d0][r] * rli[r]; }
#undef SLOAD
#undef SWRITE
#undef SWAIT
#undef RESC
}

}

namespace attn256 {
using namespace attn128;
constexpr size_t SHM_V2 = KVBLK * 256 * 2, SHM_K2 = KVBLK * D * 2;
constexpr int LDV = 1024;
__device__ __forceinline__ int v_st2(int k, int c) { const int kk = (k & ~0xC) | ((k & 4) << 1) | ((k & 8) >> 1); return ((kk >> 3) * 8 + (c >> 5)) * 512 + ((kk & 7) * 32 + (c & 31)) * 2; }
constexpr int v_rd_off2(int d0, int ks, int half) { return d0 * 512 + ks * 8192 + half * 4096; }
template <int D0> __device__ __forceinline__ void pv_one2(f32x16& od, int vb, bf16x8 pa0, bf16x8 pa1, bf16x8 pa2, bf16x8 pa3) {
  const s16x4 l0 = tr_read<v_rd_off2(D0, 0, 0)>(vb), h0 = tr_read<v_rd_off2(D0, 0, 1)>(vb), l1 = tr_read<v_rd_off2(D0, 1, 0)>(vb), h1 = tr_read<v_rd_off2(D0, 1, 1)>(vb);
  const s16x4 l2 = tr_read<v_rd_off2(D0, 2, 0)>(vb), h2 = tr_read<v_rd_off2(D0, 2, 1)>(vb), l3 = tr_read<v_rd_off2(D0, 3, 0)>(vb), h3 = tr_read<v_rd_off2(D0, 3, 1)>(vb);
  asm volatile("s_waitcnt lgkmcnt(0)" ::: "memory"); SBAR();
#define PK(L, H) (bf16x8){L[0], L[1], L[2], L[3], H[0], H[1], H[2], H[3]}
  od = __builtin_amdgcn_mfma_f32_32x32x16_bf16(pa0, PK(l0, h0), od, 0, 0, 0);
  od = __builtin_amdgcn_mfma_f32_32x32x16_bf16(pa1, PK(l1, h1), od, 0, 0, 0);
  od = __builtin_amdgcn_mfma_f32_32x32x16_bf16(pa2, PK(l2, h2), od, 0, 0, 0);
  od = __builtin_amdgcn_mfma_f32_32x32x16_bf16(pa3, PK(l3, h3), od, 0, 0, 0);
#undef PK
}
__device__ __forceinline__ void attn_o256_body(const bf16* __restrict__ Qb, const bf16* __restrict__ Kh, const bf16* __restrict__ Vh, float* __restrict__ Ob, int seq, char* lds, int wave_s_) {
  using St = Stage<bf16>;
  int tid = MK_TID(wave_s_); asm volatile("" : "+v"(tid));
  const int wid = tid >> 6, lane = tid & 63, r32 = lane & 31, hi = lane >> 5;
  bf16* V_lds = (bf16*)lds; bf16* K_lds = (bf16*)(lds + 2 * SHM_V2);
  float* ws = (float*)(lds + 2 * SHM_V2 + 2 * SHM_K2) + wid * 64; float* li_l = ws; float* al_l = ws + 32;
  float m_reg = -1e30f, l_reg = 0; f32x16 o[8] = {}; bf16x8 qr[8];
  const bf16* Qw = Qb + (long)(wid * QBLK + r32) * LDQ + hi * 8;
#pragma unroll
  for (int d0 = 0; d0 < 8; ++d0) qr[d0] = St::ld8(Qw + d0 * 16);
  const int vb0 = (int)(uintptr_t)V_lds + v_rd_base(lane);
  bf16x8 sv00, sv01, sv10, sv11, sk0, sk1;
#define SLOAD2(k0) do { const int t_ = MK_TID(wave_s_), sr = t_ >> 4, sc = (t_ & 15) * 8; const bf16* vp = Vh + (long)((k0) + sr) * LDV + sc; const bf16* kp = Kh + (long)((k0) + sr) * LDK + sc; \
    sv00 = St::ld8(vp); sv01 = St::ld8(vp + 128); sv10 = St::ld8(vp + 32 * LDV); sv11 = St::ld8(vp + 32 * LDV + 128); sk0 = St::ld8(kp); sk1 = St::ld8(kp + 32 * LDK); } while (0)
#define SWRITE2(b) do { const int t_ = MK_TID(wave_s_), sr = t_ >> 4, sc = (t_ & 15) * 8; char* vbuf = (char*)V_lds + (b) * SHM_V2 + v_st2(sr, sc); \
    *(bf16x8*)(vbuf) = sv00; *(bf16x8*)(vbuf + 2048) = sv01; *(bf16x8*)(vbuf + 16384) = sv10; *(bf16x8*)(vbuf + 18432) = sv11; \
    char* kbuf = (char*)K_lds + (b) * SHM_K2 + KSWZ(sr, sc * 2); *(bf16x8*)(kbuf) = sk0; *(bf16x8*)(kbuf + 8192) = sk1; } while (0)
  const int NT = seq / KVBLK;
  SLOAD2(0); asm volatile("s_waitcnt vmcnt(0)" ::: "memory"); SWRITE2(0); __syncthreads();
  for (int j = 0; j < NT; ++j) {
    const int b = j & 1;
    f32x16 p0, p1; float mn, al; bf16x8 pa0, pa1, pa2, pa3;
    SBAR(); qkt(p0, p1, (bf16*)((char*)K_lds + b * SHM_K2), qr, r32, hi);
    partialSM(p0, p1, m_reg, mn, al);
    finishSM(p0, p1, al, l_reg, pa0, pa1, pa2, pa3); SBAR();
    if (__any(al < 1.f)) { if (hi == 0) al_l[r32] = al; asm volatile("s_waitcnt lgkmcnt(0)" ::: "memory");
#pragma unroll
      for (int d = 0; d < 8; ++d)
#pragma unroll
        for (int r = 0; r < 16; ++r) o[d][r] *= al_l[crow(r, hi)]; }
    if (j + 1 < NT) SLOAD2((j + 1) * KVBLK);
    SBAR();
    { const int vb = vb0 + b * (int)SHM_V2;
      pv_one2<0>(o[0], vb, pa0, pa1, pa2, pa3); pv_one2<1>(o[1], vb, pa0, pa1, pa2, pa3); pv_one2<2>(o[2], vb, pa0, pa1, pa2, pa3); pv_one2<3>(o[3], vb, pa0, pa1, pa2, pa3);
      pv_one2<4>(o[4], vb, pa0, pa1, pa2, pa3); pv_one2<5>(o[5], vb, pa0, pa1, pa2, pa3); pv_one2<6>(o[6], vb, pa0, pa1, pa2, pa3); pv_one2<7>(o[7], vb, pa0, pa1, pa2, pa3); }
    if (j + 1 < NT) { asm volatile("s_waitcnt vmcnt(0)" ::: "memory"); SWRITE2(b ^ 1); }
    __syncthreads();
  }
  if (hi == 0) li_l[r32] = l_reg; asm volatile("s_waitcnt lgkmcnt(0)" ::: "memory");
  float rli[16];
#pragma unroll
  for (int r = 0; r < 16; ++r) rli[r] = __builtin_amdgcn_rcpf(li_l[crow(r, hi)]);
  float* Ow = Ob + (long)(wid * QBLK) * LDO;
#pragma unroll
  for (int r = 0; r < 16; ++r) { const int orow = crow(r, hi);
#pragma unroll
    for (int d0 = 0; d0 < 8; ++d0) Ow[(long)orow * LDO + d0 * 32 + r32] = o[d0][r] * rli[r]; }
#undef SLOAD2
#undef SWRITE2
}
}

#define GAS __attribute__((address_space(1)))
#define LAS __attribute__((address_space(3)))
typedef unsigned short bf16;
typedef unsigned v4u __attribute__((ext_vector_type(4)));
typedef float f32x4 __attribute__((ext_vector_type(4)));
typedef short bf16x8 __attribute__((ext_vector_type(8)));
typedef GAS unsigned gu32;
typedef GAS unsigned long long gu64;
#define RLX_AGENT __ATOMIC_RELAXED, __HIP_MEMORY_SCOPE_AGENT
#define LDS_WAIT() asm volatile("s_waitcnt lgkmcnt(0)" ::: "memory")
#define VM_WAIT() asm volatile("s_waitcnt vmcnt(0)" ::: "memory")
__device__ __forceinline__ unsigned long long rt() { return __builtin_amdgcn_s_memrealtime(); }
__device__ __forceinline__ unsigned f2bf(float f) { unsigned u = __builtin_bit_cast(unsigned, f); return (u + 0x7fffu + ((u >> 16) & 1u)) >> 16; }
__device__ __forceinline__ unsigned pk2(float lo, float hi) { return f2bf(lo) | (f2bf(hi) << 16); }

#define XB_TMO      128
#define XB_XCNT(j)  (256  + 64 * (j))
#define XB_XSUB(j)  (1280 + 64 * (j))
#define XB_XGEN(j)  (2304 + 64 * (j))
#define XB_TOP      3328
#define XB_TOPGEN   3392
#define XCD_BAR_WORDS 3456
#define XB_SPIN_CAP (1u << 22)

__device__ __forceinline__ unsigned xb_ld(unsigned* p)              { return __hip_atomic_load(p, __ATOMIC_RELAXED, __HIP_MEMORY_SCOPE_AGENT); }
__device__ __forceinline__ unsigned xb_add(unsigned* p, unsigned v) { return __hip_atomic_fetch_add(p, v, __ATOMIC_RELAXED, __HIP_MEMORY_SCOPE_AGENT); }
__device__ __forceinline__ unsigned xb_xcc_id() { return (unsigned)__builtin_amdgcn_s_getreg((3 << 11) | 20) & 0xFu; }
#define XB_SPIN(cond, bar) do { unsigned _sp = 0; while (cond) { __builtin_amdgcn_s_sleep(1); \
    if ((++_sp & 255u) == 0u) { if (xb_ld(&(bar)[XB_TMO])) break; if (_sp > XB_SPIN_CAP) { atomicAdd(&(bar)[XB_TMO], 1u); break; } } } } while (0)

struct XcdBarrier {
    unsigned* bar; unsigned x;
    volatile LAS unsigned* st;
};

__device__ __forceinline__ XcdBarrier xcd_barrier_post(unsigned* bar, volatile LAS unsigned* st, int tid_) {
    XcdBarrier b; b.bar = bar; b.x = xb_xcc_id(); b.st = st;
    if (tid_ == 0) (void)xb_add(&bar[XB_XCNT(b.x)], 1u);
    return b;
}
__device__ __forceinline__ void xcd_barrier_complete(unsigned* bar, unsigned x, unsigned& nloc, unsigned& nx) {
    const unsigned G = gridDim.x * gridDim.y * gridDim.z;
    unsigned sum, cnt, mine, sp = 0u;
    for (;;) {
        sum = 0u; cnt = 0u; mine = 0u;
#pragma unroll
        for (unsigned j = 0; j < 16; ++j) { const unsigned c = xb_ld(&bar[XB_XCNT(j)]); sum += c; cnt += (c > 0u) ? 1u : 0u; mine = (j == x) ? c : mine; }
        if (sum == G) break;
        __builtin_amdgcn_s_sleep(1);
        if ((++sp & 255u) == 0u) { if (xb_ld(&bar[XB_TMO])) break; if (sp > XB_SPIN_CAP) { atomicAdd(&bar[XB_TMO], 1u); break; } }
    }
    nloc = mine > 0u ? mine : 1u; nx = cnt > 0u ? cnt : 1u;
}

__device__ __forceinline__ void xcd_barrier(const XcdBarrier& b, int tid_) {
    asm volatile("s_waitcnt vmcnt(0)" ::: "memory");
    __syncthreads();
    if (tid_ == 0) {
        unsigned* bar = b.bar;
        __builtin_amdgcn_s_waitcnt(0);
        unsigned nloc = b.st[0], nx = b.st[1];
        if (nloc == 0u) { xcd_barrier_complete(bar, b.x, nloc, nx); b.st[0] = nloc; b.st[1] = nx; }
        const unsigned old = xb_add(&bar[XB_XSUB(b.x)], 1u);
        const unsigned gen = old / nloc;
        if (old + 1u == (gen + 1u) * nloc) {
            __builtin_amdgcn_fence(__ATOMIC_RELEASE, "agent");
            asm volatile("s_waitcnt vmcnt(0)" ::: "memory");
            const unsigned og = xb_add(&bar[XB_TOP], 1u);
            const unsigned tg = og / nx;
            if (og + 1u == (tg + 1u) * nx) xb_add(&bar[XB_TOPGEN], 1u);
            else XB_SPIN(xb_ld(&bar[XB_TOPGEN]) == tg, bar);
            __builtin_amdgcn_fence(__ATOMIC_ACQUIRE, "agent");
            xb_add(&bar[XB_XGEN(b.x)], 1u);
            asm volatile("s_waitcnt vmcnt(0)" ::: "memory");
        } else {
            XB_SPIN(xb_ld(&bar[XB_XGEN(b.x)]) == gen, bar);
            __builtin_amdgcn_fence(__ATOMIC_ACQUIRE, "agent");
            asm volatile("s_waitcnt vmcnt(0)" ::: "memory");
        }
    }
    __syncthreads();
}

constexpr int DM = 4096, SEQ = 8192, CTXL = 256, MT = SEQ + CTXL, DEPTH = 4, FFND = 4096;
constexpr int NZ = 20480, INC = 20496, ADAR = 256, NMOD = 9 * DM;
constexpr int ZC_UV = 0, ZC_MQ = 2048, ZC_MK = 2560, ZC_MV = 3072, ZC_MO = 4096, ZC_AQ = 5120, ZC_AK = 6144, ZC_AV = 7168, ZC_MG = 8192;
constexpr float EPS = 1e-6f;
constexpr int NWAVES = 8, NTHR = 512;

constexpr size_t MiB = 1ull << 20;
constexpr size_t WS_CTL = 0, CTL_ZERO_BYTES = 1 * MiB;
constexpr size_t WS_MODTP = 1 * MiB;
constexpr size_t WS_MOD = WS_MODTP + 512 * 1024;
constexpr size_t WS_LAM = WS_MOD + (size_t)DEPTH * 2 * NMOD * 4;
constexpr size_t WS_WG16 = WS_LAM + 256;
constexpr size_t WS_ROPE = WS_WG16 + (size_t)DEPTH * 16 * DM * 4;
constexpr size_t WS_G16 = WS_ROPE + (size_t)2 * SEQ * 64 * 4;
constexpr size_t WS_XR = 9 * MiB;
constexpr size_t SZ_ROWS_F32 = (size_t)MT * DM * 4, SZ_ROWS_BF = (size_t)MT * DM * 2;
constexpr size_t WS_H = WS_XR + SZ_ROWS_F32;
constexpr size_t WS_GB = WS_H + SZ_ROWS_BF;
constexpr size_t WS_Z = WS_GB + SZ_ROWS_BF;
constexpr size_t WS_ATTO = WS_Z + (size_t)MT * NZ * 2;
constexpr size_t WS_MLH = WS_ATTO + (size_t)2 * MT * 1024 * 4;
constexpr size_t WS_YA = WS_MLH + (size_t)2 * MT * 1024 * 4;
constexpr size_t WS_YB = WS_YA + (size_t)MT * 1024 * 2;
constexpr size_t WS_YC = WS_YB + (size_t)MT * 1024 * 2;
constexpr size_t WS_YACC = WS_YC + (size_t)MT * 1024 * 2;
constexpr size_t WS_Y = WS_YACC + SZ_ROWS_F32;
constexpr size_t WS_W13T = WS_Y + SZ_ROWS_BF;
constexpr size_t WS_W2T = WS_W13T + (size_t)DEPTH * 2 * 8192 * 4096 * 2;
constexpr size_t WS_WINT = WS_W2T + (size_t)DEPTH * 2 * 4096 * 4096 * 2;
constexpr size_t WS_WBT = WS_WINT + (size_t)DEPTH * NZ * 4096 * 2;
constexpr size_t WS_WOT = WS_WBT + (size_t)DEPTH * 3 * 4096 * 1024 * 2;
constexpr size_t WS_CT = WS_WOT + (size_t)DEPTH * 4096 * 4096 * 2;
constexpr size_t WS_MSM = WS_CT + (size_t)8 * 66 * 32768 * 2;
constexpr size_t WS_SLAB = WS_MSM + 1 * MiB;
constexpr size_t WS_GWSB = WS_SLAB + (size_t)16 * 256 * DM * 4;
constexpr size_t WS_MS3 = WS_GWSB + (size_t)DEPTH * 8 * 128 * 128 * 2;
constexpr size_t WS_END = WS_MS3 + (size_t)3 * 256 * DM * 4;
static_assert(WS_G16 + (size_t)MT * 16 * 4 <= WS_XR, "small buffers fit below XR");
static_assert(WS_XR % 256 == 0 && WS_H % 256 == 0 && WS_Z % 256 == 0 && WS_W13T % 256 == 0, "alignment");

constexpr int CW_BAR = 4096;

constexpr int RING_OFF = 0, RING_BYTES = 131072;
constexpr int LDSCTL_OFF = 143360, MISC_OFF = LDSCTL_OFF + 320;
constexpr int LDS_BYTES = 147456;

constexpr int P_PRO0 = 0, P_PRO1 = 1, P_LAYER0 = 2;
constexpr int L_N1 = 0, L_W13A = 1, L_W2A = 2, L_N2 = 3, L_WIN = 4, L_MIX1 = 5, L_POST = 6, L_M3 = 7, L_MERGE = 8, L_WOUT = 9, L_N3 = 10, L_W13B = 11, L_W2B = 12, NPL = 13;
constexpr int P_FINAL = P_LAYER0 + DEPTH * NPL, NPH = P_FINAL + 1;

__device__ __forceinline__ float wave_sum(float v) {
#pragma unroll
    for (int o = 1; o < 64; o <<= 1) v += shfl_xor_f(v, o);
    return v;
}
__device__ __forceinline__ float bf2f(unsigned short b) { return __uint_as_float((unsigned)b << 16); }
__device__ __forceinline__ float bflo(unsigned w) { return __uint_as_float(w << 16); }
__device__ __forceinline__ float bfhi(unsigned w) { return __uint_as_float(w & 0xffff0000u); }
__device__ __forceinline__ float sigmoid_f(float x) { return 1.f / (1.f + __expf(-x)); }
__device__ __forceinline__ float silu_f(float x) { return x / (1.f + __expf(-x)); }
__device__ __forceinline__ float gelu_tanh_f(float x) { const float u = 0.7978845608028654f * (x + 0.044715f * x * x * x); return x / (1.f + __expf(-2.f * u)); }
__device__ __forceinline__ float lambda_init_f(int l) { return 0.8f - 0.6f * __expf(-0.3f * (float)l); }

namespace pg8 {
struct CtxSplitOrder {
    int c, G, n;
    const float* MS3; bf16_t* Yc; int wave_s_;
    __device__ __forceinline__ bool next(int i, Unit& u) const { const int L = i * G + c; if (L >= n) return false; u.pm = 0; u.pn = L >> 4; u.koff = (L & 15) * 256; u.boff = u.koff; u.fl = 0; return true; }
    __device__ __forceinline__ void a_ready(const Unit& u) const {
        if (MS3) {
            int t_ = MK_TID(wave_s_); asm volatile("" : "+v"(t_));
            const int r = t_ >> 1, c0 = u.koff + (t_ & 1) * 128;
            const float* p0 = MS3 + (size_t)r * DM + c0; bf16_t* yo = Yc + (size_t)r * DM + c0;
#pragma unroll 1
            for (int ib = 0; ib < 16; ib += 4) { f32x4 q[4][3][2];
#pragma unroll
                for (int i = 0; i < 4; ++i)
#pragma unroll
                    for (int sgm = 0; sgm < 3; ++sgm) { q[i][sgm][0] = *(const f32x4*)(p0 + (size_t)sgm * 256 * DM + 8 * (ib + i)); q[i][sgm][1] = *(const f32x4*)(p0 + (size_t)sgm * 256 * DM + 8 * (ib + i) + 4); }
                asm volatile("" ::: "memory");
#pragma unroll
                for (int i = 0; i < 4; ++i) { const f32x4 a0 = q[i][0][0] + q[i][1][0] + q[i][2][0], a1 = q[i][0][1] + q[i][1][1] + q[i][2][1];
                    u32x4 w; w.x = cvt_pk_bf16(a0[0], a0[1]); w.y = cvt_pk_bf16(a0[2], a0[3]); w.z = cvt_pk_bf16(a1[0], a1[1]); w.w = cvt_pk_bf16(a1[2], a1[3]); *(u32x4*)(yo + 8 * (ib + i)) = w; }
                asm volatile("" ::: "memory"); }
            asm volatile("s_waitcnt vmcnt(0)" ::: "memory");
            asm volatile("" ::: "memory"); __builtin_amdgcn_s_barrier(); asm volatile("" ::: "memory");
        }
    }
    __device__ __forceinline__ void done(const Unit&) const {}
};
struct ResidOrder {
    StaticOrder lat; int c, G, n;
    __device__ __forceinline__ bool next(int i, Unit& u) const {
        const int nl = lat.c < lat.nwg ? (lat.nwg - lat.c + lat.G - 1) / lat.G : 0;
        if (i < nl) { lat.next(i, u); u.pm += 1; return true; }
        const int L = (i - nl) * G + c; if (L >= n) return false;
        u.pm = 0; u.pn = L >> 4; u.koff = (L & 15) * 256; u.boff = u.koff; u.fl = 4 << 8; return true;
    }
    __device__ __forceinline__ void a_ready(const Unit&) const {}
    __device__ __forceinline__ void done(const Unit&) const {}
};
struct MergeOrder {
    StaticOrder lat; int c, G, nctx;
    __device__ __forceinline__ bool next(int i, Unit& u) const {
        const int nl = lat.c < lat.nwg ? (lat.nwg - lat.c + lat.G - 1) / lat.G : 0;
        if (i < 3 * nl) { lat.next(i / 3, u); u.pm += 1; const int sg = i % 3; u.fl = sg | (sg != 0 ? 4 : 0); u.koff = sg * (MT * 1024); u.boff = sg * (4096 * 1024); return true; }
        const int L = (i - 3 * nl) * G + c; if (L >= nctx) return false;
        u.pm = 0; u.pn = L / 3; const int sg = L % 3; u.fl = sg; u.koff = sg * (MT * 1024); u.boff = sg * (4096 * 1024); return true;
    }
    __device__ __forceinline__ void a_ready(const Unit&) const {}
    __device__ __forceinline__ void done(const Unit&) const {}
};
struct EpiSlab {
    static constexpr bool PERM = false, AFTER_DRAIN = false;
    float* S;
    __device__ __forceinline__ void operator()(const f32x4 (&acc)[2][2][4][2], const Unit& u, int wr, int wc, int fr, int fq) const {
        { const int l_ = mk_lane_id(); fr = l_ & 15; fq = l_ >> 4; }
        const int col0 = u.pn * BM + wc * 32 + 4 * fq; float* base = S + (size_t)(u.koff >> 8) * 256 * DM;
#pragma unroll
        for (int ai = 0; ai < 2; ++ai)
#pragma unroll
            for (int m = 0; m < 4; ++m) { float* p = base + (size_t)(ai * HALF + wr * 64 + m * 16 + fr) * DM + col0;
#pragma unroll
                for (int bj = 0; bj < 2; ++bj)
#pragma unroll
                    for (int n = 0; n < 2; ++n) *(f32x4*)(p + bj * HALF + n * 16) = acc[ai][bj][m][n]; }
    }
};
struct EpiWin {
    static constexpr bool PERM = true, AFTER_DRAIN = false;
    bf16_t* ZB; const float* rc; const float* rs;
    __device__ __forceinline__ void operator()(const f32x4 (&acc)[2][2][4][2], const Unit& u, int wr, int wc, int fr, int fq) const {
        { const int l_ = mk_lane_id(); fr = l_ & 15; fq = l_ >> 4; }
        const int pn = u.pn; int kind = 0, ld = 1024, c0 = 0;
        if (pn < 8) { kind = 1; ld = 2048; c0 = 0; } else if (pn < 10) { ld = 512; c0 = 2048; } else if (pn < 12) { ld = 512; c0 = 2560; } else if (pn < 16) { c0 = 3072; }
        else if (pn < 20) { kind = 2; c0 = 4096; } else if (pn < 24) { kind = 3; c0 = 5120; } else if (pn < 28) { kind = 3; c0 = 6144; } else if (pn < 32) { c0 = 7168; } else { kind = 2; ld = 12288; c0 = 8192; }
        if (kind == 3 && u.pm == 0) kind = 0;
        bf16_t* base = ZB + (size_t)MT * c0; const int colt = pn * BM - c0 + wc * 32 + 8 * fq; const int row0 = u.pm * BM + wr * 64 + fr;
#define EPIWIN_LOOP(...) _Pragma("unroll") for (int ai = 0; ai < 2; ++ai) _Pragma("unroll") for (int m = 0; m < 4; ++m) { const int row = row0 + ai * HALF + m * 16; _Pragma("unroll") for (int bj = 0; bj < 2; ++bj) { \
            const int col = colt + bj * HALF; float v[8]; _Pragma("unroll") for (int n = 0; n < 2; ++n) _Pragma("unroll") for (int i = 0; i < 4; ++i) v[n * 4 + i] = acc[ai][bj][m][n][i]; \
            __VA_ARGS__ \
            u32x4 w; w.x = cvt_pk_bf16(v[0], v[1]); w.y = cvt_pk_bf16(v[2], v[3]); w.z = cvt_pk_bf16(v[4], v[5]); w.w = cvt_pk_bf16(v[6], v[7]); *(u32x4*)(base + (size_t)row * ld + col) = w; } }
        if (kind == 0) { EPIWIN_LOOP(;) }
        else if (kind == 1) { EPIWIN_LOOP(_Pragma("unroll") for (int i = 0; i < 8; ++i) { const float x = v[i], uu = 0.7978845608028654f * (x + 0.044715f * x * x * x); v[i] = x / (1.f + __expf(-2.f * uu)); }) }
        else if (kind == 2) { EPIWIN_LOOP(_Pragma("unroll") for (int i = 0; i < 8; ++i) v[i] = 1.f / (1.f + __expf(-v[i]));) }
        else {
#pragma unroll
            for (int ai = 0; ai < 2; ++ai) { f32x4 c4[4][2], s4[4][2];
#pragma unroll
                for (int m = 0; m < 4; ++m)
#pragma unroll
                    for (int bj = 0; bj < 2; ++bj) { const int t = row0 + ai * HALF + m * 16 - CTXL, j0 = ((colt + bj * HALF) & 127) >> 1; c4[m][bj] = *(const f32x4*)(rc + t * 64 + j0); s4[m][bj] = *(const f32x4*)(rs + t * 64 + j0); }
                asm volatile("" ::: "memory");
#pragma unroll
                for (int m = 0; m < 4; ++m)
#pragma unroll
                    for (int bj = 0; bj < 2; ++bj) { const int row = row0 + ai * HALF + m * 16, col = colt + bj * HALF; float v[8];
#pragma unroll
                        for (int n = 0; n < 2; ++n)
#pragma unroll
                            for (int i = 0; i < 4; ++i) v[n * 4 + i] = acc[ai][bj][m][n][i];
#pragma unroll
                        for (int i = 0; i < 4; ++i) { const float x1 = v[2 * i], x2 = v[2 * i + 1]; v[2 * i] = x1 * c4[m][bj][i] - x2 * s4[m][bj][i]; v[2 * i + 1] = x1 * s4[m][bj][i] + x2 * c4[m][bj][i]; }
                        u32x4 w; w.x = cvt_pk_bf16(v[0], v[1]); w.y = cvt_pk_bf16(v[2], v[3]); w.z = cvt_pk_bf16(v[4], v[5]); w.w = cvt_pk_bf16(v[6], v[7]); *(u32x4*)(base + (size_t)row * ld + col) = w; }
                asm volatile("" ::: "memory"); } }
#undef EPIWIN_LOOP
    }
};
struct EpiSwiglu {
    static constexpr bool PERM = true, AFTER_DRAIN = false;
    bf16_t* O; int ldc;
    __device__ __forceinline__ void operator()(const f32x4 (&acc)[2][2][4][2], const Unit& u, int wr, int wc, int fr, int fq) const {
        { const int l_ = mk_lane_id(); fr = l_ & 15; fq = l_ >> 4; }
        const int row0 = u.pm * BM + wr * 64 + fr, col0 = u.pn * HALF + wc * 32 + 8 * fq;
#pragma unroll
        for (int ai = 0; ai < 2; ++ai)
#pragma unroll
            for (int m = 0; m < 4; ++m) {
                bf16_t* rowp = O + (size_t)(row0 + ai * HALF + m * 16) * ldc + col0;
                float v[8];
#pragma unroll
                for (int n = 0; n < 2; ++n)
#pragma unroll
                    for (int i = 0; i < 4; ++i) { const float a = acc[ai][0][m][n][i], b = acc[ai][1][m][n][i]; v[n * 4 + i] = a / (1.f + __expf(-a)) * b; }
                u32x4 w; w.x = cvt_pk_bf16(v[0], v[1]); w.y = cvt_pk_bf16(v[2], v[3]); w.z = cvt_pk_bf16(v[4], v[5]); w.w = cvt_pk_bf16(v[6], v[7]);
                *(u32x4*)rowp = w;
            }
    }
};
struct EpiResid {
    static constexpr bool PERM = false, AFTER_DRAIN = false;
    float* X; const float* gate_lat; const float* gate_ctx; const float* XB; float f;
    __device__ __forceinline__ void operator()(const f32x4 (&acc)[2][2][4][2], const Unit& u, int wr, int wc, int fr, int fq) const {
        { const int l_ = mk_lane_id(); fr = l_ & 15; fq = l_ >> 4; }
        const int col0 = u.pn * BM + wc * 32 + 4 * fq;
        const float* gate = (u.pm == 0) ? gate_ctx : gate_lat;
        f32x4 gv[2][2];
#pragma unroll
        for (int bj = 0; bj < 2; ++bj)
#pragma unroll
            for (int n = 0; n < 2; ++n) gv[bj][n] = *(const f32x4*)(gate + col0 + bj * HALF + n * 16) * f;
#pragma unroll
        for (int ai = 0; ai < 2; ++ai) {
            f32x4 x[4][2][2];
            const size_t o0 = (size_t)(u.pm * BM + ai * HALF + wr * 64 + fr) * DM + col0; float* p0 = X + o0; const float* r0 = XB + o0;
#pragma unroll
            for (int m = 0; m < 4; ++m)
#pragma unroll
                for (int bj = 0; bj < 2; ++bj)
#pragma unroll
                    for (int n = 0; n < 2; ++n) x[m][bj][n] = *(const f32x4*)(r0 + (size_t)(m * 16) * DM + bj * HALF + n * 16);
            asm volatile("" ::: "memory");
#pragma unroll
            for (int m = 0; m < 4; ++m)
#pragma unroll
                for (int bj = 0; bj < 2; ++bj)
#pragma unroll
                    for (int n = 0; n < 2; ++n) *(f32x4*)(p0 + (size_t)(m * 16) * DM + bj * HALF + n * 16) = x[m][bj][n] + gv[bj][n] * acc[ai][bj][m][n];
            asm volatile("" ::: "memory");
        }
    }
};
struct EpiResidSlab {
    static constexpr bool PERM = false, AFTER_DRAIN = false;
    unsigned char* wsb; const float* gate_lat; const float* XB; float f;
    __device__ __forceinline__ void operator()(const f32x4 (&acc)[2][2][4][2], const Unit& u, int wr, int wc, int fr, int fq) const {
        if (u.pm == 0) { EpiSlab E{(float*)(wsb + WS_SLAB)}; E(acc, u, wr, wc, fr, fq); }
        else { EpiResid E{(float*)(wsb + WS_XR), gate_lat, gate_lat, XB, f}; E(acc, u, wr, wc, fr, fq); }
    }
};
struct EpiMergeSeg {
    static constexpr bool PERM = true, AFTER_DRAIN = false;
    const bf16_t* Zg; bf16_t* Y; float* MS3;
    __device__ __forceinline__ void operator()(f32x4 (&acc)[2][2][4][2], const Unit& u, int wr, int wc, int fr, int fq) const {
        { const int l_ = mk_lane_id(); fr = l_ & 15; fq = l_ >> 4; }
        const int seg = u.seg(); const bool ctxp = (u.pm == 0);
        const int col0 = u.pn * BM + wc * 32 + 8 * fq;
#pragma unroll
        for (int ai = 0; ai < 2; ++ai) {
            u32x4 ga[4][2], gb[4][2];
#pragma unroll
            for (int m = 0; m < 4; ++m)
#pragma unroll
                for (int bj = 0; bj < 2; ++bj) { const bf16_t* gp = Zg + (size_t)MT * ZC_MG + (size_t)(u.pm * BM + ai * HALF + wr * 64 + m * 16 + fr) * 12288 + seg * 4096 + col0 + bj * HALF;
                    ga[m][bj] = *(const u32x4*)gp; if (!ctxp && seg < 2) gb[m][bj] = *(const u32x4*)(gp + 4096); }
            asm volatile("" ::: "memory");
#pragma unroll
            for (int m = 0; m < 4; ++m)
#pragma unroll
                for (int bj = 0; bj < 2; ++bj) { const size_t row = (size_t)(u.pm * BM + ai * HALF + wr * 64 + m * 16 + fr); const int col = col0 + bj * HALF;
                    const unsigned aw[4] = {ga[m][bj].x, ga[m][bj].y, ga[m][bj].z, ga[m][bj].w};
                    float g[8];
#pragma unroll
                    for (int k = 0; k < 4; ++k) { g[2 * k] = fmaxf(__uint_as_float(aw[k] << 16), 1e-20f); g[2 * k + 1] = fmaxf(__uint_as_float(aw[k] & 0xffff0000u), 1e-20f); }
                    if (!ctxp && seg < 2) { const unsigned bw[4] = {gb[m][bj].x, gb[m][bj].y, gb[m][bj].z, gb[m][bj].w};
#pragma unroll
                        for (int k = 0; k < 4; ++k) { g[2 * k] = g[2 * k] * __builtin_amdgcn_rcpf(fmaxf(__uint_as_float(bw[k] << 16), 1e-20f)); g[2 * k + 1] = g[2 * k + 1] * __builtin_amdgcn_rcpf(fmaxf(__uint_as_float(bw[k] & 0xffff0000u), 1e-20f)); } }
                    float v[8];
#pragma unroll
                    for (int n = 0; n < 2; ++n)
#pragma unroll
                        for (int i = 0; i < 4; ++i) v[n * 4 + i] = acc[ai][bj][m][n][i] * g[n * 4 + i];
                    if (ctxp) { float* ms = MS3 + ((size_t)seg * 256 + row) * DM + col; *(f32x4*)ms = (f32x4){v[0], v[1], v[2], v[3]}; *(f32x4*)(ms + 4) = (f32x4){v[4], v[5], v[6], v[7]}; }
                    else if (seg < 2) { acc[ai][bj][m][0] = (f32x4){v[0], v[1], v[2], v[3]}; acc[ai][bj][m][1] = (f32x4){v[4], v[5], v[6], v[7]}; }
                    else { u32x4 w; w.x = cvt_pk_bf16(v[0], v[1]); w.y = cvt_pk_bf16(v[2], v[3]); w.z = cvt_pk_bf16(v[4], v[5]); w.w = cvt_pk_bf16(v[6], v[7]); *(u32x4*)(Y + row * DM + col) = w; } }
            asm volatile("" ::: "memory");
        }
    }
};
}

constexpr int TSTR = 68, TSCR_BYTES = 64 * TSTR * 4;
__device__ __forceinline__ void transpose_item(const float* __restrict__ W, size_t ldw, int K, int k0, int srccol0, bf16* WT, int dstrow0, LAS float* scr, int lane) {
    const int r4 = lane >> 4, c16 = lane & 15;
    f32x4 v[16];
#pragma unroll
    for (int i = 0; i < 16; ++i) v[i] = __builtin_nontemporal_load((const f32x4*)(W + (size_t)(k0 + 4 * i + r4) * ldw + srccol0 + 4 * c16));
#pragma unroll
    for (int i = 0; i < 16; ++i) *(LAS f32x4*)(scr + (4 * i + r4) * TSTR + 4 * c16) = v[i];
    LDS_WAIT(); asm volatile("" ::: "memory");
    const int c = lane & 7;
#pragma unroll
    for (int j = 0; j < 8; ++j) { const int n = (lane >> 3) + 8 * j; const LAS float* sp = scr + (8 * c) * TSTR + n;
        v4u o; o.x = pk2(sp[0 * TSTR], sp[1 * TSTR]); o.y = pk2(sp[2 * TSTR], sp[3 * TSTR]); o.z = pk2(sp[4 * TSTR], sp[5 * TSTR]); o.w = pk2(sp[6 * TSTR], sp[7 * TSTR]);
        __builtin_nontemporal_store(o, (GAS v4u*)(WT + (size_t)(dstrow0 + n) * K + k0 + 8 * c)); }
    LDS_WAIT(); asm volatile("" ::: "memory");
}

struct Ptrs {
    const float *x, *c, *ctx, *c_ctx, *ada_down, *ada_up, *ada_bias, *norm_g, *w13, *w2, *w_in, *gmlp_norm_g, *gmlp_ws, *gmlp_bs, *gate_b, *mlstm_norm_g, *diff_lambda, *diff_norm_g, *w_branch, *w_out, *final_g;
    float* out; unsigned char* ws;
};

constexpr int IT_W13 = 2 * 64 * 128, IT_W2 = 2 * 64 * 64, IT_WIN = 64 * 320, IT_WB = 3 * 16 * 64, IT_WO = 64 * 64, IT_LAYER = IT_W13 + IT_W2 + IT_WIN + IT_WB + IT_WO;

__device__ __forceinline__ void convert_range(const Ptrs& P, int l, int it_lo, int it_hi, int widx, int nw, LAS float* scr, int lane) {
    unsigned char* ws = P.ws;
    for (int it = it_lo + widx; it < it_hi; it += nw) {
        int r = it;
        if (r < IT_W13) { const int s = r / (64 * 128), q = r % (64 * 128), kb = q / 128, nb = q % 128, dr = nb * 64, tile = dr >> 8, within = dr & 255;
            const int src = within < 128 ? tile * 128 + within : 4096 + tile * 128 + (within - 128);
            transpose_item(P.w13 + (size_t)(l * 2 + s) * 4096 * 8192, 8192, 4096, kb * 64, src, (bf16*)(ws + WS_W13T) + (size_t)(l * 2 + s) * 8192 * 4096, dr, scr, lane); continue; }
        r -= IT_W13;
        if (r < IT_W2) { const int s = r / (64 * 64), q = r % (64 * 64), kb = q / 64, nb = q % 64;
            transpose_item(P.w2 + (size_t)(l * 2 + s) * 4096 * 4096, 4096, 4096, kb * 64, nb * 64, (bf16*)(ws + WS_W2T) + (size_t)(l * 2 + s) * 4096 * 4096, nb * 64, scr, lane); continue; }
        r -= IT_W2;
        if (r < IT_WIN) { const int kb = r / 320, nb = r % 320, dr = nb * 64, src = dr < 5120 ? dr : dr + 16;
            transpose_item(P.w_in + (size_t)l * 4096 * INC, INC, 4096, kb * 64, src, (bf16*)(ws + WS_WINT) + (size_t)l * NZ * 4096, dr, scr, lane); continue; }
        r -= IT_WIN;
        if (r < IT_WB) { const int i = r / (16 * 64), q = r % (16 * 64), kb = q / 64, nb = q % 64;
            transpose_item(P.w_branch + (size_t)(l * 3 + i) * 1024 * 4096, 4096, 1024, kb * 64, nb * 64, (bf16*)(ws + WS_WBT) + (size_t)(l * 3 + i) * 4096 * 1024, nb * 64, scr, lane); continue; }
        r -= IT_WB;
        { const int kb = r / 64, nb = r % 64;
            transpose_item(P.w_out + (size_t)l * 4096 * 4096, 4096, 4096, kb * 64, nb * 64, (bf16*)(ws + WS_WOT) + (size_t)l * 4096 * 4096, nb * 64, scr, lane); }
    }
}
#ifndef CVP_DA
#define CVP_DA 7
#endif
#ifndef CVP_TA
#define CVP_TA 5
#endif
#ifndef CVP_DW
#define CVP_DW 18
#endif
constexpr int CV_DA = IT_LAYER * CVP_DA / 100, CV_TA = IT_LAYER * CVP_TA / 100, CV_DW = IT_LAYER * CVP_DW / 100;
constexpr int CV0 = 0, CV1 = CV0 + CV_DA, CV2 = CV1 + CV_TA, CV3 = CV2 + CV_DW, CV4 = CV3 + CV_DA, CV_TOT = CV4 + CV_TA;
__device__ __forceinline__ void convert_part(const Ptrs& P, int lnext, int it_lo, int it_hi, int idx, int n, LAS unsigned char* lds, int tid) {
    asm volatile("" : "+v"(tid));
    if (lnext >= DEPTH || idx < 0 || idx >= n) return;
    const int wave = tid >> 6, lane = tid & 63;
    convert_range(P, lnext, it_lo, it_hi, idx * NWAVES + wave, n * NWAVES, (LAS float*)(lds + RING_OFF + wave * TSCR_BYTES), lane);
}
__device__ __forceinline__ void convert_idle(const Ptrs& P, int lnext, int it_lo, int it_hi, int first_idle, int gend, LAS unsigned char* lds, int bid, int tid) {
    if (gend < first_idle + 16) first_idle = 0;
    if (bid >= gend) return;
    convert_part(P, lnext, it_lo, it_hi, bid - first_idle, gend - first_idle, lds, tid);
}
__device__ __forceinline__ void pro0(const Ptrs& P, LAS unsigned char* lds, int bid, int G, int tid) {
    asm volatile("" : "+v"(tid));
    const int wave = tid >> 6, lane = tid & 63;
    LAS float* scr = (LAS float*)(lds + RING_OFF + wave * TSCR_BYTES);
    const int gw = bid * NWAVES + wave, NGW = G * NWAVES;
    unsigned char* ws = P.ws;
    convert_range(P, 0, 0, IT_LAYER, gw, NGW, scr, lane);
    for (int l = 1; l < DEPTH; ++l) convert_range(P, l, CV_TOT, IT_LAYER, gw, NGW, scr, lane);
    const int gt = bid * NTHR + tid, NGT = G * NTHR;
    { float* rc = (float*)(ws + WS_ROPE); float* rs = rc + SEQ * 64;
      for (int i = gt; i < SEQ * 64; i += NGT) { const int t = i >> 6, j = i & 63; const float inv = powf(10000.f, -(float)(j & 31) / 32.f);
          const float pos = (float)(j < 32 ? (t >> 6) : (t & 63)); const float ang = pos * inv; rc[i] = cosf(ang); rs[i] = sinf(ang); } }
    { float* tp = (float*)(ws + WS_MODTP);
      for (int task = gw; task < DEPTH * 2 * 4 * 64; task += NGW) { const int dc = task & 63, rg = (task >> 6) & 3, w = (task >> 8) & 1, l = task >> 9;
          const float* cv = w ? P.c_ctx : P.c; const float* dn = P.ada_down + (size_t)l * DM * ADAR + (size_t)(dc * 64) * ADAR + rg * 64 + lane;
          float wv[64]; const float cmine = cv[dc * 64 + lane], smine = cmine / (1.f + expf(-cmine));
#pragma unroll
          for (int d = 0; d < 64; ++d) wv[d] = dn[(size_t)d * ADAR];
          asm volatile("" ::: "memory");
          float acc = 0.f;
#pragma unroll
          for (int d = 0; d < 64; ++d) acc += __int_as_float(__builtin_amdgcn_readlane(__float_as_int(smine), d)) * wv[d];
          tp[((l * 2 + w) * 64 + dc) * 256 + rg * 64 + lane] = acc; } }
    if (bid == 0 && tid < DEPTH) { const float* dl = P.diff_lambda + tid * 4 * 128; float s1 = 0.f, s2 = 0.f;
        for (int i = 0; i < 128; ++i) { s1 += dl[i] * dl[128 + i]; s2 += dl[256 + i] * dl[384 + i]; }
        ((float*)(ws + WS_LAM))[tid] = expf(s1) - expf(s2) + lambda_init_f(tid); }
    { bf16* wb = (bf16*)(ws + WS_GWSB); for (int i = gt; i < DEPTH * 8 * 128 * 128; i += NGT) wb[i] = (bf16)f2bf(P.gmlp_ws[i]); }
    { bf16* wg = (bf16*)(ws + WS_WG16);
      for (int i = gt; i < DEPTH * DM * 16; i += NGT) { const int j = i & 15, d = (i >> 4) & (DM - 1), l = i >> 16;
          wg[((size_t)l * 16 + j) * DM + d] = (bf16)f2bf(P.w_in[((size_t)l * DM + d) * INC + 5120 + j]); } }
}

__device__ __forceinline__ void pro1(const Ptrs& P, LAS unsigned char* lds, int bid, int G, int tid) {
    asm volatile("" : "+v"(tid));
    LAS float* T = (LAS float*)(lds + RING_OFF);
    const float* tp = (const float*)(P.ws + WS_MODTP);
    for (int i = tid; i < DEPTH * 2 * 256; i += NTHR) { const int r = i & 255, lw = i >> 8; float s = 0.f;
        for (int dc = 0; dc < 64; ++dc) s += tp[(lw * 64 + dc) * 256 + r];
        T[i] = s; }
    __syncthreads();
    float* MOD = (float*)(P.ws + WS_MOD);
    for (int i = bid * NTHR + tid; i < DEPTH * NMOD; i += G * NTHR) { const int l = i / NMOD, n = i % NMOD;
        const float* up = P.ada_up + (size_t)l * ADAR * NMOD + n; const float b = P.ada_bias[(size_t)l * NMOD + n]; float a0 = b, a1 = b;
#pragma unroll 1
        for (int r0 = 0; r0 < ADAR; r0 += 32) { float uu[32];
#pragma unroll
            for (int k = 0; k < 32; ++k) uu[k] = up[(size_t)(r0 + k) * NMOD];
            asm volatile("" ::: "memory");
#pragma unroll
            for (int k = 0; k < 32; ++k) { a0 += T[(l * 2 + 0) * 256 + r0 + k] * uu[k]; a1 += T[(l * 2 + 1) * 256 + r0 + k] * uu[k]; } }
        MOD[(size_t)(l * 2 + 0) * NMOD + n] = a0; MOD[(size_t)(l * 2 + 1) * NMOD + n] = a1; }
    __syncthreads();
}

__device__ __forceinline__ void phase_norm(float* XR, const float* rdl, const float* rdc, const float* prec, const float* g, const float* modl, const float* modc, bf16* H, const float* slab, const float* cgate, float cf, LAS unsigned char* lds, int bid, int G, int tid) {
    asm volatile("" : "+v"(tid));
    const int wave = tid >> 6, lane = tid & 63;
    LAS f32x4* AL = (LAS f32x4*)lds; LAS f32x4* SL = AL + 1024; LAS f32x4* AC = AL + 2048; LAS f32x4* SC = AL + 3072;
    { f32x4 q[2][5];
#pragma unroll
      for (int k = 0; k < 2; ++k) { const int i = tid + k * NTHR; q[k][0] = ((const f32x4*)g)[i]; q[k][1] = ((const f32x4*)(modl + DM))[i]; q[k][2] = ((const f32x4*)modl)[i]; q[k][3] = ((const f32x4*)(modc + DM))[i]; q[k][4] = ((const f32x4*)modc)[i]; }
      asm volatile("" ::: "memory");
#pragma unroll
      for (int k = 0; k < 2; ++k) { const int i = tid + k * NTHR; AL[i] = q[k][0] * (q[k][1] + 1.f); SL[i] = q[k][2]; AC[i] = q[k][0] * (q[k][3] + 1.f); SC[i] = q[k][4]; } }
    const int row0 = bid * NWAVES + wave, stride = G * NWAVES;
    if (slab && row0 < CTXL) {
        f32x4* xw = (f32x4*)(XR + (size_t)row0 * DM) + lane; const f32x4* xpre = (const f32x4*)(prec + (size_t)row0 * DM) + lane; const f32x4* sp = (const f32x4*)(slab + (size_t)row0 * DM) + lane; const f32x4* gp = (const f32x4*)cgate + lane;
#pragma unroll 1
        for (int j = 0; j < 16; j += 2) { f32x4 q[2][16], xo[2];
#pragma unroll
            for (int jj = 0; jj < 2; ++jj) { xo[jj] = xpre[64 * (j + jj)];
#pragma unroll
                for (int kc = 0; kc < 16; ++kc) q[jj][kc] = sp[(size_t)kc * 256 * (DM / 4) + 64 * (j + jj)]; }
            asm volatile("" ::: "memory");
#pragma unroll
            for (int jj = 0; jj < 2; ++jj) { f32x4 a = (f32x4){0.f, 0.f, 0.f, 0.f};
#pragma unroll
                for (int kc = 0; kc < 16; ++kc) a += q[jj][kc];
                xw[64 * (j + jj)] = xo[jj] + a * gp[64 * (j + jj)] * cf; }
            asm volatile("" ::: "memory"); }
        asm volatile("s_waitcnt vmcnt(0)" ::: "memory");
    }
    __syncthreads();
    f32x4 v[16];
    if (row0 < MT) { const f32x4* xr = (const f32x4*)((row0 < CTXL ? rdc : rdl) + (size_t)row0 * DM) + lane;
#pragma unroll
        for (int j = 0; j < 16; ++j) v[j] = xr[64 * j]; }
    for (int row = row0; row < MT; row += stride) {
        f32x4 vn[16];
        if (row + stride < MT) { const f32x4* xr = (const f32x4*)(rdl + (size_t)(row + stride) * DM) + lane;
#pragma unroll
            for (int j = 0; j < 16; ++j) vn[j] = xr[64 * j]; }
        float ss = 0.f;
#pragma unroll
        for (int j = 0; j < 16; ++j) ss += (v[j].x * v[j].x + v[j].y * v[j].y) + (v[j].z * v[j].z + v[j].w * v[j].w);
        const float rstd = 1.f / sqrtf(wave_sum(ss) * (1.f / DM) + EPS);
        const LAS f32x4* Ap = row < CTXL ? AC : AL; const LAS f32x4* Sp = row < CTXL ? SC : SL;
        uint2* hr = (uint2*)(H + (size_t)row * DM) + lane;
#pragma unroll
        for (int j = 0; j < 16; ++j) { const f32x4 hv = v[j] * rstd * Ap[lane + 64 * j] + Sp[lane + 64 * j];
            uint2 o; o.x = pk2(hv.x, hv.y); o.y = pk2(hv.z, hv.w); hr[64 * j] = o; }
#pragma unroll
        for (int j = 0; j < 16; ++j) v[j] = vn[j];
    }
    __syncthreads();
}
typedef float f32x4g __attribute__((ext_vector_type(4)));
__device__ __forceinline__ void gates_unit(const bf16* H, const bf16* WGb, float* G16, int jb, int tid) {
    asm volatile("" : "+v"(tid));
    const int wave = tid >> 6, lane = tid & 63, fr = lane & 15, fq = lane >> 4;
    const bf16* ap = H + (size_t)(jb * 128 + wave * 16 + fr) * DM + 8 * fq; const bf16* bp = WGb + (size_t)fr * DM + 8 * fq;
    f32x4g acc[4];
#pragma unroll
    for (int i = 0; i < 4; ++i) acc[i] = (f32x4g){0.f, 0.f, 0.f, 0.f};
#pragma unroll 1
    for (int k = 0; k < DM; k += 512) { bf16x8 af[16], bfv[16];
#pragma unroll
        for (int i = 0; i < 16; ++i) { af[i] = *(const bf16x8*)(ap + k + 32 * i); bfv[i] = *(const bf16x8*)(bp + k + 32 * i); }
        asm volatile("" ::: "memory");
#pragma unroll
        for (int i = 0; i < 16; ++i) acc[i & 3] = __builtin_amdgcn_mfma_f32_16x16x32_bf16(af[i], bfv[i], acc[i & 3], 0, 0, 0);
    }
    const f32x4g sres = (acc[0] + acc[1]) + (acc[2] + acc[3]);
#pragma unroll
    for (int r = 0; r < 4; ++r) G16[(size_t)(jb * 128 + wave * 16 + 4 * fq + r) * 16 + fr] = sres[r];
}

__device__ __forceinline__ void phase_final(const float* XR, const float* g, float* out, int bid, int G, int tid) {
    asm volatile("" : "+v"(tid));
    const int wave = tid >> 6, lane = tid & 63;
    f32x4 gg[16];
#pragma unroll
    for (int j = 0; j < 16; ++j) gg[j] = *(const f32x4*)(g + 4 * lane + 256 * j);
    for (int t = bid * NWAVES + wave; t < SEQ; t += G * NWAVES) {
        const f32x4* xr = (const f32x4*)(XR + (size_t)(CTXL + t) * DM) + lane;
        f32x4 v[16]; float ss = 0.f;
#pragma unroll
        for (int j = 0; j < 16; ++j) { v[j] = xr[64 * j]; ss += (v[j].x * v[j].x + v[j].y * v[j].y) + (v[j].z * v[j].z + v[j].w * v[j].w); }
        const float rstd = 1.f / sqrtf(wave_sum(ss) * (1.f / DM) + EPS);
        f32x4* o = (f32x4*)(out + (size_t)t * DM) + lane;
#pragma unroll
        for (int j = 0; j < 16; ++j) o[64 * j] = v[j] * rstd * gg[j];
    }
}

typedef short s16x4 __attribute__((ext_vector_type(4)));
typedef float f32x16 __attribute__((ext_vector_type(16)));
typedef short v4i16_t __attribute__((ext_vector_type(4)));
__device__ __forceinline__ int crow16(int r, int hi) { return (r & 3) + 8 * (r >> 2) + 4 * hi; }
__device__ __forceinline__ int chain_cidx(int dir, int jb) { return dir ? (jb < 2 ? 1 - jb : 67 - jb) : jb; }
__device__ __forceinline__ s16x4 trr(LAS const unsigned char* p) { return __builtin_bit_cast(s16x4, __builtin_amdgcn_ds_read_tr16_b64_v4i16((LAS v4i16_t*)p)); }
__device__ __forceinline__ bf16x8 trfrag(LAS const unsigned char* im, int RS, int rowA, int rowB, int n0, int lane) {
    const int i = lane & 15, q = i >> 2, p = i & 3, cb = n0 + 16 * ((lane >> 4) & 1) + 4 * p;
    const s16x4 lo = trr(im + (rowA + q) * RS + cb * 2), hi = trr(im + (rowB + q) * RS + cb * 2);
    return (bf16x8){lo[0], lo[1], lo[2], lo[3], hi[0], hi[1], hi[2], hi[3]};
}
constexpr int VSTR = 528, KW_OFF = 67584;
constexpr int SM_OFF = 133120;
__device__ __forceinline__ void gate_scan(const float* G16, const float* gate_b, int jb, int h, LAS float* SM, int tid) {
    LAS float* SC = SM + 768;
    const int dir = (tid >> 7) & 1, c = tid & 127, o = dir ? 127 - c : c; const bool act = tid < 256;
    float ip = 0.f, x = 0.f;
    if (act) { const size_t row = (size_t)jb * 128 + o; ip = G16[row * 16 + dir * 8 + h] + gate_b[dir * 8 + h]; const float fp = G16[row * 16 + dir * 8 + 4 + h] + gate_b[dir * 8 + 4 + h];
        x = fminf(fp, 0.f) - __logf(1.f + __expf(-fabsf(fp))); }
    for (int s = 1; s < 128; s <<= 1) { if (act) SC[dir * 128 + c] = x; __syncthreads(); if (act && c >= s) x += SC[dir * 128 + c - s]; __syncthreads(); }
    const float b = x, u = ip - b; float y = u;
    for (int s = 1; s < 128; s <<= 1) { if (act) SC[dir * 128 + c] = y; __syncthreads(); if (act && c >= s) y = fmaxf(y, SC[dir * 128 + c - s]); __syncthreads(); }
    if (act) { SM[dir * 128 + o] = u; SM[256 + dir * 128 + o] = y; SM[512 + dir * 128 + o] = b; if (c == 127) { SM[1024 + dir] = b; SM[1026 + dir] = y; } }
    __syncthreads();
}
__device__ __forceinline__ void stage_v(const bf16* Z, size_t row0, int h, LAS unsigned char* VL, int tid) {
    v4u t[8];
#pragma unroll
    for (int k = 0; k < 8; ++k) { const int i = tid + k * NTHR, sr = i >> 5, ch = i & 31; t[k] = *(const v4u*)(Z + (size_t)MT * ZC_MV + (row0 + sr) * 1024 + h * 256 + ch * 8); }
    asm volatile("" ::: "memory");
#pragma unroll
    for (int k = 0; k < 8; ++k) { const int i = tid + k * NTHR, sr = i >> 5, ch = i & 31; *(LAS v4u*)(VL + sr * VSTR + ch * 16) = t[k]; }
}
__device__ __forceinline__ void mlstm_m1_unit(const bf16* Z, const float* G16, const float* gate_b, float* DCT, float* DN, float* CH, int jb, int h, LAS unsigned char* lds, int tid) {
    asm volatile("" : "+v"(tid));
    const int wave = tid >> 6, lane = tid & 63, hh = lane >> 5;
    LAS unsigned char* VL = lds; LAS unsigned char* KW = lds + KW_OFF; LAS float* SM = (LAS float*)(lds + SM_OFF);
    gate_scan(G16, gate_b, jb, h, SM, tid);
    const size_t row0 = (size_t)jb * 128;
    stage_v(Z, row0, h, VL, tid);
    { v4u kq[4];
#pragma unroll
      for (int k = 0; k < 4; ++k) { const int i = tid + k * NTHR, sr = i >> 4, ch = i & 15; kq[k] = *(const v4u*)(Z + (size_t)MT * ZC_MK + (row0 + sr) * 512 + h * 128 + ch * 8); }
      asm volatile("" ::: "memory");
#pragma unroll
      for (int k = 0; k < 4; ++k) { const int i = tid + k * NTHR, sr = i >> 4, ch = i & 15; const v4u kw = kq[k];
#pragma unroll
        for (int dir = 0; dir < 2; ++dir) { const float wg = __expf(SM[dir * 128 + sr] - SM[1026 + dir]); v4u o;
            o.x = pk2(bflo(kw.x) * wg, bfhi(kw.x) * wg); o.y = pk2(bflo(kw.y) * wg, bfhi(kw.y) * wg); o.z = pk2(bflo(kw.z) * wg, bfhi(kw.z) * wg); o.w = pk2(bflo(kw.w) * wg, bfhi(kw.w) * wg);
            *(LAS v4u*)(KW + dir * 32768 + sr * 256 + ch * 16) = o; } } }
    __syncthreads();
    const int dir = wave >> 2, ebp = wave & 3;
    f32x16 acc[2][4];
#pragma unroll
    for (int a = 0; a < 2; ++a)
#pragma unroll
        for (int b = 0; b < 4; ++b)
#pragma unroll
            for (int r = 0; r < 16; ++r) acc[a][b][r] = 0.f;
#pragma unroll 2
    for (int ks = 0; ks < 8; ++ks) {
        bf16x8 af[2], bfr[4];
#pragma unroll
        for (int eb = 0; eb < 2; ++eb) af[eb] = trfrag(VL, VSTR, 16 * ks + 8 * hh, 16 * ks + 8 * hh + 4, 32 * (2 * ebp + eb), lane);
#pragma unroll
        for (int db = 0; db < 4; ++db) bfr[db] = trfrag(KW + dir * 32768, 256, 16 * ks + 8 * hh, 16 * ks + 8 * hh + 4, 32 * db, lane);
#pragma unroll
        for (int eb = 0; eb < 2; ++eb)
#pragma unroll
            for (int db = 0; db < 4; ++db) acc[eb][db] = __builtin_amdgcn_mfma_f32_32x32x16_bf16(af[eb], bfr[db], acc[eb][db], 0, 0, 0);
    }
    { const int cidx = chain_cidx(dir, jb); float* dst = DCT + (size_t)((dir * 4 + h) * 66 + cidx) * 32768;
#pragma unroll
      for (int eb = 0; eb < 2; ++eb)
#pragma unroll
          for (int db = 0; db < 4; ++db)
#pragma unroll
              for (int r = 0; r < 16; ++r) dst[(32 * (2 * ebp + eb) + crow16(r, hh)) * 128 + 32 * db + (lane & 31)] = acc[eb][db][r]; }
    if (tid < 256) { const int dd = tid >> 7, d = tid & 127; float s = 0.f;
        for (int sg = 0; sg < 128; ++sg) s += bf2f(*(LAS const unsigned short*)(KW + dd * 32768 + sg * 256 + d * 2));
        DN[(size_t)((dd * 4 + h) * 66 + chain_cidx(dd, jb)) * 128 + d] = s; }
    if (tid < 2) { float* c = CH + (size_t)((tid * 4 + h) * 66 + chain_cidx(tid, jb)) * 2; c[0] = SM[1024 + tid]; c[1] = SM[1026 + tid]; }
    __syncthreads();
}
__device__ __forceinline__ void mlstm_m2_scalars(const float* CH, int chain, LAS float* SC, int tid) {
    if (tid < 66) { SC[256 + 2 * tid] = CH[(size_t)(chain * 66 + tid) * 2]; SC[256 + 2 * tid + 1] = CH[(size_t)(chain * 66 + tid) * 2 + 1]; }
    __syncthreads();
    if (tid == 0) { float m = 0.f;
        for (int j = 0; j < 66; ++j) { const float Bj = SC[256 + 2 * j], cm = SC[256 + 2 * j + 1], Mx = fmaxf(m, cm); SC[3 * j] = __expf(m - Mx); SC[3 * j + 1] = __expf(cm - Mx); SC[3 * j + 2] = m; m = Bj + Mx; } }
    __syncthreads();
}
__device__ __forceinline__ void mlstm_m2(const float* DCT, const float* DN, const float* CH, bf16* CT, float* NS, float* MS, LAS unsigned char* lds, int bid, int G, int tid) {
    asm volatile("" : "+v"(tid));
    LAS float* SC = (LAS float*)lds;
    for (int base = bid * NTHR; base < 8 * 16384; base += G * NTHR) {
        const int chain = base >> 14, p = (base & 16383) + tid;
        mlstm_m2_scalars(CH, chain, SC, tid);
        if ((base & 16383) == 0 && tid < 66) MS[chain * 66 + tid] = SC[3 * tid + 2];
        const float* dl = DCT + (size_t)chain * 66 * 32768 + 2 * p; unsigned* ct = (unsigned*)(CT + (size_t)chain * 66 * 32768 + 2 * p);
        float c0 = 0.f, c1 = 0.f;
#pragma unroll 1
        for (int jb = 0; jb < 66; jb += 11) { float2 d[11];
#pragma unroll
            for (int k = 0; k < 11; ++k) d[k] = *(const float2*)(dl + (size_t)(jb + k) * 32768);
            asm volatile("" ::: "memory");
#pragma unroll
            for (int k = 0; k < 11; ++k) { const float dec = SC[3 * (jb + k)], sc = SC[3 * (jb + k) + 1]; ct[(size_t)(jb + k) * 16384] = pk2(c0, c1); c0 = dec * c0 + sc * d[k].x; c1 = dec * c1 + sc * d[k].y; }
            asm volatile("" ::: "memory"); }
        __syncthreads();
    }
    for (int chain = bid; chain < 8; chain += G) {
        mlstm_m2_scalars(CH, chain, SC, tid);
        if (tid < 128) { float c0 = 0.f;
#pragma unroll 1
            for (int jb = 0; jb < 66; jb += 11) { float d[11];
#pragma unroll
                for (int k = 0; k < 11; ++k) d[k] = DN[(size_t)(chain * 66 + jb + k) * 128 + tid];
                asm volatile("" ::: "memory");
#pragma unroll
                for (int k = 0; k < 11; ++k) { NS[(size_t)(chain * 66 + jb + k) * 128 + tid] = c0; c0 = SC[3 * (jb + k)] * c0 + SC[3 * (jb + k) + 1] * d[k]; }
                asm volatile("" ::: "memory"); } }
        __syncthreads();
    }
}
__device__ __forceinline__ void mlstm_m3_unit(const bf16* Z, const float* G16, const float* gate_b, const bf16* CT, const float* NS, const float* MS, const float* mng, bf16* YB, int jb, int h, LAS unsigned char* lds, int tid) {
    asm volatile("" : "+v"(tid));
    const int wave = tid >> 6, lane = tid & 63, hh = lane >> 5, l31 = lane & 31;
    LAS unsigned char* VL = lds; LAS float* XCH = (LAS float*)lds; LAS float* SM = (LAS float*)(lds + SM_OFF);
    gate_scan(G16, gate_b, jb, h, SM, tid);
    const size_t row0 = (size_t)jb * 128;
    if (tid < 256) { const int dd = tid >> 7, d = tid & 127; SM[1040 + dd * 128 + d] = NS[(size_t)((dd * 4 + h) * 66 + chain_cidx(dd, jb)) * 128 + d]; }
    if (tid < 2) SM[1028 + tid] = MS[(tid * 4 + h) * 66 + chain_cidx(tid, jb)];
    stage_v(Z, row0, h, VL, tid);
    __syncthreads();
    const int tb = wave & 3, dir = wave >> 2, tau = 32 * tb + l31;
    float SCL = 0.08838834764831845f; asm volatile("" : "+v"(SCL));
    const float m = SM[1028 + dir], cmT = SM[256 + dir * 128 + tau], bT = SM[512 + dir * 128 + tau];
    const float Mt = fmaxf(m, cmT), wa = __expf(m - Mt), em = __expf(-(bT + Mt)), fa = wa * SCL;
    bf16x8 qf[8];
#pragma unroll
    for (int ks = 0; ks < 8; ++ks) qf[ks] = *(const bf16x8*)(Z + (size_t)MT * ZC_MQ + (row0 + tau) * 512 + h * 128 + 16 * ks + 8 * hh);
    f32x16 acc[8];
#pragma unroll
    for (int eb = 0; eb < 8; ++eb)
#pragma unroll
        for (int r = 0; r < 16; ++r) acc[eb][r] = 0.f;
    { const bf16* ct = CT + (size_t)((dir * 4 + h) * 66 + chain_cidx(dir, jb)) * 32768;
#pragma unroll
      for (int e2 = 0; e2 < 8; e2 += 2) { bf16x8 af[2][8];
#pragma unroll
          for (int eb = 0; eb < 2; ++eb)
#pragma unroll
              for (int ks = 0; ks < 8; ++ks) af[eb][ks] = *(const bf16x8*)(ct + (size_t)(32 * (e2 + eb) + l31) * 128 + 16 * ks + 8 * hh);
          asm volatile("" ::: "memory");
#pragma unroll
          for (int ks = 0; ks < 8; ++ks) { acc[e2] = __builtin_amdgcn_mfma_f32_32x32x16_bf16(af[0][ks], qf[ks], acc[e2], 0, 0, 0); acc[e2 + 1] = __builtin_amdgcn_mfma_f32_32x32x16_bf16(af[1][ks], qf[ks], acc[e2 + 1], 0, 0, 0); } } }
    asm volatile("" ::: "memory");
    float den = 0.f;
#pragma unroll
    for (int ks = 0; ks < 8; ++ks)
#pragma unroll
        for (int j = 0; j < 8; ++j) den += bf2f((unsigned short)qf[ks][j]) * SM[1040 + dir * 128 + 16 * ks + 8 * hh + j];
    den *= fa;
#pragma unroll
    for (int eb = 0; eb < 8; ++eb)
#pragma unroll
        for (int r = 0; r < 16; ++r) acc[eb][r] *= fa;
    asm volatile("" ::: "memory");
#pragma unroll 1
    for (int sb = 0; sb < 4; ++sb) {
        if (dir == 0 ? sb > tb : sb < tb) continue;
        asm volatile("" ::: "memory");
        f32x16 p;
#pragma unroll
        for (int r = 0; r < 16; ++r) p[r] = 0.f;
#pragma unroll
        for (int kh = 0; kh < 2; ++kh) { bf16x8 kf[4];
#pragma unroll
          for (int ks = 0; ks < 4; ++ks) kf[ks] = *(const bf16x8*)(Z + (size_t)MT * ZC_MK + (row0 + 32 * sb + l31) * 512 + h * 128 + 16 * (4 * kh + ks) + 8 * hh);
          asm volatile("" ::: "memory");
#pragma unroll
          for (int ks = 0; ks < 4; ++ks) p = __builtin_amdgcn_mfma_f32_32x32x16_bf16(kf[ks], qf[4 * kh + ks], p, 0, 0, 0); }
#pragma unroll
        for (int r = 0; r < 16; ++r) { const int sg = 32 * sb + crow16(r, hh); const bool keep = dir == 0 ? (sg <= tau) : (sg >= tau);
            const float w = keep ? __expf(SM[dir * 128 + sg] - Mt) * SCL : 0.f; p[r] *= w; den += p[r]; }
#pragma unroll
        for (int s = 0; s < 2; ++s) {
            v4u w4; w4.x = pk2(p[8 * s + 0], p[8 * s + 1]); w4.y = pk2(p[8 * s + 2], p[8 * s + 3]); w4.z = pk2(p[8 * s + 4], p[8 * s + 5]); w4.w = pk2(p[8 * s + 6], p[8 * s + 7]);
            const bf16x8 bfrag = __builtin_bit_cast(bf16x8, w4);
#pragma unroll
            for (int eb = 0; eb < 8; ++eb) { const bf16x8 a = trfrag(VL, VSTR, 32 * sb + 16 * s + 4 * hh, 32 * sb + 16 * s + 8 + 4 * hh, 32 * eb, lane);
                acc[eb] = __builtin_amdgcn_mfma_f32_32x32x16_bf16(a, bfrag, acc[eb], 0, 0, 0);
                if (eb & 1) { asm volatile("" ::: "memory"); } }
        }
    }
    den += shfl_xor_f(den, 32);
    { const float inv = 1.f / fmaxf(fabsf(den), em);
#pragma unroll
      for (int eb = 0; eb < 8; ++eb)
#pragma unroll
          for (int r = 0; r < 16; ++r) acc[eb][r] *= inv; }
    __syncthreads();
    LAS float* HS = (LAS float*)lds;
    if (dir == 1) {
#pragma unroll
        for (int eb = 0; eb < 8; ++eb)
#pragma unroll
            for (int r = 0; r < 16; ++r) HS[tau * 257 + 32 * eb + crow16(r, hh)] = acc[eb][r];
    }
    __syncthreads();
    if (dir == 0) {
#pragma unroll
        for (int eb = 0; eb < 8; ++eb)
#pragma unroll
            for (int r = 0; r < 16; ++r) HS[tau * 257 + 32 * eb + crow16(r, hh)] += acc[eb][r];
    }
    __syncthreads();
    {
        unsigned short og[16][4]; float gn[4];
#pragma unroll
        for (int rr = 0; rr < 16; ++rr)
#pragma unroll
            for (int k = 0; k < 4; ++k) og[rr][k] = Z[(size_t)MT * ZC_MO + (row0 + wave * 16 + rr) * 1024 + h * 256 + 64 * k + lane];
#pragma unroll
        for (int k = 0; k < 4; ++k) gn[k] = mng[h * 256 + 64 * k + lane];
#pragma unroll
        for (int rr = 0; rr < 16; ++rr) { const int t2 = wave * 16 + rr; float v[4]; float ss = 0.f;
#pragma unroll
            for (int k = 0; k < 4; ++k) { v[k] = HS[t2 * 257 + 64 * k + lane]; ss += v[k] * v[k]; }
            const float rstd = 1.f / sqrtf(wave_sum(ss) * (1.f / 256.f) + EPS); const size_t row = row0 + t2;
#pragma unroll
            for (int k = 0; k < 4; ++k) YB[row * 1024 + h * 256 + 64 * k + lane] = (bf16)f2bf(bf2f(og[rr][k]) * v[k] * rstd * gn[k]); }
    }
    __syncthreads();
}
__device__ __forceinline__ void gmlp_unit_mfma(const bf16* Z, const float* gng, const bf16* wsb  , const float* bs  , bf16* YA, int j, LAS unsigned char* lds, int tid) {
    asm volatile("" : "+v"(tid));
    const int wave = tid >> 6, lane = tid & 63, g = wave;
    LAS float* ST = (LAS float*)(lds + SM_OFF);
    LAS float* BSL = ST + 256;
    BSL[tid] = bs[tid]; BSL[tid + NTHR] = bs[tid + NTHR];
    LAS unsigned char* VN = lds + wave * 16384;
    const size_t row0 = (size_t)j * 128;
#pragma unroll 1
    for (int rb = 0; rb < 16; rb += 4) { v4u wq[4][2];
#pragma unroll
        for (int r4 = 0; r4 < 4; ++r4) { const v4u* zp = (const v4u*)(Z + (row0 + wave * 16 + rb + r4) * 2048 + 1024 + lane * 16); wq[r4][0] = zp[0]; wq[r4][1] = zp[1]; }
        asm volatile("" ::: "memory");
#pragma unroll
        for (int r4 = 0; r4 < 4; ++r4) { const int q = wave * 16 + rb + r4; const v4u w0 = wq[r4][0], w1 = wq[r4][1];
            float x[16]; const unsigned ww[8] = {w0.x, w0.y, w0.z, w0.w, w1.x, w1.y, w1.z, w1.w};
            float s = 0.f;
#pragma unroll
            for (int k = 0; k < 8; ++k) { x[2 * k] = bflo(ww[k]); x[2 * k + 1] = bfhi(ww[k]); s += x[2 * k] + x[2 * k + 1]; }
            const float mean = wave_sum(s) * (1.f / 1024.f); float s2 = 0.f;
#pragma unroll
            for (int k = 0; k < 16; ++k) { const float d = x[k] - mean; s2 += d * d; }
            const float rstd = 1.f / sqrtf(wave_sum(s2) * (1.f / 1024.f) + EPS);
            if (lane == 0) { ST[2 * q] = mean; ST[2 * q + 1] = rstd; } } }
    __syncthreads();
#pragma unroll 1
    for (int h = 0; h < 2; ++h) {
        const int ln = mk_lane_id(), hh = ln >> 5, l31 = ln & 31;
        const int cbase = g * 128 + 64 * h, c8 = (ln & 7) * 8;
        { const f32x4 g0 = *(const f32x4*)(gng + cbase + c8), g1 = *(const f32x4*)(gng + cbase + c8 + 4);
#pragma unroll 1
          for (int ib = 0; ib < 16; ib += 4) { v4u wv[4];
#pragma unroll
            for (int i4 = 0; i4 < 4; ++i4) wv[i4] = *(const v4u*)(Z + (row0 + (ib + i4) * 8 + (ln >> 3)) * 2048 + 1024 + cbase + c8);
            asm volatile("" ::: "memory");
#pragma unroll
            for (int i4 = 0; i4 < 4; ++i4) { const int q = (ib + i4) * 8 + (ln >> 3); const float mean = ST[2 * q], rstd = ST[2 * q + 1]; const v4u w = wv[i4]; v4u o;
              o.x = pk2((bflo(w.x) - mean) * rstd * g0.x, (bfhi(w.x) - mean) * rstd * g0.y); o.y = pk2((bflo(w.y) - mean) * rstd * g0.z, (bfhi(w.y) - mean) * rstd * g0.w);
              o.z = pk2((bflo(w.z) - mean) * rstd * g1.x, (bfhi(w.z) - mean) * rstd * g1.y); o.w = pk2((bflo(w.w) - mean) * rstd * g1.z, (bfhi(w.w) - mean) * rstd * g1.w);
              *(LAS v4u*)(VN + q * 128 + (ln & 7) * 16) = o; } } }
        LDS_WAIT(); asm volatile("" ::: "memory");
        bf16x8 bfr[8][2];
#pragma unroll
        for (int ks = 0; ks < 8; ++ks)
#pragma unroll
            for (int cb = 0; cb < 2; ++cb) bfr[ks][cb] = trfrag(VN, 128, 16 * ks + 8 * hh, 16 * ks + 8 * hh + 4, 32 * cb, ln);
        f32x16 acc[4][2];
#pragma unroll
        for (int pb = 0; pb < 4; ++pb)
#pragma unroll
            for (int cb = 0; cb < 2; ++cb)
#pragma unroll
                for (int r = 0; r < 16; ++r) acc[pb][cb][r] = 0.f;
#pragma unroll
        for (int pb = 0; pb < 4; ++pb) {
            bf16x8 af[8];
#pragma unroll
            for (int ks = 0; ks < 8; ++ks) af[ks] = *(const bf16x8*)(wsb + (size_t)(g * 128 + 32 * pb + l31) * 128 + 16 * ks + 8 * hh);
            asm volatile("" ::: "memory");
#pragma unroll
            for (int ks = 0; ks < 8; ++ks) { acc[pb][0] = __builtin_amdgcn_mfma_f32_32x32x16_bf16(af[ks], bfr[ks][0], acc[pb][0], 0, 0, 0); acc[pb][1] = __builtin_amdgcn_mfma_f32_32x32x16_bf16(af[ks], bfr[ks][1], acc[pb][1], 0, 0, 0); }
            asm volatile("" ::: "memory");
        }
        LDS_WAIT(); asm volatile("" ::: "memory");
#pragma unroll
        for (int pb = 0; pb < 4; ++pb)
#pragma unroll
            for (int q4 = 0; q4 < 4; ++q4) { const f32x4 b4 = *(const LAS f32x4*)(BSL + g * 128 + 32 * pb + 8 * q4 + 4 * hh);
#pragma unroll
                for (int i = 0; i < 4; ++i) { const int r = 4 * q4 + i, p = 32 * pb + 8 * q4 + 4 * hh + i;
#pragma unroll
                    for (int cb = 0; cb < 2; ++cb) *(LAS unsigned short*)(VN + p * 128 + (32 * cb + l31) * 2) = (unsigned short)f2bf(acc[pb][cb][r] + b4[i]); } }
        LDS_WAIT(); asm volatile("" ::: "memory");
#pragma unroll 1
        for (int ib = 0; ib < 16; ib += 4) { v4u uq[4];
#pragma unroll
            for (int i4 = 0; i4 < 4; ++i4) uq[i4] = *(const v4u*)(Z + (row0 + (ib + i4) * 8 + (ln >> 3)) * 2048 + cbase + c8);
            asm volatile("" ::: "memory");
#pragma unroll
            for (int i4 = 0; i4 < 4; ++i4) { const int p = (ib + i4) * 8 + (ln >> 3); const v4u m = *(const LAS v4u*)(VN + p * 128 + (ln & 7) * 16); const v4u u = uq[i4]; v4u o;
                o.x = pk2(bflo(u.x) * bflo(m.x), bfhi(u.x) * bfhi(m.x)); o.y = pk2(bflo(u.y) * bflo(m.y), bfhi(u.y) * bfhi(m.y));
                o.z = pk2(bflo(u.z) * bflo(m.z), bfhi(u.z) * bfhi(m.z)); o.w = pk2(bflo(u.w) * bflo(m.w), bfhi(u.w) * bfhi(m.w));
                *(v4u*)(YA + (row0 + p) * 1024 + cbase + c8) = o; } }
        LDS_WAIT(); asm volatile("" ::: "memory");
    }
    __syncthreads();
}

__device__ __forceinline__ void phase_post(const float* ATTO, const float* MLH, const bf16* Z, const float* dng, const float* mng, float lam, float linit, bf16* YB, bf16* YC, int bid, int G, int tid) {
    asm volatile("" : "+v"(tid));
    const int wave = tid >> 6, lane = tid & 63, head = lane >> 4, e0 = (lane & 15) * 16;
    for (int row = bid * NWAVES + wave; row < MT; row += G * NWAVES) {
        const size_t off = (size_t)row * 1024 + head * 256 + e0;
        {
            const f32x4* a0 = (const f32x4*)(ATTO + off); const f32x4* a1 = (const f32x4*)(ATTO + (size_t)MT * 1024 + off);
            float o[16]; float ss = 0.f;
#pragma unroll
            for (int k = 0; k < 4; ++k) { const f32x4 p = a0[k], q = a1[k];
                o[4 * k + 0] = p.x - lam * q.x; o[4 * k + 1] = p.y - lam * q.y; o[4 * k + 2] = p.z - lam * q.z; o[4 * k + 3] = p.w - lam * q.w; }
#pragma unroll
            for (int k = 0; k < 16; ++k) ss += o[k] * o[k];
            ss += shfl_xor_f(ss, 1); ss += shfl_xor_f(ss, 2); ss += shfl_xor_f(ss, 4); ss += shfl_xor_f(ss, 8);
            const float rstd = 1.f / sqrtf(ss * (1.f / 256.f) + EPS) * (1.f - linit);
            v4u w0, w1;
            w0.x = pk2(o[0] * rstd * dng[e0 + 0], o[1] * rstd * dng[e0 + 1]); w0.y = pk2(o[2] * rstd * dng[e0 + 2], o[3] * rstd * dng[e0 + 3]);
            w0.z = pk2(o[4] * rstd * dng[e0 + 4], o[5] * rstd * dng[e0 + 5]); w0.w = pk2(o[6] * rstd * dng[e0 + 6], o[7] * rstd * dng[e0 + 7]);
            w1.x = pk2(o[8] * rstd * dng[e0 + 8], o[9] * rstd * dng[e0 + 9]); w1.y = pk2(o[10] * rstd * dng[e0 + 10], o[11] * rstd * dng[e0 + 11]);
            w1.z = pk2(o[12] * rstd * dng[e0 + 12], o[13] * rstd * dng[e0 + 13]); w1.w = pk2(o[14] * rstd * dng[e0 + 14], o[15] * rstd * dng[e0 + 15]);
            v4u* yp = (v4u*)(YC + off); yp[0] = w0; yp[1] = w1;
        }
    }
}

struct Args { const float* in[21]; float* out; unsigned char* ws; int ph_lo, ph_hi; };
static_assert(sizeof(Args) == 21 * 8 + 8 + 8 + 8, "Args has no padding");

constexpr int T_ALL = -1, T_PRO0 = 0, T_PRO1 = 1, T_NORM = 2, T_W13 = 3, T_W2 = 4, T_N2 = 5, T_WIN = 6, T_ROPE = 7, T_MLSTM = 8, T_POST = 9, T_MERGE0 = 10, T_WOUT = 11, T_FINAL = 12, T_ATTN = 13, T_GMLP = 14, T_MERGE1 = 15, T_MERGE2 = 16, T_M3 = 17, NTYPES = 18;
#define SELD(t) (SEL == T_ALL || SEL == (t))
template <int SEL> __global__ void __launch_bounds__(NTHR, 2) mk_fwd(Args args) {
    extern __shared__ __attribute__((aligned(16))) unsigned char lds_raw[];
    LAS unsigned char* lds = (LAS unsigned char*)lds_raw;
    volatile LAS unsigned* MISC = (volatile LAS unsigned*)(lds + MISC_OFF);
    const int wave_s = __builtin_amdgcn_readfirstlane((int)threadIdx.x >> 6), bid_k = blockIdx.x, G = gridDim.x;
#define tid MK_TID(wave_s)
#define KARGS ((const __attribute__((address_space(4))) Args*)ka_)
#define PHASE_BEGIN const __attribute__((address_space(4))) void* ka_ = (const __attribute__((address_space(4))) void*)__builtin_amdgcn_kernarg_segment_ptr(); asm volatile("" : "+s"(ka_)); unsigned char* const ws = KARGS->ws; (void)ws; int bid = bid_k; asm volatile("" : "+s"(bid))
#define PIN(i) (KARGS->in[i])
#define XR ((float*)(ws + WS_XR))
#define H ((bf16*)(ws + WS_H))
#define GB ((bf16*)(ws + WS_GB))
#define Z ((bf16*)(ws + WS_Z))
#define ATTO ((float*)(ws + WS_ATTO))
#define MLH ((float*)(ws + WS_MLH))
#define DCT ((float*)(ws + WS_MLH))
#define YA ((bf16*)(ws + WS_YA))
#define YB ((bf16*)(ws + WS_YB))
#define YC ((bf16*)(ws + WS_YC))
#define SLAB ((float*)(ws + WS_SLAB))
#define YACC ((float*)(ws + WS_YACC))
#define Y ((bf16*)(ws + WS_Y))
#define G16 ((float*)(ws + WS_G16))
#define MOD ((const float*)(ws + WS_MOD))
#define CTS ((bf16*)(ws + WS_CT))
#define DNS ((float*)(ws + WS_MSM))
#define NSS (DNS + 8 * 66 * 128)
#define CHS (NSS + 8 * 66 * 128)
#define MSS (CHS + 8 * 66 * 2)
#define modl (MOD + (size_t)(l * 2 + 0) * NMOD)
#define modc (MOD + (size_t)(l * 2 + 1) * NMOD)
#define W13T0 ((const bf16*)(ws + WS_W13T) + (size_t)(l * 2 + 0) * 8192 * 4096)
#define W13T1 (W13T0 + (size_t)8192 * 4096)
#define W2T0 ((const bf16*)(ws + WS_W2T) + (size_t)(l * 2 + 0) * 4096 * 4096)
#define W2T1 (W2T0 + (size_t)4096 * 4096)
#define WINT ((const bf16*)(ws + WS_WINT) + (size_t)l * NZ * 4096)
#define WBT ((const bf16*)(ws + WS_WBT) + (size_t)(l * 3) * 4096 * 1024)
#define WOT ((const bf16*)(ws + WS_WOT) + (size_t)l * 4096 * 4096)
#define MKP() Ptrs P; P.x = PIN(0); P.c = PIN(1); P.ctx = PIN(2); P.c_ctx = PIN(3); P.ada_down = PIN(4); P.ada_up = PIN(5); P.ada_bias = PIN(6); P.norm_g = PIN(7); \
    P.w13 = PIN(8); P.w2 = PIN(9); P.w_in = PIN(10); P.gmlp_norm_g = PIN(11); P.gmlp_ws = PIN(12); P.gmlp_bs = PIN(13); P.gate_b = PIN(14); \
    P.mlstm_norm_g = PIN(15); P.diff_lambda = PIN(16); P.diff_norm_g = PIN(17); P.w_branch = PIN(18); P.w_out = PIN(19); P.final_g = PIN(20); P.out = KARGS->out; P.ws = KARGS->ws
    for (int u = tid; u < (LDS_BYTES - LDSCTL_OFF) / 4; u += NTHR) ((LAS unsigned*)(lds + LDSCTL_OFF))[u] = 0u;
    __syncthreads();
#if MK_ONE_LAUNCH
    XcdBarrier bar = xcd_barrier_post((unsigned*)((gu32*)(args.ws + WS_CTL) + CW_BAR), MISC + 8, tid);
#define GRID_BAR() do { XcdBarrier b2_ = bar; asm volatile("" : "+s"(b2_.bar)); xcd_barrier(b2_, tid); } while (0)
#else
#define GRID_BAR() do {} while (0)
#endif
    const int lo = args.ph_lo, hi = args.ph_hi;
#define IN(k) (lo <= (k) && (k) < hi)
#define SEAM(k) do { if (IN(k) && IN((k) + 1)) GRID_BAR(); } while (0)

    if (IN(P_PRO0)) { PHASE_BEGIN; MKP(); for (int rep_ = 0; rep_ < DBL_PRO; ++rep_) pro0(P, lds, bid, G, tid); SEAM(P_PRO0); }
    if (IN(P_PRO1)) { PHASE_BEGIN; MKP(); pro1(P, lds, bid, G, tid); SEAM(P_PRO1); }

    for (int l = 0; l < DEPTH; ++l) {
        const int pb = P_LAYER0 + l * NPL;
        if (hi <= pb || lo >= pb + NPL) continue;
#define GEMM_RESID_SPLIT2(Aptr, Bptr, gate_l, fac, ms3, yc, nctx_) do { \
            { pg8::Gemm g{(Aptr) + (size_t)CTXL * DM, (Bptr), SEQ, DM, DM, DM}; pg8::StaticOrder S; S.init(SEQ, DM, G, bid); pg8::EpiResid E{XR + (size_t)CTXL * DM, (gate_l), (gate_l), XR + (size_t)CTXL * DM, (fac)}; \
              pg8::gemm_phase<pg8::EpiResid, pg8::StaticOrder, true, true>(lds + RING_OFF, g, S, E, wave_s); } \
            { pg8::Gemm g{(Aptr), (Bptr), CTXL, DM, 256, DM}; pg8::CtxSplitOrder S{bid, G, (nctx_), (ms3), (yc), wave_s}; pg8::EpiSlab E{SLAB}; \
              pg8::gemm_phase<pg8::EpiSlab, pg8::CtxSplitOrder, true, true>(lds + RING_OFF, g, S, E, wave_s); } } while (0)
#define GEMM_RESID_SPLIT(Aptr, Bptr, gate_l, fac, ms3, yc, nctx_, xb_) do { \
            pg8::Gemm g{(Aptr), (Bptr), MT, DM, DM, DM}; pg8::ResidOrder S; S.lat.init(SEQ, DM, G, bid); S.c = bid; S.G = G; S.n = (nctx_); \
            pg8::EpiResidSlab E{ws, (gate_l), (xb_), (fac)}; \
            pg8::gemm_phase<pg8::EpiResidSlab, pg8::ResidOrder, true, true>(lds + RING_OFF, g, S, E, wave_s); } while (0)
#define GL (G >= 128 ? G - (G >> 4) : G)
#define NC (G - GL)
#define GEMM_LAT(EPI, GW_, Aptr, Bptr, Ncols, Kdim, ...) do { pg8::Gemm g{(Aptr), (Bptr), MT, (Ncols), (Kdim), (Kdim)}; pg8::StaticOrder S; S.init(MT, (Ncols), (GW_), bid); EPI E{__VA_ARGS__}; \
            pg8::gemm_phase<EPI, pg8::StaticOrder, true, true>(lds + RING_OFF, g, S, E, wave_s); } while (0)

        if (IN(pb + L_N1)) { PHASE_BEGIN; MKP(); phase_norm(XR, l == 0 ? P.x - (size_t)CTXL * DM : (const float*)XR, l == 0 ? P.ctx : (const float*)XR, XR, P.norm_g + (size_t)(l * 3 + 0) * DM, modl + 0 * 3 * DM, modc + 0 * 3 * DM, H, l > 0 ? SLAB : nullptr, modc - (size_t)2 * NMOD + 2 * 3 * DM + 2 * DM, 0.5f, lds, bid, G, tid); SEAM(pb + L_N1); }
        if (IN(pb + L_W13A)) { PHASE_BEGIN; MKP();
            if (bid < GL) { GEMM_LAT(pg8::EpiSwiglu, GL, H, W13T0, 8192, DM, GB, FFND);
                            convert_idle(P, l + 1, CV1, CV2, (MT / 256 * 32) % GL, GL, lds, bid, tid); }
            if (NC == 0 || bid >= GL) convert_part(P, l + 1, CV0, CV1, NC ? bid - GL : bid, NC ? NC : G, lds, tid);
            SEAM(pb + L_W13A); }
        if (IN(pb + L_W2A)) { PHASE_BEGIN; MKP();
            GEMM_RESID_SPLIT(GB, W2T0, modl + 0 * 3 * DM + 2 * DM, 0.5f, (const float*)nullptr, (bf16*)nullptr, 256, l == 0 ? P.x - (size_t)CTXL * DM : (const float*)XR);
            SEAM(pb + L_W2A); }
        if (IN(pb + L_N2)) { PHASE_BEGIN; MKP(); phase_norm(XR, XR, XR, l == 0 ? P.ctx : (const float*)XR, P.norm_g + (size_t)(l * 3 + 1) * DM, modl + 1 * 3 * DM, modc + 1 * 3 * DM, H, SLAB, modc + 0 * 3 * DM + 2 * DM, 0.5f, lds, bid, G, tid); SEAM(pb + L_N2); }
        if (IN(pb + L_WIN)) { PHASE_BEGIN; MKP();
            if (bid < GL) { GEMM_LAT(pg8::EpiWin, GL, H, WINT, NZ, DM, Z, (const float*)(ws + WS_ROPE), (const float*)(ws + WS_ROPE) + SEQ * 64); }
            if (NC == 0 || bid >= GL) { convert_part(P, l + 1, CV2, CV3, NC ? bid - GL : bid, NC ? NC : G, lds, tid);
                for (int u = NC ? bid - GL : bid; u < 66; u += (NC ? NC : G)) gates_unit(H, (const bf16*)(ws + WS_WG16) + (size_t)l * 16 * DM, G16, u, tid); }
            SEAM(pb + L_WIN); }
        if (IN(pb + L_MIX1)) { PHASE_BEGIN; MKP();
            for (int rep_ = 0; rep_ < DBL_M1; ++rep_) for (int u = (bid + G - (100 % G)) % G; u < 264; u += G) mlstm_m1_unit(Z, G16, P.gate_b + (size_t)l * 16, DCT, DNS, CHS, u >> 2, u & 3, lds, tid);
            for (int rep_ = 0; rep_ < DBL_ATTN; ++rep_) for (int u = bid; u < (l < DEPTH - 1 ? 264 : 256); u += G) {
                int hm, qb, seq; if (u < 256) { hm = u & 7; qb = 1 + (u >> 3); seq = MT; } else { hm = u - 256; qb = 0; seq = CTXL; }
                const int h = hm >> 1, mm = hm & 1;
                const attn128::bf16* Zb = (const attn128::bf16*)Z;
                attn256::attn_o256_body(Zb + (size_t)MT * ZC_AQ + (size_t)(qb * 256) * 1024 + h * 256 + mm * 128, Zb + (size_t)MT * ZC_AK + h * 256 + mm * 128, Zb + (size_t)MT * ZC_AV + h * 256,
                                        ATTO + (size_t)mm * MT * 1024 + (size_t)(qb * 256) * 1024 + h * 256, seq, (char*)lds_raw, wave_s);
                __syncthreads();
            }
            SEAM(pb + L_MIX1);
        }
        if (IN(pb + L_POST)) { PHASE_BEGIN; MKP();
            for (int rep_ = 0; rep_ < DBL_POST; ++rep_) { mlstm_m2(DCT, DNS, CHS, CTS, NSS, MSS, lds, bid, G, tid); } SEAM(pb + L_POST); }
        if (IN(pb + L_M3)) { PHASE_BEGIN; MKP();
            { const int u0 = (l < DEPTH - 1) ? 0 : 8, nsec = (l < DEPTH - 1) ? (264 - G > 0 ? 264 - G : 0) : 0;
              for (int rep_ = 0; rep_ < DBL_M3; ++rep_) for (int u = u0 + bid; u < 264; u += G) mlstm_m3_unit(Z, G16, P.gate_b + (size_t)l * 16, CTS, NSS, MSS, P.mlstm_norm_g + (size_t)l * 1024, YB, u >> 2, u & 3, lds, tid);
              const int ngm = (G >= 66 + nsec + 8) ? 66 : 0;
              for (int rep_ = 0; rep_ < DBL_GMLP; ++rep_) for (int u = G - 1 - bid; u < 66; u += G) gmlp_unit_mfma(Z, P.gmlp_norm_g + (size_t)l * 1024, (const bf16*)(ws + WS_GWSB) + (size_t)l * 8 * 128 * 128, P.gmlp_bs + (size_t)l * 8 * 128, YA, u, lds, tid);
              if (bid >= nsec && bid < G - ngm) phase_post(ATTO, MLH, Z, P.diff_norm_g + (size_t)l * 256, P.mlstm_norm_g + (size_t)l * 1024, ((const float*)(ws + WS_LAM))[l], lambda_init_f(l), YB, YC, bid - nsec, G - ngm - nsec, tid); }
            SEAM(pb + L_M3); }
        if (IN(pb + L_MERGE)) { PHASE_BEGIN; MKP();
            { pg8::Gemm g{YA, WBT, MT, DM, 1024, 1024}; pg8::MergeOrder S; S.lat.init(SEQ, DM, G, bid); S.c = bid; S.G = G; S.nctx = (l < DEPTH - 1) ? 48 : 0; pg8::EpiMergeSeg E{Z, Y, (float*)(ws + WS_MS3)};
              pg8::gemm_phase<pg8::EpiMergeSeg, pg8::MergeOrder, true, true>(lds + RING_OFF, g, S, E, wave_s); }
            SEAM(pb + L_MERGE); }
        if (IN(pb + L_WOUT)) { PHASE_BEGIN; MKP();
            GEMM_RESID_SPLIT2(Y, WOT, modl + 1 * 3 * DM + 2 * DM, 1.f, (const float*)(ws + WS_MS3), Y, (l < DEPTH - 1) ? 256 : 0);
            SEAM(pb + L_WOUT); }
        if (IN(pb + L_N3)) { PHASE_BEGIN; MKP(); phase_norm(XR, XR, XR, XR, P.norm_g + (size_t)(l * 3 + 2) * DM, modl + 2 * 3 * DM, modc + 2 * 3 * DM, H, SLAB, modc + 1 * 3 * DM + 2 * DM, 1.f, lds, bid, G, tid); SEAM(pb + L_N3); }
        if (IN(pb + L_W13B)) { PHASE_BEGIN; MKP();
            { const int skip = (l < DEPTH - 1) ? 0 : CTXL;
              const int GLb = (l < DEPTH - 1) ? GL : G;
              if (bid < GLb) { pg8::Gemm g{H + (size_t)skip * DM, W13T1, MT - skip, 8192, DM, DM}; pg8::StaticOrder S; S.init(MT - skip, 8192, GLb, bid); pg8::EpiSwiglu E{GB + (size_t)skip * FFND, FFND};
                  pg8::gemm_phase<pg8::EpiSwiglu, pg8::StaticOrder, true, true>(lds + RING_OFF, g, S, E, wave_s);
                  convert_idle(P, l + 1, CV4, CV_TOT, (MT / 256 * 32) % GL, GL, lds, bid, tid); }
              if (NC == 0 || bid >= GL) convert_part(P, l + 1, CV3, CV4, NC ? bid - GL : bid, NC ? NC : G, lds, tid); }
            SEAM(pb + L_W13B); }
        if (IN(pb + L_W2B)) { PHASE_BEGIN; MKP();
            GEMM_RESID_SPLIT(GB, W2T1, modl + 2 * 3 * DM + 2 * DM, 0.5f, (const float*)nullptr, (bf16*)nullptr, (l < DEPTH - 1) ? 256 : 0, (const float*)XR);
            SEAM(pb + L_W2B); }
#undef GEMM_LAT
#undef GL
#undef NC
#undef GEMM_RESID_SPLIT
#undef GEMM_RESID_SPLIT2
    }
    if (IN(P_FINAL)) { PHASE_BEGIN; MKP(); phase_final(XR, P.final_g, P.out, bid, G, tid); }
#undef IN
#undef SEAM
#undef tid
#undef XR
#undef H
#undef GB
#undef Z
#undef ATTO
#undef MLH
#undef DCT
#undef YA
#undef YB
#undef YC
#undef SLAB
#undef YACC
#undef Y
#undef G16
#undef MOD
#undef CTS
#undef DNS
#undef NSS
#undef CHS
#undef MSS
#undef modl
#undef modc
#undef W13T0
#undef W13T1
#undef W2T0
#undef W2T1
#undef WINT
#undef WBT
#undef WOT
}

extern "C" void kernel_launch(void* const* d_in, const int* in_sizes, int n_in, void* d_out, int out_size, void* d_ws, size_t ws_size, hipStream_t stream) {
    static int grid = 0;
    if (grid == 0) {
        if (n_in != 21 || in_sizes[0] != SEQ * DM || out_size != SEQ * DM || ws_size < WS_END) {
            fprintf(stderr, "kernel_launch: unexpected shapes: n_in %d in0 %d out %d ws %zu (need %zu)\n", n_in, n_in > 0 ? in_sizes[0] : -1, out_size, ws_size, (size_t)WS_END); grid = -1; return; }
        int dev = 0, cus = 0;
        if (hipGetDevice(&dev) != hipSuccess || hipDeviceGetAttribute(&cus, hipDeviceAttributeMultiprocessorCount, dev) != hipSuccess) { grid = -1; return; }
        if (hipFuncSetAttribute((const void*)mk_fwd<T_ALL>, hipFuncAttributeMaxDynamicSharedMemorySize, LDS_BYTES) != hipSuccess) { fprintf(stderr, "kernel_launch: hipFuncSetAttribute failed\n"); grid = -1; return; }
        (void)hipGetLastError();
        grid = cus;
    }
    if (grid < 0) return;
    (void)hipMemsetAsync((char*)d_ws + WS_CTL, 0, CTL_ZERO_BYTES, stream);
    Args a{};
    for (int i = 0; i < 21; ++i) a.in[i] = (const float*)d_in[i];
    a.out = (float*)d_out; a.ws = (unsigned char*)d_ws;
#if MK_ONE_LAUNCH
    a.ph_lo = 0; a.ph_hi = NPH;
    hipLaunchKernelGGL(mk_fwd<T_ALL>, dim3(grid), dim3(NTHR), LDS_BYTES, stream, a);
#else
    for (int p = 0; p < NPH; ++p) { a.ph_lo = p; a.ph_hi = p + 1; hipLaunchKernelGGL(mk_fwd<T_ALL>, dim3(grid), dim3(NTHR), LDS_BYTES, stream, a); }
#endif
    const hipError_t le = hipPeekAtLastError();
    if (le != hipSuccess) fprintf(stderr, "kernel_launch: launch failed: %s\n", hipGetErrorName(le));
}
```

```cpp
#include <hip/hip_runtime.h>
#include <hip/hip_bf16.h>
#include <cstdio>
#include <cstdint>
#include <cmath>
#ifndef MLSTM_CHUNKWISE
#define MLSTM_CHUNKWISE 1
#endif
#ifndef MK_ONE_LAUNCH
#define MK_ONE_LAUNCH 1
#endif
#ifndef DBL_ATTN
#define DBL_ATTN 1
#endif
#ifndef DBL_PRO
#define DBL_PRO 1
#endif
#ifndef DBL_M1
#define DBL_M1 1
#endif
#ifndef DBL_GMLP
#define DBL_GMLP 1
#endif
#ifndef DBL_POST
#define DBL_POST 1
#endif
#ifndef DBL_M3
#define DBL_M3 1
#endif
#ifndef DBL_NORM
#define DBL_NORM 1
#endif
__device__ __forceinline__ int mk_lane_id() { int l_; asm volatile("v_mbcnt_lo_u32_b32 %0, -1, 0\n\tv_mbcnt_hi_u32_b32 %0, -1, %0" : "=v"(l_)); return l_; }
#define MK_TID(wave_s_) (((wave_s_) << 6) | mk_lane_id())
namespace pg8 {
#define PG8_LAS __attribute__((address_space(3)))
typedef unsigned short bf16_t;
typedef short bf16x8 __attribute__((ext_vector_type(8)));
typedef float f32x4 __attribute__((ext_vector_type(4)));
typedef unsigned u32x4 __attribute__((ext_vector_type(4)));
constexpr int BM = 256, BK = 64, HALF = 128, HTB = HALF * BK * 2  , STAGE_BYTES = 8 * HTB, NXCD = 8, WGM = 8;

__host__ __device__ __forceinline__ int lds_byte(int r, int c) { const int st = (r >> 4) * 2 + (c >> 5), rr = r & 15, cc = c & 31, ob = rr * 64 + cc * 2; return st * 1024 + (ob ^ (((ob >> 9) & 1) << 5)); }
__host__ __device__ __forceinline__ void stage_rc(int b, int& R, int& C) { const int st = b / 1024, sb = b % 1024, swz = sb ^ (((sb >> 9) & 1) << 5); R = (st >> 1) * 16 + swz / 64; C = (st & 1) * 32 + (swz % 64) / 2; }
__host__ __device__ __forceinline__ int perm32(int rho) { const int n = rho >> 4, i = rho & 15; return 8 * (i >> 2) + 4 * n + (i & 3); }

struct Unit { int pm, pn, koff, boff, fl;
    __device__ __forceinline__ int seg() const { return fl & 3; } __device__ __forceinline__ bool carry() const { return (fl & 4) != 0; } __device__ __forceinline__ int ntile() const { return fl >> 8; } };
struct Gemm { const bf16_t* A; const bf16_t* Bt; int M, N, K, ld; };

struct StaticOrder {
    int nM, nN, nwg, G, c;
    __host__ __device__ void init(int M, int N, int G_, int c_) { nM = M / BM; nN = N / BM; nwg = nM * nN; G = G_; c = c_; }
    __host__ __device__ bool next(int i, Unit& u) const {
        const long L = (long)i * G + c; if (L >= nwg) return false;
        int wgid = (int)L; { const int q = nwg / NXCD, r = nwg % NXCD, xcd = wgid % NXCD, off = wgid / NXCD; wgid = (xcd < r ? xcd * (q + 1) : r * (q + 1) + (xcd - r) * q) + off; }
        const int nig = WGM * nN, gid = wgid / nig, fm = gid * WGM, gsz = (nM - fm) < WGM ? (nM - fm) : WGM;
        u.pm = fm + ((wgid % nig) % gsz); u.pn = (wgid % nig) / gsz; u.koff = 0; u.boff = 0; u.fl = 0; return true;
    }
    __device__ __forceinline__ void a_ready(const Unit&) const {}
    __device__ __forceinline__ void done(const Unit&) const {}
};

__device__ __forceinline__ unsigned cvt_pk_bf16(float lo, float hi) { unsigned r; asm volatile("v_cvt_pk_bf16_f32 %0, %1, %2" : "=v"(r) : "v"(lo), "v"(hi)); return r; }
typedef float f32x2 __attribute__((ext_vector_type(2)));
__device__ __forceinline__ f32x2 gelu_pk(f32x2 v) {
    const f32x2 av = __builtin_elementwise_abs(v), d = av * 0.2316418882f + 1.0f;
    f32x2 t; t.x = __builtin_amdgcn_rcpf(d.x); t.y = __builtin_amdgcn_rcpf(d.y);
    f32x2 q = t * 0.5307027145f + (-0.7265760135f); q = q * t + 0.7107068705f; q = q * t + (-0.142248368f); q = q * t + 0.127414796f; q = q * t;
    const f32x2 s = (v * v) * (-0.72134752044f);
    f32x2 e; e.x = __builtin_amdgcn_exp2f(s.x); e.y = __builtin_amdgcn_exp2f(s.y);
    const f32x2 m = v * (q * e), r = v - m;
    f32x2 o; o.x = v.x < 0.f ? m.x : r.x; o.y = v.y < 0.f ? m.y : r.y; return o;
}

template <int ACT  > struct EpiBf16 {
    static constexpr bool PERM = true, AFTER_DRAIN = false; static_assert(ACT == 0 || ACT == 1, "EpiBf16: ACT is 0 (none) or 1 (gelu_pk)");
    bf16_t* O; int ldc; const float* bias; int split_cols; size_t split_stride; float scale0;
    __device__ __forceinline__ void operator()(const f32x4 (&acc)[2][2][4][2], const Unit& u, int wr, int wc, int fr, int fq) const {
        const int row0 = u.pm * BM + wr * 64 + fr; int colt = u.pn * BM; bf16_t* base = O;
        float sc = 1.f; if (split_cols) { const int t = colt / split_cols; base += (size_t)t * split_stride; colt -= t * split_cols; if (t == 0) sc = scale0; }
        const int col0 = colt + wc * 32 + 8 * fq, bcol0 = u.pn * BM + wc * 32 + 8 * fq;
        f32x4 bv[2][2];
#pragma unroll
        for (int bj = 0; bj < 2; ++bj)
#pragma unroll
            for (int n = 0; n < 2; ++n) bv[bj][n] = bias ? *(const f32x4*)(bias + bcol0 + bj * HALF + 4 * n) : (f32x4){0.f, 0.f, 0.f, 0.f};
#pragma unroll
        for (int ai = 0; ai < 2; ++ai)
#pragma unroll
            for (int m = 0; m < 4; ++m) { bf16_t* rowp = base + (size_t)(row0 + ai * HALF + m * 16) * ldc + col0;
#pragma unroll
                for (int bj = 0; bj < 2; ++bj) { f32x4 v0 = acc[ai][bj][m][0] + bv[bj][0], v1 = acc[ai][bj][m][1] + bv[bj][1];
                    if (ACT == 1) { f32x2 a = gelu_pk((f32x2){v0[0], v0[1]}), b = gelu_pk((f32x2){v0[2], v0[3]}), c = gelu_pk((f32x2){v1[0], v1[1]}), d = gelu_pk((f32x2){v1[2], v1[3]});
                        v0 = (f32x4){a.x, a.y, b.x, b.y}; v1 = (f32x4){c.x, c.y, d.x, d.y}; }
                    v0 = v0 * sc; v1 = v1 * sc; u32x4 w; w.x = cvt_pk_bf16(v0[0], v0[1]); w.y = cvt_pk_bf16(v0[2], v0[3]); w.z = cvt_pk_bf16(v1[0], v1[1]); w.w = cvt_pk_bf16(v1[2], v1[3]);
                    *(u32x4*)(rowp + bj * HALF) = w; } }
    }
};

struct PanelStats {
    unsigned* xbuf;
    unsigned* cnt;
    unsigned* tmo;
    int ntn; float eps;
    unsigned code;
    __device__ __forceinline__ bool run(const f32x4 (&v)[2][2][4][2], const Unit& u, int wr, int wc, int fr, int fq, PG8_LAS unsigned char* lds, int wid, int lane) const {
        typedef float f32x2v __attribute__((ext_vector_type(2)));
        PG8_LAS f32x2v* P = (PG8_LAS f32x2v*)lds;
        PG8_LAS f32x2v* S = (PG8_LAS f32x2v*)(lds + 8192);
        PG8_LAS unsigned* flag = (PG8_LAS unsigned*)(lds + 8192 + 2048);
#pragma unroll
        for (int ai = 0; ai < 2; ++ai)
#pragma unroll
            for (int m = 0; m < 4; ++m) {
                float s = 0.f;
#pragma unroll
                for (int bj = 0; bj < 2; ++bj)
#pragma unroll
                    for (int n = 0; n < 2; ++n) { const f32x4 x = v[ai][bj][m][n]; s += (x[0] + x[1]) + (x[2] + x[3]); }
                s += __shfl_xor(s, 16); s += __shfl_xor(s, 32);
                const float mw = s * (1.0f / 64.0f); float q = 0.f;
#pragma unroll
                for (int bj = 0; bj < 2; ++bj)
#pragma unroll
                    for (int n = 0; n < 2; ++n) { const f32x4 d = v[ai][bj][m][n] - mw; q += (d[0] * d[0] + d[1] * d[1]) + (d[2] * d[2] + d[3] * d[3]); }
                q += __shfl_xor(q, 16); q += __shfl_xor(q, 32);
                if (fq == 0) P[(ai * HALF + wr * 64 + m * 16 + fr) * 4 + wc] = (f32x2v){mw, q};
            }
        asm volatile("s_waitcnt lgkmcnt(0)" ::: "memory"); __builtin_amdgcn_s_barrier(); asm volatile("" ::: "memory");
#if defined(BROKEN_EXCHANGE_NO_WAIT)
#warning BROKEN CONTROL BUILD: the row-statistics exchange does not wait; results are wrong by design
        if (blockIdx.x >= 64) { const long long t0_ = clock64(); while (clock64() - t0_ < 60000) __builtin_amdgcn_s_sleep(8); }
#endif
        const int row = wid * 32 + (lane & 31);
        if (lane < 32) {
            const f32x2v a = P[row * 4 + 0], b = P[row * 4 + 1], c = P[row * 4 + 2], d = P[row * 4 + 3];
            const float mt = (a.x + b.x + c.x + d.x) * 0.25f;
            const float da = a.x - mt, db = b.x - mt, dc = c.x - mt, dd = d.x - mt;
            const float m2 = (a.y + b.y) + (c.y + d.y) + 64.0f * ((da * da + db * db) + (dc * dc + dd * dd));
            unsigned long long* slot = (unsigned long long*)xbuf + ((size_t)(u.pm * BM + row) * 4 + u.pn);
            __hip_atomic_store(slot, ((unsigned long long)__float_as_uint(m2) << 32) | __float_as_uint(mt), __ATOMIC_RELAXED, __HIP_MEMORY_SCOPE_AGENT);
        }
        asm volatile("s_waitcnt vmcnt(0)" ::: "memory");
        if (lane == 0) __hip_atomic_fetch_add(cnt + 64 * u.pm, 1u, __ATOMIC_RELAXED, __HIP_MEMORY_SCOPE_AGENT);
        if (wid == 0) {
            bool dead = false; const unsigned long long t0 = __builtin_amdgcn_s_memrealtime(); const unsigned want = 8u * (unsigned)ntn;
            for (;;) {
#if defined(BROKEN_EXCHANGE_NO_WAIT)
                break;
#endif
                if ((unsigned)__builtin_amdgcn_readfirstlane(__hip_atomic_load(cnt + 64 * u.pm, __ATOMIC_RELAXED, __HIP_MEMORY_SCOPE_AGENT)) >= want) break;
                if (__builtin_amdgcn_s_memrealtime() - t0 > 2000000ull) {
                    if (lane == 0) { unsigned expect = 0u; __hip_atomic_compare_exchange_strong(tmo + 1, &expect, code | (unsigned)(u.pm & 0xff), __ATOMIC_RELAXED, __ATOMIC_RELAXED, __HIP_MEMORY_SCOPE_AGENT);
                                     __hip_atomic_store(tmo, 1u, __ATOMIC_RELAXED, __HIP_MEMORY_SCOPE_AGENT); }
                    dead = true; break; }
                __builtin_amdgcn_s_sleep(2);
            }
            __builtin_amdgcn_fence(__ATOMIC_ACQUIRE, "agent");
            if (lane == 0) flag[0] = dead ? 1u : 0u;
        }
        asm volatile("s_waitcnt vmcnt(0) lgkmcnt(0)" ::: "memory"); __builtin_amdgcn_s_barrier(); asm volatile("" ::: "memory");
        const bool bad = flag[0] != 0u;
        if (lane < 32) {
            const unsigned long long* slot = (const unsigned long long*)xbuf + (size_t)(u.pm * BM + row) * 4; float mt[4], m2[4]; float ms = 0.f;
#pragma unroll
            for (int t = 0; t < 4; ++t) { if (t < ntn) { const unsigned long long w = __hip_atomic_load(slot + t, __ATOMIC_RELAXED, __HIP_MEMORY_SCOPE_AGENT); mt[t] = __uint_as_float((unsigned)w); m2[t] = __uint_as_float((unsigned)(w >> 32)); } else { mt[t] = 0.f; m2[t] = 0.f; } ms += mt[t]; }
            const float mean = ms / (float)ntn; float q = 0.f;
#pragma unroll
            for (int t = 0; t < 4; ++t) if (t < ntn) { const float dm = mt[t] - mean; q += m2[t] + 256.0f * dm * dm; }
            S[row] = (f32x2v){mean, 1.0f / sqrtf(q / (256.0f * (float)ntn) + eps)};
        }
        asm volatile("s_waitcnt lgkmcnt(0)" ::: "memory"); __builtin_amdgcn_s_barrier(); asm volatile("" ::: "memory");
        return bad;
    }
};
struct EpiLnRes {
    static constexpr bool PERM = false, AFTER_DRAIN = true;
    const float* base; float* out; int ldc; const float* bias; PanelStats st; unsigned poison;
    __device__ __forceinline__ void fused(f32x4 (&acc)[2][2][4][2], const Unit& u, int wr, int wc, int fr, int fq, PG8_LAS unsigned char* lds, int wid, int lane) const {
        typedef float f32x2v __attribute__((ext_vector_type(2)));
        const PG8_LAS f32x2v* S = (const PG8_LAS f32x2v*)(lds + 8192);
        const int col0 = u.pn * BM + wc * 32 + 4 * fq;
#pragma unroll
        for (int bj = 0; bj < 2; ++bj)
#pragma unroll
            for (int n = 0; n < 2; ++n) { const f32x4 bv = bias ? *(const f32x4*)(bias + col0 + bj * HALF + n * 16) : (f32x4){0.f, 0.f, 0.f, 0.f};
#pragma unroll
                for (int ai = 0; ai < 2; ++ai)
#pragma unroll
                    for (int m = 0; m < 4; ++m) acc[ai][bj][m][n] += bv; }
        f32x4 pre[4][2][2];
#pragma unroll
        for (int m = 0; m < 4; ++m) { const size_t off = (size_t)(u.pm * BM + wr * 64 + m * 16 + fr) * ldc + col0;
#pragma unroll
            for (int bj = 0; bj < 2; ++bj)
#pragma unroll
                for (int n = 0; n < 2; ++n) pre[m][bj][n] = *(const f32x4*)(base + off + bj * HALF + n * 16); }
        const bool bad = st.run(acc, u, wr, wc, fr, fq, lds, wid, lane) || poison != 0u;
        const float qnan = __builtin_nanf("");
#pragma unroll
        for (int ai = 0; ai < 2; ++ai)
#pragma unroll
            for (int m = 0; m < 4; ++m) { const int r = ai * HALF + wr * 64 + m * 16 + fr; const f32x2v sr = S[r]; const size_t off = (size_t)(u.pm * BM + r) * ldc + col0;
#pragma unroll
                for (int bj = 0; bj < 2; ++bj)
#pragma unroll
                    for (int n = 0; n < 2; ++n) { const f32x4 bs = ai == 0 ? pre[m][bj][n] : *(const f32x4*)(base + off + bj * HALF + n * 16); f32x4 o = bs + (acc[ai][bj][m][n] - sr.x) * sr.y;
                        if (bad) o = (f32x4){qnan, qnan, qnan, qnan}; *(f32x4*)(out + off + bj * HALF + n * 16) = o; }
                if (m & 1) asm volatile("" ::: "memory"); }
    }
};
struct EpiLnResLn {
    static constexpr bool PERM = false, AFTER_DRAIN = true;
    const float* base; float* out; bf16_t* xn; int ldc; const float* bias; PanelStats st1, st2; unsigned poison;
    __device__ __forceinline__ void fused(f32x4 (&acc)[2][2][4][2], const Unit& u, int wr, int wc, int fr, int fq, PG8_LAS unsigned char* lds, int wid, int lane) const {
        typedef float f32x2v __attribute__((ext_vector_type(2))); typedef unsigned u32x2v __attribute__((ext_vector_type(2)));
        const PG8_LAS f32x2v* S = (const PG8_LAS f32x2v*)(lds + 8192);
        const int col0 = u.pn * BM + wc * 32 + 4 * fq;
#pragma unroll
        for (int bj = 0; bj < 2; ++bj)
#pragma unroll
            for (int n = 0; n < 2; ++n) { const f32x4 bv = bias ? *(const f32x4*)(bias + col0 + bj * HALF + n * 16) : (f32x4){0.f, 0.f, 0.f, 0.f};
#pragma unroll
                for (int ai = 0; ai < 2; ++ai)
#pragma unroll
                    for (int m = 0; m < 4; ++m) acc[ai][bj][m][n] += bv; }
        bool bad = st1.run(acc, u, wr, wc, fr, fq, lds, wid, lane) || poison != 0u;
        const float qnan = __builtin_nanf("");
#pragma unroll
        for (int ai = 0; ai < 2; ++ai)
#pragma unroll
            for (int m = 0; m < 4; ++m) { const int r = ai * HALF + wr * 64 + m * 16 + fr; const f32x2v sr = S[r]; const size_t off = (size_t)(u.pm * BM + r) * ldc + col0;
#pragma unroll
                for (int bj = 0; bj < 2; ++bj)
#pragma unroll
                    for (int n = 0; n < 2; ++n) { const f32x4 bs = *(const f32x4*)(base + off + bj * HALF + n * 16); acc[ai][bj][m][n] = bs + (acc[ai][bj][m][n] - sr.x) * sr.y; }
                asm volatile("" : "+v"(acc[ai][0][m][0]), "+v"(acc[ai][0][m][1]), "+v"(acc[ai][1][m][0]), "+v"(acc[ai][1][m][1]));
                if (m & 1) asm volatile("" ::: "memory"); }
        const bool bad1 = bad;
        bad = st2.run(acc, u, wr, wc, fr, fq, lds, wid, lane) || bad;
#pragma unroll
        for (int ai = 0; ai < 2; ++ai)
#pragma unroll
            for (int m = 0; m < 4; ++m) { const int r = ai * HALF + wr * 64 + m * 16 + fr; const f32x2v sr = S[r]; const size_t off = (size_t)(u.pm * BM + r) * ldc + col0;
#pragma unroll
                for (int bj = 0; bj < 2; ++bj)
#pragma unroll
                    for (int n = 0; n < 2; ++n) { const f32x4 x1 = acc[ai][bj][m][n]; *(f32x4*)(out + off + bj * HALF + n * 16) = bad1 ? (f32x4){qnan, qnan, qnan, qnan} : x1;
                        const f32x4 o = (x1 - sr.x) * sr.y; u32x2v w; w.x = cvt_pk_bf16(o[0], o[1]); w.y = cvt_pk_bf16(o[2], o[3]);
                        if (bad) { w.x = 0x7fc07fc0u; w.y = 0x7fc07fc0u; } *(u32x2v*)(xn + off + bj * HALF + n * 16) = w; }
                asm volatile("" ::: "memory"); }
    }
};

template <class Epi, class Sched, bool ALIGN_EPI = false, bool SP2 = false>
__device__ __forceinline__ void gemm_phase(PG8_LAS unsigned char* lds, const Gemm g, const Sched& S, const Epi& E, int wave_s_) {
    int tid = MK_TID(wave_s_); asm volatile("" : "+v"(tid));
    const int wid = __builtin_amdgcn_readfirstlane(tid >> 6), lane = tid & 63, wr = wid >> 2, wc = wid & 3, fr = lane & 15, fq = lane >> 4;
    const int K = g.K, nt_def = K / BK;
    unsigned voffA[2], voffB[2];
#pragma unroll
    for (int i = 0; i < 2; ++i) { int R, C; stage_rc(tid * 16 + i * 8192, R, C); const int Rb = Epi::PERM ? ((R & ~31) + perm32(R & 31)) : R;
        voffA[i] = (unsigned)(R * g.ld + C) * 2u; voffB[i] = (unsigned)(Rb * g.ld + C) * 2u; }
    const size_t kstep = (size_t)(BK * 2);
    const size_t hstep = (size_t)HALF * g.ld * 2;
    const size_t tstep = 2 * hstep;
    const unsigned ldsw = (unsigned)wid * 1024u;
    const int aoff = lds_byte(wr * 64 + fr, fq * 8), boff = lds_byte(wc * 32 + fr, fq * 8);
#define PG8_SA(b, h) (((b) * 2 + (h)) * HTB)
#define PG8_SB(b, h) ((4 + (b) * 2 + (h)) * HTB)
#define PG8_STAGE(bufoff, gbase, voff) do { _Pragma("unroll") for (int _i = 0; _i < 2; ++_i) \
        __builtin_amdgcn_global_load_lds((const unsigned*)((const char*)(gbase) + (voff)[_i]), (PG8_LAS unsigned*)(lds + (bufoff) + ldsw + _i * 8192), 16, 0, 0); } while (0)
#define PG8_LDA(dst, b, h) do { _Pragma("unroll") for (int m = 0; m < 4; ++m) _Pragma("unroll") for (int k = 0; k < 2; ++k) dst[m][k] = *(const PG8_LAS bf16x8*)(lds + PG8_SA(b, h) + aoff + m * 2048 + k * 1024); } while (0)
#define PG8_LDB(dst, b, h) do { _Pragma("unroll") for (int n = 0; n < 2; ++n) _Pragma("unroll") for (int k = 0; k < 2; ++k) dst[n][k] = *(const PG8_LAS bf16x8*)(lds + PG8_SB(b, h) + boff + n * 2048 + k * 1024); } while (0)
#define PG8_MMA(ai, bj, At, Bt) do { __builtin_amdgcn_s_setprio(1); _Pragma("unroll") for (int m = 0; m < 4; ++m) _Pragma("unroll") for (int n = 0; n < 2; ++n) _Pragma("unroll") for (int k = 0; k < 2; ++k) \
        acc[ai][bj][m][n] = __builtin_amdgcn_mfma_f32_16x16x32_bf16(Bt[n][k], At[m][k], acc[ai][bj][m][n], 0, 0, 0); __builtin_amdgcn_s_setprio(0); } while (0)
#define PG8_WAIT_V(n) asm volatile("s_waitcnt vmcnt(" #n ")" ::: "memory")
#define PG8_WAIT_L(n) asm volatile("s_waitcnt lgkmcnt(" #n ")" ::: "memory")
#define PG8_BAR __builtin_amdgcn_s_barrier()
#define PG8_SCHED __builtin_amdgcn_sched_barrier(0)
    Unit cur, nxt; int ui = 0;
    if (!S.next(0, cur)) return;
    f32x4 acc[2][2][4][2];
#pragma unroll
    for (int a = 0; a < 2; ++a)
#pragma unroll
        for (int b = 0; b < 2; ++b)
#pragma unroll
            for (int m = 0; m < 4; ++m)
#pragma unroll
                for (int n = 0; n < 2; ++n) acc[a][b][m][n] = (f32x4){0.f, 0.f, 0.f, 0.f};
    bf16x8 At[4][2], B0[2][2], B1[2][2];
    const char* cA = (const char*)g.A + (size_t)cur.pm * tstep + (size_t)cur.koff * 2; const char* cB = (const char*)g.Bt + (size_t)cur.pn * tstep + (size_t)cur.boff * 2;
    S.a_ready(cur);
    if constexpr (SP2) {
        PG8_STAGE(PG8_SB(0, 0), cB, voffB); PG8_STAGE(PG8_SB(0, 1), cB + hstep, voffB); PG8_STAGE(PG8_SA(0, 0), cA, voffA); PG8_STAGE(PG8_SA(0, 1), cA + hstep, voffA);
        if (wr == 1) PG8_BAR;
        PG8_WAIT_V(2); PG8_BAR;
        PG8_STAGE(PG8_SB(1, 0), cB + kstep, voffB); PG8_STAGE(PG8_SA(1, 0), cA + kstep, voffA); PG8_STAGE(PG8_SB(1, 1), cB + hstep + kstep, voffB);
        PG8_WAIT_V(6); PG8_BAR;
    } else {
        PG8_STAGE(PG8_SB(0, 0), cB, voffB); PG8_STAGE(PG8_SA(0, 0), cA, voffA); PG8_STAGE(PG8_SB(0, 1), cB + hstep, voffB); PG8_STAGE(PG8_SA(0, 1), cA + hstep, voffA);
        if (wr == 1) PG8_BAR;
        PG8_WAIT_V(4); PG8_BAR;
        PG8_STAGE(PG8_SB(1, 0), cB + kstep, voffB); PG8_STAGE(PG8_SA(1, 0), cA + kstep, voffA); PG8_STAGE(PG8_SB(1, 1), cB + hstep + kstep, voffB);
        PG8_WAIT_V(6); PG8_BAR;
    }
    for (;;) {
        const bool has_next = S.next(ui + 1, nxt);
        const char* nA = has_next ? (const char*)g.A + (size_t)nxt.pm * tstep + (size_t)nxt.koff * 2 : cA; const char* nB = has_next ? (const char*)g.Bt + (size_t)nxt.pn * tstep + (size_t)nxt.boff * 2 : cB;
        const int nt = cur.ntile() ? cur.ntile() : nt_def;
        for (int t = 0; t < nt; t += 2) {
            const bool last = (t == nt - 2);
            const char* a1 = cA + (size_t)(t + 1) * kstep;
            const char* a2 = last ? nA : cA + (size_t)(t + 2) * kstep; const char* b2 = last ? nB : cB + (size_t)(t + 2) * kstep;
            const char* a3 = a2 + kstep; const char* b3 = b2 + kstep;
            if (last && has_next) S.a_ready(nxt);
            if constexpr (SP2) {
            PG8_LDB(B0, 0, 0); PG8_LDB(B1, 0, 1); PG8_SCHED; PG8_LDA(At, 0, 0); PG8_STAGE(PG8_SA(1, 1), a1 + hstep, voffA);
            PG8_WAIT_V(8); PG8_WAIT_L(0); PG8_BAR; PG8_MMA(0, 0, At, B0); PG8_MMA(0, 1, At, B1); PG8_BAR; PG8_SCHED;
            PG8_LDA(At, 0, 1); PG8_STAGE(PG8_SB(0, 0), b2, voffB); PG8_STAGE(PG8_SB(0, 1), b2 + hstep, voffB); PG8_STAGE(PG8_SA(0, 0), a2, voffA);
            PG8_WAIT_V(8); PG8_WAIT_L(0); PG8_BAR; PG8_MMA(1, 0, At, B0); PG8_MMA(1, 1, At, B1); PG8_BAR; PG8_SCHED;
            PG8_LDB(B0, 1, 0); PG8_LDB(B1, 1, 1); PG8_SCHED; PG8_LDA(At, 1, 0); PG8_STAGE(PG8_SA(0, 1), a2 + hstep, voffA);
            PG8_WAIT_V(8); PG8_WAIT_L(0); PG8_BAR; PG8_MMA(0, 0, At, B0); PG8_MMA(0, 1, At, B1); PG8_BAR; PG8_SCHED;
            PG8_LDA(At, 1, 1); PG8_STAGE(PG8_SB(1, 0), b3, voffB); PG8_STAGE(PG8_SB(1, 1), b3 + hstep, voffB); PG8_STAGE(PG8_SA(1, 0), a3, voffA);
            PG8_WAIT_V(8); PG8_WAIT_L(0); PG8_BAR; PG8_MMA(1, 0, At, B0); PG8_MMA(1, 1, At, B1); PG8_BAR; PG8_SCHED;
            } else {
            PG8_LDB(B0, 0, 0); PG8_SCHED; PG8_LDA(At, 0, 0); PG8_STAGE(PG8_SA(1, 1), a1 + hstep, voffA);
            PG8_WAIT_L(8); PG8_BAR; PG8_WAIT_L(0); PG8_MMA(0, 0, At, B0); PG8_BAR; PG8_SCHED;
            PG8_LDB(B1, 0, 1); PG8_STAGE(PG8_SB(0, 0), b2, voffB);
            PG8_BAR; PG8_WAIT_L(0); PG8_MMA(0, 1, At, B1); PG8_BAR;
            PG8_LDA(At, 0, 1); PG8_STAGE(PG8_SA(0, 0), a2, voffA);
            PG8_BAR; PG8_WAIT_L(0); PG8_MMA(1, 0, At, B0); PG8_BAR; PG8_SCHED;
            PG8_STAGE(PG8_SB(0, 1), b2 + hstep, voffB);
            PG8_WAIT_V(6); PG8_BAR; PG8_MMA(1, 1, At, B1); PG8_BAR;
            PG8_LDB(B0, 1, 0); PG8_SCHED; PG8_LDA(At, 1, 0); PG8_STAGE(PG8_SA(0, 1), a2 + hstep, voffA);
            PG8_WAIT_L(8); PG8_BAR; PG8_WAIT_L(0); PG8_MMA(0, 0, At, B0); PG8_BAR; PG8_SCHED;
            PG8_LDB(B1, 1, 1); PG8_STAGE(PG8_SB(1, 0), b3, voffB);
            PG8_BAR; PG8_WAIT_L(0); PG8_MMA(0, 1, At, B1); PG8_BAR;
            PG8_LDA(At, 1, 1); PG8_STAGE(PG8_SA(1, 0), a3, voffA);
            PG8_BAR; PG8_WAIT_L(0); PG8_MMA(1, 0, At, B0); PG8_BAR; PG8_SCHED;
            PG8_STAGE(PG8_SB(1, 1), b3 + hstep, voffB);
            PG8_WAIT_V(6); PG8_BAR; PG8_MMA(1, 1, At, B1); PG8_BAR;
            }
        }
        if constexpr (ALIGN_EPI) { if (wr == 0) PG8_BAR; }
        if constexpr (!Epi::AFTER_DRAIN) { E(acc, cur, wr, wc, fr, fq); S.done(cur); }
        if (!has_next) break;
        if (!nxt.carry()) {
#pragma unroll
        for (int a = 0; a < 2; ++a)
#pragma unroll
            for (int b = 0; b < 2; ++b)
#pragma unroll
                for (int m = 0; m < 4; ++m)
#pragma unroll
                    for (int n = 0; n < 2; ++n) acc[a][b][m][n] = (f32x4){0.f, 0.f, 0.f, 0.f};
        }
        cur = nxt; cA = nA; cB = nB; ++ui;
        if constexpr (ALIGN_EPI) { if (wr == 1) PG8_BAR; }
    }
    PG8_WAIT_V(0);
    if constexpr (!ALIGN_EPI) { if (wr == 0) PG8_BAR; }
    PG8_BAR;
    if constexpr (Epi::AFTER_DRAIN) { E.fused(acc, cur, wr, wc, fr, fq, lds, wid, lane); S.done(cur); }
#undef PG8_SA
#undef PG8_SB
#undef PG8_STAGE
#undef PG8_LDA
#undef PG8_LDB
#undef PG8_MMA
#undef PG8_WAIT_V
#undef PG8_WAIT_L
#undef PG8_BAR
#undef PG8_SCHED
}
}

__device__ __forceinline__ float shfl_xor_f(float v, int o) { return __uint_as_float((unsigned)__builtin_amdgcn_ds_bpermute((mk_lane_id() ^ o) << 2, (int)__float_as_uint(v))); }
namespace attn128 {
using bf16 = __hip_bfloat16;
constexpr int D = 128, NW = 8, QBLK = 32, KVBLK = 64;
constexpr float SCALE = 0.088388347648318440f;
constexpr float THR = 8.f;
constexpr int SDEPTH = 2;
constexpr int LDQ = 1024, LDK = 1024, LDO = 1024;
constexpr size_t SHM_V = KVBLK * D * 2, SHM_K = KVBLK * D * 2, SHM_ATTN = 2 * SHM_V + 2 * SHM_K + NW * 64 * 4;
using bf16x8 = __attribute__((ext_vector_type(8))) short;
using s16x4  = __attribute__((ext_vector_type(4))) short;
using f32x16 = __attribute__((ext_vector_type(16))) float;
using f32x8  = __attribute__((ext_vector_type(8))) float;
using u32x4  = __attribute__((ext_vector_type(4))) unsigned;
#define KSWZ(row, colB) ((row) * 256 + ((colB) ^ (((row) & 7) << 4)))
#define SBAR() __builtin_amdgcn_sched_barrier(0)
__device__ __forceinline__ int crow(int r, int hi) { return (r & 3) + 8 * (r >> 2) + 4 * hi; }
__device__ __forceinline__ unsigned cvtpk(float lo, float hi) {
  unsigned r; asm volatile("v_cvt_pk_bf16_f32 %0, %1, %2" : "=v"(r) : "v"(lo), "v"(hi)); return r;
}
template <typename TIn> struct Stage;
template <> struct Stage<bf16>  { using T = bf16x8;
  __device__ static __forceinline__ T ld8(const bf16* p) { return *reinterpret_cast<const bf16x8*>(p); }
  __device__ static __forceinline__ bf16x8 tobf(T x) { return x; } };
template <> struct Stage<float> { using T = f32x8;
  __device__ static __forceinline__ T ld8(const float* p) { return *reinterpret_cast<const f32x8*>(p); }
  __device__ static __forceinline__ bf16x8 tobf(T x) {
    u32x4 w = {cvtpk(x[0], x[1]), cvtpk(x[2], x[3]), cvtpk(x[4], x[5]), cvtpk(x[6], x[7])}; return *reinterpret_cast<bf16x8*>(&w); } };

__device__ __forceinline__ void partialSM(f32x16& p0, f32x16& p1, float& m_reg, float& mn, float& alpha) {
  constexpr float C = SCALE * 1.4426950408889634f;
  float pmax = p0[0]; for (int r = 1; r < 16; ++r) pmax = fmaxf(pmax, p0[r]); for (int r = 0; r < 16; ++r) pmax = fmaxf(pmax, p1[r]);
  { auto rr = __builtin_amdgcn_permlane32_swap(__float_as_uint(pmax), __float_as_uint(pmax), false, false);
    pmax = fmaxf(__uint_as_float(rr[0]), __uint_as_float(rr[1])); }
  if (__builtin_expect(__all(pmax - m_reg <= THR / SCALE), 1)) { mn = m_reg; alpha = 1.f; }
  else { mn = fmaxf(m_reg, pmax); alpha = __builtin_amdgcn_exp2f((m_reg - mn) * C); m_reg = mn; }
  float mnC = -mn * C;
  for (int r = 0; r < 16; ++r) p0[r] = fmaf(p0[r], C, mnC); for (int r = 0; r < 16; ++r) p1[r] = fmaf(p1[r], C, mnC);
  for (int r = 0; r < 16; ++r) p0[r] = __builtin_amdgcn_exp2f(p0[r]);
}
__device__ __forceinline__ void finishSM(f32x16& p0, f32x16& p1, float alpha, float& l_reg, bf16x8& pa0, bf16x8& pa1, bf16x8& pa2, bf16x8& pa3) {
  for (int r = 0; r < 16; ++r) p1[r] = __builtin_amdgcn_exp2f(p1[r]);
  float ps = 0; for (int r = 0; r < 16; ++r) ps += p0[r]; for (int r = 0; r < 16; ++r) ps += p1[r];
  { auto rr = __builtin_amdgcn_permlane32_swap(__float_as_uint(ps), __float_as_uint(ps), false, false);
    ps = __uint_as_float(rr[0]) + __uint_as_float(rr[1]); }
  l_reg = l_reg * alpha + ps;
#define PK4(P, BASE, OUT) do { unsigned a0 = cvtpk(P[BASE + 0], P[BASE + 1]), a1 = cvtpk(P[BASE + 2], P[BASE + 3]);   \
    unsigned b0 = cvtpk(P[BASE + 4], P[BASE + 5]), b1 = cvtpk(P[BASE + 6], P[BASE + 7]);                              \
    auto r0 = __builtin_amdgcn_permlane32_swap(a0, b0, false, false); auto r1 = __builtin_amdgcn_permlane32_swap(a1, b1, false, false); \
    u32x4 w = {r0[0], r1[0], r0[1], r1[1]}; OUT = *reinterpret_cast<bf16x8*>(&w); } while (0)
  PK4(p0, 0, pa0); PK4(p0, 8, pa1); PK4(p1, 0, pa2); PK4(p1, 8, pa3);
#undef PK4
}
__device__ __forceinline__ void qkt(f32x16& p0, f32x16& p1, const bf16* Ks, const bf16x8* qr, int r32, int hi) {
  p0 = f32x16{}; p1 = f32x16{};
  for (int d0 = 0; d0 < 8; ++d0) { int cb = (d0 * 16 + hi * 8) * 2;
    bf16x8 b0 = *reinterpret_cast<const bf16x8*>((const char*)Ks + KSWZ(r32, cb));
    bf16x8 b1 = *reinterpret_cast<const bf16x8*>((const char*)Ks + KSWZ(32 + r32, cb));
    p0 = __builtin_amdgcn_mfma_f32_32x32x16_bf16(b0, qr[d0], p0, 0, 0, 0);
    p1 = __builtin_amdgcn_mfma_f32_32x32x16_bf16(b1, qr[d0], p1, 0, 0, 0); }
}
__device__ __forceinline__ int v_st(int k, int c) { const int kk = (k & ~0xC) | ((k & 4) << 1) | ((k & 8) >> 1); return ((kk >> 3) * 4 + (c >> 5)) * 512 + ((kk & 7) * 32 + (c & 31)) * 2; }
__device__ __forceinline__ int v_rd_base(int lane) { return ((lane & 3) << 3) | (((lane >> 2) & 3) << 6) | (((lane >> 4) & 1) << 5) | (((lane >> 5) & 1) << 8); }
constexpr int v_rd_off(int d0, int ks, int half) { return d0 * 512 + ks * 4096 + half * 2048; }
template <int OFF> __device__ __forceinline__ s16x4 tr_read(int vb) {
  s16x4 r; asm volatile("ds_read_b64_tr_b16 %0, %1 offset:%2" : "=&v"(r) : "v"(vb), "i"(OFF) : "memory"); return r;
}
template <int D0> __device__ __forceinline__ void pv_one(f32x16& od, int vb, bf16x8 pa0, bf16x8 pa1, bf16x8 pa2, bf16x8 pa3) {
  const s16x4 l0 = tr_read<v_rd_off(D0, 0, 0)>(vb), h0 = tr_read<v_rd_off(D0, 0, 1)>(vb), l1 = tr_read<v_rd_off(D0, 1, 0)>(vb), h1 = tr_read<v_rd_off(D0, 1, 1)>(vb);
  const s16x4 l2 = tr_read<v_rd_off(D0, 2, 0)>(vb), h2 = tr_read<v_rd_off(D0, 2, 1)>(vb), l3 = tr_read<v_rd_off(D0, 3, 0)>(vb), h3 = tr_read<v_rd_off(D0, 3, 1)>(vb);
  asm volatile("s_waitcnt lgkmcnt(0)" ::: "memory"); SBAR();
#define PK(L, H) (bf16x8){L[0], L[1], L[2], L[3], H[0], H[1], H[2], H[3]}
  od = __builtin_amdgcn_mfma_f32_32x32x16_bf16(pa0, PK(l0, h0), od, 0, 0, 0);
  od = __builtin_amdgcn_mfma_f32_32x32x16_bf16(pa1, PK(l1, h1), od, 0, 0, 0);
  od = __builtin_amdgcn_mfma_f32_32x32x16_bf16(pa2, PK(l2, h2), od, 0, 0, 0);
  od = __builtin_amdgcn_mfma_f32_32x32x16_bf16(pa3, PK(l3, h3), od, 0, 0, 0);
#undef PK
}
__device__ __forceinline__ void pv_d0(f32x16* o, int vb, bf16x8 pa0, bf16x8 pa1, bf16x8 pa2, bf16x8 pa3) {
  pv_one<0>(o[0], vb, pa0, pa1, pa2, pa3); pv_one<1>(o[1], vb, pa0, pa1, pa2, pa3); pv_one<2>(o[2], vb, pa0, pa1, pa2, pa3); pv_one<3>(o[3], vb, pa0, pa1, pa2, pa3);
}

template <typename TQ>
__device__ __forceinline__ void attn_dense_body(const TQ* __restrict__ Qb, const bf16* __restrict__ Kh, const bf16* __restrict__ Vh,
                                                float* __restrict__ Ob, int seq, char* lds, int wave_s_) {
  using St = Stage<bf16>; using SQ = Stage<TQ>;
  int tid = MK_TID(wave_s_); asm volatile("" : "+v"(tid));
  const int wid = tid >> 6, lane = tid & 63, r32 = lane & 31, hi = lane >> 5;
  bf16* V_lds = (bf16*)lds; bf16* K_lds = (bf16*)(lds + 2 * SHM_V);
  float* ws = (float*)(lds + 2 * SHM_V + 2 * SHM_K) + wid * 64; float* li_l = ws; float* al_l = ws + 32;
  float m_reg = -1e30f, l_reg = 0; f32x16 o[4] = {}; bf16x8 qr[8];
  const TQ* Qw = Qb + (long)(wid * QBLK + r32) * LDQ + hi * 8;
#pragma unroll
  for (int d0 = 0; d0 < 8; ++d0) qr[d0] = SQ::tobf(SQ::ld8(Qw + d0 * 16));
  const int sr = tid >> 4, sc = (tid & 15) * 8, vst0 = v_st(sr, sc), vst1 = v_st(32 + sr, sc);
  const int vb0 = (int)(uintptr_t)V_lds + v_rd_base(lane);
  struct { typename St::T vs0, vs1, ks0, ks1; } sr_[SDEPTH];
#define SLOAD(i, k0) do { sr_[i].vs0 = St::ld8(&Vh[(long)((k0) + sr) * LDK + sc]); sr_[i].vs1 = St::ld8(&Vh[(long)((k0) + 32 + sr) * LDK + sc]); \
    sr_[i].ks0 = St::ld8(&Kh[(long)((k0) + sr) * LDK + sc]); sr_[i].ks1 = St::ld8(&Kh[(long)((k0) + 32 + sr) * LDK + sc]); } while (0)
#define SWRITE(b, i) do { *(bf16x8*)((char*)V_lds + (b) * SHM_V + vst0) = St::tobf(sr_[i].vs0);          \
    *(bf16x8*)((char*)V_lds + (b) * SHM_V + vst1) = St::tobf(sr_[i].vs1); int kc = sc * 2;               \
    *(bf16x8*)((char*)K_lds + (b) * SHM_K + KSWZ(sr, kc)) = St::tobf(sr_[i].ks0);                       \
    *(bf16x8*)((char*)K_lds + (b) * SHM_K + KSWZ(32 + sr, kc)) = St::tobf(sr_[i].ks1); } while (0)
#define SWAIT() do { if constexpr (SDEPTH == 2) asm volatile("s_waitcnt vmcnt(4)" ::: "memory"); else asm volatile("s_waitcnt vmcnt(0)" ::: "memory"); } while (0)
#define RESC(a) do { if (__any((a) < 1.f)) { if (hi == 0) al_l[r32] = (a); asm volatile("s_waitcnt lgkmcnt(0)" ::: "memory"); \
    for (int d = 0; d < 4; ++d) for (int r = 0; r < 16; ++r) o[d][r] *= al_l[crow(r, hi)]; } } while (0)
  f32x16 pA0, pA1, pB0, pB1; float mnA, mnB, alA, alB; bf16x8 pa0, pa1, pa2, pa3; const int NT = seq / KVBLK;
  constexpr int SE = 0, SO = SDEPTH - 1;
  SLOAD(SE, 0); asm volatile("s_waitcnt vmcnt(0)" ::: "memory"); SWRITE(0, SE); __syncthreads();
  qkt(pA0, pA1, K_lds, qr, r32, hi); partialSM(pA0, pA1, m_reg, mnA, alA);
  SLOAD(SO, KVBLK); if constexpr (SDEPTH == 2) { if (2 < NT) SLOAD(SE, 2 * KVBLK); }
  SWAIT(); SWRITE(1, SO); __syncthreads();
  for (int j = 1; j + 1 < NT; j += 2) {
    SBAR(); qkt(pB0, pB1, (bf16*)((char*)K_lds + SHM_K), qr, r32, hi);
    finishSM(pA0, pA1, alA, l_reg, pa0, pa1, pa2, pa3); SBAR();
    SLOAD(SO, (j + SDEPTH) * KVBLK); SBAR();
    pv_d0(o, vb0, pa0, pa1, pa2, pa3); partialSM(pB0, pB1, m_reg, mnB, alB);
    __syncthreads(); SWAIT(); SWRITE(0, SE);
    RESC(alB); __syncthreads();
    SBAR(); qkt(pA0, pA1, K_lds, qr, r32, hi);
    finishSM(pB0, pB1, alB, l_reg, pa0, pa1, pa2, pa3); SBAR();
    if (SDEPTH == 1 || j + 3 < NT) SLOAD(SE, (j + 1 + SDEPTH) * KVBLK); SBAR();
    pv_d0(o, vb0 + (int)SHM_V, pa0, pa1, pa2, pa3); partialSM(pA0, pA1, m_reg, mnA, alA);
    __syncthreads(); SWAIT(); SWRITE(1, SO);
    RESC(alA); __syncthreads();
  }
  SBAR(); qkt(pB0, pB1, (bf16*)((char*)K_lds + SHM_K), qr, r32, hi);
  finishSM(pA0, pA1, alA, l_reg, pa0, pa1, pa2, pa3); SBAR();
  pv_d0(o, vb0, pa0, pa1, pa2, pa3); partialSM(pB0, pB1, m_reg, mnB, alB);
  __syncthreads(); RESC(alB);
  finishSM(pB0, pB1, alB, l_reg, pa0, pa1, pa2, pa3); SBAR();
  pv_d0(o, vb0 + (int)SHM_V, pa0, pa1, pa2, pa3);
  if (hi == 0) li_l[r32] = l_reg; asm volatile("s_waitcnt lgkmcnt(0)" ::: "memory");
  float rli[16];
#pragma unroll
  for (int r = 0; r < 16; ++r) rli[r] = __builtin_amdgcn_rcpf(li_l[crow(r, hi)]);
  float* Ow = Ob + (long)(wid * QBLK) * LDO;
#pragma unroll
  for (int r = 0; r < 16; ++r) { int orow = crow(r, hi);
    for (int d0 = 0; d0 < 4; ++d0) Ow[(long)orow * LDO + d0 * 32 + r32] = o[d0][r] * rli[r]; }
#undef SLOAD
#undef SWRITE
#undef SWAIT
#undef RESC
}

}

namespace attn256 {
using namespace attn128;
constexpr size_t SHM_V2 = KVBLK * 256 * 2, SHM_K2 = KVBLK * D * 2;
constexpr int LDV = 1024;
__device__ __forceinline__ int v_st2(int k, int c) { const int kk = (k & ~0xC) | ((k & 4) << 1) | ((k & 8) >> 1); return ((kk >> 3) * 8 + (c >> 5)) * 512 + ((kk & 7) * 32 + (c & 31)) * 2; }
constexpr int v_rd_off2(int d0, int ks, int half) { return d0 * 512 + ks * 8192 + half * 4096; }
template <int D0> __device__ __forceinline__ void pv_one2(f32x16& od, int vb, bf16x8 pa0, bf16x8 pa1, bf16x8 pa2, bf16x8 pa3) {
  const s16x4 l0 = tr_read<v_rd_off2(D0, 0, 0)>(vb), h0 = tr_read<v_rd_off2(D0, 0, 1)>(vb), l1 = tr_read<v_rd_off2(D0, 1, 0)>(vb), h1 = tr_read<v_rd_off2(D0, 1, 1)>(vb);
  const s16x4 l2 = tr_read<v_rd_off2(D0, 2, 0)>(vb), h2 = tr_read<v_rd_off2(D0, 2, 1)>(vb), l3 = tr_read<v_rd_off2(D0, 3, 0)>(vb), h3 = tr_read<v_rd_off2(D0, 3, 1)>(vb);
  asm volatile("s_waitcnt lgkmcnt(0)" ::: "memory"); SBAR();
#define PK(L, H) (bf16x8){L[0], L[1], L[2], L[3], H[0], H[1], H[2], H[3]}
  od = __builtin_amdgcn_mfma_f32_32x32x16_bf16(pa0, PK(l0, h0), od, 0, 0, 0);
  od = __builtin_amdgcn_mfma_f32_32x32x16_bf16(pa1, PK(l1, h1), od, 0, 0, 0);
  od = __builtin_amdgcn_mfma_f32_32x32x16_bf16(pa2, PK(l2, h2), od, 0, 0, 0);
  od = __builtin_amdgcn_mfma_f32_32x32x16_bf16(pa3, PK(l3, h3), od, 0, 0, 0);
#undef PK
}
__device__ __forceinline__ void attn_o256_body(const bf16* __restrict__ Qb, const bf16* __restrict__ Kh, const bf16* __restrict__ Vh, float* __restrict__ Ob, int seq, char* lds, int wave_s_) {
  using St = Stage<bf16>;
  int tid = MK_TID(wave_s_); asm volatile("" : "+v"(tid));
  const int wid = tid >> 6, lane = tid & 63, r32 = lane & 31, hi = lane >> 5;
  bf16* V_lds = (bf16*)lds; bf16* K_lds = (bf16*)(lds + 2 * SHM_V2);
  float* ws = (float*)(lds + 2 * SHM_V2 + 2 * SHM_K2) + wid * 64; float* li_l = ws; float* al_l = ws + 32;
  float m_reg = -1e30f, l_reg = 0; f32x16 o[8] = {}; bf16x8 qr[8];
  const bf16* Qw = Qb + (long)(wid * QBLK + r32) * LDQ + hi * 8;
#pragma unroll
  for (int d0 = 0; d0 < 8; ++d0) qr[d0] = St::ld8(Qw + d0 * 16);
  const int vb0 = (int)(uintptr_t)V_lds + v_rd_base(lane);
  bf16x8 sv00, sv01, sv10, sv11, sk0, sk1;
#define SLOAD2(k0) do { const int t_ = MK_TID(wave_s_), sr = t_ >> 4, sc = (t_ & 15) * 8; const bf16* vp = Vh + (long)((k0) + sr) * LDV + sc; const bf16* kp = Kh + (long)((k0) + sr) * LDK + sc; \
    sv00 = St::ld8(vp); sv01 = St::ld8(vp + 128); sv10 = St::ld8(vp + 32 * LDV); sv11 = St::ld8(vp + 32 * LDV + 128); sk0 = St::ld8(kp); sk1 = St::ld8(kp + 32 * LDK); } while (0)
#define SWRITE2(b) do { const int t_ = MK_TID(wave_s_), sr = t_ >> 4, sc = (t_ & 15) * 8; char* vbuf = (char*)V_lds + (b) * SHM_V2 + v_st2(sr, sc); \
    *(bf16x8*)(vbuf) = sv00; *(bf16x8*)(vbuf + 2048) = sv01; *(bf16x8*)(vbuf + 16384) = sv10; *(bf16x8*)(vbuf + 18432) = sv11; \
    char* kbuf = (char*)K_lds + (b) * SHM_K2 + KSWZ(sr, sc * 2); *(bf16x8*)(kbuf) = sk0; *(bf16x8*)(kbuf + 8192) = sk1; } while (0)
  const int NT = seq / KVBLK;
  SLOAD2(0); asm volatile("s_waitcnt vmcnt(0)" ::: "memory"); SWRITE2(0); __syncthreads();
  for (int j = 0; j < NT; ++j) {
    const int b = j & 1;
    f32x16 p0, p1; float mn, al; bf16x8 pa0, pa1, pa2, pa3;
    SBAR(); qkt(p0, p1, (bf16*)((char*)K_lds + b * SHM_K2), qr, r32, hi);
    partialSM(p0, p1, m_reg, mn, al);
    finishSM(p0, p1, al, l_reg, pa0, pa1, pa2, pa3); SBAR();
    if (__any(al < 1.f)) { if (hi == 0) al_l[r32] = al; asm volatile("s_waitcnt lgkmcnt(0)" ::: "memory");
#pragma unroll
      for (int d = 0; d < 8; ++d)
#pragma unroll
        for (int r = 0; r < 16; ++r) o[d][r] *= al_l[crow(r, hi)]; }
    if (j + 1 < NT) SLOAD2((j + 1) * KVBLK);
    SBAR();
    { const int vb = vb0 + b * (int)SHM_V2;
      pv_one2<0>(o[0], vb, pa0, pa1, pa2, pa3); pv_one2<1>(o[1], vb, pa0, pa1, pa2, pa3); pv_one2<2>(o[2], vb, pa0, pa1, pa2, pa3); pv_one2<3>(o[3], vb, pa0, pa1, pa2, pa3);
      pv_one2<4>(o[4], vb, pa0, pa1, pa2, pa3); pv_one2<5>(o[5], vb, pa0, pa1, pa2, pa3); pv_one2<6>(o[6], vb, pa0, pa1, pa2, pa3); pv_one2<7>(o[7], vb, pa0, pa1, pa2, pa3); }
    if (j + 1 < NT) { asm volatile("s_waitcnt vmcnt(0)" ::: "memory"); SWRITE2(b ^ 1); }
    __syncthreads();
  }
  if (hi == 0) li_l[r32] = l_reg; asm volatile("s_waitcnt lgkmcnt(0)" ::: "memory");
  float rli[16];
#pragma unroll
  for (int r = 0; r < 16; ++r) rli[r] = __builtin_amdgcn_rcpf(li_l[crow(r, hi)]);
  float* Ow = Ob + (long)(wid * QBLK) * LDO;
#pragma unroll
  for (int r = 0; r < 16; ++r) { const int orow = crow(r, hi);
#pragma unroll
    for (int d0 = 0; d0 < 8; ++d0) Ow[(long)orow * LDO + d0 * 32 + r32] = o[d0][r] * rli[r]; }
#undef SLOAD2
#undef SWRITE2
}
}

#define GAS __attribute__((address_space(1)))
#define LAS __attribute__((address_space(3)))
typedef unsigned short bf16;
typedef unsigned v4u __attribute__((ext_vector_type(4)));
typedef float f32x4 __attribute__((ext_vector_type(4)));
typedef short bf16x8 __attribute__((ext_vector_type(8)));
typedef GAS unsigned gu32;
typedef GAS unsigned long long gu64;
#define RLX_AGENT __ATOMIC_RELAXED, __HIP_MEMORY_SCOPE_AGENT
#define LDS_WAIT() asm volatile("s_waitcnt lgkmcnt(0)" ::: "memory")
#define VM_WAIT() asm volatile("s_waitcnt vmcnt(0)" ::: "memory")
__device__ __forceinline__ unsigned long long rt() { return __builtin_amdgcn_s_memrealtime(); }
__device__ __forceinline__ unsigned f2bf(float f) { unsigned u = __builtin_bit_cast(unsigned, f); return (u + 0x7fffu + ((u >> 16) & 1u)) >> 16; }
__device__ __forceinline__ unsigned pk2(float lo, float hi) { return f2bf(lo) | (f2bf(hi) << 16); }

#define XB_TMO      128
#define XB_XCNT(j)  (256  + 64 * (j))
#define XB_XSUB(j)  (1280 + 64 * (j))
#define XB_XGEN(j)  (2304 + 64 * (j))
#define XB_TOP      3328
#define XB_TOPGEN   3392
#define XCD_BAR_WORDS 3456
#define XB_SPIN_CAP (1u << 22)

__device__ __forceinline__ unsigned xb_ld(unsigned* p)              { return __hip_atomic_load(p, __ATOMIC_RELAXED, __HIP_MEMORY_SCOPE_AGENT); }
__device__ __forceinline__ unsigned xb_add(unsigned* p, unsigned v) { return __hip_atomic_fetch_add(p, v, __ATOMIC_RELAXED, __HIP_MEMORY_SCOPE_AGENT); }
__device__ __forceinline__ unsigned xb_xcc_id() { return (unsigned)__builtin_amdgcn_s_getreg((3 << 11) | 20) & 0xFu; }
#define XB_SPIN(cond, bar) do { unsigned _sp = 0; while (cond) { __builtin_amdgcn_s_sleep(1); \
    if ((++_sp & 255u) == 0u) { if (xb_ld(&(bar)[XB_TMO])) break; if (_sp > XB_SPIN_CAP) { atomicAdd(&(bar)[XB_TMO], 1u); break; } } } } while (0)

struct XcdBarrier {
    unsigned* bar; unsigned x;
    volatile LAS unsigned* st;
};

__device__ __forceinline__ XcdBarrier xcd_barrier_post(unsigned* bar, volatile LAS unsigned* st, int tid_) {
    XcdBarrier b; b.bar = bar; b.x = xb_xcc_id(); b.st = st;
    if (tid_ == 0) (void)xb_add(&bar[XB_XCNT(b.x)], 1u);
    return b;
}
__device__ __forceinline__ void xcd_barrier_complete(unsigned* bar, unsigned x, unsigned& nloc, unsigned& nx) {
    const unsigned G = gridDim.x * gridDim.y * gridDim.z;
    unsigned sum, cnt, mine, sp = 0u;
    for (;;) {
        sum = 0u; cnt = 0u; mine = 0u;
#pragma unroll
        for (unsigned j = 0; j < 16; ++j) { const unsigned c = xb_ld(&bar[XB_XCNT(j)]); sum += c; cnt += (c > 0u) ? 1u : 0u; mine = (j == x) ? c : mine; }
        if (sum == G) break;
        __builtin_amdgcn_s_sleep(1);
        if ((++sp & 255u) == 0u) { if (xb_ld(&bar[XB_TMO])) break; if (sp > XB_SPIN_CAP) { atomicAdd(&bar[XB_TMO], 1u); break; } }
    }
    nloc = mine > 0u ? mine : 1u; nx = cnt > 0u ? cnt : 1u;
}

__device__ __forceinline__ void xcd_barrier(const XcdBarrier& b, int tid_) {
    asm volatile("s_waitcnt vmcnt(0)" ::: "memory");
    __syncthreads();
    if (tid_ == 0) {
        unsigned* bar = b.bar;
        __builtin_amdgcn_s_waitcnt(0);
        unsigned nloc = b.st[0], nx = b.st[1];
        if (nloc == 0u) { xcd_barrier_complete(bar, b.x, nloc, nx); b.st[0] = nloc; b.st[1] = nx; }
        const unsigned old = xb_add(&bar[XB_XSUB(b.x)], 1u);
        const unsigned gen = old / nloc;
        if (old + 1u == (gen + 1u) * nloc) {
            __builtin_amdgcn_fence(__ATOMIC_RELEASE, "agent");
            asm volatile("s_waitcnt vmcnt(0)" ::: "memory");
            const unsigned og = xb_add(&bar[XB_TOP], 1u);
            const unsigned tg = og / nx;
            if (og + 1u == (tg + 1u) * nx) xb_add(&bar[XB_TOPGEN], 1u);
            else XB_SPIN(xb_ld(&bar[XB_TOPGEN]) == tg, bar);
            __builtin_amdgcn_fence(__ATOMIC_ACQUIRE, "agent");
            xb_add(&bar[XB_XGEN(b.x)], 1u);
            asm volatile("s_waitcnt vmcnt(0)" ::: "memory");
        } else {
            XB_SPIN(xb_ld(&bar[XB_XGEN(b.x)]) == gen, bar);
            __builtin_amdgcn_fence(__ATOMIC_ACQUIRE, "agent");
            asm volatile("s_waitcnt vmcnt(0)" ::: "memory");
        }
    }
    __syncthreads();
}

constexpr int DM = 4096, SEQ = 8192, CTXL = 256, MT = SEQ + CTXL, DEPTH = 4, FFND = 4096;
constexpr int NZ = 20480, INC = 20496, ADAR = 256, NMOD = 9 * DM;
constexpr int ZC_UV = 0, ZC_MQ = 2048, ZC_MK = 2560, ZC_MV = 3072, ZC_MO = 4096, ZC_AQ = 5120, ZC_AK = 6144, ZC_AV = 7168, ZC_MG = 8192;
constexpr float EPS = 1e-6f;
constexpr int NWAVES = 8, NTHR = 512;

constexpr size_t MiB = 1ull << 20;
constexpr size_t WS_CTL = 0, CTL_ZERO_BYTES = 1 * MiB;
constexpr size_t WS_MODTP = 1 * MiB;
constexpr size_t WS_MOD = WS_MODTP + 512 * 1024;
constexpr size_t WS_LAM = WS_MOD + (size_t)DEPTH * 2 * NMOD * 4;
constexpr size_t WS_WG16 = WS_LAM + 256;
constexpr size_t WS_ROPE = WS_WG16 + (size_t)DEPTH * 16 * DM * 4;
constexpr size_t WS_G16 = WS_ROPE + (size_t)2 * SEQ * 64 * 4;
constexpr size_t WS_XR = 9 * MiB;
constexpr size_t SZ_ROWS_F32 = (size_t)MT * DM * 4, SZ_ROWS_BF = (size_t)MT * DM * 2;
constexpr size_t WS_H = WS_XR + SZ_ROWS_F32;
constexpr size_t WS_GB = WS_H + SZ_ROWS_BF;
constexpr size_t WS_Z = WS_GB + SZ_ROWS_BF;
constexpr size_t WS_ATTO = WS_Z + (size_t)MT * NZ * 2;
constexpr size_t WS_MLH = WS_ATTO + (size_t)2 * MT * 1024 * 4;
constexpr size_t WS_YA = WS_MLH + (size_t)2 * MT * 1024 * 4;
constexpr size_t WS_YB = WS_YA + (size_t)MT * 1024 * 2;
constexpr size_t WS_YC = WS_YB + (size_t)MT * 1024 * 2;
constexpr size_t WS_YACC = WS_YC + (size_t)MT * 1024 * 2;
constexpr size_t WS_Y = WS_YACC + SZ_ROWS_F32;
constexpr size_t WS_W13T = WS_Y + SZ_ROWS_BF;
constexpr size_t WS_W2T = WS_W13T + (size_t)DEPTH * 2 * 8192 * 4096 * 2;
constexpr size_t WS_WINT = WS_W2T + (size_t)DEPTH * 2 * 4096 * 4096 * 2;
constexpr size_t WS_WBT = WS_WINT + (size_t)DEPTH * NZ * 4096 * 2;
constexpr size_t WS_WOT = WS_WBT + (size_t)DEPTH * 3 * 4096 * 1024 * 2;
constexpr size_t WS_CT = WS_WOT + (size_t)DEPTH * 4096 * 4096 * 2;
constexpr size_t WS_MSM = WS_CT + (size_t)8 * 66 * 32768 * 2;
constexpr size_t WS_SLAB = WS_MSM + 1 * MiB;
constexpr size_t WS_GWSB = WS_SLAB + (size_t)16 * 256 * DM * 4;
constexpr size_t WS_MS3 = WS_GWSB + (size_t)DEPTH * 8 * 128 * 128 * 2;
constexpr size_t WS_END = WS_MS3 + (size_t)3 * 256 * DM * 4;
static_assert(WS_G16 + (size_t)MT * 16 * 4 <= WS_XR, "small buffers fit below XR");
static_assert(WS_XR % 256 == 0 && WS_H % 256 == 0 && WS_Z % 256 == 0 && WS_W13T % 256 == 0, "alignment");

constexpr int CW_BAR = 4096;

constexpr int RING_OFF = 0, RING_BYTES = 131072;
constexpr int LDSCTL_OFF = 143360, MISC_OFF = LDSCTL_OFF + 320;
constexpr int LDS_BYTES = 147456;

constexpr int P_PRO0 = 0, P_PRO1 = 1, P_LAYER0 = 2;
constexpr int L_N1 = 0, L_W13A = 1, L_W2A = 2, L_N2 = 3, L_WIN = 4, L_MIX1 = 5, L_POST = 6, L_M3 = 7, L_MERGE = 8, L_WOUT = 9, L_N3 = 10, L_W13B = 11, L_W2B = 12, NPL = 13;
constexpr int P_FINAL = P_LAYER0 + DEPTH * NPL, NPH = P_FINAL + 1;

__device__ __forceinline__ float wave_sum(float v) {
#pragma unroll
    for (int o = 1; o < 64; o <<= 1) v += shfl_xor_f(v, o);
    return v;
}
__device__ __forceinline__ float bf2f(unsigned short b) { return __uint_as_float((unsigned)b << 16); }
__device__ __forceinline__ float bflo(unsigned w) { return __uint_as_float(w << 16); }
__device__ __forceinline__ float bfhi(unsigned w) { return __uint_as_float(w & 0xffff0000u); }
__device__ __forceinline__ float sigmoid_f(float x) { return 1.f / (1.f + __expf(-x)); }
__device__ __forceinline__ float silu_f(float x) { return x / (1.f + __expf(-x)); }
__device__ __forceinline__ float gelu_tanh_f(float x) { const float u = 0.7978845608028654f * (x + 0.044715f * x * x * x); return x / (1.f + __expf(-2.f * u)); }
__device__ __forceinline__ float lambda_init_f(int l) { return 0.8f - 0.6f * __expf(-0.3f * (float)l); }

namespace pg8 {
struct CtxSplitOrder {
    int c, G, n;
    const float* MS3; bf16_t* Yc; int wave_s_;
    __device__ __forceinline__ bool next(int i, Unit& u) const { const int L = i * G + c; if (L >= n) return false; u.pm = 0; u.pn = L >> 4; u.koff = (L & 15) * 256; u.boff = u.koff; u.fl = 0; return true; }
    __device__ __forceinline__ void a_ready(const Unit& u) const {
        if (MS3) {
            int t_ = MK_TID(wave_s_); asm volatile("" : "+v"(t_));
            const int r = t_ >> 1, c0 = u.koff + (t_ & 1) * 128;
            const float* p0 = MS3 + (size_t)r * DM + c0; bf16_t* yo = Yc + (size_t)r * DM + c0;
#pragma unroll 1
            for (int ib = 0; ib < 16; ib += 4) { f32x4 q[4][3][2];
#pragma unroll
                for (int i = 0; i < 4; ++i)
#pragma unroll
                    for (int sgm = 0; sgm < 3; ++sgm) { q[i][sgm][0] = *(const f32x4*)(p0 + (size_t)sgm * 256 * DM + 8 * (ib + i)); q[i][sgm][1] = *(const f32x4*)(p0 + (size_t)sgm * 256 * DM + 8 * (ib + i) + 4); }
                asm volatile("" ::: "memory");
#pragma unroll
                for (int i = 0; i < 4; ++i) { const f32x4 a0 = q[i][0][0] + q[i][1][0] + q[i][2][0], a1 = q[i][0][1] + q[i][1][1] + q[i][2][1];
                    u32x4 w; w.x = cvt_pk_bf16(a0[0], a0[1]); w.y = cvt_pk_bf16(a0[2], a0[3]); w.z = cvt_pk_bf16(a1[0], a1[1]); w.w = cvt_pk_bf16(a1[2], a1[3]); *(u32x4*)(yo + 8 * (ib + i)) = w; }
                asm volatile("" ::: "memory"); }
            asm volatile("s_waitcnt vmcnt(0)" ::: "memory");
            asm volatile("" ::: "memory"); __builtin_amdgcn_s_barrier(); asm volatile("" ::: "memory");
        }
    }
    __device__ __forceinline__ void done(const Unit&) const {}
};
struct ResidOrder {
    StaticOrder lat; int c, G, n;
    __device__ __forceinline__ bool next(int i, Unit& u) const {
        const int nl = lat.c < lat.nwg ? (lat.nwg - lat.c + lat.G - 1) / lat.G : 0;
        if (i < nl) { lat.next(i, u); u.pm += 1; return true; }
        const int L = (i - nl) * G + c; if (L >= n) return false;
        u.pm = 0; u.pn = L >> 4; u.koff = (L & 15) * 256; u.boff = u.koff; u.fl = 4 << 8; return true;
    }
    __device__ __forceinline__ void a_ready(const Unit&) const {}
    __device__ __forceinline__ void done(const Unit&) const {}
};
struct MergeOrder {
    StaticOrder lat; int c, G, nctx;
    __device__ __forceinline__ bool next(int i, Unit& u) const {
        const int nl = lat.c < lat.nwg ? (lat.nwg - lat.c + lat.G - 1) / lat.G : 0;
        if (i < 3 * nl) { lat.next(i / 3, u); u.pm += 1; const int sg = i % 3; u.fl = sg | (sg != 0 ? 4 : 0); u.koff = sg * (MT * 1024); u.boff = sg * (4096 * 1024); return true; }
        const int L = (i - 3 * nl) * G + c; if (L >= nctx) return false;
        u.pm = 0; u.pn = L / 3; const int sg = L % 3; u.fl = sg; u.koff = sg * (MT * 1024); u.boff = sg * (4096 * 1024); return true;
    }
    __device__ __forceinline__ void a_ready(const Unit&) const {}
    __device__ __forceinline__ void done(const Unit&) const {}
};
struct EpiSlab {
    static constexpr bool PERM = false, AFTER_DRAIN = false;
    float* S;
    __device__ __forceinline__ void operator()(const f32x4 (&acc)[2][2][4][2], const Unit& u, int wr, int wc, int fr, int fq) const {
        { const int l_ = mk_lane_id(); fr = l_ & 15; fq = l_ >> 4; }
        const int col0 = u.pn * BM + wc * 32 + 4 * fq; float* base = S + (size_t)(u.koff >> 8) * 256 * DM;
#pragma unroll
        for (int ai = 0; ai < 2; ++ai)
#pragma unroll
            for (int m = 0; m < 4; ++m) { float* p = base + (size_t)(ai * HALF + wr * 64 + m * 16 + fr) * DM + col0;
#pragma unroll
                for (int bj = 0; bj < 2; ++bj)
#pragma unroll
                    for (int n = 0; n < 2; ++n) *(f32x4*)(p + bj * HALF + n * 16) = acc[ai][bj][m][n]; }
    }
};
struct EpiWin {
    static constexpr bool PERM = true, AFTER_DRAIN = false;
    bf16_t* ZB; const float* rc; const float* rs;
    __device__ __forceinline__ void operator()(const f32x4 (&acc)[2][2][4][2], const Unit& u, int wr, int wc, int fr, int fq) const {
        { const int l_ = mk_lane_id(); fr = l_ & 15; fq = l_ >> 4; }
        const int pn = u.pn; int kind = 0, ld = 1024, c0 = 0;
        if (pn < 8) { kind = 1; ld = 2048; c0 = 0; } else if (pn < 10) { ld = 512; c0 = 2048; } else if (pn < 12) { ld = 512; c0 = 2560; } else if (pn < 16) { c0 = 3072; }
        else if (pn < 20) { kind = 2; c0 = 4096; } else if (pn < 24) { kind = 3; c0 = 5120; } else if (pn < 28) { kind = 3; c0 = 6144; } else if (pn < 32) { c0 = 7168; } else { kind = 2; ld = 12288; c0 = 8192; }
        if (kind == 3 && u.pm == 0) kind = 0;
        bf16_t* base = ZB + (size_t)MT * c0; const int colt = pn * BM - c0 + wc * 32 + 8 * fq; const int row0 = u.pm * BM + wr * 64 + fr;
#define EPIWIN_LOOP(...) _Pragma("unroll") for (int ai = 0; ai < 2; ++ai) _Pragma("unroll") for (int m = 0; m < 4; ++m) { const int row = row0 + ai * HALF + m * 16; _Pragma("unroll") for (int bj = 0; bj < 2; ++bj) { \
            const int col = colt + bj * HALF; float v[8]; _Pragma("unroll") for (int n = 0; n < 2; ++n) _Pragma("unroll") for (int i = 0; i < 4; ++i) v[n * 4 + i] = acc[ai][bj][m][n][i]; \
            __VA_ARGS__ \
            u32x4 w; w.x = cvt_pk_bf16(v[0], v[1]); w.y = cvt_pk_bf16(v[2], v[3]); w.z = cvt_pk_bf16(v[4], v[5]); w.w = cvt_pk_bf16(v[6], v[7]); *(u32x4*)(base + (size_t)row * ld + col) = w; } }
        if (kind == 0) { EPIWIN_LOOP(;) }
        else if (kind == 1) { EPIWIN_LOOP(_Pragma("unroll") for (int i = 0; i < 8; ++i) { const float x = v[i], uu = 0.7978845608028654f * (x + 0.044715f * x * x * x); v[i] = x / (1.f + __expf(-2.f * uu)); }) }
        else if (kind == 2) { EPIWIN_LOOP(_Pragma("unroll") for (int i = 0; i < 8; ++i) v[i] = 1.f / (1.f + __expf(-v[i]));) }
        else {
#pragma unroll
            for (int ai = 0; ai < 2; ++ai) { f32x4 c4[4][2], s4[4][2];
#pragma unroll
                for (int m = 0; m < 4; ++m)
#pragma unroll
                    for (int bj = 0; bj < 2; ++bj) { const int t = row0 + ai * HALF + m * 16 - CTXL, j0 = ((colt + bj * HALF) & 127) >> 1; c4[m][bj] = *(const f32x4*)(rc + t * 64 + j0); s4[m][bj] = *(const f32x4*)(rs + t * 64 + j0); }
                asm volatile("" ::: "memory");
#pragma unroll
                for (int m = 0; m < 4; ++m)
#pragma unroll
                    for (int bj = 0; bj < 2; ++bj) { const int row = row0 + ai * HALF + m * 16, col = colt + bj * HALF; float v[8];
#pragma unroll
                        for (int n = 0; n < 2; ++n)
#pragma unroll
                            for (int i = 0; i < 4; ++i) v[n * 4 + i] = acc[ai][bj][m][n][i];
#pragma unroll
                        for (int i = 0; i < 4; ++i) { const float x1 = v[2 * i], x2 = v[2 * i + 1]; v[2 * i] = x1 * c4[m][bj][i] - x2 * s4[m][bj][i]; v[2 * i + 1] = x1 * s4[m][bj][i] + x2 * c4[m][bj][i]; }
                        u32x4 w; w.x = cvt_pk_bf16(v[0], v[1]); w.y = cvt_pk_bf16(v[2], v[3]); w.z = cvt_pk_bf16(v[4], v[5]); w.w = cvt_pk_bf16(v[6], v[7]); *(u32x4*)(base + (size_t)row * ld + col) = w; }
                asm volatile("" ::: "memory"); } }
#undef EPIWIN_LOOP
    }
};
struct EpiSwiglu {
    static constexpr bool PERM = true, AFTER_DRAIN = false;
    bf16_t* O; int ldc;
    __device__ __forceinline__ void operator()(const f32x4 (&acc)[2][2][4][2], const Unit& u, int wr, int wc, int fr, int fq) const {
        { const int l_ = mk_lane_id(); fr = l_ & 15; fq = l_ >> 4; }
        const int row0 = u.pm * BM + wr * 64 + fr, col0 = u.pn * HALF + wc * 32 + 8 * fq;
#pragma unroll
        for (int ai = 0; ai < 2; ++ai)
#pragma unroll
            for (int m = 0; m < 4; ++m) {
                bf16_t* rowp = O + (size_t)(row0 + ai * HALF + m * 16) * ldc + col0;
                float v[8];
#pragma unroll
                for (int n = 0; n < 2; ++n)
#pragma unroll
                    for (int i = 0; i < 4; ++i) { const float a = acc[ai][0][m][n][i], b = acc[ai][1][m][n][i]; v[n * 4 + i] = a / (1.f + __expf(-a)) * b; }
                u32x4 w; w.x = cvt_pk_bf16(v[0], v[1]); w.y = cvt_pk_bf16(v[2], v[3]); w.z = cvt_pk_bf16(v[4], v[5]); w.w = cvt_pk_bf16(v[6], v[7]);
                *(u32x4*)rowp = w;
            }
    }
};
struct EpiResid {
    static constexpr bool PERM = false, AFTER_DRAIN = false;
    float* X; const float* gate_lat; const float* gate_ctx; const float* XB; float f;
    __device__ __forceinline__ void operator()(const f32x4 (&acc)[2][2][4][2], const Unit& u, int wr, int wc, int fr, int fq) const {
        { const int l_ = mk_lane_id(); fr = l_ & 15; fq = l_ >> 4; }
        const int col0 = u.pn * BM + wc * 32 + 4 * fq;
        const float* gate = (u.pm == 0) ? gate_ctx : gate_lat;
        f32x4 gv[2][2];
#pragma unroll
        for (int bj = 0; bj < 2; ++bj)
#pragma unroll
            for (int n = 0; n < 2; ++n) gv[bj][n] = *(const f32x4*)(gate + col0 + bj * HALF + n * 16) * f;
#pragma unroll
        for (int ai = 0; ai < 2; ++ai) {
            f32x4 x[4][2][2];
            const size_t o0 = (size_t)(u.pm * BM + ai * HALF + wr * 64 + fr) * DM + col0; float* p0 = X + o0; const float* r0 = XB + o0;
#pragma unroll
            for (int m = 0; m < 4; ++m)
#pragma unroll
                for (int bj = 0; bj < 2; ++bj)
#pragma unroll
                    for (int n = 0; n < 2; ++n) x[m][bj][n] = *(const f32x4*)(r0 + (size_t)(m * 16) * DM + bj * HALF + n * 16);
            asm volatile("" ::: "memory");
#pragma unroll
            for (int m = 0; m < 4; ++m)
#pragma unroll
                for (int bj = 0; bj < 2; ++bj)
#pragma unroll
                    for (int n = 0; n < 2; ++n) *(f32x4*)(p0 + (size_t)(m * 16) * DM + bj * HALF + n * 16) = x[m][bj][n] + gv[bj][n] * acc[ai][bj][m][n];
            asm volatile("" ::: "memory");
        }
    }
};
struct EpiResidSlab {
    static constexpr bool PERM = false, AFTER_DRAIN = false;
    unsigned char* wsb; const float* gate_lat; const float* XB; float f;
    __device__ __forceinline__ void operator()(const f32x4 (&acc)[2][2][4][2], const Unit& u, int wr, int wc, int fr, int fq) const {
        if (u.pm == 0) { EpiSlab E{(float*)(wsb + WS_SLAB)}; E(acc, u, wr, wc, fr, fq); }
        else { EpiResid E{(float*)(wsb + WS_XR), gate_lat, gate_lat, XB, f}; E(acc, u, wr, wc, fr, fq); }
    }
};
struct EpiMergeSeg {
    static constexpr bool PERM = true, AFTER_DRAIN = false;
    const bf16_t* Zg; bf16_t* Y; float* MS3;
    __device__ __forceinline__ void operator()(f32x4 (&acc)[2][2][4][2], const Unit& u, int wr, int wc, int fr, int fq) const {
        { const int l_ = mk_lane_id(); fr = l_ & 15; fq = l_ >> 4; }
        const int seg = u.seg(); const bool ctxp = (u.pm == 0);
        const int col0 = u.pn * BM + wc * 32 + 8 * fq;
#pragma unroll
        for (int ai = 0; ai < 2; ++ai) {
            u32x4 ga[4][2], gb[4][2];
#pragma unroll
            for (int m = 0; m < 4; ++m)
#pragma unroll
                for (int bj = 0; bj < 2; ++bj) { const bf16_t* gp = Zg + (size_t)MT * ZC_MG + (size_t)(u.pm * BM + ai * HALF + wr * 64 + m * 16 + fr) * 12288 + seg * 4096 + col0 + bj * HALF;
                    ga[m][bj] = *(const u32x4*)gp; if (!ctxp && seg < 2) gb[m][bj] = *(const u32x4*)(gp + 4096); }
            asm volatile("" ::: "memory");
#pragma unroll
            for (int m = 0; m < 4; ++m)
#pragma unroll
                for (int bj = 0; bj < 2; ++bj) { const size_t row = (size_t)(u.pm * BM + ai * HALF + wr * 64 + m * 16 + fr); const int col = col0 + bj * HALF;
                    const unsigned aw[4] = {ga[m][bj].x, ga[m][bj].y, ga[m][bj].z, ga[m][bj].w};
                    float g[8];
#pragma unroll
                    for (int k = 0; k < 4; ++k) { g[2 * k] = fmaxf(__uint_as_float(aw[k] << 16), 1e-20f); g[2 * k + 1] = fmaxf(__uint_as_float(aw[k] & 0xffff0000u), 1e-20f); }
                    if (!ctxp && seg < 2) { const unsigned bw[4] = {gb[m][bj].x, gb[m][bj].y, gb[m][bj].z, gb[m][bj].w};
#pragma unroll
                        for (int k = 0; k < 4; ++k) { g[2 * k] = g[2 * k] * __builtin_amdgcn_rcpf(fmaxf(__uint_as_float(bw[k] << 16), 1e-20f)); g[2 * k + 1] = g[2 * k + 1] * __builtin_amdgcn_rcpf(fmaxf(__uint_as_float(bw[k] & 0xffff0000u), 1e-20f)); } }
                    float v[8];
#pragma unroll
                    for (int n = 0; n < 2; ++n)
#pragma unroll
                        for (int i = 0; i < 4; ++i) v[n * 4 + i] = acc[ai][bj][m][n][i] * g[n * 4 + i];
                    if (ctxp) { float* ms = MS3 + ((size_t)seg * 256 + row) * DM + col; *(f32x4*)ms = (f32x4){v[0], v[1], v[2], v[3]}; *(f32x4*)(ms + 4) = (f32x4){v[4], v[5], v[6], v[7]}; }
                    else if (seg < 2) { acc[ai][bj][m][0] = (f32x4){v[0], v[1], v[2], v[3]}; acc[ai][bj][m][1] = (f32x4){v[4], v[5], v[6], v[7]}; }
                    else { u32x4 w; w.x = cvt_pk_bf16(v[0], v[1]); w.y = cvt_pk_bf16(v[2], v[3]); w.z = cvt_pk_bf16(v[4], v[5]); w.w = cvt_pk_bf16(v[6], v[7]); *(u32x4*)(Y + row * DM + col) = w; } }
            asm volatile("" ::: "memory");
        }
    }
};
}

constexpr int TSTR = 68, TSCR_BYTES = 64 * TSTR * 4;
__device__ __forceinline__ void transpose_item(const float* __restrict__ W, size_t ldw, int K, int k0, int srccol0, bf16* WT, int dstrow0, LAS float* scr, int lane) {
    const int r4 = lane >> 4, c16 = lane & 15;
    f32x4 v[16];
#pragma unroll
    for (int i = 0; i < 16; ++i) v[i] = __builtin_nontemporal_load((const f32x4*)(W + (size_t)(k0 + 4 * i + r4) * ldw + srccol0 + 4 * c16));
#pragma unroll
    for (int i = 0; i < 16; ++i) *(LAS f32x4*)(scr + (4 * i + r4) * TSTR + 4 * c16) = v[i];
    LDS_WAIT(); asm volatile("" ::: "memory");
    const int c = lane & 7;
#pragma unroll
    for (int j = 0; j < 8; ++j) { const int n = (lane >> 3) + 8 * j; const LAS float* sp = scr + (8 * c) * TSTR + n;
        v4u o; o.x = pk2(sp[0 * TSTR], sp[1 * TSTR]); o.y = pk2(sp[2 * TSTR], sp[3 * TSTR]); o.z = pk2(sp[4 * TSTR], sp[5 * TSTR]); o.w = pk2(sp[6 * TSTR], sp[7 * TSTR]);
        __builtin_nontemporal_store(o, (GAS v4u*)(WT + (size_t)(dstrow0 + n) * K + k0 + 8 * c)); }
    LDS_WAIT(); asm volatile("" ::: "memory");
}

struct Ptrs {
    const float *x, *c, *ctx, *c_ctx, *ada_down, *ada_up, *ada_bias, *norm_g, *w13, *w2, *w_in, *gmlp_norm_g, *gmlp_ws, *gmlp_bs, *gate_b, *mlstm_norm_g, *diff_lambda, *diff_norm_g, *w_branch, *w_out, *final_g;
    float* out; unsigned char* ws;
};

constexpr int IT_W13 = 2 * 64 * 128, IT_W2 = 2 * 64 * 64, IT_WIN = 64 * 320, IT_WB = 3 * 16 * 64, IT_WO = 64 * 64, IT_LAYER = IT_W13 + IT_W2 + IT_WIN + IT_WB + IT_WO;

constexpr int NE = 8192 + 4096 + IT_WIN, NL = IT_WB + IT_WO + 8192 + 4096;
static_assert(NE + NL == IT_LAYER, "lists cover the layer");
__device__ __forceinline__ void convert_range(const Ptrs& P, int l, int list, int it_lo, int it_hi, int widx, int nw, LAS float* scr, int lane) {
    unsigned char* ws = P.ws;
    for (int it = it_lo + widx; it < it_hi; it += nw) {
        int r;
        if (list == 0) r = it < 8192 ? it : it < 12288 ? IT_W13 + (it - 8192) : IT_W13 + IT_W2 + (it - 12288);
        else r = it < IT_WB ? IT_W13 + IT_W2 + IT_WIN + it : it < IT_WB + IT_WO ? IT_W13 + IT_W2 + IT_WIN + it : it < IT_WB + IT_WO + 8192 ? 8192 + (it - IT_WB - IT_WO) : IT_W13 + 4096 + (it - IT_WB - IT_WO - 8192);
        if (r < IT_W13) { const int s = r / (64 * 128), q = r % (64 * 128), kb = q / 128, nb = q % 128, dr = nb * 64, tile = dr >> 8, within = dr & 255;
            const int src = within < 128 ? tile * 128 + within : 4096 + tile * 128 + (within - 128);
            transpose_item(P.w13 + (size_t)(l * 2 + s) * 4096 * 8192, 8192, 4096, kb * 64, src, (bf16*)(ws + WS_W13T) + (size_t)(l * 2 + s) * 8192 * 4096, dr, scr, lane); continue; }
        r -= IT_W13;
        if (r < IT_W2) { const int s = r / (64 * 64), q = r % (64 * 64), kb = q / 64, nb = q % 64;
            transpose_item(P.w2 + (size_t)(l * 2 + s) * 4096 * 4096, 4096, 4096, kb * 64, nb * 64, (bf16*)(ws + WS_W2T) + (size_t)(l * 2 + s) * 4096 * 4096, nb * 64, scr, lane); continue; }
        r -= IT_W2;
        if (r < IT_WIN) { const int kb = r / 320, nb = r % 320, dr = nb * 64, src = dr < 5120 ? dr : dr + 16;
            transpose_item(P.w_in + (size_t)l * 4096 * INC, INC, 4096, kb * 64, src, (bf16*)(ws + WS_WINT) + (size_t)l * NZ * 4096, dr, scr, lane); continue; }
        r -= IT_WIN;
        if (r < IT_WB) { const int i = r / (16 * 64), q = r % (16 * 64), kb = q / 64, nb = q % 64;
            transpose_item(P.w_branch + (size_t)(l * 3 + i) * 1024 * 4096, 4096, 1024, kb * 64, nb * 64, (bf16*)(ws + WS_WBT) + (size_t)(l * 3 + i) * 4096 * 1024, nb * 64, scr, lane); continue; }
        r -= IT_WB;
        { const int kb = r / 64, nb = r % 64;
            transpose_item(P.w_out + (size_t)l * 4096 * 4096, 4096, 4096, kb * 64, nb * 64, (bf16*)(ws + WS_WOT) + (size_t)l * 4096 * 4096, nb * 64, scr, lane); }
    }
}
#ifndef CVP_D
#define CVP_D 9
#endif
#ifndef CVP_T
#define CVP_T 8
#endif
constexpr int CVD = IT_LAYER * CVP_D / 100, CVS = CVD + IT_LAYER * CVP_T / 100;
static_assert(CVS < NL && CVS < NE, "slot sizes");
__device__ __forceinline__ void convert_part(const Ptrs& P, int lnext, int list, int it_lo, int it_hi, int idx, int n, LAS unsigned char* lds, int tid) {
    asm volatile("" : "+v"(tid));
    if (lnext >= DEPTH || idx < 0 || idx >= n) return;
    const int wave = tid >> 6, lane = tid & 63;
    convert_range(P, lnext, list, it_lo, it_hi, idx * NWAVES + wave, n * NWAVES, (LAS float*)(lds + RING_OFF + wave * TSCR_BYTES), lane);
}
__device__ __forceinline__ void convert_idle(const Ptrs& P, int lnext, int list, int it_lo, int it_hi, int first_idle, int gend, LAS unsigned char* lds, int bid, int tid) {
    if (gend < first_idle + 16) first_idle = 0;
    if (bid >= gend) return;
    convert_part(P, lnext, list, it_lo, it_hi, bid - first_idle, gend - first_idle, lds, tid);
}
__device__ __forceinline__ void pro0(const Ptrs& P, LAS unsigned char* lds, int bid, int G, int tid) {
    asm volatile("" : "+v"(tid));
    const int wave = tid >> 6, lane = tid & 63;
    LAS float* scr = (LAS float*)(lds + RING_OFF + wave * TSCR_BYTES);
    const int gw = bid * NWAVES + wave, NGW = G * NWAVES;
    unsigned char* ws = P.ws;
    convert_range(P, 0, 0, 0, NE, gw, NGW, scr, lane);
    for (int l = 1; l < DEPTH; ++l) convert_range(P, l, 0, CVS, NE, gw, NGW, scr, lane);
    const int gt = bid * NTHR + tid, NGT = G * NTHR;
    { float* rc = (float*)(ws + WS_ROPE); float* rs = rc + SEQ * 64;
      for (int i = gt; i < SEQ * 64; i += NGT) { const int t = i >> 6, j = i & 63; const float inv = powf(10000.f, -(float)(j & 31) / 32.f);
          const float pos = (float)(j < 32 ? (t >> 6) : (t & 63)); const float ang = pos * inv; rc[i] = cosf(ang); rs[i] = sinf(ang); } }
    { float* tp = (float*)(ws + WS_MODTP);
      for (int task = gw; task < DEPTH * 2 * 4 * 64; task += NGW) { const int dc = task & 63, rg = (task >> 6) & 3, w = (task >> 8) & 1, l = task >> 9;
          const float* cv = w ? P.c_ctx : P.c; const float* dn = P.ada_down + (size_t)l * DM * ADAR + (size_t)(dc * 64) * ADAR + rg * 64 + lane;
          float wv[64]; const float cmine = cv[dc * 64 + lane], smine = cmine / (1.f + expf(-cmine));
#pragma unroll
          for (int d = 0; d < 64; ++d) wv[d] = dn[(size_t)d * ADAR];
          asm volatile("" ::: "memory");
          float acc = 0.f;
#pragma unroll
          for (int d = 0; d < 64; ++d) acc += __int_as_float(__builtin_amdgcn_readlane(__float_as_int(smine), d)) * wv[d];
          tp[((l * 2 + w) * 64 + dc) * 256 + rg * 64 + lane] = acc; } }
    if (bid == 0 && tid < DEPTH) { const float* dl = P.diff_lambda + tid * 4 * 128; float s1 = 0.f, s2 = 0.f;
        for (int i = 0; i < 128; ++i) { s1 += dl[i] * dl[128 + i]; s2 += dl[256 + i] * dl[384 + i]; }
        ((float*)(ws + WS_LAM))[tid] = expf(s1) - expf(s2) + lambda_init_f(tid); }
    { bf16* wb = (bf16*)(ws + WS_GWSB); for (int i = gt; i < DEPTH * 8 * 128 * 128; i += NGT) wb[i] = (bf16)f2bf(P.gmlp_ws[i]); }
    { bf16* wg = (bf16*)(ws + WS_WG16);
      for (int i = gt; i < DEPTH * DM * 16; i += NGT) { const int j = i & 15, d = (i >> 4) & (DM - 1), l = i >> 16;
          wg[((size_t)l * 16 + j) * DM + d] = (bf16)f2bf(P.w_in[((size_t)l * DM + d) * INC + 5120 + j]); } }
}

__device__ __forceinline__ void pro1(const Ptrs& P, LAS unsigned char* lds, int bid, int G, int tid) {
    asm volatile("" : "+v"(tid));
    LAS float* T = (LAS float*)(lds + RING_OFF);
    const float* tp = (const float*)(P.ws + WS_MODTP);
    for (int i = tid; i < DEPTH * 2 * 256; i += NTHR) { const int r = i & 255, lw = i >> 8; float s = 0.f;
        for (int dc = 0; dc < 64; ++dc) s += tp[(lw * 64 + dc) * 256 + r];
        T[i] = s; }
    __syncthreads();
    float* MOD = (float*)(P.ws + WS_MOD);
    for (int i = bid * NTHR + tid; i < DEPTH * NMOD; i += G * NTHR) { const int l = i / NMOD, n = i % NMOD;
        const float* up = P.ada_up + (size_t)l * ADAR * NMOD + n; const float b = P.ada_bias[(size_t)l * NMOD + n]; float a0 = b, a1 = b;
#pragma unroll 1
        for (int r0 = 0; r0 < ADAR; r0 += 32) { float uu[32];
#pragma unroll
            for (int k = 0; k < 32; ++k) uu[k] = up[(size_t)(r0 + k) * NMOD];
            asm volatile("" ::: "memory");
#pragma unroll
            for (int k = 0; k < 32; ++k) { a0 += T[(l * 2 + 0) * 256 + r0 + k] * uu[k]; a1 += T[(l * 2 + 1) * 256 + r0 + k] * uu[k]; } }
        MOD[(size_t)(l * 2 + 0) * NMOD + n] = a0; MOD[(size_t)(l * 2 + 1) * NMOD + n] = a1; }
    __syncthreads();
}

__device__ __forceinline__ void phase_norm(float* XR, const float* rdl, const float* rdc, const float* prec, const float* g, const float* modl, const float* modc, bf16* H, const float* slab, const float* cgate, float cf, LAS unsigned char* lds, int bid, int G, int tid) {
    asm volatile("" : "+v"(tid));
    const int wave = tid >> 6, lane = tid & 63;
    LAS f32x4* AL = (LAS f32x4*)lds; LAS f32x4* SL = AL + 1024; LAS f32x4* AC = AL + 2048; LAS f32x4* SC = AL + 3072;
    { f32x4 q[2][5];
#pragma unroll
      for (int k = 0; k < 2; ++k) { const int i = tid + k * NTHR; q[k][0] = ((const f32x4*)g)[i]; q[k][1] = ((const f32x4*)(modl + DM))[i]; q[k][2] = ((const f32x4*)modl)[i]; q[k][3] = ((const f32x4*)(modc + DM))[i]; q[k][4] = ((const f32x4*)modc)[i]; }
      asm volatile("" ::: "memory");
#pragma unroll
      for (int k = 0; k < 2; ++k) { const int i = tid + k * NTHR; AL[i] = q[k][0] * (q[k][1] + 1.f); SL[i] = q[k][2]; AC[i] = q[k][0] * (q[k][3] + 1.f); SC[i] = q[k][4]; } }
    const int row0 = bid * NWAVES + wave, stride = G * NWAVES;
    if (slab && row0 < CTXL) {
        f32x4* xw = (f32x4*)(XR + (size_t)row0 * DM) + lane; const f32x4* xpre = (const f32x4*)(prec + (size_t)row0 * DM) + lane; const f32x4* sp = (const f32x4*)(slab + (size_t)row0 * DM) + lane; const f32x4* gp = (const f32x4*)cgate + lane;
#pragma unroll 1
        for (int j = 0; j < 16; j += 2) { f32x4 q[2][16], xo[2];
#pragma unroll
            for (int jj = 0; jj < 2; ++jj) { xo[jj] = xpre[64 * (j + jj)];
#pragma unroll
                for (int kc = 0; kc < 16; ++kc) q[jj][kc] = sp[(size_t)kc * 256 * (DM / 4) + 64 * (j + jj)]; }
            asm volatile("" ::: "memory");
#pragma unroll
            for (int jj = 0; jj < 2; ++jj) { f32x4 a = (f32x4){0.f, 0.f, 0.f, 0.f};
#pragma unroll
                for (int kc = 0; kc < 16; ++kc) a += q[jj][kc];
                xw[64 * (j + jj)] = xo[jj] + a * gp[64 * (j + jj)] * cf; }
            asm volatile("" ::: "memory"); }
        asm volatile("s_waitcnt vmcnt(0)" ::: "memory");
    }
    __syncthreads();
    f32x4 v[16];
    if (row0 < MT) { const f32x4* xr = (const f32x4*)((row0 < CTXL ? rdc : rdl) + (size_t)row0 * DM) + lane;
#pragma unroll
        for (int j = 0; j < 16; ++j) v[j] = xr[64 * j]; }
    for (int row = row0; row < MT; row += stride) {
        f32x4 vn[16];
        if (row + stride < MT) { const f32x4* xr = (const f32x4*)(rdl + (size_t)(row + stride) * DM) + lane;
#pragma unroll
            for (int j = 0; j < 16; ++j) vn[j] = xr[64 * j]; }
        float ss = 0.f;
#pragma unroll
        for (int j = 0; j < 16; ++j) ss += (v[j].x * v[j].x + v[j].y * v[j].y) + (v[j].z * v[j].z + v[j].w * v[j].w);
        const float rstd = 1.f / sqrtf(wave_sum(ss) * (1.f / DM) + EPS);
        const LAS f32x4* Ap = row < CTXL ? AC : AL; const LAS f32x4* Sp = row < CTXL ? SC : SL;
        uint2* hr = (uint2*)(H + (size_t)row * DM) + lane;
#pragma unroll
        for (int j = 0; j < 16; ++j) { const f32x4 hv = v[j] * rstd * Ap[lane + 64 * j] + Sp[lane + 64 * j];
            uint2 o; o.x = pk2(hv.x, hv.y); o.y = pk2(hv.z, hv.w); hr[64 * j] = o; }
#pragma unroll
        for (int j = 0; j < 16; ++j) v[j] = vn[j];
    }
    __syncthreads();
}
typedef float f32x4g __attribute__((ext_vector_type(4)));
__device__ __forceinline__ void gates_unit(const bf16* H, const bf16* WGb, float* G16, int jb, int tid) {
    asm volatile("" : "+v"(tid));
    const int wave = tid >> 6, lane = tid & 63, fr = lane & 15, fq = lane >> 4;
    const bf16* ap = H + (size_t)(jb * 128 + wave * 16 + fr) * DM + 8 * fq; const bf16* bp = WGb + (size_t)fr * DM + 8 * fq;
    f32x4g acc[4];
#pragma unroll
    for (int i = 0; i < 4; ++i) acc[i] = (f32x4g){0.f, 0.f, 0.f, 0.f};
#pragma unroll 1
    for (int k = 0; k < DM; k += 512) { bf16x8 af[16], bfv[16];
#pragma unroll
        for (int i = 0; i < 16; ++i) { af[i] = *(const bf16x8*)(ap + k + 32 * i); bfv[i] = *(const bf16x8*)(bp + k + 32 * i); }
        asm volatile("" ::: "memory");
#pragma unroll
        for (int i = 0; i < 16; ++i) acc[i & 3] = __builtin_amdgcn_mfma_f32_16x16x32_bf16(af[i], bfv[i], acc[i & 3], 0, 0, 0);
    }
    const f32x4g sres = (acc[0] + acc[1]) + (acc[2] + acc[3]);
#pragma unroll
    for (int r = 0; r < 4; ++r) G16[(size_t)(jb * 128 + wave * 16 + 4 * fq + r) * 16 + fr] = sres[r];
}

__device__ __forceinline__ void phase_final(const float* XR, const float* g, float* out, int bid, int G, int tid) {
    asm volatile("" : "+v"(tid));
    const int wave = tid >> 6, lane = tid & 63;
    f32x4 gg[16];
#pragma unroll
    for (int j = 0; j < 16; ++j) gg[j] = *(const f32x4*)(g + 4 * lane + 256 * j);
    for (int t = bid * NWAVES + wave; t < SEQ; t += G * NWAVES) {
        const f32x4* xr = (const f32x4*)(XR + (size_t)(CTXL + t) * DM) + lane;
        f32x4 v[16]; float ss = 0.f;
#pragma unroll
        for (int j = 0; j < 16; ++j) { v[j] = xr[64 * j]; ss += (v[j].x * v[j].x + v[j].y * v[j].y) + (v[j].z * v[j].z + v[j].w * v[j].w); }
        const float rstd = 1.f / sqrtf(wave_sum(ss) * (1.f / DM) + EPS);
        f32x4* o = (f32x4*)(out + (size_t)t * DM) + lane;
#pragma unroll
        for (int j = 0; j < 16; ++j) o[64 * j] = v[j] * rstd * gg[j];
    }
}

typedef short s16x4 __attribute__((ext_vector_type(4)));
typedef float f32x16 __attribute__((ext_vector_type(16)));
typedef short v4i16_t __attribute__((ext_vector_type(4)));
__device__ __forceinline__ int crow16(int r, int hi) { return (r & 3) + 8 * (r >> 2) + 4 * hi; }
__device__ __forceinline__ int chain_cidx(int dir, int jb) { return dir ? (jb < 2 ? 1 - jb : 67 - jb) : jb; }
__device__ __forceinline__ s16x4 trr(LAS const unsigned char* p) { return __builtin_bit_cast(s16x4, __builtin_amdgcn_ds_read_tr16_b64_v4i16((LAS v4i16_t*)p)); }
__device__ __forceinline__ bf16x8 trfrag(LAS const unsigned char* im, int RS, int rowA, int rowB, int n0, int lane) {
    const int i = lane & 15, q = i >> 2, p = i & 3, cb = n0 + 16 * ((lane >> 4) & 1) + 4 * p;
    const s16x4 lo = trr(im + (rowA + q) * RS + cb * 2), hi = trr(im + (rowB + q) * RS + cb * 2);
    return (bf16x8){lo[0], lo[1], lo[2], lo[3], hi[0], hi[1], hi[2], hi[3]};
}
constexpr int VSTR = 528, KW_OFF = 67584;
constexpr int SM_OFF = 133120;
__device__ __forceinline__ void gate_scan(const float* G16, const float* gate_b, int jb, int h, LAS float* SM, int tid) {
    LAS float* SC = SM + 768;
    const int dir = (tid >> 7) & 1, c = tid & 127, o = dir ? 127 - c : c; const bool act = tid < 256;
    float ip = 0.f, x = 0.f;
    if (act) { const size_t row = (size_t)jb * 128 + o; ip = G16[row * 16 + dir * 8 + h] + gate_b[dir * 8 + h]; const float fp = G16[row * 16 + dir * 8 + 4 + h] + gate_b[dir * 8 + 4 + h];
        x = fminf(fp, 0.f) - __logf(1.f + __expf(-fabsf(fp))); }
    for (int s = 1; s < 128; s <<= 1) { if (act) SC[dir * 128 + c] = x; __syncthreads(); if (act && c >= s) x += SC[dir * 128 + c - s]; __syncthreads(); }
    const float b = x, u = ip - b; float y = u;
    for (int s = 1; s < 128; s <<= 1) { if (act) SC[dir * 128 + c] = y; __syncthreads(); if (act && c >= s) y = fmaxf(y, SC[dir * 128 + c - s]); __syncthreads(); }
    if (act) { SM[dir * 128 + o] = u; SM[256 + dir * 128 + o] = y; SM[512 + dir * 128 + o] = b; if (c == 127) { SM[1024 + dir] = b; SM[1026 + dir] = y; } }
    __syncthreads();
}
__device__ __forceinline__ void stage_v(const bf16* Z, size_t row0, int h, LAS unsigned char* VL, int tid) {
    v4u t[8];
#pragma unroll
    for (int k = 0; k < 8; ++k) { const int i = tid + k * NTHR, sr = i >> 5, ch = i & 31; t[k] = *(const v4u*)(Z + (size_t)MT * ZC_MV + (row0 + sr) * 1024 + h * 256 + ch * 8); }
    asm volatile("" ::: "memory");
#pragma unroll
    for (int k = 0; k < 8; ++k) { const int i = tid + k * NTHR, sr = i >> 5, ch = i & 31; *(LAS v4u*)(VL + sr * VSTR + ch * 16) = t[k]; }
}
__device__ __forceinline__ void mlstm_m1_unit(const bf16* Z, const float* G16, const float* gate_b, float* DCT, float* DN, float* CH, int jb, int h, LAS unsigned char* lds, int tid) {
    asm volatile("" : "+v"(tid));
    const int wave = tid >> 6, lane = tid & 63, hh = lane >> 5;
    LAS unsigned char* VL = lds; LAS unsigned char* KW = lds + KW_OFF; LAS float* SM = (LAS float*)(lds + SM_OFF);
    gate_scan(G16, gate_b, jb, h, SM, tid);
    const size_t row0 = (size_t)jb * 128;
    stage_v(Z, row0, h, VL, tid);
    { v4u kq[4];
#pragma unroll
      for (int k = 0; k < 4; ++k) { const int i = tid + k * NTHR, sr = i >> 4, ch = i & 15; kq[k] = *(const v4u*)(Z + (size_t)MT * ZC_MK + (row0 + sr) * 512 + h * 128 + ch * 8); }
      asm volatile("" ::: "memory");
#pragma unroll
      for (int k = 0; k < 4; ++k) { const int i = tid + k * NTHR, sr = i >> 4, ch = i & 15; const v4u kw = kq[k];
#pragma unroll
        for (int dir = 0; dir < 2; ++dir) { const float wg = __expf(SM[dir * 128 + sr] - SM[1026 + dir]); v4u o;
            o.x = pk2(bflo(kw.x) * wg, bfhi(kw.x) * wg); o.y = pk2(bflo(kw.y) * wg, bfhi(kw.y) * wg); o.z = pk2(bflo(kw.z) * wg, bfhi(kw.z) * wg); o.w = pk2(bflo(kw.w) * wg, bfhi(kw.w) * wg);
            *(LAS v4u*)(KW + dir * 32768 + sr * 256 + ch * 16) = o; } } }
    __syncthreads();
    const int dir = wave >> 2, ebp = wave & 3;
    f32x16 acc[2][4];
#pragma unroll
    for (int a = 0; a < 2; ++a)
#pragma unroll
        for (int b = 0; b < 4; ++b)
#pragma unroll
            for (int r = 0; r < 16; ++r) acc[a][b][r] = 0.f;
#pragma unroll 2
    for (int ks = 0; ks < 8; ++ks) {
        bf16x8 af[2], bfr[4];
#pragma unroll
        for (int eb = 0; eb < 2; ++eb) af[eb] = trfrag(VL, VSTR, 16 * ks + 8 * hh, 16 * ks + 8 * hh + 4, 32 * (2 * ebp + eb), lane);
#pragma unroll
        for (int db = 0; db < 4; ++db) bfr[db] = trfrag(KW + dir * 32768, 256, 16 * ks + 8 * hh, 16 * ks + 8 * hh + 4, 32 * db, lane);
#pragma unroll
        for (int eb = 0; eb < 2; ++eb)
#pragma unroll
            for (int db = 0; db < 4; ++db) acc[eb][db] = __builtin_amdgcn_mfma_f32_32x32x16_bf16(af[eb], bfr[db], acc[eb][db], 0, 0, 0);
    }
    { const int cidx = chain_cidx(dir, jb); float* dst = DCT + (size_t)((dir * 4 + h) * 66 + cidx) * 32768;
#pragma unroll
      for (int eb = 0; eb < 2; ++eb)
#pragma unroll
          for (int db = 0; db < 4; ++db)
#pragma unroll
              for (int r = 0; r < 16; ++r) dst[(32 * (2 * ebp + eb) + crow16(r, hh)) * 128 + 32 * db + (lane & 31)] = acc[eb][db][r]; }
    if (tid < 256) { const int dd = tid >> 7, d = tid & 127; float s = 0.f;
        for (int sg = 0; sg < 128; ++sg) s += bf2f(*(LAS const unsigned short*)(KW + dd * 32768 + sg * 256 + d * 2));
        DN[(size_t)((dd * 4 + h) * 66 + chain_cidx(dd, jb)) * 128 + d] = s; }
    if (tid < 2) { float* c = CH + (size_t)((tid * 4 + h) * 66 + chain_cidx(tid, jb)) * 2; c[0] = SM[1024 + tid]; c[1] = SM[1026 + tid]; }
    __syncthreads();
}
__device__ __forceinline__ void mlstm_m2_scalars(const float* CH, int chain, LAS float* SC, int tid) {
    if (tid < 66) { SC[256 + 2 * tid] = CH[(size_t)(chain * 66 + tid) * 2]; SC[256 + 2 * tid + 1] = CH[(size_t)(chain * 66 + tid) * 2 + 1]; }
    __syncthreads();
    if (tid == 0) { float m = 0.f;
        for (int j = 0; j < 66; ++j) { const float Bj = SC[256 + 2 * j], cm = SC[256 + 2 * j + 1], Mx = fmaxf(m, cm); SC[3 * j] = __expf(m - Mx); SC[3 * j + 1] = __expf(cm - Mx); SC[3 * j + 2] = m; m = Bj + Mx; } }
    __syncthreads();
}
__device__ __forceinline__ void mlstm_m2(const float* DCT, const float* DN, const float* CH, bf16* CT, float* NS, float* MS, LAS unsigned char* lds, int bid, int G, int tid) {
    asm volatile("" : "+v"(tid));
    LAS float* SC = (LAS float*)lds;
    for (int base = bid * NTHR; base < 8 * 16384; base += G * NTHR) {
        const int chain = base >> 14, p = (base & 16383) + tid;
        mlstm_m2_scalars(CH, chain, SC, tid);
        if ((base & 16383) == 0 && tid < 66) MS[chain * 66 + tid] = SC[3 * tid + 2];
        const float* dl = DCT + (size_t)chain * 66 * 32768 + 2 * p; unsigned* ct = (unsigned*)(CT + (size_t)chain * 66 * 32768 + 2 * p);
        float c0 = 0.f, c1 = 0.f;
#pragma unroll 1
        for (int jb = 0; jb < 66; jb += 11) { float2 d[11];
#pragma unroll
            for (int k = 0; k < 11; ++k) d[k] = *(const float2*)(dl + (size_t)(jb + k) * 32768);
            asm volatile("" ::: "memory");
#pragma unroll
            for (int k = 0; k < 11; ++k) { const float dec = SC[3 * (jb + k)], sc = SC[3 * (jb + k) + 1]; ct[(size_t)(jb + k) * 16384] = pk2(c0, c1); c0 = dec * c0 + sc * d[k].x; c1 = dec * c1 + sc * d[k].y; }
            asm volatile("" ::: "memory"); }
        __syncthreads();
    }
    for (int chain = bid; chain < 8; chain += G) {
        mlstm_m2_scalars(CH, chain, SC, tid);
        if (tid < 128) { float c0 = 0.f;
#pragma unroll 1
            for (int jb = 0; jb < 66; jb += 11) { float d[11];
#pragma unroll
                for (int k = 0; k < 11; ++k) d[k] = DN[(size_t)(chain * 66 + jb + k) * 128 + tid];
                asm volatile("" ::: "memory");
#pragma unroll
                for (int k = 0; k < 11; ++k) { NS[(size_t)(chain * 66 + jb + k) * 128 + tid] = c0; c0 = SC[3 * (jb + k)] * c0 + SC[3 * (jb + k) + 1] * d[k]; }
                asm volatile("" ::: "memory"); } }
        __syncthreads();
    }
}
__device__ __forceinline__ void mlstm_m3_unit(const bf16* Z, const float* G16, const float* gate_b, const bf16* CT, const float* NS, const float* MS, const float* mng, bf16* YB, int jb, int h, LAS unsigned char* lds, int tid) {
    asm volatile("" : "+v"(tid));
    const int wave = tid >> 6, lane = tid & 63, hh = lane >> 5, l31 = lane & 31;
    LAS unsigned char* VL = lds; LAS float* XCH = (LAS float*)lds; LAS float* SM = (LAS float*)(lds + SM_OFF);
    gate_scan(G16, gate_b, jb, h, SM, tid);
    const size_t row0 = (size_t)jb * 128;
    if (tid < 256) { const int dd = tid >> 7, d = tid & 127; SM[1040 + dd * 128 + d] = NS[(size_t)((dd * 4 + h) * 66 + chain_cidx(dd, jb)) * 128 + d]; }
    if (tid < 2) SM[1028 + tid] = MS[(tid * 4 + h) * 66 + chain_cidx(tid, jb)];
    stage_v(Z, row0, h, VL, tid);
    __syncthreads();
    const int tb = wave & 3, dir = wave >> 2, tau = 32 * tb + l31;
    float SCL = 0.08838834764831845f; asm volatile("" : "+v"(SCL));
    const float m = SM[1028 + dir], cmT = SM[256 + dir * 128 + tau], bT = SM[512 + dir * 128 + tau];
    const float Mt = fmaxf(m, cmT), wa = __expf(m - Mt), em = __expf(-(bT + Mt)), fa = wa * SCL;
    bf16x8 qf[8];
#pragma unroll
    for (int ks = 0; ks < 8; ++ks) qf[ks] = *(const bf16x8*)(Z + (size_t)MT * ZC_MQ + (row0 + tau) * 512 + h * 128 + 16 * ks + 8 * hh);
    f32x16 acc[8];
#pragma unroll
    for (int eb = 0; eb < 8; ++eb)
#pragma unroll
        for (int r = 0; r < 16; ++r) acc[eb][r] = 0.f;
    { const bf16* ct = CT + (size_t)((dir * 4 + h) * 66 + chain_cidx(dir, jb)) * 32768;
#pragma unroll
      for (int e2 = 0; e2 < 8; e2 += 2) { bf16x8 af[2][8];
#pragma unroll
          for (int eb = 0; eb < 2; ++eb)
#pragma unroll
              for (int ks = 0; ks < 8; ++ks) af[eb][ks] = *(const bf16x8*)(ct + (size_t)(32 * (e2 + eb) + l31) * 128 + 16 * ks + 8 * hh);
          asm volatile("" ::: "memory");
#pragma unroll
          for (int ks = 0; ks < 8; ++ks) { acc[e2] = __builtin_amdgcn_mfma_f32_32x32x16_bf16(af[0][ks], qf[ks], acc[e2], 0, 0, 0); acc[e2 + 1] = __builtin_amdgcn_mfma_f32_32x32x16_bf16(af[1][ks], qf[ks], acc[e2 + 1], 0, 0, 0); } } }
    asm volatile("" ::: "memory");
    float den = 0.f;
#pragma unroll
    for (int ks = 0; ks < 8; ++ks)
#pragma unroll
        for (int j = 0; j < 8; ++j) den += bf2f((unsigned short)qf[ks][j]) * SM[1040 + dir * 128 + 16 * ks + 8 * hh + j];
    den *= fa;
#pragma unroll
    for (int eb = 0; eb < 8; ++eb)
#pragma unroll
        for (int r = 0; r < 16; ++r) acc[eb][r] *= fa;
    asm volatile("" ::: "memory");
#pragma unroll 1
    for (int sb = 0; sb < 4; ++sb) {
        if (dir == 0 ? sb > tb : sb < tb) continue;
        asm volatile("" ::: "memory");
        f32x16 p;
#pragma unroll
        for (int r = 0; r < 16; ++r) p[r] = 0.f;
#pragma unroll
        for (int kh = 0; kh < 2; ++kh) { bf16x8 kf[4];
#pragma unroll
          for (int ks = 0; ks < 4; ++ks) kf[ks] = *(const bf16x8*)(Z + (size_t)MT * ZC_MK + (row0 + 32 * sb + l31) * 512 + h * 128 + 16 * (4 * kh + ks) + 8 * hh);
          asm volatile("" ::: "memory");
#pragma unroll
          for (int ks = 0; ks < 4; ++ks) p = __builtin_amdgcn_mfma_f32_32x32x16_bf16(kf[ks], qf[4 * kh + ks], p, 0, 0, 0); }
#pragma unroll
        for (int r = 0; r < 16; ++r) { const int sg = 32 * sb + crow16(r, hh); const bool keep = dir == 0 ? (sg <= tau) : (sg >= tau);
            const float w = keep ? __expf(SM[dir * 128 + sg] - Mt) * SCL : 0.f; p[r] *= w; den += p[r]; }
#pragma unroll
        for (int s = 0; s < 2; ++s) {
            v4u w4; w4.x = pk2(p[8 * s + 0], p[8 * s + 1]); w4.y = pk2(p[8 * s + 2], p[8 * s + 3]); w4.z = pk2(p[8 * s + 4], p[8 * s + 5]); w4.w = pk2(p[8 * s + 6], p[8 * s + 7]);
            const bf16x8 bfrag = __builtin_bit_cast(bf16x8, w4);
#pragma unroll
            for (int eb = 0; eb < 8; ++eb) { const bf16x8 a = trfrag(VL, VSTR, 32 * sb + 16 * s + 4 * hh, 32 * sb + 16 * s + 8 + 4 * hh, 32 * eb, lane);
                acc[eb] = __builtin_amdgcn_mfma_f32_32x32x16_bf16(a, bfrag, acc[eb], 0, 0, 0);
                if (eb & 1) { asm volatile("" ::: "memory"); } }
        }
    }
    den += shfl_xor_f(den, 32);
    { const float inv = 1.f / fmaxf(fabsf(den), em);
#pragma unroll
      for (int eb = 0; eb < 8; ++eb)
#pragma unroll
          for (int r = 0; r < 16; ++r) acc[eb][r] *= inv; }
    __syncthreads();
    LAS float* HS = (LAS float*)lds;
    if (dir == 1) {
#pragma unroll
        for (int eb = 0; eb < 8; ++eb)
#pragma unroll
            for (int r = 0; r < 16; ++r) HS[tau * 257 + 32 * eb + crow16(r, hh)] = acc[eb][r];
    }
    __syncthreads();
    if (dir == 0) {
#pragma unroll
        for (int eb = 0; eb < 8; ++eb)
#pragma unroll
            for (int r = 0; r < 16; ++r) HS[tau * 257 + 32 * eb + crow16(r, hh)] += acc[eb][r];
    }
    __syncthreads();
    {
        unsigned short og[16][4]; float gn[4];
#pragma unroll
        for (int rr = 0; rr < 16; ++rr)
#pragma unroll
            for (int k = 0; k < 4; ++k) og[rr][k] = Z[(size_t)MT * ZC_MO + (row0 + wave * 16 + rr) * 1024 + h * 256 + 64 * k + lane];
#pragma unroll
        for (int k = 0; k < 4; ++k) gn[k] = mng[h * 256 + 64 * k + lane];
#pragma unroll
        for (int rr = 0; rr < 16; ++rr) { const int t2 = wave * 16 + rr; float v[4]; float ss = 0.f;
#pragma unroll
            for (int k = 0; k < 4; ++k) { v[k] = HS[t2 * 257 + 64 * k + lane]; ss += v[k] * v[k]; }
            const float rstd = 1.f / sqrtf(wave_sum(ss) * (1.f / 256.f) + EPS); const size_t row = row0 + t2;
#pragma unroll
            for (int k = 0; k < 4; ++k) YB[row * 1024 + h * 256 + 64 * k + lane] = (bf16)f2bf(bf2f(og[rr][k]) * v[k] * rstd * gn[k]); }
    }
    __syncthreads();
}
__device__ __forceinline__ void gmlp_unit_mfma(const bf16* Z, const float* gng, const bf16* wsb  , const float* bs  , bf16* YA, int j, LAS unsigned char* lds, int tid) {
    asm volatile("" : "+v"(tid));
    const int wave = tid >> 6, lane = tid & 63, g = wave;
    LAS float* ST = (LAS float*)(lds + SM_OFF);
    LAS float* BSL = ST + 256;
    BSL[tid] = bs[tid]; BSL[tid + NTHR] = bs[tid + NTHR];
    LAS unsigned char* VN = lds + wave * 16384;
    const size_t row0 = (size_t)j * 128;
#pragma unroll 1
    for (int rb = 0; rb < 16; rb += 4) { v4u wq[4][2];
#pragma unroll
        for (int r4 = 0; r4 < 4; ++r4) { const v4u* zp = (const v4u*)(Z + (row0 + wave * 16 + rb + r4) * 2048 + 1024 + lane * 16); wq[r4][0] = zp[0]; wq[r4][1] = zp[1]; }
        asm volatile("" ::: "memory");
#pragma unroll
        for (int r4 = 0; r4 < 4; ++r4) { const int q = wave * 16 + rb + r4; const v4u w0 = wq[r4][0], w1 = wq[r4][1];
            float x[16]; const unsigned ww[8] = {w0.x, w0.y, w0.z, w0.w, w1.x, w1.y, w1.z, w1.w};
            float s = 0.f;
#pragma unroll
            for (int k = 0; k < 8; ++k) { x[2 * k] = bflo(ww[k]); x[2 * k + 1] = bfhi(ww[k]); s += x[2 * k] + x[2 * k + 1]; }
            const float mean = wave_sum(s) * (1.f / 1024.f); float s2 = 0.f;
#pragma unroll
            for (int k = 0; k < 16; ++k) { const float d = x[k] - mean; s2 += d * d; }
            const float rstd = 1.f / sqrtf(wave_sum(s2) * (1.f / 1024.f) + EPS);
            if (lane == 0) { ST[2 * q] = mean; ST[2 * q + 1] = rstd; } } }
    __syncthreads();
#pragma unroll 1
    for (int h = 0; h < 2; ++h) {
        const int ln = mk_lane_id(), hh = ln >> 5, l31 = ln & 31;
        const int cbase = g * 128 + 64 * h, c8 = (ln & 7) * 8;
        { const f32x4 g0 = *(const f32x4*)(gng + cbase + c8), g1 = *(const f32x4*)(gng + cbase + c8 + 4);
#pragma unroll 1
          for (int ib = 0; ib < 16; ib += 4) { v4u wv[4];
#pragma unroll
            for (int i4 = 0; i4 < 4; ++i4) wv[i4] = *(const v4u*)(Z + (row0 + (ib + i4) * 8 + (ln >> 3)) * 2048 + 1024 + cbase + c8);
            asm volatile("" ::: "memory");
#pragma unroll
            for (int i4 = 0; i4 < 4; ++i4) { const int q = (ib + i4) * 8 + (ln >> 3); const float mean = ST[2 * q], rstd = ST[2 * q + 1]; const v4u w = wv[i4]; v4u o;
              o.x = pk2((bflo(w.x) - mean) * rstd * g0.x, (bfhi(w.x) - mean) * rstd * g0.y); o.y = pk2((bflo(w.y) - mean) * rstd * g0.z, (bfhi(w.y) - mean) * rstd * g0.w);
              o.z = pk2((bflo(w.z) - mean) * rstd * g1.x, (bfhi(w.z) - mean) * rstd * g1.y); o.w = pk2((bflo(w.w) - mean) * rstd * g1.z, (bfhi(w.w) - mean) * rstd * g1.w);
              *(LAS v4u*)(VN + q * 128 + (ln & 7) * 16) = o; } } }
        LDS_WAIT(); asm volatile("" ::: "memory");
        bf16x8 bfr[8][2];
#pragma unroll
        for (int ks = 0; ks < 8; ++ks)
#pragma unroll
            for (int cb = 0; cb < 2; ++cb) bfr[ks][cb] = trfrag(VN, 128, 16 * ks + 8 * hh, 16 * ks + 8 * hh + 4, 32 * cb, ln);
        f32x16 acc[4][2];
#pragma unroll
        for (int pb = 0; pb < 4; ++pb)
#pragma unroll
            for (int cb = 0; cb < 2; ++cb)
#pragma unroll
                for (int r = 0; r < 16; ++r) acc[pb][cb][r] = 0.f;
#pragma unroll
        for (int pb = 0; pb < 4; ++pb) {
            bf16x8 af[8];
#pragma unroll
            for (int ks = 0; ks < 8; ++ks) af[ks] = *(const bf16x8*)(wsb + (size_t)(g * 128 + 32 * pb + l31) * 128 + 16 * ks + 8 * hh);
            asm volatile("" ::: "memory");
#pragma unroll
            for (int ks = 0; ks < 8; ++ks) { acc[pb][0] = __builtin_amdgcn_mfma_f32_32x32x16_bf16(af[ks], bfr[ks][0], acc[pb][0], 0, 0, 0); acc[pb][1] = __builtin_amdgcn_mfma_f32_32x32x16_bf16(af[ks], bfr[ks][1], acc[pb][1], 0, 0, 0); }
            asm volatile("" ::: "memory");
        }
        LDS_WAIT(); asm volatile("" ::: "memory");
#pragma unroll
        for (int pb = 0; pb < 4; ++pb)
#pragma unroll
            for (int q4 = 0; q4 < 4; ++q4) { const f32x4 b4 = *(const LAS f32x4*)(BSL + g * 128 + 32 * pb + 8 * q4 + 4 * hh);
#pragma unroll
                for (int i = 0; i < 4; ++i) { const int r = 4 * q4 + i, p = 32 * pb + 8 * q4 + 4 * hh + i;
#pragma unroll
                    for (int cb = 0; cb < 2; ++cb) *(LAS unsigned short*)(VN + p * 128 + (32 * cb + l31) * 2) = (unsigned short)f2bf(acc[pb][cb][r] + b4[i]); } }
        LDS_WAIT(); asm volatile("" ::: "memory");
#pragma unroll 1
        for (int ib = 0; ib < 16; ib += 4) { v4u uq[4];
#pragma unroll
            for (int i4 = 0; i4 < 4; ++i4) uq[i4] = *(const v4u*)(Z + (row0 + (ib + i4) * 8 + (ln >> 3)) * 2048 + cbase + c8);
            asm volatile("" ::: "memory");
#pragma unroll
            for (int i4 = 0; i4 < 4; ++i4) { const int p = (ib + i4) * 8 + (ln >> 3); const v4u m = *(const LAS v4u*)(VN + p * 128 + (ln & 7) * 16); const v4u u = uq[i4]; v4u o;
                o.x = pk2(bflo(u.x) * bflo(m.x), bfhi(u.x) * bfhi(m.x)); o.y = pk2(bflo(u.y) * bflo(m.y), bfhi(u.y) * bfhi(m.y));
                o.z = pk2(bflo(u.z) * bflo(m.z), bfhi(u.z) * bfhi(m.z)); o.w = pk2(bflo(u.w) * bflo(m.w), bfhi(u.w) * bfhi(m.w));
                *(v4u*)(YA + (row0 + p) * 1024 + cbase + c8) = o; } }
        LDS_WAIT(); asm volatile("" ::: "memory");
    }
    __syncthreads();
}

__device__ __forceinline__ void phase_post(const float* ATTO, const float* MLH, const bf16* Z, const float* dng, const float* mng, float lam, float linit, bf16* YB, bf16* YC, int bid, int G, int tid) {
    asm volatile("" : "+v"(tid));
    const int wave = tid >> 6, lane = tid & 63, head = lane >> 4, e0 = (lane & 15) * 16;
    for (int row = bid * NWAVES + wave; row < MT; row += G * NWAVES) {
        const size_t off = (size_t)row * 1024 + head * 256 + e0;
        {
            const f32x4* a0 = (const f32x4*)(ATTO + off); const f32x4* a1 = (const f32x4*)(ATTO + (size_t)MT * 1024 + off);
            float o[16]; float ss = 0.f;
#pragma unroll
            for (int k = 0; k < 4; ++k) { const f32x4 p = a0[k], q = a1[k];
                o[4 * k + 0] = p.x - lam * q.x; o[4 * k + 1] = p.y - lam * q.y; o[4 * k + 2] = p.z - lam * q.z; o[4 * k + 3] = p.w - lam * q.w; }
#pragma unroll
            for (int k = 0; k < 16; ++k) ss += o[k] * o[k];
            ss += shfl_xor_f(ss, 1); ss += shfl_xor_f(ss, 2); ss += shfl_xor_f(ss, 4); ss += shfl_xor_f(ss, 8);
            const float rstd = 1.f / sqrtf(ss * (1.f / 256.f) + EPS) * (1.f - linit);
            v4u w0, w1;
            w0.x = pk2(o[0] * rstd * dng[e0 + 0], o[1] * rstd * dng[e0 + 1]); w0.y = pk2(o[2] * rstd * dng[e0 + 2], o[3] * rstd * dng[e0 + 3]);
            w0.z = pk2(o[4] * rstd * dng[e0 + 4], o[5] * rstd * dng[e0 + 5]); w0.w = pk2(o[6] * rstd * dng[e0 + 6], o[7] * rstd * dng[e0 + 7]);
            w1.x = pk2(o[8] * rstd * dng[e0 + 8], o[9] * rstd * dng[e0 + 9]); w1.y = pk2(o[10] * rstd * dng[e0 + 10], o[11] * rstd * dng[e0 + 11]);
            w1.z = pk2(o[12] * rstd * dng[e0 + 12], o[13] * rstd * dng[e0 + 13]); w1.w = pk2(o[14] * rstd * dng[e0 + 14], o[15] * rstd * dng[e0 + 15]);
            v4u* yp = (v4u*)(YC + off); yp[0] = w0; yp[1] = w1;
        }
    }
}

struct Args { const float* in[21]; float* out; unsigned char* ws; int ph_lo, ph_hi; };
static_assert(sizeof(Args) == 21 * 8 + 8 + 8 + 8, "Args has no padding");

constexpr int T_ALL = -1, T_PRO0 = 0, T_PRO1 = 1, T_NORM = 2, T_W13 = 3, T_W2 = 4, T_N2 = 5, T_WIN = 6, T_ROPE = 7, T_MLSTM = 8, T_POST = 9, T_MERGE0 = 10, T_WOUT = 11, T_FINAL = 12, T_ATTN = 13, T_GMLP = 14, T_MERGE1 = 15, T_MERGE2 = 16, T_M3 = 17, NTYPES = 18;
#define SELD(t) (SEL == T_ALL || SEL == (t))
template <int SEL> __global__ void __launch_bounds__(NTHR, 2) mk_fwd(Args args) {
    extern __shared__ __attribute__((aligned(16))) unsigned char lds_raw[];
    LAS unsigned char* lds = (LAS unsigned char*)lds_raw;
    volatile LAS unsigned* MISC = (volatile LAS unsigned*)(lds + MISC_OFF);
    const int wave_s = __builtin_amdgcn_readfirstlane((int)threadIdx.x >> 6), bid_k = blockIdx.x, G = gridDim.x;
#define tid MK_TID(wave_s)
#define KARGS ((const __attribute__((address_space(4))) Args*)ka_)
#define PHASE_BEGIN const __attribute__((address_space(4))) void* ka_ = (const __attribute__((address_space(4))) void*)__builtin_amdgcn_kernarg_segment_ptr(); asm volatile("" : "+s"(ka_)); unsigned char* const ws = KARGS->ws; (void)ws; int bid = bid_k; asm volatile("" : "+s"(bid))
#define PIN(i) (KARGS->in[i])
#define XR ((float*)(ws + WS_XR))
#define H ((bf16*)(ws + WS_H))
#define GB ((bf16*)(ws + WS_GB))
#define Z ((bf16*)(ws + WS_Z))
#define ATTO ((float*)(ws + WS_ATTO))
#define MLH ((float*)(ws + WS_MLH))
#define DCT ((float*)(ws + WS_MLH))
#define YA ((bf16*)(ws + WS_YA))
#define YB ((bf16*)(ws + WS_YB))
#define YC ((bf16*)(ws + WS_YC))
#define SLAB ((float*)(ws + WS_SLAB))
#define YACC ((float*)(ws + WS_YACC))
#define Y ((bf16*)(ws + WS_Y))
#define G16 ((float*)(ws + WS_G16))
#define MOD ((const float*)(ws + WS_MOD))
#define CTS ((bf16*)(ws + WS_CT))
#define DNS ((float*)(ws + WS_MSM))
#define NSS (DNS + 8 * 66 * 128)
#define CHS (NSS + 8 * 66 * 128)
#define MSS (CHS + 8 * 66 * 2)
#define modl (MOD + (size_t)(l * 2 + 0) * NMOD)
#define modc (MOD + (size_t)(l * 2 + 1) * NMOD)
#define W13T0 ((const bf16*)(ws + WS_W13T) + (size_t)(l * 2 + 0) * 8192 * 4096)
#define W13T1 (W13T0 + (size_t)8192 * 4096)
#define W2T0 ((const bf16*)(ws + WS_W2T) + (size_t)(l * 2 + 0) * 4096 * 4096)
#define W2T1 (W2T0 + (size_t)4096 * 4096)
#define WINT ((const bf16*)(ws + WS_WINT) + (size_t)l * NZ * 4096)
#define WBT ((const bf16*)(ws + WS_WBT) + (size_t)(l * 3) * 4096 * 1024)
#define WOT ((const bf16*)(ws + WS_WOT) + (size_t)l * 4096 * 4096)
#define MKP() Ptrs P; P.x = PIN(0); P.c = PIN(1); P.ctx = PIN(2); P.c_ctx = PIN(3); P.ada_down = PIN(4); P.ada_up = PIN(5); P.ada_bias = PIN(6); P.norm_g = PIN(7); \
    P.w13 = PIN(8); P.w2 = PIN(9); P.w_in = PIN(10); P.gmlp_norm_g = PIN(11); P.gmlp_ws = PIN(12); P.gmlp_bs = PIN(13); P.gate_b = PIN(14); \
    P.mlstm_norm_g = PIN(15); P.diff_lambda = PIN(16); P.diff_norm_g = PIN(17); P.w_branch = PIN(18); P.w_out = PIN(19); P.final_g = PIN(20); P.out = KARGS->out; P.ws = KARGS->ws
    for (int u = tid; u < (LDS_BYTES - LDSCTL_OFF) / 4; u += NTHR) ((LAS unsigned*)(lds + LDSCTL_OFF))[u] = 0u;
    __syncthreads();
#if MK_ONE_LAUNCH
    XcdBarrier bar = xcd_barrier_post((unsigned*)((gu32*)(args.ws + WS_CTL) + CW_BAR), MISC + 8, tid);
#define GRID_BAR() do { XcdBarrier b2_ = bar; asm volatile("" : "+s"(b2_.bar)); xcd_barrier(b2_, tid); } while (0)
#else
#define GRID_BAR() do {} while (0)
#endif
    const int lo = args.ph_lo, hi = args.ph_hi;
#define IN(k) (lo <= (k) && (k) < hi)
#define SEAM(k) do { if (IN(k) && IN((k) + 1)) GRID_BAR(); } while (0)

    if (IN(P_PRO0)) { PHASE_BEGIN; MKP(); for (int rep_ = 0; rep_ < DBL_PRO; ++rep_) pro0(P, lds, bid, G, tid); SEAM(P_PRO0); }
    if (IN(P_PRO1)) { PHASE_BEGIN; MKP(); pro1(P, lds, bid, G, tid); SEAM(P_PRO1); }

    for (int l = 0; l < DEPTH; ++l) {
        const int pb = P_LAYER0 + l * NPL;
        if (hi <= pb || lo >= pb + NPL) continue;
#define GEMM_RESID_SPLIT2(Aptr, Bptr, gate_l, fac, ms3, yc, nctx_) do { \
            { pg8::Gemm g{(Aptr) + (size_t)CTXL * DM, (Bptr), SEQ, DM, DM, DM}; pg8::StaticOrder S; S.init(SEQ, DM, G, bid); pg8::EpiResid E{XR + (size_t)CTXL * DM, (gate_l), (gate_l), XR + (size_t)CTXL * DM, (fac)}; \
              pg8::gemm_phase<pg8::EpiResid, pg8::StaticOrder, true, true>(lds + RING_OFF, g, S, E, wave_s); } \
            { pg8::Gemm g{(Aptr), (Bptr), CTXL, DM, 256, DM}; pg8::CtxSplitOrder S{bid, G, (nctx_), (ms3), (yc), wave_s}; pg8::EpiSlab E{SLAB}; \
              pg8::gemm_phase<pg8::EpiSlab, pg8::CtxSplitOrder, true, true>(lds + RING_OFF, g, S, E, wave_s); } } while (0)
#define GEMM_RESID_SPLIT(Aptr, Bptr, gate_l, fac, ms3, yc, nctx_, xb_) do { \
            pg8::Gemm g{(Aptr), (Bptr), MT, DM, DM, DM}; pg8::ResidOrder S; S.lat.init(SEQ, DM, G, bid); S.c = bid; S.G = G; S.n = (nctx_); \
            pg8::EpiResidSlab E{ws, (gate_l), (xb_), (fac)}; \
            pg8::gemm_phase<pg8::EpiResidSlab, pg8::ResidOrder, true, true>(lds + RING_OFF, g, S, E, wave_s); } while (0)
#define GL (G >= 128 ? G - (G >> 4) : G)
#define NC (G - GL)
#define GEMM_LAT(EPI, GW_, Aptr, Bptr, Ncols, Kdim, ...) do { pg8::Gemm g{(Aptr), (Bptr), MT, (Ncols), (Kdim), (Kdim)}; pg8::StaticOrder S; S.init(MT, (Ncols), (GW_), bid); EPI E{__VA_ARGS__}; \
            pg8::gemm_phase<EPI, pg8::StaticOrder, true, true>(lds + RING_OFF, g, S, E, wave_s); } while (0)

        if (IN(pb + L_N1)) { PHASE_BEGIN; MKP(); phase_norm(XR, l == 0 ? P.x - (size_t)CTXL * DM : (const float*)XR, l == 0 ? P.ctx : (const float*)XR, XR, P.norm_g + (size_t)(l * 3 + 0) * DM, modl + 0 * 3 * DM, modc + 0 * 3 * DM, H, l > 0 ? SLAB : nullptr, modc - (size_t)2 * NMOD + 2 * 3 * DM + 2 * DM, 0.5f, lds, bid, G, tid); SEAM(pb + L_N1); }
        if (IN(pb + L_W13A)) { PHASE_BEGIN; MKP();
            if (bid < GL) { GEMM_LAT(pg8::EpiSwiglu, GL, H, W13T0, 8192, DM, GB, FFND);
                            convert_idle(P, l, 1, CVD, CVS, (MT / 256 * 32) % GL, GL, lds, bid, tid); }
            if (NC == 0 || bid >= GL) convert_part(P, l, 1, 0, CVD, NC ? bid - GL : bid, NC ? NC : G, lds, tid);
            SEAM(pb + L_W13A); }
        if (IN(pb + L_W2A)) { PHASE_BEGIN; MKP();
            GEMM_RESID_SPLIT(GB, W2T0, modl + 0 * 3 * DM + 2 * DM, 0.5f, (const float*)nullptr, (bf16*)nullptr, 256, l == 0 ? P.x - (size_t)CTXL * DM : (const float*)XR);
            SEAM(pb + L_W2A); }
        if (IN(pb + L_N2)) { PHASE_BEGIN; MKP(); phase_norm(XR, XR, XR, l == 0 ? P.ctx : (const float*)XR, P.norm_g + (size_t)(l * 3 + 1) * DM, modl + 1 * 3 * DM, modc + 1 * 3 * DM, H, SLAB, modc + 0 * 3 * DM + 2 * DM, 0.5f, lds, bid, G, tid); SEAM(pb + L_N2); }
        if (IN(pb + L_WIN)) { PHASE_BEGIN; MKP();
            if (bid < GL) { GEMM_LAT(pg8::EpiWin, GL, H, WINT, NZ, DM, Z, (const float*)(ws + WS_ROPE), (const float*)(ws + WS_ROPE) + SEQ * 64); }
            if (NC == 0 || bid >= GL) { convert_part(P, l, 1, CVS, NL, NC ? bid - GL : bid, NC ? NC : G, lds, tid);
                for (int u = NC ? bid - GL : bid; u < 66; u += (NC ? NC : G)) gates_unit(H, (const bf16*)(ws + WS_WG16) + (size_t)l * 16 * DM, G16, u, tid); }
            SEAM(pb + L_WIN); }
        if (IN(pb + L_MIX1)) { PHASE_BEGIN; MKP();
            for (int rep_ = 0; rep_ < DBL_M1; ++rep_) for (int u = (bid + G - (100 % G)) % G; u < 264; u += G) mlstm_m1_unit(Z, G16, P.gate_b + (size_t)l * 16, DCT, DNS, CHS, u >> 2, u & 3, lds, tid);
            for (int rep_ = 0; rep_ < DBL_ATTN; ++rep_) for (int u = bid; u < (l < DEPTH - 1 ? 264 : 256); u += G) {
                int hm, qb, seq; if (u < 256) { hm = u & 7; qb = 1 + (u >> 3); seq = MT; } else { hm = u - 256; qb = 0; seq = CTXL; }
                const int h = hm >> 1, mm = hm & 1;
                const attn128::bf16* Zb = (const attn128::bf16*)Z;
                attn256::attn_o256_body(Zb + (size_t)MT * ZC_AQ + (size_t)(qb * 256) * 1024 + h * 256 + mm * 128, Zb + (size_t)MT * ZC_AK + h * 256 + mm * 128, Zb + (size_t)MT * ZC_AV + h * 256,
                                        ATTO + (size_t)mm * MT * 1024 + (size_t)(qb * 256) * 1024 + h * 256, seq, (char*)lds_raw, wave_s);
                __syncthreads();
            }
            SEAM(pb + L_MIX1);
        }
        if (IN(pb + L_POST)) { PHASE_BEGIN; MKP();
            for (int rep_ = 0; rep_ < DBL_POST; ++rep_) { mlstm_m2(DCT, DNS, CHS, CTS, NSS, MSS, lds, bid, G, tid); } SEAM(pb + L_POST); }
        if (IN(pb + L_M3)) { PHASE_BEGIN; MKP();
            { const int u0 = (l < DEPTH - 1) ? 0 : 8, nsec = (l < DEPTH - 1) ? (264 - G > 0 ? 264 - G : 0) : 0;
              for (int rep_ = 0; rep_ < DBL_M3; ++rep_) for (int u = u0 + bid; u < 264; u += G) mlstm_m3_unit(Z, G16, P.gate_b + (size_t)l * 16, CTS, NSS, MSS, P.mlstm_norm_g + (size_t)l * 1024, YB, u >> 2, u & 3, lds, tid);
              const int ngm = (G >= 66 + nsec + 8) ? 66 : 0;
              for (int rep_ = 0; rep_ < DBL_GMLP; ++rep_) for (int u = G - 1 - bid; u < 66; u += G) gmlp_unit_mfma(Z, P.gmlp_norm_g + (size_t)l * 1024, (const bf16*)(ws + WS_GWSB) + (size_t)l * 8 * 128 * 128, P.gmlp_bs + (size_t)l * 8 * 128, YA, u, lds, tid);
              if (bid >= nsec && bid < G - ngm) phase_post(ATTO, MLH, Z, P.diff_norm_g + (size_t)l * 256, P.mlstm_norm_g + (size_t)l * 1024, ((const float*)(ws + WS_LAM))[l], lambda_init_f(l), YB, YC, bid - nsec, G - ngm - nsec, tid); }
            SEAM(pb + L_M3); }
        if (IN(pb + L_MERGE)) { PHASE_BEGIN; MKP();
            { pg8::Gemm g{YA, WBT, MT, DM, 1024, 1024}; pg8::MergeOrder S; S.lat.init(SEQ, DM, G, bid); S.c = bid; S.G = G; S.nctx = (l < DEPTH - 1) ? 48 : 0; pg8::EpiMergeSeg E{Z, Y, (float*)(ws + WS_MS3)};
              pg8::gemm_phase<pg8::EpiMergeSeg, pg8::MergeOrder, true, true>(lds + RING_OFF, g, S, E, wave_s); }
            SEAM(pb + L_MERGE); }
        if (IN(pb + L_WOUT)) { PHASE_BEGIN; MKP();
            GEMM_RESID_SPLIT2(Y, WOT, modl + 1 * 3 * DM + 2 * DM, 1.f, (const float*)(ws + WS_MS3), Y, (l < DEPTH - 1) ? 256 : 0);
            SEAM(pb + L_WOUT); }
        if (IN(pb + L_N3)) { PHASE_BEGIN; MKP(); phase_norm(XR, XR, XR, XR, P.norm_g + (size_t)(l * 3 + 2) * DM, modl + 2 * 3 * DM, modc + 2 * 3 * DM, H, SLAB, modc + 1 * 3 * DM + 2 * DM, 1.f, lds, bid, G, tid); SEAM(pb + L_N3); }
        if (IN(pb + L_W13B)) { PHASE_BEGIN; MKP();
            { const int skip = (l < DEPTH - 1) ? 0 : CTXL;
              const int GLb = (l < DEPTH - 1) ? GL : G;
              if (bid < GLb) { pg8::Gemm g{H + (size_t)skip * DM, W13T1, MT - skip, 8192, DM, DM}; pg8::StaticOrder S; S.init(MT - skip, 8192, GLb, bid); pg8::EpiSwiglu E{GB + (size_t)skip * FFND, FFND};
                  pg8::gemm_phase<pg8::EpiSwiglu, pg8::StaticOrder, true, true>(lds + RING_OFF, g, S, E, wave_s);
                  convert_idle(P, l + 1, 0, CVD, CVS, (MT / 256 * 32) % GL, GL, lds, bid, tid); }
              if (NC == 0 || bid >= GL) convert_part(P, l + 1, 0, 0, CVD, NC ? bid - GL : bid, NC ? NC : G, lds, tid); }
            SEAM(pb + L_W13B); }
        if (IN(pb + L_W2B)) { PHASE_BEGIN; MKP();
            GEMM_RESID_SPLIT(GB, W2T1, modl + 2 * 3 * DM + 2 * DM, 0.5f, (const float*)nullptr, (bf16*)nullptr, (l < DEPTH - 1) ? 256 : 0, (const float*)XR);
            SEAM(pb + L_W2B); }
#undef GEMM_LAT
#undef GL
#undef NC
#undef GEMM_RESID_SPLIT
#undef GEMM_RESID_SPLIT2
    }
    if (IN(P_FINAL)) { PHASE_BEGIN; MKP(); phase_final(XR, P.final_g, P.out, bid, G, tid); }
#undef IN
#undef SEAM
#undef tid
#undef XR
#undef H
#undef GB
#undef Z
#undef ATTO
#undef MLH
#undef DCT
#undef YA
#undef YB
#undef YC
#undef SLAB
#undef YACC
#undef Y
#undef G16
#undef MOD
#undef CTS
#undef DNS
#undef NSS
#undef CHS
#undef MSS
#undef modl
#undef modc
#undef W13T0
#undef W13T1
#undef W2T0
#undef W2T1
#undef WINT
#undef WBT
#undef WOT
}

extern "C" void kernel_launch(void* const* d_in, const int* in_sizes, int n_in, void* d_out, int out_size, void* d_ws, size_t ws_size, hipStream_t stream) {
    static int grid = 0;
    if (grid == 0) {
        if (n_in != 21 || in_sizes[0] != SEQ * DM || out_size != SEQ * DM || ws_size < WS_END) {
            fprintf(stderr, "kernel_launch: unexpected shapes: n_in %d in0 %d out %d ws %zu (need %zu)\n", n_in, n_in > 0 ? in_sizes[0] : -1, out_size, ws_size, (size_t)WS_END); grid = -1; return; }
        int dev = 0, cus = 0;
        if (hipGetDevice(&dev) != hipSuccess || hipDeviceGetAttribute(&cus, hipDeviceAttributeMultiprocessorCount, dev) != hipSuccess) { grid = -1; return; }
        if (hipFuncSetAttribute((const void*)mk_fwd<T_ALL>, hipFuncAttributeMaxDynamicSharedMemorySize, LDS_BYTES) != hipSuccess) { fprintf(stderr, "kernel_launch: hipFuncSetAttribute failed\n"); grid = -1; return; }
        (void)hipGetLastError();
        grid = cus;
    }
    if (grid < 0) return;
    (void)hipMemsetAsync((char*)d_ws + WS_CTL, 0, CTL_ZERO_BYTES, stream);
    Args a{};
    for (int i = 0; i < 21; ++i) a.in[i] = (const float*)d_in[i];
    a.out = (float*)d_out; a.ws = (unsigned char*)d_ws;
#if MK_ONE_LAUNCH
    a.ph_lo = 0; a.ph_hi = NPH;
    hipLaunchKernelGGL(mk_fwd<T_ALL>, dim3(grid), dim3(NTHR), LDS_BYTES, stream, a);
#else
    for (int p = 0; p < NPH; ++p) { a.ph_lo = p; a.ph_hi = p + 1; hipLaunchKernelGGL(mk_fwd<T_ALL>, dim3(grid), dim3(NTHR), LDS_BYTES, stream, a); }
#endif
    const hipError_t le = hipPeekAtLastError();
    if (le != hipSuccess) fprintf(stderr, "kernel_launch: launch failed: %s\n", hipGetErrorName(le));
}
```

```cpp
#include <hip/hip_runtime.h>
#include <hip/hip_bf16.h>
#include <cstdio>
#include <cstdint>
#include <cmath>
#ifndef MLSTM_CHUNKWISE
#define MLSTM_CHUNKWISE 1
#endif
#ifndef MK_ONE_LAUNCH
#define MK_ONE_LAUNCH 1
#endif
#ifndef DBL_ATTN
#define DBL_ATTN 1
#endif
#ifndef DBL_PRO
#define DBL_PRO 1
#endif
#ifndef DBL_M1
#define DBL_M1 1
#endif
#ifndef DBL_GMLP
#define DBL_GMLP 1
#endif
#ifndef DBL_POST
#define DBL_POST 1
#endif
#ifndef DBL_M3
#define DBL_M3 1
#endif
#ifndef DBL_NORM
#define DBL_NORM 1
#endif
__device__ __forceinline__ int mk_lane_id() { int l_; asm volatile("v_mbcnt_lo_u32_b32 %0, -1, 0\n\tv_mbcnt_hi_u32_b32 %0, -1, %0" : "=v"(l_)); return l_; }
#define MK_TID(wave_s_) (((wave_s_) << 6) | mk_lane_id())
namespace pg8 {
#define PG8_LAS __attribute__((address_space(3)))
typedef unsigned short bf16_t;
typedef short bf16x8 __attribute__((ext_vector_type(8)));
typedef float f32x4 __attribute__((ext_vector_type(4)));
typedef unsigned u32x4 __attribute__((ext_vector_type(4)));
constexpr int BM = 256, BK = 64, HALF = 128, HTB = HALF * BK * 2  , STAGE_BYTES = 8 * HTB, NXCD = 8, WGM = 8;

__host__ __device__ __forceinline__ int lds_byte(int r, int c) { const int st = (r >> 4) * 2 + (c >> 5), rr = r & 15, cc = c & 31, ob = rr * 64 + cc * 2; return st * 1024 + (ob ^ (((ob >> 9) & 1) << 5)); }
__host__ __device__ __forceinline__ void stage_rc(int b, int& R, int& C) { const int st = b / 1024, sb = b % 1024, swz = sb ^ (((sb >> 9) & 1) << 5); R = (st >> 1) * 16 + swz / 64; C = (st & 1) * 32 + (swz % 64) / 2; }
__host__ __device__ __forceinline__ int perm32(int rho) { const int n = rho >> 4, i = rho & 15; return 8 * (i >> 2) + 4 * n + (i & 3); }

struct Unit { int pm, pn, koff, boff, fl;
    __device__ __forceinline__ int seg() const { return fl & 3; } __device__ __forceinline__ bool carry() const { return (fl & 4) != 0; } __device__ __forceinline__ int ntile() const { return fl >> 8; } };
struct Gemm { const bf16_t* A; const bf16_t* Bt; int M, N, K, ld; };

struct StaticOrder {
    int nM, nN, nwg, G, c;
    __host__ __device__ void init(int M, int N, int G_, int c_) { nM = M / BM; nN = N / BM; nwg = nM * nN; G = G_; c = c_; }
    __host__ __device__ bool next(int i, Unit& u) const {
        const long L = (long)i * G + c; if (L >= nwg) return false;
        int wgid = (int)L; { const int q = nwg / NXCD, r = nwg % NXCD, xcd = wgid % NXCD, off = wgid / NXCD; wgid = (xcd < r ? xcd * (q + 1) : r * (q + 1) + (xcd - r) * q) + off; }
        const int nig = WGM * nN, gid = wgid / nig, fm = gid * WGM, gsz = (nM - fm) < WGM ? (nM - fm) : WGM;
        u.pm = fm + ((wgid % nig) % gsz); u.pn = (wgid % nig) / gsz; u.koff = 0; u.boff = 0; u.fl = 0; return true;
    }
    __device__ __forceinline__ void a_ready(const Unit&) const {}
    __device__ __forceinline__ void done(const Unit&) const {}
};

__device__ __forceinline__ unsigned cvt_pk_bf16(float lo, float hi) { unsigned r; asm volatile("v_cvt_pk_bf16_f32 %0, %1, %2" : "=v"(r) : "v"(lo), "v"(hi)); return r; }
typedef float f32x2 __attribute__((ext_vector_type(2)));
__device__ __forceinline__ f32x2 gelu_pk(f32x2 v) {
    const f32x2 av = __builtin_elementwise_abs(v), d = av * 0.2316418882f + 1.0f;
    f32x2 t; t.x = __builtin_amdgcn_rcpf(d.x); t.y = __builtin_amdgcn_rcpf(d.y);
    f32x2 q = t * 0.5307027145f + (-0.7265760135f); q = q * t + 0.7107068705f; q = q * t + (-0.142248368f); q = q * t + 0.127414796f; q = q * t;
    const f32x2 s = (v * v) * (-0.72134752044f);
    f32x2 e; e.x = __builtin_amdgcn_exp2f(s.x); e.y = __builtin_amdgcn_exp2f(s.y);
    const f32x2 m = v * (q * e), r = v - m;
    f32x2 o; o.x = v.x < 0.f ? m.x : r.x; o.y = v.y < 0.f ? m.y : r.y; return o;
}

template <int ACT  > struct EpiBf16 {
    static constexpr bool PERM = true, AFTER_DRAIN = false; static_assert(ACT == 0 || ACT == 1, "EpiBf16: ACT is 0 (none) or 1 (gelu_pk)");
    bf16_t* O; int ldc; const float* bias; int split_cols; size_t split_stride; float scale0;
    __device__ __forceinline__ void operator()(const f32x4 (&acc)[2][2][4][2], const Unit& u, int wr, int wc, int fr, int fq) const {
        const int row0 = u.pm * BM + wr * 64 + fr; int colt = u.pn * BM; bf16_t* base = O;
        float sc = 1.f; if (split_cols) { const int t = colt / split_cols; base += (size_t)t * split_stride; colt -= t * split_cols; if (t == 0) sc = scale0; }
        const int col0 = colt + wc * 32 + 8 * fq, bcol0 = u.pn * BM + wc * 32 + 8 * fq;
        f32x4 bv[2][2];
#pragma unroll
        for (int bj = 0; bj < 2; ++bj)
#pragma unroll
            for (int n = 0; n < 2; ++n) bv[bj][n] = bias ? *(const f32x4*)(bias + bcol0 + bj * HALF + 4 * n) : (f32x4){0.f, 0.f, 0.f, 0.f};
#pragma unroll
        for (int ai = 0; ai < 2; ++ai)
#pragma unroll
            for (int m = 0; m < 4; ++m) { bf16_t* rowp = base + (size_t)(row0 + ai * HALF + m * 16) * ldc + col0;
#pragma unroll
                for (int bj = 0; bj < 2; ++bj) { f32x4 v0 = acc[ai][bj][m][0] + bv[bj][0], v1 = acc[ai][bj][m][1] + bv[bj][1];
                    if (ACT == 1) { f32x2 a = gelu_pk((f32x2){v0[0], v0[1]}), b = gelu_pk((f32x2){v0[2], v0[3]}), c = gelu_pk((f32x2){v1[0], v1[1]}), d = gelu_pk((f32x2){v1[2], v1[3]});
                        v0 = (f32x4){a.x, a.y, b.x, b.y}; v1 = (f32x4){c.x, c.y, d.x, d.y}; }
                    v0 = v0 * sc; v1 = v1 * sc; u32x4 w; w.x = cvt_pk_bf16(v0[0], v0[1]); w.y = cvt_pk_bf16(v0[2], v0[3]); w.z = cvt_pk_bf16(v1[0], v1[1]); w.w = cvt_pk_bf16(v1[2], v1[3]);
                    *(u32x4*)(rowp + bj * HALF) = w; } }
    }
};

struct PanelStats {
    unsigned* xbuf;
    unsigned* cnt;
    unsigned* tmo;
    int ntn; float eps;
    unsigned code;
    __device__ __forceinline__ bool run(const f32x4 (&v)[2][2][4][2], const Unit& u, int wr, int wc, int fr, int fq, PG8_LAS unsigned char* lds, int wid, int lane) const {
        typedef float f32x2v __attribute__((ext_vector_type(2)));
        PG8_LAS f32x2v* P = (PG8_LAS f32x2v*)lds;
        PG8_LAS f32x2v* S = (PG8_LAS f32x2v*)(lds + 8192);
        PG8_LAS unsigned* flag = (PG8_LAS unsigned*)(lds + 8192 + 2048);
#pragma unroll
        for (int ai = 0; ai < 2; ++ai)
#pragma unroll
            for (int m = 0; m < 4; ++m) {
                float s = 0.f;
#pragma unroll
                for (int bj = 0; bj < 2; ++bj)
#pragma unroll
                    for (int n = 0; n < 2; ++n) { const f32x4 x = v[ai][bj][m][n]; s += (x[0] + x[1]) + (x[2] + x[3]); }
                s += __shfl_xor(s, 16); s += __shfl_xor(s, 32);
                const float mw = s * (1.0f / 64.0f); float q = 0.f;
#pragma unroll
                for (int bj = 0; bj < 2; ++bj)
#pragma unroll
                    for (int n = 0; n < 2; ++n) { const f32x4 d = v[ai][bj][m][n] - mw; q += (d[0] * d[0] + d[1] * d[1]) + (d[2] * d[2] + d[3] * d[3]); }
                q += __shfl_xor(q, 16); q += __shfl_xor(q, 32);
                if (fq == 0) P[(ai * HALF + wr * 64 + m * 16 + fr) * 4 + wc] = (f32x2v){mw, q};
            }
        asm volatile("s_waitcnt lgkmcnt(0)" ::: "memory"); __builtin_amdgcn_s_barrier(); asm volatile("" ::: "memory");
#if defined(BROKEN_EXCHANGE_NO_WAIT)
#warning BROKEN CONTROL BUILD: the row-statistics exchange does not wait; results are wrong by design
        if (blockIdx.x >= 64) { const long long t0_ = clock64(); while (clock64() - t0_ < 60000) __builtin_amdgcn_s_sleep(8); }
#endif
        const int row = wid * 32 + (lane & 31);
        if (lane < 32) {
            const f32x2v a = P[row * 4 + 0], b = P[row * 4 + 1], c = P[row * 4 + 2], d = P[row * 4 + 3];
            const float mt = (a.x + b.x + c.x + d.x) * 0.25f;
            const float da = a.x - mt, db = b.x - mt, dc = c.x - mt, dd = d.x - mt;
            const float m2 = (a.y + b.y) + (c.y + d.y) + 64.0f * ((da * da + db * db) + (dc * dc + dd * dd));
            unsigned long long* slot = (unsigned long long*)xbuf + ((size_t)(u.pm * BM + row) * 4 + u.pn);
            __hip_atomic_store(slot, ((unsigned long long)__float_as_uint(m2) << 32) | __float_as_uint(mt), __ATOMIC_RELAXED, __HIP_MEMORY_SCOPE_AGENT);
        }
        asm volatile("s_waitcnt vmcnt(0)" ::: "memory");
        if (lane == 0) __hip_atomic_fetch_add(cnt + 64 * u.pm, 1u, __ATOMIC_RELAXED, __HIP_MEMORY_SCOPE_AGENT);
        if (wid == 0) {
            bool dead = false; const unsigned long long t0 = __builtin_amdgcn_s_memrealtime(); const unsigned want = 8u * (unsigned)ntn;
            for (;;) {
#if defined(BROKEN_EXCHANGE_NO_WAIT)
                break;
#endif
                if ((unsigned)__builtin_amdgcn_readfirstlane(__hip_atomic_load(cnt + 64 * u.pm, __ATOMIC_RELAXED, __HIP_MEMORY_SCOPE_AGENT)) >= want) break;
                if (__builtin_amdgcn_s_memrealtime() - t0 > 2000000ull) {
                    if (lane == 0) { unsigned expect = 0u; __hip_atomic_compare_exchange_strong(tmo + 1, &expect, code | (unsigned)(u.pm & 0xff), __ATOMIC_RELAXED, __ATOMIC_RELAXED, __HIP_MEMORY_SCOPE_AGENT);
                                     __hip_atomic_store(tmo, 1u, __ATOMIC_RELAXED, __HIP_MEMORY_SCOPE_AGENT); }
                    dead = true; break; }
                __builtin_amdgcn_s_sleep(2);
            }
            __builtin_amdgcn_fence(__ATOMIC_ACQUIRE, "agent");
            if (lane == 0) flag[0] = dead ? 1u : 0u;
        }
        asm volatile("s_waitcnt vmcnt(0) lgkmcnt(0)" ::: "memory"); __builtin_amdgcn_s_barrier(); asm volatile("" ::: "memory");
        const bool bad = flag[0] != 0u;
        if (lane < 32) {
            const unsigned long long* slot = (const unsigned long long*)xbuf + (size_t)(u.pm * BM + row) * 4; float mt[4], m2[4]; float ms = 0.f;
#pragma unroll
            for (int t = 0; t < 4; ++t) { if (t < ntn) { const unsigned long long w = __hip_atomic_load(slot + t, __ATOMIC_RELAXED, __HIP_MEMORY_SCOPE_AGENT); mt[t] = __uint_as_float((unsigned)w); m2[t] = __uint_as_float((unsigned)(w >> 32)); } else { mt[t] = 0.f; m2[t] = 0.f; } ms += mt[t]; }
            const float mean = ms / (float)ntn; float q = 0.f;
#pragma unroll
            for (int t = 0; t < 4; ++t) if (t < ntn) { const float dm = mt[t] - mean; q += m2[t] + 256.0f * dm * dm; }
            S[row] = (f32x2v){mean, 1.0f / sqrtf(q / (256.0f * (float)ntn) + eps)};
        }
        asm volatile("s_waitcnt lgkmcnt(0)" ::: "memory"); __builtin_amdgcn_s_barrier(); asm volatile("" ::: "memory");
        return bad;
    }
};
struct EpiLnRes {
    static constexpr bool PERM = false, AFTER_DRAIN = true;
    const float* base; float* out; int ldc; const float* bias; PanelStats st; unsigned poison;
    __device__ __forceinline__ void fused(f32x4 (&acc)[2][2][4][2], const Unit& u, int wr, int wc, int fr, int fq, PG8_LAS unsigned char* lds, int wid, int lane) const {
        typedef float f32x2v __attribute__((ext_vector_type(2)));
        const PG8_LAS f32x2v* S = (const PG8_LAS f32x2v*)(lds + 8192);
        const int col0 = u.pn * BM + wc * 32 + 4 * fq;
#pragma unroll
        for (int bj = 0; bj < 2; ++bj)
#pragma unroll
            for (int n = 0; n < 2; ++n) { const f32x4 bv = bias ? *(const f32x4*)(bias + col0 + bj * HALF + n * 16) : (f32x4){0.f, 0.f, 0.f, 0.f};
#pragma unroll
                for (int ai = 0; ai < 2; ++ai)
#pragma unroll
                    for (int m = 0; m < 4; ++m) acc[ai][bj][m][n] += bv; }
        f32x4 pre[4][2][2];
#pragma unroll
        for (int m = 0; m < 4; ++m) { const size_t off = (size_t)(u.pm * BM + wr * 64 + m * 16 + fr) * ldc + col0;
#pragma unroll
            for (int bj = 0; bj < 2; ++bj)
#pragma unroll
                for (int n = 0; n < 2; ++n) pre[m][bj][n] = *(const f32x4*)(base + off + bj * HALF + n * 16); }
        const bool bad = st.run(acc, u, wr, wc, fr, fq, lds, wid, lane) || poison != 0u;
        const float qnan = __builtin_nanf("");
#pragma unroll
        for (int ai = 0; ai < 2; ++ai)
#pragma unroll
            for (int m = 0; m < 4; ++m) { const int r = ai * HALF + wr * 64 + m * 16 + fr; const f32x2v sr = S[r]; const size_t off = (size_t)(u.pm * BM + r) * ldc + col0;
#pragma unroll
                for (int bj = 0; bj < 2; ++bj)
#pragma unroll
                    for (int n = 0; n < 2; ++n) { const f32x4 bs = ai == 0 ? pre[m][bj][n] : *(const f32x4*)(base + off + bj * HALF + n * 16); f32x4 o = bs + (acc[ai][bj][m][n] - sr.x) * sr.y;
                        if (bad) o = (f32x4){qnan, qnan, qnan, qnan}; *(f32x4*)(out + off + bj * HALF + n * 16) = o; }
                if (m & 1) asm volatile("" ::: "memory"); }
    }
};
struct EpiLnResLn {
    static constexpr bool PERM = false, AFTER_DRAIN = true;
    const float* base; float* out; bf16_t* xn; int ldc; const float* bias; PanelStats st1, st2; unsigned poison;
    __device__ __forceinline__ void fused(f32x4 (&acc)[2][2][4][2], const Unit& u, int wr, int wc, int fr, int fq, PG8_LAS unsigned char* lds, int wid, int lane) const {
        typedef float f32x2v __attribute__((ext_vector_type(2))); typedef unsigned u32x2v __attribute__((ext_vector_type(2)));
        const PG8_LAS f32x2v* S = (const PG8_LAS f32x2v*)(lds + 8192);
        const int col0 = u.pn * BM + wc * 32 + 4 * fq;
#pragma unroll
        for (int bj = 0; bj < 2; ++bj)
#pragma unroll
            for (int n = 0; n < 2; ++n) { const f32x4 bv = bias ? *(const f32x4*)(bias + col0 + bj * HALF + n * 16) : (f32x4){0.f, 0.f, 0.f, 0.f};
#pragma unroll
                for (int ai = 0; ai < 2; ++ai)
#pragma unroll
                    for (int m = 0; m < 4; ++m) acc[ai][bj][m][n] += bv; }
        bool bad = st1.run(acc, u, wr, wc, fr, fq, lds, wid, lane) || poison != 0u;
        const float qnan = __builtin_nanf("");
#pragma unroll
        for (int ai = 0; ai < 2; ++ai)
#pragma unroll
            for (int m = 0; m < 4; ++m) { const int r = ai * HALF + wr * 64 + m * 16 + fr; const f32x2v sr = S[r]; const size_t off = (size_t)(u.pm * BM + r) * ldc + col0;
#pragma unroll
                for (int bj = 0; bj < 2; ++bj)
#pragma unroll
                    for (int n = 0; n < 2; ++n) { const f32x4 bs = *(const f32x4*)(base + off + bj * HALF + n * 16); acc[ai][bj][m][n] = bs + (acc[ai][bj][m][n] - sr.x) * sr.y; }
                asm volatile("" : "+v"(acc[ai][0][m][0]), "+v"(acc[ai][0][m][1]), "+v"(acc[ai][1][m][0]), "+v"(acc[ai][1][m][1]));
                if (m & 1) asm volatile("" ::: "memory"); }
        const bool bad1 = bad;
        bad = st2.run(acc, u, wr, wc, fr, fq, lds, wid, lane) || bad;
#pragma unroll
        for (int ai = 0; ai < 2; ++ai)
#pragma unroll
            for (int m = 0; m < 4; ++m) { const int r = ai * HALF + wr * 64 + m * 16 + fr; const f32x2v sr = S[r]; const size_t off = (size_t)(u.pm * BM + r) * ldc + col0;
#pragma unroll
                for (int bj = 0; bj < 2; ++bj)
#pragma unroll
                    for (int n = 0; n < 2; ++n) { const f32x4 x1 = acc[ai][bj][m][n]; *(f32x4*)(out + off + bj * HALF + n * 16) = bad1 ? (f32x4){qnan, qnan, qnan, qnan} : x1;
                        const f32x4 o = (x1 - sr.x) * sr.y; u32x2v w; w.x = cvt_pk_bf16(o[0], o[1]); w.y = cvt_pk_bf16(o[2], o[3]);
                        if (bad) { w.x = 0x7fc07fc0u; w.y = 0x7fc07fc0u; } *(u32x2v*)(xn + off + bj * HALF + n * 16) = w; }
                asm volatile("" ::: "memory"); }
    }
};

template <class Epi, class Sched, bool ALIGN_EPI = false, bool SP2 = false>
__device__ __forceinline__ void gemm_phase(PG8_LAS unsigned char* lds, const Gemm g, const Sched& S, const Epi& E, int wave_s_) {
    int tid = MK_TID(wave_s_); asm volatile("" : "+v"(tid));
    const int wid = __builtin_amdgcn_readfirstlane(tid >> 6), lane = tid & 63, wr = wid >> 2, wc = wid & 3, fr = lane & 15, fq = lane >> 4;
    const int K = g.K, nt_def = K / BK;
    unsigned voffA[2], voffB[2];
#pragma unroll
    for (int i = 0; i < 2; ++i) { int R, C; stage_rc(tid * 16 + i * 8192, R, C); const int Rb = Epi::PERM ? ((R & ~31) + perm32(R & 31)) : R;
        voffA[i] = (unsigned)(R * g.ld + C) * 2u; voffB[i] = (unsigned)(Rb * g.ld + C) * 2u; }
    const size_t kstep = (size_t)(BK * 2);
    const size_t hstep = (size_t)HALF * g.ld * 2;
    const size_t tstep = 2 * hstep;
    const unsigned ldsw = (unsigned)wid * 1024u;
    const int aoff = lds_byte(wr * 64 + fr, fq * 8), boff = lds_byte(wc * 32 + fr, fq * 8);
#define PG8_SA(b, h) (((b) * 2 + (h)) * HTB)
#define PG8_SB(b, h) ((4 + (b) * 2 + (h)) * HTB)
#define PG8_STAGE(bufoff, gbase, voff) do { _Pragma("unroll") for (int _i = 0; _i < 2; ++_i) \
        __builtin_amdgcn_global_load_lds((const unsigned*)((const char*)(gbase) + (voff)[_i]), (PG8_LAS unsigned*)(lds + (bufoff) + ldsw + _i * 8192), 16, 0, 0); } while (0)
#define PG8_LDA(dst, b, h) do { _Pragma("unroll") for (int m = 0; m < 4; ++m) _Pragma("unroll") for (int k = 0; k < 2; ++k) dst[m][k] = *(const PG8_LAS bf16x8*)(lds + PG8_SA(b, h) + aoff + m * 2048 + k * 1024); } while (0)
#define PG8_LDB(dst, b, h) do { _Pragma("unroll") for (int n = 0; n < 2; ++n) _Pragma("unroll") for (int k = 0; k < 2; ++k) dst[n][k] = *(const PG8_LAS bf16x8*)(lds + PG8_SB(b, h) + boff + n * 2048 + k * 1024); } while (0)
#define PG8_MMA(ai, bj, At, Bt) do { __builtin_amdgcn_s_setprio(1); _Pragma("unroll") for (int m = 0; m < 4; ++m) _Pragma("unroll") for (int n = 0; n < 2; ++n) _Pragma("unroll") for (int k = 0; k < 2; ++k) \
        acc[ai][bj][m][n] = __builtin_amdgcn_mfma_f32_16x16x32_bf16(Bt[n][k], At[m][k], acc[ai][bj][m][n], 0, 0, 0); __builtin_amdgcn_s_setprio(0); } while (0)
#define PG8_WAIT_V(n) asm volatile("s_waitcnt vmcnt(" #n ")" ::: "memory")
#define PG8_WAIT_L(n) asm volatile("s_waitcnt lgkmcnt(" #n ")" ::: "memory")
#define PG8_BAR __builtin_amdgcn_s_barrier()
#define PG8_SCHED __builtin_amdgcn_sched_barrier(0)
    Unit cur, nxt; int ui = 0;
    if (!S.next(0, cur)) return;
    f32x4 acc[2][2][4][2];
#pragma unroll
    for (int a = 0; a < 2; ++a)
#pragma unroll
        for (int b = 0; b < 2; ++b)
#pragma unroll
            for (int m = 0; m < 4; ++m)
#pragma unroll
                for (int n = 0; n < 2; ++n) acc[a][b][m][n] = (f32x4){0.f, 0.f, 0.f, 0.f};
    bf16x8 At[4][2], B0[2][2], B1[2][2];
    const char* cA = (const char*)g.A + (size_t)cur.pm * tstep + (size_t)cur.koff * 2; const char* cB = (const char*)g.Bt + (size_t)cur.pn * tstep + (size_t)cur.boff * 2;
    S.a_ready(cur);
    if constexpr (SP2) {
        PG8_STAGE(PG8_SB(0, 0), cB, voffB); PG8_STAGE(PG8_SB(0, 1), cB + hstep, voffB); PG8_STAGE(PG8_SA(0, 0), cA, voffA); PG8_STAGE(PG8_SA(0, 1), cA + hstep, voffA);
        if (wr == 1) PG8_BAR;
        PG8_WAIT_V(2); PG8_BAR;
        PG8_STAGE(PG8_SB(1, 0), cB + kstep, voffB); PG8_STAGE(PG8_SA(1, 0), cA + kstep, voffA); PG8_STAGE(PG8_SB(1, 1), cB + hstep + kstep, voffB);
        PG8_WAIT_V(6); PG8_BAR;
    } else {
        PG8_STAGE(PG8_SB(0, 0), cB, voffB); PG8_STAGE(PG8_SA(0, 0), cA, voffA); PG8_STAGE(PG8_SB(0, 1), cB + hstep, voffB); PG8_STAGE(PG8_SA(0, 1), cA + hstep, voffA);
        if (wr == 1) PG8_BAR;
        PG8_WAIT_V(4); PG8_BAR;
        PG8_STAGE(PG8_SB(1, 0), cB + kstep, voffB); PG8_STAGE(PG8_SA(1, 0), cA + kstep, voffA); PG8_STAGE(PG8_SB(1, 1), cB + hstep + kstep, voffB);
        PG8_WAIT_V(6); PG8_BAR;
    }
    for (;;) {
        const bool has_next = S.next(ui + 1, nxt);
        const char* nA = has_next ? (const char*)g.A + (size_t)nxt.pm * tstep + (size_t)nxt.koff * 2 : cA; const char* nB = has_next ? (const char*)g.Bt + (size_t)nxt.pn * tstep + (size_t)nxt.boff * 2 : cB;
        const int nt = cur.ntile() ? cur.ntile() : nt_def;
        for (int t = 0; t < nt; t += 2) {
            const bool last = (t == nt - 2);
            const char* a1 = cA + (size_t)(t + 1) * kstep;
            const char* a2 = last ? nA : cA + (size_t)(t + 2) * kstep; const char* b2 = last ? nB : cB + (size_t)(t + 2) * kstep;
            const char* a3 = a2 + kstep; const char* b3 = b2 + kstep;
            if (last && has_next) S.a_ready(nxt);
            if constexpr (SP2) {
            PG8_LDB(B0, 0, 0); PG8_LDB(B1, 0, 1); PG8_SCHED; PG8_LDA(At, 0, 0); PG8_STAGE(PG8_SA(1, 1), a1 + hstep, voffA);
            PG8_WAIT_V(8); PG8_WAIT_L(0); PG8_BAR; PG8_MMA(0, 0, At, B0); PG8_MMA(0, 1, At, B1); PG8_BAR; PG8_SCHED;
            PG8_LDA(At, 0, 1); PG8_STAGE(PG8_SB(0, 0), b2, voffB); PG8_STAGE(PG8_SB(0, 1), b2 + hstep, voffB); PG8_STAGE(PG8_SA(0, 0), a2, voffA);
            PG8_WAIT_V(8); PG8_WAIT_L(0); PG8_BAR; PG8_MMA(1, 0, At, B0); PG8_MMA(1, 1, At, B1); PG8_BAR; PG8_SCHED;
            PG8_LDB(B0, 1, 0); PG8_LDB(B1, 1, 1); PG8_SCHED; PG8_LDA(At, 1, 0); PG8_STAGE(PG8_SA(0, 1), a2 + hstep, voffA);
            PG8_WAIT_V(8); PG8_WAIT_L(0); PG8_BAR; PG8_MMA(0, 0, At, B0); PG8_MMA(0, 1, At, B1); PG8_BAR; PG8_SCHED;
            PG8_LDA(At, 1, 1); PG8_STAGE(PG8_SB(1, 0), b3, voffB); PG8_STAGE(PG8_SB(1, 1), b3 + hstep, voffB); PG8_STAGE(PG8_SA(1, 0), a3, voffA);
            PG8_WAIT_V(8); PG8_WAIT_L(0); PG8_BAR; PG8_MMA(1, 0, At, B0); PG8_MMA(1, 1, At, B1); PG8_BAR; PG8_SCHED;
            } else {
            PG8_LDB(B0, 0, 0); PG8_SCHED; PG8_LDA(At, 0, 0); PG8_STAGE(PG8_SA(1, 1), a1 + hstep, voffA);
            PG8_WAIT_L(8); PG8_BAR; PG8_WAIT_L(0); PG8_MMA(0, 0, At, B0); PG8_BAR; PG8_SCHED;
            PG8_LDB(B1, 0, 1); PG8_STAGE(PG8_SB(0, 0), b2, voffB);
            PG8_BAR; PG8_WAIT_L(0); PG8_MMA(0, 1, At, B1); PG8_BAR;
            PG8_LDA(At, 0, 1); PG8_STAGE(PG8_SA(0, 0), a2, voffA);
            PG8_BAR; PG8_WAIT_L(0); PG8_MMA(1, 0, At, B0); PG8_BAR; PG8_SCHED;
            PG8_STAGE(PG8_SB(0, 1), b2 + hstep, voffB);
            PG8_WAIT_V(6); PG8_BAR; PG8_MMA(1, 1, At, B1); PG8_BAR;
            PG8_LDB(B0, 1, 0); PG8_SCHED; PG8_LDA(At, 1, 0); PG8_STAGE(PG8_SA(0, 1), a2 + hstep, voffA);
            PG8_WAIT_L(8); PG8_BAR; PG8_WAIT_L(0); PG8_MMA(0, 0, At, B0); PG8_BAR; PG8_SCHED;
            PG8_LDB(B1, 1, 1); PG8_STAGE(PG8_SB(1, 0), b3, voffB);
            PG8_BAR; PG8_WAIT_L(0); PG8_MMA(0, 1, At, B1); PG8_BAR;
            PG8_LDA(At, 1, 1); PG8_STAGE(PG8_SA(1, 0), a3, voffA);
            PG8_BAR; PG8_WAIT_L(0); PG8_MMA(1, 0, At, B0); PG8_BAR; PG8_SCHED;
            PG8_STAGE(PG8_SB(1, 1), b3 + hstep, voffB);
            PG8_WAIT_V(6); PG8_BAR; PG8_MMA(1, 1, At, B1); PG8_BAR;
            }
        }
        if constexpr (ALIGN_EPI) { if (wr == 0) PG8_BAR; }
        if constexpr (!Epi::AFTER_DRAIN) { E(acc, cur, wr, wc, fr, fq); S.done(cur); }
        if (!has_next) break;
        if (!nxt.carry()) {
#pragma unroll
        for (int a = 0; a < 2; ++a)
#pragma unroll
            for (int b = 0; b < 2; ++b)
#pragma unroll
                for (int m = 0; m < 4; ++m)
#pragma unroll
                    for (int n = 0; n < 2; ++n) acc[a][b][m][n] = (f32x4){0.f, 0.f, 0.f, 0.f};
        }
        cur = nxt; cA = nA; cB = nB; ++ui;
        if constexpr (ALIGN_EPI) { if (wr == 1) PG8_BAR; }
    }
    PG8_WAIT_V(0);
    if constexpr (!ALIGN_EPI) { if (wr == 0) PG8_BAR; }
    PG8_BAR;
    if constexpr (Epi::AFTER_DRAIN) { E.fused(acc, cur, wr, wc, fr, fq, lds, wid, lane); S.done(cur); }
#undef PG8_SA
#undef PG8_SB
#undef PG8_STAGE
#undef PG8_LDA
#undef PG8_LDB
#undef PG8_MMA
#undef PG8_WAIT_V
#undef PG8_WAIT_L
#undef PG8_BAR
#undef PG8_SCHED
}
}

__device__ __forceinline__ float shfl_xor_f(float v, int o) { return __uint_as_float((unsigned)__builtin_amdgcn_ds_bpermute((mk_lane_id() ^ o) << 2, (int)__float_as_uint(v))); }
namespace attn128 {
using bf16 = __hip_bfloat16;
constexpr int D = 128, NW = 8, QBLK = 32, KVBLK = 64;
constexpr float SCALE = 0.088388347648318440f;
constexpr float THR = 8.f;
constexpr int SDEPTH = 2;
constexpr int LDQ = 1024, LDK = 1024, LDO = 1024;
constexpr size_t SHM_V = KVBLK * D * 2, SHM_K = KVBLK * D * 2, SHM_ATTN = 2 * SHM_V + 2 * SHM_K + NW * 64 * 4;
using bf16x8 = __attribute__((ext_vector_type(8))) short;
using s16x4  = __attribute__((ext_vector_type(4))) short;
using f32x16 = __attribute__((ext_vector_type(16))) float;
using f32x8  = __attribute__((ext_vector_type(8))) float;
using u32x4  = __attribute__((ext_vector_type(4))) unsigned;
#define KSWZ(row, colB) ((row) * 256 + ((colB) ^ (((row) & 7) << 4)))
#define SBAR() __builtin_amdgcn_sched_barrier(0)
__device__ __forceinline__ int crow(int r, int hi) { return (r & 3) + 8 * (r >> 2) + 4 * hi; }
__device__ __forceinline__ unsigned cvtpk(float lo, float hi) {
  unsigned r; asm volatile("v_cvt_pk_bf16_f32 %0, %1, %2" : "=v"(r) : "v"(lo), "v"(hi)); return r;
}
template <typename TIn> struct Stage;
template <> struct Stage<bf16>  { using T = bf16x8;
  __device__ static __forceinline__ T ld8(const bf16* p) { return *reinterpret_cast<const bf16x8*>(p); }
  __device__ static __forceinline__ bf16x8 tobf(T x) { return x; } };
template <> struct Stage<float> { using T = f32x8;
  __device__ static __forceinline__ T ld8(const float* p) { return *reinterpret_cast<const f32x8*>(p); }
  __device__ static __forceinline__ bf16x8 tobf(T x) {
    u32x4 w = {cvtpk(x[0], x[1]), cvtpk(x[2], x[3]), cvtpk(x[4], x[5]), cvtpk(x[6], x[7])}; return *reinterpret_cast<bf16x8*>(&w); } };

__device__ __forceinline__ void partialSM(f32x16& p0, f32x16& p1, float& m_reg, float& mn, float& alpha) {
  constexpr float C = SCALE * 1.4426950408889634f;
  float pmax = p0[0]; for (int r = 1; r < 16; ++r) pmax = fmaxf(pmax, p0[r]); for (int r = 0; r < 16; ++r) pmax = fmaxf(pmax, p1[r]);
  { auto rr = __builtin_amdgcn_permlane32_swap(__float_as_uint(pmax), __float_as_uint(pmax), false, false);
    pmax = fmaxf(__uint_as_float(rr[0]), __uint_as_float(rr[1])); }
  if (__builtin_expect(__all(pmax - m_reg <= THR / SCALE), 1)) { mn = m_reg; alpha = 1.f; }
  else { mn = fmaxf(m_reg, pmax); alpha = __builtin_amdgcn_exp2f((m_reg - mn) * C); m_reg = mn; }
  float mnC = -mn * C;
  for (int r = 0; r < 16; ++r) p0[r] = fmaf(p0[r], C, mnC); for (int r = 0; r < 16; ++r) p1[r] = fmaf(p1[r], C, mnC);
  for (int r = 0; r < 16; ++r) p0[r] = __builtin_amdgcn_exp2f(p0[r]);
}
__device__ __forceinline__ void finishSM(f32x16& p0, f32x16& p1, float alpha, float& l_reg, bf16x8& pa0, bf16x8& pa1, bf16x8& pa2, bf16x8& pa3) {
  for (int r = 0; r < 16; ++r) p1[r] = __builtin_amdgcn_exp2f(p1[r]);
  float ps = 0; for (int r = 0; r < 16; ++r) ps += p0[r]; for (int r = 0; r < 16; ++r) ps += p1[r];
  { auto rr = __builtin_amdgcn_permlane32_swap(__float_as_uint(ps), __float_as_uint(ps), false, false);
    ps = __uint_as_float(rr[0]) + __uint_as_float(rr[1]); }
  l_reg = l_reg * alpha + ps;
#define PK4(P, BASE, OUT) do { unsigned a0 = cvtpk(P[BASE + 0], P[BASE + 1]), a1 = cvtpk(P[BASE + 2], P[BASE + 3]);   \
    unsigned b0 = cvtpk(P[BASE + 4], P[BASE + 5]), b1 = cvtpk(P[BASE + 6], P[BASE + 7]);                              \
    auto r0 = __builtin_amdgcn_permlane32_swap(a0, b0, false, false); auto r1 = __builtin_amdgcn_permlane32_swap(a1, b1, false, false); \
    u32x4 w = {r0[0], r1[0], r0[1], r1[1]}; OUT = *reinterpret_cast<bf16x8*>(&w); } while (0)
  PK4(p0, 0, pa0); PK4(p0, 8, pa1); PK4(p1, 0, pa2); PK4(p1, 8, pa3);
#undef PK4
}
__device__ __forceinline__ void qkt(f32x16& p0, f32x16& p1, const bf16* Ks, const bf16x8* qr, int r32, int hi) {
  p0 = f32x16{}; p1 = f32x16{};
  for (int d0 = 0; d0 < 8; ++d0) { int cb = (d0 * 16 + hi * 8) * 2;
    bf16x8 b0 = *reinterpret_cast<const bf16x8*>((const char*)Ks + KSWZ(r32, cb));
    bf16x8 b1 = *reinterpret_cast<const bf16x8*>((const char*)Ks + KSWZ(32 + r32, cb));
    p0 = __builtin_amdgcn_mfma_f32_32x32x16_bf16(b0, qr[d0], p0, 0, 0, 0);
    p1 = __builtin_amdgcn_mfma_f32_32x32x16_bf16(b1, qr[d0], p1, 0, 0, 0); }
}
__device__ __forceinline__ int v_st(int k, int c) { const int kk = (k & ~0xC) | ((k & 4) << 1) | ((k & 8) >> 1); return ((kk >> 3) * 4 + (c >> 5)) * 512 + ((kk & 7) * 32 + (c & 31)) * 2; }
__device__ __forceinline__ int v_rd_base(int lane) { return ((lane & 3) << 3) | (((lane >> 2) & 3) << 6) | (((lane >> 4) & 1) << 5) | (((lane >> 5) & 1) << 8); }
constexpr int v_rd_off(int d0, int ks, int half) { return d0 * 512 + ks * 4096 + half * 2048; }
template <int OFF> __device__ __forceinline__ s16x4 tr_read(int vb) {
  s16x4 r; asm volatile("ds_read_b64_tr_b16 %0, %1 offset:%2" : "=&v"(r) : "v"(vb), "i"(OFF) : "memory"); return r;
}
template <int D0> __device__ __forceinline__ void pv_one(f32x16& od, int vb, bf16x8 pa0, bf16x8 pa1, bf16x8 pa2, bf16x8 pa3) {
  const s16x4 l0 = tr_read<v_rd_off(D0, 0, 0)>(vb), h0 = tr_read<v_rd_off(D0, 0, 1)>(vb), l1 = tr_read<v_rd_off(D0, 1, 0)>(vb), h1 = tr_read<v_rd_off(D0, 1, 1)>(vb);
  const s16x4 l2 = tr_read<v_rd_off(D0, 2, 0)>(vb), h2 = tr_read<v_rd_off(D0, 2, 1)>(vb), l3 = tr_read<v_rd_off(D0, 3, 0)>(vb), h3 = tr_read<v_rd_off(D0, 3, 1)>(vb);
  asm volatile("s_waitcnt lgkmcnt(0)" ::: "memory"); SBAR();
#define PK(L, H) (bf16x8){L[0], L[1], L[2], L[3], H[0], H[1], H[2], H[3]}
  od = __builtin_amdgcn_mfma_f32_32x32x16_bf16(pa0, PK(l0, h0), od, 0, 0, 0);
  od = __builtin_amdgcn_mfma_f32_32x32x16_bf16(pa1, PK(l1, h1), od, 0, 0, 0);
  od = __builtin_amdgcn_mfma_f32_32x32x16_bf16(pa2, PK(l2, h2), od, 0, 0, 0);
  od = __builtin_amdgcn_mfma_f32_32x32x16_bf16(pa3, PK(l3, h3), od, 0, 0, 0);
#undef PK
}
__device__ __forceinline__ void pv_d0(f32x16* o, int vb, bf16x8 pa0, bf16x8 pa1, bf16x8 pa2, bf16x8 pa3) {
  pv_one<0>(o[0], vb, pa0, pa1, pa2, pa3); pv_one<1>(o[1], vb, pa0, pa1, pa2, pa3); pv_one<2>(o[2], vb, pa0, pa1, pa2, pa3); pv_one<3>(o[3], vb, pa0, pa1, pa2, pa3);
}

template <typename TQ>
__device__ __forceinline__ void attn_dense_body(const TQ* __restrict__ Qb, const bf16* __restrict__ Kh, const bf16* __restrict__ Vh,
                                                float* __restrict__ Ob, int seq, char* lds, int wave_s_) {
  using St = Stage<bf16>; using SQ = Stage<TQ>;
  int tid = MK_TID(wave_s_); asm volatile("" : "+v"(tid));
  const int wid = tid >> 6, lane = tid & 63, r32 = lane & 31, hi = lane >> 5;
  bf16* V_lds = (bf16*)lds; bf16* K_lds = (bf16*)(lds + 2 * SHM_V);
  float* ws = (float*)(lds + 2 * SHM_V + 2 * SHM_K) + wid * 64; float* li_l = ws; float* al_l = ws + 32;
  float m_reg = -1e30f, l_reg = 0; f32x16 o[4] = {}; bf16x8 qr[8];
  const TQ* Qw = Qb + (long)(wid * QBLK + r32) * LDQ + hi * 8;
#pragma unroll
  for (int d0 = 0; d0 < 8; ++d0) qr[d0] = SQ::tobf(SQ::ld8(Qw + d0 * 16));
  const int sr = tid >> 4, sc = (tid & 15) * 8, vst0 = v_st(sr, sc), vst1 = v_st(32 + sr, sc);
  const int vb0 = (int)(uintptr_t)V_lds + v_rd_base(lane);
  struct { typename St::T vs0, vs1, ks0, ks1; } sr_[SDEPTH];
#define SLOAD(i, k0) do { sr_[i].vs0 = St::ld8(&Vh[(long)((k0) + sr) * LDK + sc]); sr_[i].vs1 = St::ld8(&Vh[(long)((k0) + 32 + sr) * LDK + sc]); \
    sr_[i].ks0 = St::ld8(&Kh[(long)((k0) + sr) * LDK + sc]); sr_[i].ks1 = St::ld8(&Kh[(long)((k0) + 32 + sr) * LDK + sc]); } while (0)
#define SWRITE(b, i) do { *(bf16x8*)((char*)V_lds + (b) * SHM_V + vst0) = St::tobf(sr_[i].vs0);          \
    *(bf16x8*)((char*)V_lds + (b) * SHM_V + vst1) = St::tobf(sr_[i].vs1); int kc = sc * 2;               \
    *(bf16x8*)((char*)K_lds + (b) * SHM_K + KSWZ(sr, kc)) = St::tobf(sr_[i].ks0);                       \
    *(bf16x8*)((char*)K_lds + (b) * SHM_K + KSWZ(32 + sr, kc)) = St::tobf(sr_[i].ks1); } while (0)
#define SWAIT() do { if constexpr (SDEPTH == 2) asm volatile("s_waitcnt vmcnt(4)" ::: "memory"); else asm volatile("s_waitcnt vmcnt(0)" ::: "memory"); } while (0)
#define RESC(a) do { if (__any((a) < 1.f)) { if (hi == 0) al_l[r32] = (a); asm volatile("s_waitcnt lgkmcnt(0)" ::: "memory"); \
    for (int d = 0; d < 4; ++d) for (int r = 0; r < 16; ++r) o[d][r] *= al_l[crow(r, hi)]; } } while (0)
  f32x16 pA0, pA1, pB0, pB1; float mnA, mnB, alA, alB; bf16x8 pa0, pa1, pa2, pa3; const int NT = seq / KVBLK;
  constexpr int SE = 0, SO = SDEPTH - 1;
  SLOAD(SE, 0); asm volatile("s_waitcnt vmcnt(0)" ::: "memory"); SWRITE(0, SE); __syncthreads();
  qkt(pA0, pA1, K_lds, qr, r32, hi); partialSM(pA0, pA1, m_reg, mnA, alA);
  SLOAD(SO, KVBLK); if constexpr (SDEPTH == 2) { if (2 < NT) SLOAD(SE, 2 * KVBLK); }
  SWAIT(); SWRITE(1, SO); __syncthreads();
  for (int j = 1; j + 1 < NT; j += 2) {
    SBAR(); qkt(pB0, pB1, (bf16*)((char*)K_lds + SHM_K), qr, r32, hi);
    finishSM(pA0, pA1, alA, l_reg, pa0, pa1, pa2, pa3); SBAR();
    SLOAD(SO, (j + SDEPTH) * KVBLK); SBAR();
    pv_d0(o, vb0, pa0, pa1, pa2, pa3); partialSM(pB0, pB1, m_reg, mnB, alB);
    __syncthreads(); SWAIT(); SWRITE(0, SE);
    RESC(alB); __syncthreads();
    SBAR(); qkt(pA0, pA1, K_lds, qr, r32, hi);
    finishSM(pB0, pB1, alB, l_reg, pa0, pa1, pa2, pa3); SBAR();
    if (SDEPTH == 1 || j + 3 < NT) SLOAD(SE, (j + 1 + SDEPTH) * KVBLK); SBAR();
    pv_d0(o, vb0 + (int)SHM_V, pa0, pa1, pa2, pa3); partialSM(pA0, pA1, m_reg, mnA, alA);
    __syncthreads(); SWAIT(); SWRITE(1, SO);
    RESC(alA); __syncthreads();
  }
  SBAR(); qkt(pB0, pB1, (bf16*)((char*)K_lds + SHM_K), qr, r32, hi);
  finishSM(pA0, pA1, alA, l_reg, pa0, pa1, pa2, pa3); SBAR();
  pv_d0(o, vb0, pa0, pa1, pa2, pa3); partialSM(pB0, pB1, m_reg, mnB, alB);
  __syncthreads(); RESC(alB);
  finishSM(pB0, pB1, alB, l_reg, pa0, pa1, pa2, pa3); SBAR();
  pv_d0(o, vb0 + (int)SHM_V, pa0, pa1, pa2, pa3);
  if (hi == 0) li_l[r32] = l_reg; asm volatile("s_waitcnt lgkmcnt(0)" ::: "memory");
  float rli[16];
#pragma unroll
  for (int r = 0; r < 16; ++r) rli[r] = __builtin_amdgcn_rcpf(li_l[crow(r, hi)]);
  float* Ow = Ob + (long)(wid * QBLK) * LDO;
#pragma unroll
  for (int r = 0; r < 16; ++r) { int orow = crow(r, hi);
    for (int d0 = 0; d0 < 4; ++d0) Ow[(long)orow * LDO + d0 * 32 + r32] = o[d0][r] * rli[r]; }
#undef SLOAD
#undef SWRITE
#undef SWAIT
#undef RESC
}

}

namespace attn256 {
using namespace attn128;
constexpr size_t SHM_V2 = KVBLK * 256 * 2, SHM_K2 = KVBLK * D * 2;
constexpr int LDV = 1024;
__device__ __forceinline__ int v_st2(int k, int c) { const int kk = (k & ~0xC) | ((k & 4) << 1) | ((k & 8) >> 1); return ((kk >> 3) * 8 + (c >> 5)) * 512 + ((kk & 7) * 32 + (c & 31)) * 2; }
constexpr int v_rd_off2(int d0, int ks, int half) { return d0 * 512 + ks * 8192 + half * 4096; }
template <int D0> __device__ __forceinline__ void pv_one2(f32x16& od, int vb, bf16x8 pa0, bf16x8 pa1, bf16x8 pa2, bf16x8 pa3) {
  const s16x4 l0 = tr_read<v_rd_off2(D0, 0, 0)>(vb), h0 = tr_read<v_rd_off2(D0, 0, 1)>(vb), l1 = tr_read<v_rd_off2(D0, 1, 0)>(vb), h1 = tr_read<v_rd_off2(D0, 1, 1)>(vb);
  const s16x4 l2 = tr_read<v_rd_off2(D0, 2, 0)>(vb), h2 = tr_read<v_rd_off2(D0, 2, 1)>(vb), l3 = tr_read<v_rd_off2(D0, 3, 0)>(vb), h3 = tr_read<v_rd_off2(D0, 3, 1)>(vb);
  asm volatile("s_waitcnt lgkmcnt(0)" ::: "memory"); SBAR();
#define PK(L, H) (bf16x8){L[0], L[1], L[2], L[3], H[0], H[1], H[2], H[3]}
  od = __builtin_amdgcn_mfma_f32_32x32x16_bf16(pa0, PK(l0, h0), od, 0, 0, 0);
  od = __builtin_amdgcn_mfma_f32_32x32x16_bf16(pa1, PK(l1, h1), od, 0, 0, 0);
  od = __builtin_amdgcn_mfma_f32_32x32x16_bf16(pa2, PK(l2, h2), od, 0, 0, 0);
  od = __builtin_amdgcn_mfma_f32_32x32x16_bf16(pa3, PK(l3, h3), od, 0, 0, 0);
#undef PK
}
__device__ __forceinline__ void attn_o256_body(const bf16* __restrict__ Qb, const bf16* __restrict__ Kh, const bf16* __restrict__ Vh, float* __restrict__ Ob, int seq, char* lds, int wave_s_) {
  using St = Stage<bf16>;
  int tid = MK_TID(wave_s_); asm volatile("" : "+v"(tid));
  const int wid = tid >> 6, lane = tid & 63, r32 = lane & 31, hi = lane >> 5;
  bf16* V_lds = (bf16*)lds; bf16* K_lds = (bf16*)(lds + 2 * SHM_V2);
  float* ws = (float*)(lds + 2 * SHM_V2 + 2 * SHM_K2) + wid * 64; float* li_l = ws; float* al_l = ws + 32;
  float m_reg = -1e30f, l_reg = 0; f32x16 o[8] = {}; bf16x8 qr[8];
  const bf16* Qw = Qb + (long)(wid * QBLK + r32) * LDQ + hi * 8;
#pragma unroll
  for (int d0 = 0; d0 < 8; ++d0) qr[d0] = St::ld8(Qw + d0 * 16);
  const int vb0 = (int)(uintptr_t)V_lds + v_rd_base(lane);
  bf16x8 sv00, sv01, sv10, sv11, sk0, sk1;
#define SLOAD2(k0) do { const int t_ = MK_TID(wave_s_), sr = t_ >> 4, sc = (t_ & 15) * 8; const bf16* vp = Vh + (long)((k0) + sr) * LDV + sc; const bf16* kp = Kh + (long)((k0) + sr) * LDK + sc; \
    sv00 = St::ld8(vp); sv01 = St::ld8(vp + 128); sv10 = St::ld8(vp + 32 * LDV); sv11 = St::ld8(vp + 32 * LDV + 128); sk0 = St::ld8(kp); sk1 = St::ld8(kp + 32 * LDK); } while (0)
#define SWRITE2(b) do { const int t_ = MK_TID(wave_s_), sr = t_ >> 4, sc = (t_ & 15) * 8; char* vbuf = (char*)V_lds + (b) * SHM_V2 + v_st2(sr, sc); \
    *(bf16x8*)(vbuf) = sv00; *(bf16x8*)(vbuf + 2048) = sv01; *(bf16x8*)(vbuf + 16384) = sv10; *(bf16x8*)(vbuf + 18432) = sv11; \
    char* kbuf = (char*)K_lds + (b) * SHM_K2 + KSWZ(sr, sc * 2); *(bf16x8*)(kbuf) = sk0; *(bf16x8*)(kbuf + 8192) = sk1; } while (0)
  const int NT = seq / KVBLK;
  SLOAD2(0); asm volatile("s_waitcnt vmcnt(0)" ::: "memory"); SWRITE2(0); __syncthreads();
  for (int j = 0; j < NT; ++j) {
    const int b = j & 1;
    f32x16 p0, p1; float mn, al; bf16x8 pa0, pa1, pa2, pa3;
    SBAR(); qkt(p0, p1, (bf16*)((char*)K_lds + b * SHM_K2), qr, r32, hi);
    partialSM(p0, p1, m_reg, mn, al);
    finishSM(p0, p1, al, l_reg, pa0, pa1, pa2, pa3); SBAR();
    if (__any(al < 1.f)) { if (hi == 0) al_l[r32] = al; asm volatile("s_waitcnt lgkmcnt(0)" ::: "memory");
#pragma unroll
      for (int d = 0; d < 8; ++d)
#pragma unroll
        for (int r = 0; r < 16; ++r) o[d][r] *= al_l[crow(r, hi)]; }
    if (j + 1 < NT) SLOAD2((j + 1) * KVBLK);
    SBAR();
    { const int vb = vb0 + b * (int)SHM_V2;
      pv_one2<0>(o[0], vb, pa0, pa1, pa2, pa3); pv_one2<1>(o[1], vb, pa0, pa1, pa2, pa3); pv_one2<2>(o[2], vb, pa0, pa1, pa2, pa3); pv_one2<3>(o[3], vb, pa0, pa1, pa2, pa3);
      pv_one2<4>(o[4], vb, pa0, pa1, pa2, pa3); pv_one2<5>(o[5], vb, pa0, pa1, pa2, pa3); pv_one2<6>(o[6], vb, pa0, pa1, pa2, pa3); pv_one2<7>(o[7], vb, pa0, pa1, pa2, pa3); }
    if (j + 1 < NT) { asm volatile("s_waitcnt vmcnt(0)" ::: "memory"); SWRITE2(b ^ 1); }
    __syncthreads();
  }
  if (hi == 0) li_l[r32] = l_reg; asm volatile("s_waitcnt lgkmcnt(0)" ::: "memory");
  float rli[16];
#pragma unroll
  for (int r = 0; r < 16; ++r) rli[r] = __builtin_amdgcn_rcpf(li_l[crow(r, hi)]);
  float* Ow = Ob + (long)(wid * QBLK) * LDO;
#pragma unroll
  for (int r = 0; r < 16; ++r) { const int orow = crow(r, hi);
#pragma unroll
    for (int d0 = 0; d0 < 8; ++d0) Ow[(long)orow * LDO + d0 * 32 + r32] = o[d0][r] * rli[r]; }
#undef SLOAD2
#undef SWRITE2
}
}

#define GAS __attribute__((address_space(1)))
#define LAS __attribute__((address_space(3)))
typedef unsigned short bf16;
typedef unsigned v4u __attribute__((ext_vector_type(4)));
typedef float f32x4 __attribute__((ext_vector_type(4)));
typedef short bf16x8 __attribute__((ext_vector_type(8)));
typedef GAS unsigned gu32;
typedef GAS unsigned long long gu64;
#define RLX_AGENT __ATOMIC_RELAXED, __HIP_MEMORY_SCOPE_AGENT
#define LDS_WAIT() asm volatile("s_waitcnt lgkmcnt(0)" ::: "memory")
#define VM_WAIT() asm volatile("s_waitcnt vmcnt(0)" ::: "memory")
__device__ __forceinline__ unsigned long long rt() { return __builtin_amdgcn_s_memrealtime(); }
__device__ __forceinline__ unsigned f2bf(float f) { unsigned u = __builtin_bit_cast(unsigned, f); return (u + 0x7fffu + ((u >> 16) & 1u)) >> 16; }
__device__ __forceinline__ unsigned pk2(float lo, float hi) { return f2bf(lo) | (f2bf(hi) << 16); }

#define XB_TMO      128
#define XB_XCNT(j)  (256  + 64 * (j))
#define XB_XSUB(j)  (1280 + 64 * (j))
#define XB_XGEN(j)  (2304 + 64 * (j))
#define XB_TOP      3328
#define XB_TOPGEN   3392
#define XCD_BAR_WORDS 3456
#define XB_SPIN_CAP (1u << 22)

__device__ __forceinline__ unsigned xb_ld(unsigned* p)              { return __hip_atomic_load(p, __ATOMIC_RELAXED, __HIP_MEMORY_SCOPE_AGENT); }
__device__ __forceinline__ unsigned xb_add(unsigned* p, unsigned v) { return __hip_atomic_fetch_add(p, v, __ATOMIC_RELAXED, __HIP_MEMORY_SCOPE_AGENT); }
__device__ __forceinline__ unsigned xb_xcc_id() { return (unsigned)__builtin_amdgcn_s_getreg((3 << 11) | 20) & 0xFu; }
#define XB_SPIN(cond, bar) do { unsigned _sp = 0; while (cond) { __builtin_amdgcn_s_sleep(1); \
    if ((++_sp & 255u) == 0u) { if (xb_ld(&(bar)[XB_TMO])) break; if (_sp > XB_SPIN_CAP) { atomicAdd(&(bar)[XB_TMO], 1u); break; } } } } while (0)

struct XcdBarrier {
    unsigned* bar; unsigned x;
    volatile LAS unsigned* st;
};

__device__ __forceinline__ XcdBarrier xcd_barrier_post(unsigned* bar, volatile LAS unsigned* st, int tid_) {
    XcdBarrier b; b.bar = bar; b.x = xb_xcc_id(); b.st = st;
    if (tid_ == 0) (void)xb_add(&bar[XB_XCNT(b.x)], 1u);
    return b;
}
__device__ __forceinline__ void xcd_barrier_complete(unsigned* bar, unsigned x, unsigned& nloc, unsigned& nx) {
    const unsigned G = gridDim.x * gridDim.y * gridDim.z;
    unsigned sum, cnt, mine, sp = 0u;
    for (;;) {
        sum = 0u; cnt = 0u; mine = 0u;
#pragma unroll
        for (unsigned j = 0; j < 16; ++j) { const unsigned c = xb_ld(&bar[XB_XCNT(j)]); sum += c; cnt += (c > 0u) ? 1u : 0u; mine = (j == x) ? c : mine; }
        if (sum == G) break;
        __builtin_amdgcn_s_sleep(1);
        if ((++sp & 255u) == 0u) { if (xb_ld(&bar[XB_TMO])) break; if (sp > XB_SPIN_CAP) { atomicAdd(&bar[XB_TMO], 1u); break; } }
    }
    nloc = mine > 0u ? mine : 1u; nx = cnt > 0u ? cnt : 1u;
}

__device__ __forceinline__ void xcd_barrier(const XcdBarrier& b, int tid_) {
    asm volatile("s_waitcnt vmcnt(0)" ::: "memory");
    __syncthreads();
    if (tid_ == 0) {
        unsigned* bar = b.bar;
        __builtin_amdgcn_s_waitcnt(0);
        unsigned nloc = b.st[0], nx = b.st[1];
        if (nloc == 0u) { xcd_barrier_complete(bar, b.x, nloc, nx); b.st[0] = nloc; b.st[1] = nx; }
        const unsigned old = xb_add(&bar[XB_XSUB(b.x)], 1u);
        const unsigned gen = old / nloc;
        if (old + 1u == (gen + 1u) * nloc) {
            __builtin_amdgcn_fence(__ATOMIC_RELEASE, "agent");
            asm volatile("s_waitcnt vmcnt(0)" ::: "memory");
            const unsigned og = xb_add(&bar[XB_TOP], 1u);
            const unsigned tg = og / nx;
            if (og + 1u == (tg + 1u) * nx) xb_add(&bar[XB_TOPGEN], 1u);
            else XB_SPIN(xb_ld(&bar[XB_TOPGEN]) == tg, bar);
            __builtin_amdgcn_fence(__ATOMIC_ACQUIRE, "agent");
            xb_add(&bar[XB_XGEN(b.x)], 1u);
            asm volatile("s_waitcnt vmcnt(0)" ::: "memory");
        } else {
            XB_SPIN(xb_ld(&bar[XB_XGEN(b.x)]) == gen, bar);
            __builtin_amdgcn_fence(__ATOMIC_ACQUIRE, "agent");
            asm volatile("s_waitcnt vmcnt(0)" ::: "memory");
        }
    }
    __syncthreads();
}

constexpr int DM = 4096, SEQ = 8192, CTXL = 256, MT = SEQ + CTXL, DEPTH = 4, FFND = 4096;
constexpr int NZ = 20480, INC = 20496, ADAR = 256, NMOD = 9 * DM;
constexpr int ZC_UV = 0, ZC_MQ = 2048, ZC_MK = 2560, ZC_MV = 3072, ZC_MO = 4096, ZC_AQ = 5120, ZC_AK = 6144, ZC_AV = 7168, ZC_MG = 8192;
constexpr float EPS = 1e-6f;
constexpr int NWAVES = 8, NTHR = 512;

constexpr size_t MiB = 1ull << 20;
constexpr size_t WS_CTL = 0, CTL_ZERO_BYTES = 1 * MiB;
constexpr size_t WS_MODTP = 1 * MiB;
constexpr size_t WS_MOD = WS_MODTP + 512 * 1024;
constexpr size_t WS_LAM = WS_MOD + (size_t)DEPTH * 2 * NMOD * 4;
constexpr size_t WS_WG16 = WS_LAM + 256;
constexpr size_t WS_ROPE = WS_WG16 + (size_t)DEPTH * 16 * DM * 4;
constexpr size_t WS_G16 = WS_ROPE + (size_t)2 * SEQ * 64 * 4;
constexpr size_t WS_XR = 9 * MiB;
constexpr size_t SZ_ROWS_F32 = (size_t)MT * DM * 4, SZ_ROWS_BF = (size_t)MT * DM * 2;
constexpr size_t WS_H = WS_XR + SZ_ROWS_F32;
constexpr size_t WS_GB = WS_H + SZ_ROWS_BF;
constexpr size_t WS_Z = WS_GB + SZ_ROWS_BF;
constexpr size_t WS_ATTO = WS_Z + (size_t)MT * NZ * 2;
constexpr size_t WS_MLH = WS_ATTO + (size_t)2 * MT * 1024 * 4;
constexpr size_t WS_YA = WS_MLH + (size_t)2 * MT * 1024 * 4;
constexpr size_t WS_YB = WS_YA + (size_t)MT * 1024 * 2;
constexpr size_t WS_YC = WS_YB + (size_t)MT * 1024 * 2;
constexpr size_t WS_YACC = WS_YC + (size_t)MT * 1024 * 2;
constexpr size_t WS_Y = WS_YACC + SZ_ROWS_F32;
constexpr size_t WS_W13T = WS_Y + SZ_ROWS_BF;
constexpr size_t WS_W2T = WS_W13T + (size_t)DEPTH * 2 * 8192 * 4096 * 2;
constexpr size_t WS_WINT = WS_W2T + (size_t)DEPTH * 2 * 4096 * 4096 * 2;
constexpr size_t WS_WBT = WS_WINT + (size_t)DEPTH * NZ * 4096 * 2;
constexpr size_t WS_WOT = WS_WBT + (size_t)DEPTH * 3 * 4096 * 1024 * 2;
constexpr size_t WS_CT = WS_WOT + (size_t)DEPTH * 4096 * 4096 * 2;
constexpr size_t WS_MSM = WS_CT + (size_t)8 * 66 * 32768 * 2;
constexpr size_t WS_SLAB = WS_MSM + 1 * MiB;
constexpr size_t WS_GWSB = WS_SLAB + (size_t)16 * 256 * DM * 4;
constexpr size_t WS_MS3 = WS_GWSB + (size_t)DEPTH * 8 * 128 * 128 * 2;
constexpr size_t WS_END = WS_MS3 + (size_t)3 * 256 * DM * 4;
static_assert(WS_G16 + (size_t)MT * 16 * 4 <= WS_XR, "small buffers fit below XR");
static_assert(WS_XR % 256 == 0 && WS_H % 256 == 0 && WS_Z % 256 == 0 && WS_W13T % 256 == 0, "alignment");

constexpr int CW_BAR = 4096;

constexpr int RING_OFF = 0, RING_BYTES = 131072;
constexpr int LDSCTL_OFF = 143360, MISC_OFF = LDSCTL_OFF + 320;
constexpr int LDS_BYTES = 147456;

constexpr int P_PRO0 = 0, P_PRO1 = 1, P_LAYER0 = 2;
constexpr int L_N1 = 0, L_W13A = 1, L_W2A = 2, L_N2 = 3, L_WIN = 4, L_MIX1 = 5, L_POST = 6, L_M3 = 7, L_MERGE = 8, L_WOUT = 9, L_N3 = 10, L_W13B = 11, L_W2B = 12, NPL = 13;
constexpr int P_FINAL = P_LAYER0 + DEPTH * NPL, NPH = P_FINAL + 1;

__device__ __forceinline__ float wave_sum(float v) {
#pragma unroll
    for (int o = 1; o < 64; o <<= 1) v += shfl_xor_f(v, o);
    return v;
}
__device__ __forceinline__ float bf2f(unsigned short b) { return __uint_as_float((unsigned)b << 16); }
__device__ __forceinline__ float bflo(unsigned w) { return __uint_as_float(w << 16); }
__device__ __forceinline__ float bfhi(unsigned w) { return __uint_as_float(w & 0xffff0000u); }
__device__ __forceinline__ float sigmoid_f(float x) { return 1.f / (1.f + __expf(-x)); }
__device__ __forceinline__ float silu_f(float x) { return x / (1.f + __expf(-x)); }
__device__ __forceinline__ float gelu_tanh_f(float x) { const float u = 0.7978845608028654f * (x + 0.044715f * x * x * x); return x / (1.f + __expf(-2.f * u)); }
__device__ __forceinline__ float lambda_init_f(int l) { return 0.8f - 0.6f * __expf(-0.3f * (float)l); }

namespace pg8 {
struct CtxSplitOrder {
    int c, G, n;
    const float* MS3; bf16_t* Yc; int wave_s_;
    __device__ __forceinline__ bool next(int i, Unit& u) const { const int L = i * G + c; if (L >= n) return false; u.pm = 0; u.pn = L >> 4; u.koff = (L & 15) * 256; u.boff = u.koff; u.fl = 0; return true; }
    __device__ __forceinline__ void a_ready(const Unit& u) const {
        if (MS3) {
            int t_ = MK_TID(wave_s_); asm volatile("" : "+v"(t_));
            const int r = t_ >> 1, c0 = u.koff + (t_ & 1) * 128;
            const float* p0 = MS3 + (size_t)r * DM + c0; bf16_t* yo = Yc + (size_t)r * DM + c0;
#pragma unroll 1
            for (int ib = 0; ib < 16; ib += 4) { f32x4 q[4][3][2];
#pragma unroll
                for (int i = 0; i < 4; ++i)
#pragma unroll
                    for (int sgm = 0; sgm < 3; ++sgm) { q[i][sgm][0] = *(const f32x4*)(p0 + (size_t)sgm * 256 * DM + 8 * (ib + i)); q[i][sgm][1] = *(const f32x4*)(p0 + (size_t)sgm * 256 * DM + 8 * (ib + i) + 4); }
                asm volatile("" ::: "memory");
#pragma unroll
                for (int i = 0; i < 4; ++i) { const f32x4 a0 = q[i][0][0] + q[i][1][0] + q[i][2][0], a1 = q[i][0][1] + q[i][1][1] + q[i][2][1];
                    u32x4 w; w.x = cvt_pk_bf16(a0[0], a0[1]); w.y = cvt_pk_bf16(a0[2], a0[3]); w.z = cvt_pk_bf16(a1[0], a1[1]); w.w = cvt_pk_bf16(a1[2], a1[3]); *(u32x4*)(yo + 8 * (ib + i)) = w; }
                asm volatile("" ::: "memory"); }
            asm volatile("s_waitcnt vmcnt(0)" ::: "memory");
            asm volatile("" ::: "memory"); __builtin_amdgcn_s_barrier(); asm volatile("" ::: "memory");
        }
    }
    __device__ __forceinline__ void done(const Unit&) const {}
};
struct ResidOrder {
    StaticOrder lat; int c, G, n;
    __device__ __forceinline__ bool next(int i, Unit& u) const {
        const int nl = lat.c < lat.nwg ? (lat.nwg - lat.c + lat.G - 1) / lat.G : 0;
        if (i < nl) { lat.next(i, u); u.pm += 1; return true; }
        const int L = (i - nl) * G + c; if (L >= n) return false;
        u.pm = 0; u.pn = L >> 4; u.koff = (L & 15) * 256; u.boff = u.koff; u.fl = 4 << 8; return true;
    }
    __device__ __forceinline__ void a_ready(const Unit&) const {}
    __device__ __forceinline__ void done(const Unit&) const {}
};
struct MergeOrder {
    StaticOrder lat; int c, G, nctx;
    __device__ __forceinline__ bool next(int i, Unit& u) const {
        const int nl = lat.c < lat.nwg ? (lat.nwg - lat.c + lat.G - 1) / lat.G : 0;
        if (i < 3 * nl) { lat.next(i / 3, u); u.pm += 1; const int sg = i % 3; u.fl = sg | (sg != 0 ? 4 : 0); u.koff = sg * (MT * 1024); u.boff = sg * (4096 * 1024); return true; }
        const int L = (i - 3 * nl) * G + c; if (L >= nctx) return false;
        u.pm = 0; u.pn = L / 3; const int sg = L % 3; u.fl = sg; u.koff = sg * (MT * 1024); u.boff = sg * (4096 * 1024); return true;
    }
    __device__ __forceinline__ void a_ready(const Unit&) const {}
    __device__ __forceinline__ void done(const Unit&) const {}
};
struct EpiSlab {
    static constexpr bool PERM = false, AFTER_DRAIN = false;
    float* S;
    __device__ __forceinline__ void operator()(const f32x4 (&acc)[2][2][4][2], const Unit& u, int wr, int wc, int fr, int fq) const {
        { const int l_ = mk_lane_id(); fr = l_ & 15; fq = l_ >> 4; }
        const int col0 = u.pn * BM + wc * 32 + 4 * fq; float* base = S + (size_t)(u.koff >> 8) * 256 * DM;
#pragma unroll
        for (int ai = 0; ai < 2; ++ai)
#pragma unroll
            for (int m = 0; m < 4; ++m) { float* p = base + (size_t)(ai * HALF + wr * 64 + m * 16 + fr) * DM + col0;
#pragma unroll
                for (int bj = 0; bj < 2; ++bj)
#pragma unroll
                    for (int n = 0; n < 2; ++n) *(f32x4*)(p + bj * HALF + n * 16) = acc[ai][bj][m][n]; }
    }
};
struct EpiWin {
    static constexpr bool PERM = true, AFTER_DRAIN = false;
    bf16_t* ZB; const float* rc; const float* rs;
    __device__ __forceinline__ void operator()(const f32x4 (&acc)[2][2][4][2], const Unit& u, int wr, int wc, int fr, int fq) const {
        { const int l_ = mk_lane_id(); fr = l_ & 15; fq = l_ >> 4; }
        const int pn = u.pn; int kind = 0, ld = 1024, c0 = 0;
        if (pn < 8) { kind = 1; ld = 2048; c0 = 0; } else if (pn < 10) { ld = 512; c0 = 2048; } else if (pn < 12) { ld = 512; c0 = 2560; } else if (pn < 16) { c0 = 3072; }
        else if (pn < 20) { kind = 2; c0 = 4096; } else if (pn < 24) { kind = 3; c0 = 5120; } else if (pn < 28) { kind = 3; c0 = 6144; } else if (pn < 32) { c0 = 7168; } else { kind = 2; ld = 12288; c0 = 8192; }
        if (kind == 3 && u.pm == 0) kind = 0;
        bf16_t* base = ZB + (size_t)MT * c0; const int colt = pn * BM - c0 + wc * 32 + 8 * fq; const int row0 = u.pm * BM + wr * 64 + fr;
#define EPIWIN_LOOP(...) _Pragma("unroll") for (int ai = 0; ai < 2; ++ai) _Pragma("unroll") for (int m = 0; m < 4; ++m) { const int row = row0 + ai * HALF + m * 16; _Pragma("unroll") for (int bj = 0; bj < 2; ++bj) { \
            const int col = colt + bj * HALF; float v[8]; _Pragma("unroll") for (int n = 0; n < 2; ++n) _Pragma("unroll") for (int i = 0; i < 4; ++i) v[n * 4 + i] = acc[ai][bj][m][n][i]; \
            __VA_ARGS__ \
            u32x4 w; w.x = cvt_pk_bf16(v[0], v[1]); w.y = cvt_pk_bf16(v[2], v[3]); w.z = cvt_pk_bf16(v[4], v[5]); w.w = cvt_pk_bf16(v[6], v[7]); *(u32x4*)(base + (size_t)row * ld + col) = w; } }
        if (kind == 0) { EPIWIN_LOOP(;) }
        else if (kind == 1) { EPIWIN_LOOP(_Pragma("unroll") for (int i = 0; i < 8; ++i) { const float x = v[i], uu = 0.7978845608028654f * (x + 0.044715f * x * x * x); v[i] = x * __builtin_amdgcn_rcpf(1.f + __expf(-2.f * uu)); }) }
        else if (kind == 2) { EPIWIN_LOOP(_Pragma("unroll") for (int i = 0; i < 8; ++i) v[i] = fminf(__builtin_amdgcn_rcpf(1.f + __expf(-v[i])), 1.f);) }
        else {
#pragma unroll
            for (int ai = 0; ai < 2; ++ai) { f32x4 c4[4][2], s4[4][2];
#pragma unroll
                for (int m = 0; m < 4; ++m)
#pragma unroll
                    for (int bj = 0; bj < 2; ++bj) { const int t = row0 + ai * HALF + m * 16 - CTXL, j0 = ((colt + bj * HALF) & 127) >> 1; c4[m][bj] = *(const f32x4*)(rc + t * 64 + j0); s4[m][bj] = *(const f32x4*)(rs + t * 64 + j0); }
                asm volatile("" ::: "memory");
#pragma unroll
                for (int m = 0; m < 4; ++m)
#pragma unroll
                    for (int bj = 0; bj < 2; ++bj) { const int row = row0 + ai * HALF + m * 16, col = colt + bj * HALF; float v[8];
#pragma unroll
                        for (int n = 0; n < 2; ++n)
#pragma unroll
                            for (int i = 0; i < 4; ++i) v[n * 4 + i] = acc[ai][bj][m][n][i];
#pragma unroll
                        for (int i = 0; i < 4; ++i) { const float x1 = v[2 * i], x2 = v[2 * i + 1]; v[2 * i] = x1 * c4[m][bj][i] - x2 * s4[m][bj][i]; v[2 * i + 1] = x1 * s4[m][bj][i] + x2 * c4[m][bj][i]; }
                        u32x4 w; w.x = cvt_pk_bf16(v[0], v[1]); w.y = cvt_pk_bf16(v[2], v[3]); w.z = cvt_pk_bf16(v[4], v[5]); w.w = cvt_pk_bf16(v[6], v[7]); *(u32x4*)(base + (size_t)row * ld + col) = w; }
                asm volatile("" ::: "memory"); } }
#undef EPIWIN_LOOP
    }
};
struct EpiSwiglu {
    static constexpr bool PERM = true, AFTER_DRAIN = false;
    bf16_t* O; int ldc;
    __device__ __forceinline__ void operator()(const f32x4 (&acc)[2][2][4][2], const Unit& u, int wr, int wc, int fr, int fq) const {
        { const int l_ = mk_lane_id(); fr = l_ & 15; fq = l_ >> 4; }
        const int row0 = u.pm * BM + wr * 64 + fr, col0 = u.pn * HALF + wc * 32 + 8 * fq;
#pragma unroll
        for (int ai = 0; ai < 2; ++ai)
#pragma unroll
            for (int m = 0; m < 4; ++m) {
                bf16_t* rowp = O + (size_t)(row0 + ai * HALF + m * 16) * ldc + col0;
                float v[8];
#pragma unroll
                for (int n = 0; n < 2; ++n)
#pragma unroll
                    for (int i = 0; i < 4; ++i) { const float a = acc[ai][0][m][n][i], b = acc[ai][1][m][n][i]; v[n * 4 + i] = a * __builtin_amdgcn_rcpf(1.f + __expf(-a)) * b; }
                u32x4 w; w.x = cvt_pk_bf16(v[0], v[1]); w.y = cvt_pk_bf16(v[2], v[3]); w.z = cvt_pk_bf16(v[4], v[5]); w.w = cvt_pk_bf16(v[6], v[7]);
                *(u32x4*)rowp = w;
            }
    }
};
struct EpiResid {
    static constexpr bool PERM = false, AFTER_DRAIN = false;
    float* X; const float* gate_lat; const float* gate_ctx; const float* XB; float f;
    __device__ __forceinline__ void operator()(const f32x4 (&acc)[2][2][4][2], const Unit& u, int wr, int wc, int fr, int fq) const {
        { const int l_ = mk_lane_id(); fr = l_ & 15; fq = l_ >> 4; }
        const int col0 = u.pn * BM + wc * 32 + 4 * fq;
        const float* gate = (u.pm == 0) ? gate_ctx : gate_lat;
        f32x4 gv[2][2];
#pragma unroll
        for (int bj = 0; bj < 2; ++bj)
#pragma unroll
            for (int n = 0; n < 2; ++n) gv[bj][n] = *(const f32x4*)(gate + col0 + bj * HALF + n * 16) * f;
#pragma unroll
        for (int ai = 0; ai < 2; ++ai) {
            f32x4 x[4][2][2];
            const size_t o0 = (size_t)(u.pm * BM + ai * HALF + wr * 64 + fr) * DM + col0; float* p0 = X + o0; const float* r0 = XB + o0;
#pragma unroll
            for (int m = 0; m < 4; ++m)
#pragma unroll
                for (int bj = 0; bj < 2; ++bj)
#pragma unroll
                    for (int n = 0; n < 2; ++n) x[m][bj][n] = *(const f32x4*)(r0 + (size_t)(m * 16) * DM + bj * HALF + n * 16);
            asm volatile("" ::: "memory");
#pragma unroll
            for (int m = 0; m < 4; ++m)
#pragma unroll
                for (int bj = 0; bj < 2; ++bj)
#pragma unroll
                    for (int n = 0; n < 2; ++n) *(f32x4*)(p0 + (size_t)(m * 16) * DM + bj * HALF + n * 16) = x[m][bj][n] + gv[bj][n] * acc[ai][bj][m][n];
            asm volatile("" ::: "memory");
        }
    }
};
struct EpiResidSlab {
    static constexpr bool PERM = false, AFTER_DRAIN = false;
    unsigned char* wsb; const float* gate_lat; const float* XB; float f;
    __device__ __forceinline__ void operator()(const f32x4 (&acc)[2][2][4][2], const Unit& u, int wr, int wc, int fr, int fq) const {
        if (u.pm == 0) { EpiSlab E{(float*)(wsb + WS_SLAB)}; E(acc, u, wr, wc, fr, fq); }
        else { EpiResid E{(float*)(wsb + WS_XR), gate_lat, gate_lat, XB, f}; E(acc, u, wr, wc, fr, fq); }
    }
};
struct EpiMergeSeg {
    static constexpr bool PERM = true, AFTER_DRAIN = false;
    const bf16_t* Zg; bf16_t* Y; float* MS3;
    __device__ __forceinline__ void operator()(f32x4 (&acc)[2][2][4][2], const Unit& u, int wr, int wc, int fr, int fq) const {
        { const int l_ = mk_lane_id(); fr = l_ & 15; fq = l_ >> 4; }
        const int seg = u.seg(); const bool ctxp = (u.pm == 0);
        const int col0 = u.pn * BM + wc * 32 + 8 * fq;
#pragma unroll
        for (int ai = 0; ai < 2; ++ai) {
            u32x4 ga[4][2], gb[4][2];
#pragma unroll
            for (int m = 0; m < 4; ++m)
#pragma unroll
                for (int bj = 0; bj < 2; ++bj) { const bf16_t* gp = Zg + (size_t)MT * ZC_MG + (size_t)(u.pm * BM + ai * HALF + wr * 64 + m * 16 + fr) * 12288 + seg * 4096 + col0 + bj * HALF;
                    ga[m][bj] = *(const u32x4*)gp; if (!ctxp && seg < 2) gb[m][bj] = *(const u32x4*)(gp + 4096); }
            asm volatile("" ::: "memory");
#pragma unroll
            for (int m = 0; m < 4; ++m)
#pragma unroll
                for (int bj = 0; bj < 2; ++bj) { const size_t row = (size_t)(u.pm * BM + ai * HALF + wr * 64 + m * 16 + fr); const int col = col0 + bj * HALF;
                    const unsigned aw[4] = {ga[m][bj].x, ga[m][bj].y, ga[m][bj].z, ga[m][bj].w};
                    float g[8];
#pragma unroll
                    for (int k = 0; k < 4; ++k) { g[2 * k] = fmaxf(__uint_as_float(aw[k] << 16), 1e-20f); g[2 * k + 1] = fmaxf(__uint_as_float(aw[k] & 0xffff0000u), 1e-20f); }
                    if (!ctxp && seg < 2) { const unsigned bw[4] = {gb[m][bj].x, gb[m][bj].y, gb[m][bj].z, gb[m][bj].w};
#pragma unroll
                        for (int k = 0; k < 4; ++k) { g[2 * k] = g[2 * k] * __builtin_amdgcn_rcpf(fmaxf(__uint_as_float(bw[k] << 16), 1e-20f)); g[2 * k + 1] = g[2 * k + 1] * __builtin_amdgcn_rcpf(fmaxf(__uint_as_float(bw[k] & 0xffff0000u), 1e-20f)); } }
                    float v[8];
#pragma unroll
                    for (int n = 0; n < 2; ++n)
#pragma unroll
                        for (int i = 0; i < 4; ++i) v[n * 4 + i] = acc[ai][bj][m][n][i] * g[n * 4 + i];
                    if (ctxp) { float* ms = MS3 + ((size_t)seg * 256 + row) * DM + col; *(f32x4*)ms = (f32x4){v[0], v[1], v[2], v[3]}; *(f32x4*)(ms + 4) = (f32x4){v[4], v[5], v[6], v[7]}; }
                    else if (seg < 2) { acc[ai][bj][m][0] = (f32x4){v[0], v[1], v[2], v[3]}; acc[ai][bj][m][1] = (f32x4){v[4], v[5], v[6], v[7]}; }
                    else { u32x4 w; w.x = cvt_pk_bf16(v[0], v[1]); w.y = cvt_pk_bf16(v[2], v[3]); w.z = cvt_pk_bf16(v[4], v[5]); w.w = cvt_pk_bf16(v[6], v[7]); *(u32x4*)(Y + row * DM + col) = w; } }
            asm volatile("" ::: "memory");
        }
    }
};
}

constexpr int TSTR = 68, TSCR_BYTES = 64 * TSTR * 4;
__device__ __forceinline__ void transpose_item(const float* __restrict__ W, size_t ldw, int K, int k0, int srccol0, bf16* WT, int dstrow0, LAS float* scr, int lane) {
    const int r4 = lane >> 4, c16 = lane & 15;
    f32x4 v[16];
#pragma unroll
    for (int i = 0; i < 16; ++i) v[i] = __builtin_nontemporal_load((const f32x4*)(W + (size_t)(k0 + 4 * i + r4) * ldw + srccol0 + 4 * c16));
#pragma unroll
    for (int i = 0; i < 16; ++i) *(LAS f32x4*)(scr + (4 * i + r4) * TSTR + 4 * c16) = v[i];
    LDS_WAIT(); asm volatile("" ::: "memory");
    const int c = lane & 7;
#pragma unroll
    for (int j = 0; j < 8; ++j) { const int n = (lane >> 3) + 8 * j; const LAS float* sp = scr + (8 * c) * TSTR + n;
        v4u o; o.x = pk2(sp[0 * TSTR], sp[1 * TSTR]); o.y = pk2(sp[2 * TSTR], sp[3 * TSTR]); o.z = pk2(sp[4 * TSTR], sp[5 * TSTR]); o.w = pk2(sp[6 * TSTR], sp[7 * TSTR]);
        __builtin_nontemporal_store(o, (GAS v4u*)(WT + (size_t)(dstrow0 + n) * K + k0 + 8 * c)); }
    LDS_WAIT(); asm volatile("" ::: "memory");
}

struct Ptrs {
    const float *x, *c, *ctx, *c_ctx, *ada_down, *ada_up, *ada_bias, *norm_g, *w13, *w2, *w_in, *gmlp_norm_g, *gmlp_ws, *gmlp_bs, *gate_b, *mlstm_norm_g, *diff_lambda, *diff_norm_g, *w_branch, *w_out, *final_g;
    float* out; unsigned char* ws;
};

constexpr int IT_W13 = 2 * 64 * 128, IT_W2 = 2 * 64 * 64, IT_WIN = 64 * 320, IT_WB = 3 * 16 * 64, IT_WO = 64 * 64, IT_LAYER = IT_W13 + IT_W2 + IT_WIN + IT_WB + IT_WO;

constexpr int NE = 8192 + 4096 + IT_WIN, NL = IT_WB + IT_WO + 8192 + 4096;
static_assert(NE + NL == IT_LAYER, "lists cover the layer");
__device__ __forceinline__ void convert_range(const Ptrs& P, int l, int list, int it_lo, int it_hi, int widx, int nw, LAS float* scr, int lane) {
    unsigned char* ws = P.ws;
    for (int it = it_lo + widx; it < it_hi; it += nw) {
        int r;
        if (list == 0) r = it < 8192 ? it : it < 12288 ? IT_W13 + (it - 8192) : IT_W13 + IT_W2 + (it - 12288);
        else r = it < IT_WB ? IT_W13 + IT_W2 + IT_WIN + it : it < IT_WB + IT_WO ? IT_W13 + IT_W2 + IT_WIN + it : it < IT_WB + IT_WO + 8192 ? 8192 + (it - IT_WB - IT_WO) : IT_W13 + 4096 + (it - IT_WB - IT_WO - 8192);
        if (r < IT_W13) { const int s = r / (64 * 128), q = r % (64 * 128), kb = q / 128, nb = q % 128, dr = nb * 64, tile = dr >> 8, within = dr & 255;
            const int src = within < 128 ? tile * 128 + within : 4096 + tile * 128 + (within - 128);
            transpose_item(P.w13 + (size_t)(l * 2 + s) * 4096 * 8192, 8192, 4096, kb * 64, src, (bf16*)(ws + WS_W13T) + (size_t)(l * 2 + s) * 8192 * 4096, dr, scr, lane); continue; }
        r -= IT_W13;
        if (r < IT_W2) { const int s = r / (64 * 64), q = r % (64 * 64), kb = q / 64, nb = q % 64;
            transpose_item(P.w2 + (size_t)(l * 2 + s) * 4096 * 4096, 4096, 4096, kb * 64, nb * 64, (bf16*)(ws + WS_W2T) + (size_t)(l * 2 + s) * 4096 * 4096, nb * 64, scr, lane); continue; }
        r -= IT_W2;
        if (r < IT_WIN) { const int kb = r / 320, nb = r % 320, dr = nb * 64, src = dr < 5120 ? dr : dr + 16;
            transpose_item(P.w_in + (size_t)l * 4096 * INC, INC, 4096, kb * 64, src, (bf16*)(ws + WS_WINT) + (size_t)l * NZ * 4096, dr, scr, lane); continue; }
        r -= IT_WIN;
        if (r < IT_WB) { const int i = r / (16 * 64), q = r % (16 * 64), kb = q / 64, nb = q % 64;
            transpose_item(P.w_branch + (size_t)(l * 3 + i) * 1024 * 4096, 4096, 1024, kb * 64, nb * 64, (bf16*)(ws + WS_WBT) + (size_t)(l * 3 + i) * 4096 * 1024, nb * 64, scr, lane); continue; }
        r -= IT_WB;
        { const int kb = r / 64, nb = r % 64;
            transpose_item(P.w_out + (size_t)l * 4096 * 4096, 4096, 4096, kb * 64, nb * 64, (bf16*)(ws + WS_WOT) + (size_t)l * 4096 * 4096, nb * 64, scr, lane); }
    }
}
#ifndef CVP_D
#define CVP_D 9
#endif
#ifndef CVP_T
#define CVP_T 8
#endif
constexpr int CVD = IT_LAYER * CVP_D / 100, CVS = CVD + IT_LAYER * CVP_T / 100;
static_assert(CVS < NL && CVS < NE, "slot sizes");
__device__ __forceinline__ void convert_part(const Ptrs& P, int lnext, int list, int it_lo, int it_hi, int idx, int n, LAS unsigned char* lds, int tid) {
    asm volatile("" : "+v"(tid));
    if (lnext >= DEPTH || idx < 0 || idx >= n) return;
    const int wave = tid >> 6, lane = tid & 63;
    convert_range(P, lnext, list, it_lo, it_hi, idx * NWAVES + wave, n * NWAVES, (LAS float*)(lds + RING_OFF + wave * TSCR_BYTES), lane);
}
__device__ __forceinline__ void convert_idle(const Ptrs& P, int lnext, int list, int it_lo, int it_hi, int first_idle, int gend, LAS unsigned char* lds, int bid, int tid) {
    if (gend < first_idle + 16) first_idle = 0;
    if (bid >= gend) return;
    convert_part(P, lnext, list, it_lo, it_hi, bid - first_idle, gend - first_idle, lds, tid);
}
__device__ __forceinline__ void pro0(const Ptrs& P, LAS unsigned char* lds, int bid, int G, int tid) {
    asm volatile("" : "+v"(tid));
    const int wave = tid >> 6, lane = tid & 63;
    LAS float* scr = (LAS float*)(lds + RING_OFF + wave * TSCR_BYTES);
    const int gw = bid * NWAVES + wave, NGW = G * NWAVES;
    unsigned char* ws = P.ws;
    convert_range(P, 0, 0, 0, NE, gw, NGW, scr, lane);
    for (int l = 1; l < DEPTH; ++l) convert_range(P, l, 0, CVS, NE, gw, NGW, scr, lane);
    const int gt = bid * NTHR + tid, NGT = G * NTHR;
    { float* rc = (float*)(ws + WS_ROPE); float* rs = rc + SEQ * 64;
      for (int i = gt; i < SEQ * 64; i += NGT) { const int t = i >> 6, j = i & 63; const float inv = powf(10000.f, -(float)(j & 31) / 32.f);
          const float pos = (float)(j < 32 ? (t >> 6) : (t & 63)); const float ang = pos * inv; rc[i] = cosf(ang); rs[i] = sinf(ang); } }
    { float* tp = (float*)(ws + WS_MODTP);
      for (int task = gw; task < DEPTH * 2 * 4 * 64; task += NGW) { const int dc = task & 63, rg = (task >> 6) & 3, w = (task >> 8) & 1, l = task >> 9;
          const float* cv = w ? P.c_ctx : P.c; const float* dn = P.ada_down + (size_t)l * DM * ADAR + (size_t)(dc * 64) * ADAR + rg * 64 + lane;
          float wv[64]; const float cmine = cv[dc * 64 + lane], smine = cmine / (1.f + expf(-cmine));
#pragma unroll
          for (int d = 0; d < 64; ++d) wv[d] = dn[(size_t)d * ADAR];
          asm volatile("" ::: "memory");
          float acc = 0.f;
#pragma unroll
          for (int d = 0; d < 64; ++d) acc += __int_as_float(__builtin_amdgcn_readlane(__float_as_int(smine), d)) * wv[d];
          tp[((l * 2 + w) * 64 + dc) * 256 + rg * 64 + lane] = acc; } }
    if (bid == 0 && tid < DEPTH) { const float* dl = P.diff_lambda + tid * 4 * 128; float s1 = 0.f, s2 = 0.f;
        for (int i = 0; i < 128; ++i) { s1 += dl[i] * dl[128 + i]; s2 += dl[256 + i] * dl[384 + i]; }
        ((float*)(ws + WS_LAM))[tid] = expf(s1) - expf(s2) + lambda_init_f(tid); }
    { bf16* wb = (bf16*)(ws + WS_GWSB); for (int i = gt; i < DEPTH * 8 * 128 * 128; i += NGT) wb[i] = (bf16)f2bf(P.gmlp_ws[i]); }
    { bf16* wg = (bf16*)(ws + WS_WG16);
      for (int i = gt; i < DEPTH * DM * 16; i += NGT) { const int j = i & 15, d = (i >> 4) & (DM - 1), l = i >> 16;
          wg[((size_t)l * 16 + j) * DM + d] = (bf16)f2bf(P.w_in[((size_t)l * DM + d) * INC + 5120 + j]); } }
}

__device__ __forceinline__ void pro1(const Ptrs& P, LAS unsigned char* lds, int bid, int G, int tid) {
    asm volatile("" : "+v"(tid));
    LAS float* T = (LAS float*)(lds + RING_OFF);
    const float* tp = (const float*)(P.ws + WS_MODTP);
    for (int i = tid; i < DEPTH * 2 * 256; i += NTHR) { const int r = i & 255, lw = i >> 8; float s = 0.f;
        for (int dc = 0; dc < 64; ++dc) s += tp[(lw * 64 + dc) * 256 + r];
        T[i] = s; }
    __syncthreads();
    float* MOD = (float*)(P.ws + WS_MOD);
    for (int i = bid * NTHR + tid; i < DEPTH * NMOD; i += G * NTHR) { const int l = i / NMOD, n = i % NMOD;
        const float* up = P.ada_up + (size_t)l * ADAR * NMOD + n; const float b = P.ada_bias[(size_t)l * NMOD + n]; float a0 = b, a1 = b;
#pragma unroll 1
        for (int r0 = 0; r0 < ADAR; r0 += 32) { float uu[32];
#pragma unroll
            for (int k = 0; k < 32; ++k) uu[k] = up[(size_t)(r0 + k) * NMOD];
            asm volatile("" ::: "memory");
#pragma unroll
            for (int k = 0; k < 32; ++k) { a0 += T[(l * 2 + 0) * 256 + r0 + k] * uu[k]; a1 += T[(l * 2 + 1) * 256 + r0 + k] * uu[k]; } }
        MOD[(size_t)(l * 2 + 0) * NMOD + n] = a0; MOD[(size_t)(l * 2 + 1) * NMOD + n] = a1; }
    __syncthreads();
}

__device__ __forceinline__ void phase_norm(float* XR, const float* rdl, const float* rdc, const float* prec, const float* g, const float* modl, const float* modc, bf16* H, const float* slab, const float* cgate, float cf, LAS unsigned char* lds, int bid, int G, int tid) {
    asm volatile("" : "+v"(tid));
    const int wave = tid >> 6, lane = tid & 63;
    LAS f32x4* AL = (LAS f32x4*)lds; LAS f32x4* SL = AL + 1024; LAS f32x4* AC = AL + 2048; LAS f32x4* SC = AL + 3072;
    { f32x4 q[2][5];
#pragma unroll
      for (int k = 0; k < 2; ++k) { const int i = tid + k * NTHR; q[k][0] = ((const f32x4*)g)[i]; q[k][1] = ((const f32x4*)(modl + DM))[i]; q[k][2] = ((const f32x4*)modl)[i]; q[k][3] = ((const f32x4*)(modc + DM))[i]; q[k][4] = ((const f32x4*)modc)[i]; }
      asm volatile("" ::: "memory");
#pragma unroll
      for (int k = 0; k < 2; ++k) { const int i = tid + k * NTHR; AL[i] = q[k][0] * (q[k][1] + 1.f); SL[i] = q[k][2]; AC[i] = q[k][0] * (q[k][3] + 1.f); SC[i] = q[k][4]; } }
    const int row0 = bid * NWAVES + wave, stride = G * NWAVES;
    if (slab && row0 < CTXL) {
        f32x4* xw = (f32x4*)(XR + (size_t)row0 * DM) + lane; const f32x4* xpre = (const f32x4*)(prec + (size_t)row0 * DM) + lane; const f32x4* sp = (const f32x4*)(slab + (size_t)row0 * DM) + lane; const f32x4* gp = (const f32x4*)cgate + lane;
#pragma unroll 1
        for (int j = 0; j < 16; j += 2) { f32x4 q[2][16], xo[2];
#pragma unroll
            for (int jj = 0; jj < 2; ++jj) { xo[jj] = xpre[64 * (j + jj)];
#pragma unroll
                for (int kc = 0; kc < 16; ++kc) q[jj][kc] = sp[(size_t)kc * 256 * (DM / 4) + 64 * (j + jj)]; }
            asm volatile("" ::: "memory");
#pragma unroll
            for (int jj = 0; jj < 2; ++jj) { f32x4 a = (f32x4){0.f, 0.f, 0.f, 0.f};
#pragma unroll
                for (int kc = 0; kc < 16; ++kc) a += q[jj][kc];
                xw[64 * (j + jj)] = xo[jj] + a * gp[64 * (j + jj)] * cf; }
            asm volatile("" ::: "memory"); }
        asm volatile("s_waitcnt vmcnt(0)" ::: "memory");
    }
    __syncthreads();
    f32x4 v[16];
    if (row0 < MT) { const f32x4* xr = (const f32x4*)((row0 < CTXL ? rdc : rdl) + (size_t)row0 * DM) + lane;
#pragma unroll
        for (int j = 0; j < 16; ++j) v[j] = xr[64 * j]; }
    for (int row = row0; row < MT; row += stride) {
        f32x4 vn[16];
        if (row + stride < MT) { const f32x4* xr = (const f32x4*)(rdl + (size_t)(row + stride) * DM) + lane;
#pragma unroll
            for (int j = 0; j < 16; ++j) vn[j] = xr[64 * j]; }
        float ss = 0.f;
#pragma unroll
        for (int j = 0; j < 16; ++j) ss += (v[j].x * v[j].x + v[j].y * v[j].y) + (v[j].z * v[j].z + v[j].w * v[j].w);
        const float rstd = 1.f / sqrtf(wave_sum(ss) * (1.f / DM) + EPS);
        const LAS f32x4* Ap = row < CTXL ? AC : AL; const LAS f32x4* Sp = row < CTXL ? SC : SL;
        uint2* hr = (uint2*)(H + (size_t)row * DM) + lane;
#pragma unroll
        for (int j = 0; j < 16; ++j) { const f32x4 hv = v[j] * rstd * Ap[lane + 64 * j] + Sp[lane + 64 * j];
            uint2 o; o.x = pk2(hv.x, hv.y); o.y = pk2(hv.z, hv.w); hr[64 * j] = o; }
#pragma unroll
        for (int j = 0; j < 16; ++j) v[j] = vn[j];
    }
    __syncthreads();
}
typedef float f32x4g __attribute__((ext_vector_type(4)));
__device__ __forceinline__ void gates_unit(const bf16* H, const bf16* WGb, float* G16, int jb, int tid) {
    asm volatile("" : "+v"(tid));
    const int wave = tid >> 6, lane = tid & 63, fr = lane & 15, fq = lane >> 4;
    const bf16* ap = H + (size_t)(jb * 128 + wave * 16 + fr) * DM + 8 * fq; const bf16* bp = WGb + (size_t)fr * DM + 8 * fq;
    f32x4g acc[4];
#pragma unroll
    for (int i = 0; i < 4; ++i) acc[i] = (f32x4g){0.f, 0.f, 0.f, 0.f};
#pragma unroll 1
    for (int k = 0; k < DM; k += 512) { bf16x8 af[16], bfv[16];
#pragma unroll
        for (int i = 0; i < 16; ++i) { af[i] = *(const bf16x8*)(ap + k + 32 * i); bfv[i] = *(const bf16x8*)(bp + k + 32 * i); }
        asm volatile("" ::: "memory");
#pragma unroll
        for (int i = 0; i < 16; ++i) acc[i & 3] = __builtin_amdgcn_mfma_f32_16x16x32_bf16(af[i], bfv[i], acc[i & 3], 0, 0, 0);
    }
    const f32x4g sres = (acc[0] + acc[1]) + (acc[2] + acc[3]);
#pragma unroll
    for (int r = 0; r < 4; ++r) G16[(size_t)(jb * 128 + wave * 16 + 4 * fq + r) * 16 + fr] = sres[r];
}

__device__ __forceinline__ void phase_final(const float* XR, const float* g, float* out, int bid, int G, int tid) {
    asm volatile("" : "+v"(tid));
    const int wave = tid >> 6, lane = tid & 63;
    f32x4 gg[16];
#pragma unroll
    for (int j = 0; j < 16; ++j) gg[j] = *(const f32x4*)(g + 4 * lane + 256 * j);
    for (int t = bid * NWAVES + wave; t < SEQ; t += G * NWAVES) {
        const f32x4* xr = (const f32x4*)(XR + (size_t)(CTXL + t) * DM) + lane;
        f32x4 v[16]; float ss = 0.f;
#pragma unroll
        for (int j = 0; j < 16; ++j) { v[j] = xr[64 * j]; ss += (v[j].x * v[j].x + v[j].y * v[j].y) + (v[j].z * v[j].z + v[j].w * v[j].w); }
        const float rstd = 1.f / sqrtf(wave_sum(ss) * (1.f / DM) + EPS);
        f32x4* o = (f32x4*)(out + (size_t)t * DM) + lane;
#pragma unroll
        for (int j = 0; j < 16; ++j) o[64 * j] = v[j] * rstd * gg[j];
    }
}

typedef short s16x4 __attribute__((ext_vector_type(4)));
typedef float f32x16 __attribute__((ext_vector_type(16)));
typedef short v4i16_t __attribute__((ext_vector_type(4)));
__device__ __forceinline__ int crow16(int r, int hi) { return (r & 3) + 8 * (r >> 2) + 4 * hi; }
__device__ __forceinline__ int chain_cidx(int dir, int jb) { return dir ? (jb < 2 ? 1 - jb : 67 - jb) : jb; }
__device__ __forceinline__ s16x4 trr(LAS const unsigned char* p) { return __builtin_bit_cast(s16x4, __builtin_amdgcn_ds_read_tr16_b64_v4i16((LAS v4i16_t*)p)); }
__device__ __forceinline__ bf16x8 trfrag(LAS const unsigned char* im, int RS, int rowA, int rowB, int n0, int lane) {
    const int i = lane & 15, q = i >> 2, p = i & 3, cb = n0 + 16 * ((lane >> 4) & 1) + 4 * p;
    const s16x4 lo = trr(im + (rowA + q) * RS + cb * 2), hi = trr(im + (rowB + q) * RS + cb * 2);
    return (bf16x8){lo[0], lo[1], lo[2], lo[3], hi[0], hi[1], hi[2], hi[3]};
}
constexpr int VSTR = 528, KW_OFF = 67584;
constexpr int SM_OFF = 133120;
__device__ __forceinline__ void gate_scan(const float* G16, const float* gate_b, int jb, int h, LAS float* SM, int tid) {
    LAS float* SC = SM + 768;
    const int dir = (tid >> 7) & 1, c = tid & 127, o = dir ? 127 - c : c; const bool act = tid < 256;
    float ip = 0.f, x = 0.f;
    if (act) { const size_t row = (size_t)jb * 128 + o; ip = G16[row * 16 + dir * 8 + h] + gate_b[dir * 8 + h]; const float fp = G16[row * 16 + dir * 8 + 4 + h] + gate_b[dir * 8 + 4 + h];
        x = fminf(fp, 0.f) - __logf(1.f + __expf(-fabsf(fp))); }
    for (int s = 1; s < 128; s <<= 1) { if (act) SC[dir * 128 + c] = x; __syncthreads(); if (act && c >= s) x += SC[dir * 128 + c - s]; __syncthreads(); }
    const float b = x, u = ip - b; float y = u;
    for (int s = 1; s < 128; s <<= 1) { if (act) SC[dir * 128 + c] = y; __syncthreads(); if (act && c >= s) y = fmaxf(y, SC[dir * 128 + c - s]); __syncthreads(); }
    if (act) { SM[dir * 128 + o] = u; SM[256 + dir * 128 + o] = y; SM[512 + dir * 128 + o] = b; if (c == 127) { SM[1024 + dir] = b; SM[1026 + dir] = y; } }
    __syncthreads();
}
__device__ __forceinline__ void stage_v(const bf16* Z, size_t row0, int h, LAS unsigned char* VL, int tid) {
    v4u t[8];
#pragma unroll
    for (int k = 0; k < 8; ++k) { const int i = tid + k * NTHR, sr = i >> 5, ch = i & 31; t[k] = *(const v4u*)(Z + (size_t)MT * ZC_MV + (row0 + sr) * 1024 + h * 256 + ch * 8); }
    asm volatile("" ::: "memory");
#pragma unroll
    for (int k = 0; k < 8; ++k) { const int i = tid + k * NTHR, sr = i >> 5, ch = i & 31; *(LAS v4u*)(VL + sr * VSTR + ch * 16) = t[k]; }
}
__device__ __forceinline__ void mlstm_m1_unit(const bf16* Z, const float* G16, const float* gate_b, float* DCT, float* DN, float* CH, int jb, int h, LAS unsigned char* lds, int tid) {
    asm volatile("" : "+v"(tid));
    const int wave = tid >> 6, lane = tid & 63, hh = lane >> 5;
    LAS unsigned char* VL = lds; LAS unsigned char* KW = lds + KW_OFF; LAS float* SM = (LAS float*)(lds + SM_OFF);
    gate_scan(G16, gate_b, jb, h, SM, tid);
    const size_t row0 = (size_t)jb * 128;
    stage_v(Z, row0, h, VL, tid);
    { v4u kq[4];
#pragma unroll
      for (int k = 0; k < 4; ++k) { const int i = tid + k * NTHR, sr = i >> 4, ch = i & 15; kq[k] = *(const v4u*)(Z + (size_t)MT * ZC_MK + (row0 + sr) * 512 + h * 128 + ch * 8); }
      asm volatile("" ::: "memory");
#pragma unroll
      for (int k = 0; k < 4; ++k) { const int i = tid + k * NTHR, sr = i >> 4, ch = i & 15; const v4u kw = kq[k];
#pragma unroll
        for (int dir = 0; dir < 2; ++dir) { const float wg = __expf(SM[dir * 128 + sr] - SM[1026 + dir]); v4u o;
            o.x = pk2(bflo(kw.x) * wg, bfhi(kw.x) * wg); o.y = pk2(bflo(kw.y) * wg, bfhi(kw.y) * wg); o.z = pk2(bflo(kw.z) * wg, bfhi(kw.z) * wg); o.w = pk2(bflo(kw.w) * wg, bfhi(kw.w) * wg);
            *(LAS v4u*)(KW + dir * 32768 + sr * 256 + ch * 16) = o; } } }
    __syncthreads();
    const int dir = wave >> 2, ebp = wave & 3;
    f32x16 acc[2][4];
#pragma unroll
    for (int a = 0; a < 2; ++a)
#pragma unroll
        for (int b = 0; b < 4; ++b)
#pragma unroll
            for (int r = 0; r < 16; ++r) acc[a][b][r] = 0.f;
#pragma unroll 2
    for (int ks = 0; ks < 8; ++ks) {
        bf16x8 af[2], bfr[4];
#pragma unroll
        for (int eb = 0; eb < 2; ++eb) af[eb] = trfrag(VL, VSTR, 16 * ks + 8 * hh, 16 * ks + 8 * hh + 4, 32 * (2 * ebp + eb), lane);
#pragma unroll
        for (int db = 0; db < 4; ++db) bfr[db] = trfrag(KW + dir * 32768, 256, 16 * ks + 8 * hh, 16 * ks + 8 * hh + 4, 32 * db, lane);
#pragma unroll
        for (int eb = 0; eb < 2; ++eb)
#pragma unroll
            for (int db = 0; db < 4; ++db) acc[eb][db] = __builtin_amdgcn_mfma_f32_32x32x16_bf16(af[eb], bfr[db], acc[eb][db], 0, 0, 0);
    }
    { const int cidx = chain_cidx(dir, jb); float* dst = DCT + (size_t)((dir * 4 + h) * 66 + cidx) * 32768;
#pragma unroll
      for (int eb = 0; eb < 2; ++eb)
#pragma unroll
          for (int db = 0; db < 4; ++db)
#pragma unroll
              for (int r = 0; r < 16; ++r) dst[(32 * (2 * ebp + eb) + crow16(r, hh)) * 128 + 32 * db + (lane & 31)] = acc[eb][db][r]; }
    if (tid < 256) { const int dd = tid >> 7, d = tid & 127; float s = 0.f;
        for (int sg = 0; sg < 128; ++sg) s += bf2f(*(LAS const unsigned short*)(KW + dd * 32768 + sg * 256 + d * 2));
        DN[(size_t)((dd * 4 + h) * 66 + chain_cidx(dd, jb)) * 128 + d] = s; }
    if (tid < 2) { float* c = CH + (size_t)((tid * 4 + h) * 66 + chain_cidx(tid, jb)) * 2; c[0] = SM[1024 + tid]; c[1] = SM[1026 + tid]; }
    __syncthreads();
}
__device__ __forceinline__ void mlstm_m2_scalars(const float* CH, int chain, LAS float* SC, int tid) {
    if (tid < 66) { SC[256 + 2 * tid] = CH[(size_t)(chain * 66 + tid) * 2]; SC[256 + 2 * tid + 1] = CH[(size_t)(chain * 66 + tid) * 2 + 1]; }
    __syncthreads();
    if (tid == 0) { float m = 0.f;
        for (int j = 0; j < 66; ++j) { const float Bj = SC[256 + 2 * j], cm = SC[256 + 2 * j + 1], Mx = fmaxf(m, cm); SC[3 * j] = __expf(m - Mx); SC[3 * j + 1] = __expf(cm - Mx); SC[3 * j + 2] = m; m = Bj + Mx; } }
    __syncthreads();
}
__device__ __forceinline__ void mlstm_m2(const float* DCT, const float* DN, const float* CH, bf16* CT, float* NS, float* MS, LAS unsigned char* lds, int bid, int G, int tid) {
    asm volatile("" : "+v"(tid));
    LAS float* SC = (LAS float*)lds;
    for (int base = bid * NTHR; base < 8 * 16384; base += G * NTHR) {
        const int chain = base >> 14, p = (base & 16383) + tid;
        mlstm_m2_scalars(CH, chain, SC, tid);
        if ((base & 16383) == 0 && tid < 66) MS[chain * 66 + tid] = SC[3 * tid + 2];
        const float* dl = DCT + (size_t)chain * 66 * 32768 + 2 * p; unsigned* ct = (unsigned*)(CT + (size_t)chain * 66 * 32768 + 2 * p);
        float c0 = 0.f, c1 = 0.f;
#pragma unroll 1
        for (int jb = 0; jb < 66; jb += 11) { float2 d[11];
#pragma unroll
            for (int k = 0; k < 11; ++k) d[k] = *(const float2*)(dl + (size_t)(jb + k) * 32768);
            asm volatile("" ::: "memory");
#pragma unroll
            for (int k = 0; k < 11; ++k) { const float dec = SC[3 * (jb + k)], sc = SC[3 * (jb + k) + 1]; ct[(size_t)(jb + k) * 16384] = pk2(c0, c1); c0 = dec * c0 + sc * d[k].x; c1 = dec * c1 + sc * d[k].y; }
            asm volatile("" ::: "memory"); }
        __syncthreads();
    }
    for (int chain = bid; chain < 8; chain += G) {
        mlstm_m2_scalars(CH, chain, SC, tid);
        if (tid < 128) { float c0 = 0.f;
#pragma unroll 1
            for (int jb = 0; jb < 66; jb += 11) { float d[11];
#pragma unroll
                for (int k = 0; k < 11; ++k) d[k] = DN[(size_t)(chain * 66 + jb + k) * 128 + tid];
                asm volatile("" ::: "memory");
#pragma unroll
                for (int k = 0; k < 11; ++k) { NS[(size_t)(chain * 66 + jb + k) * 128 + tid] = c0; c0 = SC[3 * (jb + k)] * c0 + SC[3 * (jb + k) + 1] * d[k]; }
                asm volatile("" ::: "memory"); } }
        __syncthreads();
    }
}
__device__ __forceinline__ void mlstm_m3_unit(const bf16* Z, const float* G16, const float* gate_b, const bf16* CT, const float* NS, const float* MS, const float* mng, bf16* YB, int jb, int h, LAS unsigned char* lds, int tid) {
    asm volatile("" : "+v"(tid));
    const int wave = tid >> 6, lane = tid & 63, hh = lane >> 5, l31 = lane & 31;
    LAS unsigned char* VL = lds; LAS float* XCH = (LAS float*)lds; LAS float* SM = (LAS float*)(lds + SM_OFF);
    gate_scan(G16, gate_b, jb, h, SM, tid);
    const size_t row0 = (size_t)jb * 128;
    if (tid < 256) { const int dd = tid >> 7, d = tid & 127; SM[1040 + dd * 128 + d] = NS[(size_t)((dd * 4 + h) * 66 + chain_cidx(dd, jb)) * 128 + d]; }
    if (tid < 2) SM[1028 + tid] = MS[(tid * 4 + h) * 66 + chain_cidx(tid, jb)];
    stage_v(Z, row0, h, VL, tid);
    __syncthreads();
    const int tb = wave & 3, dir = wave >> 2, tau = 32 * tb + l31;
    float SCL = 0.08838834764831845f; asm volatile("" : "+v"(SCL));
    const float m = SM[1028 + dir], cmT = SM[256 + dir * 128 + tau], bT = SM[512 + dir * 128 + tau];
    const float Mt = fmaxf(m, cmT), wa = __expf(m - Mt), em = __expf(-(bT + Mt)), fa = wa * SCL;
    bf16x8 qf[8];
#pragma unroll
    for (int ks = 0; ks < 8; ++ks) qf[ks] = *(const bf16x8*)(Z + (size_t)MT * ZC_MQ + (row0 + tau) * 512 + h * 128 + 16 * ks + 8 * hh);
    f32x16 acc[8];
#pragma unroll
    for (int eb = 0; eb < 8; ++eb)
#pragma unroll
        for (int r = 0; r < 16; ++r) acc[eb][r] = 0.f;
    { const bf16* ct = CT + (size_t)((dir * 4 + h) * 66 + chain_cidx(dir, jb)) * 32768;
#pragma unroll
      for (int e2 = 0; e2 < 8; e2 += 2) { bf16x8 af[2][8];
#pragma unroll
          for (int eb = 0; eb < 2; ++eb)
#pragma unroll
              for (int ks = 0; ks < 8; ++ks) af[eb][ks] = *(const bf16x8*)(ct + (size_t)(32 * (e2 + eb) + l31) * 128 + 16 * ks + 8 * hh);
          asm volatile("" ::: "memory");
#pragma unroll
          for (int ks = 0; ks < 8; ++ks) { acc[e2] = __builtin_amdgcn_mfma_f32_32x32x16_bf16(af[0][ks], qf[ks], acc[e2], 0, 0, 0); acc[e2 + 1] = __builtin_amdgcn_mfma_f32_32x32x16_bf16(af[1][ks], qf[ks], acc[e2 + 1], 0, 0, 0); } } }
    asm volatile("" ::: "memory");
    float den = 0.f;
#pragma unroll
    for (int ks = 0; ks < 8; ++ks)
#pragma unroll
        for (int j = 0; j < 8; ++j) den += bf2f((unsigned short)qf[ks][j]) * SM[1040 + dir * 128 + 16 * ks + 8 * hh + j];
    den *= fa;
#pragma unroll
    for (int eb = 0; eb < 8; ++eb)
#pragma unroll
        for (int r = 0; r < 16; ++r) acc[eb][r] *= fa;
    asm volatile("" ::: "memory");
#pragma unroll 1
    for (int sb = 0; sb < 4; ++sb) {
        if (dir == 0 ? sb > tb : sb < tb) continue;
        asm volatile("" ::: "memory");
        f32x16 p;
#pragma unroll
        for (int r = 0; r < 16; ++r) p[r] = 0.f;
#pragma unroll
        for (int kh = 0; kh < 2; ++kh) { bf16x8 kf[4];
#pragma unroll
          for (int ks = 0; ks < 4; ++ks) kf[ks] = *(const bf16x8*)(Z + (size_t)MT * ZC_MK + (row0 + 32 * sb + l31) * 512 + h * 128 + 16 * (4 * kh + ks) + 8 * hh);
          asm volatile("" ::: "memory");
#pragma unroll
          for (int ks = 0; ks < 4; ++ks) p = __builtin_amdgcn_mfma_f32_32x32x16_bf16(kf[ks], qf[4 * kh + ks], p, 0, 0, 0); }
#pragma unroll
        for (int r = 0; r < 16; ++r) { const int sg = 32 * sb + crow16(r, hh); const bool keep = dir == 0 ? (sg <= tau) : (sg >= tau);
            const float w = keep ? __expf(SM[dir * 128 + sg] - Mt) * SCL : 0.f; p[r] *= w; den += p[r]; }
#pragma unroll
        for (int s = 0; s < 2; ++s) {
            v4u w4; w4.x = pk2(p[8 * s + 0], p[8 * s + 1]); w4.y = pk2(p[8 * s + 2], p[8 * s + 3]); w4.z = pk2(p[8 * s + 4], p[8 * s + 5]); w4.w = pk2(p[8 * s + 6], p[8 * s + 7]);
            const bf16x8 bfrag = __builtin_bit_cast(bf16x8, w4);
#pragma unroll
            for (int eb = 0; eb < 8; ++eb) { const bf16x8 a = trfrag(VL, VSTR, 32 * sb + 16 * s + 4 * hh, 32 * sb + 16 * s + 8 + 4 * hh, 32 * eb, lane);
                acc[eb] = __builtin_amdgcn_mfma_f32_32x32x16_bf16(a, bfrag, acc[eb], 0, 0, 0);
                if (eb & 1) { asm volatile("" ::: "memory"); } }
        }
    }
    den += shfl_xor_f(den, 32);
    { const float inv = 1.f / fmaxf(fabsf(den), em);
#pragma unroll
      for (int eb = 0; eb < 8; ++eb)
#pragma unroll
          for (int r = 0; r < 16; ++r) acc[eb][r] *= inv; }
    __syncthreads();
    LAS float* HS = (LAS float*)lds;
    if (dir == 1) {
#pragma unroll
        for (int eb = 0; eb < 8; ++eb)
#pragma unroll
            for (int r = 0; r < 16; ++r) HS[tau * 257 + 32 * eb + crow16(r, hh)] = acc[eb][r];
    }
    __syncthreads();
    if (dir == 0) {
#pragma unroll
        for (int eb = 0; eb < 8; ++eb)
#pragma unroll
            for (int r = 0; r < 16; ++r) HS[tau * 257 + 32 * eb + crow16(r, hh)] += acc[eb][r];
    }
    __syncthreads();
    {
        unsigned short og[16][4]; float gn[4];
#pragma unroll
        for (int rr = 0; rr < 16; ++rr)
#pragma unroll
            for (int k = 0; k < 4; ++k) og[rr][k] = Z[(size_t)MT * ZC_MO + (row0 + wave * 16 + rr) * 1024 + h * 256 + 64 * k + lane];
#pragma unroll
        for (int k = 0; k < 4; ++k) gn[k] = mng[h * 256 + 64 * k + lane];
#pragma unroll
        for (int rr = 0; rr < 16; ++rr) { const int t2 = wave * 16 + rr; float v[4]; float ss = 0.f;
#pragma unroll
            for (int k = 0; k < 4; ++k) { v[k] = HS[t2 * 257 + 64 * k + lane]; ss += v[k] * v[k]; }
            const float rstd = 1.f / sqrtf(wave_sum(ss) * (1.f / 256.f) + EPS); const size_t row = row0 + t2;
#pragma unroll
            for (int k = 0; k < 4; ++k) YB[row * 1024 + h * 256 + 64 * k + lane] = (bf16)f2bf(bf2f(og[rr][k]) * v[k] * rstd * gn[k]); }
    }
    __syncthreads();
}
__device__ __forceinline__ void gmlp_unit_mfma(const bf16* Z, const float* gng, const bf16* wsb  , const float* bs  , bf16* YA, int j, LAS unsigned char* lds, int tid) {
    asm volatile("" : "+v"(tid));
    const int wave = tid >> 6, lane = tid & 63, g = wave;
    LAS float* ST = (LAS float*)(lds + SM_OFF);
    LAS float* BSL = ST + 256;
    BSL[tid] = bs[tid]; BSL[tid + NTHR] = bs[tid + NTHR];
    LAS unsigned char* VN = lds + wave * 16384;
    const size_t row0 = (size_t)j * 128;
#pragma unroll 1
    for (int rb = 0; rb < 16; rb += 4) { v4u wq[4][2];
#pragma unroll
        for (int r4 = 0; r4 < 4; ++r4) { const v4u* zp = (const v4u*)(Z + (row0 + wave * 16 + rb + r4) * 2048 + 1024 + lane * 16); wq[r4][0] = zp[0]; wq[r4][1] = zp[1]; }
        asm volatile("" ::: "memory");
#pragma unroll
        for (int r4 = 0; r4 < 4; ++r4) { const int q = wave * 16 + rb + r4; const v4u w0 = wq[r4][0], w1 = wq[r4][1];
            float x[16]; const unsigned ww[8] = {w0.x, w0.y, w0.z, w0.w, w1.x, w1.y, w1.z, w1.w};
            float s = 0.f;
#pragma unroll
            for (int k = 0; k < 8; ++k) { x[2 * k] = bflo(ww[k]); x[2 * k + 1] = bfhi(ww[k]); s += x[2 * k] + x[2 * k + 1]; }
            const float mean = wave_sum(s) * (1.f / 1024.f); float s2 = 0.f;
#pragma unroll
            for (int k = 0; k < 16; ++k) { const float d = x[k] - mean; s2 += d * d; }
            const float rstd = 1.f / sqrtf(wave_sum(s2) * (1.f / 1024.f) + EPS);
            if (lane == 0) { ST[2 * q] = mean; ST[2 * q + 1] = rstd; } } }
    __syncthreads();
#pragma unroll 1
    for (int h = 0; h < 2; ++h) {
        const int ln = mk_lane_id(), hh = ln >> 5, l31 = ln & 31;
        const int cbase = g * 128 + 64 * h, c8 = (ln & 7) * 8;
        { const f32x4 g0 = *(const f32x4*)(gng + cbase + c8), g1 = *(const f32x4*)(gng + cbase + c8 + 4);
#pragma unroll 1
          for (int ib = 0; ib < 16; ib += 4) { v4u wv[4];
#pragma unroll
            for (int i4 = 0; i4 < 4; ++i4) wv[i4] = *(const v4u*)(Z + (row0 + (ib + i4) * 8 + (ln >> 3)) * 2048 + 1024 + cbase + c8);
            asm volatile("" ::: "memory");
#pragma unroll
            for (int i4 = 0; i4 < 4; ++i4) { const int q = (ib + i4) * 8 + (ln >> 3); const float mean = ST[2 * q], rstd = ST[2 * q + 1]; const v4u w = wv[i4]; v4u o;
              o.x = pk2((bflo(w.x) - mean) * rstd * g0.x, (bfhi(w.x) - mean) * rstd * g0.y); o.y = pk2((bflo(w.y) - mean) * rstd * g0.z, (bfhi(w.y) - mean) * rstd * g0.w);
              o.z = pk2((bflo(w.z) - mean) * rstd * g1.x, (bfhi(w.z) - mean) * rstd * g1.y); o.w = pk2((bflo(w.w) - mean) * rstd * g1.z, (bfhi(w.w) - mean) * rstd * g1.w);
              *(LAS v4u*)(VN + q * 128 + (ln & 7) * 16) = o; } } }
        LDS_WAIT(); asm volatile("" ::: "memory");
        bf16x8 bfr[8][2];
#pragma unroll
        for (int ks = 0; ks < 8; ++ks)
#pragma unroll
            for (int cb = 0; cb < 2; ++cb) bfr[ks][cb] = trfrag(VN, 128, 16 * ks + 8 * hh, 16 * ks + 8 * hh + 4, 32 * cb, ln);
        f32x16 acc[4][2];
#pragma unroll
        for (int pb = 0; pb < 4; ++pb)
#pragma unroll
            for (int cb = 0; cb < 2; ++cb)
#pragma unroll
                for (int r = 0; r < 16; ++r) acc[pb][cb][r] = 0.f;
#pragma unroll
        for (int pb = 0; pb < 4; ++pb) {
            bf16x8 af[8];
#pragma unroll
            for (int ks = 0; ks < 8; ++ks) af[ks] = *(const bf16x8*)(wsb + (size_t)(g * 128 + 32 * pb + l31) * 128 + 16 * ks + 8 * hh);
            asm volatile("" ::: "memory");
#pragma unroll
            for (int ks = 0; ks < 8; ++ks) { acc[pb][0] = __builtin_amdgcn_mfma_f32_32x32x16_bf16(af[ks], bfr[ks][0], acc[pb][0], 0, 0, 0); acc[pb][1] = __builtin_amdgcn_mfma_f32_32x32x16_bf16(af[ks], bfr[ks][1], acc[pb][1], 0, 0, 0); }
            asm volatile("" ::: "memory");
        }
        LDS_WAIT(); asm volatile("" ::: "memory");
#pragma unroll
        for (int pb = 0; pb < 4; ++pb)
#pragma unroll
            for (int q4 = 0; q4 < 4; ++q4) { const f32x4 b4 = *(const LAS f32x4*)(BSL + g * 128 + 32 * pb + 8 * q4 + 4 * hh);
#pragma unroll
                for (int i = 0; i < 4; ++i) { const int r = 4 * q4 + i, p = 32 * pb + 8 * q4 + 4 * hh + i;
#pragma unroll
                    for (int cb = 0; cb < 2; ++cb) *(LAS unsigned short*)(VN + p * 128 + (32 * cb + l31) * 2) = (unsigned short)f2bf(acc[pb][cb][r] + b4[i]); } }
        LDS_WAIT(); asm volatile("" ::: "memory");
#pragma unroll 1
        for (int ib = 0; ib < 16; ib += 4) { v4u uq[4];
#pragma unroll
            for (int i4 = 0; i4 < 4; ++i4) uq[i4] = *(const v4u*)(Z + (row0 + (ib + i4) * 8 + (ln >> 3)) * 2048 + cbase + c8);
            asm volatile("" ::: "memory");
#pragma unroll
            for (int i4 = 0; i4 < 4; ++i4) { const int p = (ib + i4) * 8 + (ln >> 3); const v4u m = *(const LAS v4u*)(VN + p * 128 + (ln & 7) * 16); const v4u u = uq[i4]; v4u o;
                o.x = pk2(bflo(u.x) * bflo(m.x), bfhi(u.x) * bfhi(m.x)); o.y = pk2(bflo(u.y) * bflo(m.y), bfhi(u.y) * bfhi(m.y));
                o.z = pk2(bflo(u.z) * bflo(m.z), bfhi(u.z) * bfhi(m.z)); o.w = pk2(bflo(u.w) * bflo(m.w), bfhi(u.w) * bfhi(m.w));
                *(v4u*)(YA + (row0 + p) * 1024 + cbase + c8) = o; } }
        LDS_WAIT(); asm volatile("" ::: "memory");
    }
    __syncthreads();
}

__device__ __forceinline__ void phase_post(const float* ATTO, const float* MLH, const bf16* Z, const float* dng, const float* mng, float lam, float linit, bf16* YB, bf16* YC, int bid, int G, int tid) {
    asm volatile("" : "+v"(tid));
    const int wave = tid >> 6, lane = tid & 63, head = lane >> 4, e0 = (lane & 15) * 16;
    for (int row = bid * NWAVES + wave; row < MT; row += G * NWAVES) {
        const size_t off = (size_t)row * 1024 + head * 256 + e0;
        {
            const f32x4* a0 = (const f32x4*)(ATTO + off); const f32x4* a1 = (const f32x4*)(ATTO + (size_t)MT * 1024 + off);
            float o[16]; float ss = 0.f;
#pragma unroll
            for (int k = 0; k < 4; ++k) { const f32x4 p = a0[k], q = a1[k];
                o[4 * k + 0] = p.x - lam * q.x; o[4 * k + 1] = p.y - lam * q.y; o[4 * k + 2] = p.z - lam * q.z; o[4 * k + 3] = p.w - lam * q.w; }
#pragma unroll
            for (int k = 0; k < 16; ++k) ss += o[k] * o[k];
            ss += shfl_xor_f(ss, 1); ss += shfl_xor_f(ss, 2); ss += shfl_xor_f(ss, 4); ss += shfl_xor_f(ss, 8);
            const float rstd = 1.f / sqrtf(ss * (1.f / 256.f) + EPS) * (1.f - linit);
            v4u w0, w1;
            w0.x = pk2(o[0] * rstd * dng[e0 + 0], o[1] * rstd * dng[e0 + 1]); w0.y = pk2(o[2] * rstd * dng[e0 + 2], o[3] * rstd * dng[e0 + 3]);
            w0.z = pk2(o[4] * rstd * dng[e0 + 4], o[5] * rstd * dng[e0 + 5]); w0.w = pk2(o[6] * rstd * dng[e0 + 6], o[7] * rstd * dng[e0 + 7]);
            w1.x = pk2(o[8] * rstd * dng[e0 + 8], o[9] * rstd * dng[e0 + 9]); w1.y = pk2(o[10] * rstd * dng[e0 + 10], o[11] * rstd * dng[e0 + 11]);
            w1.z = pk2(o[12] * rstd * dng[e0 + 12], o[13] * rstd * dng[e0 + 13]); w1.w = pk2(o[14] * rstd * dng[e0 + 14], o[15] * rstd * dng[e0 + 15]);
            v4u* yp = (v4u*)(YC + off); yp[0] = w0; yp[1] = w1;
        }
    }
}

struct Args { const float* in[21]; float* out; unsigned char* ws; int ph_lo, ph_hi; };
static_assert(sizeof(Args) == 21 * 8 + 8 + 8 + 8, "Args has no padding");

constexpr int T_ALL = -1, T_PRO0 = 0, T_PRO1 = 1, T_NORM = 2, T_W13 = 3, T_W2 = 4, T_N2 = 5, T_WIN = 6, T_ROPE = 7, T_MLSTM = 8, T_POST = 9, T_MERGE0 = 10, T_WOUT = 11, T_FINAL = 12, T_ATTN = 13, T_GMLP = 14, T_MERGE1 = 15, T_MERGE2 = 16, T_M3 = 17, NTYPES = 18;
#define SELD(t) (SEL == T_ALL || SEL == (t))
template <int SEL> __global__ void __launch_bounds__(NTHR, 2) mk_fwd(Args args) {
    extern __shared__ __attribute__((aligned(16))) unsigned char lds_raw[];
    LAS unsigned char* lds = (LAS unsigned char*)lds_raw;
    volatile LAS unsigned* MISC = (volatile LAS unsigned*)(lds + MISC_OFF);
    const int wave_s = __builtin_amdgcn_readfirstlane((int)threadIdx.x >> 6), bid_k = blockIdx.x, G = gridDim.x;
#define tid MK_TID(wave_s)
#define KARGS ((const __attribute__((address_space(4))) Args*)ka_)
#define PHASE_BEGIN const __attribute__((address_space(4))) void* ka_ = (const __attribute__((address_space(4))) void*)__builtin_amdgcn_kernarg_segment_ptr(); asm volatile("" : "+s"(ka_)); unsigned char* const ws = KARGS->ws; (void)ws; int bid = bid_k; asm volatile("" : "+s"(bid))
#define PIN(i) (KARGS->in[i])
#define XR ((float*)(ws + WS_XR))
#define H ((bf16*)(ws + WS_H))
#define GB ((bf16*)(ws + WS_GB))
#define Z ((bf16*)(ws + WS_Z))
#define ATTO ((float*)(ws + WS_ATTO))
#define MLH ((float*)(ws + WS_MLH))
#define DCT ((float*)(ws + WS_MLH))
#define YA ((bf16*)(ws + WS_YA))
#define YB ((bf16*)(ws + WS_YB))
#define YC ((bf16*)(ws + WS_YC))
#define SLAB ((float*)(ws + WS_SLAB))
#define YACC ((float*)(ws + WS_YACC))
#define Y ((bf16*)(ws + WS_Y))
#define G16 ((float*)(ws + WS_G16))
#define MOD ((const float*)(ws + WS_MOD))
#define CTS ((bf16*)(ws + WS_CT))
#define DNS ((float*)(ws + WS_MSM))
#define NSS (DNS + 8 * 66 * 128)
#define CHS (NSS + 8 * 66 * 128)
#define MSS (CHS + 8 * 66 * 2)
#define modl (MOD + (size_t)(l * 2 + 0) * NMOD)
#define modc (MOD + (size_t)(l * 2 + 1) * NMOD)
#define W13T0 ((const bf16*)(ws + WS_W13T) + (size_t)(l * 2 + 0) * 8192 * 4096)
#define W13T1 (W13T0 + (size_t)8192 * 4096)
#define W2T0 ((const bf16*)(ws + WS_W2T) + (size_t)(l * 2 + 0) * 4096 * 4096)
#define W2T1 (W2T0 + (size_t)4096 * 4096)
#define WINT ((const bf16*)(ws + WS_WINT) + (size_t)l * NZ * 4096)
#define WBT ((const bf16*)(ws + WS_WBT) + (size_t)(l * 3) * 4096 * 1024)
#define WOT ((const bf16*)(ws + WS_WOT) + (size_t)l * 4096 * 4096)
#define MKP() Ptrs P; P.x = PIN(0); P.c = PIN(1); P.ctx = PIN(2); P.c_ctx = PIN(3); P.ada_down = PIN(4); P.ada_up = PIN(5); P.ada_bias = PIN(6); P.norm_g = PIN(7); \
    P.w13 = PIN(8); P.w2 = PIN(9); P.w_in = PIN(10); P.gmlp_norm_g = PIN(11); P.gmlp_ws = PIN(12); P.gmlp_bs = PIN(13); P.gate_b = PIN(14); \
    P.mlstm_norm_g = PIN(15); P.diff_lambda = PIN(16); P.diff_norm_g = PIN(17); P.w_branch = PIN(18); P.w_out = PIN(19); P.final_g = PIN(20); P.out = KARGS->out; P.ws = KARGS->ws
    for (int u = tid; u < (LDS_BYTES - LDSCTL_OFF) / 4; u += NTHR) ((LAS unsigned*)(lds + LDSCTL_OFF))[u] = 0u;
    __syncthreads();
#if MK_ONE_LAUNCH
    XcdBarrier bar = xcd_barrier_post((unsigned*)((gu32*)(args.ws + WS_CTL) + CW_BAR), MISC + 8, tid);
#define GRID_BAR() do { XcdBarrier b2_ = bar; asm volatile("" : "+s"(b2_.bar)); xcd_barrier(b2_, tid); } while (0)
#else
#define GRID_BAR() do {} while (0)
#endif
    const int lo = args.ph_lo, hi = args.ph_hi;
#define IN(k) (lo <= (k) && (k) < hi)
#define SEAM(k) do { if (IN(k) && IN((k) + 1)) GRID_BAR(); } while (0)

    if (IN(P_PRO0)) { PHASE_BEGIN; MKP(); for (int rep_ = 0; rep_ < DBL_PRO; ++rep_) pro0(P, lds, bid, G, tid); SEAM(P_PRO0); }
    if (IN(P_PRO1)) { PHASE_BEGIN; MKP(); pro1(P, lds, bid, G, tid); SEAM(P_PRO1); }

    for (int l = 0; l < DEPTH; ++l) {
        const int pb = P_LAYER0 + l * NPL;
        if (hi <= pb || lo >= pb + NPL) continue;
#define GEMM_RESID_SPLIT2(Aptr, Bptr, gate_l, fac, ms3, yc, nctx_) do { \
            { pg8::Gemm g{(Aptr) + (size_t)CTXL * DM, (Bptr), SEQ, DM, DM, DM}; pg8::StaticOrder S; S.init(SEQ, DM, G, bid); pg8::EpiResid E{XR + (size_t)CTXL * DM, (gate_l), (gate_l), XR + (size_t)CTXL * DM, (fac)}; \
              pg8::gemm_phase<pg8::EpiResid, pg8::StaticOrder, true, true>(lds + RING_OFF, g, S, E, wave_s); } \
            { pg8::Gemm g{(Aptr), (Bptr), CTXL, DM, 256, DM}; pg8::CtxSplitOrder S{bid, G, (nctx_), (ms3), (yc), wave_s}; pg8::EpiSlab E{SLAB}; \
              pg8::gemm_phase<pg8::EpiSlab, pg8::CtxSplitOrder, true, true>(lds + RING_OFF, g, S, E, wave_s); } } while (0)
#define GEMM_RESID_SPLIT(Aptr, Bptr, gate_l, fac, ms3, yc, nctx_, xb_) do { \
            pg8::Gemm g{(Aptr), (Bptr), MT, DM, DM, DM}; pg8::ResidOrder S; S.lat.init(SEQ, DM, G, bid); S.c = bid; S.G = G; S.n = (nctx_); \
            pg8::EpiResidSlab E{ws, (gate_l), (xb_), (fac)}; \
            pg8::gemm_phase<pg8::EpiResidSlab, pg8::ResidOrder, true, true>(lds + RING_OFF, g, S, E, wave_s); } while (0)
#define GL (G >= 128 ? G - (G >> 4) : G)
#define NC (G - GL)
#define GEMM_LAT(EPI, GW_, Aptr, Bptr, Ncols, Kdim, ...) do { pg8::Gemm g{(Aptr), (Bptr), MT, (Ncols), (Kdim), (Kdim)}; pg8::StaticOrder S; S.init(MT, (Ncols), (GW_), bid); EPI E{__VA_ARGS__}; \
            pg8::gemm_phase<EPI, pg8::StaticOrder, true, true>(lds + RING_OFF, g, S, E, wave_s); } while (0)

        if (IN(pb + L_N1)) { PHASE_BEGIN; MKP(); phase_norm(XR, l == 0 ? P.x - (size_t)CTXL * DM : (const float*)XR, l == 0 ? P.ctx : (const float*)XR, XR, P.norm_g + (size_t)(l * 3 + 0) * DM, modl + 0 * 3 * DM, modc + 0 * 3 * DM, H, l > 0 ? SLAB : nullptr, modc - (size_t)2 * NMOD + 2 * 3 * DM + 2 * DM, 0.5f, lds, bid, G, tid); SEAM(pb + L_N1); }
        if (IN(pb + L_W13A)) { PHASE_BEGIN; MKP();
            if (bid < GL) { GEMM_LAT(pg8::EpiSwiglu, GL, H, W13T0, 8192, DM, GB, FFND);
                            convert_idle(P, l, 1, CVD, CVS, (MT / 256 * 32) % GL, GL, lds, bid, tid); }
            if (NC == 0 || bid >= GL) convert_part(P, l, 1, 0, CVD, NC ? bid - GL : bid, NC ? NC : G, lds, tid);
            SEAM(pb + L_W13A); }
        if (IN(pb + L_W2A)) { PHASE_BEGIN; MKP();
            GEMM_RESID_SPLIT(GB, W2T0, modl + 0 * 3 * DM + 2 * DM, 0.5f, (const float*)nullptr, (bf16*)nullptr, 256, l == 0 ? P.x - (size_t)CTXL * DM : (const float*)XR);
            SEAM(pb + L_W2A); }
        if (IN(pb + L_N2)) { PHASE_BEGIN; MKP(); phase_norm(XR, XR, XR, l == 0 ? P.ctx : (const float*)XR, P.norm_g + (size_t)(l * 3 + 1) * DM, modl + 1 * 3 * DM, modc + 1 * 3 * DM, H, SLAB, modc + 0 * 3 * DM + 2 * DM, 0.5f, lds, bid, G, tid); SEAM(pb + L_N2); }
        if (IN(pb + L_WIN)) { PHASE_BEGIN; MKP();
            if (bid < GL) { GEMM_LAT(pg8::EpiWin, GL, H, WINT, NZ, DM, Z, (const float*)(ws + WS_ROPE), (const float*)(ws + WS_ROPE) + SEQ * 64); }
            if (NC == 0 || bid >= GL) { convert_part(P, l, 1, CVS, NL, NC ? bid - GL : bid, NC ? NC : G, lds, tid);
                for (int u = NC ? bid - GL : bid; u < 66; u += (NC ? NC : G)) gates_unit(H, (const bf16*)(ws + WS_WG16) + (size_t)l * 16 * DM, G16, u, tid); }
            SEAM(pb + L_WIN); }
        if (IN(pb + L_MIX1)) { PHASE_BEGIN; MKP();
            for (int rep_ = 0; rep_ < DBL_M1; ++rep_) for (int u = (bid + G - (100 % G)) % G; u < 264; u += G) mlstm_m1_unit(Z, G16, P.gate_b + (size_t)l * 16, DCT, DNS, CHS, u >> 2, u & 3, lds, tid);
            for (int rep_ = 0; rep_ < DBL_ATTN; ++rep_) for (int u = bid; u < (l < DEPTH - 1 ? 264 : 256); u += G) {
                int hm, qb, seq; if (u < 256) { hm = u & 7; qb = 1 + (u >> 3); seq = MT; } else { hm = u - 256; qb = 0; seq = CTXL; }
                const int h = hm >> 1, mm = hm & 1;
                const attn128::bf16* Zb = (const attn128::bf16*)Z;
                attn256::attn_o256_body(Zb + (size_t)MT * ZC_AQ + (size_t)(qb * 256) * 1024 + h * 256 + mm * 128, Zb + (size_t)MT * ZC_AK + h * 256 + mm * 128, Zb + (size_t)MT * ZC_AV + h * 256,
                                        ATTO + (size_t)mm * MT * 1024 + (size_t)(qb * 256) * 1024 + h * 256, seq, (char*)lds_raw, wave_s);
                __syncthreads();
            }
            SEAM(pb + L_MIX1);
        }
        if (IN(pb + L_POST)) { PHASE_BEGIN; MKP();
            for (int rep_ = 0; rep_ < DBL_POST; ++rep_) { mlstm_m2(DCT, DNS, CHS, CTS, NSS, MSS, lds, bid, G, tid); } SEAM(pb + L_POST); }
        if (IN(pb + L_M3)) { PHASE_BEGIN; MKP();
            { const int u0 = (l < DEPTH - 1) ? 0 : 8, nsec = (l < DEPTH - 1) ? (264 - G > 0 ? 264 - G : 0) : 0;
              for (int rep_ = 0; rep_ < DBL_M3; ++rep_) for (int u = u0 + bid; u < 264; u += G) mlstm_m3_unit(Z, G16, P.gate_b + (size_t)l * 16, CTS, NSS, MSS, P.mlstm_norm_g + (size_t)l * 1024, YB, u >> 2, u & 3, lds, tid);
              const int ngm = (G >= 66 + nsec + 8) ? 66 : 0;
              for (int rep_ = 0; rep_ < DBL_GMLP; ++rep_) for (int u = G - 1 - bid; u < 66; u += G) gmlp_unit_mfma(Z, P.gmlp_norm_g + (size_t)l * 1024, (const bf16*)(ws + WS_GWSB) + (size_t)l * 8 * 128 * 128, P.gmlp_bs + (size_t)l * 8 * 128, YA, u, lds, tid);
              if (bid >= nsec && bid < G - ngm) phase_post(ATTO, MLH, Z, P.diff_norm_g + (size_t)l * 256, P.mlstm_norm_g + (size_t)l * 1024, ((const float*)(ws + WS_LAM))[l], lambda_init_f(l), YB, YC, bid - nsec, G - ngm - nsec, tid); }
            SEAM(pb + L_M3); }
        if (IN(pb + L_MERGE)) { PHASE_BEGIN; MKP();
            { pg8::Gemm g{YA, WBT, MT, DM, 1024, 1024}; pg8::MergeOrder S; S.lat.init(SEQ, DM, G, bid); S.c = bid; S.G = G; S.nctx = (l < DEPTH - 1) ? 48 : 0; pg8::EpiMergeSeg E{Z, Y, (float*)(ws + WS_MS3)};
              pg8::gemm_phase<pg8::EpiMergeSeg, pg8::MergeOrder, true, true>(lds + RING_OFF, g, S, E, wave_s); }
            SEAM(pb + L_MERGE); }
        if (IN(pb + L_WOUT)) { PHASE_BEGIN; MKP();
            GEMM_RESID_SPLIT2(Y, WOT, modl + 1 * 3 * DM + 2 * DM, 1.f, (const float*)(ws + WS_MS3), Y, (l < DEPTH - 1) ? 256 : 0);
            SEAM(pb + L_WOUT); }
        if (IN(pb + L_N3)) { PHASE_BEGIN; MKP(); phase_norm(XR, XR, XR, XR, P.norm_g + (size_t)(l * 3 + 2) * DM, modl + 2 * 3 * DM, modc + 2 * 3 * DM, H, SLAB, modc + 1 * 3 * DM + 2 * DM, 1.f, lds, bid, G, tid); SEAM(pb + L_N3); }
        if (IN(pb + L_W13B)) { PHASE_BEGIN; MKP();
            { const int skip = (l < DEPTH - 1) ? 0 : CTXL;
              const int GLb = (l < DEPTH - 1) ? GL : G;
              if (bid < GLb) { pg8::Gemm g{H + (size_t)skip * DM, W13T1, MT - skip, 8192, DM, DM}; pg8::StaticOrder S; S.init(MT - skip, 8192, GLb, bid); pg8::EpiSwiglu E{GB + (size_t)skip * FFND, FFND};
                  pg8::gemm_phase<pg8::EpiSwiglu, pg8::StaticOrder, true, true>(lds + RING_OFF, g, S, E, wave_s);
                  convert_idle(P, l + 1, 0, CVD, CVS, (MT / 256 * 32) % GL, GL, lds, bid, tid); }
              if (NC == 0 || bid >= GL) convert_part(P, l + 1, 0, 0, CVD, NC ? bid - GL : bid, NC ? NC : G, lds, tid); }
            SEAM(pb + L_W13B); }
        if (IN(pb + L_W2B)) { PHASE_BEGIN; MKP();
            GEMM_RESID_SPLIT(GB, W2T1, modl + 2 * 3 * DM + 2 * DM, 0.5f, (const float*)nullptr, (bf16*)nullptr, (l < DEPTH - 1) ? 256 : 0, (const float*)XR);
            SEAM(pb + L_W2B); }
#undef GEMM_LAT
#undef GL
#undef NC
#undef GEMM_RESID_SPLIT
#undef GEMM_RESID_SPLIT2
    }
    if (IN(P_FINAL)) { PHASE_BEGIN; MKP(); phase_final(XR, P.final_g, P.out, bid, G, tid); }
#undef IN
#undef SEAM
#undef tid
#undef XR
#undef H
#undef GB
#undef Z
#undef ATTO
#undef MLH
#undef DCT
#undef YA
#undef YB
#undef YC
#undef SLAB
#undef YACC
#undef Y
#undef G16
#undef MOD
#undef CTS
#undef DNS
#undef NSS
#undef CHS
#undef MSS
#undef modl
#undef modc
#undef W13T0
#undef W13T1
#undef W2T0
#undef W2T1
#undef WINT
#undef WBT
#undef WOT
}

extern "C" void kernel_launch(void* const* d_in, const int* in_sizes, int n_in, void* d_out, int out_size, void* d_ws, size_t ws_size, hipStream_t stream) {
    static int grid = 0;
    if (grid == 0) {
        if (n_in != 21 || in_sizes[0] != SEQ * DM || out_size != SEQ * DM || ws_size < WS_END) {
            fprintf(stderr, "kernel_launch: unexpected shapes: n_in %d in0 %d out %d ws %zu (need %zu)\n", n_in, n_in > 0 ? in_sizes[0] : -1, out_size, ws_size, (size_t)WS_END); grid = -1; return; }
        int dev = 0, cus = 0;
        if (hipGetDevice(&dev) != hipSuccess || hipDeviceGetAttribute(&cus, hipDeviceAttributeMultiprocessorCount, dev) != hipSuccess) { grid = -1; return; }
        if (hipFuncSetAttribute((const void*)mk_fwd<T_ALL>, hipFuncAttributeMaxDynamicSharedMemorySize, LDS_BYTES) != hipSuccess) { fprintf(stderr, "kernel_launch: hipFuncSetAttribute failed\n"); grid = -1; return; }
        (void)hipGetLastError();
        grid = cus;
    }
    if (grid < 0) return;
    (void)hipMemsetAsync((char*)d_ws + WS_CTL, 0, CTL_ZERO_BYTES, stream);
    Args a{};
    for (int i = 0; i < 21; ++i) a.in[i] = (const float*)d_in[i];
    a.out = (float*)d_out; a.ws = (unsigned char*)d_ws;
#if MK_ONE_LAUNCH
    a.ph_lo = 0; a.ph_hi = NPH;
    hipLaunchKernelGGL(mk_fwd<T_ALL>, dim3(grid), dim3(NTHR), LDS_BYTES, stream, a);
#else
    for (int p = 0; p < NPH; ++p) { a.ph_lo = p; a.ph_hi = p + 1; hipLaunchKernelGGL(mk_fwd<T_ALL>, dim3(grid), dim3(NTHR), LDS_BYTES, stream, a); }
#endif
    const hipError_t le = hipPeekAtLastError();
    if (le != hipSuccess) fprintf(stderr, "kernel_launch: launch failed: %s\n", hipGetErrorName(le));
}
```

```cpp
#include <hip/hip_runtime.h>
#include <hip/hip_bf16.h>
#include <cstdio>
#include <cstdint>
#include <cmath>
#ifndef MLSTM_CHUNKWISE
#define MLSTM_CHUNKWISE 1
#endif
#ifndef MK_ONE_LAUNCH
#define MK_ONE_LAUNCH 1
#endif
#ifndef DBL_ATTN
#define DBL_ATTN 1
#endif
#ifndef DBL_PRO
#define DBL_PRO 1
#endif
#ifndef DBL_M1
#define DBL_M1 1
#endif
#ifndef DBL_GMLP
#define DBL_GMLP 1
#endif
#ifndef DBL_POST
#define DBL_POST 1
#endif
#ifndef DBL_M3
#define DBL_M3 1
#endif
#ifndef DBL_NORM
#define DBL_NORM 1
#endif
__device__ __forceinline__ int mk_lane_id() { int l_; asm volatile("v_mbcnt_lo_u32_b32 %0, -1, 0\n\tv_mbcnt_hi_u32_b32 %0, -1, %0" : "=v"(l_)); return l_; }
#define MK_TID(wave_s_) (((wave_s_) << 6) | mk_lane_id())
namespace pg8 {
#define PG8_LAS __attribute__((address_space(3)))
typedef unsigned short bf16_t;
typedef short bf16x8 __attribute__((ext_vector_type(8)));
typedef float f32x4 __attribute__((ext_vector_type(4)));
typedef unsigned u32x4 __attribute__((ext_vector_type(4)));
constexpr int BM = 256, BK = 64, HALF = 128, HTB = HALF * BK * 2  , STAGE_BYTES = 8 * HTB, NXCD = 8, WGM = 8;

__host__ __device__ __forceinline__ int lds_byte(int r, int c) { const int st = (r >> 4) * 2 + (c >> 5), rr = r & 15, cc = c & 31, ob = rr * 64 + cc * 2; return st * 1024 + (ob ^ (((ob >> 9) & 1) << 5)); }
__host__ __device__ __forceinline__ void stage_rc(int b, int& R, int& C) { const int st = b / 1024, sb = b % 1024, swz = sb ^ (((sb >> 9) & 1) << 5); R = (st >> 1) * 16 + swz / 64; C = (st & 1) * 32 + (swz % 64) / 2; }
__host__ __device__ __forceinline__ int perm32(int rho) { const int n = rho >> 4, i = rho & 15; return 8 * (i >> 2) + 4 * n + (i & 3); }

struct Unit { int pm, pn, koff, boff, fl;
    __device__ __forceinline__ int seg() const { return fl & 3; } __device__ __forceinline__ bool carry() const { return (fl & 4) != 0; } __device__ __forceinline__ int ntile() const { return fl >> 8; } };
struct Gemm { const bf16_t* A; const bf16_t* Bt; int M, N, K, ld; };

struct StaticOrder {
    int nM, nN, nwg, G, c;
    __host__ __device__ void init(int M, int N, int G_, int c_) { nM = M / BM; nN = N / BM; nwg = nM * nN; G = G_; c = c_; }
    __host__ __device__ bool next(int i, Unit& u) const {
        const long L = (long)i * G + c; if (L >= nwg) return false;
        int wgid = (int)L; { const int q = nwg / NXCD, r = nwg % NXCD, xcd = wgid % NXCD, off = wgid / NXCD; wgid = (xcd < r ? xcd * (q + 1) : r * (q + 1) + (xcd - r) * q) + off; }
        const int nig = WGM * nN, gid = wgid / nig, fm = gid * WGM, gsz = (nM - fm) < WGM ? (nM - fm) : WGM;
        u.pm = fm + ((wgid % nig) % gsz); u.pn = (wgid % nig) / gsz; u.koff = 0; u.boff = 0; u.fl = 0; return true;
    }
    __device__ __forceinline__ void a_ready(const Unit&) const {}
    __device__ __forceinline__ void done(const Unit&) const {}
};

__device__ __forceinline__ unsigned cvt_pk_bf16(float lo, float hi) { unsigned r; asm volatile("v_cvt_pk_bf16_f32 %0, %1, %2" : "=v"(r) : "v"(lo), "v"(hi)); return r; }
typedef float f32x2 __attribute__((ext_vector_type(2)));
__device__ __forceinline__ f32x2 gelu_pk(f32x2 v) {
    const f32x2 av = __builtin_elementwise_abs(v), d = av * 0.2316418882f + 1.0f;
    f32x2 t; t.x = __builtin_amdgcn_rcpf(d.x); t.y = __builtin_amdgcn_rcpf(d.y);
    f32x2 q = t * 0.5307027145f + (-0.7265760135f); q = q * t + 0.7107068705f; q = q * t + (-0.142248368f); q = q * t + 0.127414796f; q = q * t;
    const f32x2 s = (v * v) * (-0.72134752044f);
    f32x2 e; e.x = __builtin_amdgcn_exp2f(s.x); e.y = __builtin_amdgcn_exp2f(s.y);
    const f32x2 m = v * (q * e), r = v - m;
    f32x2 o; o.x = v.x < 0.f ? m.x : r.x; o.y = v.y < 0.f ? m.y : r.y; return o;
}

template <int ACT  > struct EpiBf16 {
    static constexpr bool PERM = true, AFTER_DRAIN = false; static_assert(ACT == 0 || ACT == 1, "EpiBf16: ACT is 0 (none) or 1 (gelu_pk)");
    bf16_t* O; int ldc; const float* bias; int split_cols; size_t split_stride; float scale0;
    __device__ __forceinline__ void operator()(const f32x4 (&acc)[2][2][4][2], const Unit& u, int wr, int wc, int fr, int fq) const {
        const int row0 = u.pm * BM + wr * 64 + fr; int colt = u.pn * BM; bf16_t* base = O;
        float sc = 1.f; if (split_cols) { const int t = colt / split_cols; base += (size_t)t * split_stride; colt -= t * split_cols; if (t == 0) sc = scale0; }
        const int col0 = colt + wc * 32 + 8 * fq, bcol0 = u.pn * BM + wc * 32 + 8 * fq;
        f32x4 bv[2][2];
#pragma unroll
        for (int bj = 0; bj < 2; ++bj)
#pragma unroll
            for (int n = 0; n < 2; ++n) bv[bj][n] = bias ? *(const f32x4*)(bias + bcol0 + bj * HALF + 4 * n) : (f32x4){0.f, 0.f, 0.f, 0.f};
#pragma unroll
        for (int ai = 0; ai < 2; ++ai)
#pragma unroll
            for (int m = 0; m < 4; ++m) { bf16_t* rowp = base + (size_t)(row0 + ai * HALF + m * 16) * ldc + col0;
#pragma unroll
                for (int bj = 0; bj < 2; ++bj) { f32x4 v0 = acc[ai][bj][m][0] + bv[bj][0], v1 = acc[ai][bj][m][1] + bv[bj][1];
                    if (ACT == 1) { f32x2 a = gelu_pk((f32x2){v0[0], v0[1]}), b = gelu_pk((f32x2){v0[2], v0[3]}), c = gelu_pk((f32x2){v1[0], v1[1]}), d = gelu_pk((f32x2){v1[2], v1[3]});
                        v0 = (f32x4){a.x, a.y, b.x, b.y}; v1 = (f32x4){c.x, c.y, d.x, d.y}; }
                    v0 = v0 * sc; v1 = v1 * sc; u32x4 w; w.x = cvt_pk_bf16(v0[0], v0[1]); w.y = cvt_pk_bf16(v0[2], v0[3]); w.z = cvt_pk_bf16(v1[0], v1[1]); w.w = cvt_pk_bf16(v1[2], v1[3]);
                    *(u32x4*)(rowp + bj * HALF) = w; } }
    }
};

struct PanelStats {
    unsigned* xbuf;
    unsigned* cnt;
    unsigned* tmo;
    int ntn; float eps;
    unsigned code;
    __device__ __forceinline__ bool run(const f32x4 (&v)[2][2][4][2], const Unit& u, int wr, int wc, int fr, int fq, PG8_LAS unsigned char* lds, int wid, int lane) const {
        typedef float f32x2v __attribute__((ext_vector_type(2)));
        PG8_LAS f32x2v* P = (PG8_LAS f32x2v*)lds;
        PG8_LAS f32x2v* S = (PG8_LAS f32x2v*)(lds + 8192);
        PG8_LAS unsigned* flag = (PG8_LAS unsigned*)(lds + 8192 + 2048);
#pragma unroll
        for (int ai = 0; ai < 2; ++ai)
#pragma unroll
            for (int m = 0; m < 4; ++m) {
                float s = 0.f;
#pragma unroll
                for (int bj = 0; bj < 2; ++bj)
#pragma unroll
                    for (int n = 0; n < 2; ++n) { const f32x4 x = v[ai][bj][m][n]; s += (x[0] + x[1]) + (x[2] + x[3]); }
                s += __shfl_xor(s, 16); s += __shfl_xor(s, 32);
                const float mw = s * (1.0f / 64.0f); float q = 0.f;
#pragma unroll
                for (int bj = 0; bj < 2; ++bj)
#pragma unroll
                    for (int n = 0; n < 2; ++n) { const f32x4 d = v[ai][bj][m][n] - mw; q += (d[0] * d[0] + d[1] * d[1]) + (d[2] * d[2] + d[3] * d[3]); }
                q += __shfl_xor(q, 16); q += __shfl_xor(q, 32);
                if (fq == 0) P[(ai * HALF + wr * 64 + m * 16 + fr) * 4 + wc] = (f32x2v){mw, q};
            }
        asm volatile("s_waitcnt lgkmcnt(0)" ::: "memory"); __builtin_amdgcn_s_barrier(); asm volatile("" ::: "memory");
#if defined(BROKEN_EXCHANGE_NO_WAIT)
#warning BROKEN CONTROL BUILD: the row-statistics exchange does not wait; results are wrong by design
        if (blockIdx.x >= 64) { const long long t0_ = clock64(); while (clock64() - t0_ < 60000) __builtin_amdgcn_s_sleep(8); }
#endif
        const int row = wid * 32 + (lane & 31);
        if (lane < 32) {
            const f32x2v a = P[row * 4 + 0], b = P[row * 4 + 1], c = P[row * 4 + 2], d = P[row * 4 + 3];
            const float mt = (a.x + b.x + c.x + d.x) * 0.25f;
            const float da = a.x - mt, db = b.x - mt, dc = c.x - mt, dd = d.x - mt;
            const float m2 = (a.y + b.y) + (c.y + d.y) + 64.0f * ((da * da + db * db) + (dc * dc + dd * dd));
            unsigned long long* slot = (unsigned long long*)xbuf + ((size_t)(u.pm * BM + row) * 4 + u.pn);
            __hip_atomic_store(slot, ((unsigned long long)__float_as_uint(m2) << 32) | __float_as_uint(mt), __ATOMIC_RELAXED, __HIP_MEMORY_SCOPE_AGENT);
        }
        asm volatile("s_waitcnt vmcnt(0)" ::: "memory");
        if (lane == 0) __hip_atomic_fetch_add(cnt + 64 * u.pm, 1u, __ATOMIC_RELAXED, __HIP_MEMORY_SCOPE_AGENT);
        if (wid == 0) {
            bool dead = false; const unsigned long long t0 = __builtin_amdgcn_s_memrealtime(); const unsigned want = 8u * (unsigned)ntn;
            for (;;) {
#if defined(BROKEN_EXCHANGE_NO_WAIT)
                break;
#endif
                if ((unsigned)__builtin_amdgcn_readfirstlane(__hip_atomic_load(cnt + 64 * u.pm, __ATOMIC_RELAXED, __HIP_MEMORY_SCOPE_AGENT)) >= want) break;
                if (__builtin_amdgcn_s_memrealtime() - t0 > 2000000ull) {
                    if (lane == 0) { unsigned expect = 0u; __hip_atomic_compare_exchange_strong(tmo + 1, &expect, code | (unsigned)(u.pm & 0xff), __ATOMIC_RELAXED, __ATOMIC_RELAXED, __HIP_MEMORY_SCOPE_AGENT);
                                     __hip_atomic_store(tmo, 1u, __ATOMIC_RELAXED, __HIP_MEMORY_SCOPE_AGENT); }
                    dead = true; break; }
                __builtin_amdgcn_s_sleep(2);
            }
            __builtin_amdgcn_fence(__ATOMIC_ACQUIRE, "agent");
            if (lane == 0) flag[0] = dead ? 1u : 0u;
        }
        asm volatile("s_waitcnt vmcnt(0) lgkmcnt(0)" ::: "memory"); __builtin_amdgcn_s_barrier(); asm volatile("" ::: "memory");
        const bool bad = flag[0] != 0u;
        if (lane < 32) {
            const unsigned long long* slot = (const unsigned long long*)xbuf + (size_t)(u.pm * BM + row) * 4; float mt[4], m2[4]; float ms = 0.f;
#pragma unroll
            for (int t = 0; t < 4; ++t) { if (t < ntn) { const unsigned long long w = __hip_atomic_load(slot + t, __ATOMIC_RELAXED, __HIP_MEMORY_SCOPE_AGENT); mt[t] = __uint_as_float((unsigned)w); m2[t] = __uint_as_float((unsigned)(w >> 32)); } else { mt[t] = 0.f; m2[t] = 0.f; } ms += mt[t]; }
            const float mean = ms / (float)ntn; float q = 0.f;
#pragma unroll
            for (int t = 0; t < 4; ++t) if (t < ntn) { const float dm = mt[t] - mean; q += m2[t] + 256.0f * dm * dm; }
            S[row] = (f32x2v){mean, 1.0f / sqrtf(q / (256.0f * (float)ntn) + eps)};
        }
        asm volatile("s_waitcnt lgkmcnt(0)" ::: "memory"); __builtin_amdgcn_s_barrier(); asm volatile("" ::: "memory");
        return bad;
    }
};
struct EpiLnRes {
    static constexpr bool PERM = false, AFTER_DRAIN = true;
    const float* base; float* out; int ldc; const float* bias; PanelStats st; unsigned poison;
    __device__ __forceinline__ void fused(f32x4 (&acc)[2][2][4][2], const Unit& u, int wr, int wc, int fr, int fq, PG8_LAS unsigned char* lds, int wid, int lane) const {
        typedef float f32x2v __attribute__((ext_vector_type(2)));
        const PG8_LAS f32x2v* S = (const PG8_LAS f32x2v*)(lds + 8192);
        const int col0 = u.pn * BM + wc * 32 + 4 * fq;
#pragma unroll
        for (int bj = 0; bj < 2; ++bj)
#pragma unroll
            for (int n = 0; n < 2; ++n) { const f32x4 bv = bias ? *(const f32x4*)(bias + col0 + bj * HALF + n * 16) : (f32x4){0.f, 0.f, 0.f, 0.f};
#pragma unroll
                for (int ai = 0; ai < 2; ++ai)
#pragma unroll
                    for (int m = 0; m < 4; ++m) acc[ai][bj][m][n] += bv; }
        f32x4 pre[4][2][2];
#pragma unroll
        for (int m = 0; m < 4; ++m) { const size_t off = (size_t)(u.pm * BM + wr * 64 + m * 16 + fr) * ldc + col0;
#pragma unroll
            for (int bj = 0; bj < 2; ++bj)
#pragma unroll
                for (int n = 0; n < 2; ++n) pre[m][bj][n] = *(const f32x4*)(base + off + bj * HALF + n * 16); }
        const bool bad = st.run(acc, u, wr, wc, fr, fq, lds, wid, lane) || poison != 0u;
        const float qnan = __builtin_nanf("");
#pragma unroll
        for (int ai = 0; ai < 2; ++ai)
#pragma unroll
            for (int m = 0; m < 4; ++m) { const int r = ai * HALF + wr * 64 + m * 16 + fr; const f32x2v sr = S[r]; const size_t off = (size_t)(u.pm * BM + r) * ldc + col0;
#pragma unroll
                for (int bj = 0; bj < 2; ++bj)
#pragma unroll
                    for (int n = 0; n < 2; ++n) { const f32x4 bs = ai == 0 ? pre[m][bj][n] : *(const f32x4*)(base + off + bj * HALF + n * 16); f32x4 o = bs + (acc[ai][bj][m][n] - sr.x) * sr.y;
                        if (bad) o = (f32x4){qnan, qnan, qnan, qnan}; *(f32x4*)(out + off + bj * HALF + n * 16) = o; }
                if (m & 1) asm volatile("" ::: "memory"); }
    }
};
struct EpiLnResLn {
    static constexpr bool PERM = false, AFTER_DRAIN = true;
    const float* base; float* out; bf16_t* xn; int ldc; const float* bias; PanelStats st1, st2; unsigned poison;
    __device__ __forceinline__ void fused(f32x4 (&acc)[2][2][4][2], const Unit& u, int wr, int wc, int fr, int fq, PG8_LAS unsigned char* lds, int wid, int lane) const {
        typedef float f32x2v __attribute__((ext_vector_type(2))); typedef unsigned u32x2v __attribute__((ext_vector_type(2)));
        const PG8_LAS f32x2v* S = (const PG8_LAS f32x2v*)(lds + 8192);
        const int col0 = u.pn * BM + wc * 32 + 4 * fq;
#pragma unroll
        for (int bj = 0; bj < 2; ++bj)
#pragma unroll
            for (int n = 0; n < 2; ++n) { const f32x4 bv = bias ? *(const f32x4*)(bias + col0 + bj * HALF + n * 16) : (f32x4){0.f, 0.f, 0.f, 0.f};
#pragma unroll
                for (int ai = 0; ai < 2; ++ai)
#pragma unroll
                    for (int m = 0; m < 4; ++m) acc[ai][bj][m][n] += bv; }
        bool bad = st1.run(acc, u, wr, wc, fr, fq, lds, wid, lane) || poison != 0u;
        const float qnan = __builtin_nanf("");
#pragma unroll
        for (int ai = 0; ai < 2; ++ai)
#pragma unroll
            for (int m = 0; m < 4; ++m) { const int r = ai * HALF + wr * 64 + m * 16 + fr; const f32x2v sr = S[r]; const size_t off = (size_t)(u.pm * BM + r) * ldc + col0;
#pragma unroll
                for (int bj = 0; bj < 2; ++bj)
#pragma unroll
                    for (int n = 0; n < 2; ++n) { const f32x4 bs = *(const f32x4*)(base + off + bj * HALF + n * 16); acc[ai][bj][m][n] = bs + (acc[ai][bj][m][n] - sr.x) * sr.y; }
                asm volatile("" : "+v"(acc[ai][0][m][0]), "+v"(acc[ai][0][m][1]), "+v"(acc[ai][1][m][0]), "+v"(acc[ai][1][m][1]));
                if (m & 1) asm volatile("" ::: "memory"); }
        const bool bad1 = bad;
        bad = st2.run(acc, u, wr, wc, fr, fq, lds, wid, lane) || bad;
#pragma unroll
        for (int ai = 0; ai < 2; ++ai)
#pragma unroll
            for (int m = 0; m < 4; ++m) { const int r = ai * HALF + wr * 64 + m * 16 + fr; const f32x2v sr = S[r]; const size_t off = (size_t)(u.pm * BM + r) * ldc + col0;
#pragma unroll
                for (int bj = 0; bj < 2; ++bj)
#pragma unroll
                    for (int n = 0; n < 2; ++n) { const f32x4 x1 = acc[ai][bj][m][n]; *(f32x4*)(out + off + bj * HALF + n * 16) = bad1 ? (f32x4){qnan, qnan, qnan, qnan} : x1;
                        const f32x4 o = (x1 - sr.x) * sr.y; u32x2v w; w.x = cvt_pk_bf16(o[0], o[1]); w.y = cvt_pk_bf16(o[2], o[3]);
                        if (bad) { w.x = 0x7fc07fc0u; w.y = 0x7fc07fc0u; } *(u32x2v*)(xn + off + bj * HALF + n * 16) = w; }
                asm volatile("" ::: "memory"); }
    }
};

template <class Epi, class Sched, bool ALIGN_EPI = false, bool SP2 = false>
__device__ __forceinline__ void gemm_phase(PG8_LAS unsigned char* lds, const Gemm g, const Sched& S, const Epi& E, int wave_s_) {
    int tid = MK_TID(wave_s_); asm volatile("" : "+v"(tid));
    const int wid = __builtin_amdgcn_readfirstlane(tid >> 6), lane = tid & 63, wr = wid >> 2, wc = wid & 3, fr = lane & 15, fq = lane >> 4;
    const int K = g.K, nt_def = K / BK;
    unsigned voffA[2], voffB[2];
#pragma unroll
    for (int i = 0; i < 2; ++i) { int R, C; stage_rc(tid * 16 + i * 8192, R, C); const int Rb = Epi::PERM ? ((R & ~31) + perm32(R & 31)) : R;
        voffA[i] = (unsigned)(R * g.ld + C) * 2u; voffB[i] = (unsigned)(Rb * g.ld + C) * 2u; }
    const size_t kstep = (size_t)(BK * 2);
    const size_t hstep = (size_t)HALF * g.ld * 2;
    const size_t tstep = 2 * hstep;
    const unsigned ldsw = (unsigned)wid * 1024u;
    const int aoff = lds_byte(wr * 64 + fr, fq * 8), boff = lds_byte(wc * 32 + fr, fq * 8);
#define PG8_SA(b, h) (((b) * 2 + (h)) * HTB)
#define PG8_SB(b, h) ((4 + (b) * 2 + (h)) * HTB)
#define PG8_STAGE(bufoff, gbase, voff) do { _Pragma("unroll") for (int _i = 0; _i < 2; ++_i) \
        __builtin_amdgcn_global_load_lds((const unsigned*)((const char*)(gbase) + (voff)[_i]), (PG8_LAS unsigned*)(lds + (bufoff) + ldsw + _i * 8192), 16, 0, 0); } while (0)
#define PG8_LDA(dst, b, h) do { _Pragma("unroll") for (int m = 0; m < 4; ++m) _Pragma("unroll") for (int k = 0; k < 2; ++k) dst[m][k] = *(const PG8_LAS bf16x8*)(lds + PG8_SA(b, h) + aoff + m * 2048 + k * 1024); } while (0)
#define PG8_LDB(dst, b, h) do { _Pragma("unroll") for (int n = 0; n < 2; ++n) _Pragma("unroll") for (int k = 0; k < 2; ++k) dst[n][k] = *(const PG8_LAS bf16x8*)(lds + PG8_SB(b, h) + boff + n * 2048 + k * 1024); } while (0)
#define PG8_MMA(ai, bj, At, Bt) do { __builtin_amdgcn_s_setprio(1); _Pragma("unroll") for (int m = 0; m < 4; ++m) _Pragma("unroll") for (int n = 0; n < 2; ++n) _Pragma("unroll") for (int k = 0; k < 2; ++k) \
        acc[ai][bj][m][n] = __builtin_amdgcn_mfma_f32_16x16x32_bf16(Bt[n][k], At[m][k], acc[ai][bj][m][n], 0, 0, 0); __builtin_amdgcn_s_setprio(0); } while (0)
#define PG8_WAIT_V(n) asm volatile("s_waitcnt vmcnt(" #n ")" ::: "memory")
#define PG8_WAIT_L(n) asm volatile("s_waitcnt lgkmcnt(" #n ")" ::: "memory")
#define PG8_BAR __builtin_amdgcn_s_barrier()
#define PG8_SCHED __builtin_amdgcn_sched_barrier(0)
    Unit cur, nxt; int ui = 0;
    if (!S.next(0, cur)) return;
    f32x4 acc[2][2][4][2];
#pragma unroll
    for (int a = 0; a < 2; ++a)
#pragma unroll
        for (int b = 0; b < 2; ++b)
#pragma unroll
            for (int m = 0; m < 4; ++m)
#pragma unroll
                for (int n = 0; n < 2; ++n) acc[a][b][m][n] = (f32x4){0.f, 0.f, 0.f, 0.f};
    bf16x8 At[4][2], B0[2][2], B1[2][2];
    const char* cA = (const char*)g.A + (size_t)cur.pm * tstep + (size_t)cur.koff * 2; const char* cB = (const char*)g.Bt + (size_t)cur.pn * tstep + (size_t)cur.boff * 2;
    S.a_ready(cur);
    if constexpr (SP2) {
        PG8_STAGE(PG8_SB(0, 0), cB, voffB); PG8_STAGE(PG8_SB(0, 1), cB + hstep, voffB); PG8_STAGE(PG8_SA(0, 0), cA, voffA); PG8_STAGE(PG8_SA(0, 1), cA + hstep, voffA);
        if (wr == 1) PG8_BAR;
        PG8_WAIT_V(2); PG8_BAR;
        PG8_STAGE(PG8_SB(1, 0), cB + kstep, voffB); PG8_STAGE(PG8_SA(1, 0), cA + kstep, voffA); PG8_STAGE(PG8_SB(1, 1), cB + hstep + kstep, voffB);
        PG8_WAIT_V(6); PG8_BAR;
    } else {
        PG8_STAGE(PG8_SB(0, 0), cB, voffB); PG8_STAGE(PG8_SA(0, 0), cA, voffA); PG8_STAGE(PG8_SB(0, 1), cB + hstep, voffB); PG8_STAGE(PG8_SA(0, 1), cA + hstep, voffA);
        if (wr == 1) PG8_BAR;
        PG8_WAIT_V(4); PG8_BAR;
        PG8_STAGE(PG8_SB(1, 0), cB + kstep, voffB); PG8_STAGE(PG8_SA(1, 0), cA + kstep, voffA); PG8_STAGE(PG8_SB(1, 1), cB + hstep + kstep, voffB);
        PG8_WAIT_V(6); PG8_BAR;
    }
    for (;;) {
        const bool has_next = S.next(ui + 1, nxt);
        const char* nA = has_next ? (const char*)g.A + (size_t)nxt.pm * tstep + (size_t)nxt.koff * 2 : cA; const char* nB = has_next ? (const char*)g.Bt + (size_t)nxt.pn * tstep + (size_t)nxt.boff * 2 : cB;
        const int nt = cur.ntile() ? cur.ntile() : nt_def;
        for (int t = 0; t < nt; t += 2) {
            const bool last = (t == nt - 2);
            const char* a1 = cA + (size_t)(t + 1) * kstep;
            const char* a2 = last ? nA : cA + (size_t)(t + 2) * kstep; const char* b2 = last ? nB : cB + (size_t)(t + 2) * kstep;
            const char* a3 = a2 + kstep; const char* b3 = b2 + kstep;
            if (last && has_next) S.a_ready(nxt);
            if constexpr (SP2) {
            PG8_LDB(B0, 0, 0); PG8_LDB(B1, 0, 1); PG8_SCHED; PG8_LDA(At, 0, 0); PG8_STAGE(PG8_SA(1, 1), a1 + hstep, voffA);
            PG8_WAIT_V(8); PG8_WAIT_L(0); PG8_BAR; PG8_MMA(0, 0, At, B0); PG8_MMA(0, 1, At, B1); PG8_BAR; PG8_SCHED;
            PG8_LDA(At, 0, 1); PG8_STAGE(PG8_SB(0, 0), b2, voffB); PG8_STAGE(PG8_SB(0, 1), b2 + hstep, voffB); PG8_STAGE(PG8_SA(0, 0), a2, voffA);
            PG8_WAIT_V(8); PG8_WAIT_L(0); PG8_BAR; PG8_MMA(1, 0, At, B0); PG8_MMA(1, 1, At, B1); PG8_BAR; PG8_SCHED;
            PG8_LDB(B0, 1, 0); PG8_LDB(B1, 1, 1); PG8_SCHED; PG8_LDA(At, 1, 0); PG8_STAGE(PG8_SA(0, 1), a2 + hstep, voffA);
            PG8_WAIT_V(8); PG8_WAIT_L(0); PG8_BAR; PG8_MMA(0, 0, At, B0); PG8_MMA(0, 1, At, B1); PG8_BAR; PG8_SCHED;
            PG8_LDA(At, 1, 1); PG8_STAGE(PG8_SB(1, 0), b3, voffB); PG8_STAGE(PG8_SB(1, 1), b3 + hstep, voffB); PG8_STAGE(PG8_SA(1, 0), a3, voffA);
            PG8_WAIT_V(8); PG8_WAIT_L(0); PG8_BAR; PG8_MMA(1, 0, At, B0); PG8_MMA(1, 1, At, B1); PG8_BAR; PG8_SCHED;
            } else {
            PG8_LDB(B0, 0, 0); PG8_SCHED; PG8_LDA(At, 0, 0); PG8_STAGE(PG8_SA(1, 1), a1 + hstep, voffA);
            PG8_WAIT_L(8); PG8_BAR; PG8_WAIT_L(0); PG8_MMA(0, 0, At, B0); PG8_BAR; PG8_SCHED;
            PG8_LDB(B1, 0, 1); PG8_STAGE(PG8_SB(0, 0), b2, voffB);
            PG8_BAR; PG8_WAIT_L(0); PG8_MMA(0, 1, At, B1); PG8_BAR;
            PG8_LDA(At, 0, 1); PG8_STAGE(PG8_SA(0, 0), a2, voffA);
            PG8_BAR; PG8_WAIT_L(0); PG8_MMA(1, 0, At, B0); PG8_BAR; PG8_SCHED;
            PG8_STAGE(PG8_SB(0, 1), b2 + hstep, voffB);
            PG8_WAIT_V(6); PG8_BAR; PG8_MMA(1, 1, At, B1); PG8_BAR;
            PG8_LDB(B0, 1, 0); PG8_SCHED; PG8_LDA(At, 1, 0); PG8_STAGE(PG8_SA(0, 1), a2 + hstep, voffA);
            PG8_WAIT_L(8); PG8_BAR; PG8_WAIT_L(0); PG8_MMA(0, 0, At, B0); PG8_BAR; PG8_SCHED;
            PG8_LDB(B1, 1, 1); PG8_STAGE(PG8_SB(1, 0), b3, voffB);
            PG8_BAR; PG8_WAIT_L(0); PG8_MMA(0, 1, At, B1); PG8_BAR;
            PG8_LDA(At, 1, 1); PG8_STAGE(PG8_SA(1, 0), a3, voffA);
            PG8_BAR; PG8_WAIT_L(0); PG8_MMA(1, 0, At, B0); PG8_BAR; PG8_SCHED;
            PG8_STAGE(PG8_SB(1, 1), b3 + hstep, voffB);
            PG8_WAIT_V(6); PG8_BAR; PG8_MMA(1, 1, At, B1); PG8_BAR;
            }
        }
        if constexpr (ALIGN_EPI) { if (wr == 0) PG8_BAR; }
        if constexpr (!Epi::AFTER_DRAIN) { E(acc, cur, wr, wc, fr, fq); S.done(cur); }
        if (!has_next) break;
        if (!nxt.carry()) {
#pragma unroll
        for (int a = 0; a < 2; ++a)
#pragma unroll
            for (int b = 0; b < 2; ++b)
#pragma unroll
                for (int m = 0; m < 4; ++m)
#pragma unroll
                    for (int n = 0; n < 2; ++n) acc[a][b][m][n] = (f32x4){0.f, 0.f, 0.f, 0.f};
        }
        cur = nxt; cA = nA; cB = nB; ++ui;
        if constexpr (ALIGN_EPI) { if (wr == 1) PG8_BAR; }
    }
    PG8_WAIT_V(0);
    if constexpr (!ALIGN_EPI) { if (wr == 0) PG8_BAR; }
    PG8_BAR;
    if constexpr (Epi::AFTER_DRAIN) { E.fused(acc, cur, wr, wc, fr, fq, lds, wid, lane); S.done(cur); }
#undef PG8_SA
#undef PG8_SB
#undef PG8_STAGE
#undef PG8_LDA
#undef PG8_LDB
#undef PG8_MMA
#undef PG8_WAIT_V
#undef PG8_WAIT_L
#undef PG8_BAR
#undef PG8_SCHED
}
}

__device__ __forceinline__ float shfl_xor_f(float v, int o) { return __uint_as_float((unsigned)__builtin_amdgcn_ds_bpermute((mk_lane_id() ^ o) << 2, (int)__float_as_uint(v))); }
namespace attn128 {
using bf16 = __hip_bfloat16;
constexpr int D = 128, NW = 8, QBLK = 32, KVBLK = 64;
constexpr float SCALE = 0.088388347648318440f;
constexpr float THR = 8.f;
constexpr int SDEPTH = 2;
constexpr int LDQ = 1024, LDK = 1024, LDO = 1024;
constexpr size_t SHM_V = KVBLK * D * 2, SHM_K = KVBLK * D * 2, SHM_ATTN = 2 * SHM_V + 2 * SHM_K + NW * 64 * 4;
using bf16x8 = __attribute__((ext_vector_type(8))) short;
using s16x4  = __attribute__((ext_vector_type(4))) short;
using f32x16 = __attribute__((ext_vector_type(16))) float;
using f32x8  = __attribute__((ext_vector_type(8))) float;
using u32x4  = __attribute__((ext_vector_type(4))) unsigned;
#define KSWZ(row, colB) ((row) * 256 + ((colB) ^ (((row) & 7) << 4)))
#define SBAR() __builtin_amdgcn_sched_barrier(0)
__device__ __forceinline__ int crow(int r, int hi) { return (r & 3) + 8 * (r >> 2) + 4 * hi; }
__device__ __forceinline__ unsigned cvtpk(float lo, float hi) {
  unsigned r; asm volatile("v_cvt_pk_bf16_f32 %0, %1, %2" : "=v"(r) : "v"(lo), "v"(hi)); return r;
}
template <typename TIn> struct Stage;
template <> struct Stage<bf16>  { using T = bf16x8;
  __device__ static __forceinline__ T ld8(const bf16* p) { return *reinterpret_cast<const bf16x8*>(p); }
  __device__ static __forceinline__ bf16x8 tobf(T x) { return x; } };
template <> struct Stage<float> { using T = f32x8;
  __device__ static __forceinline__ T ld8(const float* p) { return *reinterpret_cast<const f32x8*>(p); }
  __device__ static __forceinline__ bf16x8 tobf(T x) {
    u32x4 w = {cvtpk(x[0], x[1]), cvtpk(x[2], x[3]), cvtpk(x[4], x[5]), cvtpk(x[6], x[7])}; return *reinterpret_cast<bf16x8*>(&w); } };

__device__ __forceinline__ void partialSM(f32x16& p0, f32x16& p1, float& m_reg, float& mn, float& alpha) {
  constexpr float C = SCALE * 1.4426950408889634f;
  float pmax = p0[0]; for (int r = 1; r < 16; ++r) pmax = fmaxf(pmax, p0[r]); for (int r = 0; r < 16; ++r) pmax = fmaxf(pmax, p1[r]);
  { auto rr = __builtin_amdgcn_permlane32_swap(__float_as_uint(pmax), __float_as_uint(pmax), false, false);
    pmax = fmaxf(__uint_as_float(rr[0]), __uint_as_float(rr[1])); }
  if (__builtin_expect(__all(pmax - m_reg <= THR / SCALE), 1)) { mn = m_reg; alpha = 1.f; }
  else { mn = fmaxf(m_reg, pmax); alpha = __builtin_amdgcn_exp2f((m_reg - mn) * C); m_reg = mn; }
  float mnC = -mn * C;
  for (int r = 0; r < 16; ++r) p0[r] = fmaf(p0[r], C, mnC); for (int r = 0; r < 16; ++r) p1[r] = fmaf(p1[r], C, mnC);
  for (int r = 0; r < 16; ++r) p0[r] = __builtin_amdgcn_exp2f(p0[r]);
}
__device__ __forceinline__ void finishSM(f32x16& p0, f32x16& p1, float alpha, float& l_reg, bf16x8& pa0, bf16x8& pa1, bf16x8& pa2, bf16x8& pa3) {
  for (int r = 0; r < 16; ++r) p1[r] = __builtin_amdgcn_exp2f(p1[r]);
  float ps = 0; for (int r = 0; r < 16; ++r) ps += p0[r]; for (int r = 0; r < 16; ++r) ps += p1[r];
  { auto rr = __builtin_amdgcn_permlane32_swap(__float_as_uint(ps), __float_as_uint(ps), false, false);
    ps = __uint_as_float(rr[0]) + __uint_as_float(rr[1]); }
  l_reg = l_reg * alpha + ps;
#define PK4(P, BASE, OUT) do { unsigned a0 = cvtpk(P[BASE + 0], P[BASE + 1]), a1 = cvtpk(P[BASE + 2], P[BASE + 3]);   \
    unsigned b0 = cvtpk(P[BASE + 4], P[BASE + 5]), b1 = cvtpk(P[BASE + 6], P[BASE + 7]);                              \
    auto r0 = __builtin_amdgcn_permlane32_swap(a0, b0, false, false); auto r1 = __builtin_amdgcn_permlane32_swap(a1, b1, false, false); \
    u32x4 w = {r0[0], r1[0], r0[1], r1[1]}; OUT = *reinterpret_cast<bf16x8*>(&w); } while (0)
  PK4(p0, 0, pa0); PK4(p0, 8, pa1); PK4(p1, 0, pa2); PK4(p1, 8, pa3);
#undef PK4
}
__device__ __forceinline__ void qkt(f32x16& p0, f32x16& p1, const bf16* Ks, const bf16x8* qr, int r32, int hi) {
  p0 = f32x16{}; p1 = f32x16{};
  for (int d0 = 0; d0 < 8; ++d0) { int cb = (d0 * 16 + hi * 8) * 2;
    bf16x8 b0 = *reinterpret_cast<const bf16x8*>((const char*)Ks + KSWZ(r32, cb));
    bf16x8 b1 = *reinterpret_cast<const bf16x8*>((const char*)Ks + KSWZ(32 + r32, cb));
    p0 = __builtin_amdgcn_mfma_f32_32x32x16_bf16(b0, qr[d0], p0, 0, 0, 0);
    p1 = __builtin_amdgcn_mfma_f32_32x32x16_bf16(b1, qr[d0], p1, 0, 0, 0); }
}
__device__ __forceinline__ int v_st(int k, int c) { const int kk = (k & ~0xC) | ((k & 4) << 1) | ((k & 8) >> 1); return ((kk >> 3) * 4 + (c >> 5)) * 512 + ((kk & 7) * 32 + (c & 31)) * 2; }
__device__ __forceinline__ int v_rd_base(int lane) { return ((lane & 3) << 3) | (((lane >> 2) & 3) << 6) | (((lane >> 4) & 1) << 5) | (((lane >> 5) & 1) << 8); }
constexpr int v_rd_off(int d0, int ks, int half) { return d0 * 512 + ks * 4096 + half * 2048; }
template <int OFF> __device__ __forceinline__ s16x4 tr_read(int vb) {
  s16x4 r; asm volatile("ds_read_b64_tr_b16 %0, %1 offset:%2" : "=&v"(r) : "v"(vb), "i"(OFF) : "memory"); return r;
}
template <int D0> __device__ __forceinline__ void pv_one(f32x16& od, int vb, bf16x8 pa0, bf16x8 pa1, bf16x8 pa2, bf16x8 pa3) {
  const s16x4 l0 = tr_read<v_rd_off(D0, 0, 0)>(vb), h0 = tr_read<v_rd_off(D0, 0, 1)>(vb), l1 = tr_read<v_rd_off(D0, 1, 0)>(vb), h1 = tr_read<v_rd_off(D0, 1, 1)>(vb);
  const s16x4 l2 = tr_read<v_rd_off(D0, 2, 0)>(vb), h2 = tr_read<v_rd_off(D0, 2, 1)>(vb), l3 = tr_read<v_rd_off(D0, 3, 0)>(vb), h3 = tr_read<v_rd_off(D0, 3, 1)>(vb);
  asm volatile("s_waitcnt lgkmcnt(0)" ::: "memory"); SBAR();
#define PK(L, H) (bf16x8){L[0], L[1], L[2], L[3], H[0], H[1], H[2], H[3]}
  od = __builtin_amdgcn_mfma_f32_32x32x16_bf16(pa0, PK(l0, h0), od, 0, 0, 0);
  od = __builtin_amdgcn_mfma_f32_32x32x16_bf16(pa1, PK(l1, h1), od, 0, 0, 0);
  od = __builtin_amdgcn_mfma_f32_32x32x16_bf16(pa2, PK(l2, h2), od, 0, 0, 0);
  od = __builtin_amdgcn_mfma_f32_32x32x16_bf16(pa3, PK(l3, h3), od, 0, 0, 0);
#undef PK
}
__device__ __forceinline__ void pv_d0(f32x16* o, int vb, bf16x8 pa0, bf16x8 pa1, bf16x8 pa2, bf16x8 pa3) {
  pv_one<0>(o[0], vb, pa0, pa1, pa2, pa3); pv_one<1>(o[1], vb, pa0, pa1, pa2, pa3); pv_one<2>(o[2], vb, pa0, pa1, pa2, pa3); pv_one<3>(o[3], vb, pa0, pa1, pa2, pa3);
}

template <typename TQ>
__device__ __forceinline__ void attn_dense_body(const TQ* __restrict__ Qb, const bf16* __restrict__ Kh, const bf16* __restrict__ Vh,
                                                float* __restrict__ Ob, int seq, char* lds, int wave_s_) {
  using St = Stage<bf16>; using SQ = Stage<TQ>;
  int tid = MK_TID(wave_s_); asm volatile("" : "+v"(tid));
  const int wid = tid >> 6, lane = tid & 63, r32 = lane & 31, hi = lane >> 5;
  bf16* V_lds = (bf16*)lds; bf16* K_lds = (bf16*)(lds + 2 * SHM_V);
  float* ws = (float*)(lds + 2 * SHM_V + 2 * SHM_K) + wid * 64; float* li_l = ws; float* al_l = ws + 32;
  float m_reg = -1e30f, l_reg = 0; f32x16 o[4] = {}; bf16x8 qr[8];
  const TQ* Qw = Qb + (long)(wid * QBLK + r32) * LDQ + hi * 8;
#pragma unroll
  for (int d0 = 0; d0 < 8; ++d0) qr[d0] = SQ::tobf(SQ::ld8(Qw + d0 * 16));
  const int sr = tid >> 4, sc = (tid & 15) * 8, vst0 = v_st(sr, sc), vst1 = v_st(32 + sr, sc);
  const int vb0 = (int)(uintptr_t)V_lds + v_rd_base(lane);
  struct { typename St::T vs0, vs1, ks0, ks1; } sr_[SDEPTH];
#define SLOAD(i, k0) do { sr_[i].vs0 = St::ld8(&Vh[(long)((k0) + sr) * LDK + sc]); sr_[i].vs1 = St::ld8(&Vh[(long)((k0) + 32 + sr) * LDK + sc]); \
    sr_[i].ks0 = St::ld8(&Kh[(long)((k0) + sr) * LDK + sc]); sr_[i].ks1 = St::ld8(&Kh[(long)((k0) + 32 + sr) * LDK + sc]); } while (0)
#define SWRITE(b, i) do { *(bf16x8*)((char*)V_lds + (b) * SHM_V + vst0) = St::tobf(sr_[i].vs0);          \
    *(bf16x8*)((char*)V_lds + (b) * SHM_V + vst1) = St::tobf(sr_[i].vs1); int kc = sc * 2;               \
    *(bf16x8*)((char*)K_lds + (b) * SHM_K + KSWZ(sr, kc)) = St::tobf(sr_[i].ks0);                       \
    *(bf16x8*)((char*)K_lds + (b) * SHM_K + KSWZ(32 + sr, kc)) = St::tobf(sr_[i].ks1); } while (0)
#define SWAIT() do { if constexpr (SDEPTH == 2) asm volatile("s_waitcnt vmcnt(4)" ::: "memory"); else asm volatile("s_waitcnt vmcnt(0)" ::: "memory"); } while (0)
#define RESC(a) do { if (__any((a) < 1.f)) { if (hi == 0) al_l[r32] = (a); asm volatile("s_waitcnt lgkmcnt(0)" ::: "memory"); \
    for (int d = 0; d < 4; ++d) for (int r = 0; r < 16; ++r) o[d][r] *= al_l[crow(r, hi)]; } } while (0)
  f32x16 pA0, pA1, pB0, pB1; float mnA, mnB, alA, alB; bf16x8 pa0, pa1, pa2, pa3; const int NT = seq / KVBLK;
  constexpr int SE = 0, SO = SDEPTH - 1;
  SLOAD(SE, 0); asm volatile("s_waitcnt vmcnt(0)" ::: "memory"); SWRITE(0, SE); __syncthreads();
  qkt(pA0, pA1, K_lds, qr, r32, hi); partialSM(pA0, pA1, m_reg, mnA, alA);
  SLOAD(SO, KVBLK); if constexpr (SDEPTH == 2) { if (2 < NT) SLOAD(SE, 2 * KVBLK); }
  SWAIT(); SWRITE(1, SO); __syncthreads();
  for (int j = 1; j + 1 < NT; j += 2) {
    SBAR(); qkt(pB0, pB1, (bf16*)((char*)K_lds + SHM_K), qr, r32, hi);
    finishSM(pA0, pA1, alA, l_reg, pa0, pa1, pa2, pa3); SBAR();
    SLOAD(SO, (j + SDEPTH) * KVBLK); SBAR();
    pv_d0(o, vb0, pa0, pa1, pa2, pa3); partialSM(pB0, pB1, m_reg, mnB, alB);
    __syncthreads(); SWAIT(); SWRITE(0, SE);
    RESC(alB); __syncthreads();
    SBAR(); qkt(pA0, pA1, K_lds, qr, r32, hi);
    finishSM(pB0, pB1, alB, l_reg, pa0, pa1, pa2, pa3); SBAR();
    if (SDEPTH == 1 || j + 3 < NT) SLOAD(SE, (j + 1 + SDEPTH) * KVBLK); SBAR();
    pv_d0(o, vb0 + (int)SHM_V, pa0, pa1, pa2, pa3); partialSM(pA0, pA1, m_reg, mnA, alA);
    __syncthreads(); SWAIT(); SWRITE(1, SO);
    RESC(alA); __syncthreads();
  }
  SBAR(); qkt(pB0, pB1, (bf16*)((char*)K_lds + SHM_K), qr, r32, hi);
  finishSM(pA0, pA1, alA, l_reg, pa0, pa1, pa2, pa3); SBAR();
  pv_d0(o, vb0, pa0, pa1, pa2, pa3); partialSM(pB0, pB1, m_reg, mnB, alB);
  __syncthreads(); RESC(alB);
  finishSM(pB0, pB1, alB, l_reg, pa0, pa1, pa2, pa3); SBAR();
  pv_d0(o, vb0 + (int)SHM_V, pa0, pa1, pa2, pa3);
  if (hi == 0) li_l[r32] = l_reg; asm volatile("s_waitcnt lgkmcnt(0)" ::: "memory");
  float rli[16];
#pragma unroll
  for (int r = 0; r < 16; ++r) rli[r] = __builtin_amdgcn_rcpf(li_l[crow(r, hi)]);
  float* Ow = Ob + (long)(wid * QBLK) * LDO;
#pragma unroll
  for (int r = 0; r < 16; ++r) { int orow = crow(r, hi);
    for (int d0 = 0; d0 < 4; ++d0) Ow[(long)orow * LDO + d0 * 32 + r32] = o[d0][r] * rli[r]; }
#undef SLOAD
#undef SWRITE
#undef SWAIT
#undef RESC
}

}

namespace attn256 {
using namespace attn128;
constexpr size_t SHM_V2 = KVBLK * 256 * 2, SHM_K2 = KVBLK * D * 2;
constexpr int LDV = 1024;
__device__ __forceinline__ int v_st2(int k, int c) { const int kk = (k & ~0xC) | ((k & 4) << 1) | ((k & 8) >> 1); return ((kk >> 3) * 8 + (c >> 5)) * 512 + ((kk & 7) * 32 + (c & 31)) * 2; }
constexpr int v_rd_off2(int d0, int ks, int half) { return d0 * 512 + ks * 8192 + half * 4096; }
typedef __attribute__((address_space(3))) s16x4 lds_s16x4_t;
template <int OFF> __device__ __forceinline__ s16x4 tr_read_b(int vb) { return __builtin_amdgcn_ds_read_tr16_b64_v4i16((lds_s16x4_t*)(unsigned long)(unsigned)(vb + OFF)); }
template <int D0> __device__ __forceinline__ void pv_one2(f32x16& od, int vb, bf16x8 pa0, bf16x8 pa1, bf16x8 pa2, bf16x8 pa3) {
  const s16x4 l0 = tr_read_b<v_rd_off2(D0, 0, 0)>(vb), h0 = tr_read_b<v_rd_off2(D0, 0, 1)>(vb), l1 = tr_read_b<v_rd_off2(D0, 1, 0)>(vb), h1 = tr_read_b<v_rd_off2(D0, 1, 1)>(vb);
  const s16x4 l2 = tr_read_b<v_rd_off2(D0, 2, 0)>(vb), h2 = tr_read_b<v_rd_off2(D0, 2, 1)>(vb), l3 = tr_read_b<v_rd_off2(D0, 3, 0)>(vb), h3 = tr_read_b<v_rd_off2(D0, 3, 1)>(vb);
  SBAR();
#define PK(L, H) (bf16x8){L[0], L[1], L[2], L[3], H[0], H[1], H[2], H[3]}
  od = __builtin_amdgcn_mfma_f32_32x32x16_bf16(pa0, PK(l0, h0), od, 0, 0, 0);
  od = __builtin_amdgcn_mfma_f32_32x32x16_bf16(pa1, PK(l1, h1), od, 0, 0, 0);
  od = __builtin_amdgcn_mfma_f32_32x32x16_bf16(pa2, PK(l2, h2), od, 0, 0, 0);
  od = __builtin_amdgcn_mfma_f32_32x32x16_bf16(pa3, PK(l3, h3), od, 0, 0, 0);
#undef PK
}
__device__ __forceinline__ void attn_o256_body(const bf16* __restrict__ Qb, const bf16* __restrict__ Kh, const bf16* __restrict__ Vh, float* __restrict__ Ob, int seq, char* lds, int wave_s_) {
  using St = Stage<bf16>;
  int tid = MK_TID(wave_s_); asm volatile("" : "+v"(tid));
  const int wid = tid >> 6, lane = tid & 63, r32 = lane & 31, hi = lane >> 5;
  bf16* V_lds = (bf16*)lds; bf16* K_lds = (bf16*)(lds + 2 * SHM_V2);
  float* ws = (float*)(lds + 2 * SHM_V2 + 2 * SHM_K2) + wid * 64; float* li_l = ws; float* al_l = ws + 32;
  float m_reg = -1e30f, l_reg = 0; f32x16 o[8] = {}; bf16x8 qr[8];
  const bf16* Qw = Qb + (long)(wid * QBLK + r32) * LDQ + hi * 8;
#pragma unroll
  for (int d0 = 0; d0 < 8; ++d0) qr[d0] = St::ld8(Qw + d0 * 16);
  const int vb0 = (int)(uintptr_t)V_lds + v_rd_base(lane);
  bf16x8 sv00, sv01, sv10, sv11, sk0, sk1;
#define SLOAD2(k0) do { const int t_ = MK_TID(wave_s_), sr = t_ >> 4, sc = (t_ & 15) * 8; const bf16* vp = Vh + (long)((k0) + sr) * LDV + sc; const bf16* kp = Kh + (long)((k0) + sr) * LDK + sc; \
    sv00 = St::ld8(vp); sv01 = St::ld8(vp + 128); sv10 = St::ld8(vp + 32 * LDV); sv11 = St::ld8(vp + 32 * LDV + 128); sk0 = St::ld8(kp); sk1 = St::ld8(kp + 32 * LDK); } while (0)
#define SWRITE2(b) do { const int t_ = MK_TID(wave_s_), sr = t_ >> 4, sc = (t_ & 15) * 8; char* vbuf = (char*)V_lds + (b) * SHM_V2 + v_st2(sr, sc); \
    *(bf16x8*)(vbuf) = sv00; *(bf16x8*)(vbuf + 2048) = sv01; *(bf16x8*)(vbuf + 16384) = sv10; *(bf16x8*)(vbuf + 18432) = sv11; \
    char* kbuf = (char*)K_lds + (b) * SHM_K2 + KSWZ(sr, sc * 2); *(bf16x8*)(kbuf) = sk0; *(bf16x8*)(kbuf + 8192) = sk1; } while (0)
  const int NT = seq / KVBLK;
  SLOAD2(0); asm volatile("s_waitcnt vmcnt(0)" ::: "memory"); SWRITE2(0); __syncthreads();
  for (int j = 0; j < NT; ++j) {
    const int b = j & 1;
    f32x16 p0, p1; float mn, al; bf16x8 pa0, pa1, pa2, pa3;
    SBAR(); qkt(p0, p1, (bf16*)((char*)K_lds + b * SHM_K2), qr, r32, hi);
    partialSM(p0, p1, m_reg, mn, al);
    finishSM(p0, p1, al, l_reg, pa0, pa1, pa2, pa3); SBAR();
    if (__any(al < 1.f)) { if (hi == 0) al_l[r32] = al; asm volatile("s_waitcnt lgkmcnt(0)" ::: "memory");
#pragma unroll
      for (int d = 0; d < 8; ++d)
#pragma unroll
        for (int r = 0; r < 16; ++r) o[d][r] *= al_l[crow(r, hi)]; }
    if (j + 1 < NT) SLOAD2((j + 1) * KVBLK);
    SBAR();
    { const int vb = vb0 + b * (int)SHM_V2;
      pv_one2<0>(o[0], vb, pa0, pa1, pa2, pa3); pv_one2<1>(o[1], vb, pa0, pa1, pa2, pa3); pv_one2<2>(o[2], vb, pa0, pa1, pa2, pa3); pv_one2<3>(o[3], vb, pa0, pa1, pa2, pa3);
      pv_one2<4>(o[4], vb, pa0, pa1, pa2, pa3); pv_one2<5>(o[5], vb, pa0, pa1, pa2, pa3); pv_one2<6>(o[6], vb, pa0, pa1, pa2, pa3); pv_one2<7>(o[7], vb, pa0, pa1, pa2, pa3); }
    if (j + 1 < NT) { asm volatile("s_waitcnt vmcnt(0)" ::: "memory"); SWRITE2(b ^ 1); }
    __syncthreads();
  }
  if (hi == 0) li_l[r32] = l_reg; asm volatile("s_waitcnt lgkmcnt(0)" ::: "memory");
  float rli[16];
#pragma unroll
  for (int r = 0; r < 16; ++r) rli[r] = __builtin_amdgcn_rcpf(li_l[crow(r, hi)]);
  float* Ow = Ob + (long)(wid * QBLK) * LDO;
#pragma unroll
  for (int r = 0; r < 16; ++r) { const int orow = crow(r, hi);
#pragma unroll
    for (int d0 = 0; d0 < 8; ++d0) Ow[(long)orow * LDO + d0 * 32 + r32] = o[d0][r] * rli[r]; }
#undef SLOAD2
#undef SWRITE2
}
}

#define GAS __attribute__((address_space(1)))
#define LAS __attribute__((address_space(3)))
typedef unsigned short bf16;
typedef unsigned v4u __attribute__((ext_vector_type(4)));
typedef float f32x4 __attribute__((ext_vector_type(4)));
typedef short bf16x8 __attribute__((ext_vector_type(8)));
typedef GAS unsigned gu32;
typedef GAS unsigned long long gu64;
#define RLX_AGENT __ATOMIC_RELAXED, __HIP_MEMORY_SCOPE_AGENT
#define LDS_WAIT() asm volatile("s_waitcnt lgkmcnt(0)" ::: "memory")
#define VM_WAIT() asm volatile("s_waitcnt vmcnt(0)" ::: "memory")
__device__ __forceinline__ unsigned long long rt() { return __builtin_amdgcn_s_memrealtime(); }
__device__ __forceinline__ unsigned f2bf(float f) { unsigned u = __builtin_bit_cast(unsigned, f); return (u + 0x7fffu + ((u >> 16) & 1u)) >> 16; }
__device__ __forceinline__ unsigned pk2(float lo, float hi) { return f2bf(lo) | (f2bf(hi) << 16); }

#define XB_TMO      128
#define XB_XCNT(j)  (256  + 64 * (j))
#define XB_XSUB(j)  (1280 + 64 * (j))
#define XB_XGEN(j)  (2304 + 64 * (j))
#define XB_TOP      3328
#define XB_TOPGEN   3392
#define XCD_BAR_WORDS 3456
#define XB_SPIN_CAP (1u << 22)

__device__ __forceinline__ unsigned xb_ld(unsigned* p)              { return __hip_atomic_load(p, __ATOMIC_RELAXED, __HIP_MEMORY_SCOPE_AGENT); }
__device__ __forceinline__ unsigned xb_add(unsigned* p, unsigned v) { return __hip_atomic_fetch_add(p, v, __ATOMIC_RELAXED, __HIP_MEMORY_SCOPE_AGENT); }
__device__ __forceinline__ unsigned xb_xcc_id() { return (unsigned)__builtin_amdgcn_s_getreg((3 << 11) | 20) & 0xFu; }
#define XB_SPIN(cond, bar) do { unsigned _sp = 0; while (cond) { __builtin_amdgcn_s_sleep(1); \
    if ((++_sp & 255u) == 0u) { if (xb_ld(&(bar)[XB_TMO])) break; if (_sp > XB_SPIN_CAP) { atomicAdd(&(bar)[XB_TMO], 1u); break; } } } } while (0)

struct XcdBarrier {
    unsigned* bar; unsigned x;
    volatile LAS unsigned* st;
};

__device__ __forceinline__ XcdBarrier xcd_barrier_post(unsigned* bar, volatile LAS unsigned* st, int tid_) {
    XcdBarrier b; b.bar = bar; b.x = xb_xcc_id(); b.st = st;
    if (tid_ == 0) (void)xb_add(&bar[XB_XCNT(b.x)], 1u);
    return b;
}
__device__ __forceinline__ void xcd_barrier_complete(unsigned* bar, unsigned x, unsigned& nloc, unsigned& nx) {
    const unsigned G = gridDim.x * gridDim.y * gridDim.z;
    unsigned sum, cnt, mine, sp = 0u;
    for (;;) {
        sum = 0u; cnt = 0u; mine = 0u;
#pragma unroll
        for (unsigned j = 0; j < 16; ++j) { const unsigned c = xb_ld(&bar[XB_XCNT(j)]); sum += c; cnt += (c > 0u) ? 1u : 0u; mine = (j == x) ? c : mine; }
        if (sum == G) break;
        __builtin_amdgcn_s_sleep(1);
        if ((++sp & 255u) == 0u) { if (xb_ld(&bar[XB_TMO])) break; if (sp > XB_SPIN_CAP) { atomicAdd(&bar[XB_TMO], 1u); break; } }
    }
    nloc = mine > 0u ? mine : 1u; nx = cnt > 0u ? cnt : 1u;
}

__device__ __forceinline__ void xcd_barrier(const XcdBarrier& b, int tid_) {
    asm volatile("s_waitcnt vmcnt(0)" ::: "memory");
    __syncthreads();
    if (tid_ == 0) {
        unsigned* bar = b.bar;
        __builtin_amdgcn_s_waitcnt(0);
        unsigned nloc = b.st[0], nx = b.st[1];
        if (nloc == 0u) { xcd_barrier_complete(bar, b.x, nloc, nx); b.st[0] = nloc; b.st[1] = nx; }
        const unsigned old = xb_add(&bar[XB_XSUB(b.x)], 1u);
        const unsigned gen = old / nloc;
        if (old + 1u == (gen + 1u) * nloc) {
            __builtin_amdgcn_fence(__ATOMIC_RELEASE, "agent");
            asm volatile("s_waitcnt vmcnt(0)" ::: "memory");
            const unsigned og = xb_add(&bar[XB_TOP], 1u);
            const unsigned tg = og / nx;
            if (og + 1u == (tg + 1u) * nx) xb_add(&bar[XB_TOPGEN], 1u);
            else XB_SPIN(xb_ld(&bar[XB_TOPGEN]) == tg, bar);
            __builtin_amdgcn_fence(__ATOMIC_ACQUIRE, "agent");
            xb_add(&bar[XB_XGEN(b.x)], 1u);
            asm volatile("s_waitcnt vmcnt(0)" ::: "memory");
        } else {
            XB_SPIN(xb_ld(&bar[XB_XGEN(b.x)]) == gen, bar);
            __builtin_amdgcn_fence(__ATOMIC_ACQUIRE, "agent");
            asm volatile("s_waitcnt vmcnt(0)" ::: "memory");
        }
    }
    __syncthreads();
}

constexpr int DM = 4096, SEQ = 8192, CTXL = 256, MT = SEQ + CTXL, DEPTH = 4, FFND = 4096;
constexpr int NZ = 20480, INC = 20496, ADAR = 256, NMOD = 9 * DM;
constexpr int ZC_UV = 0, ZC_MQ = 2048, ZC_MK = 2560, ZC_MV = 3072, ZC_MO = 4096, ZC_AQ = 5120, ZC_AK = 6144, ZC_AV = 7168, ZC_MG = 8192;
constexpr float EPS = 1e-6f;
constexpr int NWAVES = 8, NTHR = 512;

constexpr size_t MiB = 1ull << 20;
constexpr size_t WS_CTL = 0, CTL_ZERO_BYTES = 1 * MiB;
constexpr size_t WS_MODTP = 1 * MiB;
constexpr size_t WS_MOD = WS_MODTP + 512 * 1024;
constexpr size_t WS_LAM = WS_MOD + (size_t)DEPTH * 2 * NMOD * 4;
constexpr size_t WS_WG16 = WS_LAM + 256;
constexpr size_t WS_ROPE = WS_WG16 + (size_t)DEPTH * 16 * DM * 4;
constexpr size_t WS_G16 = WS_ROPE + (size_t)2 * SEQ * 64 * 4;
constexpr size_t WS_XR = 9 * MiB;
constexpr size_t SZ_ROWS_F32 = (size_t)MT * DM * 4, SZ_ROWS_BF = (size_t)MT * DM * 2;
constexpr size_t WS_H = WS_XR + SZ_ROWS_F32;
constexpr size_t WS_GB = WS_H + SZ_ROWS_BF;
constexpr size_t WS_Z = WS_GB + SZ_ROWS_BF;
constexpr size_t WS_ATTO = WS_Z + (size_t)MT * NZ * 2;
constexpr size_t WS_MLH = WS_ATTO + (size_t)2 * MT * 1024 * 4;
constexpr size_t WS_YA = WS_MLH + (size_t)2 * MT * 1024 * 4;
constexpr size_t WS_YB = WS_YA + (size_t)MT * 1024 * 2;
constexpr size_t WS_YC = WS_YB + (size_t)MT * 1024 * 2;
constexpr size_t WS_YACC = WS_YC + (size_t)MT * 1024 * 2;
constexpr size_t WS_Y = WS_YACC + SZ_ROWS_F32;
constexpr size_t WS_W13T = WS_Y + SZ_ROWS_BF;
constexpr size_t WS_W2T = WS_W13T + (size_t)DEPTH * 2 * 8192 * 4096 * 2;
constexpr size_t WS_WINT = WS_W2T + (size_t)DEPTH * 2 * 4096 * 4096 * 2;
constexpr size_t WS_WBT = WS_WINT + (size_t)DEPTH * NZ * 4096 * 2;
constexpr size_t WS_WOT = WS_WBT + (size_t)DEPTH * 3 * 4096 * 1024 * 2;
constexpr size_t WS_CT = WS_WOT + (size_t)DEPTH * 4096 * 4096 * 2;
constexpr size_t WS_MSM = WS_CT + (size_t)8 * 66 * 32768 * 2;
constexpr size_t WS_SLAB = WS_MSM + 1 * MiB;
constexpr size_t WS_GWSB = WS_SLAB + (size_t)16 * 256 * DM * 4;
constexpr size_t WS_MS3 = WS_GWSB + (size_t)DEPTH * 8 * 128 * 128 * 2;
constexpr size_t WS_END = WS_MS3 + (size_t)3 * 256 * DM * 4;
static_assert(WS_G16 + (size_t)MT * 16 * 4 <= WS_XR, "small buffers fit below XR");
static_assert(WS_XR % 256 == 0 && WS_H % 256 == 0 && WS_Z % 256 == 0 && WS_W13T % 256 == 0, "alignment");

constexpr int CW_BAR = 4096;

constexpr int RING_OFF = 0, RING_BYTES = 131072;
constexpr int LDSCTL_OFF = 143360, MISC_OFF = LDSCTL_OFF + 320;
constexpr int LDS_BYTES = 147456;

constexpr int P_PRO0 = 0, P_PRO1 = 1, P_LAYER0 = 2;
constexpr int L_N1 = 0, L_W13A = 1, L_W2A = 2, L_N2 = 3, L_WIN = 4, L_MIX1 = 5, L_POST = 6, L_M3 = 7, L_MERGE = 8, L_WOUT = 9, L_N3 = 10, L_W13B = 11, L_W2B = 12, NPL = 13;
constexpr int P_FINAL = P_LAYER0 + DEPTH * NPL, NPH = P_FINAL + 1;

__device__ __forceinline__ float wave_sum(float v) {
#pragma unroll
    for (int o = 1; o < 64; o <<= 1) v += shfl_xor_f(v, o);
    return v;
}
__device__ __forceinline__ float bf2f(unsigned short b) { return __uint_as_float((unsigned)b << 16); }
__device__ __forceinline__ float bflo(unsigned w) { return __uint_as_float(w << 16); }
__device__ __forceinline__ float bfhi(unsigned w) { return __uint_as_float(w & 0xffff0000u); }
__device__ __forceinline__ float sigmoid_f(float x) { return 1.f / (1.f + __expf(-x)); }
__device__ __forceinline__ float silu_f(float x) { return x / (1.f + __expf(-x)); }
__device__ __forceinline__ float gelu_tanh_f(float x) { const float u = 0.7978845608028654f * (x + 0.044715f * x * x * x); return x / (1.f + __expf(-2.f * u)); }
__device__ __forceinline__ float lambda_init_f(int l) { return 0.8f - 0.6f * __expf(-0.3f * (float)l); }

namespace pg8 {
struct CtxSplitOrder {
    int c, G, n;
    const float* MS3; bf16_t* Yc; int wave_s_;
    __device__ __forceinline__ bool next(int i, Unit& u) const { const int L = i * G + c; if (L >= n) return false; u.pm = 0; u.pn = L >> 4; u.koff = (L & 15) * 256; u.boff = u.koff; u.fl = 0; return true; }
    __device__ __forceinline__ void a_ready(const Unit& u) const {
        if (MS3) {
            int t_ = MK_TID(wave_s_); asm volatile("" : "+v"(t_));
            const int r = t_ >> 1, c0 = u.koff + (t_ & 1) * 128;
            const float* p0 = MS3 + (size_t)r * DM + c0; bf16_t* yo = Yc + (size_t)r * DM + c0;
#pragma unroll 1
            for (int ib = 0; ib < 16; ib += 4) { f32x4 q[4][3][2];
#pragma unroll
                for (int i = 0; i < 4; ++i)
#pragma unroll
                    for (int sgm = 0; sgm < 3; ++sgm) { q[i][sgm][0] = *(const f32x4*)(p0 + (size_t)sgm * 256 * DM + 8 * (ib + i)); q[i][sgm][1] = *(const f32x4*)(p0 + (size_t)sgm * 256 * DM + 8 * (ib + i) + 4); }
                asm volatile("" ::: "memory");
#pragma unroll
                for (int i = 0; i < 4; ++i) { const f32x4 a0 = q[i][0][0] + q[i][1][0] + q[i][2][0], a1 = q[i][0][1] + q[i][1][1] + q[i][2][1];
                    u32x4 w; w.x = cvt_pk_bf16(a0[0], a0[1]); w.y = cvt_pk_bf16(a0[2], a0[3]); w.z = cvt_pk_bf16(a1[0], a1[1]); w.w = cvt_pk_bf16(a1[2], a1[3]); *(u32x4*)(yo + 8 * (ib + i)) = w; }
                asm volatile("" ::: "memory"); }
            asm volatile("s_waitcnt vmcnt(0)" ::: "memory");
            asm volatile("" ::: "memory"); __builtin_amdgcn_s_barrier(); asm volatile("" ::: "memory");
        }
    }
    __device__ __forceinline__ void done(const Unit&) const {}
};
struct ResidOrder {
    StaticOrder lat; int c, G, n;
    __device__ __forceinline__ bool next(int i, Unit& u) const {
        const int nl = lat.c < lat.nwg ? (lat.nwg - lat.c + lat.G - 1) / lat.G : 0;
        if (i < nl) { lat.next(i, u); u.pm += 1; return true; }
        const int L = (i - nl) * G + c; if (L >= n) return false;
        u.pm = 0; u.pn = L >> 4; u.koff = (L & 15) * 256; u.boff = u.koff; u.fl = 4 << 8; return true;
    }
    __device__ __forceinline__ void a_ready(const Unit&) const {}
    __device__ __forceinline__ void done(const Unit&) const {}
};
struct MergeOrder {
    StaticOrder lat; int c, G, nctx;
    __device__ __forceinline__ bool next(int i, Unit& u) const {
        const int nl = lat.c < lat.nwg ? (lat.nwg - lat.c + lat.G - 1) / lat.G : 0;
        if (i < 3 * nl) { lat.next(i / 3, u); u.pm += 1; const int sg = i % 3; u.fl = sg | (sg != 0 ? 4 : 0); u.koff = sg * (MT * 1024); u.boff = sg * (4096 * 1024); return true; }
        const int L = (i - 3 * nl) * G + c; if (L >= nctx) return false;
        u.pm = 0; u.pn = L / 3; const int sg = L % 3; u.fl = sg; u.koff = sg * (MT * 1024); u.boff = sg * (4096 * 1024); return true;
    }
    __device__ __forceinline__ void a_ready(const Unit&) const {}
    __device__ __forceinline__ void done(const Unit&) const {}
};
struct EpiSlab {
    static constexpr bool PERM = false, AFTER_DRAIN = false;
    float* S;
    __device__ __forceinline__ void operator()(const f32x4 (&acc)[2][2][4][2], const Unit& u, int wr, int wc, int fr, int fq) const {
        { const int l_ = mk_lane_id(); fr = l_ & 15; fq = l_ >> 4; }
        const int col0 = u.pn * BM + wc * 32 + 4 * fq; float* base = S + (size_t)(u.koff >> 8) * 256 * DM;
#pragma unroll
        for (int ai = 0; ai < 2; ++ai)
#pragma unroll
            for (int m = 0; m < 4; ++m) { float* p = base + (size_t)(ai * HALF + wr * 64 + m * 16 + fr) * DM + col0;
#pragma unroll
                for (int bj = 0; bj < 2; ++bj)
#pragma unroll
                    for (int n = 0; n < 2; ++n) *(f32x4*)(p + bj * HALF + n * 16) = acc[ai][bj][m][n]; }
    }
};
struct EpiWin {
    static constexpr bool PERM = true, AFTER_DRAIN = false;
    bf16_t* ZB; const float* rc; const float* rs;
    __device__ __forceinline__ void operator()(const f32x4 (&acc)[2][2][4][2], const Unit& u, int wr, int wc, int fr, int fq) const {
        { const int l_ = mk_lane_id(); fr = l_ & 15; fq = l_ >> 4; }
        const int pn = u.pn; int kind = 0, ld = 1024, c0 = 0;
        if (pn < 8) { kind = 1; ld = 2048; c0 = 0; } else if (pn < 10) { ld = 512; c0 = 2048; } else if (pn < 12) { ld = 512; c0 = 2560; } else if (pn < 16) { c0 = 3072; }
        else if (pn < 20) { kind = 2; c0 = 4096; } else if (pn < 24) { kind = 3; c0 = 5120; } else if (pn < 28) { kind = 3; c0 = 6144; } else if (pn < 32) { c0 = 7168; } else { kind = 2; ld = 12288; c0 = 8192; }
        if (kind == 3 && u.pm == 0) kind = 0;
        bf16_t* base = ZB + (size_t)MT * c0; const int colt = pn * BM - c0 + wc * 32 + 8 * fq; const int row0 = u.pm * BM + wr * 64 + fr;
#define EPIWIN_LOOP(...) _Pragma("unroll") for (int ai = 0; ai < 2; ++ai) _Pragma("unroll") for (int m = 0; m < 4; ++m) { const int row = row0 + ai * HALF + m * 16; _Pragma("unroll") for (int bj = 0; bj < 2; ++bj) { \
            const int col = colt + bj * HALF; float v[8]; _Pragma("unroll") for (int n = 0; n < 2; ++n) _Pragma("unroll") for (int i = 0; i < 4; ++i) v[n * 4 + i] = acc[ai][bj][m][n][i]; \
            __VA_ARGS__ \
            u32x4 w; w.x = cvt_pk_bf16(v[0], v[1]); w.y = cvt_pk_bf16(v[2], v[3]); w.z = cvt_pk_bf16(v[4], v[5]); w.w = cvt_pk_bf16(v[6], v[7]); *(u32x4*)(base + (size_t)row * ld + col) = w; } }
        if (kind == 0) { EPIWIN_LOOP(;) }
        else if (kind == 1) { EPIWIN_LOOP(_Pragma("unroll") for (int i = 0; i < 8; ++i) { const float x = v[i], uu = 0.7978845608028654f * (x + 0.044715f * x * x * x); v[i] = x * __builtin_amdgcn_rcpf(1.f + __expf(-2.f * uu)); }) }
        else if (kind == 2) { EPIWIN_LOOP(_Pragma("unroll") for (int i = 0; i < 8; ++i) v[i] = fminf(__builtin_amdgcn_rcpf(1.f + __expf(-v[i])), 1.f);) }
        else {
#pragma unroll
            for (int ai = 0; ai < 2; ++ai) { f32x4 c4[4][2], s4[4][2];
#pragma unroll
                for (int m = 0; m < 4; ++m)
#pragma unroll
                    for (int bj = 0; bj < 2; ++bj) { const int t = row0 + ai * HALF + m * 16 - CTXL, j0 = ((colt + bj * HALF) & 127) >> 1; c4[m][bj] = *(const f32x4*)(rc + t * 64 + j0); s4[m][bj] = *(const f32x4*)(rs + t * 64 + j0); }
                asm volatile("" ::: "memory");
#pragma unroll
                for (int m = 0; m < 4; ++m)
#pragma unroll
                    for (int bj = 0; bj < 2; ++bj) { const int row = row0 + ai * HALF + m * 16, col = colt + bj * HALF; float v[8];
#pragma unroll
                        for (int n = 0; n < 2; ++n)
#pragma unroll
                            for (int i = 0; i < 4; ++i) v[n * 4 + i] = acc[ai][bj][m][n][i];
#pragma unroll
                        for (int i = 0; i < 4; ++i) { const float x1 = v[2 * i], x2 = v[2 * i + 1]; v[2 * i] = x1 * c4[m][bj][i] - x2 * s4[m][bj][i]; v[2 * i + 1] = x1 * s4[m][bj][i] + x2 * c4[m][bj][i]; }
                        u32x4 w; w.x = cvt_pk_bf16(v[0], v[1]); w.y = cvt_pk_bf16(v[2], v[3]); w.z = cvt_pk_bf16(v[4], v[5]); w.w = cvt_pk_bf16(v[6], v[7]); *(u32x4*)(base + (size_t)row * ld + col) = w; }
                asm volatile("" ::: "memory"); } }
#undef EPIWIN_LOOP
    }
};
struct EpiSwiglu {
    static constexpr bool PERM = true, AFTER_DRAIN = false;
    bf16_t* O; int ldc;
    __device__ __forceinline__ void operator()(const f32x4 (&acc)[2][2][4][2], const Unit& u, int wr, int wc, int fr, int fq) const {
        { const int l_ = mk_lane_id(); fr = l_ & 15; fq = l_ >> 4; }
        const int row0 = u.pm * BM + wr * 64 + fr, col0 = u.pn * HALF + wc * 32 + 8 * fq;
#pragma unroll
        for (int ai = 0; ai < 2; ++ai)
#pragma unroll
            for (int m = 0; m < 4; ++m) {
                bf16_t* rowp = O + (size_t)(row0 + ai * HALF + m * 16) * ldc + col0;
                float v[8];
#pragma unroll
                for (int n = 0; n < 2; ++n)
#pragma unroll
                    for (int i = 0; i < 4; ++i) { const float a = acc[ai][0][m][n][i], b = acc[ai][1][m][n][i]; v[n * 4 + i] = a * __builtin_amdgcn_rcpf(1.f + __expf(-a)) * b; }
                u32x4 w; w.x = cvt_pk_bf16(v[0], v[1]); w.y = cvt_pk_bf16(v[2], v[3]); w.z = cvt_pk_bf16(v[4], v[5]); w.w = cvt_pk_bf16(v[6], v[7]);
                *(u32x4*)rowp = w;
            }
    }
};
struct EpiResid {
    static constexpr bool PERM = false, AFTER_DRAIN = false;
    float* X; const float* gate_lat; const float* gate_ctx; const float* XB; float f;
    __device__ __forceinline__ void operator()(const f32x4 (&acc)[2][2][4][2], const Unit& u, int wr, int wc, int fr, int fq) const {
        { const int l_ = mk_lane_id(); fr = l_ & 15; fq = l_ >> 4; }
        const int col0 = u.pn * BM + wc * 32 + 4 * fq;
        const float* gate = (u.pm == 0) ? gate_ctx : gate_lat;
        f32x4 gv[2][2];
#pragma unroll
        for (int bj = 0; bj < 2; ++bj)
#pragma unroll
            for (int n = 0; n < 2; ++n) gv[bj][n] = *(const f32x4*)(gate + col0 + bj * HALF + n * 16) * f;
#pragma unroll
        for (int ai = 0; ai < 2; ++ai) {
            f32x4 x[4][2][2];
            const size_t o0 = (size_t)(u.pm * BM + ai * HALF + wr * 64 + fr) * DM + col0; float* p0 = X + o0; const float* r0 = XB + o0;
#pragma unroll
            for (int m = 0; m < 4; ++m)
#pragma unroll
                for (int bj = 0; bj < 2; ++bj)
#pragma unroll
                    for (int n = 0; n < 2; ++n) x[m][bj][n] = *(const f32x4*)(r0 + (size_t)(m * 16) * DM + bj * HALF + n * 16);
            asm volatile("" ::: "memory");
#pragma unroll
            for (int m = 0; m < 4; ++m)
#pragma unroll
                for (int bj = 0; bj < 2; ++bj)
#pragma unroll
                    for (int n = 0; n < 2; ++n) *(f32x4*)(p0 + (size_t)(m * 16) * DM + bj * HALF + n * 16) = x[m][bj][n] + gv[bj][n] * acc[ai][bj][m][n];
            asm volatile("" ::: "memory");
        }
    }
};
struct EpiResidSlab {
    static constexpr bool PERM = false, AFTER_DRAIN = false;
    unsigned char* wsb; const float* gate_lat; const float* XB; float f;
    __device__ __forceinline__ void operator()(const f32x4 (&acc)[2][2][4][2], const Unit& u, int wr, int wc, int fr, int fq) const {
        if (u.pm == 0) { EpiSlab E{(float*)(wsb + WS_SLAB)}; E(acc, u, wr, wc, fr, fq); }
        else { EpiResid E{(float*)(wsb + WS_XR), gate_lat, gate_lat, XB, f}; E(acc, u, wr, wc, fr, fq); }
    }
};
struct EpiMergeSeg {
    static constexpr bool PERM = true, AFTER_DRAIN = false;
    const bf16_t* Zg; bf16_t* Y; float* MS3;
    __device__ __forceinline__ void operator()(f32x4 (&acc)[2][2][4][2], const Unit& u, int wr, int wc, int fr, int fq) const {
        { const int l_ = mk_lane_id(); fr = l_ & 15; fq = l_ >> 4; }
        const int seg = u.seg(); const bool ctxp = (u.pm == 0);
        const int col0 = u.pn * BM + wc * 32 + 8 * fq;
#pragma unroll
        for (int ai = 0; ai < 2; ++ai) {
            u32x4 ga[4][2], gb[4][2];
#pragma unroll
            for (int m = 0; m < 4; ++m)
#pragma unroll
                for (int bj = 0; bj < 2; ++bj) { const bf16_t* gp = Zg + (size_t)MT * ZC_MG + (size_t)(u.pm * BM + ai * HALF + wr * 64 + m * 16 + fr) * 12288 + seg * 4096 + col0 + bj * HALF;
                    ga[m][bj] = *(const u32x4*)gp; if (!ctxp && seg < 2) gb[m][bj] = *(const u32x4*)(gp + 4096); }
            asm volatile("" ::: "memory");
#pragma unroll
            for (int m = 0; m < 4; ++m)
#pragma unroll
                for (int bj = 0; bj < 2; ++bj) { const size_t row = (size_t)(u.pm * BM + ai * HALF + wr * 64 + m * 16 + fr); const int col = col0 + bj * HALF;
                    const unsigned aw[4] = {ga[m][bj].x, ga[m][bj].y, ga[m][bj].z, ga[m][bj].w};
                    float g[8];
#pragma unroll
                    for (int k = 0; k < 4; ++k) { g[2 * k] = fmaxf(__uint_as_float(aw[k] << 16), 1e-20f); g[2 * k + 1] = fmaxf(__uint_as_float(aw[k] & 0xffff0000u), 1e-20f); }
                    if (!ctxp && seg < 2) { const unsigned bw[4] = {gb[m][bj].x, gb[m][bj].y, gb[m][bj].z, gb[m][bj].w};
#pragma unroll
                        for (int k = 0; k < 4; ++k) { g[2 * k] = g[2 * k] * __builtin_amdgcn_rcpf(fmaxf(__uint_as_float(bw[k] << 16), 1e-20f)); g[2 * k + 1] = g[2 * k + 1] * __builtin_amdgcn_rcpf(fmaxf(__uint_as_float(bw[k] & 0xffff0000u), 1e-20f)); } }
                    float v[8];
#pragma unroll
                    for (int n = 0; n < 2; ++n)
#pragma unroll
                        for (int i = 0; i < 4; ++i) v[n * 4 + i] = acc[ai][bj][m][n][i] * g[n * 4 + i];
                    if (ctxp) { float* ms = MS3 + ((size_t)seg * 256 + row) * DM + col; *(f32x4*)ms = (f32x4){v[0], v[1], v[2], v[3]}; *(f32x4*)(ms + 4) = (f32x4){v[4], v[5], v[6], v[7]}; }
                    else if (seg < 2) { acc[ai][bj][m][0] = (f32x4){v[0], v[1], v[2], v[3]}; acc[ai][bj][m][1] = (f32x4){v[4], v[5], v[6], v[7]}; }
                    else { u32x4 w; w.x = cvt_pk_bf16(v[0], v[1]); w.y = cvt_pk_bf16(v[2], v[3]); w.z = cvt_pk_bf16(v[4], v[5]); w.w = cvt_pk_bf16(v[6], v[7]); *(u32x4*)(Y + row * DM + col) = w; } }
            asm volatile("" ::: "memory");
        }
    }
};
}

constexpr int TSTR = 68, TSCR_BYTES = 64 * TSTR * 4;
__device__ __forceinline__ void transpose_item(const float* __restrict__ W, size_t ldw, int K, int k0, int srccol0, bf16* WT, int dstrow0, LAS float* scr, int lane) {
    const int r4 = lane >> 4, c16 = lane & 15;
    f32x4 v[16];
#pragma unroll
    for (int i = 0; i < 16; ++i) v[i] = __builtin_nontemporal_load((const f32x4*)(W + (size_t)(k0 + 4 * i + r4) * ldw + srccol0 + 4 * c16));
#pragma unroll
    for (int i = 0; i < 16; ++i) *(LAS f32x4*)(scr + (4 * i + r4) * TSTR + 4 * c16) = v[i];
    LDS_WAIT(); asm volatile("" ::: "memory");
    const int c = lane & 7;
#pragma unroll
    for (int j = 0; j < 8; ++j) { const int n = (lane >> 3) + 8 * j; const LAS float* sp = scr + (8 * c) * TSTR + n;
        v4u o; o.x = pk2(sp[0 * TSTR], sp[1 * TSTR]); o.y = pk2(sp[2 * TSTR], sp[3 * TSTR]); o.z = pk2(sp[4 * TSTR], sp[5 * TSTR]); o.w = pk2(sp[6 * TSTR], sp[7 * TSTR]);
        __builtin_nontemporal_store(o, (GAS v4u*)(WT + (size_t)(dstrow0 + n) * K + k0 + 8 * c)); }
    LDS_WAIT(); asm volatile("" ::: "memory");
}

struct Ptrs {
    const float *x, *c, *ctx, *c_ctx, *ada_down, *ada_up, *ada_bias, *norm_g, *w13, *w2, *w_in, *gmlp_norm_g, *gmlp_ws, *gmlp_bs, *gate_b, *mlstm_norm_g, *diff_lambda, *diff_norm_g, *w_branch, *w_out, *final_g;
    float* out; unsigned char* ws;
};

constexpr int IT_W13 = 2 * 64 * 128, IT_W2 = 2 * 64 * 64, IT_WIN = 64 * 320, IT_WB = 3 * 16 * 64, IT_WO = 64 * 64, IT_LAYER = IT_W13 + IT_W2 + IT_WIN + IT_WB + IT_WO;

constexpr int NE = 8192 + 4096 + IT_WIN, NL = IT_WB + IT_WO + 8192 + 4096;
static_assert(NE + NL == IT_LAYER, "lists cover the layer");
__device__ __forceinline__ void convert_range(const Ptrs& P, int l, int list, int it_lo, int it_hi, int widx, int nw, LAS float* scr, int lane) {
    unsigned char* ws = P.ws;
    for (int it = it_lo + widx; it < it_hi; it += nw) {
        int r;
        if (list == 0) r = it < 8192 ? it : it < 12288 ? IT_W13 + (it - 8192) : IT_W13 + IT_W2 + (it - 12288);
        else r = it < IT_WB ? IT_W13 + IT_W2 + IT_WIN + it : it < IT_WB + IT_WO ? IT_W13 + IT_W2 + IT_WIN + it : it < IT_WB + IT_WO + 8192 ? 8192 + (it - IT_WB - IT_WO) : IT_W13 + 4096 + (it - IT_WB - IT_WO - 8192);
        if (r < IT_W13) { const int s = r / (64 * 128), q = r % (64 * 128), kb = q / 128, nb = q % 128, dr = nb * 64, tile = dr >> 8, within = dr & 255;
            const int src = within < 128 ? tile * 128 + within : 4096 + tile * 128 + (within - 128);
            transpose_item(P.w13 + (size_t)(l * 2 + s) * 4096 * 8192, 8192, 4096, kb * 64, src, (bf16*)(ws + WS_W13T) + (size_t)(l * 2 + s) * 8192 * 4096, dr, scr, lane); continue; }
        r -= IT_W13;
        if (r < IT_W2) { const int s = r / (64 * 64), q = r % (64 * 64), kb = q / 64, nb = q % 64;
            transpose_item(P.w2 + (size_t)(l * 2 + s) * 4096 * 4096, 4096, 4096, kb * 64, nb * 64, (bf16*)(ws + WS_W2T) + (size_t)(l * 2 + s) * 4096 * 4096, nb * 64, scr, lane); continue; }
        r -= IT_W2;
        if (r < IT_WIN) { const int kb = r / 320, nb = r % 320, dr = nb * 64, src = dr < 5120 ? dr : dr + 16;
            transpose_item(P.w_in + (size_t)l * 4096 * INC, INC, 4096, kb * 64, src, (bf16*)(ws + WS_WINT) + (size_t)l * NZ * 4096, dr, scr, lane); continue; }
        r -= IT_WIN;
        if (r < IT_WB) { const int i = r / (16 * 64), q = r % (16 * 64), kb = q / 64, nb = q % 64;
            transpose_item(P.w_branch + (size_t)(l * 3 + i) * 1024 * 4096, 4096, 1024, kb * 64, nb * 64, (bf16*)(ws + WS_WBT) + (size_t)(l * 3 + i) * 4096 * 1024, nb * 64, scr, lane); continue; }
        r -= IT_WB;
        { const int kb = r / 64, nb = r % 64;
            transpose_item(P.w_out + (size_t)l * 4096 * 4096, 4096, 4096, kb * 64, nb * 64, (bf16*)(ws + WS_WOT) + (size_t)l * 4096 * 4096, nb * 64, scr, lane); }
    }
}
#ifndef CVP_D
#define CVP_D 9
#endif
#ifndef CVP_T
#define CVP_T 8
#endif
constexpr int CVD = IT_LAYER * CVP_D / 100, CVS = CVD + IT_LAYER * CVP_T / 100;
static_assert(CVS < NL && CVS < NE, "slot sizes");
__device__ __forceinline__ void convert_part(const Ptrs& P, int lnext, int list, int it_lo, int it_hi, int idx, int n, LAS unsigned char* lds, int tid) {
    asm volatile("" : "+v"(tid));
    if (lnext >= DEPTH || idx < 0 || idx >= n) return;
    const int wave = tid >> 6, lane = tid & 63;
    convert_range(P, lnext, list, it_lo, it_hi, idx * NWAVES + wave, n * NWAVES, (LAS float*)(lds + RING_OFF + wave * TSCR_BYTES), lane);
}
__device__ __forceinline__ void convert_idle(const Ptrs& P, int lnext, int list, int it_lo, int it_hi, int first_idle, int gend, LAS unsigned char* lds, int bid, int tid) {
    if (gend < first_idle + 16) first_idle = 0;
    if (bid >= gend) return;
    convert_part(P, lnext, list, it_lo, it_hi, bid - first_idle, gend - first_idle, lds, tid);
}
__device__ __forceinline__ void pro0(const Ptrs& P, LAS unsigned char* lds, int bid, int G, int tid) {
    asm volatile("" : "+v"(tid));
    const int wave = tid >> 6, lane = tid & 63;
    LAS float* scr = (LAS float*)(lds + RING_OFF + wave * TSCR_BYTES);
    const int gw = bid * NWAVES + wave, NGW = G * NWAVES;
    unsigned char* ws = P.ws;
    convert_range(P, 0, 0, 0, NE, gw, NGW, scr, lane);
    for (int l = 1; l < DEPTH; ++l) convert_range(P, l, 0, CVS, NE, gw, NGW, scr, lane);
    const int gt = bid * NTHR + tid, NGT = G * NTHR;
    { float* rc = (float*)(ws + WS_ROPE); float* rs = rc + SEQ * 64;
      for (int i = gt; i < SEQ * 64; i += NGT) { const int t = i >> 6, j = i & 63; const float inv = powf(10000.f, -(float)(j & 31) / 32.f);
          const float pos = (float)(j < 32 ? (t >> 6) : (t & 63)); const float ang = pos * inv; rc[i] = cosf(ang); rs[i] = sinf(ang); } }
    { float* tp = (float*)(ws + WS_MODTP);
      for (int task = gw; task < DEPTH * 2 * 4 * 64; task += NGW) { const int dc = task & 63, rg = (task >> 6) & 3, w = (task >> 8) & 1, l = task >> 9;
          const float* cv = w ? P.c_ctx : P.c; const float* dn = P.ada_down + (size_t)l * DM * ADAR + (size_t)(dc * 64) * ADAR + rg * 64 + lane;
          float wv[64]; const float cmine = cv[dc * 64 + lane], smine = cmine / (1.f + expf(-cmine));
#pragma unroll
          for (int d = 0; d < 64; ++d) wv[d] = dn[(size_t)d * ADAR];
          asm volatile("" ::: "memory");
          float acc = 0.f;
#pragma unroll
          for (int d = 0; d < 64; ++d) acc += __int_as_float(__builtin_amdgcn_readlane(__float_as_int(smine), d)) * wv[d];
          tp[((l * 2 + w) * 64 + dc) * 256 + rg * 64 + lane] = acc; } }
    if (bid == 0 && tid < DEPTH) { const float* dl = P.diff_lambda + tid * 4 * 128; float s1 = 0.f, s2 = 0.f;
        for (int i = 0; i < 128; ++i) { s1 += dl[i] * dl[128 + i]; s2 += dl[256 + i] * dl[384 + i]; }
        ((float*)(ws + WS_LAM))[tid] = expf(s1) - expf(s2) + lambda_init_f(tid); }
    { bf16* wb = (bf16*)(ws + WS_GWSB); for (int i = gt; i < DEPTH * 8 * 128 * 128; i += NGT) wb[i] = (bf16)f2bf(P.gmlp_ws[i]); }
    { bf16* wg = (bf16*)(ws + WS_WG16);
      for (int i = gt; i < DEPTH * DM * 16; i += NGT) { const int j = i & 15, d = (i >> 4) & (DM - 1), l = i >> 16;
          wg[((size_t)l * 16 + j) * DM + d] = (bf16)f2bf(P.w_in[((size_t)l * DM + d) * INC + 5120 + j]); } }
}

__device__ __forceinline__ void pro1(const Ptrs& P, LAS unsigned char* lds, int bid, int G, int tid) {
    asm volatile("" : "+v"(tid));
    LAS float* T = (LAS float*)(lds + RING_OFF);
    const float* tp = (const float*)(P.ws + WS_MODTP);
    for (int i = tid; i < DEPTH * 2 * 256; i += NTHR) { const int r = i & 255, lw = i >> 8; float s = 0.f;
        for (int dc = 0; dc < 64; ++dc) s += tp[(lw * 64 + dc) * 256 + r];
        T[i] = s; }
    __syncthreads();
    float* MOD = (float*)(P.ws + WS_MOD);
    for (int i = bid * NTHR + tid; i < DEPTH * NMOD; i += G * NTHR) { const int l = i / NMOD, n = i % NMOD;
        const float* up = P.ada_up + (size_t)l * ADAR * NMOD + n; const float b = P.ada_bias[(size_t)l * NMOD + n]; float a0 = b, a1 = b;
#pragma unroll 1
        for (int r0 = 0; r0 < ADAR; r0 += 32) { float uu[32];
#pragma unroll
            for (int k = 0; k < 32; ++k) uu[k] = up[(size_t)(r0 + k) * NMOD];
            asm volatile("" ::: "memory");
#pragma unroll
            for (int k = 0; k < 32; ++k) { a0 += T[(l * 2 + 0) * 256 + r0 + k] * uu[k]; a1 += T[(l * 2 + 1) * 256 + r0 + k] * uu[k]; } }
        MOD[(size_t)(l * 2 + 0) * NMOD + n] = a0; MOD[(size_t)(l * 2 + 1) * NMOD + n] = a1; }
    __syncthreads();
}

__device__ __forceinline__ void phase_norm(float* XR, const float* rdl, const float* rdc, const float* prec, const float* g, const float* modl, const float* modc, bf16* H, const float* slab, const float* cgate, float cf, LAS unsigned char* lds, int bid, int G, int tid) {
    asm volatile("" : "+v"(tid));
    const int wave = tid >> 6, lane = tid & 63;
    LAS f32x4* AL = (LAS f32x4*)lds; LAS f32x4* SL = AL + 1024; LAS f32x4* AC = AL + 2048; LAS f32x4* SC = AL + 3072;
    { f32x4 q[2][5];
#pragma unroll
      for (int k = 0; k < 2; ++k) { const int i = tid + k * NTHR; q[k][0] = ((const f32x4*)g)[i]; q[k][1] = ((const f32x4*)(modl + DM))[i]; q[k][2] = ((const f32x4*)modl)[i]; q[k][3] = ((const f32x4*)(modc + DM))[i]; q[k][4] = ((const f32x4*)modc)[i]; }
      asm volatile("" ::: "memory");
#pragma unroll
      for (int k = 0; k < 2; ++k) { const int i = tid + k * NTHR; AL[i] = q[k][0] * (q[k][1] + 1.f); SL[i] = q[k][2]; AC[i] = q[k][0] * (q[k][3] + 1.f); SC[i] = q[k][4]; } }
    const int row0 = bid * NWAVES + wave, stride = G * NWAVES;
    if (slab && row0 < CTXL) {
        f32x4* xw = (f32x4*)(XR + (size_t)row0 * DM) + lane; const f32x4* xpre = (const f32x4*)(prec + (size_t)row0 * DM) + lane; const f32x4* sp = (const f32x4*)(slab + (size_t)row0 * DM) + lane; const f32x4* gp = (const f32x4*)cgate + lane;
#pragma unroll 1
        for (int j = 0; j < 16; j += 2) { f32x4 q[2][16], xo[2];
#pragma unroll
            for (int jj = 0; jj < 2; ++jj) { xo[jj] = xpre[64 * (j + jj)];
#pragma unroll
                for (int kc = 0; kc < 16; ++kc) q[jj][kc] = sp[(size_t)kc * 256 * (DM / 4) + 64 * (j + jj)]; }
            asm volatile("" ::: "memory");
#pragma unroll
            for (int jj = 0; jj < 2; ++jj) { f32x4 a = (f32x4){0.f, 0.f, 0.f, 0.f};
#pragma unroll
                for (int kc = 0; kc < 16; ++kc) a += q[jj][kc];
                xw[64 * (j + jj)] = xo[jj] + a * gp[64 * (j + jj)] * cf; }
            asm volatile("" ::: "memory"); }
        asm volatile("s_waitcnt vmcnt(0)" ::: "memory");
    }
    __syncthreads();
    f32x4 v[16];
    if (row0 < MT) { const f32x4* xr = (const f32x4*)((row0 < CTXL ? rdc : rdl) + (size_t)row0 * DM) + lane;
#pragma unroll
        for (int j = 0; j < 16; ++j) v[j] = xr[64 * j]; }
    for (int row = row0; row < MT; row += stride) {
        f32x4 vn[16];
        if (row + stride < MT) { const f32x4* xr = (const f32x4*)(rdl + (size_t)(row + stride) * DM) + lane;
#pragma unroll
            for (int j = 0; j < 16; ++j) vn[j] = xr[64 * j]; }
        float ss = 0.f;
#pragma unroll
        for (int j = 0; j < 16; ++j) ss += (v[j].x * v[j].x + v[j].y * v[j].y) + (v[j].z * v[j].z + v[j].w * v[j].w);
        const float rstd = 1.f / sqrtf(wave_sum(ss) * (1.f / DM) + EPS);
        const LAS f32x4* Ap = row < CTXL ? AC : AL; const LAS f32x4* Sp = row < CTXL ? SC : SL;
        uint2* hr = (uint2*)(H + (size_t)row * DM) + lane;
#pragma unroll
        for (int j = 0; j < 16; ++j) { const f32x4 hv = v[j] * rstd * Ap[lane + 64 * j] + Sp[lane + 64 * j];
            uint2 o; o.x = pk2(hv.x, hv.y); o.y = pk2(hv.z, hv.w); hr[64 * j] = o; }
#pragma unroll
        for (int j = 0; j < 16; ++j) v[j] = vn[j];
    }
    __syncthreads();
}
typedef float f32x4g __attribute__((ext_vector_type(4)));
__device__ __forceinline__ void gates_unit(const bf16* H, const bf16* WGb, float* G16, int jb, int tid) {
    asm volatile("" : "+v"(tid));
    const int wave = tid >> 6, lane = tid & 63, fr = lane & 15, fq = lane >> 4;
    const bf16* ap = H + (size_t)(jb * 128 + wave * 16 + fr) * DM + 8 * fq; const bf16* bp = WGb + (size_t)fr * DM + 8 * fq;
    f32x4g acc[4];
#pragma unroll
    for (int i = 0; i < 4; ++i) acc[i] = (f32x4g){0.f, 0.f, 0.f, 0.f};
#pragma unroll 1
    for (int k = 0; k < DM; k += 512) { bf16x8 af[16], bfv[16];
#pragma unroll
        for (int i = 0; i < 16; ++i) { af[i] = *(const bf16x8*)(ap + k + 32 * i); bfv[i] = *(const bf16x8*)(bp + k + 32 * i); }
        asm volatile("" ::: "memory");
#pragma unroll
        for (int i = 0; i < 16; ++i) acc[i & 3] = __builtin_amdgcn_mfma_f32_16x16x32_bf16(af[i], bfv[i], acc[i & 3], 0, 0, 0);
    }
    const f32x4g sres = (acc[0] + acc[1]) + (acc[2] + acc[3]);
#pragma unroll
    for (int r = 0; r < 4; ++r) G16[(size_t)(jb * 128 + wave * 16 + 4 * fq + r) * 16 + fr] = sres[r];
}

__device__ __forceinline__ void phase_final(const float* XR, const float* g, float* out, int bid, int G, int tid) {
    asm volatile("" : "+v"(tid));
    const int wave = tid >> 6, lane = tid & 63;
    f32x4 gg[16];
#pragma unroll
    for (int j = 0; j < 16; ++j) gg[j] = *(const f32x4*)(g + 4 * lane + 256 * j);
    for (int t = bid * NWAVES + wave; t < SEQ; t += G * NWAVES) {
        const f32x4* xr = (const f32x4*)(XR + (size_t)(CTXL + t) * DM) + lane;
        f32x4 v[16]; float ss = 0.f;
#pragma unroll
        for (int j = 0; j < 16; ++j) { v[j] = xr[64 * j]; ss += (v[j].x * v[j].x + v[j].y * v[j].y) + (v[j].z * v[j].z + v[j].w * v[j].w); }
        const float rstd = 1.f / sqrtf(wave_sum(ss) * (1.f / DM) + EPS);
        f32x4* o = (f32x4*)(out + (size_t)t * DM) + lane;
#pragma unroll
        for (int j = 0; j < 16; ++j) o[64 * j] = v[j] * rstd * gg[j];
    }
}

typedef short s16x4 __attribute__((ext_vector_type(4)));
typedef float f32x16 __attribute__((ext_vector_type(16)));
typedef short v4i16_t __attribute__((ext_vector_type(4)));
__device__ __forceinline__ int crow16(int r, int hi) { return (r & 3) + 8 * (r >> 2) + 4 * hi; }
__device__ __forceinline__ int chain_cidx(int dir, int jb) { return dir ? (jb < 2 ? 1 - jb : 67 - jb) : jb; }
__device__ __forceinline__ s16x4 trr(LAS const unsigned char* p) { return __builtin_bit_cast(s16x4, __builtin_amdgcn_ds_read_tr16_b64_v4i16((LAS v4i16_t*)p)); }
__device__ __forceinline__ bf16x8 trfrag(LAS const unsigned char* im, int RS, int rowA, int rowB, int n0, int lane) {
    const int i = lane & 15, q = i >> 2, p = i & 3, cb = n0 + 16 * ((lane >> 4) & 1) + 4 * p;
    const s16x4 lo = trr(im + (rowA + q) * RS + cb * 2), hi = trr(im + (rowB + q) * RS + cb * 2);
    return (bf16x8){lo[0], lo[1], lo[2], lo[3], hi[0], hi[1], hi[2], hi[3]};
}
constexpr int VSTR = 528, KW_OFF = 67584;
constexpr int SM_OFF = 133120;
__device__ __forceinline__ void gate_scan(const float* G16, const float* gate_b, int jb, int h, LAS float* SM, int tid) {
    LAS float* SC = SM + 768;
    const int dir = (tid >> 7) & 1, c = tid & 127, o = dir ? 127 - c : c; const bool act = tid < 256;
    float ip = 0.f, x = 0.f;
    if (act) { const size_t row = (size_t)jb * 128 + o; ip = G16[row * 16 + dir * 8 + h] + gate_b[dir * 8 + h]; const float fp = G16[row * 16 + dir * 8 + 4 + h] + gate_b[dir * 8 + 4 + h];
        x = fminf(fp, 0.f) - __logf(1.f + __expf(-fabsf(fp))); }
    for (int s = 1; s < 128; s <<= 1) { if (act) SC[dir * 128 + c] = x; __syncthreads(); if (act && c >= s) x += SC[dir * 128 + c - s]; __syncthreads(); }
    const float b = x, u = ip - b; float y = u;
    for (int s = 1; s < 128; s <<= 1) { if (act) SC[dir * 128 + c] = y; __syncthreads(); if (act && c >= s) y = fmaxf(y, SC[dir * 128 + c - s]); __syncthreads(); }
    if (act) { SM[dir * 128 + o] = u; SM[256 + dir * 128 + o] = y; SM[512 + dir * 128 + o] = b; if (c == 127) { SM[1024 + dir] = b; SM[1026 + dir] = y; } }
    __syncthreads();
}
__device__ __forceinline__ void stage_v(const bf16* Z, size_t row0, int h, LAS unsigned char* VL, int tid) {
    v4u t[8];
#pragma unroll
    for (int k = 0; k < 8; ++k) { const int i = tid + k * NTHR, sr = i >> 5, ch = i & 31; t[k] = *(const v4u*)(Z + (size_t)MT * ZC_MV + (row0 + sr) * 1024 + h * 256 + ch * 8); }
    asm volatile("" ::: "memory");
#pragma unroll
    for (int k = 0; k < 8; ++k) { const int i = tid + k * NTHR, sr = i >> 5, ch = i & 31; *(LAS v4u*)(VL + sr * VSTR + ch * 16) = t[k]; }
}
__device__ __forceinline__ void mlstm_m1_unit(const bf16* Z, const float* G16, const float* gate_b, float* DCT, float* DN, float* CH, int jb, int h, LAS unsigned char* lds, int tid) {
    asm volatile("" : "+v"(tid));
    const int wave = tid >> 6, lane = tid & 63, hh = lane >> 5;
    LAS unsigned char* VL = lds; LAS unsigned char* KW = lds + KW_OFF; LAS float* SM = (LAS float*)(lds + SM_OFF);
    gate_scan(G16, gate_b, jb, h, SM, tid);
    const size_t row0 = (size_t)jb * 128;
    stage_v(Z, row0, h, VL, tid);
    { v4u kq[4];
#pragma unroll
      for (int k = 0; k < 4; ++k) { const int i = tid + k * NTHR, sr = i >> 4, ch = i & 15; kq[k] = *(const v4u*)(Z + (size_t)MT * ZC_MK + (row0 + sr) * 512 + h * 128 + ch * 8); }
      asm volatile("" ::: "memory");
#pragma unroll
      for (int k = 0; k < 4; ++k) { const int i = tid + k * NTHR, sr = i >> 4, ch = i & 15; const v4u kw = kq[k];
#pragma unroll
        for (int dir = 0; dir < 2; ++dir) { const float wg = __expf(SM[dir * 128 + sr] - SM[1026 + dir]); v4u o;
            o.x = pk2(bflo(kw.x) * wg, bfhi(kw.x) * wg); o.y = pk2(bflo(kw.y) * wg, bfhi(kw.y) * wg); o.z = pk2(bflo(kw.z) * wg, bfhi(kw.z) * wg); o.w = pk2(bflo(kw.w) * wg, bfhi(kw.w) * wg);
            *(LAS v4u*)(KW + dir * 32768 + sr * 256 + ch * 16) = o; } } }
    __syncthreads();
    const int dir = wave >> 2, ebp = wave & 3;
    f32x16 acc[2][4];
#pragma unroll
    for (int a = 0; a < 2; ++a)
#pragma unroll
        for (int b = 0; b < 4; ++b)
#pragma unroll
            for (int r = 0; r < 16; ++r) acc[a][b][r] = 0.f;
#pragma unroll 2
    for (int ks = 0; ks < 8; ++ks) {
        bf16x8 af[2], bfr[4];
#pragma unroll
        for (int eb = 0; eb < 2; ++eb) af[eb] = trfrag(VL, VSTR, 16 * ks + 8 * hh, 16 * ks + 8 * hh + 4, 32 * (2 * ebp + eb), lane);
#pragma unroll
        for (int db = 0; db < 4; ++db) bfr[db] = trfrag(KW + dir * 32768, 256, 16 * ks + 8 * hh, 16 * ks + 8 * hh + 4, 32 * db, lane);
#pragma unroll
        for (int eb = 0; eb < 2; ++eb)
#pragma unroll
            for (int db = 0; db < 4; ++db) acc[eb][db] = __builtin_amdgcn_mfma_f32_32x32x16_bf16(af[eb], bfr[db], acc[eb][db], 0, 0, 0);
    }
    { const int cidx = chain_cidx(dir, jb); float* dst = DCT + (size_t)((dir * 4 + h) * 66 + cidx) * 32768;
#pragma unroll
      for (int eb = 0; eb < 2; ++eb)
#pragma unroll
          for (int db = 0; db < 4; ++db)
#pragma unroll
              for (int r = 0; r < 16; ++r) dst[(32 * (2 * ebp + eb) + crow16(r, hh)) * 128 + 32 * db + (lane & 31)] = acc[eb][db][r]; }
    if (tid < 256) { const int dd = tid >> 7, d = tid & 127; float s = 0.f;
        for (int sg = 0; sg < 128; ++sg) s += bf2f(*(LAS const unsigned short*)(KW + dd * 32768 + sg * 256 + d * 2));
        DN[(size_t)((dd * 4 + h) * 66 + chain_cidx(dd, jb)) * 128 + d] = s; }
    if (tid < 2) { float* c = CH + (size_t)((tid * 4 + h) * 66 + chain_cidx(tid, jb)) * 2; c[0] = SM[1024 + tid]; c[1] = SM[1026 + tid]; }
    __syncthreads();
}
__device__ __forceinline__ void mlstm_m2_scalars(const float* CH, int chain, LAS float* SC, int tid) {
    if (tid < 66) { SC[256 + 2 * tid] = CH[(size_t)(chain * 66 + tid) * 2]; SC[256 + 2 * tid + 1] = CH[(size_t)(chain * 66 + tid) * 2 + 1]; }
    __syncthreads();
    if (tid == 0) { float m = 0.f;
        for (int j = 0; j < 66; ++j) { const float Bj = SC[256 + 2 * j], cm = SC[256 + 2 * j + 1], Mx = fmaxf(m, cm); SC[3 * j] = __expf(m - Mx); SC[3 * j + 1] = __expf(cm - Mx); SC[3 * j + 2] = m; m = Bj + Mx; } }
    __syncthreads();
}
__device__ __forceinline__ void mlstm_m2(const float* DCT, const float* DN, const float* CH, bf16* CT, float* NS, float* MS, LAS unsigned char* lds, int bid, int G, int tid) {
    asm volatile("" : "+v"(tid));
    LAS float* SC = (LAS float*)lds;
    for (int base = bid * NTHR; base < 8 * 16384; base += G * NTHR) {
        const int chain = base >> 14, p = (base & 16383) + tid;
        mlstm_m2_scalars(CH, chain, SC, tid);
        if ((base & 16383) == 0 && tid < 66) MS[chain * 66 + tid] = SC[3 * tid + 2];
        const float* dl = DCT + (size_t)chain * 66 * 32768 + 2 * p; unsigned* ct = (unsigned*)(CT + (size_t)chain * 66 * 32768 + 2 * p);
        float c0 = 0.f, c1 = 0.f;
#pragma unroll 1
        for (int jb = 0; jb < 66; jb += 11) { float2 d[11];
#pragma unroll
            for (int k = 0; k < 11; ++k) d[k] = *(const float2*)(dl + (size_t)(jb + k) * 32768);
            asm volatile("" ::: "memory");
#pragma unroll
            for (int k = 0; k < 11; ++k) { const float dec = SC[3 * (jb + k)], sc = SC[3 * (jb + k) + 1]; ct[(size_t)(jb + k) * 16384] = pk2(c0, c1); c0 = dec * c0 + sc * d[k].x; c1 = dec * c1 + sc * d[k].y; }
            asm volatile("" ::: "memory"); }
        __syncthreads();
    }
    for (int chain = bid; chain < 8; chain += G) {
        mlstm_m2_scalars(CH, chain, SC, tid);
        if (tid < 128) { float c0 = 0.f;
#pragma unroll 1
            for (int jb = 0; jb < 66; jb += 11) { float d[11];
#pragma unroll
                for (int k = 0; k < 11; ++k) d[k] = DN[(size_t)(chain * 66 + jb + k) * 128 + tid];
                asm volatile("" ::: "memory");
#pragma unroll
                for (int k = 0; k < 11; ++k) { NS[(size_t)(chain * 66 + jb + k) * 128 + tid] = c0; c0 = SC[3 * (jb + k)] * c0 + SC[3 * (jb + k) + 1] * d[k]; }
                asm volatile("" ::: "memory"); } }
        __syncthreads();
    }
}
__device__ __forceinline__ void mlstm_m3_unit(const bf16* Z, const float* G16, const float* gate_b, const bf16* CT, const float* NS, const float* MS, const float* mng, bf16* YB, int jb, int h, LAS unsigned char* lds, int tid) {
    asm volatile("" : "+v"(tid));
    const int wave = tid >> 6, lane = tid & 63, hh = lane >> 5, l31 = lane & 31;
    LAS unsigned char* VL = lds; LAS float* XCH = (LAS float*)lds; LAS float* SM = (LAS float*)(lds + SM_OFF);
    gate_scan(G16, gate_b, jb, h, SM, tid);
    const size_t row0 = (size_t)jb * 128;
    if (tid < 256) { const int dd = tid >> 7, d = tid & 127; SM[1040 + dd * 128 + d] = NS[(size_t)((dd * 4 + h) * 66 + chain_cidx(dd, jb)) * 128 + d]; }
    if (tid < 2) SM[1028 + tid] = MS[(tid * 4 + h) * 66 + chain_cidx(tid, jb)];
    stage_v(Z, row0, h, VL, tid);
    __syncthreads();
    const int tb = wave & 3, dir = wave >> 2, tau = 32 * tb + l31;
    float SCL = 0.08838834764831845f; asm volatile("" : "+v"(SCL));
    const float m = SM[1028 + dir], cmT = SM[256 + dir * 128 + tau], bT = SM[512 + dir * 128 + tau];
    const float Mt = fmaxf(m, cmT), wa = __expf(m - Mt), em = __expf(-(bT + Mt)), fa = wa * SCL;
    bf16x8 qf[8];
#pragma unroll
    for (int ks = 0; ks < 8; ++ks) qf[ks] = *(const bf16x8*)(Z + (size_t)MT * ZC_MQ + (row0 + tau) * 512 + h * 128 + 16 * ks + 8 * hh);
    f32x16 acc[8];
#pragma unroll
    for (int eb = 0; eb < 8; ++eb)
#pragma unroll
        for (int r = 0; r < 16; ++r) acc[eb][r] = 0.f;
    { const bf16* ct = CT + (size_t)((dir * 4 + h) * 66 + chain_cidx(dir, jb)) * 32768;
#pragma unroll
      for (int e2 = 0; e2 < 8; e2 += 2) { bf16x8 af[2][8];
#pragma unroll
          for (int eb = 0; eb < 2; ++eb)
#pragma unroll
              for (int ks = 0; ks < 8; ++ks) af[eb][ks] = *(const bf16x8*)(ct + (size_t)(32 * (e2 + eb) + l31) * 128 + 16 * ks + 8 * hh);
          asm volatile("" ::: "memory");
#pragma unroll
          for (int ks = 0; ks < 8; ++ks) { acc[e2] = __builtin_amdgcn_mfma_f32_32x32x16_bf16(af[0][ks], qf[ks], acc[e2], 0, 0, 0); acc[e2 + 1] = __builtin_amdgcn_mfma_f32_32x32x16_bf16(af[1][ks], qf[ks], acc[e2 + 1], 0, 0, 0); } } }
    asm volatile("" ::: "memory");
    float den = 0.f;
#pragma unroll
    for (int ks = 0; ks < 8; ++ks)
#pragma unroll
        for (int j = 0; j < 8; ++j) den += bf2f((unsigned short)qf[ks][j]) * SM[1040 + dir * 128 + 16 * ks + 8 * hh + j];
    den *= fa;
#pragma unroll
    for (int eb = 0; eb < 8; ++eb)
#pragma unroll
        for (int r = 0; r < 16; ++r) acc[eb][r] *= fa;
    asm volatile("" ::: "memory");
#pragma unroll 1
    for (int sb = 0; sb < 4; ++sb) {
        if (dir == 0 ? sb > tb : sb < tb) continue;
        asm volatile("" ::: "memory");
        f32x16 p;
#pragma unroll
        for (int r = 0; r < 16; ++r) p[r] = 0.f;
#pragma unroll
        for (int kh = 0; kh < 2; ++kh) { bf16x8 kf[4];
#pragma unroll
          for (int ks = 0; ks < 4; ++ks) kf[ks] = *(const bf16x8*)(Z + (size_t)MT * ZC_MK + (row0 + 32 * sb + l31) * 512 + h * 128 + 16 * (4 * kh + ks) + 8 * hh);
          asm volatile("" ::: "memory");
#pragma unroll
          for (int ks = 0; ks < 4; ++ks) p = __builtin_amdgcn_mfma_f32_32x32x16_bf16(kf[ks], qf[4 * kh + ks], p, 0, 0, 0); }
#pragma unroll
        for (int r = 0; r < 16; ++r) { const int sg = 32 * sb + crow16(r, hh); const bool keep = dir == 0 ? (sg <= tau) : (sg >= tau);
            const float w = keep ? __expf(SM[dir * 128 + sg] - Mt) * SCL : 0.f; p[r] *= w; den += p[r]; }
#pragma unroll
        for (int s = 0; s < 2; ++s) {
            v4u w4; w4.x = pk2(p[8 * s + 0], p[8 * s + 1]); w4.y = pk2(p[8 * s + 2], p[8 * s + 3]); w4.z = pk2(p[8 * s + 4], p[8 * s + 5]); w4.w = pk2(p[8 * s + 6], p[8 * s + 7]);
            const bf16x8 bfrag = __builtin_bit_cast(bf16x8, w4);
#pragma unroll
            for (int eb = 0; eb < 8; ++eb) { const bf16x8 a = trfrag(VL, VSTR, 32 * sb + 16 * s + 4 * hh, 32 * sb + 16 * s + 8 + 4 * hh, 32 * eb, lane);
                acc[eb] = __builtin_amdgcn_mfma_f32_32x32x16_bf16(a, bfrag, acc[eb], 0, 0, 0);
                if (eb & 1) { asm volatile("" ::: "memory"); } }
        }
    }
    den += shfl_xor_f(den, 32);
    { const float inv = 1.f / fmaxf(fabsf(den), em);
#pragma unroll
      for (int eb = 0; eb < 8; ++eb)
#pragma unroll
          for (int r = 0; r < 16; ++r) acc[eb][r] *= inv; }
    __syncthreads();
    LAS float* HS = (LAS float*)lds;
    if (dir == 1) {
#pragma unroll
        for (int eb = 0; eb < 8; ++eb)
#pragma unroll
            for (int r = 0; r < 16; ++r) HS[tau * 257 + 32 * eb + crow16(r, hh)] = acc[eb][r];
    }
    __syncthreads();
    if (dir == 0) {
#pragma unroll
        for (int eb = 0; eb < 8; ++eb)
#pragma unroll
            for (int r = 0; r < 16; ++r) HS[tau * 257 + 32 * eb + crow16(r, hh)] += acc[eb][r];
    }
    __syncthreads();
    {
        unsigned short og[16][4]; float gn[4];
#pragma unroll
        for (int rr = 0; rr < 16; ++rr)
#pragma unroll
            for (int k = 0; k < 4; ++k) og[rr][k] = Z[(size_t)MT * ZC_MO + (row0 + wave * 16 + rr) * 1024 + h * 256 + 64 * k + lane];
#pragma unroll
        for (int k = 0; k < 4; ++k) gn[k] = mng[h * 256 + 64 * k + lane];
#pragma unroll
        for (int rr = 0; rr < 16; ++rr) { const int t2 = wave * 16 + rr; float v[4]; float ss = 0.f;
#pragma unroll
            for (int k = 0; k < 4; ++k) { v[k] = HS[t2 * 257 + 64 * k + lane]; ss += v[k] * v[k]; }
            const float rstd = 1.f / sqrtf(wave_sum(ss) * (1.f / 256.f) + EPS); const size_t row = row0 + t2;
#pragma unroll
            for (int k = 0; k < 4; ++k) YB[row * 1024 + h * 256 + 64 * k + lane] = (bf16)f2bf(bf2f(og[rr][k]) * v[k] * rstd * gn[k]); }
    }
    __syncthreads();
}
__device__ __forceinline__ void gmlp_unit_mfma(const bf16* Z, const float* gng, const bf16* wsb  , const float* bs  , bf16* YA, int j, LAS unsigned char* lds, int tid) {
    asm volatile("" : "+v"(tid));
    const int wave = tid >> 6, lane = tid & 63, g = wave;
    LAS float* ST = (LAS float*)(lds + SM_OFF);
    LAS float* BSL = ST + 256;
    BSL[tid] = bs[tid]; BSL[tid + NTHR] = bs[tid + NTHR];
    LAS unsigned char* VN = lds + wave * 16384;
    const size_t row0 = (size_t)j * 128;
#pragma unroll 1
    for (int rb = 0; rb < 16; rb += 4) { v4u wq[4][2];
#pragma unroll
        for (int r4 = 0; r4 < 4; ++r4) { const v4u* zp = (const v4u*)(Z + (row0 + wave * 16 + rb + r4) * 2048 + 1024 + lane * 16); wq[r4][0] = zp[0]; wq[r4][1] = zp[1]; }
        asm volatile("" ::: "memory");
#pragma unroll
        for (int r4 = 0; r4 < 4; ++r4) { const int q = wave * 16 + rb + r4; const v4u w0 = wq[r4][0], w1 = wq[r4][1];
            float x[16]; const unsigned ww[8] = {w0.x, w0.y, w0.z, w0.w, w1.x, w1.y, w1.z, w1.w};
            float s = 0.f;
#pragma unroll
            for (int k = 0; k < 8; ++k) { x[2 * k] = bflo(ww[k]); x[2 * k + 1] = bfhi(ww[k]); s += x[2 * k] + x[2 * k + 1]; }
            const float mean = wave_sum(s) * (1.f / 1024.f); float s2 = 0.f;
#pragma unroll
            for (int k = 0; k < 16; ++k) { const float d = x[k] - mean; s2 += d * d; }
            const float rstd = 1.f / sqrtf(wave_sum(s2) * (1.f / 1024.f) + EPS);
            if (lane == 0) { ST[2 * q] = mean; ST[2 * q + 1] = rstd; } } }
    __syncthreads();
#pragma unroll 1
    for (int h = 0; h < 2; ++h) {
        const int ln = mk_lane_id(), hh = ln >> 5, l31 = ln & 31;
        const int cbase = g * 128 + 64 * h, c8 = (ln & 7) * 8;
        { const f32x4 g0 = *(const f32x4*)(gng + cbase + c8), g1 = *(const f32x4*)(gng + cbase + c8 + 4);
#pragma unroll 1
          for (int ib = 0; ib < 16; ib += 4) { v4u wv[4];
#pragma unroll
            for (int i4 = 0; i4 < 4; ++i4) wv[i4] = *(const v4u*)(Z + (row0 + (ib + i4) * 8 + (ln >> 3)) * 2048 + 1024 + cbase + c8);
            asm volatile("" ::: "memory");
#pragma unroll
            for (int i4 = 0; i4 < 4; ++i4) { const int q = (ib + i4) * 8 + (ln >> 3); const float mean = ST[2 * q], rstd = ST[2 * q + 1]; const v4u w = wv[i4]; v4u o;
              o.x = pk2((bflo(w.x) - mean) * rstd * g0.x, (bfhi(w.x) - mean) * rstd * g0.y); o.y = pk2((bflo(w.y) - mean) * rstd * g0.z, (bfhi(w.y) - mean) * rstd * g0.w);
              o.z = pk2((bflo(w.z) - mean) * rstd * g1.x, (bfhi(w.z) - mean) * rstd * g1.y); o.w = pk2((bflo(w.w) - mean) * rstd * g1.z, (bfhi(w.w) - mean) * rstd * g1.w);
              *(LAS v4u*)(VN + q * 128 + (ln & 7) * 16) = o; } } }
        LDS_WAIT(); asm volatile("" ::: "memory");
        bf16x8 bfr[8][2];
#pragma unroll
        for (int ks = 0; ks < 8; ++ks)
#pragma unroll
            for (int cb = 0; cb < 2; ++cb) bfr[ks][cb] = trfrag(VN, 128, 16 * ks + 8 * hh, 16 * ks + 8 * hh + 4, 32 * cb, ln);
        f32x16 acc[4][2];
#pragma unroll
        for (int pb = 0; pb < 4; ++pb)
#pragma unroll
            for (int cb = 0; cb < 2; ++cb)
#pragma unroll
                for (int r = 0; r < 16; ++r) acc[pb][cb][r] = 0.f;
#pragma unroll
        for (int pb = 0; pb < 4; ++pb) {
            bf16x8 af[8];
#pragma unroll
            for (int ks = 0; ks < 8; ++ks) af[ks] = *(const bf16x8*)(wsb + (size_t)(g * 128 + 32 * pb + l31) * 128 + 16 * ks + 8 * hh);
            asm volatile("" ::: "memory");
#pragma unroll
            for (int ks = 0; ks < 8; ++ks) { acc[pb][0] = __builtin_amdgcn_mfma_f32_32x32x16_bf16(af[ks], bfr[ks][0], acc[pb][0], 0, 0, 0); acc[pb][1] = __builtin_amdgcn_mfma_f32_32x32x16_bf16(af[ks], bfr[ks][1], acc[pb][1], 0, 0, 0); }
            asm volatile("" ::: "memory");
        }
        LDS_WAIT(); asm volatile("" ::: "memory");
#pragma unroll
        for (int pb = 0; pb < 4; ++pb)
#pragma unroll
            for (int q4 = 0; q4 < 4; ++q4) { const f32x4 b4 = *(const LAS f32x4*)(BSL + g * 128 + 32 * pb + 8 * q4 + 4 * hh);
#pragma unroll
                for (int i = 0; i < 4; ++i) { const int r = 4 * q4 + i, p = 32 * pb + 8 * q4 + 4 * hh + i;
#pragma unroll
                    for (int cb = 0; cb < 2; ++cb) *(LAS unsigned short*)(VN + p * 128 + (32 * cb + l31) * 2) = (unsigned short)f2bf(acc[pb][cb][r] + b4[i]); } }
        LDS_WAIT(); asm volatile("" ::: "memory");
#pragma unroll 1
        for (int ib = 0; ib < 16; ib += 4) { v4u uq[4];
#pragma unroll
            for (int i4 = 0; i4 < 4; ++i4) uq[i4] = *(const v4u*)(Z + (row0 + (ib + i4) * 8 + (ln >> 3)) * 2048 + cbase + c8);
            asm volatile("" ::: "memory");
#pragma unroll
            for (int i4 = 0; i4 < 4; ++i4) { const int p = (ib + i4) * 8 + (ln >> 3); const v4u m = *(const LAS v4u*)(VN + p * 128 + (ln & 7) * 16); const v4u u = uq[i4]; v4u o;
                o.x = pk2(bflo(u.x) * bflo(m.x), bfhi(u.x) * bfhi(m.x)); o.y = pk2(bflo(u.y) * bflo(m.y), bfhi(u.y) * bfhi(m.y));
                o.z = pk2(bflo(u.z) * bflo(m.z), bfhi(u.z) * bfhi(m.z)); o.w = pk2(bflo(u.w) * bflo(m.w), bfhi(u.w) * bfhi(m.w));
                *(v4u*)(YA + (row0 + p) * 1024 + cbase + c8) = o; } }
        LDS_WAIT(); asm volatile("" ::: "memory");
    }
    __syncthreads();
}

__device__ __forceinline__ void phase_post(const float* ATTO, const float* MLH, const bf16* Z, const float* dng, const float* mng, float lam, float linit, bf16* YB, bf16* YC, int bid, int G, int tid) {
    asm volatile("" : "+v"(tid));
    const int wave = tid >> 6, lane = tid & 63, head = lane >> 4, e0 = (lane & 15) * 16;
    for (int row = bid * NWAVES + wave; row < MT; row += G * NWAVES) {
        const size_t off = (size_t)row * 1024 + head * 256 + e0;
        {
            const f32x4* a0 = (const f32x4*)(ATTO + off); const f32x4* a1 = (const f32x4*)(ATTO + (size_t)MT * 1024 + off);
            float o[16]; float ss = 0.f;
#pragma unroll
            for (int k = 0; k < 4; ++k) { const f32x4 p = a0[k], q = a1[k];
                o[4 * k + 0] = p.x - lam * q.x; o[4 * k + 1] = p.y - lam * q.y; o[4 * k + 2] = p.z - lam * q.z; o[4 * k + 3] = p.w - lam * q.w; }
#pragma unroll
            for (int k = 0; k < 16; ++k) ss += o[k] * o[k];
            ss += shfl_xor_f(ss, 1); ss += shfl_xor_f(ss, 2); ss += shfl_xor_f(ss, 4); ss += shfl_xor_f(ss, 8);
            const float rstd = 1.f / sqrtf(ss * (1.f / 256.f) + EPS) * (1.f - linit);
            v4u w0, w1;
            w0.x = pk2(o[0] * rstd * dng[e0 + 0], o[1] * rstd * dng[e0 + 1]); w0.y = pk2(o[2] * rstd * dng[e0 + 2], o[3] * rstd * dng[e0 + 3]);
            w0.z = pk2(o[4] * rstd * dng[e0 + 4], o[5] * rstd * dng[e0 + 5]); w0.w = pk2(o[6] * rstd * dng[e0 + 6], o[7] * rstd * dng[e0 + 7]);
            w1.x = pk2(o[8] * rstd * dng[e0 + 8], o[9] * rstd * dng[e0 + 9]); w1.y = pk2(o[10] * rstd * dng[e0 + 10], o[11] * rstd * dng[e0 + 11]);
            w1.z = pk2(o[12] * rstd * dng[e0 + 12], o[13] * rstd * dng[e0 + 13]); w1.w = pk2(o[14] * rstd * dng[e0 + 14], o[15] * rstd * dng[e0 + 15]);
            v4u* yp = (v4u*)(YC + off); yp[0] = w0; yp[1] = w1;
        }
    }
}

struct Args { const float* in[21]; float* out; unsigned char* ws; int ph_lo, ph_hi; };
static_assert(sizeof(Args) == 21 * 8 + 8 + 8 + 8, "Args has no padding");

constexpr int T_ALL = -1, T_PRO0 = 0, T_PRO1 = 1, T_NORM = 2, T_W13 = 3, T_W2 = 4, T_N2 = 5, T_WIN = 6, T_ROPE = 7, T_MLSTM = 8, T_POST = 9, T_MERGE0 = 10, T_WOUT = 11, T_FINAL = 12, T_ATTN = 13, T_GMLP = 14, T_MERGE1 = 15, T_MERGE2 = 16, T_M3 = 17, NTYPES = 18;
#define SELD(t) (SEL == T_ALL || SEL == (t))
template <int SEL> __global__ void __launch_bounds__(NTHR, 2) mk_fwd(Args args) {
    extern __shared__ __attribute__((aligned(16))) unsigned char lds_raw[];
    LAS unsigned char* lds = (LAS unsigned char*)lds_raw;
    volatile LAS unsigned* MISC = (volatile LAS unsigned*)(lds + MISC_OFF);
    const int wave_s = __builtin_amdgcn_readfirstlane((int)threadIdx.x >> 6), bid_k = blockIdx.x, G = gridDim.x;
#define tid MK_TID(wave_s)
#define KARGS ((const __attribute__((address_space(4))) Args*)ka_)
#define PHASE_BEGIN const __attribute__((address_space(4))) void* ka_ = (const __attribute__((address_space(4))) void*)__builtin_amdgcn_kernarg_segment_ptr(); asm volatile("" : "+s"(ka_)); unsigned char* const ws = KARGS->ws; (void)ws; int bid = bid_k; asm volatile("" : "+s"(bid))
#define PIN(i) (KARGS->in[i])
#define XR ((float*)(ws + WS_XR))
#define H ((bf16*)(ws + WS_H))
#define GB ((bf16*)(ws + WS_GB))
#define Z ((bf16*)(ws + WS_Z))
#define ATTO ((float*)(ws + WS_ATTO))
#define MLH ((float*)(ws + WS_MLH))
#define DCT ((float*)(ws + WS_MLH))
#define YA ((bf16*)(ws + WS_YA))
#define YB ((bf16*)(ws + WS_YB))
#define YC ((bf16*)(ws + WS_YC))
#define SLAB ((float*)(ws + WS_SLAB))
#define YACC ((float*)(ws + WS_YACC))
#define Y ((bf16*)(ws + WS_Y))
#define G16 ((float*)(ws + WS_G16))
#define MOD ((const float*)(ws + WS_MOD))
#define CTS ((bf16*)(ws + WS_CT))
#define DNS ((float*)(ws + WS_MSM))
#define NSS (DNS + 8 * 66 * 128)
#define CHS (NSS + 8 * 66 * 128)
#define MSS (CHS + 8 * 66 * 2)
#define modl (MOD + (size_t)(l * 2 + 0) * NMOD)
#define modc (MOD + (size_t)(l * 2 + 1) * NMOD)
#define W13T0 ((const bf16*)(ws + WS_W13T) + (size_t)(l * 2 + 0) * 8192 * 4096)
#define W13T1 (W13T0 + (size_t)8192 * 4096)
#define W2T0 ((const bf16*)(ws + WS_W2T) + (size_t)(l * 2 + 0) * 4096 * 4096)
#define W2T1 (W2T0 + (size_t)4096 * 4096)
#define WINT ((const bf16*)(ws + WS_WINT) + (size_t)l * NZ * 4096)
#define WBT ((const bf16*)(ws + WS_WBT) + (size_t)(l * 3) * 4096 * 1024)
#define WOT ((const bf16*)(ws + WS_WOT) + (size_t)l * 4096 * 4096)
#define MKP() Ptrs P; P.x = PIN(0); P.c = PIN(1); P.ctx = PIN(2); P.c_ctx = PIN(3); P.ada_down = PIN(4); P.ada_up = PIN(5); P.ada_bias = PIN(6); P.norm_g = PIN(7); \
    P.w13 = PIN(8); P.w2 = PIN(9); P.w_in = PIN(10); P.gmlp_norm_g = PIN(11); P.gmlp_ws = PIN(12); P.gmlp_bs = PIN(13); P.gate_b = PIN(14); \
    P.mlstm_norm_g = PIN(15); P.diff_lambda = PIN(16); P.diff_norm_g = PIN(17); P.w_branch = PIN(18); P.w_out = PIN(19); P.final_g = PIN(20); P.out = KARGS->out; P.ws = KARGS->ws
    for (int u = tid; u < (LDS_BYTES - LDSCTL_OFF) / 4; u += NTHR) ((LAS unsigned*)(lds + LDSCTL_OFF))[u] = 0u;
    __syncthreads();
#if MK_ONE_LAUNCH
    XcdBarrier bar = xcd_barrier_post((unsigned*)((gu32*)(args.ws + WS_CTL) + CW_BAR), MISC + 8, tid);
#define GRID_BAR() do { XcdBarrier b2_ = bar; asm volatile("" : "+s"(b2_.bar)); xcd_barrier(b2_, tid); } while (0)
#else
#define GRID_BAR() do {} while (0)
#endif
    const int lo = args.ph_lo, hi = args.ph_hi;
#define IN(k) (lo <= (k) && (k) < hi)
#define SEAM(k) do { if (IN(k) && IN((k) + 1)) GRID_BAR(); } while (0)

    if (IN(P_PRO0)) { PHASE_BEGIN; MKP(); for (int rep_ = 0; rep_ < DBL_PRO; ++rep_) pro0(P, lds, bid, G, tid); SEAM(P_PRO0); }
    if (IN(P_PRO1)) { PHASE_BEGIN; MKP(); pro1(P, lds, bid, G, tid); SEAM(P_PRO1); }

    for (int l = 0; l < DEPTH; ++l) {
        const int pb = P_LAYER0 + l * NPL;
        if (hi <= pb || lo >= pb + NPL) continue;
#define GEMM_RESID_SPLIT2(Aptr, Bptr, gate_l, fac, ms3, yc, nctx_) do { \
            { pg8::Gemm g{(Aptr) + (size_t)CTXL * DM, (Bptr), SEQ, DM, DM, DM}; pg8::StaticOrder S; S.init(SEQ, DM, G, bid); pg8::EpiResid E{XR + (size_t)CTXL * DM, (gate_l), (gate_l), XR + (size_t)CTXL * DM, (fac)}; \
              pg8::gemm_phase<pg8::EpiResid, pg8::StaticOrder, true, true>(lds + RING_OFF, g, S, E, wave_s); } \
            { pg8::Gemm g{(Aptr), (Bptr), CTXL, DM, 256, DM}; pg8::CtxSplitOrder S{bid, G, (nctx_), (ms3), (yc), wave_s}; pg8::EpiSlab E{SLAB}; \
              pg8::gemm_phase<pg8::EpiSlab, pg8::CtxSplitOrder, true, true>(lds + RING_OFF, g, S, E, wave_s); } } while (0)
#define GEMM_RESID_SPLIT(Aptr, Bptr, gate_l, fac, ms3, yc, nctx_, xb_) do { \
            pg8::Gemm g{(Aptr), (Bptr), MT, DM, DM, DM}; pg8::ResidOrder S; S.lat.init(SEQ, DM, G, bid); S.c = bid; S.G = G; S.n = (nctx_); \
            pg8::EpiResidSlab E{ws, (gate_l), (xb_), (fac)}; \
            pg8::gemm_phase<pg8::EpiResidSlab, pg8::ResidOrder, true, true>(lds + RING_OFF, g, S, E, wave_s); } while (0)
#define GL (G >= 128 ? G - (G >> 4) : G)
#define NC (G - GL)
#define GEMM_LAT(EPI, GW_, Aptr, Bptr, Ncols, Kdim, ...) do { pg8::Gemm g{(Aptr), (Bptr), MT, (Ncols), (Kdim), (Kdim)}; pg8::StaticOrder S; S.init(MT, (Ncols), (GW_), bid); EPI E{__VA_ARGS__}; \
            pg8::gemm_phase<EPI, pg8::StaticOrder, true, true>(lds + RING_OFF, g, S, E, wave_s); } while (0)

        if (IN(pb + L_N1)) { PHASE_BEGIN; MKP(); phase_norm(XR, l == 0 ? P.x - (size_t)CTXL * DM : (const float*)XR, l == 0 ? P.ctx : (const float*)XR, XR, P.norm_g + (size_t)(l * 3 + 0) * DM, modl + 0 * 3 * DM, modc + 0 * 3 * DM, H, l > 0 ? SLAB : nullptr, modc - (size_t)2 * NMOD + 2 * 3 * DM + 2 * DM, 0.5f, lds, bid, G, tid); SEAM(pb + L_N1); }
        if (IN(pb + L_W13A)) { PHASE_BEGIN; MKP();
            if (bid < GL) { GEMM_LAT(pg8::EpiSwiglu, GL, H, W13T0, 8192, DM, GB, FFND);
                            convert_idle(P, l, 1, CVD, CVS, (MT / 256 * 32) % GL, GL, lds, bid, tid); }
            if (NC == 0 || bid >= GL) convert_part(P, l, 1, 0, CVD, NC ? bid - GL : bid, NC ? NC : G, lds, tid);
            SEAM(pb + L_W13A); }
        if (IN(pb + L_W2A)) { PHASE_BEGIN; MKP();
            GEMM_RESID_SPLIT(GB, W2T0, modl + 0 * 3 * DM + 2 * DM, 0.5f, (const float*)nullptr, (bf16*)nullptr, 256, l == 0 ? P.x - (size_t)CTXL * DM : (const float*)XR);
            SEAM(pb + L_W2A); }
        if (IN(pb + L_N2)) { PHASE_BEGIN; MKP(); phase_norm(XR, XR, XR, l == 0 ? P.ctx : (const float*)XR, P.norm_g + (size_t)(l * 3 + 1) * DM, modl + 1 * 3 * DM, modc + 1 * 3 * DM, H, SLAB, modc + 0 * 3 * DM + 2 * DM, 0.5f, lds, bid, G, tid); SEAM(pb + L_N2); }
        if (IN(pb + L_WIN)) { PHASE_BEGIN; MKP();
            if (bid < GL) { GEMM_LAT(pg8::EpiWin, GL, H, WINT, NZ, DM, Z, (const float*)(ws + WS_ROPE), (const float*)(ws + WS_ROPE) + SEQ * 64); }
            if (NC == 0 || bid >= GL) { convert_part(P, l, 1, CVS, NL, NC ? bid - GL : bid, NC ? NC : G, lds, tid);
                for (int u = NC ? bid - GL : bid; u < 66; u += (NC ? NC : G)) gates_unit(H, (const bf16*)(ws + WS_WG16) + (size_t)l * 16 * DM, G16, u, tid); }
            SEAM(pb + L_WIN); }
        if (IN(pb + L_MIX1)) { PHASE_BEGIN; MKP();
            for (int rep_ = 0; rep_ < DBL_M1; ++rep_) for (int u = (bid + G - (100 % G)) % G; u < 264; u += G) mlstm_m1_unit(Z, G16, P.gate_b + (size_t)l * 16, DCT, DNS, CHS, u >> 2, u & 3, lds, tid);
            for (int rep_ = 0; rep_ < DBL_ATTN; ++rep_) for (int u = bid; u < (l < DEPTH - 1 ? 264 : 256); u += G) {
                int hm, qb, seq; if (u < 256) { hm = u & 7; qb = 1 + (u >> 3); seq = MT; } else { hm = u - 256; qb = 0; seq = CTXL; }
                const int h = hm >> 1, mm = hm & 1;
                const attn128::bf16* Zb = (const attn128::bf16*)Z;
                attn256::attn_o256_body(Zb + (size_t)MT * ZC_AQ + (size_t)(qb * 256) * 1024 + h * 256 + mm * 128, Zb + (size_t)MT * ZC_AK + h * 256 + mm * 128, Zb + (size_t)MT * ZC_AV + h * 256,
                                        ATTO + (size_t)mm * MT * 1024 + (size_t)(qb * 256) * 1024 + h * 256, seq, (char*)lds_raw, wave_s);
                __syncthreads();
            }
            SEAM(pb + L_MIX1);
        }
        if (IN(pb + L_POST)) { PHASE_BEGIN; MKP();
            for (int rep_ = 0; rep_ < DBL_POST; ++rep_) { mlstm_m2(DCT, DNS, CHS, CTS, NSS, MSS, lds, bid, G, tid); } SEAM(pb + L_POST); }
        if (IN(pb + L_M3)) { PHASE_BEGIN; MKP();
            { const int u0 = (l < DEPTH - 1) ? 0 : 8, nsec = (l < DEPTH - 1) ? (264 - G > 0 ? 264 - G : 0) : 0;
              for (int rep_ = 0; rep_ < DBL_M3; ++rep_) for (int u = u0 + bid; u < 264; u += G) mlstm_m3_unit(Z, G16, P.gate_b + (size_t)l * 16, CTS, NSS, MSS, P.mlstm_norm_g + (size_t)l * 1024, YB, u >> 2, u & 3, lds, tid);
              const int ngm = (G >= 66 + nsec + 8) ? 66 : 0;
              for (int rep_ = 0; rep_ < DBL_GMLP; ++rep_) for (int u = G - 1 - bid; u < 66; u += G) gmlp_unit_mfma(Z, P.gmlp_norm_g + (size_t)l * 1024, (const bf16*)(ws + WS_GWSB) + (size_t)l * 8 * 128 * 128, P.gmlp_bs + (size_t)l * 8 * 128, YA, u, lds, tid);
              if (bid >= nsec && bid < G - ngm) phase_post(ATTO, MLH, Z, P.diff_norm_g + (size_t)l * 256, P.mlstm_norm_g + (size_t)l * 1024, ((const float*)(ws + WS_LAM))[l], lambda_init_f(l), YB, YC, bid - nsec, G - ngm - nsec, tid); }
            SEAM(pb + L_M3); }
        if (IN(pb + L_MERGE)) { PHASE_BEGIN; MKP();
            { pg8::Gemm g{YA, WBT, MT, DM, 1024, 1024}; pg8::MergeOrder S; S.lat.init(SEQ, DM, G, bid); S.c = bid; S.G = G; S.nctx = (l < DEPTH - 1) ? 48 : 0; pg8::EpiMergeSeg E{Z, Y, (float*)(ws + WS_MS3)};
              pg8::gemm_phase<pg8::EpiMergeSeg, pg8::MergeOrder, true, true>(lds + RING_OFF, g, S, E, wave_s); }
            SEAM(pb + L_MERGE); }
        if (IN(pb + L_WOUT)) { PHASE_BEGIN; MKP();
            GEMM_RESID_SPLIT2(Y, WOT, modl + 1 * 3 * DM + 2 * DM, 1.f, (const float*)(ws + WS_MS3), Y, (l < DEPTH - 1) ? 256 : 0);
            SEAM(pb + L_WOUT); }
        if (IN(pb + L_N3)) { PHASE_BEGIN; MKP(); phase_norm(XR, XR, XR, XR, P.norm_g + (size_t)(l * 3 + 2) * DM, modl + 2 * 3 * DM, modc + 2 * 3 * DM, H, SLAB, modc + 1 * 3 * DM + 2 * DM, 1.f, lds, bid, G, tid); SEAM(pb + L_N3); }
        if (IN(pb + L_W13B)) { PHASE_BEGIN; MKP();
            { const int skip = (l < DEPTH - 1) ? 0 : CTXL;
              const int GLb = (l < DEPTH - 1) ? GL : G;
              if (bid < GLb) { pg8::Gemm g{H + (size_t)skip * DM, W13T1, MT - skip, 8192, DM, DM}; pg8::StaticOrder S; S.init(MT - skip, 8192, GLb, bid); pg8::EpiSwiglu E{GB + (size_t)skip * FFND, FFND};
                  pg8::gemm_phase<pg8::EpiSwiglu, pg8::StaticOrder, true, true>(lds + RING_OFF, g, S, E, wave_s);
                  convert_idle(P, l + 1, 0, CVD, CVS, (MT / 256 * 32) % GL, GL, lds, bid, tid); }
              if (NC == 0 || bid >= GL) convert_part(P, l + 1, 0, 0, CVD, NC ? bid - GL : bid, NC ? NC : G, lds, tid); }
            SEAM(pb + L_W13B); }
        if (IN(pb + L_W2B)) { PHASE_BEGIN; MKP();
            GEMM_RESID_SPLIT(GB, W2T1, modl + 2 * 3 * DM + 2 * DM, 0.5f, (const float*)nullptr, (bf16*)nullptr, (l < DEPTH - 1) ? 256 : 0, (const float*)XR);
            SEAM(pb + L_W2B); }
#undef GEMM_LAT
#undef GL
#undef NC
#undef GEMM_RESID_SPLIT
#undef GEMM_RESID_SPLIT2
    }
    if (IN(P_FINAL)) { PHASE_BEGIN; MKP(); phase_final(XR, P.final_g, P.out, bid, G, tid); }
#undef IN
#undef SEAM
#undef tid
#undef XR
#undef H
#undef GB
#undef Z
#undef ATTO
#undef MLH
#undef DCT
#undef YA
#undef YB
#undef YC
#undef SLAB
#undef YACC
#undef Y
#undef G16
#undef MOD
#undef CTS
#undef DNS
#undef NSS
#undef CHS
#undef MSS
#undef modl
#undef modc
#undef W13T0
#undef W13T1
#undef W2T0
#undef W2T1
#undef WINT
#undef WBT
#undef WOT
}

extern "C" void kernel_launch(void* const* d_in, const int* in_sizes, int n_in, void* d_out, int out_size, void* d_ws, size_t ws_size, hipStream_t stream) {
    static int grid = 0;
    if (grid == 0) {
        if (n_in != 21 || in_sizes[0] != SEQ * DM || out_size != SEQ * DM || ws_size < WS_END) {
            fprintf(stderr, "kernel_launch: unexpected shapes: n_in %d in0 %d out %d ws %zu (need %zu)\n", n_in, n_in > 0 ? in_sizes[0] : -1, out_size, ws_size, (size_t)WS_END); grid = -1; return; }
        int dev = 0, cus = 0;
        if (hipGetDevice(&dev) != hipSuccess || hipDeviceGetAttribute(&cus, hipDeviceAttributeMultiprocessorCount, dev) != hipSuccess) { grid = -1; return; }
        if (hipFuncSetAttribute((const void*)mk_fwd<T_ALL>, hipFuncAttributeMaxDynamicSharedMemorySize, LDS_BYTES) != hipSuccess) { fprintf(stderr, "kernel_launch: hipFuncSetAttribute failed\n"); grid = -1; return; }
        (void)hipGetLastError();
        grid = cus;
    }
    if (grid < 0) return;
    (void)hipMemsetAsync((char*)d_ws + WS_CTL, 0, CTL_ZERO_BYTES, stream);
    Args a{};
    for (int i = 0; i < 21; ++i) a.in[i] = (const float*)d_in[i];
    a.out = (float*)d_out; a.ws = (unsigned char*)d_ws;
#if MK_ONE_LAUNCH
    a.ph_lo = 0; a.ph_hi = NPH;
    hipLaunchKernelGGL(mk_fwd<T_ALL>, dim3(grid), dim3(NTHR), LDS_BYTES, stream, a);
#else
    for (int p = 0; p < NPH; ++p) { a.ph_lo = p; a.ph_hi = p + 1; hipLaunchKernelGGL(mk_fwd<T_ALL>, dim3(grid), dim3(NTHR), LDS_BYTES, stream, a); }
#endif
    const hipError_t le = hipPeekAtLastError();
    if (le != hipSuccess) fprintf(stderr, "kernel_launch: launch failed: %s\n", hipGetErrorName(le));
}
```

```cpp
#include <hip/hip_runtime.h>
#include <hip/hip_bf16.h>
#include <cstdio>
#include <cstdint>
#include <cmath>
#ifndef MLSTM_CHUNKWISE
#define MLSTM_CHUNKWISE 1
#endif
#ifndef MK_ONE_LAUNCH
#define MK_ONE_LAUNCH 1
#endif
#ifndef DBL_ATTN
#define DBL_ATTN 1
#endif
#ifndef DBL_PRO
#define DBL_PRO 1
#endif
#ifndef DBL_M1
#define DBL_M1 1
#endif
#ifndef DBL_GMLP
#define DBL_GMLP 1
#endif
#ifndef DBL_POST
#define DBL_POST 1
#endif
#ifndef DBL_M3
#define DBL_M3 1
#endif
#ifndef DBL_NORM
#define DBL_NORM 1
#endif
__device__ __forceinline__ int mk_lane_id() { int l_; asm volatile("v_mbcnt_lo_u32_b32 %0, -1, 0\n\tv_mbcnt_hi_u32_b32 %0, -1, %0" : "=v"(l_)); return l_; }
#define MK_TID(wave_s_) (((wave_s_) << 6) | mk_lane_id())
namespace pg8 {
#define PG8_LAS __attribute__((address_space(3)))
typedef unsigned short bf16_t;
typedef short bf16x8 __attribute__((ext_vector_type(8)));
typedef float f32x4 __attribute__((ext_vector_type(4)));
typedef unsigned u32x4 __attribute__((ext_vector_type(4)));
constexpr int BM = 256, BK = 64, HALF = 128, HTB = HALF * BK * 2  , STAGE_BYTES = 8 * HTB, NXCD = 8, WGM = 8;

__host__ __device__ __forceinline__ int lds_byte(int r, int c) { const int st = (r >> 4) * 2 + (c >> 5), rr = r & 15, cc = c & 31, ob = rr * 64 + cc * 2; return st * 1024 + (ob ^ (((ob >> 9) & 1) << 5)); }
__host__ __device__ __forceinline__ void stage_rc(int b, int& R, int& C) { const int st = b / 1024, sb = b % 1024, swz = sb ^ (((sb >> 9) & 1) << 5); R = (st >> 1) * 16 + swz / 64; C = (st & 1) * 32 + (swz % 64) / 2; }
__host__ __device__ __forceinline__ int perm32(int rho) { const int n = rho >> 4, i = rho & 15; return 8 * (i >> 2) + 4 * n + (i & 3); }

struct Unit { int pm, pn, koff, boff, fl;
    __device__ __forceinline__ int seg() const { return fl & 3; } __device__ __forceinline__ bool carry() const { return (fl & 4) != 0; } __device__ __forceinline__ int ntile() const { return fl >> 8; } };
struct Gemm { const bf16_t* A; const bf16_t* Bt; int M, N, K, ld; };

struct StaticOrder {
    int nM, nN, nwg, G, c;
    __host__ __device__ void init(int M, int N, int G_, int c_) { nM = M / BM; nN = N / BM; nwg = nM * nN; G = G_; c = c_; }
    __host__ __device__ bool next(int i, Unit& u) const {
        const long L = (long)i * G + c; if (L >= nwg) return false;
        int wgid = (int)L; { const int q = nwg / NXCD, r = nwg % NXCD, xcd = wgid % NXCD, off = wgid / NXCD; wgid = (xcd < r ? xcd * (q + 1) : r * (q + 1) + (xcd - r) * q) + off; }
        const int nig = WGM * nN, gid = wgid / nig, fm = gid * WGM, gsz = (nM - fm) < WGM ? (nM - fm) : WGM;
        u.pm = fm + ((wgid % nig) % gsz); u.pn = (wgid % nig) / gsz; u.koff = 0; u.boff = 0; u.fl = 0; return true;
    }
    __device__ __forceinline__ void a_ready(const Unit&) const {}
    __device__ __forceinline__ void done(const Unit&) const {}
};

__device__ __forceinline__ unsigned cvt_pk_bf16(float lo, float hi) { unsigned r; asm volatile("v_cvt_pk_bf16_f32 %0, %1, %2" : "=v"(r) : "v"(lo), "v"(hi)); return r; }
typedef float f32x2 __attribute__((ext_vector_type(2)));
__device__ __forceinline__ f32x2 gelu_pk(f32x2 v) {
    const f32x2 av = __builtin_elementwise_abs(v), d = av * 0.2316418882f + 1.0f;
    f32x2 t; t.x = __builtin_amdgcn_rcpf(d.x); t.y = __builtin_amdgcn_rcpf(d.y);
    f32x2 q = t * 0.5307027145f + (-0.7265760135f); q = q * t + 0.7107068705f; q = q * t + (-0.142248368f); q = q * t + 0.127414796f; q = q * t;
    const f32x2 s = (v * v) * (-0.72134752044f);
    f32x2 e; e.x = __builtin_amdgcn_exp2f(s.x); e.y = __builtin_amdgcn_exp2f(s.y);
    const f32x2 m = v * (q * e), r = v - m;
    f32x2 o; o.x = v.x < 0.f ? m.x : r.x; o.y = v.y < 0.f ? m.y : r.y; return o;
}

template <int ACT  > struct EpiBf16 {
    static constexpr bool PERM = true, AFTER_DRAIN = false; static_assert(ACT == 0 || ACT == 1, "EpiBf16: ACT is 0 (none) or 1 (gelu_pk)");
    bf16_t* O; int ldc; const float* bias; int split_cols; size_t split_stride; float scale0;
    __device__ __forceinline__ void operator()(const f32x4 (&acc)[2][2][4][2], const Unit& u, int wr, int wc, int fr, int fq) const {
        const int row0 = u.pm * BM + wr * 64 + fr; int colt = u.pn * BM; bf16_t* base = O;
        float sc = 1.f; if (split_cols) { const int t = colt / split_cols; base += (size_t)t * split_stride; colt -= t * split_cols; if (t == 0) sc = scale0; }
        const int col0 = colt + wc * 32 + 8 * fq, bcol0 = u.pn * BM + wc * 32 + 8 * fq;
        f32x4 bv[2][2];
#pragma unroll
        for (int bj = 0; bj < 2; ++bj)
#pragma unroll
            for (int n = 0; n < 2; ++n) bv[bj][n] = bias ? *(const f32x4*)(bias + bcol0 + bj * HALF + 4 * n) : (f32x4){0.f, 0.f, 0.f, 0.f};
#pragma unroll
        for (int ai = 0; ai < 2; ++ai)
#pragma unroll
            for (int m = 0; m < 4; ++m) { bf16_t* rowp = base + (size_t)(row0 + ai * HALF + m * 16) * ldc + col0;
#pragma unroll
                for (int bj = 0; bj < 2; ++bj) { f32x4 v0 = acc[ai][bj][m][0] + bv[bj][0], v1 = acc[ai][bj][m][1] + bv[bj][1];
                    if (ACT == 1) { f32x2 a = gelu_pk((f32x2){v0[0], v0[1]}), b = gelu_pk((f32x2){v0[2], v0[3]}), c = gelu_pk((f32x2){v1[0], v1[1]}), d = gelu_pk((f32x2){v1[2], v1[3]});
                        v0 = (f32x4){a.x, a.y, b.x, b.y}; v1 = (f32x4){c.x, c.y, d.x, d.y}; }
                    v0 = v0 * sc; v1 = v1 * sc; u32x4 w; w.x = cvt_pk_bf16(v0[0], v0[1]); w.y = cvt_pk_bf16(v0[2], v0[3]); w.z = cvt_pk_bf16(v1[0], v1[1]); w.w = cvt_pk_bf16(v1[2], v1[3]);
                    *(u32x4*)(rowp + bj * HALF) = w; } }
    }
};

struct PanelStats {
    unsigned* xbuf;
    unsigned* cnt;
    unsigned* tmo;
    int ntn; float eps;
    unsigned code;
    __device__ __forceinline__ bool run(const f32x4 (&v)[2][2][4][2], const Unit& u, int wr, int wc, int fr, int fq, PG8_LAS unsigned char* lds, int wid, int lane) const {
        typedef float f32x2v __attribute__((ext_vector_type(2)));
        PG8_LAS f32x2v* P = (PG8_LAS f32x2v*)lds;
        PG8_LAS f32x2v* S = (PG8_LAS f32x2v*)(lds + 8192);
        PG8_LAS unsigned* flag = (PG8_LAS unsigned*)(lds + 8192 + 2048);
#pragma unroll
        for (int ai = 0; ai < 2; ++ai)
#pragma unroll
            for (int m = 0; m < 4; ++m) {
                float s = 0.f;
#pragma unroll
                for (int bj = 0; bj < 2; ++bj)
#pragma unroll
                    for (int n = 0; n < 2; ++n) { const f32x4 x = v[ai][bj][m][n]; s += (x[0] + x[1]) + (x[2] + x[3]); }
                s += __shfl_xor(s, 16); s += __shfl_xor(s, 32);
                const float mw = s * (1.0f / 64.0f); float q = 0.f;
#pragma unroll
                for (int bj = 0; bj < 2; ++bj)
#pragma unroll
                    for (int n = 0; n < 2; ++n) { const f32x4 d = v[ai][bj][m][n] - mw; q += (d[0] * d[0] + d[1] * d[1]) + (d[2] * d[2] + d[3] * d[3]); }
                q += __shfl_xor(q, 16); q += __shfl_xor(q, 32);
                if (fq == 0) P[(ai * HALF + wr * 64 + m * 16 + fr) * 4 + wc] = (f32x2v){mw, q};
            }
        asm volatile("s_waitcnt lgkmcnt(0)" ::: "memory"); __builtin_amdgcn_s_barrier(); asm volatile("" ::: "memory");
#if defined(BROKEN_EXCHANGE_NO_WAIT)
#warning BROKEN CONTROL BUILD: the row-statistics exchange does not wait; results are wrong by design
        if (blockIdx.x >= 64) { const long long t0_ = clock64(); while (clock64() - t0_ < 60000) __builtin_amdgcn_s_sleep(8); }
#endif
        const int row = wid * 32 + (lane & 31);
        if (lane < 32) {
            const f32x2v a = P[row * 4 + 0], b = P[row * 4 + 1], c = P[row * 4 + 2], d = P[row * 4 + 3];
            const float mt = (a.x + b.x + c.x + d.x) * 0.25f;
            const float da = a.x - mt, db = b.x - mt, dc = c.x - mt, dd = d.x - mt;
            const float m2 = (a.y + b.y) + (c.y + d.y) + 64.0f * ((da * da + db * db) + (dc * dc + dd * dd));
            unsigned long long* slot = (unsigned long long*)xbuf + ((size_t)(u.pm * BM + row) * 4 + u.pn);
            __hip_atomic_store(slot, ((unsigned long long)__float_as_uint(m2) << 32) | __float_as_uint(mt), __ATOMIC_RELAXED, __HIP_MEMORY_SCOPE_AGENT);
        }
        asm volatile("s_waitcnt vmcnt(0)" ::: "memory");
        if (lane == 0) __hip_atomic_fetch_add(cnt + 64 * u.pm, 1u, __ATOMIC_RELAXED, __HIP_MEMORY_SCOPE_AGENT);
        if (wid == 0) {
            bool dead = false; const unsigned long long t0 = __builtin_amdgcn_s_memrealtime(); const unsigned want = 8u * (unsigned)ntn;
            for (;;) {
#if defined(BROKEN_EXCHANGE_NO_WAIT)
                break;
#endif
                if ((unsigned)__builtin_amdgcn_readfirstlane(__hip_atomic_load(cnt + 64 * u.pm, __ATOMIC_RELAXED, __HIP_MEMORY_SCOPE_AGENT)) >= want) break;
                if (__builtin_amdgcn_s_memrealtime() - t0 > 2000000ull) {
                    if (lane == 0) { unsigned expect = 0u; __hip_atomic_compare_exchange_strong(tmo + 1, &expect, code | (unsigned)(u.pm & 0xff), __ATOMIC_RELAXED, __ATOMIC_RELAXED, __HIP_MEMORY_SCOPE_AGENT);
                                     __hip_atomic_store(tmo, 1u, __ATOMIC_RELAXED, __HIP_MEMORY_SCOPE_AGENT); }
                    dead = true; break; }
                __builtin_amdgcn_s_sleep(2);
            }
            __builtin_amdgcn_fence(__ATOMIC_ACQUIRE, "agent");
            if (lane == 0) flag[0] = dead ? 1u : 0u;
        }
        asm volatile("s_waitcnt vmcnt(0) lgkmcnt(0)" ::: "memory"); __builtin_amdgcn_s_barrier(); asm volatile("" ::: "memory");
        const bool bad = flag[0] != 0u;
        if (lane < 32) {
            const unsigned long long* slot = (const unsigned long long*)xbuf + (size_t)(u.pm * BM + row) * 4; float mt[4], m2[4]; float ms = 0.f;
#pragma unroll
            for (int t = 0; t < 4; ++t) { if (t < ntn) { const unsigned long long w = __hip_atomic_load(slot + t, __ATOMIC_RELAXED, __HIP_MEMORY_SCOPE_AGENT); mt[t] = __uint_as_float((unsigned)w); m2[t] = __uint_as_float((unsigned)(w >> 32)); } else { mt[t] = 0.f; m2[t] = 0.f; } ms += mt[t]; }
            const float mean = ms / (float)ntn; float q = 0.f;
#pragma unroll
            for (int t = 0; t < 4; ++t) if (t < ntn) { const float dm = mt[t] - mean; q += m2[t] + 256.0f * dm * dm; }
            S[row] = (f32x2v){mean, 1.0f / sqrtf(q / (256.0f * (float)ntn) + eps)};
        }
        asm volatile("s_waitcnt lgkmcnt(0)" ::: "memory"); __builtin_amdgcn_s_barrier(); asm volatile("" ::: "memory");
        return bad;
    }
};
struct EpiLnRes {
    static constexpr bool PERM = false, AFTER_DRAIN = true;
    const float* base; float* out; int ldc; const float* bias; PanelStats st; unsigned poison;
    __device__ __forceinline__ void fused(f32x4 (&acc)[2][2][4][2], const Unit& u, int wr, int wc, int fr, int fq, PG8_LAS unsigned char* lds, int wid, int lane) const {
        typedef float f32x2v __attribute__((ext_vector_type(2)));
        const PG8_LAS f32x2v* S = (const PG8_LAS f32x2v*)(lds + 8192);
        const int col0 = u.pn * BM + wc * 32 + 4 * fq;
#pragma unroll
        for (int bj = 0; bj < 2; ++bj)
#pragma unroll
            for (int n = 0; n < 2; ++n) { const f32x4 bv = bias ? *(const f32x4*)(bias + col0 + bj * HALF + n * 16) : (f32x4){0.f, 0.f, 0.f, 0.f};
#pragma unroll
                for (int ai = 0; ai < 2; ++ai)
#pragma unroll
                    for (int m = 0; m < 4; ++m) acc[ai][bj][m][n] += bv; }
        f32x4 pre[4][2][2];
#pragma unroll
        for (int m = 0; m < 4; ++m) { const size_t off = (size_t)(u.pm * BM + wr * 64 + m * 16 + fr) * ldc + col0;
#pragma unroll
            for (int bj = 0; bj < 2; ++bj)
#pragma unroll
                for (int n = 0; n < 2; ++n) pre[m][bj][n] = *(const f32x4*)(base + off + bj * HALF + n * 16); }
        const bool bad = st.run(acc, u, wr, wc, fr, fq, lds, wid, lane) || poison != 0u;
        const float qnan = __builtin_nanf("");
#pragma unroll
        for (int ai = 0; ai < 2; ++ai)
#pragma unroll
            for (int m = 0; m < 4; ++m) { const int r = ai * HALF + wr * 64 + m * 16 + fr; const f32x2v sr = S[r]; const size_t off = (size_t)(u.pm * BM + r) * ldc + col0;
#pragma unroll
                for (int bj = 0; bj < 2; ++bj)
#pragma unroll
                    for (int n = 0; n < 2; ++n) { const f32x4 bs = ai == 0 ? pre[m][bj][n] : *(const f32x4*)(base + off + bj * HALF + n * 16); f32x4 o = bs + (acc[ai][bj][m][n] - sr.x) * sr.y;
                        if (bad) o = (f32x4){qnan, qnan, qnan, qnan}; *(f32x4*)(out + off + bj * HALF + n * 16) = o; }
                if (m & 1) asm volatile("" ::: "memory"); }
    }
};
struct EpiLnResLn {
    static constexpr bool PERM = false, AFTER_DRAIN = true;
    const float* base; float* out; bf16_t* xn; int ldc; const float* bias; PanelStats st1, st2; unsigned poison;
    __device__ __forceinline__ void fused(f32x4 (&acc)[2][2][4][2], const Unit& u, int wr, int wc, int fr, int fq, PG8_LAS unsigned char* lds, int wid, int lane) const {
        typedef float f32x2v __attribute__((ext_vector_type(2))); typedef unsigned u32x2v __attribute__((ext_vector_type(2)));
        const PG8_LAS f32x2v* S = (const PG8_LAS f32x2v*)(lds + 8192);
        const int col0 = u.pn * BM + wc * 32 + 4 * fq;
#pragma unroll
        for (int bj = 0; bj < 2; ++bj)
#pragma unroll
            for (int n = 0; n < 2; ++n) { const f32x4 bv = bias ? *(const f32x4*)(bias + col0 + bj * HALF + n * 16) : (f32x4){0.f, 0.f, 0.f, 0.f};
#pragma unroll
                for (int ai = 0; ai < 2; ++ai)
#pragma unroll
                    for (int m = 0; m < 4; ++m) acc[ai][bj][m][n] += bv; }
        bool bad = st1.run(acc, u, wr, wc, fr, fq, lds, wid, lane) || poison != 0u;
        const float qnan = __builtin_nanf("");
#pragma unroll
        for (int ai = 0; ai < 2; ++ai)
#pragma unroll
            for (int m = 0; m < 4; ++m) { const int r = ai * HALF + wr * 64 + m * 16 + fr; const f32x2v sr = S[r]; const size_t off = (size_t)(u.pm * BM + r) * ldc + col0;
#pragma unroll
                for (int bj = 0; bj < 2; ++bj)
#pragma unroll
                    for (int n = 0; n < 2; ++n) { const f32x4 bs = *(const f32x4*)(base + off + bj * HALF + n * 16); acc[ai][bj][m][n] = bs + (acc[ai][bj][m][n] - sr.x) * sr.y; }
                asm volatile("" : "+v"(acc[ai][0][m][0]), "+v"(acc[ai][0][m][1]), "+v"(acc[ai][1][m][0]), "+v"(acc[ai][1][m][1]));
                if (m & 1) asm volatile("" ::: "memory"); }
        const bool bad1 = bad;
        bad = st2.run(acc, u, wr, wc, fr, fq, lds, wid, lane) || bad;
#pragma unroll
        for (int ai = 0; ai < 2; ++ai)
#pragma unroll
            for (int m = 0; m < 4; ++m) { const int r = ai * HALF + wr * 64 + m * 16 + fr; const f32x2v sr = S[r]; const size_t off = (size_t)(u.pm * BM + r) * ldc + col0;
#pragma unroll
                for (int bj = 0; bj < 2; ++bj)
#pragma unroll
                    for (int n = 0; n < 2; ++n) { const f32x4 x1 = acc[ai][bj][m][n]; *(f32x4*)(out + off + bj * HALF + n * 16) = bad1 ? (f32x4){qnan, qnan, qnan, qnan} : x1;
                        const f32x4 o = (x1 - sr.x) * sr.y; u32x2v w; w.x = cvt_pk_bf16(o[0], o[1]); w.y = cvt_pk_bf16(o[2], o[3]);
                        if (bad) { w.x = 0x7fc07fc0u; w.y = 0x7fc07fc0u; } *(u32x2v*)(xn + off + bj * HALF + n * 16) = w; }
                asm volatile("" ::: "memory"); }
    }
};

template <class Epi, class Sched, bool ALIGN_EPI = false, bool SP2 = false>
__device__ __forceinline__ void gemm_phase(PG8_LAS unsigned char* lds, const Gemm g, const Sched& S, const Epi& E, int wave_s_) {
    int tid = MK_TID(wave_s_); asm volatile("" : "+v"(tid));
    const int wid = __builtin_amdgcn_readfirstlane(tid >> 6), lane = tid & 63, wr = wid >> 2, wc = wid & 3, fr = lane & 15, fq = lane >> 4;
    const int K = g.K, nt_def = K / BK;
    unsigned voffA[2], voffB[2];
#pragma unroll
    for (int i = 0; i < 2; ++i) { int R, C; stage_rc(tid * 16 + i * 8192, R, C); const int Rb = Epi::PERM ? ((R & ~31) + perm32(R & 31)) : R;
        voffA[i] = (unsigned)(R * g.ld + C) * 2u; voffB[i] = (unsigned)(Rb * g.ld + C) * 2u; }
    const size_t kstep = (size_t)(BK * 2);
    const size_t hstep = (size_t)HALF * g.ld * 2;
    const size_t tstep = 2 * hstep;
    const unsigned ldsw = (unsigned)wid * 1024u;
    const int aoff = lds_byte(wr * 64 + fr, fq * 8), boff = lds_byte(wc * 32 + fr, fq * 8);
#define PG8_SA(b, h) (((b) * 2 + (h)) * HTB)
#define PG8_SB(b, h) ((4 + (b) * 2 + (h)) * HTB)
#define PG8_STAGE(bufoff, gbase, voff) do { _Pragma("unroll") for (int _i = 0; _i < 2; ++_i) \
        __builtin_amdgcn_global_load_lds((const unsigned*)((const char*)(gbase) + (voff)[_i]), (PG8_LAS unsigned*)(lds + (bufoff) + ldsw + _i * 8192), 16, 0, 0); } while (0)
#define PG8_LDA(dst, b, h) do { _Pragma("unroll") for (int m = 0; m < 4; ++m) _Pragma("unroll") for (int k = 0; k < 2; ++k) dst[m][k] = *(const PG8_LAS bf16x8*)(lds + PG8_SA(b, h) + aoff + m * 2048 + k * 1024); } while (0)
#define PG8_LDB(dst, b, h) do { _Pragma("unroll") for (int n = 0; n < 2; ++n) _Pragma("unroll") for (int k = 0; k < 2; ++k) dst[n][k] = *(const PG8_LAS bf16x8*)(lds + PG8_SB(b, h) + boff + n * 2048 + k * 1024); } while (0)
#define PG8_MMA(ai, bj, At, Bt) do { __builtin_amdgcn_s_setprio(1); _Pragma("unroll") for (int m = 0; m < 4; ++m) _Pragma("unroll") for (int n = 0; n < 2; ++n) _Pragma("unroll") for (int k = 0; k < 2; ++k) \
        acc[ai][bj][m][n] = __builtin_amdgcn_mfma_f32_16x16x32_bf16(Bt[n][k], At[m][k], acc[ai][bj][m][n], 0, 0, 0); __builtin_amdgcn_s_setprio(0); } while (0)
#define PG8_WAIT_V(n) asm volatile("s_waitcnt vmcnt(" #n ")" ::: "memory")
#define PG8_WAIT_L(n) asm volatile("s_waitcnt lgkmcnt(" #n ")" ::: "memory")
#define PG8_BAR __builtin_amdgcn_s_barrier()
#define PG8_SCHED __builtin_amdgcn_sched_barrier(0)
    Unit cur, nxt; int ui = 0;
    if (!S.next(0, cur)) return;
    f32x4 acc[2][2][4][2];
#pragma unroll
    for (int a = 0; a < 2; ++a)
#pragma unroll
        for (int b = 0; b < 2; ++b)
#pragma unroll
            for (int m = 0; m < 4; ++m)
#pragma unroll
                for (int n = 0; n < 2; ++n) acc[a][b][m][n] = (f32x4){0.f, 0.f, 0.f, 0.f};
    bf16x8 At[4][2], B0[2][2], B1[2][2];
    const char* cA = (const char*)g.A + (size_t)cur.pm * tstep + (size_t)cur.koff * 2; const char* cB = (const char*)g.Bt + (size_t)cur.pn * tstep + (size_t)cur.boff * 2;
    S.a_ready(cur);
    if constexpr (SP2) {
        PG8_STAGE(PG8_SB(0, 0), cB, voffB); PG8_STAGE(PG8_SB(0, 1), cB + hstep, voffB); PG8_STAGE(PG8_SA(0, 0), cA, voffA); PG8_STAGE(PG8_SA(0, 1), cA + hstep, voffA);
        if (wr == 1) PG8_BAR;
        PG8_WAIT_V(2); PG8_BAR;
        PG8_STAGE(PG8_SB(1, 0), cB + kstep, voffB); PG8_STAGE(PG8_SA(1, 0), cA + kstep, voffA); PG8_STAGE(PG8_SB(1, 1), cB + hstep + kstep, voffB);
        PG8_WAIT_V(6); PG8_BAR;
    } else {
        PG8_STAGE(PG8_SB(0, 0), cB, voffB); PG8_STAGE(PG8_SA(0, 0), cA, voffA); PG8_STAGE(PG8_SB(0, 1), cB + hstep, voffB); PG8_STAGE(PG8_SA(0, 1), cA + hstep, voffA);
        if (wr == 1) PG8_BAR;
        PG8_WAIT_V(4); PG8_BAR;
        PG8_STAGE(PG8_SB(1, 0), cB + kstep, voffB); PG8_STAGE(PG8_SA(1, 0), cA + kstep, voffA); PG8_STAGE(PG8_SB(1, 1), cB + hstep + kstep, voffB);
        PG8_WAIT_V(6); PG8_BAR;
    }
    for (;;) {
        const bool has_next = S.next(ui + 1, nxt);
        const char* nA = has_next ? (const char*)g.A + (size_t)nxt.pm * tstep + (size_t)nxt.koff * 2 : cA; const char* nB = has_next ? (const char*)g.Bt + (size_t)nxt.pn * tstep + (size_t)nxt.boff * 2 : cB;
        const int nt = cur.ntile() ? cur.ntile() : nt_def;
        for (int t = 0; t < nt; t += 2) {
            const bool last = (t == nt - 2);
            const char* a1 = cA + (size_t)(t + 1) * kstep;
            const char* a2 = last ? nA : cA + (size_t)(t + 2) * kstep; const char* b2 = last ? nB : cB + (size_t)(t + 2) * kstep;
            const char* a3 = a2 + kstep; const char* b3 = b2 + kstep;
            if (last && has_next) S.a_ready(nxt);
            if constexpr (SP2) {
            PG8_LDB(B0, 0, 0); PG8_LDB(B1, 0, 1); PG8_SCHED; PG8_LDA(At, 0, 0); PG8_STAGE(PG8_SA(1, 1), a1 + hstep, voffA);
            PG8_WAIT_V(8); PG8_WAIT_L(0); PG8_BAR; PG8_MMA(0, 0, At, B0); PG8_MMA(0, 1, At, B1); PG8_BAR; PG8_SCHED;
            PG8_LDA(At, 0, 1); PG8_STAGE(PG8_SB(0, 0), b2, voffB); PG8_STAGE(PG8_SB(0, 1), b2 + hstep, voffB); PG8_STAGE(PG8_SA(0, 0), a2, voffA);
            PG8_WAIT_V(8); PG8_WAIT_L(0); PG8_BAR; PG8_MMA(1, 0, At, B0); PG8_MMA(1, 1, At, B1); PG8_BAR; PG8_SCHED;
            PG8_LDB(B0, 1, 0); PG8_LDB(B1, 1, 1); PG8_SCHED; PG8_LDA(At, 1, 0); PG8_STAGE(PG8_SA(0, 1), a2 + hstep, voffA);
            PG8_WAIT_V(8); PG8_WAIT_L(0); PG8_BAR; PG8_MMA(0, 0, At, B0); PG8_MMA(0, 1, At, B1); PG8_BAR; PG8_SCHED;
            PG8_LDA(At, 1, 1); PG8_STAGE(PG8_SB(1, 0), b3, voffB); PG8_STAGE(PG8_SB(1, 1), b3 + hstep, voffB); PG8_STAGE(PG8_SA(1, 0), a3, voffA);
            PG8_WAIT_V(8); PG8_WAIT_L(0); PG8_BAR; PG8_MMA(1, 0, At, B0); PG8_MMA(1, 1, At, B1); PG8_BAR; PG8_SCHED;
            } else {
            PG8_LDB(B0, 0, 0); PG8_SCHED; PG8_LDA(At, 0, 0); PG8_STAGE(PG8_SA(1, 1), a1 + hstep, voffA);
            PG8_WAIT_L(8); PG8_BAR; PG8_WAIT_L(0); PG8_MMA(0, 0, At, B0); PG8_BAR; PG8_SCHED;
            PG8_LDB(B1, 0, 1); PG8_STAGE(PG8_SB(0, 0), b2, voffB);
            PG8_BAR; PG8_WAIT_L(0); PG8_MMA(0, 1, At, B1); PG8_BAR;
            PG8_LDA(At, 0, 1); PG8_STAGE(PG8_SA(0, 0), a2, voffA);
            PG8_BAR; PG8_WAIT_L(0); PG8_MMA(1, 0, At, B0); PG8_BAR; PG8_SCHED;
            PG8_STAGE(PG8_SB(0, 1), b2 + hstep, voffB);
            PG8_WAIT_V(6); PG8_BAR; PG8_MMA(1, 1, At, B1); PG8_BAR;
            PG8_LDB(B0, 1, 0); PG8_SCHED; PG8_LDA(At, 1, 0); PG8_STAGE(PG8_SA(0, 1), a2 + hstep, voffA);
            PG8_WAIT_L(8); PG8_BAR; PG8_WAIT_L(0); PG8_MMA(0, 0, At, B0); PG8_BAR; PG8_SCHED;
            PG8_LDB(B1, 1, 1); PG8_STAGE(PG8_SB(1, 0), b3, voffB);
            PG8_BAR; PG8_WAIT_L(0); PG8_MMA(0, 1, At, B1); PG8_BAR;
            PG8_LDA(At, 1, 1); PG8_STAGE(PG8_SA(1, 0), a3, voffA);
            PG8_BAR; PG8_WAIT_L(0); PG8_MMA(1, 0, At, B0); PG8_BAR; PG8_SCHED;
            PG8_STAGE(PG8_SB(1, 1), b3 + hstep, voffB);
            PG8_WAIT_V(6); PG8_BAR; PG8_MMA(1, 1, At, B1); PG8_BAR;
            }
        }
        if constexpr (ALIGN_EPI) { if (wr == 0) PG8_BAR; }
        if constexpr (!Epi::AFTER_DRAIN) { E(acc, cur, wr, wc, fr, fq); S.done(cur); }
        if (!has_next) break;
        if (!nxt.carry()) {
#pragma unroll
        for (int a = 0; a < 2; ++a)
#pragma unroll
            for (int b = 0; b < 2; ++b)
#pragma unroll
                for (int m = 0; m < 4; ++m)
#pragma unroll
                    for (int n = 0; n < 2; ++n) acc[a][b][m][n] = (f32x4){0.f, 0.f, 0.f, 0.f};
        }
        cur = nxt; cA = nA; cB = nB; ++ui;
        if constexpr (ALIGN_EPI) { if (wr == 1) PG8_BAR; }
    }
    PG8_WAIT_V(0);
    if constexpr (!ALIGN_EPI) { if (wr == 0) PG8_BAR; }
    PG8_BAR;
    if constexpr (Epi::AFTER_DRAIN) { E.fused(acc, cur, wr, wc, fr, fq, lds, wid, lane); S.done(cur); }
#undef PG8_SA
#undef PG8_SB
#undef PG8_STAGE
#undef PG8_LDA
#undef PG8_LDB
#undef PG8_MMA
#undef PG8_WAIT_V
#undef PG8_WAIT_L
#undef PG8_BAR
#undef PG8_SCHED
}
}

__device__ __forceinline__ float shfl_xor_f(float v, int o) { return __uint_as_float((unsigned)__builtin_amdgcn_ds_bpermute((mk_lane_id() ^ o) << 2, (int)__float_as_uint(v))); }
namespace attn128 {
using bf16 = __hip_bfloat16;
constexpr int D = 128, NW = 8, QBLK = 32, KVBLK = 64;
constexpr float SCALE = 0.088388347648318440f;
constexpr float THR = 8.f;
constexpr int SDEPTH = 2;
constexpr int LDQ = 1024, LDK = 1024, LDO = 1024;
constexpr size_t SHM_V = KVBLK * D * 2, SHM_K = KVBLK * D * 2, SHM_ATTN = 2 * SHM_V + 2 * SHM_K + NW * 64 * 4;
using bf16x8 = __attribute__((ext_vector_type(8))) short;
using s16x4  = __attribute__((ext_vector_type(4))) short;
using f32x16 = __attribute__((ext_vector_type(16))) float;
using f32x8  = __attribute__((ext_vector_type(8))) float;
using u32x4  = __attribute__((ext_vector_type(4))) unsigned;
#define KSWZ(row, colB) ((row) * 256 + ((colB) ^ (((row) & 7) << 4)))
#define SBAR() __builtin_amdgcn_sched_barrier(0)
__device__ __forceinline__ int crow(int r, int hi) { return (r & 3) + 8 * (r >> 2) + 4 * hi; }
__device__ __forceinline__ unsigned cvtpk(float lo, float hi) {
  unsigned r; asm volatile("v_cvt_pk_bf16_f32 %0, %1, %2" : "=v"(r) : "v"(lo), "v"(hi)); return r;
}
template <typename TIn> struct Stage;
template <> struct Stage<bf16>  { using T = bf16x8;
  __device__ static __forceinline__ T ld8(const bf16* p) { return *reinterpret_cast<const bf16x8*>(p); }
  __device__ static __forceinline__ bf16x8 tobf(T x) { return x; } };
template <> struct Stage<float> { using T = f32x8;
  __device__ static __forceinline__ T ld8(const float* p) { return *reinterpret_cast<const f32x8*>(p); }
  __device__ static __forceinline__ bf16x8 tobf(T x) {
    u32x4 w = {cvtpk(x[0], x[1]), cvtpk(x[2], x[3]), cvtpk(x[4], x[5]), cvtpk(x[6], x[7])}; return *reinterpret_cast<bf16x8*>(&w); } };

__device__ __forceinline__ void partialSM(f32x16& p0, f32x16& p1, float& m_reg, float& mn, float& alpha) {
  constexpr float C = SCALE * 1.4426950408889634f;
  float pmax = p0[0]; for (int r = 1; r < 16; ++r) pmax = fmaxf(pmax, p0[r]); for (int r = 0; r < 16; ++r) pmax = fmaxf(pmax, p1[r]);
  { auto rr = __builtin_amdgcn_permlane32_swap(__float_as_uint(pmax), __float_as_uint(pmax), false, false);
    pmax = fmaxf(__uint_as_float(rr[0]), __uint_as_float(rr[1])); }
  if (__builtin_expect(__all(pmax - m_reg <= THR / SCALE), 1)) { mn = m_reg; alpha = 1.f; }
  else { mn = fmaxf(m_reg, pmax); alpha = __builtin_amdgcn_exp2f((m_reg - mn) * C); m_reg = mn; }
  float mnC = -mn * C;
  for (int r = 0; r < 16; ++r) p0[r] = fmaf(p0[r], C, mnC); for (int r = 0; r < 16; ++r) p1[r] = fmaf(p1[r], C, mnC);
  for (int r = 0; r < 16; ++r) p0[r] = __builtin_amdgcn_exp2f(p0[r]);
}
__device__ __forceinline__ void finishSM(f32x16& p0, f32x16& p1, float alpha, float& l_reg, bf16x8& pa0, bf16x8& pa1, bf16x8& pa2, bf16x8& pa3) {
  for (int r = 0; r < 16; ++r) p1[r] = __builtin_amdgcn_exp2f(p1[r]);
  float ps = 0; for (int r = 0; r < 16; ++r) ps += p0[r]; for (int r = 0; r < 16; ++r) ps += p1[r];
  { auto rr = __builtin_amdgcn_permlane32_swap(__float_as_uint(ps), __float_as_uint(ps), false, false);
    ps = __uint_as_float(rr[0]) + __uint_as_float(rr[1]); }
  l_reg = l_reg * alpha + ps;
#define PK4(P, BASE, OUT) do { unsigned a0 = cvtpk(P[BASE + 0], P[BASE + 1]), a1 = cvtpk(P[BASE + 2], P[BASE + 3]);   \
    unsigned b0 = cvtpk(P[BASE + 4], P[BASE + 5]), b1 = cvtpk(P[BASE + 6], P[BASE + 7]);                              \
    auto r0 = __builtin_amdgcn_permlane32_swap(a0, b0, false, false); auto r1 = __builtin_amdgcn_permlane32_swap(a1, b1, false, false); \
    u32x4 w = {r0[0], r1[0], r0[1], r1[1]}; OUT = *reinterpret_cast<bf16x8*>(&w); } while (0)
  PK4(p0, 0, pa0); PK4(p0, 8, pa1); PK4(p1, 0, pa2); PK4(p1, 8, pa3);
#undef PK4
}
__device__ __forceinline__ void qkt(f32x16& p0, f32x16& p1, const bf16* Ks, const bf16x8* qr, int r32, int hi) {
  p0 = f32x16{}; p1 = f32x16{};
  for (int d0 = 0; d0 < 8; ++d0) { int cb = (d0 * 16 + hi * 8) * 2;
    bf16x8 b0 = *reinterpret_cast<const bf16x8*>((const char*)Ks + KSWZ(r32, cb));
    bf16x8 b1 = *reinterpret_cast<const bf16x8*>((const char*)Ks + KSWZ(32 + r32, cb));
    p0 = __builtin_amdgcn_mfma_f32_32x32x16_bf16(b0, qr[d0], p0, 0, 0, 0);
    p1 = __builtin_amdgcn_mfma_f32_32x32x16_bf16(b1, qr[d0], p1, 0, 0, 0); }
}
__device__ __forceinline__ int v_st(int k, int c) { const int kk = (k & ~0xC) | ((k & 4) << 1) | ((k & 8) >> 1); return ((kk >> 3) * 4 + (c >> 5)) * 512 + ((kk & 7) * 32 + (c & 31)) * 2; }
__device__ __forceinline__ int v_rd_base(int lane) { return ((lane & 3) << 3) | (((lane >> 2) & 3) << 6) | (((lane >> 4) & 1) << 5) | (((lane >> 5) & 1) << 8); }
constexpr int v_rd_off(int d0, int ks, int half) { return d0 * 512 + ks * 4096 + half * 2048; }
template <int OFF> __device__ __forceinline__ s16x4 tr_read(int vb) {
  s16x4 r; asm volatile("ds_read_b64_tr_b16 %0, %1 offset:%2" : "=&v"(r) : "v"(vb), "i"(OFF) : "memory"); return r;
}
template <int D0> __device__ __forceinline__ void pv_one(f32x16& od, int vb, bf16x8 pa0, bf16x8 pa1, bf16x8 pa2, bf16x8 pa3) {
  const s16x4 l0 = tr_read<v_rd_off(D0, 0, 0)>(vb), h0 = tr_read<v_rd_off(D0, 0, 1)>(vb), l1 = tr_read<v_rd_off(D0, 1, 0)>(vb), h1 = tr_read<v_rd_off(D0, 1, 1)>(vb);
  const s16x4 l2 = tr_read<v_rd_off(D0, 2, 0)>(vb), h2 = tr_read<v_rd_off(D0, 2, 1)>(vb), l3 = tr_read<v_rd_off(D0, 3, 0)>(vb), h3 = tr_read<v_rd_off(D0, 3, 1)>(vb);
  asm volatile("s_waitcnt lgkmcnt(0)" ::: "memory"); SBAR();
#define PK(L, H) (bf16x8){L[0], L[1], L[2], L[3], H[0], H[1], H[2], H[3]}
  od = __builtin_amdgcn_mfma_f32_32x32x16_bf16(pa0, PK(l0, h0), od, 0, 0, 0);
  od = __builtin_amdgcn_mfma_f32_32x32x16_bf16(pa1, PK(l1, h1), od, 0, 0, 0);
  od = __builtin_amdgcn_mfma_f32_32x32x16_bf16(pa2, PK(l2, h2), od, 0, 0, 0);
  od = __builtin_amdgcn_mfma_f32_32x32x16_bf16(pa3, PK(l3, h3), od, 0, 0, 0);
#undef PK
}
__device__ __forceinline__ void pv_d0(f32x16* o, int vb, bf16x8 pa0, bf16x8 pa1, bf16x8 pa2, bf16x8 pa3) {
  pv_one<0>(o[0], vb, pa0, pa1, pa2, pa3); pv_one<1>(o[1], vb, pa0, pa1, pa2, pa3); pv_one<2>(o[2], vb, pa0, pa1, pa2, pa3); pv_one<3>(o[3], vb, pa0, pa1, pa2, pa3);
}

template <typename TQ>
__device__ __forceinline__ void attn_dense_body(const TQ* __restrict__ Qb, const bf16* __restrict__ Kh, const bf16* __restrict__ Vh,
                                                float* __restrict__ Ob, int seq, char* lds, int wave_s_) {
  using St = Stage<bf16>; using SQ = Stage<TQ>;
  int tid = MK_TID(wave_s_); asm volatile("" : "+v"(tid));
  const int wid = tid >> 6, lane = tid & 63, r32 = lane & 31, hi = lane >> 5;
  bf16* V_lds = (bf16*)lds; bf16* K_lds = (bf16*)(lds + 2 * SHM_V);
  float* ws = (float*)(lds + 2 * SHM_V + 2 * SHM_K) + wid * 64; float* li_l = ws; float* al_l = ws + 32;
  float m_reg = -1e30f, l_reg = 0; f32x16 o[4] = {}; bf16x8 qr[8];
  const TQ* Qw = Qb + (long)(wid * QBLK + r32) * LDQ + hi * 8;
#pragma unroll
  for (int d0 = 0; d0 < 8; ++d0) qr[d0] = SQ::tobf(SQ::ld8(Qw + d0 * 16));
  const int sr = tid >> 4, sc = (tid & 15) * 8, vst0 = v_st(sr, sc), vst1 = v_st(32 + sr, sc);
  const int vb0 = (int)(uintptr_t)V_lds + v_rd_base(lane);
  struct { typename St::T vs0, vs1, ks0, ks1; } sr_[SDEPTH];
#define SLOAD(i, k0) do { sr_[i].vs0 = St::ld8(&Vh[(long)((k0) + sr) * LDK + sc]); sr_[i].vs1 = St::ld8(&Vh[(long)((k0) + 32 + sr) * LDK + sc]); \
    sr_[i].ks0 = St::ld8(&Kh[(long)((k0) + sr) * LDK + sc]); sr_[i].ks1 = St::ld8(&Kh[(long)((k0) + 32 + sr) * LDK + sc]); } while (0)
#define SWRITE(b, i) do { *(bf16x8*)((char*)V_lds + (b) * SHM_V + vst0) = St::tobf(sr_[i].vs0);          \
    *(bf16x8*)((char*)V_lds + (b) * SHM_V + vst1) = St::tobf(sr_[i].vs1); int kc = sc * 2;               \
    *(bf16x8*)((char*)K_lds + (b) * SHM_K + KSWZ(sr, kc)) = St::tobf(sr_[i].ks0);                       \
    *(bf16x8*)((char*)K_lds + (b) * SHM_K + KSWZ(32 + sr, kc)) = St::tobf(sr_[i].ks1); } while (0)
#define SWAIT() do { if constexpr (SDEPTH == 2) asm volatile("s_waitcnt vmcnt(4)" ::: "memory"); else asm volatile("s_waitcnt vmcnt(0)" ::: "memory"); } while (0)
#define RESC(a) do { if (__any((a) < 1.f)) { if (hi == 0) al_l[r32] = (a); asm volatile("s_waitcnt lgkmcnt(0)" ::: "memory"); \
    for (int d = 0; d < 4; ++d) for (int r = 0; r < 16; ++r) o[d][r] *= al_l[crow(r, hi)]; } } while (0)
  f32x16 pA0, pA1, pB0, pB1; float mnA, mnB, alA, alB; bf16x8 pa0, pa1, pa2, pa3; const int NT = seq / KVBLK;
  constexpr int SE = 0, SO = SDEPTH - 1;
  SLOAD(SE, 0); asm volatile("s_waitcnt vmcnt(0)" ::: "memory"); SWRITE(0, SE); __syncthreads();
  qkt(pA0, pA1, K_lds, qr, r32, hi); partialSM(pA0, pA1, m_reg, mnA, alA);
  SLOAD(SO, KVBLK); if constexpr (SDEPTH == 2) { if (2 < NT) SLOAD(SE, 2 * KVBLK); }
  SWAIT(); SWRITE(1, SO); __syncthreads();
  for (int j = 1; j + 1 < NT; j += 2) {
    SBAR(); qkt(pB0, pB1, (bf16*)((char*)K_lds + SHM_K), qr, r32, hi);
    finishSM(pA0, pA1, alA, l_reg, pa0, pa1, pa2, pa3); SBAR();
    SLOAD(SO, (j + SDEPTH) * KVBLK); SBAR();
    pv_d0(o, vb0, pa0, pa1, pa2, pa3); partialSM(pB0, pB1, m_reg, mnB, alB);
    __syncthreads(); SWAIT(); SWRITE(0, SE);
    RESC(alB); __syncthreads();
    SBAR(); qkt(pA0, pA1, K_lds, qr, r32, hi);
    finishSM(pB0, pB1, alB, l_reg, pa0, pa1, pa2, pa3); SBAR();
    if (SDEPTH == 1 || j + 3 < NT) SLOAD(SE, (j + 1 + SDEPTH) * KVBLK); SBAR();
    pv_d0(o, vb0 + (int)SHM_V, pa0, pa1, pa2, pa3); partialSM(pA0, pA1, m_reg, mnA, alA);
    __syncthreads(); SWAIT(); SWRITE(1, SO);
    RESC(alA); __syncthreads();
  }
  SBAR(); qkt(pB0, pB1, (bf16*)((char*)K_lds + SHM_K), qr, r32, hi);
  finishSM(pA0, pA1, alA, l_reg, pa0, pa1, pa2, pa3); SBAR();
  pv_d0(o, vb0, pa0, pa1, pa2, pa3); partialSM(pB0, pB1, m_reg, mnB, alB);
  __syncthreads(); RESC(alB);
  finishSM(pB0, pB1, alB, l_reg, pa0, pa1, pa2, pa3); SBAR();
  pv_d0(o, vb0 + (int)SHM_V, pa0, pa1, pa2, pa3);
  if (hi == 0) li_l[r32] = l_reg; asm volatile("s_waitcnt lgkmcnt(0)" ::: "memory");
  float rli[16];
#pragma unroll
  for (int r = 0; r < 16; ++r) rli[r] = __builtin_amdgcn_rcpf(li_l[crow(r, hi)]);
  float* Ow = Ob + (long)(wid * QBLK) * LDO;
#pragma unroll
  for (int r = 0; r < 16; ++r) { int orow = crow(r, hi);
    for (int d0 = 0; d0 < 4; ++d0) Ow[(long)orow * LDO + d0 * 32 + r32] = o[d0][r] * rli[r]; }
#undef SLOAD
#undef SWRITE
#undef SWAIT
#undef RESC
}

}

namespace attn256 {
using namespace attn128;
constexpr size_t SHM_V2 = KVBLK * 256 * 2, SHM_K2 = KVBLK * D * 2;
constexpr int LDV = 1024;
__device__ __forceinline__ int v_st2(int k, int c) { const int kk = (k & ~0xC) | ((k & 4) << 1) | ((k & 8) >> 1); return ((kk >> 3) * 8 + (c >> 5)) * 512 + ((kk & 7) * 32 + (c & 31)) * 2; }
constexpr int v_rd_off2(int d0, int ks, int half) { return d0 * 512 + ks * 8192 + half * 4096; }
typedef __attribute__((address_space(3))) s16x4 lds_s16x4_t;
template <int OFF> __device__ __forceinline__ s16x4 tr_read_b(int vb) { return __builtin_amdgcn_ds_read_tr16_b64_v4i16((lds_s16x4_t*)(unsigned long)(unsigned)(vb + OFF)); }
template <int D0> __device__ __forceinline__ void pv_one2(f32x16& od, int vb, bf16x8 pa0, bf16x8 pa1, bf16x8 pa2, bf16x8 pa3) {
  const s16x4 l0 = tr_read_b<v_rd_off2(D0, 0, 0)>(vb), h0 = tr_read_b<v_rd_off2(D0, 0, 1)>(vb), l1 = tr_read_b<v_rd_off2(D0, 1, 0)>(vb), h1 = tr_read_b<v_rd_off2(D0, 1, 1)>(vb);
  const s16x4 l2 = tr_read_b<v_rd_off2(D0, 2, 0)>(vb), h2 = tr_read_b<v_rd_off2(D0, 2, 1)>(vb), l3 = tr_read_b<v_rd_off2(D0, 3, 0)>(vb), h3 = tr_read_b<v_rd_off2(D0, 3, 1)>(vb);
  SBAR();
#define PK(L, H) (bf16x8){L[0], L[1], L[2], L[3], H[0], H[1], H[2], H[3]}
  od = __builtin_amdgcn_mfma_f32_32x32x16_bf16(pa0, PK(l0, h0), od, 0, 0, 0);
  od = __builtin_amdgcn_mfma_f32_32x32x16_bf16(pa1, PK(l1, h1), od, 0, 0, 0);
  od = __builtin_amdgcn_mfma_f32_32x32x16_bf16(pa2, PK(l2, h2), od, 0, 0, 0);
  od = __builtin_amdgcn_mfma_f32_32x32x16_bf16(pa3, PK(l3, h3), od, 0, 0, 0);
#undef PK
}
__device__ __forceinline__ void attn_o256_body(const bf16* __restrict__ Qb, const bf16* __restrict__ Kh, const bf16* __restrict__ Vh, float* __restrict__ Ob, int seq, char* lds, int wave_s_) {
  using St = Stage<bf16>;
  int tid = MK_TID(wave_s_); asm volatile("" : "+v"(tid));
  const int wid = tid >> 6, lane = tid & 63, r32 = lane & 31, hi = lane >> 5;
  bf16* V_lds = (bf16*)lds; bf16* K_lds = (bf16*)(lds + 2 * SHM_V2);
  float* ws = (float*)(lds + 2 * SHM_V2 + 2 * SHM_K2) + wid * 64; float* li_l = ws; float* al_l = ws + 32;
  float m_reg = -1e30f, l_reg = 0; f32x16 o[8] = {}; bf16x8 qr[8];
  const bf16* Qw = Qb + (long)(wid * QBLK + r32) * LDQ + hi * 8;
#pragma unroll
  for (int d0 = 0; d0 < 8; ++d0) qr[d0] = St::ld8(Qw + d0 * 16);
  const int vb0 = (int)(uintptr_t)V_lds + v_rd_base(lane);
  bf16x8 sv00, sv01, sv10, sv11, sk0, sk1;
#define SLOAD2(k0) do { const int t_ = MK_TID(wave_s_), sr = t_ >> 4, sc = (t_ & 15) * 8; const bf16* vp = Vh + (long)((k0) + sr) * LDV + sc; const bf16* kp = Kh + (long)((k0) + sr) * LDK + sc; \
    sv00 = St::ld8(vp); sv01 = St::ld8(vp + 128); sv10 = St::ld8(vp + 32 * LDV); sv11 = St::ld8(vp + 32 * LDV + 128); sk0 = St::ld8(kp); sk1 = St::ld8(kp + 32 * LDK); } while (0)
#define SWRITE2(b) do { const int t_ = MK_TID(wave_s_), sr = t_ >> 4, sc = (t_ & 15) * 8; char* vbuf = (char*)V_lds + (b) * SHM_V2 + v_st2(sr, sc); \
    *(bf16x8*)(vbuf) = sv00; *(bf16x8*)(vbuf + 2048) = sv01; *(bf16x8*)(vbuf + 16384) = sv10; *(bf16x8*)(vbuf + 18432) = sv11; \
    char* kbuf = (char*)K_lds + (b) * SHM_K2 + KSWZ(sr, sc * 2); *(bf16x8*)(kbuf) = sk0; *(bf16x8*)(kbuf + 8192) = sk1; } while (0)
  const int NT = seq / KVBLK;
  SLOAD2(0); asm volatile("s_waitcnt vmcnt(0)" ::: "memory"); SWRITE2(0); __syncthreads();
  for (int j = 0; j < NT; ++j) {
    const int b = j & 1;
    f32x16 p0, p1; float mn, al; bf16x8 pa0, pa1, pa2, pa3;
    SBAR(); qkt(p0, p1, (bf16*)((char*)K_lds + b * SHM_K2), qr, r32, hi);
    partialSM(p0, p1, m_reg, mn, al);
    finishSM(p0, p1, al, l_reg, pa0, pa1, pa2, pa3); SBAR();
    if (__any(al < 1.f)) { if (hi == 0) al_l[r32] = al; asm volatile("s_waitcnt lgkmcnt(0)" ::: "memory");
#pragma unroll
      for (int d = 0; d < 8; ++d)
#pragma unroll
        for (int r = 0; r < 16; ++r) o[d][r] *= al_l[crow(r, hi)]; }
    if (j + 1 < NT) SLOAD2((j + 1) * KVBLK);
    SBAR();
    { const int vb = vb0 + b * (int)SHM_V2;
      pv_one2<0>(o[0], vb, pa0, pa1, pa2, pa3); pv_one2<1>(o[1], vb, pa0, pa1, pa2, pa3); pv_one2<2>(o[2], vb, pa0, pa1, pa2, pa3); pv_one2<3>(o[3], vb, pa0, pa1, pa2, pa3);
      pv_one2<4>(o[4], vb, pa0, pa1, pa2, pa3); pv_one2<5>(o[5], vb, pa0, pa1, pa2, pa3); pv_one2<6>(o[6], vb, pa0, pa1, pa2, pa3); pv_one2<7>(o[7], vb, pa0, pa1, pa2, pa3); }
    if (j + 1 < NT) { asm volatile("s_waitcnt vmcnt(0)" ::: "memory"); SWRITE2(b ^ 1); }
    __syncthreads();
  }
  if (hi == 0) li_l[r32] = l_reg; asm volatile("s_waitcnt lgkmcnt(0)" ::: "memory");
  float rli[16];
#pragma unroll
  for (int r = 0; r < 16; ++r) rli[r] = __builtin_amdgcn_rcpf(li_l[crow(r, hi)]);
  float* Ow = Ob + (long)(wid * QBLK) * LDO;
#pragma unroll
  for (int r = 0; r < 16; ++r) { const int orow = crow(r, hi);
#pragma unroll
    for (int d0 = 0; d0 < 8; ++d0) Ow[(long)orow * LDO + d0 * 32 + r32] = o[d0][r] * rli[r]; }
#undef SLOAD2
#undef SWRITE2
}
}

#define GAS __attribute__((address_space(1)))
#define LAS __attribute__((address_space(3)))
typedef unsigned short bf16;
typedef unsigned v4u __attribute__((ext_vector_type(4)));
typedef float f32x4 __attribute__((ext_vector_type(4)));
typedef short bf16x8 __attribute__((ext_vector_type(8)));
typedef GAS unsigned gu32;
typedef GAS unsigned long long gu64;
#define RLX_AGENT __ATOMIC_RELAXED, __HIP_MEMORY_SCOPE_AGENT
#define LDS_WAIT() asm volatile("s_waitcnt lgkmcnt(0)" ::: "memory")
#define VM_WAIT() asm volatile("s_waitcnt vmcnt(0)" ::: "memory")
__device__ __forceinline__ unsigned long long rt() { return __builtin_amdgcn_s_memrealtime(); }
__device__ __forceinline__ unsigned f2bf(float f) { unsigned u = __builtin_bit_cast(unsigned, f); return (u + 0x7fffu + ((u >> 16) & 1u)) >> 16; }
__device__ __forceinline__ unsigned pk2(float lo, float hi) { return f2bf(lo) | (f2bf(hi) << 16); }

#define XB_TMO      128
#define XB_XCNT(j)  (256  + 64 * (j))
#define XB_XSUB(j)  (1280 + 64 * (j))
#define XB_XGEN(j)  (2304 + 64 * (j))
#define XB_TOP      3328
#define XB_TOPGEN   3392
#define XCD_BAR_WORDS 3456
#define XB_SPIN_CAP (1u << 22)

__device__ __forceinline__ unsigned xb_ld(unsigned* p)              { return __hip_atomic_load(p, __ATOMIC_RELAXED, __HIP_MEMORY_SCOPE_AGENT); }
__device__ __forceinline__ unsigned xb_add(unsigned* p, unsigned v) { return __hip_atomic_fetch_add(p, v, __ATOMIC_RELAXED, __HIP_MEMORY_SCOPE_AGENT); }
__device__ __forceinline__ unsigned xb_xcc_id() { return (unsigned)__builtin_amdgcn_s_getreg((3 << 11) | 20) & 0xFu; }
#define XB_SPIN(cond, bar) do { unsigned _sp = 0; while (cond) { __builtin_amdgcn_s_sleep(1); \
    if ((++_sp & 255u) == 0u) { if (xb_ld(&(bar)[XB_TMO])) break; if (_sp > XB_SPIN_CAP) { atomicAdd(&(bar)[XB_TMO], 1u); break; } } } } while (0)

struct XcdBarrier {
    unsigned* bar; unsigned x;
    volatile LAS unsigned* st;
};

__device__ __forceinline__ XcdBarrier xcd_barrier_post(unsigned* bar, volatile LAS unsigned* st, int tid_) {
    XcdBarrier b; b.bar = bar; b.x = xb_xcc_id(); b.st = st;
    if (tid_ == 0) (void)xb_add(&bar[XB_XCNT(b.x)], 1u);
    return b;
}
__device__ __forceinline__ void xcd_barrier_complete(unsigned* bar, unsigned x, unsigned& nloc, unsigned& nx) {
    const unsigned G = gridDim.x * gridDim.y * gridDim.z;
    unsigned sum, cnt, mine, sp = 0u;
    for (;;) {
        sum = 0u; cnt = 0u; mine = 0u;
#pragma unroll
        for (unsigned j = 0; j < 16; ++j) { const unsigned c = xb_ld(&bar[XB_XCNT(j)]); sum += c; cnt += (c > 0u) ? 1u : 0u; mine = (j == x) ? c : mine; }
        if (sum == G) break;
        __builtin_amdgcn_s_sleep(1);
        if ((++sp & 255u) == 0u) { if (xb_ld(&bar[XB_TMO])) break; if (sp > XB_SPIN_CAP) { atomicAdd(&bar[XB_TMO], 1u); break; } }
    }
    nloc = mine > 0u ? mine : 1u; nx = cnt > 0u ? cnt : 1u;
}

__device__ __forceinline__ void xcd_barrier(const XcdBarrier& b, int tid_) {
    asm volatile("s_waitcnt vmcnt(0)" ::: "memory");
    __syncthreads();
    if (tid_ == 0) {
        unsigned* bar = b.bar;
        __builtin_amdgcn_s_waitcnt(0);
        unsigned nloc = b.st[0], nx = b.st[1];
        if (nloc == 0u) { xcd_barrier_complete(bar, b.x, nloc, nx); b.st[0] = nloc; b.st[1] = nx; }
        const unsigned old = xb_add(&bar[XB_XSUB(b.x)], 1u);
        const unsigned gen = old / nloc;
        if (old + 1u == (gen + 1u) * nloc) {
            __builtin_amdgcn_fence(__ATOMIC_RELEASE, "agent");
            asm volatile("s_waitcnt vmcnt(0)" ::: "memory");
            const unsigned og = xb_add(&bar[XB_TOP], 1u);
            const unsigned tg = og / nx;
            if (og + 1u == (tg + 1u) * nx) xb_add(&bar[XB_TOPGEN], 1u);
            else XB_SPIN(xb_ld(&bar[XB_TOPGEN]) == tg, bar);
            __builtin_amdgcn_fence(__ATOMIC_ACQUIRE, "agent");
            xb_add(&bar[XB_XGEN(b.x)], 1u);
            asm volatile("s_waitcnt vmcnt(0)" ::: "memory");
        } else {
            XB_SPIN(xb_ld(&bar[XB_XGEN(b.x)]) == gen, bar);
            __builtin_amdgcn_fence(__ATOMIC_ACQUIRE, "agent");
            asm volatile("s_waitcnt vmcnt(0)" ::: "memory");
        }
    }
    __syncthreads();
}

constexpr int DM = 4096, SEQ = 8192, CTXL = 256, MT = SEQ + CTXL, DEPTH = 4, FFND = 4096;
constexpr int NZ = 20480, INC = 20496, ADAR = 256, NMOD = 9 * DM;
constexpr int ZC_UV = 0, ZC_MQ = 2048, ZC_MK = 2560, ZC_MV = 3072, ZC_MO = 4096, ZC_AQ = 5120, ZC_AK = 6144, ZC_AV = 7168, ZC_MG = 8192;
constexpr float EPS = 1e-6f;
constexpr int NWAVES = 8, NTHR = 512;

constexpr size_t MiB = 1ull << 20;
constexpr size_t WS_CTL = 0, CTL_ZERO_BYTES = 1 * MiB;
constexpr size_t WS_MODTP = 1 * MiB;
constexpr size_t WS_MOD = WS_MODTP + 512 * 1024;
constexpr size_t WS_LAM = WS_MOD + (size_t)DEPTH * 2 * NMOD * 4;
constexpr size_t WS_WG16 = WS_LAM + 256;
constexpr size_t WS_ROPE = WS_WG16 + (size_t)DEPTH * 16 * DM * 4;
constexpr size_t WS_G16 = WS_ROPE + (size_t)2 * SEQ * 64 * 4;
constexpr size_t WS_XR = 9 * MiB;
constexpr size_t SZ_ROWS_F32 = (size_t)MT * DM * 4, SZ_ROWS_BF = (size_t)MT * DM * 2;
constexpr size_t WS_H = WS_XR + SZ_ROWS_F32;
constexpr size_t WS_GB = WS_H + SZ_ROWS_BF;
constexpr size_t WS_Z = WS_GB + SZ_ROWS_BF;
constexpr size_t WS_ATTO = WS_Z + (size_t)MT * NZ * 2;
constexpr size_t WS_MLH = WS_ATTO + (size_t)2 * MT * 1024 * 4;
constexpr size_t WS_YA = WS_MLH + (size_t)2 * MT * 1024 * 4;
constexpr size_t WS_YB = WS_YA + (size_t)MT * 1024 * 2;
constexpr size_t WS_YC = WS_YB + (size_t)MT * 1024 * 2;
constexpr size_t WS_YACC = WS_YC + (size_t)MT * 1024 * 2;
constexpr size_t WS_Y = WS_YACC + SZ_ROWS_F32;
constexpr size_t WS_W13T = WS_Y + SZ_ROWS_BF;
constexpr size_t WS_W2T = WS_W13T + (size_t)DEPTH * 2 * 8192 * 4096 * 2;
constexpr size_t WS_WINT = WS_W2T + (size_t)DEPTH * 2 * 4096 * 4096 * 2;
constexpr size_t WS_WBT = WS_WINT + (size_t)DEPTH * NZ * 4096 * 2;
constexpr size_t WS_WOT = WS_WBT + (size_t)DEPTH * 3 * 4096 * 1024 * 2;
constexpr size_t WS_CT = WS_WOT + (size_t)DEPTH * 4096 * 4096 * 2;
constexpr size_t WS_MSM = WS_CT + (size_t)8 * 66 * 32768 * 2;
constexpr size_t WS_SLAB = WS_MSM + 1 * MiB;
constexpr size_t WS_GWSB = WS_SLAB + (size_t)16 * 256 * DM * 4;
constexpr size_t WS_MS3 = WS_GWSB + (size_t)DEPTH * 8 * 128 * 128 * 2;
constexpr size_t WS_END = WS_MS3 + (size_t)3 * 256 * DM * 4;
static_assert(WS_G16 + (size_t)MT * 16 * 4 <= WS_XR, "small buffers fit below XR");
static_assert(WS_XR % 256 == 0 && WS_H % 256 == 0 && WS_Z % 256 == 0 && WS_W13T % 256 == 0, "alignment");

constexpr int CW_BAR = 4096;

constexpr int RING_OFF = 0, RING_BYTES = 131072;
constexpr int LDSCTL_OFF = 143360, MISC_OFF = LDSCTL_OFF + 320;
constexpr int LDS_BYTES = 147456;

constexpr int P_PRO0 = 0, P_PRO1 = 1, P_LAYER0 = 2;
constexpr int L_N1 = 0, L_W13A = 1, L_W2A = 2, L_N2 = 3, L_WIN = 4, L_MIX1 = 5, L_POST = 6, L_M3 = 7, L_MERGE = 8, L_WOUT = 9, L_N3 = 10, L_W13B = 11, L_W2B = 12, NPL = 13;
constexpr int P_FINAL = P_LAYER0 + DEPTH * NPL, NPH = P_FINAL + 1;

__device__ __forceinline__ float wave_sum(float v) {
#pragma unroll
    for (int o = 1; o < 64; o <<= 1) v += shfl_xor_f(v, o);
    return v;
}
__device__ __forceinline__ float bf2f(unsigned short b) { return __uint_as_float((unsigned)b << 16); }
__device__ __forceinline__ float bflo(unsigned w) { return __uint_as_float(w << 16); }
__device__ __forceinline__ float bfhi(unsigned w) { return __uint_as_float(w & 0xffff0000u); }
__device__ __forceinline__ float sigmoid_f(float x) { return 1.f / (1.f + __expf(-x)); }
__device__ __forceinline__ float silu_f(float x) { return x / (1.f + __expf(-x)); }
__device__ __forceinline__ float gelu_tanh_f(float x) { const float u = 0.7978845608028654f * (x + 0.044715f * x * x * x); return x / (1.f + __expf(-2.f * u)); }
__device__ __forceinline__ float lambda_init_f(int l) { return 0.8f - 0.6f * __expf(-0.3f * (float)l); }

namespace pg8 {
struct CtxSplitOrder {
    int c, G, n;
    const float* MS3; bf16_t* Yc; int wave_s_;
    __device__ __forceinline__ bool next(int i, Unit& u) const { const int L = i * G + c; if (L >= n) return false; u.pm = 0; u.pn = L >> 4; u.koff = (L & 15) * 256; u.boff = u.koff; u.fl = 0; return true; }
    __device__ __forceinline__ void a_ready(const Unit& u) const {
        if (MS3) {
            int t_ = MK_TID(wave_s_); asm volatile("" : "+v"(t_));
            const int r = t_ >> 1, c0 = u.koff + (t_ & 1) * 128;
            const float* p0 = MS3 + (size_t)r * DM + c0; bf16_t* yo = Yc + (size_t)r * DM + c0;
#pragma unroll 1
            for (int ib = 0; ib < 16; ib += 4) { f32x4 q[4][3][2];
#pragma unroll
                for (int i = 0; i < 4; ++i)
#pragma unroll
                    for (int sgm = 0; sgm < 3; ++sgm) { q[i][sgm][0] = *(const f32x4*)(p0 + (size_t)sgm * 256 * DM + 8 * (ib + i)); q[i][sgm][1] = *(const f32x4*)(p0 + (size_t)sgm * 256 * DM + 8 * (ib + i) + 4); }
                asm volatile("" ::: "memory");
#pragma unroll
                for (int i = 0; i < 4; ++i) { const f32x4 a0 = q[i][0][0] + q[i][1][0] + q[i][2][0], a1 = q[i][0][1] + q[i][1][1] + q[i][2][1];
                    u32x4 w; w.x = cvt_pk_bf16(a0[0], a0[1]); w.y = cvt_pk_bf16(a0[2], a0[3]); w.z = cvt_pk_bf16(a1[0], a1[1]); w.w = cvt_pk_bf16(a1[2], a1[3]); *(u32x4*)(yo + 8 * (ib + i)) = w; }
                asm volatile("" ::: "memory"); }
            asm volatile("s_waitcnt vmcnt(0)" ::: "memory");
            asm volatile("" ::: "memory"); __builtin_amdgcn_s_barrier(); asm volatile("" ::: "memory");
        }
    }
    __device__ __forceinline__ void done(const Unit&) const {}
};
struct ResidOrder {
    StaticOrder lat; int c, G, n;
    __device__ __forceinline__ bool next(int i, Unit& u) const {
        const int nl = lat.c < lat.nwg ? (lat.nwg - lat.c + lat.G - 1) / lat.G : 0;
        if (i < nl) { lat.next(i, u); u.pm += 1; return true; }
        const int L = (i - nl) * G + c; if (L >= n) return false;
        u.pm = 0; u.pn = L >> 4; u.koff = (L & 15) * 256; u.boff = u.koff; u.fl = 4 << 8; return true;
    }
    __device__ __forceinline__ void a_ready(const Unit&) const {}
    __device__ __forceinline__ void done(const Unit&) const {}
};
struct MergeOrder {
    StaticOrder lat; int c, G, nctx;
    __device__ __forceinline__ bool next(int i, Unit& u) const {
        const int nl = lat.c < lat.nwg ? (lat.nwg - lat.c + lat.G - 1) / lat.G : 0;
        if (i < 3 * nl) { lat.next(i / 3, u); u.pm += 1; const int sg = i % 3; u.fl = sg | (sg != 0 ? 4 : 0); u.koff = sg * (MT * 1024); u.boff = sg * (4096 * 1024); return true; }
        const int L = (i - 3 * nl) * G + c; if (L >= nctx) return false;
        u.pm = 0; u.pn = L / 3; const int sg = L % 3; u.fl = sg; u.koff = sg * (MT * 1024); u.boff = sg * (4096 * 1024); return true;
    }
    __device__ __forceinline__ void a_ready(const Unit&) const {}
    __device__ __forceinline__ void done(const Unit&) const {}
};
struct EpiSlab {
    static constexpr bool PERM = false, AFTER_DRAIN = false;
    float* S;
    __device__ __forceinline__ void operator()(const f32x4 (&acc)[2][2][4][2], const Unit& u, int wr, int wc, int fr, int fq) const {
        { const int l_ = mk_lane_id(); fr = l_ & 15; fq = l_ >> 4; }
        const int col0 = u.pn * BM + wc * 32 + 4 * fq; float* base = S + (size_t)(u.koff >> 8) * 256 * DM;
#pragma unroll
        for (int ai = 0; ai < 2; ++ai)
#pragma unroll
            for (int m = 0; m < 4; ++m) { float* p = base + (size_t)(ai * HALF + wr * 64 + m * 16 + fr) * DM + col0;
#pragma unroll
                for (int bj = 0; bj < 2; ++bj)
#pragma unroll
                    for (int n = 0; n < 2; ++n) *(f32x4*)(p + bj * HALF + n * 16) = acc[ai][bj][m][n]; }
    }
};
struct EpiWin {
    static constexpr bool PERM = true, AFTER_DRAIN = false;
    bf16_t* ZB; const float* rc; const float* rs;
    __device__ __forceinline__ void operator()(const f32x4 (&acc)[2][2][4][2], const Unit& u, int wr, int wc, int fr, int fq) const {
        { const int l_ = mk_lane_id(); fr = l_ & 15; fq = l_ >> 4; }
        const int pn = u.pn; int kind = 0, ld = 1024, c0 = 0;
        if (pn < 8) { kind = 1; ld = 2048; c0 = 0; } else if (pn < 10) { ld = 512; c0 = 2048; } else if (pn < 12) { ld = 512; c0 = 2560; } else if (pn < 16) { c0 = 3072; }
        else if (pn < 20) { kind = 2; c0 = 4096; } else if (pn < 24) { kind = 3; c0 = 5120; } else if (pn < 28) { kind = 3; c0 = 6144; } else if (pn < 32) { c0 = 7168; } else { kind = 2; ld = 12288; c0 = 8192; }
        if (kind == 3 && u.pm == 0) kind = 0;
        bf16_t* base = ZB + (size_t)MT * c0; const int colt = pn * BM - c0 + wc * 32 + 8 * fq; const int row0 = u.pm * BM + wr * 64 + fr;
#define EPIWIN_LOOP(...) _Pragma("unroll") for (int ai = 0; ai < 2; ++ai) _Pragma("unroll") for (int m = 0; m < 4; ++m) { const int row = row0 + ai * HALF + m * 16; _Pragma("unroll") for (int bj = 0; bj < 2; ++bj) { \
            const int col = colt + bj * HALF; float v[8]; _Pragma("unroll") for (int n = 0; n < 2; ++n) _Pragma("unroll") for (int i = 0; i < 4; ++i) v[n * 4 + i] = acc[ai][bj][m][n][i]; \
            __VA_ARGS__ \
            u32x4 w; w.x = cvt_pk_bf16(v[0], v[1]); w.y = cvt_pk_bf16(v[2], v[3]); w.z = cvt_pk_bf16(v[4], v[5]); w.w = cvt_pk_bf16(v[6], v[7]); *(u32x4*)(base + (size_t)row * ld + col) = w; } }
        if (kind == 0) { EPIWIN_LOOP(;) }
        else if (kind == 1) { EPIWIN_LOOP(_Pragma("unroll") for (int i = 0; i < 8; ++i) { const float x = v[i], uu = 0.7978845608028654f * (x + 0.044715f * x * x * x); v[i] = x * __builtin_amdgcn_rcpf(1.f + __expf(-2.f * uu)); }) }
        else if (kind == 2) { EPIWIN_LOOP(_Pragma("unroll") for (int i = 0; i < 8; ++i) v[i] = fminf(__builtin_amdgcn_rcpf(1.f + __expf(-v[i])), 1.f);) }
        else {
#pragma unroll
            for (int ai = 0; ai < 2; ++ai) { f32x4 c4[4][2], s4[4][2];
#pragma unroll
                for (int m = 0; m < 4; ++m)
#pragma unroll
                    for (int bj = 0; bj < 2; ++bj) { const int t = row0 + ai * HALF + m * 16 - CTXL, j0 = ((colt + bj * HALF) & 127) >> 1; c4[m][bj] = *(const f32x4*)(rc + t * 64 + j0); s4[m][bj] = *(const f32x4*)(rs + t * 64 + j0); }
                asm volatile("" ::: "memory");
#pragma unroll
                for (int m = 0; m < 4; ++m)
#pragma unroll
                    for (int bj = 0; bj < 2; ++bj) { const int row = row0 + ai * HALF + m * 16, col = colt + bj * HALF; float v[8];
#pragma unroll
                        for (int n = 0; n < 2; ++n)
#pragma unroll
                            for (int i = 0; i < 4; ++i) v[n * 4 + i] = acc[ai][bj][m][n][i];
#pragma unroll
                        for (int i = 0; i < 4; ++i) { const float x1 = v[2 * i], x2 = v[2 * i + 1]; v[2 * i] = x1 * c4[m][bj][i] - x2 * s4[m][bj][i]; v[2 * i + 1] = x1 * s4[m][bj][i] + x2 * c4[m][bj][i]; }
                        u32x4 w; w.x = cvt_pk_bf16(v[0], v[1]); w.y = cvt_pk_bf16(v[2], v[3]); w.z = cvt_pk_bf16(v[4], v[5]); w.w = cvt_pk_bf16(v[6], v[7]); *(u32x4*)(base + (size_t)row * ld + col) = w; }
                asm volatile("" ::: "memory"); } }
#undef EPIWIN_LOOP
    }
};
struct EpiSwiglu {
    static constexpr bool PERM = true, AFTER_DRAIN = false;
    bf16_t* O; int ldc;
    __device__ __forceinline__ void operator()(const f32x4 (&acc)[2][2][4][2], const Unit& u, int wr, int wc, int fr, int fq) const {
        { const int l_ = mk_lane_id(); fr = l_ & 15; fq = l_ >> 4; }
        const int row0 = u.pm * BM + wr * 64 + fr, col0 = u.pn * HALF + wc * 32 + 8 * fq;
#pragma unroll
        for (int ai = 0; ai < 2; ++ai)
#pragma unroll
            for (int m = 0; m < 4; ++m) {
                bf16_t* rowp = O + (size_t)(row0 + ai * HALF + m * 16) * ldc + col0;
                float v[8];
#pragma unroll
                for (int n = 0; n < 2; ++n)
#pragma unroll
                    for (int i = 0; i < 4; ++i) { const float a = acc[ai][0][m][n][i], b = acc[ai][1][m][n][i]; v[n * 4 + i] = a * __builtin_amdgcn_rcpf(1.f + __expf(-a)) * b; }
                u32x4 w; w.x = cvt_pk_bf16(v[0], v[1]); w.y = cvt_pk_bf16(v[2], v[3]); w.z = cvt_pk_bf16(v[4], v[5]); w.w = cvt_pk_bf16(v[6], v[7]);
                *(u32x4*)rowp = w;
            }
    }
};
struct EpiResid {
    static constexpr bool PERM = false, AFTER_DRAIN = false;
    float* X; const float* gate_lat; const float* gate_ctx; const float* XB; float f;
    __device__ __forceinline__ void operator()(const f32x4 (&acc)[2][2][4][2], const Unit& u, int wr, int wc, int fr, int fq) const {
        { const int l_ = mk_lane_id(); fr = l_ & 15; fq = l_ >> 4; }
        const int col0 = u.pn * BM + wc * 32 + 4 * fq;
        const float* gate = (u.pm == 0) ? gate_ctx : gate_lat;
        f32x4 gv[2][2];
#pragma unroll
        for (int bj = 0; bj < 2; ++bj)
#pragma unroll
            for (int n = 0; n < 2; ++n) gv[bj][n] = *(const f32x4*)(gate + col0 + bj * HALF + n * 16);
        asm volatile("" ::: "memory");
#pragma unroll
        for (int bj = 0; bj < 2; ++bj)
#pragma unroll
            for (int n = 0; n < 2; ++n) gv[bj][n] = gv[bj][n] * f;
        const size_t ob = (size_t)(u.pm * BM + wr * 64 + fr) * DM + col0;
#define ER_OFF(q) (ob + (size_t)(((q) >> 1) * HALF + ((q) & 1) * 32) * DM)
#define ER_LOAD(xq, q) do { const float* r0 = XB + ER_OFF(q); _Pragma("unroll") for (int m = 0; m < 2; ++m) _Pragma("unroll") for (int bj = 0; bj < 2; ++bj) _Pragma("unroll") for (int n = 0; n < 2; ++n) \
            xq[m][bj][n] = *(const f32x4*)(r0 + (size_t)(m * 16) * DM + bj * HALF + n * 16); asm volatile("" ::: "memory"); } while (0)
#define ER_STORE(xq, q) do { float* p0 = X + ER_OFF(q); _Pragma("unroll") for (int m = 0; m < 2; ++m) _Pragma("unroll") for (int bj = 0; bj < 2; ++bj) _Pragma("unroll") for (int n = 0; n < 2; ++n) \
            *(f32x4*)(p0 + (size_t)(m * 16) * DM + bj * HALF + n * 16) = xq[m][bj][n] + gv[bj][n] * acc[(q) >> 1][bj][((q) & 1) * 2 + m][n]; asm volatile("" ::: "memory"); } while (0)
        f32x4 xa[2][2][2], xb[2][2][2];
        ER_LOAD(xa, 0); ER_LOAD(xb, 1);
        ER_STORE(xa, 0); ER_LOAD(xa, 2);
        ER_STORE(xb, 1); ER_LOAD(xb, 3);
        ER_STORE(xa, 2); ER_STORE(xb, 3);
#undef ER_OFF
#undef ER_LOAD
#undef ER_STORE
    }
};
struct EpiResidSlab {
    static constexpr bool PERM = false, AFTER_DRAIN = false;
    unsigned char* wsb; const float* gate_lat; const float* XB; float f;
    __device__ __forceinline__ void operator()(const f32x4 (&acc)[2][2][4][2], const Unit& u, int wr, int wc, int fr, int fq) const {
        if (u.pm == 0) { EpiSlab E{(float*)(wsb + WS_SLAB)}; E(acc, u, wr, wc, fr, fq); }
        else { EpiResid E{(float*)(wsb + WS_XR), gate_lat, gate_lat, XB, f}; E(acc, u, wr, wc, fr, fq); }
    }
};
struct EpiMergeSeg {
    static constexpr bool PERM = true, AFTER_DRAIN = false;
    const bf16_t* Zg; bf16_t* Y; float* MS3;
    __device__ __forceinline__ void operator()(f32x4 (&acc)[2][2][4][2], const Unit& u, int wr, int wc, int fr, int fq) const {
        { const int l_ = mk_lane_id(); fr = l_ & 15; fq = l_ >> 4; }
        const int seg = u.seg(); const bool ctxp = (u.pm == 0);
        const int col0 = u.pn * BM + wc * 32 + 8 * fq;
#pragma unroll
        for (int ai = 0; ai < 2; ++ai) {
            u32x4 ga[4][2], gb[4][2];
#pragma unroll
            for (int m = 0; m < 4; ++m)
#pragma unroll
                for (int bj = 0; bj < 2; ++bj) { const bf16_t* gp = Zg + (size_t)MT * ZC_MG + (size_t)(u.pm * BM + ai * HALF + wr * 64 + m * 16 + fr) * 12288 + seg * 4096 + col0 + bj * HALF;
                    ga[m][bj] = *(const u32x4*)gp; if (!ctxp && seg < 2) gb[m][bj] = *(const u32x4*)(gp + 4096); }
            asm volatile("" ::: "memory");
#pragma unroll
            for (int m = 0; m < 4; ++m)
#pragma unroll
                for (int bj = 0; bj < 2; ++bj) { const size_t row = (size_t)(u.pm * BM + ai * HALF + wr * 64 + m * 16 + fr); const int col = col0 + bj * HALF;
                    const unsigned aw[4] = {ga[m][bj].x, ga[m][bj].y, ga[m][bj].z, ga[m][bj].w};
                    float g[8];
#pragma unroll
                    for (int k = 0; k < 4; ++k) { g[2 * k] = fmaxf(__uint_as_float(aw[k] << 16), 1e-20f); g[2 * k + 1] = fmaxf(__uint_as_float(aw[k] & 0xffff0000u), 1e-20f); }
                    if (!ctxp && seg < 2) { const unsigned bw[4] = {gb[m][bj].x, gb[m][bj].y, gb[m][bj].z, gb[m][bj].w};
#pragma unroll
                        for (int k = 0; k < 4; ++k) { g[2 * k] = g[2 * k] * __builtin_amdgcn_rcpf(fmaxf(__uint_as_float(bw[k] << 16), 1e-20f)); g[2 * k + 1] = g[2 * k + 1] * __builtin_amdgcn_rcpf(fmaxf(__uint_as_float(bw[k] & 0xffff0000u), 1e-20f)); } }
                    float v[8];
#pragma unroll
                    for (int n = 0; n < 2; ++n)
#pragma unroll
                        for (int i = 0; i < 4; ++i) v[n * 4 + i] = acc[ai][bj][m][n][i] * g[n * 4 + i];
                    if (ctxp) { float* ms = MS3 + ((size_t)seg * 256 + row) * DM + col; *(f32x4*)ms = (f32x4){v[0], v[1], v[2], v[3]}; *(f32x4*)(ms + 4) = (f32x4){v[4], v[5], v[6], v[7]}; }
                    else if (seg < 2) { acc[ai][bj][m][0] = (f32x4){v[0], v[1], v[2], v[3]}; acc[ai][bj][m][1] = (f32x4){v[4], v[5], v[6], v[7]}; }
                    else { u32x4 w; w.x = cvt_pk_bf16(v[0], v[1]); w.y = cvt_pk_bf16(v[2], v[3]); w.z = cvt_pk_bf16(v[4], v[5]); w.w = cvt_pk_bf16(v[6], v[7]); *(u32x4*)(Y + row * DM + col) = w; } }
            asm volatile("" ::: "memory");
        }
    }
};
}

constexpr int TSTR = 68, TSCR_BYTES = 64 * TSTR * 4;
__device__ __forceinline__ void transpose_item(const float* __restrict__ W, size_t ldw, int K, int k0, int srccol0, bf16* WT, int dstrow0, LAS float* scr, int lane) {
    const int r4 = lane >> 4, c16 = lane & 15;
    f32x4 v[16];
#pragma unroll
    for (int i = 0; i < 16; ++i) v[i] = __builtin_nontemporal_load((const f32x4*)(W + (size_t)(k0 + 4 * i + r4) * ldw + srccol0 + 4 * c16));
#pragma unroll
    for (int i = 0; i < 16; ++i) *(LAS f32x4*)(scr + (4 * i + r4) * TSTR + 4 * c16) = v[i];
    LDS_WAIT(); asm volatile("" ::: "memory");
    const int c = lane & 7;
#pragma unroll
    for (int j = 0; j < 8; ++j) { const int n = (lane >> 3) + 8 * j; const LAS float* sp = scr + (8 * c) * TSTR + n;
        v4u o; o.x = pk2(sp[0 * TSTR], sp[1 * TSTR]); o.y = pk2(sp[2 * TSTR], sp[3 * TSTR]); o.z = pk2(sp[4 * TSTR], sp[5 * TSTR]); o.w = pk2(sp[6 * TSTR], sp[7 * TSTR]);
        __builtin_nontemporal_store(o, (GAS v4u*)(WT + (size_t)(dstrow0 + n) * K + k0 + 8 * c)); }
    LDS_WAIT(); asm volatile("" ::: "memory");
}

struct Ptrs {
    const float *x, *c, *ctx, *c_ctx, *ada_down, *ada_up, *ada_bias, *norm_g, *w13, *w2, *w_in, *gmlp_norm_g, *gmlp_ws, *gmlp_bs, *gate_b, *mlstm_norm_g, *diff_lambda, *diff_norm_g, *w_branch, *w_out, *final_g;
    float* out; unsigned char* ws;
};

constexpr int IT_W13 = 2 * 64 * 128, IT_W2 = 2 * 64 * 64, IT_WIN = 64 * 320, IT_WB = 3 * 16 * 64, IT_WO = 64 * 64, IT_LAYER = IT_W13 + IT_W2 + IT_WIN + IT_WB + IT_WO;

constexpr int NE = 8192 + 4096 + IT_WIN, NL = IT_WB + IT_WO + 8192 + 4096;
static_assert(NE + NL == IT_LAYER, "lists cover the layer");
__device__ __forceinline__ void convert_range(const Ptrs& P, int l, int list, int it_lo, int it_hi, int widx, int nw, LAS float* scr, int lane) {
    unsigned char* ws = P.ws;
    for (int it = it_lo + widx; it < it_hi; it += nw) {
        int r;
        if (list == 0) r = it < 8192 ? it : it < 12288 ? IT_W13 + (it - 8192) : IT_W13 + IT_W2 + (it - 12288);
        else r = it < IT_WB ? IT_W13 + IT_W2 + IT_WIN + it : it < IT_WB + IT_WO ? IT_W13 + IT_W2 + IT_WIN + it : it < IT_WB + IT_WO + 8192 ? 8192 + (it - IT_WB - IT_WO) : IT_W13 + 4096 + (it - IT_WB - IT_WO - 8192);
        if (r < IT_W13) { const int s = r / (64 * 128), q = r % (64 * 128), kb = q / 128, nb = q % 128, dr = nb * 64, tile = dr >> 8, within = dr & 255;
            const int src = within < 128 ? tile * 128 + within : 4096 + tile * 128 + (within - 128);
            transpose_item(P.w13 + (size_t)(l * 2 + s) * 4096 * 8192, 8192, 4096, kb * 64, src, (bf16*)(ws + WS_W13T) + (size_t)(l * 2 + s) * 8192 * 4096, dr, scr, lane); continue; }
        r -= IT_W13;
        if (r < IT_W2) { const int s = r / (64 * 64), q = r % (64 * 64), kb = q / 64, nb = q % 64;
            transpose_item(P.w2 + (size_t)(l * 2 + s) * 4096 * 4096, 4096, 4096, kb * 64, nb * 64, (bf16*)(ws + WS_W2T) + (size_t)(l * 2 + s) * 4096 * 4096, nb * 64, scr, lane); continue; }
        r -= IT_W2;
        if (r < IT_WIN) { const int kb = r / 320, nb = r % 320, dr = nb * 64, src = dr < 5120 ? dr : dr + 16;
            transpose_item(P.w_in + (size_t)l * 4096 * INC, INC, 4096, kb * 64, src, (bf16*)(ws + WS_WINT) + (size_t)l * NZ * 4096, dr, scr, lane); continue; }
        r -= IT_WIN;
        if (r < IT_WB) { const int i = r / (16 * 64), q = r % (16 * 64), kb = q / 64, nb = q % 64;
            transpose_item(P.w_branch + (size_t)(l * 3 + i) * 1024 * 4096, 4096, 1024, kb * 64, nb * 64, (bf16*)(ws + WS_WBT) + (size_t)(l * 3 + i) * 4096 * 1024, nb * 64, scr, lane); continue; }
        r -= IT_WB;
        { const int kb = r / 64, nb = r % 64;
            transpose_item(P.w_out + (size_t)l * 4096 * 4096, 4096, 4096, kb * 64, nb * 64, (bf16*)(ws + WS_WOT) + (size_t)l * 4096 * 4096, nb * 64, scr, lane); }
    }
}
#ifndef CVP_D
#define CVP_D 9
#endif
#ifndef CVP_T
#define CVP_T 8
#endif
constexpr int CVD = IT_LAYER * CVP_D / 100, CVS = CVD + IT_LAYER * CVP_T / 100;
static_assert(CVS < NL && CVS < NE, "slot sizes");
__device__ __forceinline__ void convert_part(const Ptrs& P, int lnext, int list, int it_lo, int it_hi, int idx, int n, LAS unsigned char* lds, int tid) {
    asm volatile("" : "+v"(tid));
    if (lnext >= DEPTH || idx < 0 || idx >= n) return;
    const int wave = tid >> 6, lane = tid & 63;
    convert_range(P, lnext, list, it_lo, it_hi, idx * NWAVES + wave, n * NWAVES, (LAS float*)(lds + RING_OFF + wave * TSCR_BYTES), lane);
}
__device__ __forceinline__ void convert_idle(const Ptrs& P, int lnext, int list, int it_lo, int it_hi, int first_idle, int gend, LAS unsigned char* lds, int bid, int tid) {
    if (gend < first_idle + 16) first_idle = 0;
    if (bid >= gend) return;
    convert_part(P, lnext, list, it_lo, it_hi, bid - first_idle, gend - first_idle, lds, tid);
}
__device__ __forceinline__ void pro0(const Ptrs& P, LAS unsigned char* lds, int bid, int G, int tid) {
    asm volatile("" : "+v"(tid));
    const int wave = tid >> 6, lane = tid & 63;
    LAS float* scr = (LAS float*)(lds + RING_OFF + wave * TSCR_BYTES);
    const int gw = bid * NWAVES + wave, NGW = G * NWAVES;
    unsigned char* ws = P.ws;
    convert_range(P, 0, 0, 0, NE, gw, NGW, scr, lane);
    for (int l = 1; l < DEPTH; ++l) convert_range(P, l, 0, CVS, NE, gw, NGW, scr, lane);
    const int gt = bid * NTHR + tid, NGT = G * NTHR;
    { float* rc = (float*)(ws + WS_ROPE); float* rs = rc + SEQ * 64;
      for (int i = gt; i < SEQ * 64; i += NGT) { const int t = i >> 6, j = i & 63; const float inv = powf(10000.f, -(float)(j & 31) / 32.f);
          const float pos = (float)(j < 32 ? (t >> 6) : (t & 63)); const float ang = pos * inv; rc[i] = cosf(ang); rs[i] = sinf(ang); } }
    { float* tp = (float*)(ws + WS_MODTP);
      for (int task = gw; task < DEPTH * 2 * 4 * 64; task += NGW) { const int dc = task & 63, rg = (task >> 6) & 3, w = (task >> 8) & 1, l = task >> 9;
          const float* cv = w ? P.c_ctx : P.c; const float* dn = P.ada_down + (size_t)l * DM * ADAR + (size_t)(dc * 64) * ADAR + rg * 64 + lane;
          float wv[64]; const float cmine = cv[dc * 64 + lane], smine = cmine / (1.f + expf(-cmine));
#pragma unroll
          for (int d = 0; d < 64; ++d) wv[d] = dn[(size_t)d * ADAR];
          asm volatile("" ::: "memory");
          float acc = 0.f;
#pragma unroll
          for (int d = 0; d < 64; ++d) acc += __int_as_float(__builtin_amdgcn_readlane(__float_as_int(smine), d)) * wv[d];
          tp[((l * 2 + w) * 64 + dc) * 256 + rg * 64 + lane] = acc; } }
    if (bid == 0 && tid < DEPTH) { const float* dl = P.diff_lambda + tid * 4 * 128; float s1 = 0.f, s2 = 0.f;
        for (int i = 0; i < 128; ++i) { s1 += dl[i] * dl[128 + i]; s2 += dl[256 + i] * dl[384 + i]; }
        ((float*)(ws + WS_LAM))[tid] = expf(s1) - expf(s2) + lambda_init_f(tid); }
    { bf16* wb = (bf16*)(ws + WS_GWSB); for (int i = gt; i < DEPTH * 8 * 128 * 128; i += NGT) wb[i] = (bf16)f2bf(P.gmlp_ws[i]); }
    { bf16* wg = (bf16*)(ws + WS_WG16);
      for (int i = gt; i < DEPTH * DM * 16; i += NGT) { const int j = i & 15, d = (i >> 4) & (DM - 1), l = i >> 16;
          wg[((size_t)l * 16 + j) * DM + d] = (bf16)f2bf(P.w_in[((size_t)l * DM + d) * INC + 5120 + j]); } }
}

__device__ __forceinline__ void pro1(const Ptrs& P, LAS unsigned char* lds, int bid, int G, int tid) {
    asm volatile("" : "+v"(tid));
    LAS float* T = (LAS float*)(lds + RING_OFF);
    const float* tp = (const float*)(P.ws + WS_MODTP);
    for (int i = tid; i < DEPTH * 2 * 256; i += NTHR) { const int r = i & 255, lw = i >> 8; float s = 0.f;
        for (int dc = 0; dc < 64; ++dc) s += tp[(lw * 64 + dc) * 256 + r];
        T[i] = s; }
    __syncthreads();
    float* MOD = (float*)(P.ws + WS_MOD);
    for (int i = bid * NTHR + tid; i < DEPTH * NMOD; i += G * NTHR) { const int l = i / NMOD, n = i % NMOD;
        const float* up = P.ada_up + (size_t)l * ADAR * NMOD + n; const float b = P.ada_bias[(size_t)l * NMOD + n]; float a0 = b, a1 = b;
#pragma unroll 1
        for (int r0 = 0; r0 < ADAR; r0 += 32) { float uu[32];
#pragma unroll
            for (int k = 0; k < 32; ++k) uu[k] = up[(size_t)(r0 + k) * NMOD];
            asm volatile("" ::: "memory");
#pragma unroll
            for (int k = 0; k < 32; ++k) { a0 += T[(l * 2 + 0) * 256 + r0 + k] * uu[k]; a1 += T[(l * 2 + 1) * 256 + r0 + k] * uu[k]; } }
        MOD[(size_t)(l * 2 + 0) * NMOD + n] = a0; MOD[(size_t)(l * 2 + 1) * NMOD + n] = a1; }
    __syncthreads();
}

__device__ __forceinline__ void phase_norm(float* XR, const float* rdl, const float* rdc, const float* prec, const float* g, const float* modl, const float* modc, bf16* H, const float* slab, const float* cgate, float cf, LAS unsigned char* lds, int bid, int G, int tid) {
    asm volatile("" : "+v"(tid));
    const int wave = tid >> 6, lane = tid & 63;
    LAS f32x4* AL = (LAS f32x4*)lds; LAS f32x4* SL = AL + 1024; LAS f32x4* AC = AL + 2048; LAS f32x4* SC = AL + 3072;
    { f32x4 q[2][5];
#pragma unroll
      for (int k = 0; k < 2; ++k) { const int i = tid + k * NTHR; q[k][0] = ((const f32x4*)g)[i]; q[k][1] = ((const f32x4*)(modl + DM))[i]; q[k][2] = ((const f32x4*)modl)[i]; q[k][3] = ((const f32x4*)(modc + DM))[i]; q[k][4] = ((const f32x4*)modc)[i]; }
      asm volatile("" ::: "memory");
#pragma unroll
      for (int k = 0; k < 2; ++k) { const int i = tid + k * NTHR; AL[i] = q[k][0] * (q[k][1] + 1.f); SL[i] = q[k][2]; AC[i] = q[k][0] * (q[k][3] + 1.f); SC[i] = q[k][4]; } }
    const int row0 = bid * NWAVES + wave, stride = G * NWAVES;
    if (slab && row0 < CTXL) {
        f32x4* xw = (f32x4*)(XR + (size_t)row0 * DM) + lane; const f32x4* xpre = (const f32x4*)(prec + (size_t)row0 * DM) + lane; const f32x4* sp = (const f32x4*)(slab + (size_t)row0 * DM) + lane; const f32x4* gp = (const f32x4*)cgate + lane;
#pragma unroll 1
        for (int j = 0; j < 16; j += 2) { f32x4 q[2][16], xo[2];
#pragma unroll
            for (int jj = 0; jj < 2; ++jj) { xo[jj] = xpre[64 * (j + jj)];
#pragma unroll
                for (int kc = 0; kc < 16; ++kc) q[jj][kc] = sp[(size_t)kc * 256 * (DM / 4) + 64 * (j + jj)]; }
            asm volatile("" ::: "memory");
#pragma unroll
            for (int jj = 0; jj < 2; ++jj) { f32x4 a = (f32x4){0.f, 0.f, 0.f, 0.f};
#pragma unroll
                for (int kc = 0; kc < 16; ++kc) a += q[jj][kc];
                xw[64 * (j + jj)] = xo[jj] + a * gp[64 * (j + jj)] * cf; }
            asm volatile("" ::: "memory"); }
        asm volatile("s_waitcnt vmcnt(0)" ::: "memory");
    }
    __syncthreads();
    f32x4 v[16];
    if (row0 < MT) { const f32x4* xr = (const f32x4*)((row0 < CTXL ? rdc : rdl) + (size_t)row0 * DM) + lane;
#pragma unroll
        for (int j = 0; j < 16; ++j) v[j] = xr[64 * j]; }
    for (int row = row0; row < MT; row += stride) {
        f32x4 vn[16];
        if (row + stride < MT) { const f32x4* xr = (const f32x4*)(rdl + (size_t)(row + stride) * DM) + lane;
#pragma unroll
            for (int j = 0; j < 16; ++j) vn[j] = xr[64 * j]; }
        float ss = 0.f;
#pragma unroll
        for (int j = 0; j < 16; ++j) ss += (v[j].x * v[j].x + v[j].y * v[j].y) + (v[j].z * v[j].z + v[j].w * v[j].w);
        const float rstd = 1.f / sqrtf(wave_sum(ss) * (1.f / DM) + EPS);
        const LAS f32x4* Ap = row < CTXL ? AC : AL; const LAS f32x4* Sp = row < CTXL ? SC : SL;
        uint2* hr = (uint2*)(H + (size_t)row * DM) + lane;
#pragma unroll
        for (int j = 0; j < 16; ++j) { const f32x4 hv = v[j] * rstd * Ap[lane + 64 * j] + Sp[lane + 64 * j];
            uint2 o; o.x = pk2(hv.x, hv.y); o.y = pk2(hv.z, hv.w); hr[64 * j] = o; }
#pragma unroll
        for (int j = 0; j < 16; ++j) v[j] = vn[j];
    }
    __syncthreads();
}
typedef float f32x4g __attribute__((ext_vector_type(4)));
__device__ __forceinline__ void gates_unit(const bf16* H, const bf16* WGb, float* G16, int jb, int tid) {
    asm volatile("" : "+v"(tid));
    const int wave = tid >> 6, lane = tid & 63, fr = lane & 15, fq = lane >> 4;
    const bf16* ap = H + (size_t)(jb * 128 + wave * 16 + fr) * DM + 8 * fq; const bf16* bp = WGb + (size_t)fr * DM + 8 * fq;
    f32x4g acc[4];
#pragma unroll
    for (int i = 0; i < 4; ++i) acc[i] = (f32x4g){0.f, 0.f, 0.f, 0.f};
#pragma unroll 1
    for (int k = 0; k < DM; k += 512) { bf16x8 af[16], bfv[16];
#pragma unroll
        for (int i = 0; i < 16; ++i) { af[i] = *(const bf16x8*)(ap + k + 32 * i); bfv[i] = *(const bf16x8*)(bp + k + 32 * i); }
        asm volatile("" ::: "memory"); __builtin_amdgcn_sched_barrier(0);
#pragma unroll
        for (int i = 0; i < 16; ++i) acc[i & 3] = __builtin_amdgcn_mfma_f32_16x16x32_bf16(af[i], bfv[i], acc[i & 3], 0, 0, 0);
    }
    const f32x4g sres = (acc[0] + acc[1]) + (acc[2] + acc[3]);
#pragma unroll
    for (int r = 0; r < 4; ++r) G16[(size_t)(jb * 128 + wave * 16 + 4 * fq + r) * 16 + fr] = sres[r];
}

__device__ __forceinline__ void phase_final(const float* XR, const float* g, float* out, int bid, int G, int tid) {
    asm volatile("" : "+v"(tid));
    const int wave = tid >> 6, lane = tid & 63;
    f32x4 gg[16];
#pragma unroll
    for (int j = 0; j < 16; ++j) gg[j] = *(const f32x4*)(g + 4 * lane + 256 * j);
    for (int t = bid * NWAVES + wave; t < SEQ; t += G * NWAVES) {
        const f32x4* xr = (const f32x4*)(XR + (size_t)(CTXL + t) * DM) + lane;
        f32x4 v[16]; float ss = 0.f;
#pragma unroll
        for (int j = 0; j < 16; ++j) { v[j] = xr[64 * j]; ss += (v[j].x * v[j].x + v[j].y * v[j].y) + (v[j].z * v[j].z + v[j].w * v[j].w); }
        const float rstd = 1.f / sqrtf(wave_sum(ss) * (1.f / DM) + EPS);
        f32x4* o = (f32x4*)(out + (size_t)t * DM) + lane;
#pragma unroll
        for (int j = 0; j < 16; ++j) o[64 * j] = v[j] * rstd * gg[j];
    }
}

typedef short s16x4 __attribute__((ext_vector_type(4)));
typedef float f32x16 __attribute__((ext_vector_type(16)));
typedef short v4i16_t __attribute__((ext_vector_type(4)));
__device__ __forceinline__ int crow16(int r, int hi) { return (r & 3) + 8 * (r >> 2) + 4 * hi; }
__device__ __forceinline__ int chain_cidx(int dir, int jb) { return dir ? (jb < 2 ? 1 - jb : 67 - jb) : jb; }
__device__ __forceinline__ s16x4 trr(LAS const unsigned char* p) { return __builtin_bit_cast(s16x4, __builtin_amdgcn_ds_read_tr16_b64_v4i16((LAS v4i16_t*)p)); }
__device__ __forceinline__ bf16x8 trfrag(LAS const unsigned char* im, int RS, int rowA, int rowB, int n0, int lane) {
    const int i = lane & 15, q = i >> 2, p = i & 3, cb = n0 + 16 * ((lane >> 4) & 1) + 4 * p;
    const s16x4 lo = trr(im + (rowA + q) * RS + cb * 2), hi = trr(im + (rowB + q) * RS + cb * 2);
    return (bf16x8){lo[0], lo[1], lo[2], lo[3], hi[0], hi[1], hi[2], hi[3]};
}
constexpr int VSTR = 528, KW_OFF = 67584;
constexpr int SM_OFF = 133120;
__device__ __forceinline__ void gate_scan(const float* G16, const float* gate_b, int jb, int h, LAS float* SM, int tid) {
    LAS float* SC = SM + 768;
    const int dir = (tid >> 7) & 1, c = tid & 127, o = dir ? 127 - c : c; const bool act = tid < 256;
    float ip = 0.f, x = 0.f;
    if (act) { const size_t row = (size_t)jb * 128 + o; ip = G16[row * 16 + dir * 8 + h] + gate_b[dir * 8 + h]; const float fp = G16[row * 16 + dir * 8 + 4 + h] + gate_b[dir * 8 + 4 + h];
        x = fminf(fp, 0.f) - __logf(1.f + __expf(-fabsf(fp))); }
    for (int s = 1; s < 128; s <<= 1) { if (act) SC[dir * 128 + c] = x; __syncthreads(); if (act && c >= s) x += SC[dir * 128 + c - s]; __syncthreads(); }
    const float b = x, u = ip - b; float y = u;
    for (int s = 1; s < 128; s <<= 1) { if (act) SC[dir * 128 + c] = y; __syncthreads(); if (act && c >= s) y = fmaxf(y, SC[dir * 128 + c - s]); __syncthreads(); }
    if (act) { SM[dir * 128 + o] = u; SM[256 + dir * 128 + o] = y; SM[512 + dir * 128 + o] = b; if (c == 127) { SM[1024 + dir] = b; SM[1026 + dir] = y; } }
    __syncthreads();
}
__device__ __forceinline__ void stage_v(const bf16* Z, size_t row0, int h, LAS unsigned char* VL, int tid) {
    v4u t[8];
#pragma unroll
    for (int k = 0; k < 8; ++k) { const int i = tid + k * NTHR, sr = i >> 5, ch = i & 31; t[k] = *(const v4u*)(Z + (size_t)MT * ZC_MV + (row0 + sr) * 1024 + h * 256 + ch * 8); }
    asm volatile("" ::: "memory");
#pragma unroll
    for (int k = 0; k < 8; ++k) { const int i = tid + k * NTHR, sr = i >> 5, ch = i & 31; *(LAS v4u*)(VL + sr * VSTR + ch * 16) = t[k]; }
}
__device__ __forceinline__ void mlstm_m1_unit(const bf16* Z, const float* G16, const float* gate_b, float* DCT, float* DN, float* CH, int jb, int h, LAS unsigned char* lds, int tid) {
    asm volatile("" : "+v"(tid));
    const int wave = tid >> 6, lane = tid & 63, hh = lane >> 5;
    LAS unsigned char* VL = lds; LAS unsigned char* KW = lds + KW_OFF; LAS float* SM = (LAS float*)(lds + SM_OFF);
    gate_scan(G16, gate_b, jb, h, SM, tid);
    const size_t row0 = (size_t)jb * 128;
    stage_v(Z, row0, h, VL, tid);
    { v4u kq[4];
#pragma unroll
      for (int k = 0; k < 4; ++k) { const int i = tid + k * NTHR, sr = i >> 4, ch = i & 15; kq[k] = *(const v4u*)(Z + (size_t)MT * ZC_MK + (row0 + sr) * 512 + h * 128 + ch * 8); }
      asm volatile("" ::: "memory");
#pragma unroll
      for (int k = 0; k < 4; ++k) { const int i = tid + k * NTHR, sr = i >> 4, ch = i & 15; const v4u kw = kq[k];
#pragma unroll
        for (int dir = 0; dir < 2; ++dir) { const float wg = __expf(SM[dir * 128 + sr] - SM[1026 + dir]); v4u o;
            o.x = pk2(bflo(kw.x) * wg, bfhi(kw.x) * wg); o.y = pk2(bflo(kw.y) * wg, bfhi(kw.y) * wg); o.z = pk2(bflo(kw.z) * wg, bfhi(kw.z) * wg); o.w = pk2(bflo(kw.w) * wg, bfhi(kw.w) * wg);
            *(LAS v4u*)(KW + dir * 32768 + sr * 256 + ch * 16) = o; } } }
    __syncthreads();
    const int dir = wave >> 2, ebp = wave & 3;
    f32x16 acc[2][4];
#pragma unroll
    for (int a = 0; a < 2; ++a)
#pragma unroll
        for (int b = 0; b < 4; ++b)
#pragma unroll
            for (int r = 0; r < 16; ++r) acc[a][b][r] = 0.f;
#pragma unroll 2
    for (int ks = 0; ks < 8; ++ks) {
        bf16x8 af[2], bfr[4];
#pragma unroll
        for (int eb = 0; eb < 2; ++eb) af[eb] = trfrag(VL, VSTR, 16 * ks + 8 * hh, 16 * ks + 8 * hh + 4, 32 * (2 * ebp + eb), lane);
#pragma unroll
        for (int db = 0; db < 4; ++db) bfr[db] = trfrag(KW + dir * 32768, 256, 16 * ks + 8 * hh, 16 * ks + 8 * hh + 4, 32 * db, lane);
#pragma unroll
        for (int eb = 0; eb < 2; ++eb)
#pragma unroll
            for (int db = 0; db < 4; ++db) acc[eb][db] = __builtin_amdgcn_mfma_f32_32x32x16_bf16(af[eb], bfr[db], acc[eb][db], 0, 0, 0);
    }
    { const int cidx = chain_cidx(dir, jb); float* dst = DCT + (size_t)((dir * 4 + h) * 66 + cidx) * 32768;
#pragma unroll
      for (int eb = 0; eb < 2; ++eb)
#pragma unroll
          for (int db = 0; db < 4; ++db)
#pragma unroll
              for (int r = 0; r < 16; ++r) dst[(32 * (2 * ebp + eb) + crow16(r, hh)) * 128 + 32 * db + (lane & 31)] = acc[eb][db][r]; }
    if (tid < 256) { const int dd = tid >> 7, d = tid & 127; float s = 0.f;
#pragma unroll 1
        for (int sg0 = 0; sg0 < 128; sg0 += 32) { unsigned short kq[32];
#pragma unroll
            for (int k = 0; k < 32; ++k) kq[k] = *(LAS const unsigned short*)(KW + dd * 32768 + (sg0 + k) * 256 + d * 2);
            asm volatile("" ::: "memory");
#pragma unroll
            for (int k = 0; k < 32; ++k) s += bf2f(kq[k]); }
        DN[(size_t)((dd * 4 + h) * 66 + chain_cidx(dd, jb)) * 128 + d] = s; }
    if (tid < 2) { float* c = CH + (size_t)((tid * 4 + h) * 66 + chain_cidx(tid, jb)) * 2; c[0] = SM[1024 + tid]; c[1] = SM[1026 + tid]; }
    __syncthreads();
}
__device__ __forceinline__ void mlstm_m2_scalars(const float* CH, int chain, LAS float* SC, int tid) {
    if (tid < 66) { SC[256 + 2 * tid] = CH[(size_t)(chain * 66 + tid) * 2]; SC[256 + 2 * tid + 1] = CH[(size_t)(chain * 66 + tid) * 2 + 1]; }
    __syncthreads();
    if (tid == 0) { float m = 0.f;
        for (int j = 0; j < 66; ++j) { const float Bj = SC[256 + 2 * j], cm = SC[256 + 2 * j + 1], Mx = fmaxf(m, cm); SC[3 * j] = __expf(m - Mx); SC[3 * j + 1] = __expf(cm - Mx); SC[3 * j + 2] = m; m = Bj + Mx; } }
    __syncthreads();
}
__device__ __forceinline__ void mlstm_m2(const float* DCT, const float* DN, const float* CH, bf16* CT, float* NS, float* MS, LAS unsigned char* lds, int bid, int G, int tid) {
    asm volatile("" : "+v"(tid));
    LAS float* SC = (LAS float*)lds;
    for (int base = bid * NTHR; base < 8 * 16384; base += G * NTHR) {
        const int chain = base >> 14, p = (base & 16383) + tid;
        mlstm_m2_scalars(CH, chain, SC, tid);
        if ((base & 16383) == 0 && tid < 66) MS[chain * 66 + tid] = SC[3 * tid + 2];
        const float* dl = DCT + (size_t)chain * 66 * 32768 + 2 * p; unsigned* ct = (unsigned*)(CT + (size_t)chain * 66 * 32768 + 2 * p);
        float c0 = 0.f, c1 = 0.f;
#pragma unroll 1
        for (int jb = 0; jb < 66; jb += 11) { float2 d[11];
#pragma unroll
            for (int k = 0; k < 11; ++k) d[k] = *(const float2*)(dl + (size_t)(jb + k) * 32768);
            asm volatile("" ::: "memory");
#pragma unroll
            for (int k = 0; k < 11; ++k) { const float dec = SC[3 * (jb + k)], sc = SC[3 * (jb + k) + 1]; ct[(size_t)(jb + k) * 16384] = pk2(c0, c1); c0 = dec * c0 + sc * d[k].x; c1 = dec * c1 + sc * d[k].y; }
            asm volatile("" ::: "memory"); }
        __syncthreads();
    }
    for (int chain = bid; chain < 8; chain += G) {
        mlstm_m2_scalars(CH, chain, SC, tid);
        if (tid < 128) { float c0 = 0.f;
#pragma unroll 1
            for (int jb = 0; jb < 66; jb += 11) { float d[11];
#pragma unroll
                for (int k = 0; k < 11; ++k) d[k] = DN[(size_t)(chain * 66 + jb + k) * 128 + tid];
                asm volatile("" ::: "memory");
#pragma unroll
                for (int k = 0; k < 11; ++k) { NS[(size_t)(chain * 66 + jb + k) * 128 + tid] = c0; c0 = SC[3 * (jb + k)] * c0 + SC[3 * (jb + k) + 1] * d[k]; }
                asm volatile("" ::: "memory"); } }
        __syncthreads();
    }
}
__device__ __forceinline__ void mlstm_m3_unit(const bf16* Z, const float* G16, const float* gate_b, const bf16* CT, const float* NS, const float* MS, const float* mng, bf16* YB, int jb, int h, LAS unsigned char* lds, int tid) {
    asm volatile("" : "+v"(tid));
    const int wave = tid >> 6, lane = tid & 63, hh = lane >> 5, l31 = lane & 31;
    LAS unsigned char* VL = lds; LAS float* XCH = (LAS float*)lds; LAS float* SM = (LAS float*)(lds + SM_OFF);
    gate_scan(G16, gate_b, jb, h, SM, tid);
    const size_t row0 = (size_t)jb * 128;
    if (tid < 256) { const int dd = tid >> 7, d = tid & 127; SM[1040 + dd * 128 + d] = NS[(size_t)((dd * 4 + h) * 66 + chain_cidx(dd, jb)) * 128 + d]; }
    if (tid < 2) SM[1028 + tid] = MS[(tid * 4 + h) * 66 + chain_cidx(tid, jb)];
    stage_v(Z, row0, h, VL, tid);
    __syncthreads();
    const int tb = wave & 3, dir = wave >> 2, tau = 32 * tb + l31;
    float SCL = 0.08838834764831845f; asm volatile("" : "+v"(SCL));
    const float m = SM[1028 + dir], cmT = SM[256 + dir * 128 + tau], bT = SM[512 + dir * 128 + tau];
    const float Mt = fmaxf(m, cmT), wa = __expf(m - Mt), em = __expf(-(bT + Mt)), fa = wa * SCL;
    bf16x8 qf[8];
#pragma unroll
    for (int ks = 0; ks < 8; ++ks) qf[ks] = *(const bf16x8*)(Z + (size_t)MT * ZC_MQ + (row0 + tau) * 512 + h * 128 + 16 * ks + 8 * hh);
    f32x16 acc[8];
#pragma unroll
    for (int eb = 0; eb < 8; ++eb)
#pragma unroll
        for (int r = 0; r < 16; ++r) acc[eb][r] = 0.f;
    { const bf16* ct = CT + (size_t)((dir * 4 + h) * 66 + chain_cidx(dir, jb)) * 32768;
#pragma unroll
      for (int e2 = 0; e2 < 8; e2 += 2) { bf16x8 af[2][8];
#pragma unroll
          for (int eb = 0; eb < 2; ++eb)
#pragma unroll
              for (int ks = 0; ks < 8; ++ks) af[eb][ks] = *(const bf16x8*)(ct + (size_t)(32 * (e2 + eb) + l31) * 128 + 16 * ks + 8 * hh);
          asm volatile("" ::: "memory");
#pragma unroll
          for (int ks = 0; ks < 8; ++ks) { acc[e2] = __builtin_amdgcn_mfma_f32_32x32x16_bf16(af[0][ks], qf[ks], acc[e2], 0, 0, 0); acc[e2 + 1] = __builtin_amdgcn_mfma_f32_32x32x16_bf16(af[1][ks], qf[ks], acc[e2 + 1], 0, 0, 0); } } }
    asm volatile("" ::: "memory");
    float den = 0.f;
    { float nq[8][8];
#pragma unroll
      for (int ks = 0; ks < 8; ++ks)
#pragma unroll
          for (int j = 0; j < 8; ++j) nq[ks][j] = SM[1040 + dir * 128 + 16 * ks + 8 * hh + j];
      asm volatile("" ::: "memory");
#pragma unroll
      for (int ks = 0; ks < 8; ++ks)
#pragma unroll
          for (int j = 0; j < 8; ++j) den += bf2f((unsigned short)qf[ks][j]) * nq[ks][j]; }
    den *= fa;
#pragma unroll
    for (int eb = 0; eb < 8; ++eb)
#pragma unroll
        for (int r = 0; r < 16; ++r) acc[eb][r] *= fa;
    asm volatile("" ::: "memory");
#pragma unroll 1
    for (int sb = 0; sb < 4; ++sb) {
        if (dir == 0 ? sb > tb : sb < tb) continue;
        asm volatile("" ::: "memory");
        f32x16 p;
#pragma unroll
        for (int r = 0; r < 16; ++r) p[r] = 0.f;
        { bf16x8 kf[8];
#pragma unroll
          for (int ks = 0; ks < 8; ++ks) kf[ks] = *(const bf16x8*)(Z + (size_t)MT * ZC_MK + (row0 + 32 * sb + l31) * 512 + h * 128 + 16 * ks + 8 * hh);
          asm volatile("" : "+v"(kf[0]), "+v"(kf[1]), "+v"(kf[2]), "+v"(kf[3]), "+v"(kf[4]), "+v"(kf[5]), "+v"(kf[6]), "+v"(kf[7]) :: "memory");
#pragma unroll
          for (int ks = 0; ks < 8; ++ks) p = __builtin_amdgcn_mfma_f32_32x32x16_bf16(kf[ks], qf[ks], p, 0, 0, 0); }
        { float sv[16];
#pragma unroll
          for (int r = 0; r < 16; ++r) sv[r] = SM[dir * 128 + 32 * sb + crow16(r, hh)];
          asm volatile("" ::: "memory");
#pragma unroll
          for (int r = 0; r < 16; ++r) { const int sg = 32 * sb + crow16(r, hh); const bool keep = dir == 0 ? (sg <= tau) : (sg >= tau);
              const float e = __expf(sv[r] - Mt) * SCL; const float w = keep ? e : 0.f; p[r] *= w; den += p[r]; } }
#pragma unroll
        for (int s = 0; s < 2; ++s) {
            v4u w4; w4.x = pk2(p[8 * s + 0], p[8 * s + 1]); w4.y = pk2(p[8 * s + 2], p[8 * s + 3]); w4.z = pk2(p[8 * s + 4], p[8 * s + 5]); w4.w = pk2(p[8 * s + 6], p[8 * s + 7]);
            const bf16x8 bfrag = __builtin_bit_cast(bf16x8, w4);
#pragma unroll
            for (int eb = 0; eb < 8; ++eb) { const bf16x8 a = trfrag(VL, VSTR, 32 * sb + 16 * s + 4 * hh, 32 * sb + 16 * s + 8 + 4 * hh, 32 * eb, lane);
                acc[eb] = __builtin_amdgcn_mfma_f32_32x32x16_bf16(a, bfrag, acc[eb], 0, 0, 0);
                if (eb & 1) { asm volatile("" ::: "memory"); } }
        }
    }
    den += shfl_xor_f(den, 32);
    { const float inv = 1.f / fmaxf(fabsf(den), em);
#pragma unroll
      for (int eb = 0; eb < 8; ++eb)
#pragma unroll
          for (int r = 0; r < 16; ++r) acc[eb][r] *= inv; }
    __syncthreads();
    LAS float* HS = (LAS float*)lds;
    if (dir == 1) {
#pragma unroll
        for (int eb = 0; eb < 8; ++eb)
#pragma unroll
            for (int r = 0; r < 16; ++r) HS[tau * 257 + 32 * eb + crow16(r, hh)] = acc[eb][r];
    }
    __syncthreads();
    if (dir == 0) {
#pragma unroll
        for (int eb = 0; eb < 8; eb += 2) { float hq[2][16];
#pragma unroll
            for (int e = 0; e < 2; ++e)
#pragma unroll
                for (int r = 0; r < 16; ++r) hq[e][r] = HS[tau * 257 + 32 * (eb + e) + crow16(r, hh)];
#define PIN16(a) asm volatile("" : "+v"(a[0]), "+v"(a[1]), "+v"(a[2]), "+v"(a[3]), "+v"(a[4]), "+v"(a[5]), "+v"(a[6]), "+v"(a[7]), "+v"(a[8]), "+v"(a[9]), "+v"(a[10]), "+v"(a[11]), "+v"(a[12]), "+v"(a[13]), "+v"(a[14]), "+v"(a[15]) :: "memory")
            PIN16(hq[0]); PIN16(hq[1]);
#undef PIN16
#pragma unroll
            for (int e = 0; e < 2; ++e)
#pragma unroll
                for (int r = 0; r < 16; ++r) HS[tau * 257 + 32 * (eb + e) + crow16(r, hh)] = hq[e][r] + acc[eb + e][r];
            asm volatile("" ::: "memory"); }
    }
    __syncthreads();
    {
        unsigned short og[16][4]; float gn[4];
#pragma unroll
        for (int rr = 0; rr < 16; ++rr)
#pragma unroll
            for (int k = 0; k < 4; ++k) og[rr][k] = Z[(size_t)MT * ZC_MO + (row0 + wave * 16 + rr) * 1024 + h * 256 + 64 * k + lane];
#pragma unroll
        for (int k = 0; k < 4; ++k) gn[k] = mng[h * 256 + 64 * k + lane];
#pragma unroll
        for (int rr = 0; rr < 16; ++rr) { const int t2 = wave * 16 + rr; float v[4]; float ss = 0.f;
#pragma unroll
            for (int k = 0; k < 4; ++k) { v[k] = HS[t2 * 257 + 64 * k + lane]; ss += v[k] * v[k]; }
            const float rstd = 1.f / sqrtf(wave_sum(ss) * (1.f / 256.f) + EPS); const size_t row = row0 + t2;
#pragma unroll
            for (int k = 0; k < 4; ++k) YB[row * 1024 + h * 256 + 64 * k + lane] = (bf16)f2bf(bf2f(og[rr][k]) * v[k] * rstd * gn[k]); }
    }
    __syncthreads();
}
__device__ __forceinline__ void gmlp_unit_mfma(const bf16* Z, const float* gng, const bf16* wsb  , const float* bs  , bf16* YA, int j, LAS unsigned char* lds, int tid) {
    asm volatile("" : "+v"(tid));
    const int wave = tid >> 6, lane = tid & 63, g = wave;
    LAS float* ST = (LAS float*)(lds + SM_OFF);
    LAS float* BSL = ST + 256;
    BSL[tid] = bs[tid]; BSL[tid + NTHR] = bs[tid + NTHR];
    LAS unsigned char* VN = lds + wave * 16384;
    const size_t row0 = (size_t)j * 128;
#pragma unroll 1
    for (int rb = 0; rb < 16; rb += 4) { v4u wq[4][2];
#pragma unroll
        for (int r4 = 0; r4 < 4; ++r4) { const v4u* zp = (const v4u*)(Z + (row0 + wave * 16 + rb + r4) * 2048 + 1024 + lane * 16); wq[r4][0] = zp[0]; wq[r4][1] = zp[1]; }
        asm volatile("" ::: "memory");
#pragma unroll
        for (int r4 = 0; r4 < 4; ++r4) { const int q = wave * 16 + rb + r4; const v4u w0 = wq[r4][0], w1 = wq[r4][1];
            float x[16]; const unsigned ww[8] = {w0.x, w0.y, w0.z, w0.w, w1.x, w1.y, w1.z, w1.w};
            float s = 0.f;
#pragma unroll
            for (int k = 0; k < 8; ++k) { x[2 * k] = bflo(ww[k]); x[2 * k + 1] = bfhi(ww[k]); s += x[2 * k] + x[2 * k + 1]; }
            const float mean = wave_sum(s) * (1.f / 1024.f); float s2 = 0.f;
#pragma unroll
            for (int k = 0; k < 16; ++k) { const float d = x[k] - mean; s2 += d * d; }
            const float rstd = 1.f / sqrtf(wave_sum(s2) * (1.f / 1024.f) + EPS);
            if (lane == 0) { ST[2 * q] = mean; ST[2 * q + 1] = rstd; } } }
    __syncthreads();
#pragma unroll 1
    for (int h = 0; h < 2; ++h) {
        const int ln = mk_lane_id(), hh = ln >> 5, l31 = ln & 31;
        const int cbase = g * 128 + 64 * h, c8 = (ln & 7) * 8;
        { const f32x4 g0 = *(const f32x4*)(gng + cbase + c8), g1 = *(const f32x4*)(gng + cbase + c8 + 4);
#pragma unroll 1
          for (int ib = 0; ib < 16; ib += 4) { v4u wv[4];
#pragma unroll
            for (int i4 = 0; i4 < 4; ++i4) wv[i4] = *(const v4u*)(Z + (row0 + (ib + i4) * 8 + (ln >> 3)) * 2048 + 1024 + cbase + c8);
            asm volatile("" ::: "memory");
#pragma unroll
            for (int i4 = 0; i4 < 4; ++i4) { const int q = (ib + i4) * 8 + (ln >> 3); const float mean = ST[2 * q], rstd = ST[2 * q + 1]; const v4u w = wv[i4]; v4u o;
              o.x = pk2((bflo(w.x) - mean) * rstd * g0.x, (bfhi(w.x) - mean) * rstd * g0.y); o.y = pk2((bflo(w.y) - mean) * rstd * g0.z, (bfhi(w.y) - mean) * rstd * g0.w);
              o.z = pk2((bflo(w.z) - mean) * rstd * g1.x, (bfhi(w.z) - mean) * rstd * g1.y); o.w = pk2((bflo(w.w) - mean) * rstd * g1.z, (bfhi(w.w) - mean) * rstd * g1.w);
              *(LAS v4u*)(VN + q * 128 + (ln & 7) * 16) = o; } } }
        LDS_WAIT(); asm volatile("" ::: "memory");
        bf16x8 bfr[8][2];
#pragma unroll
        for (int ks = 0; ks < 8; ++ks)
#pragma unroll
            for (int cb = 0; cb < 2; ++cb) bfr[ks][cb] = trfrag(VN, 128, 16 * ks + 8 * hh, 16 * ks + 8 * hh + 4, 32 * cb, ln);
        f32x16 acc[4][2];
#pragma unroll
        for (int pb = 0; pb < 4; ++pb)
#pragma unroll
            for (int cb = 0; cb < 2; ++cb)
#pragma unroll
                for (int r = 0; r < 16; ++r) acc[pb][cb][r] = 0.f;
#pragma unroll
        for (int pb = 0; pb < 4; ++pb) {
            bf16x8 af[8];
#pragma unroll
            for (int ks = 0; ks < 8; ++ks) af[ks] = *(const bf16x8*)(wsb + (size_t)(g * 128 + 32 * pb + l31) * 128 + 16 * ks + 8 * hh);
            asm volatile("" ::: "memory");
#pragma unroll
            for (int ks = 0; ks < 8; ++ks) { acc[pb][0] = __builtin_amdgcn_mfma_f32_32x32x16_bf16(af[ks], bfr[ks][0], acc[pb][0], 0, 0, 0); acc[pb][1] = __builtin_amdgcn_mfma_f32_32x32x16_bf16(af[ks], bfr[ks][1], acc[pb][1], 0, 0, 0); }
            asm volatile("" ::: "memory");
        }
        LDS_WAIT(); asm volatile("" ::: "memory");
#pragma unroll
        for (int pb = 0; pb < 4; ++pb)
#pragma unroll
            for (int q4 = 0; q4 < 4; ++q4) { const f32x4 b4 = *(const LAS f32x4*)(BSL + g * 128 + 32 * pb + 8 * q4 + 4 * hh);
#pragma unroll
                for (int i = 0; i < 4; ++i) { const int r = 4 * q4 + i, p = 32 * pb + 8 * q4 + 4 * hh + i;
#pragma unroll
                    for (int cb = 0; cb < 2; ++cb) *(LAS unsigned short*)(VN + p * 128 + (32 * cb + l31) * 2) = (unsigned short)f2bf(acc[pb][cb][r] + b4[i]); } }
        LDS_WAIT(); asm volatile("" ::: "memory");
#pragma unroll 1
        for (int ib = 0; ib < 16; ib += 4) { v4u uq[4];
#pragma unroll
            for (int i4 = 0; i4 < 4; ++i4) uq[i4] = *(const v4u*)(Z + (row0 + (ib + i4) * 8 + (ln >> 3)) * 2048 + cbase + c8);
            asm volatile("" ::: "memory");
#pragma unroll
            for (int i4 = 0; i4 < 4; ++i4) { const int p = (ib + i4) * 8 + (ln >> 3); const v4u m = *(const LAS v4u*)(VN + p * 128 + (ln & 7) * 16); const v4u u = uq[i4]; v4u o;
                o.x = pk2(bflo(u.x) * bflo(m.x), bfhi(u.x) * bfhi(m.x)); o.y = pk2(bflo(u.y) * bflo(m.y), bfhi(u.y) * bfhi(m.y));
                o.z = pk2(bflo(u.z) * bflo(m.z), bfhi(u.z) * bfhi(m.z)); o.w = pk2(bflo(u.w) * bflo(m.w), bfhi(u.w) * bfhi(m.w));
                *(v4u*)(YA + (row0 + p) * 1024 + cbase + c8) = o; } }
        LDS_WAIT(); asm volatile("" ::: "memory");
    }
    __syncthreads();
}

__device__ __forceinline__ void phase_post(const float* ATTO, const float* MLH, const bf16* Z, const float* dng, const float* mng, float lam, float linit, bf16* YB, bf16* YC, int bid, int G, int tid) {
    asm volatile("" : "+v"(tid));
    const int wave = tid >> 6, lane = tid & 63, head = lane >> 4, e0 = (lane & 15) * 16;
    for (int row = bid * NWAVES + wave; row < MT; row += G * NWAVES) {
        const size_t off = (size_t)row * 1024 + head * 256 + e0;
        {
            const f32x4* a0 = (const f32x4*)(ATTO + off); const f32x4* a1 = (const f32x4*)(ATTO + (size_t)MT * 1024 + off);
            float o[16]; float ss = 0.f;
#pragma unroll
            for (int k = 0; k < 4; ++k) { const f32x4 p = a0[k], q = a1[k];
                o[4 * k + 0] = p.x - lam * q.x; o[4 * k + 1] = p.y - lam * q.y; o[4 * k + 2] = p.z - lam * q.z; o[4 * k + 3] = p.w - lam * q.w; }
#pragma unroll
            for (int k = 0; k < 16; ++k) ss += o[k] * o[k];
            ss += shfl_xor_f(ss, 1); ss += shfl_xor_f(ss, 2); ss += shfl_xor_f(ss, 4); ss += shfl_xor_f(ss, 8);
            const float rstd = 1.f / sqrtf(ss * (1.f / 256.f) + EPS) * (1.f - linit);
            v4u w0, w1;
            w0.x = pk2(o[0] * rstd * dng[e0 + 0], o[1] * rstd * dng[e0 + 1]); w0.y = pk2(o[2] * rstd * dng[e0 + 2], o[3] * rstd * dng[e0 + 3]);
            w0.z = pk2(o[4] * rstd * dng[e0 + 4], o[5] * rstd * dng[e0 + 5]); w0.w = pk2(o[6] * rstd * dng[e0 + 6], o[7] * rstd * dng[e0 + 7]);
            w1.x = pk2(o[8] * rstd * dng[e0 + 8], o[9] * rstd * dng[e0 + 9]); w1.y = pk2(o[10] * rstd * dng[e0 + 10], o[11] * rstd * dng[e0 + 11]);
            w1.z = pk2(o[12] * rstd * dng[e0 + 12], o[13] * rstd * dng[e0 + 13]); w1.w = pk2(o[14] * rstd * dng[e0 + 14], o[15] * rstd * dng[e0 + 15]);
            v4u* yp = (v4u*)(YC + off); yp[0] = w0; yp[1] = w1;
        }
    }
}

struct Args { const float* in[21]; float* out; unsigned char* ws; int ph_lo, ph_hi; };
static_assert(sizeof(Args) == 21 * 8 + 8 + 8 + 8, "Args has no padding");

constexpr int T_ALL = -1, T_PRO0 = 0, T_PRO1 = 1, T_NORM = 2, T_W13 = 3, T_W2 = 4, T_N2 = 5, T_WIN = 6, T_ROPE = 7, T_MLSTM = 8, T_POST = 9, T_MERGE0 = 10, T_WOUT = 11, T_FINAL = 12, T_ATTN = 13, T_GMLP = 14, T_MERGE1 = 15, T_MERGE2 = 16, T_M3 = 17, NTYPES = 18;
#define SELD(t) (SEL == T_ALL || SEL == (t))
template <int SEL> __global__ void __launch_bounds__(NTHR, 2) mk_fwd(Args args) {
    extern __shared__ __attribute__((aligned(16))) unsigned char lds_raw[];
    LAS unsigned char* lds = (LAS unsigned char*)lds_raw;
    volatile LAS unsigned* MISC = (volatile LAS unsigned*)(lds + MISC_OFF);
    const int wave_s = __builtin_amdgcn_readfirstlane((int)threadIdx.x >> 6), bid_k = blockIdx.x, G = gridDim.x;
#define tid MK_TID(wave_s)
#define KARGS ((const __attribute__((address_space(4))) Args*)ka_)
#define PHASE_BEGIN const __attribute__((address_space(4))) void* ka_ = (const __attribute__((address_space(4))) void*)__builtin_amdgcn_kernarg_segment_ptr(); asm volatile("" : "+s"(ka_)); unsigned char* const ws = KARGS->ws; (void)ws; int bid = bid_k; asm volatile("" : "+s"(bid))
#define PIN(i) (KARGS->in[i])
#define XR ((float*)(ws + WS_XR))
#define H ((bf16*)(ws + WS_H))
#define GB ((bf16*)(ws + WS_GB))
#define Z ((bf16*)(ws + WS_Z))
#define ATTO ((float*)(ws + WS_ATTO))
#define MLH ((float*)(ws + WS_MLH))
#define DCT ((float*)(ws + WS_MLH))
#define YA ((bf16*)(ws + WS_YA))
#define YB ((bf16*)(ws + WS_YB))
#define YC ((bf16*)(ws + WS_YC))
#define SLAB ((float*)(ws + WS_SLAB))
#define YACC ((float*)(ws + WS_YACC))
#define Y ((bf16*)(ws + WS_Y))
#define G16 ((float*)(ws + WS_G16))
#define MOD ((const float*)(ws + WS_MOD))
#define CTS ((bf16*)(ws + WS_CT))
#define DNS ((float*)(ws + WS_MSM))
#define NSS (DNS + 8 * 66 * 128)
#define CHS (NSS + 8 * 66 * 128)
#define MSS (CHS + 8 * 66 * 2)
#define modl (MOD + (size_t)(l * 2 + 0) * NMOD)
#define modc (MOD + (size_t)(l * 2 + 1) * NMOD)
#define W13T0 ((const bf16*)(ws + WS_W13T) + (size_t)(l * 2 + 0) * 8192 * 4096)
#define W13T1 (W13T0 + (size_t)8192 * 4096)
#define W2T0 ((const bf16*)(ws + WS_W2T) + (size_t)(l * 2 + 0) * 4096 * 4096)
#define W2T1 (W2T0 + (size_t)4096 * 4096)
#define WINT ((const bf16*)(ws + WS_WINT) + (size_t)l * NZ * 4096)
#define WBT ((const bf16*)(ws + WS_WBT) + (size_t)(l * 3) * 4096 * 1024)
#define WOT ((const bf16*)(ws + WS_WOT) + (size_t)l * 4096 * 4096)
#define MKP() Ptrs P; P.x = PIN(0); P.c = PIN(1); P.ctx = PIN(2); P.c_ctx = PIN(3); P.ada_down = PIN(4); P.ada_up = PIN(5); P.ada_bias = PIN(6); P.norm_g = PIN(7); \
    P.w13 = PIN(8); P.w2 = PIN(9); P.w_in = PIN(10); P.gmlp_norm_g = PIN(11); P.gmlp_ws = PIN(12); P.gmlp_bs = PIN(13); P.gate_b = PIN(14); \
    P.mlstm_norm_g = PIN(15); P.diff_lambda = PIN(16); P.diff_norm_g = PIN(17); P.w_branch = PIN(18); P.w_out = PIN(19); P.final_g = PIN(20); P.out = KARGS->out; P.ws = KARGS->ws
    for (int u = tid; u < (LDS_BYTES - LDSCTL_OFF) / 4; u += NTHR) ((LAS unsigned*)(lds + LDSCTL_OFF))[u] = 0u;
    __syncthreads();
#if MK_ONE_LAUNCH
    XcdBarrier bar = xcd_barrier_post((unsigned*)((gu32*)(args.ws + WS_CTL) + CW_BAR), MISC + 8, tid);
#define GRID_BAR() do { XcdBarrier b2_ = bar; asm volatile("" : "+s"(b2_.bar)); xcd_barrier(b2_, tid); } while (0)
#else
#define GRID_BAR() do {} while (0)
#endif
    const int lo = args.ph_lo, hi = args.ph_hi;
#define IN(k) (lo <= (k) && (k) < hi)
#define SEAM(k) do { if (IN(k) && IN((k) + 1)) GRID_BAR(); } while (0)

    if (IN(P_PRO0)) { PHASE_BEGIN; MKP(); for (int rep_ = 0; rep_ < DBL_PRO; ++rep_) pro0(P, lds, bid, G, tid); SEAM(P_PRO0); }
    if (IN(P_PRO1)) { PHASE_BEGIN; MKP(); pro1(P, lds, bid, G, tid); SEAM(P_PRO1); }

    for (int l = 0; l < DEPTH; ++l) {
        const int pb = P_LAYER0 + l * NPL;
        if (hi <= pb || lo >= pb + NPL) continue;
#define GEMM_RESID_SPLIT2(Aptr, Bptr, gate_l, fac, ms3, yc, nctx_) do { \
            { pg8::Gemm g{(Aptr) + (size_t)CTXL * DM, (Bptr), SEQ, DM, DM, DM}; pg8::StaticOrder S; S.init(SEQ, DM, G, bid); pg8::EpiResid E{XR + (size_t)CTXL * DM, (gate_l), (gate_l), XR + (size_t)CTXL * DM, (fac)}; \
              pg8::gemm_phase<pg8::EpiResid, pg8::StaticOrder, true, true>(lds + RING_OFF, g, S, E, wave_s); } \
            { pg8::Gemm g{(Aptr), (Bptr), CTXL, DM, 256, DM}; pg8::CtxSplitOrder S{bid, G, (nctx_), (ms3), (yc), wave_s}; pg8::EpiSlab E{SLAB}; \
              pg8::gemm_phase<pg8::EpiSlab, pg8::CtxSplitOrder, true, true>(lds + RING_OFF, g, S, E, wave_s); } } while (0)
#define GEMM_RESID_SPLIT(Aptr, Bptr, gate_l, fac, ms3, yc, nctx_, xb_) do { \
            pg8::Gemm g{(Aptr), (Bptr), MT, DM, DM, DM}; pg8::ResidOrder S; S.lat.init(SEQ, DM, G, bid); S.c = bid; S.G = G; S.n = (nctx_); \
            pg8::EpiResidSlab E{ws, (gate_l), (xb_), (fac)}; \
            pg8::gemm_phase<pg8::EpiResidSlab, pg8::ResidOrder, true, true>(lds + RING_OFF, g, S, E, wave_s); } while (0)
#define GL (G >= 128 ? G - (G >> 4) : G)
#define NC (G - GL)
#define GEMM_LAT(EPI, GW_, Aptr, Bptr, Ncols, Kdim, ...) do { pg8::Gemm g{(Aptr), (Bptr), MT, (Ncols), (Kdim), (Kdim)}; pg8::StaticOrder S; S.init(MT, (Ncols), (GW_), bid); EPI E{__VA_ARGS__}; \
            pg8::gemm_phase<EPI, pg8::StaticOrder, true, true>(lds + RING_OFF, g, S, E, wave_s); } while (0)

        if (IN(pb + L_N1)) { PHASE_BEGIN; MKP(); phase_norm(XR, l == 0 ? P.x - (size_t)CTXL * DM : (const float*)XR, l == 0 ? P.ctx : (const float*)XR, XR, P.norm_g + (size_t)(l * 3 + 0) * DM, modl + 0 * 3 * DM, modc + 0 * 3 * DM, H, l > 0 ? SLAB : nullptr, modc - (size_t)2 * NMOD + 2 * 3 * DM + 2 * DM, 0.5f, lds, bid, G, tid); SEAM(pb + L_N1); }
        if (IN(pb + L_W13A)) { PHASE_BEGIN; MKP();
            if (bid < GL) { GEMM_LAT(pg8::EpiSwiglu, GL, H, W13T0, 8192, DM, GB, FFND);
                            convert_idle(P, l, 1, CVD, CVS, (MT / 256 * 32) % GL, GL, lds, bid, tid); }
            if (NC == 0 || bid >= GL) convert_part(P, l, 1, 0, CVD, NC ? bid - GL : bid, NC ? NC : G, lds, tid);
            SEAM(pb + L_W13A); }
        if (IN(pb + L_W2A)) { PHASE_BEGIN; MKP();
            GEMM_RESID_SPLIT(GB, W2T0, modl + 0 * 3 * DM + 2 * DM, 0.5f, (const float*)nullptr, (bf16*)nullptr, 256, l == 0 ? P.x - (size_t)CTXL * DM : (const float*)XR);
            SEAM(pb + L_W2A); }
        if (IN(pb + L_N2)) { PHASE_BEGIN; MKP(); phase_norm(XR, XR, XR, l == 0 ? P.ctx : (const float*)XR, P.norm_g + (size_t)(l * 3 + 1) * DM, modl + 1 * 3 * DM, modc + 1 * 3 * DM, H, SLAB, modc + 0 * 3 * DM + 2 * DM, 0.5f, lds, bid, G, tid); SEAM(pb + L_N2); }
        if (IN(pb + L_WIN)) { PHASE_BEGIN; MKP();
            if (bid < GL) { GEMM_LAT(pg8::EpiWin, GL, H, WINT, NZ, DM, Z, (const float*)(ws + WS_ROPE), (const float*)(ws + WS_ROPE) + SEQ * 64); }
            if (NC == 0 || bid >= GL) { convert_part(P, l, 1, CVS, NL, NC ? bid - GL : bid, NC ? NC : G, lds, tid);
                for (int u = NC ? bid - GL : bid; u < 66; u += (NC ? NC : G)) gates_unit(H, (const bf16*)(ws + WS_WG16) + (size_t)l * 16 * DM, G16, u, tid); }
            SEAM(pb + L_WIN); }
        if (IN(pb + L_MIX1)) { PHASE_BEGIN; MKP();
            for (int rep_ = 0; rep_ < DBL_M1; ++rep_) for (int u = (bid + G - (100 % G)) % G; u < 264; u += G) mlstm_m1_unit(Z, G16, P.gate_b + (size_t)l * 16, DCT, DNS, CHS, u >> 2, u & 3, lds, tid);
            for (int rep_ = 0; rep_ < DBL_ATTN; ++rep_) for (int u = bid; u < (l < DEPTH - 1 ? 264 : 256); u += G) {
                int hm, qb, seq; if (u < 256) { hm = u & 7; qb = 1 + (u >> 3); seq = MT; } else { hm = u - 256; qb = 0; seq = CTXL; }
                const int h = hm >> 1, mm = hm & 1;
                const attn128::bf16* Zb = (const attn128::bf16*)Z;
                attn256::attn_o256_body(Zb + (size_t)MT * ZC_AQ + (size_t)(qb * 256) * 1024 + h * 256 + mm * 128, Zb + (size_t)MT * ZC_AK + h * 256 + mm * 128, Zb + (size_t)MT * ZC_AV + h * 256,
                                        ATTO + (size_t)mm * MT * 1024 + (size_t)(qb * 256) * 1024 + h * 256, seq, (char*)lds_raw, wave_s);
                __syncthreads();
            }
            SEAM(pb + L_MIX1);
        }
        if (IN(pb + L_POST)) { PHASE_BEGIN; MKP();
            for (int rep_ = 0; rep_ < DBL_POST; ++rep_) { mlstm_m2(DCT, DNS, CHS, CTS, NSS, MSS, lds, bid, G, tid); } SEAM(pb + L_POST); }
        if (IN(pb + L_M3)) { PHASE_BEGIN; MKP();
            { const int u0 = (l < DEPTH - 1) ? 0 : 8, nsec = (l < DEPTH - 1) ? (264 - G > 0 ? 264 - G : 0) : 0;
              for (int rep_ = 0; rep_ < DBL_M3; ++rep_) for (int u = u0 + bid; u < 264; u += G) mlstm_m3_unit(Z, G16, P.gate_b + (size_t)l * 16, CTS, NSS, MSS, P.mlstm_norm_g + (size_t)l * 1024, YB, u >> 2, u & 3, lds, tid);
              const int ngm = (G >= 66 + nsec + 8) ? 66 : 0;
              for (int rep_ = 0; rep_ < DBL_GMLP; ++rep_) for (int u = G - 1 - bid; u < 66; u += G) gmlp_unit_mfma(Z, P.gmlp_norm_g + (size_t)l * 1024, (const bf16*)(ws + WS_GWSB) + (size_t)l * 8 * 128 * 128, P.gmlp_bs + (size_t)l * 8 * 128, YA, u, lds, tid);
              if (bid >= nsec && bid < G - ngm) phase_post(ATTO, MLH, Z, P.diff_norm_g + (size_t)l * 256, P.mlstm_norm_g + (size_t)l * 1024, ((const float*)(ws + WS_LAM))[l], lambda_init_f(l), YB, YC, bid - nsec, G - ngm - nsec, tid); }
            SEAM(pb + L_M3); }
        if (IN(pb + L_MERGE)) { PHASE_BEGIN; MKP();
            { pg8::Gemm g{YA, WBT, MT, DM, 1024, 1024}; pg8::MergeOrder S; S.lat.init(SEQ, DM, G, bid); S.c = bid; S.G = G; S.nctx = (l < DEPTH - 1) ? 48 : 0; pg8::EpiMergeSeg E{Z, Y, (float*)(ws + WS_MS3)};
              pg8::gemm_phase<pg8::EpiMergeSeg, pg8::MergeOrder, true, true>(lds + RING_OFF, g, S, E, wave_s); }
            SEAM(pb + L_MERGE); }
        if (IN(pb + L_WOUT)) { PHASE_BEGIN; MKP();
            GEMM_RESID_SPLIT2(Y, WOT, modl + 1 * 3 * DM + 2 * DM, 1.f, (const float*)(ws + WS_MS3), Y, (l < DEPTH - 1) ? 256 : 0);
            SEAM(pb + L_WOUT); }
        if (IN(pb + L_N3)) { PHASE_BEGIN; MKP(); phase_norm(XR, XR, XR, XR, P.norm_g + (size_t)(l * 3 + 2) * DM, modl + 2 * 3 * DM, modc + 2 * 3 * DM, H, SLAB, modc + 1 * 3 * DM + 2 * DM, 1.f, lds, bid, G, tid); SEAM(pb + L_N3); }
        if (IN(pb + L_W13B)) { PHASE_BEGIN; MKP();
            { const int skip = (l < DEPTH - 1) ? 0 : CTXL;
              const int GLb = (l < DEPTH - 1) ? GL : G;
              if (bid < GLb) { pg8::Gemm g{H + (size_t)skip * DM, W13T1, MT - skip, 8192, DM, DM}; pg8::StaticOrder S; S.init(MT - skip, 8192, GLb, bid); pg8::EpiSwiglu E{GB + (size_t)skip * FFND, FFND};
                  pg8::gemm_phase<pg8::EpiSwiglu, pg8::StaticOrder, true, true>(lds + RING_OFF, g, S, E, wave_s);
                  convert_idle(P, l + 1, 0, CVD, CVS, (MT / 256 * 32) % GL, GL, lds, bid, tid); }
              if (NC == 0 || bid >= GL) convert_part(P, l + 1, 0, 0, CVD, NC ? bid - GL : bid, NC ? NC : G, lds, tid); }
            SEAM(pb + L_W13B); }
        if (IN(pb + L_W2B)) { PHASE_BEGIN; MKP();
            GEMM_RESID_SPLIT(GB, W2T1, modl + 2 * 3 * DM + 2 * DM, 0.5f, (const float*)nullptr, (bf16*)nullptr, (l < DEPTH - 1) ? 256 : 0, (const float*)XR);
            SEAM(pb + L_W2B); }
#undef GEMM_LAT
#undef GL
#undef NC
#undef GEMM_RESID_SPLIT
#undef GEMM_RESID_SPLIT2
    }
    if (IN(P_FINAL)) { PHASE_BEGIN; MKP(); phase_final(XR, P.final_g, P.out, bid, G, tid); }
#undef IN
#undef SEAM
#undef tid
#undef XR
#undef H
#undef GB
#undef Z
#undef ATTO
#undef MLH
#undef DCT
#undef YA
#undef YB
#undef YC
#undef SLAB
#undef YACC
#undef Y
#undef G16
#undef MOD
#undef CTS
#undef DNS
#undef NSS
#undef CHS
#undef MSS
#undef modl
#undef modc
#undef W13T0
#undef W13T1
#undef W2T0
#undef W2T1
#undef WINT
#undef WBT
#undef WOT
}

extern "C" void kernel_launch(void* const* d_in, const int* in_sizes, int n_in, void* d_out, int out_size, void* d_ws, size_t ws_size, hipStream_t stream) {
    static int grid = 0;
    if (grid == 0) {
        if (n_in != 21 || in_sizes[0] != SEQ * DM || out_size != SEQ * DM || ws_size < WS_END) {
            fprintf(stderr, "kernel_launch: unexpected shapes: n_in %d in0 %d out %d ws %zu (need %zu)\n", n_in, n_in > 0 ? in_sizes[0] : -1, out_size, ws_size, (size_t)WS_END); grid = -1; return; }
        int dev = 0, cus = 0;
        if (hipGetDevice(&dev) != hipSuccess || hipDeviceGetAttribute(&cus, hipDeviceAttributeMultiprocessorCount, dev) != hipSuccess) { grid = -1; return; }
        if (hipFuncSetAttribute((const void*)mk_fwd<T_ALL>, hipFuncAttributeMaxDynamicSharedMemorySize, LDS_BYTES) != hipSuccess) { fprintf(stderr, "kernel_launch: hipFuncSetAttribute failed\n"); grid = -1; return; }
        (void)hipGetLastError();
        grid = cus;
    }
    if (grid < 0) return;
    (void)hipMemsetAsync((char*)d_ws + WS_CTL, 0, CTL_ZERO_BYTES, stream);
    Args a{};
    for (int i = 0; i < 21; ++i) a.in[i] = (const float*)d_in[i];
    a.out = (float*)d_out; a.ws = (unsigned char*)d_ws;
#if MK_ONE_LAUNCH
    a.ph_lo = 0; a.ph_hi = NPH;
    hipLaunchKernelGGL(mk_fwd<T_ALL>, dim3(grid), dim3(NTHR), LDS_BYTES, stream, a);
#else
    for (int p = 0; p < NPH; ++p) { a.ph_lo = p; a.ph_hi = p + 1; hipLaunchKernelGGL(mk_fwd<T_ALL>, dim3(grid), dim3(NTHR), LDS_BYTES, stream, a); }
#endif
    const hipError_t le = hipPeekAtLastError();
    if (le != hipSuccess) fprintf(stderr, "kernel_launch: launch failed: %s\n", hipGetErrorName(le));
}
```

```cpp
#include <hip/hip_runtime.h>
#include <hip/hip_bf16.h>
#include <cstdio>
#include <cstdint>
#include <cmath>
#ifndef MLSTM_CHUNKWISE
#define MLSTM_CHUNKWISE 1
#endif
#ifndef MK_ONE_LAUNCH
#define MK_ONE_LAUNCH 1
#endif
#ifndef DBL_ATTN
#define DBL_ATTN 1
#endif
#ifndef DBL_PRO
#define DBL_PRO 1
#endif
#ifndef DBL_M1
#define DBL_M1 1
#endif
#ifndef DBL_GMLP
#define DBL_GMLP 1
#endif
#ifndef DBL_POST
#define DBL_POST 1
#endif
#ifndef DBL_M3
#define DBL_M3 1
#endif
#ifndef DBL_NORM
#define DBL_NORM 1
#endif
__device__ __forceinline__ int mk_lane_id() { int l_; asm volatile("v_mbcnt_lo_u32_b32 %0, -1, 0\n\tv_mbcnt_hi_u32_b32 %0, -1, %0" : "=v"(l_)); return l_; }
#define MK_TID(wave_s_) (((wave_s_) << 6) | mk_lane_id())
namespace pg8 {
#define PG8_LAS __attribute__((address_space(3)))
typedef unsigned short bf16_t;
typedef short bf16x8 __attribute__((ext_vector_type(8)));
typedef float f32x4 __attribute__((ext_vector_type(4)));
typedef unsigned u32x4 __attribute__((ext_vector_type(4)));
constexpr int BM = 256, BK = 64, HALF = 128, HTB = HALF * BK * 2  , STAGE_BYTES = 8 * HTB, NXCD = 8, WGM = 8;

__host__ __device__ __forceinline__ int lds_byte(int r, int c) { const int st = (r >> 4) * 2 + (c >> 5), rr = r & 15, cc = c & 31, ob = rr * 64 + cc * 2; return st * 1024 + (ob ^ (((ob >> 9) & 1) << 5)); }
__host__ __device__ __forceinline__ void stage_rc(int b, int& R, int& C) { const int st = b / 1024, sb = b % 1024, swz = sb ^ (((sb >> 9) & 1) << 5); R = (st >> 1) * 16 + swz / 64; C = (st & 1) * 32 + (swz % 64) / 2; }
__host__ __device__ __forceinline__ int perm32(int rho) { const int n = rho >> 4, i = rho & 15; return 8 * (i >> 2) + 4 * n + (i & 3); }

struct Unit { int pm, pn, koff, boff, fl;
    __device__ __forceinline__ int seg() const { return fl & 3; } __device__ __forceinline__ bool carry() const { return (fl & 4) != 0; } __device__ __forceinline__ int ntile() const { return fl >> 8; } };
struct Gemm { const bf16_t* A; const bf16_t* Bt; int M, N, K, ld; };

struct StaticOrder {
    int nM, nN, nwg, G, c;
    __host__ __device__ void init(int M, int N, int G_, int c_) { nM = M / BM; nN = N / BM; nwg = nM * nN; G = G_; c = c_; }
    __host__ __device__ bool next(int i, Unit& u) const {
        const long L = (long)i * G + c; if (L >= nwg) return false;
        int wgid = (int)L; { const int q = nwg / NXCD, r = nwg % NXCD, xcd = wgid % NXCD, off = wgid / NXCD; wgid = (xcd < r ? xcd * (q + 1) : r * (q + 1) + (xcd - r) * q) + off; }
        const int nig = WGM * nN, gid = wgid / nig, fm = gid * WGM, gsz = (nM - fm) < WGM ? (nM - fm) : WGM;
        u.pm = fm + ((wgid % nig) % gsz); u.pn = (wgid % nig) / gsz; u.koff = 0; u.boff = 0; u.fl = 0; return true;
    }
    __device__ __forceinline__ void a_ready(const Unit&) const {}
    __device__ __forceinline__ void done(const Unit&) const {}
};

__device__ __forceinline__ unsigned cvt_pk_bf16(float lo, float hi) { unsigned r; asm volatile("v_cvt_pk_bf16_f32 %0, %1, %2" : "=v"(r) : "v"(lo), "v"(hi)); return r; }
typedef float f32x2 __attribute__((ext_vector_type(2)));
__device__ __forceinline__ f32x2 gelu_pk(f32x2 v) {
    const f32x2 av = __builtin_elementwise_abs(v), d = av * 0.2316418882f + 1.0f;
    f32x2 t; t.x = __builtin_amdgcn_rcpf(d.x); t.y = __builtin_amdgcn_rcpf(d.y);
    f32x2 q = t * 0.5307027145f + (-0.7265760135f); q = q * t + 0.7107068705f; q = q * t + (-0.142248368f); q = q * t + 0.127414796f; q = q * t;
    const f32x2 s = (v * v) * (-0.72134752044f);
    f32x2 e; e.x = __builtin_amdgcn_exp2f(s.x); e.y = __builtin_amdgcn_exp2f(s.y);
    const f32x2 m = v * (q * e), r = v - m;
    f32x2 o; o.x = v.x < 0.f ? m.x : r.x; o.y = v.y < 0.f ? m.y : r.y; return o;
}

template <int ACT  > struct EpiBf16 {
    static constexpr bool PERM = true, AFTER_DRAIN = false; static_assert(ACT == 0 || ACT == 1, "EpiBf16: ACT is 0 (none) or 1 (gelu_pk)");
    bf16_t* O; int ldc; const float* bias; int split_cols; size_t split_stride; float scale0;
    __device__ __forceinline__ void operator()(const f32x4 (&acc)[2][2][4][2], const Unit& u, int wr, int wc, int fr, int fq) const {
        const int row0 = u.pm * BM + wr * 64 + fr; int colt = u.pn * BM; bf16_t* base = O;
        float sc = 1.f; if (split_cols) { const int t = colt / split_cols; base += (size_t)t * split_stride; colt -= t * split_cols; if (t == 0) sc = scale0; }
        const int col0 = colt + wc * 32 + 8 * fq, bcol0 = u.pn * BM + wc * 32 + 8 * fq;
        f32x4 bv[2][2];
#pragma unroll
        for (int bj = 0; bj < 2; ++bj)
#pragma unroll
            for (int n = 0; n < 2; ++n) bv[bj][n] = bias ? *(const f32x4*)(bias + bcol0 + bj * HALF + 4 * n) : (f32x4){0.f, 0.f, 0.f, 0.f};
#pragma unroll
        for (int ai = 0; ai < 2; ++ai)
#pragma unroll
            for (int m = 0; m < 4; ++m) { bf16_t* rowp = base + (size_t)(row0 + ai * HALF + m * 16) * ldc + col0;
#pragma unroll
                for (int bj = 0; bj < 2; ++bj) { f32x4 v0 = acc[ai][bj][m][0] + bv[bj][0], v1 = acc[ai][bj][m][1] + bv[bj][1];
                    if (ACT == 1) { f32x2 a = gelu_pk((f32x2){v0[0], v0[1]}), b = gelu_pk((f32x2){v0[2], v0[3]}), c = gelu_pk((f32x2){v1[0], v1[1]}), d = gelu_pk((f32x2){v1[2], v1[3]});
                        v0 = (f32x4){a.x, a.y, b.x, b.y}; v1 = (f32x4){c.x, c.y, d.x, d.y}; }
                    v0 = v0 * sc; v1 = v1 * sc; u32x4 w; w.x = cvt_pk_bf16(v0[0], v0[1]); w.y = cvt_pk_bf16(v0[2], v0[3]); w.z = cvt_pk_bf16(v1[0], v1[1]); w.w = cvt_pk_bf16(v1[2], v1[3]);
                    *(u32x4*)(rowp + bj * HALF) = w; } }
    }
};

struct PanelStats {
    unsigned* xbuf;
    unsigned* cnt;
    unsigned* tmo;
    int ntn; float eps;
    unsigned code;
    __device__ __forceinline__ bool run(const f32x4 (&v)[2][2][4][2], const Unit& u, int wr, int wc, int fr, int fq, PG8_LAS unsigned char* lds, int wid, int lane) const {
        typedef float f32x2v __attribute__((ext_vector_type(2)));
        PG8_LAS f32x2v* P = (PG8_LAS f32x2v*)lds;
        PG8_LAS f32x2v* S = (PG8_LAS f32x2v*)(lds + 8192);
        PG8_LAS unsigned* flag = (PG8_LAS unsigned*)(lds + 8192 + 2048);
#pragma unroll
        for (int ai = 0; ai < 2; ++ai)
#pragma unroll
            for (int m = 0; m < 4; ++m) {
                float s = 0.f;
#pragma unroll
                for (int bj = 0; bj < 2; ++bj)
#pragma unroll
                    for (int n = 0; n < 2; ++n) { const f32x4 x = v[ai][bj][m][n]; s += (x[0] + x[1]) + (x[2] + x[3]); }
                s += __shfl_xor(s, 16); s += __shfl_xor(s, 32);
                const float mw = s * (1.0f / 64.0f); float q = 0.f;
#pragma unroll
                for (int bj = 0; bj < 2; ++bj)
#pragma unroll
                    for (int n = 0; n < 2; ++n) { const f32x4 d = v[ai][bj][m][n] - mw; q += (d[0] * d[0] + d[1] * d[1]) + (d[2] * d[2] + d[3] * d[3]); }
                q += __shfl_xor(q, 16); q += __shfl_xor(q, 32);
                if (fq == 0) P[(ai * HALF + wr * 64 + m * 16 + fr) * 4 + wc] = (f32x2v){mw, q};
            }
        asm volatile("s_waitcnt lgkmcnt(0)" ::: "memory"); __builtin_amdgcn_s_barrier(); asm volatile("" ::: "memory");
#if defined(BROKEN_EXCHANGE_NO_WAIT)
#warning BROKEN CONTROL BUILD: the row-statistics exchange does not wait; results are wrong by design
        if (blockIdx.x >= 64) { const long long t0_ = clock64(); while (clock64() - t0_ < 60000) __builtin_amdgcn_s_sleep(8); }
#endif
        const int row = wid * 32 + (lane & 31);
        if (lane < 32) {
            const f32x2v a = P[row * 4 + 0], b = P[row * 4 + 1], c = P[row * 4 + 2], d = P[row * 4 + 3];
            const float mt = (a.x + b.x + c.x + d.x) * 0.25f;
            const float da = a.x - mt, db = b.x - mt, dc = c.x - mt, dd = d.x - mt;
            const float m2 = (a.y + b.y) + (c.y + d.y) + 64.0f * ((da * da + db * db) + (dc * dc + dd * dd));
            unsigned long long* slot = (unsigned long long*)xbuf + ((size_t)(u.pm * BM + row) * 4 + u.pn);
            __hip_atomic_store(slot, ((unsigned long long)__float_as_uint(m2) << 32) | __float_as_uint(mt), __ATOMIC_RELAXED, __HIP_MEMORY_SCOPE_AGENT);
        }
        asm volatile("s_waitcnt vmcnt(0)" ::: "memory");
        if (lane == 0) __hip_atomic_fetch_add(cnt + 64 * u.pm, 1u, __ATOMIC_RELAXED, __HIP_MEMORY_SCOPE_AGENT);
        if (wid == 0) {
            bool dead = false; const unsigned long long t0 = __builtin_amdgcn_s_memrealtime(); const unsigned want = 8u * (unsigned)ntn;
            for (;;) {
#if defined(BROKEN_EXCHANGE_NO_WAIT)
                break;
#endif
                if ((unsigned)__builtin_amdgcn_readfirstlane(__hip_atomic_load(cnt + 64 * u.pm, __ATOMIC_RELAXED, __HIP_MEMORY_SCOPE_AGENT)) >= want) break;
                if (__builtin_amdgcn_s_memrealtime() - t0 > 2000000ull) {
                    if (lane == 0) { unsigned expect = 0u; __hip_atomic_compare_exchange_strong(tmo + 1, &expect, code | (unsigned)(u.pm & 0xff), __ATOMIC_RELAXED, __ATOMIC_RELAXED, __HIP_MEMORY_SCOPE_AGENT);
                                     __hip_atomic_store(tmo, 1u, __ATOMIC_RELAXED, __HIP_MEMORY_SCOPE_AGENT); }
                    dead = true; break; }
                __builtin_amdgcn_s_sleep(2);
            }
            __builtin_amdgcn_fence(__ATOMIC_ACQUIRE, "agent");
            if (lane == 0) flag[0] = dead ? 1u : 0u;
        }
        asm volatile("s_waitcnt vmcnt(0) lgkmcnt(0)" ::: "memory"); __builtin_amdgcn_s_barrier(); asm volatile("" ::: "memory");
        const bool bad = flag[0] != 0u;
        if (lane < 32) {
            const unsigned long long* slot = (const unsigned long long*)xbuf + (size_t)(u.pm * BM + row) * 4; float mt[4], m2[4]; float ms = 0.f;
#pragma unroll
            for (int t = 0; t < 4; ++t) { if (t < ntn) { const unsigned long long w = __hip_atomic_load(slot + t, __ATOMIC_RELAXED, __HIP_MEMORY_SCOPE_AGENT); mt[t] = __uint_as_float((unsigned)w); m2[t] = __uint_as_float((unsigned)(w >> 32)); } else { mt[t] = 0.f; m2[t] = 0.f; } ms += mt[t]; }
            const float mean = ms / (float)ntn; float q = 0.f;
#pragma unroll
            for (int t = 0; t < 4; ++t) if (t < ntn) { const float dm = mt[t] - mean; q += m2[t] + 256.0f * dm * dm; }
            S[row] = (f32x2v){mean, 1.0f / sqrtf(q / (256.0f * (float)ntn) + eps)};
        }
        asm volatile("s_waitcnt lgkmcnt(0)" ::: "memory"); __builtin_amdgcn_s_barrier(); asm volatile("" ::: "memory");
        return bad;
    }
};
struct EpiLnRes {
    static constexpr bool PERM = false, AFTER_DRAIN = true;
    const float* base; float* out; int ldc; const float* bias; PanelStats st; unsigned poison;
    __device__ __forceinline__ void fused(f32x4 (&acc)[2][2][4][2], const Unit& u, int wr, int wc, int fr, int fq, PG8_LAS unsigned char* lds, int wid, int lane) const {
        typedef float f32x2v __attribute__((ext_vector_type(2)));
        const PG8_LAS f32x2v* S = (const PG8_LAS f32x2v*)(lds + 8192);
        const int col0 = u.pn * BM + wc * 32 + 4 * fq;
#pragma unroll
        for (int bj = 0; bj < 2; ++bj)
#pragma unroll
            for (int n = 0; n < 2; ++n) { const f32x4 bv = bias ? *(const f32x4*)(bias + col0 + bj * HALF + n * 16) : (f32x4){0.f, 0.f, 0.f, 0.f};
#pragma unroll
                for (int ai = 0; ai < 2; ++ai)
#pragma unroll
                    for (int m = 0; m < 4; ++m) acc[ai][bj][m][n] += bv; }
        f32x4 pre[4][2][2];
#pragma unroll
        for (int m = 0; m < 4; ++m) { const size_t off = (size_t)(u.pm * BM + wr * 64 + m * 16 + fr) * ldc + col0;
#pragma unroll
            for (int bj = 0; bj < 2; ++bj)
#pragma unroll
                for (int n = 0; n < 2; ++n) pre[m][bj][n] = *(const f32x4*)(base + off + bj * HALF + n * 16); }
        const bool bad = st.run(acc, u, wr, wc, fr, fq, lds, wid, lane) || poison != 0u;
        const float qnan = __builtin_nanf("");
#pragma unroll
        for (int ai = 0; ai < 2; ++ai)
#pragma unroll
            for (int m = 0; m < 4; ++m) { const int r = ai * HALF + wr * 64 + m * 16 + fr; const f32x2v sr = S[r]; const size_t off = (size_t)(u.pm * BM + r) * ldc + col0;
#pragma unroll
                for (int bj = 0; bj < 2; ++bj)
#pragma unroll
                    for (int n = 0; n < 2; ++n) { const f32x4 bs = ai == 0 ? pre[m][bj][n] : *(const f32x4*)(base + off + bj * HALF + n * 16); f32x4 o = bs + (acc[ai][bj][m][n] - sr.x) * sr.y;
                        if (bad) o = (f32x4){qnan, qnan, qnan, qnan}; *(f32x4*)(out + off + bj * HALF + n * 16) = o; }
                if (m & 1) asm volatile("" ::: "memory"); }
    }
};
struct EpiLnResLn {
    static constexpr bool PERM = false, AFTER_DRAIN = true;
    const float* base; float* out; bf16_t* xn; int ldc; const float* bias; PanelStats st1, st2; unsigned poison;
    __device__ __forceinline__ void fused(f32x4 (&acc)[2][2][4][2], const Unit& u, int wr, int wc, int fr, int fq, PG8_LAS unsigned char* lds, int wid, int lane) const {
        typedef float f32x2v __attribute__((ext_vector_type(2))); typedef unsigned u32x2v __attribute__((ext_vector_type(2)));
        const PG8_LAS f32x2v* S = (const PG8_LAS f32x2v*)(lds + 8192);
        const int col0 = u.pn * BM + wc * 32 + 4 * fq;
#pragma unroll
        for (int bj = 0; bj < 2; ++bj)
#pragma unroll
            for (int n = 0; n < 2; ++n) { const f32x4 bv = bias ? *(const f32x4*)(bias + col0 + bj * HALF + n * 16) : (f32x4){0.f, 0.f, 0.f, 0.f};
#pragma unroll
                for (int ai = 0; ai < 2; ++ai)
#pragma unroll
                    for (int m = 0; m < 4; ++m) acc[ai][bj][m][n] += bv; }
        bool bad = st1.run(acc, u, wr, wc, fr, fq, lds, wid, lane) || poison != 0u;
        const float qnan = __builtin_nanf("");
#pragma unroll
        for (int ai = 0; ai < 2; ++ai)
#pragma unroll
            for (int m = 0; m < 4; ++m) { const int r = ai * HALF + wr * 64 + m * 16 + fr; const f32x2v sr = S[r]; const size_t off = (size_t)(u.pm * BM + r) * ldc + col0;
#pragma unroll
                for (int bj = 0; bj < 2; ++bj)
#pragma unroll
                    for (int n = 0; n < 2; ++n) { const f32x4 bs = *(const f32x4*)(base + off + bj * HALF + n * 16); acc[ai][bj][m][n] = bs + (acc[ai][bj][m][n] - sr.x) * sr.y; }
                asm volatile("" : "+v"(acc[ai][0][m][0]), "+v"(acc[ai][0][m][1]), "+v"(acc[ai][1][m][0]), "+v"(acc[ai][1][m][1]));
                if (m & 1) asm volatile("" ::: "memory"); }
        const bool bad1 = bad;
        bad = st2.run(acc, u, wr, wc, fr, fq, lds, wid, lane) || bad;
#pragma unroll
        for (int ai = 0; ai < 2; ++ai)
#pragma unroll
            for (int m = 0; m < 4; ++m) { const int r = ai * HALF + wr * 64 + m * 16 + fr; const f32x2v sr = S[r]; const size_t off = (size_t)(u.pm * BM + r) * ldc + col0;
#pragma unroll
                for (int bj = 0; bj < 2; ++bj)
#pragma unroll
                    for (int n = 0; n < 2; ++n) { const f32x4 x1 = acc[ai][bj][m][n]; *(f32x4*)(out + off + bj * HALF + n * 16) = bad1 ? (f32x4){qnan, qnan, qnan, qnan} : x1;
                        const f32x4 o = (x1 - sr.x) * sr.y; u32x2v w; w.x = cvt_pk_bf16(o[0], o[1]); w.y = cvt_pk_bf16(o[2], o[3]);
                        if (bad) { w.x = 0x7fc07fc0u; w.y = 0x7fc07fc0u; } *(u32x2v*)(xn + off + bj * HALF + n * 16) = w; }
                asm volatile("" ::: "memory"); }
    }
};

template <class Epi, class Sched, bool ALIGN_EPI = false, bool SP2 = false>
__device__ __forceinline__ void gemm_phase(PG8_LAS unsigned char* lds, const Gemm g, const Sched& S, const Epi& E, int wave_s_) {
    int tid = MK_TID(wave_s_); asm volatile("" : "+v"(tid));
    const int wid = __builtin_amdgcn_readfirstlane(tid >> 6), lane = tid & 63, wr = wid >> 2, wc = wid & 3, fr = lane & 15, fq = lane >> 4;
    const int K = g.K, nt_def = K / BK;
    unsigned voffA[2], voffB[2];
#pragma unroll
    for (int i = 0; i < 2; ++i) { int R, C; stage_rc(tid * 16 + i * 8192, R, C); const int Rb = Epi::PERM ? ((R & ~31) + perm32(R & 31)) : R;
        voffA[i] = (unsigned)(R * g.ld + C) * 2u; voffB[i] = (unsigned)(Rb * g.ld + C) * 2u; }
    const size_t kstep = (size_t)(BK * 2);
    const size_t hstep = (size_t)HALF * g.ld * 2;
    const size_t tstep = 2 * hstep;
    const unsigned ldsw = (unsigned)wid * 1024u;
    const int aoff = lds_byte(wr * 64 + fr, fq * 8), boff = lds_byte(wc * 32 + fr, fq * 8);
#define PG8_SA(b, h) (((b) * 2 + (h)) * HTB)
#define PG8_SB(b, h) ((4 + (b) * 2 + (h)) * HTB)
#define PG8_STAGE(bufoff, gbase, voff) do { _Pragma("unroll") for (int _i = 0; _i < 2; ++_i) \
        __builtin_amdgcn_global_load_lds((const unsigned*)((const char*)(gbase) + (voff)[_i]), (PG8_LAS unsigned*)(lds + (bufoff) + ldsw + _i * 8192), 16, 0, 0); } while (0)
#define PG8_LDA(dst, b, h) do { _Pragma("unroll") for (int m = 0; m < 4; ++m) _Pragma("unroll") for (int k = 0; k < 2; ++k) dst[m][k] = *(const PG8_LAS bf16x8*)(lds + PG8_SA(b, h) + aoff + m * 2048 + k * 1024); } while (0)
#define PG8_LDB(dst, b, h) do { _Pragma("unroll") for (int n = 0; n < 2; ++n) _Pragma("unroll") for (int k = 0; k < 2; ++k) dst[n][k] = *(const PG8_LAS bf16x8*)(lds + PG8_SB(b, h) + boff + n * 2048 + k * 1024); } while (0)
#define PG8_MMA(ai, bj, At, Bt) do { __builtin_amdgcn_s_setprio(1); _Pragma("unroll") for (int m = 0; m < 4; ++m) _Pragma("unroll") for (int n = 0; n < 2; ++n) _Pragma("unroll") for (int k = 0; k < 2; ++k) \
        acc[ai][bj][m][n] = __builtin_amdgcn_mfma_f32_16x16x32_bf16(Bt[n][k], At[m][k], acc[ai][bj][m][n], 0, 0, 0); __builtin_amdgcn_s_setprio(0); } while (0)
#define PG8_WAIT_V(n) asm volatile("s_waitcnt vmcnt(" #n ")" ::: "memory")
#define PG8_WAIT_L(n) asm volatile("s_waitcnt lgkmcnt(" #n ")" ::: "memory")
#define PG8_BAR __builtin_amdgcn_s_barrier()
#define PG8_SCHED __builtin_amdgcn_sched_barrier(0)
    Unit cur, nxt; int ui = 0;
    if (!S.next(0, cur)) return;
    f32x4 acc[2][2][4][2];
#pragma unroll
    for (int a = 0; a < 2; ++a)
#pragma unroll
        for (int b = 0; b < 2; ++b)
#pragma unroll
            for (int m = 0; m < 4; ++m)
#pragma unroll
                for (int n = 0; n < 2; ++n) acc[a][b][m][n] = (f32x4){0.f, 0.f, 0.f, 0.f};
    bf16x8 At[4][2], B0[2][2], B1[2][2];
    const char* cA = (const char*)g.A + (size_t)cur.pm * tstep + (size_t)cur.koff * 2; const char* cB = (const char*)g.Bt + (size_t)cur.pn * tstep + (size_t)cur.boff * 2;
    S.a_ready(cur);
    if constexpr (SP2) {
        PG8_STAGE(PG8_SB(0, 0), cB, voffB); PG8_STAGE(PG8_SB(0, 1), cB + hstep, voffB); PG8_STAGE(PG8_SA(0, 0), cA, voffA); PG8_STAGE(PG8_SA(0, 1), cA + hstep, voffA);
        if (wr == 1) PG8_BAR;
        PG8_WAIT_V(2); PG8_BAR;
        PG8_STAGE(PG8_SB(1, 0), cB + kstep, voffB); PG8_STAGE(PG8_SA(1, 0), cA + kstep, voffA); PG8_STAGE(PG8_SB(1, 1), cB + hstep + kstep, voffB);
        PG8_WAIT_V(6); PG8_BAR;
    } else {
        PG8_STAGE(PG8_SB(0, 0), cB, voffB); PG8_STAGE(PG8_SA(0, 0), cA, voffA); PG8_STAGE(PG8_SB(0, 1), cB + hstep, voffB); PG8_STAGE(PG8_SA(0, 1), cA + hstep, voffA);
        if (wr == 1) PG8_BAR;
        PG8_WAIT_V(4); PG8_BAR;
        PG8_STAGE(PG8_SB(1, 0), cB + kstep, voffB); PG8_STAGE(PG8_SA(1, 0), cA + kstep, voffA); PG8_STAGE(PG8_SB(1, 1), cB + hstep + kstep, voffB);
        PG8_WAIT_V(6); PG8_BAR;
    }
    for (;;) {
        const bool has_next = S.next(ui + 1, nxt);
        const char* nA = has_next ? (const char*)g.A + (size_t)nxt.pm * tstep + (size_t)nxt.koff * 2 : cA; const char* nB = has_next ? (const char*)g.Bt + (size_t)nxt.pn * tstep + (size_t)nxt.boff * 2 : cB;
        const int nt = cur.ntile() ? cur.ntile() : nt_def;
        for (int t = 0; t < nt; t += 2) {
            const bool last = (t == nt - 2);
            const char* a1 = cA + (size_t)(t + 1) * kstep;
            const char* a2 = last ? nA : cA + (size_t)(t + 2) * kstep; const char* b2 = last ? nB : cB + (size_t)(t + 2) * kstep;
            const char* a3 = a2 + kstep; const char* b3 = b2 + kstep;
            if (last && has_next) S.a_ready(nxt);
            if constexpr (SP2) {
            PG8_LDB(B0, 0, 0); PG8_LDB(B1, 0, 1); PG8_SCHED; PG8_LDA(At, 0, 0); PG8_STAGE(PG8_SA(1, 1), a1 + hstep, voffA);
            PG8_WAIT_V(8); PG8_WAIT_L(0); PG8_BAR; PG8_MMA(0, 0, At, B0); PG8_MMA(0, 1, At, B1); PG8_BAR; PG8_SCHED;
            PG8_LDA(At, 0, 1); PG8_STAGE(PG8_SB(0, 0), b2, voffB); PG8_STAGE(PG8_SB(0, 1), b2 + hstep, voffB); PG8_STAGE(PG8_SA(0, 0), a2, voffA);
            PG8_WAIT_V(8); PG8_WAIT_L(0); PG8_BAR; PG8_MMA(1, 0, At, B0); PG8_MMA(1, 1, At, B1); PG8_BAR; PG8_SCHED;
            PG8_LDB(B0, 1, 0); PG8_LDB(B1, 1, 1); PG8_SCHED; PG8_LDA(At, 1, 0); PG8_STAGE(PG8_SA(0, 1), a2 + hstep, voffA);
            PG8_WAIT_V(8); PG8_WAIT_L(0); PG8_BAR; PG8_MMA(0, 0, At, B0); PG8_MMA(0, 1, At, B1); PG8_BAR; PG8_SCHED;
            PG8_LDA(At, 1, 1); PG8_STAGE(PG8_SB(1, 0), b3, voffB); PG8_STAGE(PG8_SB(1, 1), b3 + hstep, voffB); PG8_STAGE(PG8_SA(1, 0), a3, voffA);
            PG8_WAIT_V(8); PG8_WAIT_L(0); PG8_BAR; PG8_MMA(1, 0, At, B0); PG8_MMA(1, 1, At, B1); PG8_BAR; PG8_SCHED;
            } else {
            PG8_LDB(B0, 0, 0); PG8_SCHED; PG8_LDA(At, 0, 0); PG8_STAGE(PG8_SA(1, 1), a1 + hstep, voffA);
            PG8_WAIT_L(8); PG8_BAR; PG8_WAIT_L(0); PG8_MMA(0, 0, At, B0); PG8_BAR; PG8_SCHED;
            PG8_LDB(B1, 0, 1); PG8_STAGE(PG8_SB(0, 0), b2, voffB);
            PG8_BAR; PG8_WAIT_L(0); PG8_MMA(0, 1, At, B1); PG8_BAR;
            PG8_LDA(At, 0, 1); PG8_STAGE(PG8_SA(0, 0), a2, voffA);
            PG8_BAR; PG8_WAIT_L(0); PG8_MMA(1, 0, At, B0); PG8_BAR; PG8_SCHED;
            PG8_STAGE(PG8_SB(0, 1), b2 + hstep, voffB);
            PG8_WAIT_V(6); PG8_BAR; PG8_MMA(1, 1, At, B1); PG8_BAR;
            PG8_LDB(B0, 1, 0); PG8_SCHED; PG8_LDA(At, 1, 0); PG8_STAGE(PG8_SA(0, 1), a2 + hstep, voffA);
            PG8_WAIT_L(8); PG8_BAR; PG8_WAIT_L(0); PG8_MMA(0, 0, At, B0); PG8_BAR; PG8_SCHED;
            PG8_LDB(B1, 1, 1); PG8_STAGE(PG8_SB(1, 0), b3, voffB);
            PG8_BAR; PG8_WAIT_L(0); PG8_MMA(0, 1, At, B1); PG8_BAR;
            PG8_LDA(At, 1, 1); PG8_STAGE(PG8_SA(1, 0), a3, voffA);
            PG8_BAR; PG8_WAIT_L(0); PG8_MMA(1, 0, At, B0); PG8_BAR; PG8_SCHED;
            PG8_STAGE(PG8_SB(1, 1), b3 + hstep, voffB);
            PG8_WAIT_V(6); PG8_BAR; PG8_MMA(1, 1, At, B1); PG8_BAR;
            }
        }
        if constexpr (ALIGN_EPI) { if (wr == 0) PG8_BAR; }
        if constexpr (!Epi::AFTER_DRAIN) { E(acc, cur, wr, wc, fr, fq); S.done(cur); }
        if (!has_next) break;
        if (!nxt.carry()) {
#pragma unroll
        for (int a = 0; a < 2; ++a)
#pragma unroll
            for (int b = 0; b < 2; ++b)
#pragma unroll
                for (int m = 0; m < 4; ++m)
#pragma unroll
                    for (int n = 0; n < 2; ++n) acc[a][b][m][n] = (f32x4){0.f, 0.f, 0.f, 0.f};
        }
        cur = nxt; cA = nA; cB = nB; ++ui;
        if constexpr (ALIGN_EPI) { if (wr == 1) PG8_BAR; }
    }
    PG8_WAIT_V(0);
    if constexpr (!ALIGN_EPI) { if (wr == 0) PG8_BAR; }
    PG8_BAR;
    if constexpr (Epi::AFTER_DRAIN) { E.fused(acc, cur, wr, wc, fr, fq, lds, wid, lane); S.done(cur); }
#undef PG8_SA
#undef PG8_SB
#undef PG8_STAGE
#undef PG8_LDA
#undef PG8_LDB
#undef PG8_MMA
#undef PG8_WAIT_V
#undef PG8_WAIT_L
#undef PG8_BAR
#undef PG8_SCHED
}
}

__device__ __forceinline__ float shfl_xor_f(float v, int o) { return __uint_as_float((unsigned)__builtin_amdgcn_ds_bpermute((mk_lane_id() ^ o) << 2, (int)__float_as_uint(v))); }
namespace attn128 {
using bf16 = __hip_bfloat16;
constexpr int D = 128, NW = 8, QBLK = 32, KVBLK = 64;
constexpr float SCALE = 0.088388347648318440f;
constexpr float THR = 8.f;
constexpr int SDEPTH = 2;
constexpr int LDQ = 1024, LDK = 1024, LDO = 1024;
constexpr size_t SHM_V = KVBLK * D * 2, SHM_K = KVBLK * D * 2, SHM_ATTN = 2 * SHM_V + 2 * SHM_K + NW * 64 * 4;
using bf16x8 = __attribute__((ext_vector_type(8))) short;
using s16x4  = __attribute__((ext_vector_type(4))) short;
using f32x16 = __attribute__((ext_vector_type(16))) float;
using f32x8  = __attribute__((ext_vector_type(8))) float;
using u32x4  = __attribute__((ext_vector_type(4))) unsigned;
#define KSWZ(row, colB) ((row) * 256 + ((colB) ^ (((row) & 7) << 4)))
#define SBAR() __builtin_amdgcn_sched_barrier(0)
__device__ __forceinline__ int crow(int r, int hi) { return (r & 3) + 8 * (r >> 2) + 4 * hi; }
__device__ __forceinline__ unsigned cvtpk(float lo, float hi) {
  unsigned r; asm volatile("v_cvt_pk_bf16_f32 %0, %1, %2" : "=v"(r) : "v"(lo), "v"(hi)); return r;
}
template <typename TIn> struct Stage;
template <> struct Stage<bf16>  { using T = bf16x8;
  __device__ static __forceinline__ T ld8(const bf16* p) { return *reinterpret_cast<const bf16x8*>(p); }
  __device__ static __forceinline__ bf16x8 tobf(T x) { return x; } };
template <> struct Stage<float> { using T = f32x8;
  __device__ static __forceinline__ T ld8(const float* p) { return *reinterpret_cast<const f32x8*>(p); }
  __device__ static __forceinline__ bf16x8 tobf(T x) {
    u32x4 w = {cvtpk(x[0], x[1]), cvtpk(x[2], x[3]), cvtpk(x[4], x[5]), cvtpk(x[6], x[7])}; return *reinterpret_cast<bf16x8*>(&w); } };

__device__ __forceinline__ void partialSM(f32x16& p0, f32x16& p1, float& m_reg, float& mn, float& alpha) {
  constexpr float C = SCALE * 1.4426950408889634f;
  float pmax = p0[0]; for (int r = 1; r < 16; ++r) pmax = fmaxf(pmax, p0[r]); for (int r = 0; r < 16; ++r) pmax = fmaxf(pmax, p1[r]);
  { auto rr = __builtin_amdgcn_permlane32_swap(__float_as_uint(pmax), __float_as_uint(pmax), false, false);
    pmax = fmaxf(__uint_as_float(rr[0]), __uint_as_float(rr[1])); }
  if (__builtin_expect(__all(pmax - m_reg <= THR / SCALE), 1)) { mn = m_reg; alpha = 1.f; }
  else { mn = fmaxf(m_reg, pmax); alpha = __builtin_amdgcn_exp2f((m_reg - mn) * C); m_reg = mn; }
  float mnC = -mn * C;
  for (int r = 0; r < 16; ++r) p0[r] = fmaf(p0[r], C, mnC); for (int r = 0; r < 16; ++r) p1[r] = fmaf(p1[r], C, mnC);
  for (int r = 0; r < 16; ++r) p0[r] = __builtin_amdgcn_exp2f(p0[r]);
}
__device__ __forceinline__ void finishSM(f32x16& p0, f32x16& p1, float alpha, float& l_reg, bf16x8& pa0, bf16x8& pa1, bf16x8& pa2, bf16x8& pa3) {
  for (int r = 0; r < 16; ++r) p1[r] = __builtin_amdgcn_exp2f(p1[r]);
  float ps = 0; for (int r = 0; r < 16; ++r) ps += p0[r]; for (int r = 0; r < 16; ++r) ps += p1[r];
  { auto rr = __builtin_amdgcn_permlane32_swap(__float_as_uint(ps), __float_as_uint(ps), false, false);
    ps = __uint_as_float(rr[0]) + __uint_as_float(rr[1]); }
  l_reg = l_reg * alpha + ps;
#define PK4(P, BASE, OUT) do { unsigned a0 = cvtpk(P[BASE + 0], P[BASE + 1]), a1 = cvtpk(P[BASE + 2], P[BASE + 3]);   \
    unsigned b0 = cvtpk(P[BASE + 4], P[BASE + 5]), b1 = cvtpk(P[BASE + 6], P[BASE + 7]);                              \
    auto r0 = __builtin_amdgcn_permlane32_swap(a0, b0, false, false); auto r1 = __builtin_amdgcn_permlane32_swap(a1, b1, false, false); \
    u32x4 w = {r0[0], r1[0], r0[1], r1[1]}; OUT = *reinterpret_cast<bf16x8*>(&w); } while (0)
  PK4(p0, 0, pa0); PK4(p0, 8, pa1); PK4(p1, 0, pa2); PK4(p1, 8, pa3);
#undef PK4
}
__device__ __forceinline__ void qkt(f32x16& p0, f32x16& p1, const bf16* Ks, const bf16x8* qr, int r32, int hi) {
  p0 = f32x16{}; p1 = f32x16{};
  for (int d0 = 0; d0 < 8; ++d0) { int cb = (d0 * 16 + hi * 8) * 2;
    bf16x8 b0 = *reinterpret_cast<const bf16x8*>((const char*)Ks + KSWZ(r32, cb));
    bf16x8 b1 = *reinterpret_cast<const bf16x8*>((const char*)Ks + KSWZ(32 + r32, cb));
    p0 = __builtin_amdgcn_mfma_f32_32x32x16_bf16(b0, qr[d0], p0, 0, 0, 0);
    p1 = __builtin_amdgcn_mfma_f32_32x32x16_bf16(b1, qr[d0], p1, 0, 0, 0); }
}
__device__ __forceinline__ int v_st(int k, int c) { const int kk = (k & ~0xC) | ((k & 4) << 1) | ((k & 8) >> 1); return ((kk >> 3) * 4 + (c >> 5)) * 512 + ((kk & 7) * 32 + (c & 31)) * 2; }
__device__ __forceinline__ int v_rd_base(int lane) { return ((lane & 3) << 3) | (((lane >> 2) & 3) << 6) | (((lane >> 4) & 1) << 5) | (((lane >> 5) & 1) << 8); }
constexpr int v_rd_off(int d0, int ks, int half) { return d0 * 512 + ks * 4096 + half * 2048; }
template <int OFF> __device__ __forceinline__ s16x4 tr_read(int vb) {
  s16x4 r; asm volatile("ds_read_b64_tr_b16 %0, %1 offset:%2" : "=&v"(r) : "v"(vb), "i"(OFF) : "memory"); return r;
}
template <int D0> __device__ __forceinline__ void pv_one(f32x16& od, int vb, bf16x8 pa0, bf16x8 pa1, bf16x8 pa2, bf16x8 pa3) {
  const s16x4 l0 = tr_read<v_rd_off(D0, 0, 0)>(vb), h0 = tr_read<v_rd_off(D0, 0, 1)>(vb), l1 = tr_read<v_rd_off(D0, 1, 0)>(vb), h1 = tr_read<v_rd_off(D0, 1, 1)>(vb);
  const s16x4 l2 = tr_read<v_rd_off(D0, 2, 0)>(vb), h2 = tr_read<v_rd_off(D0, 2, 1)>(vb), l3 = tr_read<v_rd_off(D0, 3, 0)>(vb), h3 = tr_read<v_rd_off(D0, 3, 1)>(vb);
  asm volatile("s_waitcnt lgkmcnt(0)" ::: "memory"); SBAR();
#define PK(L, H) (bf16x8){L[0], L[1], L[2], L[3], H[0], H[1], H[2], H[3]}
  od = __builtin_amdgcn_mfma_f32_32x32x16_bf16(pa0, PK(l0, h0), od, 0, 0, 0);
  od = __builtin_amdgcn_mfma_f32_32x32x16_bf16(pa1, PK(l1, h1), od, 0, 0, 0);
  od = __builtin_amdgcn_mfma_f32_32x32x16_bf16(pa2, PK(l2, h2), od, 0, 0, 0);
  od = __builtin_amdgcn_mfma_f32_32x32x16_bf16(pa3, PK(l3, h3), od, 0, 0, 0);
#undef PK
}
__device__ __forceinline__ void pv_d0(f32x16* o, int vb, bf16x8 pa0, bf16x8 pa1, bf16x8 pa2, bf16x8 pa3) {
  pv_one<0>(o[0], vb, pa0, pa1, pa2, pa3); pv_one<1>(o[1], vb, pa0, pa1, pa2, pa3); pv_one<2>(o[2], vb, pa0, pa1, pa2, pa3); pv_one<3>(o[3], vb, pa0, pa1, pa2, pa3);
}

template <typename TQ>
__device__ __forceinline__ void attn_dense_body(const TQ* __restrict__ Qb, const bf16* __restrict__ Kh, const bf16* __restrict__ Vh,
                                                float* __restrict__ Ob, int seq, char* lds, int wave_s_) {
  using St = Stage<bf16>; using SQ = Stage<TQ>;
  int tid = MK_TID(wave_s_); asm volatile("" : "+v"(tid));
  const int wid = tid >> 6, lane = tid & 63, r32 = lane & 31, hi = lane >> 5;
  bf16* V_lds = (bf16*)lds; bf16* K_lds = (bf16*)(lds + 2 * SHM_V);
  float* ws = (float*)(lds + 2 * SHM_V + 2 * SHM_K) + wid * 64; float* li_l = ws; float* al_l = ws + 32;
  float m_reg = -1e30f, l_reg = 0; f32x16 o[4] = {}; bf16x8 qr[8];
  const TQ* Qw = Qb + (long)(wid * QBLK + r32) * LDQ + hi * 8;
#pragma unroll
  for (int d0 = 0; d0 < 8; ++d0) qr[d0] = SQ::tobf(SQ::ld8(Qw + d0 * 16));
  const int sr = tid >> 4, sc = (tid & 15) * 8, vst0 = v_st(sr, sc), vst1 = v_st(32 + sr, sc);
  const int vb0 = (int)(uintptr_t)V_lds + v_rd_base(lane);
  struct { typename St::T vs0, vs1, ks0, ks1; } sr_[SDEPTH];
#define SLOAD(i, k0) do { sr_[i].vs0 = St::ld8(&Vh[(long)((k0) + sr) * LDK + sc]); sr_[i].vs1 = St::ld8(&Vh[(long)((k0) + 32 + sr) * LDK + sc]); \
    sr_[i].ks0 = St::ld8(&Kh[(long)((k0) + sr) * LDK + sc]); sr_[i].ks1 = St::ld8(&Kh[(long)((k0) + 32 + sr) * LDK + sc]); } while (0)
#define SWRITE(b, i) do { *(bf16x8*)((char*)V_lds + (b) * SHM_V + vst0) = St::tobf(sr_[i].vs0);          \
    *(bf16x8*)((char*)V_lds + (b) * SHM_V + vst1) = St::tobf(sr_[i].vs1); int kc = sc * 2;               \
    *(bf16x8*)((char*)K_lds + (b) * SHM_K + KSWZ(sr, kc)) = St::tobf(sr_[i].ks0);                       \
    *(bf16x8*)((char*)K_lds + (b) * SHM_K + KSWZ(32 + sr, kc)) = St::tobf(sr_[i].ks1); } while (0)
#define SWAIT() do { if constexpr (SDEPTH == 2) asm volatile("s_waitcnt vmcnt(4)" ::: "memory"); else asm volatile("s_waitcnt vmcnt(0)" ::: "memory"); } while (0)
#define RESC(a) do { if (__any((a) < 1.f)) { if (hi == 0) al_l[r32] = (a); asm volatile("s_waitcnt lgkmcnt(0)" ::: "memory"); \
    for (int d = 0; d < 4; ++d) for (int r = 0; r < 16; ++r) o[d][r] *= al_l[crow(r, hi)]; } } while (0)
  f32x16 pA0, pA1, pB0, pB1; float mnA, mnB, alA, alB; bf16x8 pa0, pa1, pa2, pa3; const int NT = seq / KVBLK;
  constexpr int SE = 0, SO = SDEPTH - 1;
  SLOAD(SE, 0); asm volatile("s_waitcnt vmcnt(0)" ::: "memory"); SWRITE(0, SE); __syncthreads();
  qkt(pA0, pA1, K_lds, qr, r32, hi); partialSM(pA0, pA1, m_reg, mnA, alA);
  SLOAD(SO, KVBLK); if constexpr (SDEPTH == 2) { if (2 < NT) SLOAD(SE, 2 * KVBLK); }
  SWAIT(); SWRITE(1, SO); __syncthreads();
  for (int j = 1; j + 1 < NT; j += 2) {
    SBAR(); qkt(pB0, pB1, (bf16*)((char*)K_lds + SHM_K), qr, r32, hi);
    finishSM(pA0, pA1, alA, l_reg, pa0, pa1, pa2, pa3); SBAR();
    SLOAD(SO, (j + SDEPTH) * KVBLK); SBAR();
    pv_d0(o, vb0, pa0, pa1, pa2, pa3); partialSM(pB0, pB1, m_reg, mnB, alB);
    __syncthreads(); SWAIT(); SWRITE(0, SE);
    RESC(alB); __syncthreads();
    SBAR(); qkt(pA0, pA1, K_lds, qr, r32, hi);
    finishSM(pB0, pB1, alB, l_reg, pa0, pa1, pa2, pa3); SBAR();
    if (SDEPTH == 1 || j + 3 < NT) SLOAD(SE, (j + 1 + SDEPTH) * KVBLK); SBAR();
    pv_d0(o, vb0 + (int)SHM_V, pa0, pa1, pa2, pa3); partialSM(pA0, pA1, m_reg, mnA, alA);
    __syncthreads(); SWAIT(); SWRITE(1, SO);
    RESC(alA); __syncthreads();
  }
  SBAR(); qkt(pB0, pB1, (bf16*)((char*)K_lds + SHM_K), qr, r32, hi);
  finishSM(pA0, pA1, alA, l_reg, pa0, pa1, pa2, pa3); SBAR();
  pv_d0(o, vb0, pa0, pa1, pa2, pa3); partialSM(pB0, pB1, m_reg, mnB, alB);
  __syncthreads(); RESC(alB);
  finishSM(pB0, pB1, alB, l_reg, pa0, pa1, pa2, pa3); SBAR();
  pv_d0(o, vb0 + (int)SHM_V, pa0, pa1, pa2, pa3);
  if (hi == 0) li_l[r32] = l_reg; asm volatile("s_waitcnt lgkmcnt(0)" ::: "memory");
  float rli[16];
#pragma unroll
  for (int r = 0; r < 16; ++r) rli[r] = __builtin_amdgcn_rcpf(li_l[crow(r, hi)]);
  float* Ow = Ob + (long)(wid * QBLK) * LDO;
#pragma unroll
  for (int r = 0; r < 16; ++r) { int orow = crow(r, hi);
    for (int d0 = 0; d0 < 4; ++d0) Ow[(long)orow * LDO + d0 * 32 + r32] = o[d0][r] * rli[r]; }
#undef SLOAD
#undef SWRITE
#undef SWAIT
#undef RESC
}

}

namespace attn256 {
using namespace attn128;
constexpr size_t SHM_V2 = KVBLK * 256 * 2, SHM_K2 = KVBLK * D * 2;
constexpr int LDV = 1024;
__device__ __forceinline__ int v_st2(int k, int c) { const int kk = (k & ~0xC) | ((k & 4) << 1) | ((k & 8) >> 1); return ((kk >> 3) * 8 + (c >> 5)) * 512 + ((kk & 7) * 32 + (c & 31)) * 2; }
constexpr int v_rd_off2(int d0, int ks, int half) { return d0 * 512 + ks * 8192 + half * 4096; }
typedef __attribute__((address_space(3))) s16x4 lds_s16x4_t;
template <int OFF> __device__ __forceinline__ s16x4 tr_read_b(int vb) { return __builtin_amdgcn_ds_read_tr16_b64_v4i16((lds_s16x4_t*)(unsigned long)(unsigned)(vb + OFF)); }
template <int D0> __device__ __forceinline__ void pv_one2(f32x16& od, int vb, bf16x8 pa0, bf16x8 pa1, bf16x8 pa2, bf16x8 pa3) {
  const s16x4 l0 = tr_read_b<v_rd_off2(D0, 0, 0)>(vb), h0 = tr_read_b<v_rd_off2(D0, 0, 1)>(vb), l1 = tr_read_b<v_rd_off2(D0, 1, 0)>(vb), h1 = tr_read_b<v_rd_off2(D0, 1, 1)>(vb);
  const s16x4 l2 = tr_read_b<v_rd_off2(D0, 2, 0)>(vb), h2 = tr_read_b<v_rd_off2(D0, 2, 1)>(vb), l3 = tr_read_b<v_rd_off2(D0, 3, 0)>(vb), h3 = tr_read_b<v_rd_off2(D0, 3, 1)>(vb);
  SBAR();
#define PK(L, H) (bf16x8){L[0], L[1], L[2], L[3], H[0], H[1], H[2], H[3]}
  od = __builtin_amdgcn_mfma_f32_32x32x16_bf16(pa0, PK(l0, h0), od, 0, 0, 0);
  od = __builtin_amdgcn_mfma_f32_32x32x16_bf16(pa1, PK(l1, h1), od, 0, 0, 0);
  od = __builtin_amdgcn_mfma_f32_32x32x16_bf16(pa2, PK(l2, h2), od, 0, 0, 0);
  od = __builtin_amdgcn_mfma_f32_32x32x16_bf16(pa3, PK(l3, h3), od, 0, 0, 0);
#undef PK
}
__device__ __forceinline__ void attn_o256_body(const bf16* __restrict__ Qb, const bf16* __restrict__ Kh, const bf16* __restrict__ Vh, float* __restrict__ Ob, int seq, char* lds, int wave_s_) {
  using St = Stage<bf16>;
  int tid = MK_TID(wave_s_); asm volatile("" : "+v"(tid));
  const int wid = tid >> 6, lane = tid & 63, r32 = lane & 31, hi = lane >> 5;
  bf16* V_lds = (bf16*)lds; bf16* K_lds = (bf16*)(lds + 2 * SHM_V2);
  float* ws = (float*)(lds + 2 * SHM_V2 + 2 * SHM_K2) + wid * 64; float* li_l = ws; float* al_l = ws + 32;
  float m_reg = -1e30f, l_reg = 0; f32x16 o[8] = {}; bf16x8 qr[8];
  const bf16* Qw = Qb + (long)(wid * QBLK + r32) * LDQ + hi * 8;
#pragma unroll
  for (int d0 = 0; d0 < 8; ++d0) qr[d0] = St::ld8(Qw + d0 * 16);
  const int vb0 = (int)(uintptr_t)V_lds + v_rd_base(lane);
  bf16x8 sv00, sv01, sv10, sv11, sk0, sk1;
#define SLOAD2(k0) do { const int t_ = MK_TID(wave_s_), sr = t_ >> 4, sc = (t_ & 15) * 8; const bf16* vp = Vh + (long)((k0) + sr) * LDV + sc; const bf16* kp = Kh + (long)((k0) + sr) * LDK + sc; \
    sv00 = St::ld8(vp); sv01 = St::ld8(vp + 128); sv10 = St::ld8(vp + 32 * LDV); sv11 = St::ld8(vp + 32 * LDV + 128); sk0 = St::ld8(kp); sk1 = St::ld8(kp + 32 * LDK); } while (0)
#define SWRITE2(b) do { const int t_ = MK_TID(wave_s_), sr = t_ >> 4, sc = (t_ & 15) * 8; char* vbuf = (char*)V_lds + (b) * SHM_V2 + v_st2(sr, sc); \
    *(bf16x8*)(vbuf) = sv00; *(bf16x8*)(vbuf + 2048) = sv01; *(bf16x8*)(vbuf + 16384) = sv10; *(bf16x8*)(vbuf + 18432) = sv11; \
    char* kbuf = (char*)K_lds + (b) * SHM_K2 + KSWZ(sr, sc * 2); *(bf16x8*)(kbuf) = sk0; *(bf16x8*)(kbuf + 8192) = sk1; } while (0)
  const int NT = seq / KVBLK;
  SLOAD2(0); asm volatile("s_waitcnt vmcnt(0)" ::: "memory"); SWRITE2(0); __syncthreads();
  for (int j = 0; j < NT; ++j) {
    const int b = j & 1;
    f32x16 p0, p1; float mn, al; bf16x8 pa0, pa1, pa2, pa3;
    SBAR(); qkt(p0, p1, (bf16*)((char*)K_lds + b * SHM_K2), qr, r32, hi);
    partialSM(p0, p1, m_reg, mn, al);
    finishSM(p0, p1, al, l_reg, pa0, pa1, pa2, pa3); SBAR();
    if (__any(al < 1.f)) { if (hi == 0) al_l[r32] = al; asm volatile("s_waitcnt lgkmcnt(0)" ::: "memory");
#pragma unroll
      for (int d = 0; d < 8; ++d)
#pragma unroll
        for (int r = 0; r < 16; ++r) o[d][r] *= al_l[crow(r, hi)]; }
    if (j + 1 < NT) SLOAD2((j + 1) * KVBLK);
    SBAR();
    { const int vb = vb0 + b * (int)SHM_V2;
      pv_one2<0>(o[0], vb, pa0, pa1, pa2, pa3); pv_one2<1>(o[1], vb, pa0, pa1, pa2, pa3); pv_one2<2>(o[2], vb, pa0, pa1, pa2, pa3); pv_one2<3>(o[3], vb, pa0, pa1, pa2, pa3);
      pv_one2<4>(o[4], vb, pa0, pa1, pa2, pa3); pv_one2<5>(o[5], vb, pa0, pa1, pa2, pa3); pv_one2<6>(o[6], vb, pa0, pa1, pa2, pa3); pv_one2<7>(o[7], vb, pa0, pa1, pa2, pa3); }
    if (j + 1 < NT) { asm volatile("s_waitcnt vmcnt(0)" ::: "memory"); SWRITE2(b ^ 1); }
    __syncthreads();
  }
  if (hi == 0) li_l[r32] = l_reg; asm volatile("s_waitcnt lgkmcnt(0)" ::: "memory");
  float rli[16];
#pragma unroll
  for (int r = 0; r < 16; ++r) rli[r] = __builtin_amdgcn_rcpf(li_l[crow(r, hi)]);
  float* Ow = Ob + (long)(wid * QBLK) * LDO;
#pragma unroll
  for (int r = 0; r < 16; ++r) { const int orow = crow(r, hi);
#pragma unroll
    for (int d0 = 0; d0 < 8; ++d0) Ow[(long)orow * LDO + d0 * 32 + r32] = o[d0][r] * rli[r]; }
#undef SLOAD2
#undef SWRITE2
}
}

#define GAS __attribute__((address_space(1)))
#define LAS __attribute__((address_space(3)))
typedef unsigned short bf16;
typedef unsigned v4u __attribute__((ext_vector_type(4)));
typedef float f32x4 __attribute__((ext_vector_type(4)));
typedef short bf16x8 __attribute__((ext_vector_type(8)));
typedef GAS unsigned gu32;
typedef GAS unsigned long long gu64;
#define RLX_AGENT __ATOMIC_RELAXED, __HIP_MEMORY_SCOPE_AGENT
#define LDS_WAIT() asm volatile("s_waitcnt lgkmcnt(0)" ::: "memory")
#define VM_WAIT() asm volatile("s_waitcnt vmcnt(0)" ::: "memory")
__device__ __forceinline__ unsigned long long rt() { return __builtin_amdgcn_s_memrealtime(); }
__device__ __forceinline__ unsigned f2bf(float f) { unsigned u = __builtin_bit_cast(unsigned, f); return (u + 0x7fffu + ((u >> 16) & 1u)) >> 16; }
__device__ __forceinline__ unsigned pk2(float lo, float hi) { return f2bf(lo) | (f2bf(hi) << 16); }

#define XB_TMO      128
#define XB_XCNT(j)  (256  + 64 * (j))
#define XB_XSUB(j)  (1280 + 64 * (j))
#define XB_XGEN(j)  (2304 + 64 * (j))
#define XB_TOP      3328
#define XB_TOPGEN   3392
#define XCD_BAR_WORDS 3456
#define XB_SPIN_CAP (1u << 22)

__device__ __forceinline__ unsigned xb_ld(unsigned* p)              { return __hip_atomic_load(p, __ATOMIC_RELAXED, __HIP_MEMORY_SCOPE_AGENT); }
__device__ __forceinline__ unsigned xb_add(unsigned* p, unsigned v) { return __hip_atomic_fetch_add(p, v, __ATOMIC_RELAXED, __HIP_MEMORY_SCOPE_AGENT); }
__device__ __forceinline__ unsigned xb_xcc_id() { return (unsigned)__builtin_amdgcn_s_getreg((3 << 11) | 20) & 0xFu; }
#define XB_SPIN(cond, bar) do { unsigned _sp = 0; while (cond) { __builtin_amdgcn_s_sleep(1); \
    if ((++_sp & 255u) == 0u) { if (xb_ld(&(bar)[XB_TMO])) break; if (_sp > XB_SPIN_CAP) { atomicAdd(&(bar)[XB_TMO], 1u); break; } } } } while (0)

struct XcdBarrier {
    unsigned* bar; unsigned x;
    volatile LAS unsigned* st;
};

__device__ __forceinline__ XcdBarrier xcd_barrier_post(unsigned* bar, volatile LAS unsigned* st, int tid_) {
    XcdBarrier b; b.bar = bar; b.x = xb_xcc_id(); b.st = st;
    if (tid_ == 0) (void)xb_add(&bar[XB_XCNT(b.x)], 1u);
    return b;
}
__device__ __forceinline__ void xcd_barrier_complete(unsigned* bar, unsigned x, unsigned& nloc, unsigned& nx) {
    const unsigned G = gridDim.x * gridDim.y * gridDim.z;
    unsigned sum, cnt, mine, sp = 0u;
    for (;;) {
        sum = 0u; cnt = 0u; mine = 0u;
#pragma unroll
        for (unsigned j = 0; j < 16; ++j) { const unsigned c = xb_ld(&bar[XB_XCNT(j)]); sum += c; cnt += (c > 0u) ? 1u : 0u; mine = (j == x) ? c : mine; }
        if (sum == G) break;
        __builtin_amdgcn_s_sleep(1);
        if ((++sp & 255u) == 0u) { if (xb_ld(&bar[XB_TMO])) break; if (sp > XB_SPIN_CAP) { atomicAdd(&bar[XB_TMO], 1u); break; } }
    }
    nloc = mine > 0u ? mine : 1u; nx = cnt > 0u ? cnt : 1u;
}

__device__ __forceinline__ void xcd_barrier(const XcdBarrier& b, int tid_) {
    asm volatile("s_waitcnt vmcnt(0)" ::: "memory");
    __syncthreads();
    if (tid_ == 0) {
        unsigned* bar = b.bar;
        __builtin_amdgcn_s_waitcnt(0);
        unsigned nloc = b.st[0], nx = b.st[1];
        if (nloc == 0u) { xcd_barrier_complete(bar, b.x, nloc, nx); b.st[0] = nloc; b.st[1] = nx; }
        const unsigned old = xb_add(&bar[XB_XSUB(b.x)], 1u);
        const unsigned gen = old / nloc;
        if (old + 1u == (gen + 1u) * nloc) {
            __builtin_amdgcn_fence(__ATOMIC_RELEASE, "agent");
            asm volatile("s_waitcnt vmcnt(0)" ::: "memory");
            const unsigned og = xb_add(&bar[XB_TOP], 1u);
            const unsigned tg = og / nx;
            if (og + 1u == (tg + 1u) * nx) xb_add(&bar[XB_TOPGEN], 1u);
            else XB_SPIN(xb_ld(&bar[XB_TOPGEN]) == tg, bar);
            __builtin_amdgcn_fence(__ATOMIC_ACQUIRE, "agent");
            xb_add(&bar[XB_XGEN(b.x)], 1u);
            asm volatile("s_waitcnt vmcnt(0)" ::: "memory");
        } else {
            XB_SPIN(xb_ld(&bar[XB_XGEN(b.x)]) == gen, bar);
            __builtin_amdgcn_fence(__ATOMIC_ACQUIRE, "agent");
            asm volatile("s_waitcnt vmcnt(0)" ::: "memory");
        }
    }
    __syncthreads();
}

constexpr int DM = 4096, SEQ = 8192, CTXL = 256, MT = SEQ + CTXL, DEPTH = 4, FFND = 4096;
constexpr int NZ = 20480, INC = 20496, ADAR = 256, NMOD = 9 * DM;
constexpr int ZC_UV = 0, ZC_MQ = 2048, ZC_MK = 2560, ZC_MV = 3072, ZC_MO = 4096, ZC_AQ = 5120, ZC_AK = 6144, ZC_AV = 7168, ZC_MG = 8192;
constexpr float EPS = 1e-6f;
constexpr int NWAVES = 8, NTHR = 512;

constexpr size_t MiB = 1ull << 20;
constexpr size_t WS_CTL = 0, CTL_ZERO_BYTES = 1 * MiB;
constexpr size_t WS_MODTP = 1 * MiB;
constexpr size_t WS_MOD = WS_MODTP + 512 * 1024;
constexpr size_t WS_LAM = WS_MOD + (size_t)DEPTH * 2 * NMOD * 4;
constexpr size_t WS_WG16 = WS_LAM + 256;
constexpr size_t WS_ROPE = WS_WG16 + (size_t)DEPTH * 16 * DM * 4;
constexpr size_t WS_G16 = WS_ROPE + (size_t)2 * SEQ * 64 * 4;
constexpr size_t WS_XR = 9 * MiB;
constexpr size_t SZ_ROWS_F32 = (size_t)MT * DM * 4, SZ_ROWS_BF = (size_t)MT * DM * 2;
constexpr size_t WS_H = WS_XR + SZ_ROWS_F32;
constexpr size_t WS_GB = WS_H + SZ_ROWS_BF;
constexpr size_t WS_Z = WS_GB + SZ_ROWS_BF;
constexpr size_t WS_ATTO = WS_Z + (size_t)MT * NZ * 2;
constexpr size_t WS_MLH = WS_ATTO + (size_t)2 * MT * 1024 * 4;
constexpr size_t WS_YA = WS_MLH + (size_t)2 * MT * 1024 * 4;
constexpr size_t WS_YB = WS_YA + (size_t)MT * 1024 * 2;
constexpr size_t WS_YC = WS_YB + (size_t)MT * 1024 * 2;
constexpr size_t WS_YACC = WS_YC + (size_t)MT * 1024 * 2;
constexpr size_t WS_Y = WS_YACC + SZ_ROWS_F32;
constexpr size_t WS_W13T = WS_Y + SZ_ROWS_BF;
constexpr size_t WS_W2T = WS_W13T + (size_t)DEPTH * 2 * 8192 * 4096 * 2;
constexpr size_t WS_WINT = WS_W2T + (size_t)DEPTH * 2 * 4096 * 4096 * 2;
constexpr size_t WS_WBT = WS_WINT + (size_t)DEPTH * NZ * 4096 * 2;
constexpr size_t WS_WOT = WS_WBT + (size_t)DEPTH * 3 * 4096 * 1024 * 2;
constexpr size_t WS_CT = WS_WOT + (size_t)DEPTH * 4096 * 4096 * 2;
constexpr size_t WS_MSM = WS_CT + (size_t)8 * 66 * 32768 * 2;
constexpr size_t WS_SLAB = WS_MSM + 1 * MiB;
constexpr size_t WS_GWSB = WS_SLAB + (size_t)16 * 256 * DM * 4;
constexpr size_t WS_MS3 = WS_GWSB + (size_t)DEPTH * 8 * 128 * 128 * 2;
constexpr size_t WS_END = WS_MS3 + (size_t)3 * 256 * DM * 4;
static_assert(WS_G16 + (size_t)MT * 16 * 4 <= WS_XR, "small buffers fit below XR");
static_assert(WS_XR % 256 == 0 && WS_H % 256 == 0 && WS_Z % 256 == 0 && WS_W13T % 256 == 0, "alignment");

constexpr int CW_BAR = 4096;

constexpr int RING_OFF = 0, RING_BYTES = 131072;
constexpr int LDSCTL_OFF = 143360, MISC_OFF = LDSCTL_OFF + 320;
constexpr int LDS_BYTES = 147456;

constexpr int P_PRO0 = 0, P_PRO1 = 1, P_LAYER0 = 2;
constexpr int L_N1 = 0, L_W13A = 1, L_W2A = 2, L_N2 = 3, L_WIN = 4, L_MIX1 = 5, L_POST = 6, L_M3 = 7, L_MERGE = 8, L_WOUT = 9, L_N3 = 10, L_W13B = 11, L_W2B = 12, NPL = 13;
constexpr int P_FINAL = P_LAYER0 + DEPTH * NPL, NPH = P_FINAL + 1;

__device__ __forceinline__ float wave_sum(float v) {
#pragma unroll
    for (int o = 1; o < 64; o <<= 1) v += shfl_xor_f(v, o);
    return v;
}
__device__ __forceinline__ float bf2f(unsigned short b) { return __uint_as_float((unsigned)b << 16); }
__device__ __forceinline__ float bflo(unsigned w) { return __uint_as_float(w << 16); }
__device__ __forceinline__ float bfhi(unsigned w) { return __uint_as_float(w & 0xffff0000u); }
__device__ __forceinline__ float sigmoid_f(float x) { return 1.f / (1.f + __expf(-x)); }
__device__ __forceinline__ float silu_f(float x) { return x / (1.f + __expf(-x)); }
__device__ __forceinline__ float gelu_tanh_f(float x) { const float u = 0.7978845608028654f * (x + 0.044715f * x * x * x); return x / (1.f + __expf(-2.f * u)); }
__device__ __forceinline__ float lambda_init_f(int l) { return 0.8f - 0.6f * __expf(-0.3f * (float)l); }

namespace pg8 {
struct CtxSplitOrder {
    int c, G, n;
    const float* MS3; bf16_t* Yc; int wave_s_;
    __device__ __forceinline__ bool next(int i, Unit& u) const { const int L = i * G + c; if (L >= n) return false; u.pm = 0; u.pn = L >> 4; u.koff = (L & 15) * 256; u.boff = u.koff; u.fl = 0; return true; }
    __device__ __forceinline__ void a_ready(const Unit& u) const {
        if (MS3) {
            int t_ = MK_TID(wave_s_); asm volatile("" : "+v"(t_));
            const int r = t_ >> 1, c0 = u.koff + (t_ & 1) * 128;
            const float* p0 = MS3 + (size_t)r * DM + c0; bf16_t* yo = Yc + (size_t)r * DM + c0;
#pragma unroll 1
            for (int ib = 0; ib < 16; ib += 4) { f32x4 q[4][3][2];
#pragma unroll
                for (int i = 0; i < 4; ++i)
#pragma unroll
                    for (int sgm = 0; sgm < 3; ++sgm) { q[i][sgm][0] = *(const f32x4*)(p0 + (size_t)sgm * 256 * DM + 8 * (ib + i)); q[i][sgm][1] = *(const f32x4*)(p0 + (size_t)sgm * 256 * DM + 8 * (ib + i) + 4); }
                asm volatile("" ::: "memory");
#pragma unroll
                for (int i = 0; i < 4; ++i) { const f32x4 a0 = q[i][0][0] + q[i][1][0] + q[i][2][0], a1 = q[i][0][1] + q[i][1][1] + q[i][2][1];
                    u32x4 w; w.x = cvt_pk_bf16(a0[0], a0[1]); w.y = cvt_pk_bf16(a0[2], a0[3]); w.z = cvt_pk_bf16(a1[0], a1[1]); w.w = cvt_pk_bf16(a1[2], a1[3]); *(u32x4*)(yo + 8 * (ib + i)) = w; }
                asm volatile("" ::: "memory"); }
            asm volatile("s_waitcnt vmcnt(0)" ::: "memory");
            asm volatile("" ::: "memory"); __builtin_amdgcn_s_barrier(); asm volatile("" ::: "memory");
        }
    }
    __device__ __forceinline__ void done(const Unit&) const {}
};
struct ResidOrder {
    StaticOrder lat; int c, G, n;
    __device__ __forceinline__ bool next(int i, Unit& u) const {
        const int nl = lat.c < lat.nwg ? (lat.nwg - lat.c + lat.G - 1) / lat.G : 0;
        if (i < nl) { lat.next(i, u); u.pm += 1; return true; }
        const int L = (i - nl) * G + c; if (L >= n) return false;
        u.pm = 0; u.pn = L >> 4; u.koff = (L & 15) * 256; u.boff = u.koff; u.fl = 4 << 8; return true;
    }
    __device__ __forceinline__ void a_ready(const Unit&) const {}
    __device__ __forceinline__ void done(const Unit&) const {}
};
struct MergeOrder {
    StaticOrder lat; int c, G, nctx;
    __device__ __forceinline__ bool next(int i, Unit& u) const {
        const int nl = lat.c < lat.nwg ? (lat.nwg - lat.c + lat.G - 1) / lat.G : 0;
        if (i < 3 * nl) { lat.next(i / 3, u); u.pm += 1; const int sg = i % 3; u.fl = sg | (sg != 0 ? 4 : 0); u.koff = sg * (MT * 1024); u.boff = sg * (4096 * 1024); return true; }
        const int L = (i - 3 * nl) * G + c; if (L >= nctx) return false;
        u.pm = 0; u.pn = L / 3; const int sg = L % 3; u.fl = sg; u.koff = sg * (MT * 1024); u.boff = sg * (4096 * 1024); return true;
    }
    __device__ __forceinline__ void a_ready(const Unit&) const {}
    __device__ __forceinline__ void done(const Unit&) const {}
};
struct EpiSlab {
    static constexpr bool PERM = false, AFTER_DRAIN = false;
    float* S;
    __device__ __forceinline__ void operator()(const f32x4 (&acc)[2][2][4][2], const Unit& u, int wr, int wc, int fr, int fq) const {
        { const int l_ = mk_lane_id(); fr = l_ & 15; fq = l_ >> 4; }
        const int col0 = u.pn * BM + wc * 32 + 4 * fq; float* base = S + (size_t)(u.koff >> 8) * 256 * DM;
#pragma unroll
        for (int ai = 0; ai < 2; ++ai)
#pragma unroll
            for (int m = 0; m < 4; ++m) { float* p = base + (size_t)(ai * HALF + wr * 64 + m * 16 + fr) * DM + col0;
#pragma unroll
                for (int bj = 0; bj < 2; ++bj)
#pragma unroll
                    for (int n = 0; n < 2; ++n) *(f32x4*)(p + bj * HALF + n * 16) = acc[ai][bj][m][n]; }
    }
};
struct EpiWin {
    static constexpr bool PERM = true, AFTER_DRAIN = false;
    bf16_t* ZB; const float* rc; const float* rs;
    __device__ __forceinline__ void operator()(const f32x4 (&acc)[2][2][4][2], const Unit& u, int wr, int wc, int fr, int fq) const {
        { const int l_ = mk_lane_id(); fr = l_ & 15; fq = l_ >> 4; }
        const int pn = u.pn; int kind = 0, ld = 1024, c0 = 0;
        if (pn < 8) { kind = 1; ld = 2048; c0 = 0; } else if (pn < 10) { ld = 512; c0 = 2048; } else if (pn < 12) { ld = 512; c0 = 2560; } else if (pn < 16) { c0 = 3072; }
        else if (pn < 20) { kind = 2; c0 = 4096; } else if (pn < 24) { kind = 3; c0 = 5120; } else if (pn < 28) { kind = 3; c0 = 6144; } else if (pn < 32) { c0 = 7168; } else { kind = 2; ld = 12288; c0 = 8192; }
        if (kind == 3 && u.pm == 0) kind = 0;
        bf16_t* base = ZB + (size_t)MT * c0; const int colt = pn * BM - c0 + wc * 32 + 8 * fq; const int row0 = u.pm * BM + wr * 64 + fr;
#define EPIWIN_LOOP(...) _Pragma("unroll") for (int ai = 0; ai < 2; ++ai) _Pragma("unroll") for (int m = 0; m < 4; ++m) { const int row = row0 + ai * HALF + m * 16; _Pragma("unroll") for (int bj = 0; bj < 2; ++bj) { \
            const int col = colt + bj * HALF; float v[8]; _Pragma("unroll") for (int n = 0; n < 2; ++n) _Pragma("unroll") for (int i = 0; i < 4; ++i) v[n * 4 + i] = acc[ai][bj][m][n][i]; \
            __VA_ARGS__ \
            u32x4 w; w.x = cvt_pk_bf16(v[0], v[1]); w.y = cvt_pk_bf16(v[2], v[3]); w.z = cvt_pk_bf16(v[4], v[5]); w.w = cvt_pk_bf16(v[6], v[7]); *(u32x4*)(base + (size_t)row * ld + col) = w; } }
        if (kind == 0) { EPIWIN_LOOP(;) }
        else if (kind == 1) { EPIWIN_LOOP(_Pragma("unroll") for (int i = 0; i < 8; ++i) { const float x = v[i], uu = 0.7978845608028654f * (x + 0.044715f * x * x * x); v[i] = x * __builtin_amdgcn_rcpf(1.f + __expf(-2.f * uu)); }) }
        else if (kind == 2) { EPIWIN_LOOP(_Pragma("unroll") for (int i = 0; i < 8; ++i) v[i] = fminf(__builtin_amdgcn_rcpf(1.f + __expf(-v[i])), 1.f);) }
        else {
#pragma unroll
            for (int ai = 0; ai < 2; ++ai) { f32x4 c4[4][2], s4[4][2];
#pragma unroll
                for (int m = 0; m < 4; ++m)
#pragma unroll
                    for (int bj = 0; bj < 2; ++bj) { const int t = row0 + ai * HALF + m * 16 - CTXL, j0 = ((colt + bj * HALF) & 127) >> 1; c4[m][bj] = *(const f32x4*)(rc + t * 64 + j0); s4[m][bj] = *(const f32x4*)(rs + t * 64 + j0); }
                asm volatile("" ::: "memory");
#pragma unroll
                for (int m = 0; m < 4; ++m)
#pragma unroll
                    for (int bj = 0; bj < 2; ++bj) { const int row = row0 + ai * HALF + m * 16, col = colt + bj * HALF; float v[8];
#pragma unroll
                        for (int n = 0; n < 2; ++n)
#pragma unroll
                            for (int i = 0; i < 4; ++i) v[n * 4 + i] = acc[ai][bj][m][n][i];
#pragma unroll
                        for (int i = 0; i < 4; ++i) { const float x1 = v[2 * i], x2 = v[2 * i + 1]; v[2 * i] = x1 * c4[m][bj][i] - x2 * s4[m][bj][i]; v[2 * i + 1] = x1 * s4[m][bj][i] + x2 * c4[m][bj][i]; }
                        u32x4 w; w.x = cvt_pk_bf16(v[0], v[1]); w.y = cvt_pk_bf16(v[2], v[3]); w.z = cvt_pk_bf16(v[4], v[5]); w.w = cvt_pk_bf16(v[6], v[7]); *(u32x4*)(base + (size_t)row * ld + col) = w; }
                asm volatile("" ::: "memory"); } }
#undef EPIWIN_LOOP
    }
};
struct EpiSwiglu {
    static constexpr bool PERM = true, AFTER_DRAIN = false;
    bf16_t* O; int ldc;
    __device__ __forceinline__ void operator()(const f32x4 (&acc)[2][2][4][2], const Unit& u, int wr, int wc, int fr, int fq) const {
        { const int l_ = mk_lane_id(); fr = l_ & 15; fq = l_ >> 4; }
        const int row0 = u.pm * BM + wr * 64 + fr, col0 = u.pn * HALF + wc * 32 + 8 * fq;
#pragma unroll
        for (int ai = 0; ai < 2; ++ai)
#pragma unroll
            for (int m = 0; m < 4; ++m) {
                bf16_t* rowp = O + (size_t)(row0 + ai * HALF + m * 16) * ldc + col0;
                float v[8];
#pragma unroll
                for (int n = 0; n < 2; ++n)
#pragma unroll
                    for (int i = 0; i < 4; ++i) { const float a = acc[ai][0][m][n][i], b = acc[ai][1][m][n][i]; v[n * 4 + i] = a * __builtin_amdgcn_rcpf(1.f + __expf(-a)) * b; }
                u32x4 w; w.x = cvt_pk_bf16(v[0], v[1]); w.y = cvt_pk_bf16(v[2], v[3]); w.z = cvt_pk_bf16(v[4], v[5]); w.w = cvt_pk_bf16(v[6], v[7]);
                *(u32x4*)rowp = w;
            }
    }
};
struct EpiResid {
    static constexpr bool PERM = false, AFTER_DRAIN = false;
    float* X; const float* gate_lat; const float* gate_ctx; const float* XB; float f;
    __device__ __forceinline__ void operator()(const f32x4 (&acc)[2][2][4][2], const Unit& u, int wr, int wc, int fr, int fq) const {
        { const int l_ = mk_lane_id(); fr = l_ & 15; fq = l_ >> 4; }
        const int col0 = u.pn * BM + wc * 32 + 4 * fq;
        const float* gate = (u.pm == 0) ? gate_ctx : gate_lat;
        f32x4 gv[2][2];
#pragma unroll
        for (int bj = 0; bj < 2; ++bj)
#pragma unroll
            for (int n = 0; n < 2; ++n) gv[bj][n] = *(const f32x4*)(gate + col0 + bj * HALF + n * 16);
        asm volatile("" ::: "memory");
#pragma unroll
        for (int bj = 0; bj < 2; ++bj)
#pragma unroll
            for (int n = 0; n < 2; ++n) gv[bj][n] = gv[bj][n] * f;
        const size_t ob = (size_t)(u.pm * BM + wr * 64 + fr) * DM + col0;
#define ER_OFF(q) (ob + (size_t)(((q) >> 1) * HALF + ((q) & 1) * 32) * DM)
#define ER_LOAD(xq, q) do { const float* r0 = XB + ER_OFF(q); _Pragma("unroll") for (int m = 0; m < 2; ++m) _Pragma("unroll") for (int bj = 0; bj < 2; ++bj) _Pragma("unroll") for (int n = 0; n < 2; ++n) \
            xq[m][bj][n] = *(const f32x4*)(r0 + (size_t)(m * 16) * DM + bj * HALF + n * 16); asm volatile("" ::: "memory"); } while (0)
#define ER_STORE(xq, q) do { float* p0 = X + ER_OFF(q); _Pragma("unroll") for (int m = 0; m < 2; ++m) _Pragma("unroll") for (int bj = 0; bj < 2; ++bj) _Pragma("unroll") for (int n = 0; n < 2; ++n) \
            *(f32x4*)(p0 + (size_t)(m * 16) * DM + bj * HALF + n * 16) = xq[m][bj][n] + gv[bj][n] * acc[(q) >> 1][bj][((q) & 1) * 2 + m][n]; asm volatile("" ::: "memory"); } while (0)
        f32x4 xa[2][2][2], xb[2][2][2];
        ER_LOAD(xa, 0); ER_LOAD(xb, 1);
        ER_STORE(xa, 0); ER_LOAD(xa, 2);
        ER_STORE(xb, 1); ER_LOAD(xb, 3);
        ER_STORE(xa, 2); ER_STORE(xb, 3);
#undef ER_OFF
#undef ER_LOAD
#undef ER_STORE
    }
};
struct EpiResidSlab {
    static constexpr bool PERM = false, AFTER_DRAIN = false;
    unsigned char* wsb; const float* gate_lat; const float* XB; float f;
    __device__ __forceinline__ void operator()(const f32x4 (&acc)[2][2][4][2], const Unit& u, int wr, int wc, int fr, int fq) const {
        if (u.pm == 0) { EpiSlab E{(float*)(wsb + WS_SLAB)}; E(acc, u, wr, wc, fr, fq); }
        else { EpiResid E{(float*)(wsb + WS_XR), gate_lat, gate_lat, XB, f}; E(acc, u, wr, wc, fr, fq); }
    }
};
struct EpiMergeSeg {
    static constexpr bool PERM = true, AFTER_DRAIN = false;
    const bf16_t* Zg; bf16_t* Y; float* MS3;
    __device__ __forceinline__ void operator()(f32x4 (&acc)[2][2][4][2], const Unit& u, int wr, int wc, int fr, int fq) const {
        { const int l_ = mk_lane_id(); fr = l_ & 15; fq = l_ >> 4; }
        const int seg = u.seg(); const bool ctxp = (u.pm == 0);
        const int col0 = u.pn * BM + wc * 32 + 8 * fq;
#pragma unroll
        for (int ai = 0; ai < 2; ++ai) {
            u32x4 ga[4][2], gb[4][2];
#pragma unroll
            for (int m = 0; m < 4; ++m)
#pragma unroll
                for (int bj = 0; bj < 2; ++bj) { const bf16_t* gp = Zg + (size_t)MT * ZC_MG + (size_t)(u.pm * BM + ai * HALF + wr * 64 + m * 16 + fr) * 12288 + seg * 4096 + col0 + bj * HALF;
                    ga[m][bj] = *(const u32x4*)gp; if (!ctxp && seg < 2) gb[m][bj] = *(const u32x4*)(gp + 4096); }
            asm volatile("" ::: "memory");
#pragma unroll
            for (int m = 0; m < 4; ++m)
#pragma unroll
                for (int bj = 0; bj < 2; ++bj) { const size_t row = (size_t)(u.pm * BM + ai * HALF + wr * 64 + m * 16 + fr); const int col = col0 + bj * HALF;
                    const unsigned aw[4] = {ga[m][bj].x, ga[m][bj].y, ga[m][bj].z, ga[m][bj].w};
                    float g[8];
#pragma unroll
                    for (int k = 0; k < 4; ++k) { g[2 * k] = fmaxf(__uint_as_float(aw[k] << 16), 1e-20f); g[2 * k + 1] = fmaxf(__uint_as_float(aw[k] & 0xffff0000u), 1e-20f); }
                    if (!ctxp && seg < 2) { const unsigned bw[4] = {gb[m][bj].x, gb[m][bj].y, gb[m][bj].z, gb[m][bj].w};
#pragma unroll
                        for (int k = 0; k < 4; ++k) { g[2 * k] = g[2 * k] * __builtin_amdgcn_rcpf(fmaxf(__uint_as_float(bw[k] << 16), 1e-20f)); g[2 * k + 1] = g[2 * k + 1] * __builtin_amdgcn_rcpf(fmaxf(__uint_as_float(bw[k] & 0xffff0000u), 1e-20f)); } }
                    float v[8];
#pragma unroll
                    for (int n = 0; n < 2; ++n)
#pragma unroll
                        for (int i = 0; i < 4; ++i) v[n * 4 + i] = acc[ai][bj][m][n][i] * g[n * 4 + i];
                    if (ctxp) { float* ms = MS3 + ((size_t)seg * 256 + row) * DM + col; *(f32x4*)ms = (f32x4){v[0], v[1], v[2], v[3]}; *(f32x4*)(ms + 4) = (f32x4){v[4], v[5], v[6], v[7]}; }
                    else if (seg < 2) { acc[ai][bj][m][0] = (f32x4){v[0], v[1], v[2], v[3]}; acc[ai][bj][m][1] = (f32x4){v[4], v[5], v[6], v[7]}; }
                    else { u32x4 w; w.x = cvt_pk_bf16(v[0], v[1]); w.y = cvt_pk_bf16(v[2], v[3]); w.z = cvt_pk_bf16(v[4], v[5]); w.w = cvt_pk_bf16(v[6], v[7]); *(u32x4*)(Y + row * DM + col) = w; } }
            asm volatile("" ::: "memory");
        }
    }
};
}

constexpr int TSTR = 68, TSCR_BYTES = 64 * TSTR * 4;
__device__ __forceinline__ void transpose_item(const float* __restrict__ W, size_t ldw, int K, int k0, int srccol0, bf16* WT, int dstrow0, LAS float* scr, int lane) {
    const int r4 = lane >> 4, c16 = lane & 15;
    f32x4 v[16];
#pragma unroll
    for (int i = 0; i < 16; ++i) v[i] = __builtin_nontemporal_load((const f32x4*)(W + (size_t)(k0 + 4 * i + r4) * ldw + srccol0 + 4 * c16));
#pragma unroll
    for (int i = 0; i < 16; ++i) *(LAS f32x4*)(scr + (4 * i + r4) * TSTR + 4 * c16) = v[i];
    LDS_WAIT(); asm volatile("" ::: "memory");
    const int c = lane & 7;
#pragma unroll
    for (int j = 0; j < 8; ++j) { const int n = (lane >> 3) + 8 * j; const LAS float* sp = scr + (8 * c) * TSTR + n;
        v4u o; o.x = pk2(sp[0 * TSTR], sp[1 * TSTR]); o.y = pk2(sp[2 * TSTR], sp[3 * TSTR]); o.z = pk2(sp[4 * TSTR], sp[5 * TSTR]); o.w = pk2(sp[6 * TSTR], sp[7 * TSTR]);
        __builtin_nontemporal_store(o, (GAS v4u*)(WT + (size_t)(dstrow0 + n) * K + k0 + 8 * c)); }
    LDS_WAIT(); asm volatile("" ::: "memory");
}

struct Ptrs {
    const float *x, *c, *ctx, *c_ctx, *ada_down, *ada_up, *ada_bias, *norm_g, *w13, *w2, *w_in, *gmlp_norm_g, *gmlp_ws, *gmlp_bs, *gate_b, *mlstm_norm_g, *diff_lambda, *diff_norm_g, *w_branch, *w_out, *final_g;
    float* out; unsigned char* ws;
};

constexpr int IT_W13 = 2 * 64 * 128, IT_W2 = 2 * 64 * 64, IT_WIN = 64 * 320, IT_WB = 3 * 16 * 64, IT_WO = 64 * 64, IT_LAYER = IT_W13 + IT_W2 + IT_WIN + IT_WB + IT_WO;

constexpr int NE = 8192 + 4096 + IT_WIN, NL = IT_WB + IT_WO + 8192 + 4096;
static_assert(NE + NL == IT_LAYER, "lists cover the layer");
__device__ __forceinline__ void convert_range(const Ptrs& P, int l, int list, int it_lo, int it_hi, int widx, int nw, LAS float* scr, int lane) {
    unsigned char* ws = P.ws;
    for (int it = it_lo + widx; it < it_hi; it += nw) {
        int r;
        if (list == 0) r = it < 8192 ? it : it < 12288 ? IT_W13 + (it - 8192) : IT_W13 + IT_W2 + (it - 12288);
        else r = it < IT_WB ? IT_W13 + IT_W2 + IT_WIN + it : it < IT_WB + IT_WO ? IT_W13 + IT_W2 + IT_WIN + it : it < IT_WB + IT_WO + 8192 ? 8192 + (it - IT_WB - IT_WO) : IT_W13 + 4096 + (it - IT_WB - IT_WO - 8192);
        if (r < IT_W13) { const int s = r / (64 * 128), q = r % (64 * 128), kb = q / 128, nb = q % 128, dr = nb * 64, tile = dr >> 8, within = dr & 255;
            const int src = within < 128 ? tile * 128 + within : 4096 + tile * 128 + (within - 128);
            transpose_item(P.w13 + (size_t)(l * 2 + s) * 4096 * 8192, 8192, 4096, kb * 64, src, (bf16*)(ws + WS_W13T) + (size_t)(l * 2 + s) * 8192 * 4096, dr, scr, lane); continue; }
        r -= IT_W13;
        if (r < IT_W2) { const int s = r / (64 * 64), q = r % (64 * 64), kb = q / 64, nb = q % 64;
            transpose_item(P.w2 + (size_t)(l * 2 + s) * 4096 * 4096, 4096, 4096, kb * 64, nb * 64, (bf16*)(ws + WS_W2T) + (size_t)(l * 2 + s) * 4096 * 4096, nb * 64, scr, lane); continue; }
        r -= IT_W2;
        if (r < IT_WIN) { const int kb = r / 320, nb = r % 320, dr = nb * 64, src = dr < 5120 ? dr : dr + 16;
            transpose_item(P.w_in + (size_t)l * 4096 * INC, INC, 4096, kb * 64, src, (bf16*)(ws + WS_WINT) + (size_t)l * NZ * 4096, dr, scr, lane); continue; }
        r -= IT_WIN;
        if (r < IT_WB) { const int i = r / (16 * 64), q = r % (16 * 64), kb = q / 64, nb = q % 64;
            transpose_item(P.w_branch + (size_t)(l * 3 + i) * 1024 * 4096, 4096, 1024, kb * 64, nb * 64, (bf16*)(ws + WS_WBT) + (size_t)(l * 3 + i) * 4096 * 1024, nb * 64, scr, lane); continue; }
        r -= IT_WB;
        { const int kb = r / 64, nb = r % 64;
            transpose_item(P.w_out + (size_t)l * 4096 * 4096, 4096, 4096, kb * 64, nb * 64, (bf16*)(ws + WS_WOT) + (size_t)l * 4096 * 4096, nb * 64, scr, lane); }
    }
}
#ifndef CVP_D
#define CVP_D 11
#endif
#ifndef CVP_T
#define CVP_T 8
#endif
constexpr int CVD = IT_LAYER * CVP_D / 100, CVS = CVD + IT_LAYER * CVP_T / 100;
static_assert(CVS < NL && CVS < NE, "slot sizes");
__device__ __forceinline__ void convert_part(const Ptrs& P, int lnext, int list, int it_lo, int it_hi, int idx, int n, LAS unsigned char* lds, int tid) {
    asm volatile("" : "+v"(tid));
    if (lnext >= DEPTH || idx < 0 || idx >= n) return;
    const int wave = tid >> 6, lane = tid & 63;
    convert_range(P, lnext, list, it_lo, it_hi, idx * NWAVES + wave, n * NWAVES, (LAS float*)(lds + RING_OFF + wave * TSCR_BYTES), lane);
}
__device__ __forceinline__ void convert_idle(const Ptrs& P, int lnext, int list, int it_lo, int it_hi, int first_idle, int gend, LAS unsigned char* lds, int bid, int tid) {
    if (gend < first_idle + 16) first_idle = 0;
    if (bid >= gend) return;
    convert_part(P, lnext, list, it_lo, it_hi, bid - first_idle, gend - first_idle, lds, tid);
}
__device__ __forceinline__ void pro0(const Ptrs& P, LAS unsigned char* lds, int bid, int G, int tid) {
    asm volatile("" : "+v"(tid));
    const int wave = tid >> 6, lane = tid & 63;
    LAS float* scr = (LAS float*)(lds + RING_OFF + wave * TSCR_BYTES);
    const int gw = bid * NWAVES + wave, NGW = G * NWAVES;
    unsigned char* ws = P.ws;
    convert_range(P, 0, 0, 0, NE, gw, NGW, scr, lane);
    for (int l = 1; l < DEPTH; ++l) convert_range(P, l, 0, CVS, NE, gw, NGW, scr, lane);
    const int gt = bid * NTHR + tid, NGT = G * NTHR;
    { float* rc = (float*)(ws + WS_ROPE); float* rs = rc + SEQ * 64;
      for (int i = gt; i < SEQ * 64; i += NGT) { const int t = i >> 6, j = i & 63; const float inv = powf(10000.f, -(float)(j & 31) / 32.f);
          const float pos = (float)(j < 32 ? (t >> 6) : (t & 63)); const float ang = pos * inv; rc[i] = cosf(ang); rs[i] = sinf(ang); } }
    { float* tp = (float*)(ws + WS_MODTP);
      for (int task = gw; task < DEPTH * 2 * 4 * 64; task += NGW) { const int dc = task & 63, rg = (task >> 6) & 3, w = (task >> 8) & 1, l = task >> 9;
          const float* cv = w ? P.c_ctx : P.c; const float* dn = P.ada_down + (size_t)l * DM * ADAR + (size_t)(dc * 64) * ADAR + rg * 64 + lane;
          float wv[64]; const float cmine = cv[dc * 64 + lane], smine = cmine / (1.f + expf(-cmine));
#pragma unroll
          for (int d = 0; d < 64; ++d) wv[d] = dn[(size_t)d * ADAR];
          asm volatile("" ::: "memory");
          float acc = 0.f;
#pragma unroll
          for (int d = 0; d < 64; ++d) acc += __int_as_float(__builtin_amdgcn_readlane(__float_as_int(smine), d)) * wv[d];
          tp[((l * 2 + w) * 64 + dc) * 256 + rg * 64 + lane] = acc; } }
    if (bid == 0 && tid < DEPTH) { const float* dl = P.diff_lambda + tid * 4 * 128; float s1 = 0.f, s2 = 0.f;
        for (int i = 0; i < 128; ++i) { s1 += dl[i] * dl[128 + i]; s2 += dl[256 + i] * dl[384 + i]; }
        ((float*)(ws + WS_LAM))[tid] = expf(s1) - expf(s2) + lambda_init_f(tid); }
    { bf16* wb = (bf16*)(ws + WS_GWSB); for (int i = gt; i < DEPTH * 8 * 128 * 128; i += NGT) wb[i] = (bf16)f2bf(P.gmlp_ws[i]); }
    { bf16* wg = (bf16*)(ws + WS_WG16);
      for (int i = gt; i < DEPTH * DM * 16; i += NGT) { const int j = i & 15, d = (i >> 4) & (DM - 1), l = i >> 16;
          wg[((size_t)l * 16 + j) * DM + d] = (bf16)f2bf(P.w_in[((size_t)l * DM + d) * INC + 5120 + j]); } }
}

__device__ __forceinline__ void pro1(const Ptrs& P, LAS unsigned char* lds, int bid, int G, int tid) {
    asm volatile("" : "+v"(tid));
    LAS float* T = (LAS float*)(lds + RING_OFF);
    const float* tp = (const float*)(P.ws + WS_MODTP);
    for (int i = tid; i < DEPTH * 2 * 256; i += NTHR) { const int r = i & 255, lw = i >> 8; float s = 0.f;
        for (int dc = 0; dc < 64; ++dc) s += tp[(lw * 64 + dc) * 256 + r];
        T[i] = s; }
    __syncthreads();
    float* MOD = (float*)(P.ws + WS_MOD);
    for (int i = bid * NTHR + tid; i < DEPTH * NMOD; i += G * NTHR) { const int l = i / NMOD, n = i % NMOD;
        const float* up = P.ada_up + (size_t)l * ADAR * NMOD + n; const float b = P.ada_bias[(size_t)l * NMOD + n]; float a0 = b, a1 = b;
#pragma unroll 1
        for (int r0 = 0; r0 < ADAR; r0 += 32) { float uu[32];
#pragma unroll
            for (int k = 0; k < 32; ++k) uu[k] = up[(size_t)(r0 + k) * NMOD];
            asm volatile("" ::: "memory");
#pragma unroll
            for (int k = 0; k < 32; ++k) { a0 += T[(l * 2 + 0) * 256 + r0 + k] * uu[k]; a1 += T[(l * 2 + 1) * 256 + r0 + k] * uu[k]; } }
        MOD[(size_t)(l * 2 + 0) * NMOD + n] = a0; MOD[(size_t)(l * 2 + 1) * NMOD + n] = a1; }
    __syncthreads();
}

__device__ __forceinline__ void phase_norm(float* XR, const float* rdl, const float* rdc, const float* prec, const float* g, const float* modl, const float* modc, bf16* H, const float* slab, const float* cgate, float cf, LAS unsigned char* lds, int bid, int G, int tid) {
    asm volatile("" : "+v"(tid));
    const int wave = tid >> 6, lane = tid & 63;
    LAS f32x4* AL = (LAS f32x4*)lds; LAS f32x4* SL = AL + 1024; LAS f32x4* AC = AL + 2048; LAS f32x4* SC = AL + 3072;
    { f32x4 q[2][5];
#pragma unroll
      for (int k = 0; k < 2; ++k) { const int i = tid + k * NTHR; q[k][0] = ((const f32x4*)g)[i]; q[k][1] = ((const f32x4*)(modl + DM))[i]; q[k][2] = ((const f32x4*)modl)[i]; q[k][3] = ((const f32x4*)(modc + DM))[i]; q[k][4] = ((const f32x4*)modc)[i]; }
      asm volatile("" ::: "memory");
#pragma unroll
      for (int k = 0; k < 2; ++k) { const int i = tid + k * NTHR; AL[i] = q[k][0] * (q[k][1] + 1.f); SL[i] = q[k][2]; AC[i] = q[k][0] * (q[k][3] + 1.f); SC[i] = q[k][4]; } }
    const int row0 = bid * NWAVES + wave, stride = G * NWAVES;
    if (slab && row0 < CTXL) {
        f32x4* xw = (f32x4*)(XR + (size_t)row0 * DM) + lane; const f32x4* xpre = (const f32x4*)(prec + (size_t)row0 * DM) + lane; const f32x4* sp = (const f32x4*)(slab + (size_t)row0 * DM) + lane; const f32x4* gp = (const f32x4*)cgate + lane;
#pragma unroll 1
        for (int j = 0; j < 16; j += 2) { f32x4 q[2][16], xo[2];
#pragma unroll
            for (int jj = 0; jj < 2; ++jj) { xo[jj] = xpre[64 * (j + jj)];
#pragma unroll
                for (int kc = 0; kc < 16; ++kc) q[jj][kc] = sp[(size_t)kc * 256 * (DM / 4) + 64 * (j + jj)]; }
            asm volatile("" ::: "memory");
#pragma unroll
            for (int jj = 0; jj < 2; ++jj) { f32x4 a = (f32x4){0.f, 0.f, 0.f, 0.f};
#pragma unroll
                for (int kc = 0; kc < 16; ++kc) a += q[jj][kc];
                xw[64 * (j + jj)] = xo[jj] + a * gp[64 * (j + jj)] * cf; }
            asm volatile("" ::: "memory"); }
        asm volatile("s_waitcnt vmcnt(0)" ::: "memory");
    }
    __syncthreads();
    f32x4 v[16];
    if (row0 < MT) { const f32x4* xr = (const f32x4*)((row0 < CTXL ? rdc : rdl) + (size_t)row0 * DM) + lane;
#pragma unroll
        for (int j = 0; j < 16; ++j) v[j] = xr[64 * j]; }
    for (int row = row0; row < MT; row += stride) {
        f32x4 vn[16];
        if (row + stride < MT) { const f32x4* xr = (const f32x4*)(rdl + (size_t)(row + stride) * DM) + lane;
#pragma unroll
            for (int j = 0; j < 16; ++j) vn[j] = xr[64 * j]; }
        float ss = 0.f;
#pragma unroll
        for (int j = 0; j < 16; ++j) ss += (v[j].x * v[j].x + v[j].y * v[j].y) + (v[j].z * v[j].z + v[j].w * v[j].w);
        const float rstd = 1.f / sqrtf(wave_sum(ss) * (1.f / DM) + EPS);
        const LAS f32x4* Ap = row < CTXL ? AC : AL; const LAS f32x4* Sp = row < CTXL ? SC : SL;
        uint2* hr = (uint2*)(H + (size_t)row * DM) + lane;
#pragma unroll
        for (int j = 0; j < 16; ++j) { const f32x4 hv = v[j] * rstd * Ap[lane + 64 * j] + Sp[lane + 64 * j];
            uint2 o; o.x = pk2(hv.x, hv.y); o.y = pk2(hv.z, hv.w); hr[64 * j] = o; }
#pragma unroll
        for (int j = 0; j < 16; ++j) v[j] = vn[j];
    }
    __syncthreads();
}
typedef float f32x4g __attribute__((ext_vector_type(4)));
__device__ __forceinline__ void gates_unit(const bf16* H, const bf16* WGb, float* G16, int jb, int tid) {
    asm volatile("" : "+v"(tid));
    const int wave = tid >> 6, lane = tid & 63, fr = lane & 15, fq = lane >> 4;
    const bf16* ap = H + (size_t)(jb * 128 + wave * 16 + fr) * DM + 8 * fq; const bf16* bp = WGb + (size_t)fr * DM + 8 * fq;
    f32x4g acc[4];
#pragma unroll
    for (int i = 0; i < 4; ++i) acc[i] = (f32x4g){0.f, 0.f, 0.f, 0.f};
#pragma unroll 1
    for (int k = 0; k < DM; k += 512) { bf16x8 af[16], bfv[16];
#pragma unroll
        for (int i = 0; i < 16; ++i) { af[i] = *(const bf16x8*)(ap + k + 32 * i); bfv[i] = *(const bf16x8*)(bp + k + 32 * i); }
        asm volatile("" ::: "memory"); __builtin_amdgcn_sched_barrier(0);
#pragma unroll
        for (int i = 0; i < 16; ++i) acc[i & 3] = __builtin_amdgcn_mfma_f32_16x16x32_bf16(af[i], bfv[i], acc[i & 3], 0, 0, 0);
    }
    const f32x4g sres = (acc[0] + acc[1]) + (acc[2] + acc[3]);
#pragma unroll
    for (int r = 0; r < 4; ++r) G16[(size_t)(jb * 128 + wave * 16 + 4 * fq + r) * 16 + fr] = sres[r];
}

__device__ __forceinline__ void phase_final(const float* XR, const float* g, float* out, int bid, int G, int tid) {
    asm volatile("" : "+v"(tid));
    const int wave = tid >> 6, lane = tid & 63;
    f32x4 gg[16];
#pragma unroll
    for (int j = 0; j < 16; ++j) gg[j] = *(const f32x4*)(g + 4 * lane + 256 * j);
    for (int t = bid * NWAVES + wave; t < SEQ; t += G * NWAVES) {
        const f32x4* xr = (const f32x4*)(XR + (size_t)(CTXL + t) * DM) + lane;
        f32x4 v[16]; float ss = 0.f;
#pragma unroll
        for (int j = 0; j < 16; ++j) { v[j] = xr[64 * j]; ss += (v[j].x * v[j].x + v[j].y * v[j].y) + (v[j].z * v[j].z + v[j].w * v[j].w); }
        const float rstd = 1.f / sqrtf(wave_sum(ss) * (1.f / DM) + EPS);
        f32x4* o = (f32x4*)(out + (size_t)t * DM) + lane;
#pragma unroll
        for (int j = 0; j < 16; ++j) o[64 * j] = v[j] * rstd * gg[j];
    }
}

typedef short s16x4 __attribute__((ext_vector_type(4)));
typedef float f32x16 __attribute__((ext_vector_type(16)));
typedef short v4i16_t __attribute__((ext_vector_type(4)));
__device__ __forceinline__ int crow16(int r, int hi) { return (r & 3) + 8 * (r >> 2) + 4 * hi; }
__device__ __forceinline__ int chain_cidx(int dir, int jb) { return dir ? (jb < 2 ? 1 - jb : 67 - jb) : jb; }
__device__ __forceinline__ s16x4 trr(LAS const unsigned char* p) { return __builtin_bit_cast(s16x4, __builtin_amdgcn_ds_read_tr16_b64_v4i16((LAS v4i16_t*)p)); }
__device__ __forceinline__ bf16x8 trfrag(LAS const unsigned char* im, int RS, int rowA, int rowB, int n0, int lane) {
    const int i = lane & 15, q = i >> 2, p = i & 3, cb = n0 + 16 * ((lane >> 4) & 1) + 4 * p;
    const s16x4 lo = trr(im + (rowA + q) * RS + cb * 2), hi = trr(im + (rowB + q) * RS + cb * 2);
    return (bf16x8){lo[0], lo[1], lo[2], lo[3], hi[0], hi[1], hi[2], hi[3]};
}
constexpr int VSTR = 528, KW_OFF = 67584;
constexpr int SM_OFF = 133120;
__device__ __forceinline__ void gate_scan(const float* G16, const float* gate_b, int jb, int h, LAS float* SM, int tid) {
    LAS float* SC = SM + 768;
    const int dir = (tid >> 7) & 1, c = tid & 127, o = dir ? 127 - c : c; const bool act = tid < 256;
    float ip = 0.f, x = 0.f;
    if (act) { const size_t row = (size_t)jb * 128 + o; ip = G16[row * 16 + dir * 8 + h] + gate_b[dir * 8 + h]; const float fp = G16[row * 16 + dir * 8 + 4 + h] + gate_b[dir * 8 + 4 + h];
        x = fminf(fp, 0.f) - __logf(1.f + __expf(-fabsf(fp))); }
    for (int s = 1; s < 128; s <<= 1) { if (act) SC[dir * 128 + c] = x; __syncthreads(); if (act && c >= s) x += SC[dir * 128 + c - s]; __syncthreads(); }
    const float b = x, u = ip - b; float y = u;
    for (int s = 1; s < 128; s <<= 1) { if (act) SC[dir * 128 + c] = y; __syncthreads(); if (act && c >= s) y = fmaxf(y, SC[dir * 128 + c - s]); __syncthreads(); }
    if (act) { SM[dir * 128 + o] = u; SM[256 + dir * 128 + o] = y; SM[512 + dir * 128 + o] = b; if (c == 127) { SM[1024 + dir] = b; SM[1026 + dir] = y; } }
    __syncthreads();
}
__device__ __forceinline__ void stage_v(const bf16* Z, size_t row0, int h, LAS unsigned char* VL, int tid) {
    v4u t[8];
#pragma unroll
    for (int k = 0; k < 8; ++k) { const int i = tid + k * NTHR, sr = i >> 5, ch = i & 31; t[k] = *(const v4u*)(Z + (size_t)MT * ZC_MV + (row0 + sr) * 1024 + h * 256 + ch * 8); }
    asm volatile("" ::: "memory");
#pragma unroll
    for (int k = 0; k < 8; ++k) { const int i = tid + k * NTHR, sr = i >> 5, ch = i & 31; *(LAS v4u*)(VL + sr * VSTR + ch * 16) = t[k]; }
}
__device__ __forceinline__ void mlstm_m1_unit(const bf16* Z, const float* G16, const float* gate_b, float* DCT, float* DN, float* CH, int jb, int h, LAS unsigned char* lds, int tid) {
    asm volatile("" : "+v"(tid));
    const int wave = tid >> 6, lane = tid & 63, hh = lane >> 5;
    LAS unsigned char* VL = lds; LAS unsigned char* KW = lds + KW_OFF; LAS float* SM = (LAS float*)(lds + SM_OFF);
    gate_scan(G16, gate_b, jb, h, SM, tid);
    const size_t row0 = (size_t)jb * 128;
    stage_v(Z, row0, h, VL, tid);
    { v4u kq[4];
#pragma unroll
      for (int k = 0; k < 4; ++k) { const int i = tid + k * NTHR, sr = i >> 4, ch = i & 15; kq[k] = *(const v4u*)(Z + (size_t)MT * ZC_MK + (row0 + sr) * 512 + h * 128 + ch * 8); }
      asm volatile("" ::: "memory");
#pragma unroll
      for (int k = 0; k < 4; ++k) { const int i = tid + k * NTHR, sr = i >> 4, ch = i & 15; const v4u kw = kq[k];
#pragma unroll
        for (int dir = 0; dir < 2; ++dir) { const float wg = __expf(SM[dir * 128 + sr] - SM[1026 + dir]); v4u o;
            o.x = pk2(bflo(kw.x) * wg, bfhi(kw.x) * wg); o.y = pk2(bflo(kw.y) * wg, bfhi(kw.y) * wg); o.z = pk2(bflo(kw.z) * wg, bfhi(kw.z) * wg); o.w = pk2(bflo(kw.w) * wg, bfhi(kw.w) * wg);
            *(LAS v4u*)(KW + dir * 32768 + sr * 256 + ch * 16) = o; } } }
    __syncthreads();
    const int dir = wave >> 2, ebp = wave & 3;
    f32x16 acc[2][4];
#pragma unroll
    for (int a = 0; a < 2; ++a)
#pragma unroll
        for (int b = 0; b < 4; ++b)
#pragma unroll
            for (int r = 0; r < 16; ++r) acc[a][b][r] = 0.f;
#pragma unroll 2
    for (int ks = 0; ks < 8; ++ks) {
        bf16x8 af[2], bfr[4];
#pragma unroll
        for (int eb = 0; eb < 2; ++eb) af[eb] = trfrag(VL, VSTR, 16 * ks + 8 * hh, 16 * ks + 8 * hh + 4, 32 * (2 * ebp + eb), lane);
#pragma unroll
        for (int db = 0; db < 4; ++db) bfr[db] = trfrag(KW + dir * 32768, 256, 16 * ks + 8 * hh, 16 * ks + 8 * hh + 4, 32 * db, lane);
#pragma unroll
        for (int eb = 0; eb < 2; ++eb)
#pragma unroll
            for (int db = 0; db < 4; ++db) acc[eb][db] = __builtin_amdgcn_mfma_f32_32x32x16_bf16(af[eb], bfr[db], acc[eb][db], 0, 0, 0);
    }
    { const int cidx = chain_cidx(dir, jb); float* dst = DCT + (size_t)((dir * 4 + h) * 66 + cidx) * 32768;
#pragma unroll
      for (int eb = 0; eb < 2; ++eb)
#pragma unroll
          for (int db = 0; db < 4; ++db)
#pragma unroll
              for (int r = 0; r < 16; ++r) dst[(32 * (2 * ebp + eb) + crow16(r, hh)) * 128 + 32 * db + (lane & 31)] = acc[eb][db][r]; }
    if (tid < 256) { const int dd = tid >> 7, d = tid & 127; float s = 0.f;
#pragma unroll 1
        for (int sg0 = 0; sg0 < 128; sg0 += 32) { unsigned short kq[32];
#pragma unroll
            for (int k = 0; k < 32; ++k) kq[k] = *(LAS const unsigned short*)(KW + dd * 32768 + (sg0 + k) * 256 + d * 2);
            asm volatile("" ::: "memory");
#pragma unroll
            for (int k = 0; k < 32; ++k) s += bf2f(kq[k]); }
        DN[(size_t)((dd * 4 + h) * 66 + chain_cidx(dd, jb)) * 128 + d] = s; }
    if (tid < 2) { float* c = CH + (size_t)((tid * 4 + h) * 66 + chain_cidx(tid, jb)) * 2; c[0] = SM[1024 + tid]; c[1] = SM[1026 + tid]; }
    __syncthreads();
}
__device__ __forceinline__ void mlstm_m2_scalars(const float* CH, int chain, LAS float* SC, int tid) {
    if (tid < 66) { SC[256 + 2 * tid] = CH[(size_t)(chain * 66 + tid) * 2]; SC[256 + 2 * tid + 1] = CH[(size_t)(chain * 66 + tid) * 2 + 1]; }
    __syncthreads();
    if (tid == 0) { float m = 0.f;
        for (int j = 0; j < 66; ++j) { const float Bj = SC[256 + 2 * j], cm = SC[256 + 2 * j + 1], Mx = fmaxf(m, cm); SC[3 * j] = __expf(m - Mx); SC[3 * j + 1] = __expf(cm - Mx); SC[3 * j + 2] = m; m = Bj + Mx; } }
    __syncthreads();
}
__device__ __forceinline__ void mlstm_m2(const float* DCT, const float* DN, const float* CH, bf16* CT, float* NS, float* MS, LAS unsigned char* lds, int bid, int G, int tid) {
    asm volatile("" : "+v"(tid));
    LAS float* SC = (LAS float*)lds;
    for (int base = bid * NTHR; base < 8 * 16384; base += G * NTHR) {
        const int chain = base >> 14, p = (base & 16383) + tid;
        mlstm_m2_scalars(CH, chain, SC, tid);
        if ((base & 16383) == 0 && tid < 66) MS[chain * 66 + tid] = SC[3 * tid + 2];
        const float* dl = DCT + (size_t)chain * 66 * 32768 + 2 * p; unsigned* ct = (unsigned*)(CT + (size_t)chain * 66 * 32768 + 2 * p);
        float c0 = 0.f, c1 = 0.f;
#pragma unroll 1
        for (int jb = 0; jb < 66; jb += 11) { float2 d[11];
#pragma unroll
            for (int k = 0; k < 11; ++k) d[k] = *(const float2*)(dl + (size_t)(jb + k) * 32768);
            asm volatile("" ::: "memory");
#pragma unroll
            for (int k = 0; k < 11; ++k) { const float dec = SC[3 * (jb + k)], sc = SC[3 * (jb + k) + 1]; ct[(size_t)(jb + k) * 16384] = pk2(c0, c1); c0 = dec * c0 + sc * d[k].x; c1 = dec * c1 + sc * d[k].y; }
            asm volatile("" ::: "memory"); }
        __syncthreads();
    }
    for (int chain = bid; chain < 8; chain += G) {
        mlstm_m2_scalars(CH, chain, SC, tid);
        if (tid < 128) { float c0 = 0.f;
#pragma unroll 1
            for (int jb = 0; jb < 66; jb += 11) { float d[11];
#pragma unroll
                for (int k = 0; k < 11; ++k) d[k] = DN[(size_t)(chain * 66 + jb + k) * 128 + tid];
                asm volatile("" ::: "memory");
#pragma unroll
                for (int k = 0; k < 11; ++k) { NS[(size_t)(chain * 66 + jb + k) * 128 + tid] = c0; c0 = SC[3 * (jb + k)] * c0 + SC[3 * (jb + k) + 1] * d[k]; }
                asm volatile("" ::: "memory"); } }
        __syncthreads();
    }
}
__device__ __forceinline__ void mlstm_m3_unit(const bf16* Z, const float* G16, const float* gate_b, const bf16* CT, const float* NS, const float* MS, const float* mng, bf16* YB, int jb, int h, LAS unsigned char* lds, int tid) {
    asm volatile("" : "+v"(tid));
    const int wave = tid >> 6, lane = tid & 63, hh = lane >> 5, l31 = lane & 31;
    LAS unsigned char* VL = lds; LAS float* XCH = (LAS float*)lds; LAS float* SM = (LAS float*)(lds + SM_OFF);
    gate_scan(G16, gate_b, jb, h, SM, tid);
    const size_t row0 = (size_t)jb * 128;
    if (tid < 256) { const int dd = tid >> 7, d = tid & 127; SM[1040 + dd * 128 + d] = NS[(size_t)((dd * 4 + h) * 66 + chain_cidx(dd, jb)) * 128 + d]; }
    if (tid < 2) SM[1028 + tid] = MS[(tid * 4 + h) * 66 + chain_cidx(tid, jb)];
    stage_v(Z, row0, h, VL, tid);
    __syncthreads();
    const int tb = wave & 3, dir = wave >> 2, tau = 32 * tb + l31;
    float SCL = 0.08838834764831845f; asm volatile("" : "+v"(SCL));
    const float m = SM[1028 + dir], cmT = SM[256 + dir * 128 + tau], bT = SM[512 + dir * 128 + tau];
    const float Mt = fmaxf(m, cmT), wa = __expf(m - Mt), em = __expf(-(bT + Mt)), fa = wa * SCL;
    bf16x8 qf[8];
#pragma unroll
    for (int ks = 0; ks < 8; ++ks) qf[ks] = *(const bf16x8*)(Z + (size_t)MT * ZC_MQ + (row0 + tau) * 512 + h * 128 + 16 * ks + 8 * hh);
    f32x16 acc[8];
#pragma unroll
    for (int eb = 0; eb < 8; ++eb)
#pragma unroll
        for (int r = 0; r < 16; ++r) acc[eb][r] = 0.f;
    { const bf16* ct = CT + (size_t)((dir * 4 + h) * 66 + chain_cidx(dir, jb)) * 32768;
#pragma unroll
      for (int e2 = 0; e2 < 8; e2 += 2) { bf16x8 af[2][8];
#pragma unroll
          for (int eb = 0; eb < 2; ++eb)
#pragma unroll
              for (int ks = 0; ks < 8; ++ks) af[eb][ks] = *(const bf16x8*)(ct + (size_t)(32 * (e2 + eb) + l31) * 128 + 16 * ks + 8 * hh);
          asm volatile("" ::: "memory");
#pragma unroll
          for (int ks = 0; ks < 8; ++ks) { acc[e2] = __builtin_amdgcn_mfma_f32_32x32x16_bf16(af[0][ks], qf[ks], acc[e2], 0, 0, 0); acc[e2 + 1] = __builtin_amdgcn_mfma_f32_32x32x16_bf16(af[1][ks], qf[ks], acc[e2 + 1], 0, 0, 0); } } }
    asm volatile("" ::: "memory");
    float den = 0.f;
    { float nq[8][8];
#pragma unroll
      for (int ks = 0; ks < 8; ++ks)
#pragma unroll
          for (int j = 0; j < 8; ++j) nq[ks][j] = SM[1040 + dir * 128 + 16 * ks + 8 * hh + j];
      asm volatile("" ::: "memory");
#pragma unroll
      for (int ks = 0; ks < 8; ++ks)
#pragma unroll
          for (int j = 0; j < 8; ++j) den += bf2f((unsigned short)qf[ks][j]) * nq[ks][j]; }
    den *= fa;
#pragma unroll
    for (int eb = 0; eb < 8; ++eb)
#pragma unroll
        for (int r = 0; r < 16; ++r) acc[eb][r] *= fa;
    asm volatile("" ::: "memory");
#pragma unroll 1
    for (int sb = 0; sb < 4; ++sb) {
        if (dir == 0 ? sb > tb : sb < tb) continue;
        asm volatile("" ::: "memory");
        f32x16 p;
#pragma unroll
        for (int r = 0; r < 16; ++r) p[r] = 0.f;
        { bf16x8 kf[8];
#pragma unroll
          for (int ks = 0; ks < 8; ++ks) kf[ks] = *(const bf16x8*)(Z + (size_t)MT * ZC_MK + (row0 + 32 * sb + l31) * 512 + h * 128 + 16 * ks + 8 * hh);
          asm volatile("" : "+v"(kf[0]), "+v"(kf[1]), "+v"(kf[2]), "+v"(kf[3]), "+v"(kf[4]), "+v"(kf[5]), "+v"(kf[6]), "+v"(kf[7]) :: "memory");
#pragma unroll
          for (int ks = 0; ks < 8; ++ks) p = __builtin_amdgcn_mfma_f32_32x32x16_bf16(kf[ks], qf[ks], p, 0, 0, 0); }
        { float sv[16];
#pragma unroll
          for (int r = 0; r < 16; ++r) sv[r] = SM[dir * 128 + 32 * sb + crow16(r, hh)];
          asm volatile("" ::: "memory");
#pragma unroll
          for (int r = 0; r < 16; ++r) { const int sg = 32 * sb + crow16(r, hh); const bool keep = dir == 0 ? (sg <= tau) : (sg >= tau);
              const float e = __expf(sv[r] - Mt) * SCL; const float w = keep ? e : 0.f; p[r] *= w; den += p[r]; } }
#pragma unroll
        for (int s = 0; s < 2; ++s) {
            v4u w4; w4.x = pk2(p[8 * s + 0], p[8 * s + 1]); w4.y = pk2(p[8 * s + 2], p[8 * s + 3]); w4.z = pk2(p[8 * s + 4], p[8 * s + 5]); w4.w = pk2(p[8 * s + 6], p[8 * s + 7]);
            const bf16x8 bfrag = __builtin_bit_cast(bf16x8, w4);
#pragma unroll
            for (int eb = 0; eb < 8; ++eb) { const bf16x8 a = trfrag(VL, VSTR, 32 * sb + 16 * s + 4 * hh, 32 * sb + 16 * s + 8 + 4 * hh, 32 * eb, lane);
                acc[eb] = __builtin_amdgcn_mfma_f32_32x32x16_bf16(a, bfrag, acc[eb], 0, 0, 0);
                if (eb & 1) { asm volatile("" ::: "memory"); } }
        }
    }
    den += shfl_xor_f(den, 32);
    { const float inv = 1.f / fmaxf(fabsf(den), em);
#pragma unroll
      for (int eb = 0; eb < 8; ++eb)
#pragma unroll
          for (int r = 0; r < 16; ++r) acc[eb][r] *= inv; }
    __syncthreads();
    LAS float* HS = (LAS float*)lds;
    if (dir == 1) {
#pragma unroll
        for (int eb = 0; eb < 8; ++eb)
#pragma unroll
            for (int r = 0; r < 16; ++r) HS[tau * 257 + 32 * eb + crow16(r, hh)] = acc[eb][r];
    }
    __syncthreads();
    if (dir == 0) {
#pragma unroll
        for (int eb = 0; eb < 8; eb += 2) { float hq[2][16];
#pragma unroll
            for (int e = 0; e < 2; ++e)
#pragma unroll
                for (int r = 0; r < 16; ++r) hq[e][r] = HS[tau * 257 + 32 * (eb + e) + crow16(r, hh)];
#define PIN16(a) asm volatile("" : "+v"(a[0]), "+v"(a[1]), "+v"(a[2]), "+v"(a[3]), "+v"(a[4]), "+v"(a[5]), "+v"(a[6]), "+v"(a[7]), "+v"(a[8]), "+v"(a[9]), "+v"(a[10]), "+v"(a[11]), "+v"(a[12]), "+v"(a[13]), "+v"(a[14]), "+v"(a[15]) :: "memory")
            PIN16(hq[0]); PIN16(hq[1]);
#undef PIN16
#pragma unroll
            for (int e = 0; e < 2; ++e)
#pragma unroll
                for (int r = 0; r < 16; ++r) HS[tau * 257 + 32 * (eb + e) + crow16(r, hh)] = hq[e][r] + acc[eb + e][r];
            asm volatile("" ::: "memory"); }
    }
    __syncthreads();
    {
        unsigned short og[16][4]; float gn[4];
#pragma unroll
        for (int rr = 0; rr < 16; ++rr)
#pragma unroll
            for (int k = 0; k < 4; ++k) og[rr][k] = Z[(size_t)MT * ZC_MO + (row0 + wave * 16 + rr) * 1024 + h * 256 + 64 * k + lane];
#pragma unroll
        for (int k = 0; k < 4; ++k) gn[k] = mng[h * 256 + 64 * k + lane];
#pragma unroll
        for (int rr = 0; rr < 16; ++rr) { const int t2 = wave * 16 + rr; float v[4]; float ss = 0.f;
#pragma unroll
            for (int k = 0; k < 4; ++k) { v[k] = HS[t2 * 257 + 64 * k + lane]; ss += v[k] * v[k]; }
            const float rstd = 1.f / sqrtf(wave_sum(ss) * (1.f / 256.f) + EPS); const size_t row = row0 + t2;
#pragma unroll
            for (int k = 0; k < 4; ++k) YB[row * 1024 + h * 256 + 64 * k + lane] = (bf16)f2bf(bf2f(og[rr][k]) * v[k] * rstd * gn[k]); }
    }
    __syncthreads();
}
__device__ __forceinline__ void gmlp_unit_mfma(const bf16* Z, const float* gng, const bf16* wsb  , const float* bs  , bf16* YA, int j, LAS unsigned char* lds, int tid) {
    asm volatile("" : "+v"(tid));
    const int wave = tid >> 6, lane = tid & 63, g = wave;
    LAS float* ST = (LAS float*)(lds + SM_OFF);
    LAS float* BSL = ST + 256;
    BSL[tid] = bs[tid]; BSL[tid + NTHR] = bs[tid + NTHR];
    LAS unsigned char* VN = lds + wave * 16384;
    const size_t row0 = (size_t)j * 128;
#pragma unroll 1
    for (int rb = 0; rb < 16; rb += 4) { v4u wq[4][2];
#pragma unroll
        for (int r4 = 0; r4 < 4; ++r4) { const v4u* zp = (const v4u*)(Z + (row0 + wave * 16 + rb + r4) * 2048 + 1024 + lane * 16); wq[r4][0] = zp[0]; wq[r4][1] = zp[1]; }
        asm volatile("" ::: "memory");
#pragma unroll
        for (int r4 = 0; r4 < 4; ++r4) { const int q = wave * 16 + rb + r4; const v4u w0 = wq[r4][0], w1 = wq[r4][1];
            float x[16]; const unsigned ww[8] = {w0.x, w0.y, w0.z, w0.w, w1.x, w1.y, w1.z, w1.w};
            float s = 0.f;
#pragma unroll
            for (int k = 0; k < 8; ++k) { x[2 * k] = bflo(ww[k]); x[2 * k + 1] = bfhi(ww[k]); s += x[2 * k] + x[2 * k + 1]; }
            const float mean = wave_sum(s) * (1.f / 1024.f); float s2 = 0.f;
#pragma unroll
            for (int k = 0; k < 16; ++k) { const float d = x[k] - mean; s2 += d * d; }
            const float rstd = 1.f / sqrtf(wave_sum(s2) * (1.f / 1024.f) + EPS);
            if (lane == 0) { ST[2 * q] = mean; ST[2 * q + 1] = rstd; } } }
    __syncthreads();
#pragma unroll 1
    for (int h = 0; h < 2; ++h) {
        const int ln = mk_lane_id(), hh = ln >> 5, l31 = ln & 31;
        const int cbase = g * 128 + 64 * h, c8 = (ln & 7) * 8;
        { const f32x4 g0 = *(const f32x4*)(gng + cbase + c8), g1 = *(const f32x4*)(gng + cbase + c8 + 4);
#pragma unroll 1
          for (int ib = 0; ib < 16; ib += 4) { v4u wv[4];
#pragma unroll
            for (int i4 = 0; i4 < 4; ++i4) wv[i4] = *(const v4u*)(Z + (row0 + (ib + i4) * 8 + (ln >> 3)) * 2048 + 1024 + cbase + c8);
            asm volatile("" ::: "memory");
#pragma unroll
            for (int i4 = 0; i4 < 4; ++i4) { const int q = (ib + i4) * 8 + (ln >> 3); const float mean = ST[2 * q], rstd = ST[2 * q + 1]; const v4u w = wv[i4]; v4u o;
              o.x = pk2((bflo(w.x) - mean) * rstd * g0.x, (bfhi(w.x) - mean) * rstd * g0.y); o.y = pk2((bflo(w.y) - mean) * rstd * g0.z, (bfhi(w.y) - mean) * rstd * g0.w);
              o.z = pk2((bflo(w.z) - mean) * rstd * g1.x, (bfhi(w.z) - mean) * rstd * g1.y); o.w = pk2((bflo(w.w) - mean) * rstd * g1.z, (bfhi(w.w) - mean) * rstd * g1.w);
              *(LAS v4u*)(VN + q * 128 + (ln & 7) * 16) = o; } } }
        LDS_WAIT(); asm volatile("" ::: "memory");
        bf16x8 bfr[8][2];
#pragma unroll
        for (int ks = 0; ks < 8; ++ks)
#pragma unroll
            for (int cb = 0; cb < 2; ++cb) bfr[ks][cb] = trfrag(VN, 128, 16 * ks + 8 * hh, 16 * ks + 8 * hh + 4, 32 * cb, ln);
        f32x16 acc[4][2];
#pragma unroll
        for (int pb = 0; pb < 4; ++pb)
#pragma unroll
            for (int cb = 0; cb < 2; ++cb)
#pragma unroll
                for (int r = 0; r < 16; ++r) acc[pb][cb][r] = 0.f;
#pragma unroll
        for (int pb = 0; pb < 4; ++pb) {
            bf16x8 af[8];
#pragma unroll
            for (int ks = 0; ks < 8; ++ks) af[ks] = *(const bf16x8*)(wsb + (size_t)(g * 128 + 32 * pb + l31) * 128 + 16 * ks + 8 * hh);
            asm volatile("" ::: "memory");
#pragma unroll
            for (int ks = 0; ks < 8; ++ks) { acc[pb][0] = __builtin_amdgcn_mfma_f32_32x32x16_bf16(af[ks], bfr[ks][0], acc[pb][0], 0, 0, 0); acc[pb][1] = __builtin_amdgcn_mfma_f32_32x32x16_bf16(af[ks], bfr[ks][1], acc[pb][1], 0, 0, 0); }
            asm volatile("" ::: "memory");
        }
        LDS_WAIT(); asm volatile("" ::: "memory");
#pragma unroll
        for (int pb = 0; pb < 4; ++pb)
#pragma unroll
            for (int q4 = 0; q4 < 4; ++q4) { const f32x4 b4 = *(const LAS f32x4*)(BSL + g * 128 + 32 * pb + 8 * q4 + 4 * hh);
#pragma unroll
                for (int i = 0; i < 4; ++i) { const int r = 4 * q4 + i, p = 32 * pb + 8 * q4 + 4 * hh + i;
#pragma unroll
                    for (int cb = 0; cb < 2; ++cb) *(LAS unsigned short*)(VN + p * 128 + (32 * cb + l31) * 2) = (unsigned short)f2bf(acc[pb][cb][r] + b4[i]); } }
        LDS_WAIT(); asm volatile("" ::: "memory");
#pragma unroll 1
        for (int ib = 0; ib < 16; ib += 4) { v4u uq[4];
#pragma unroll
            for (int i4 = 0; i4 < 4; ++i4) uq[i4] = *(const v4u*)(Z + (row0 + (ib + i4) * 8 + (ln >> 3)) * 2048 + cbase + c8);
            asm volatile("" ::: "memory");
#pragma unroll
            for (int i4 = 0; i4 < 4; ++i4) { const int p = (ib + i4) * 8 + (ln >> 3); const v4u m = *(const LAS v4u*)(VN + p * 128 + (ln & 7) * 16); const v4u u = uq[i4]; v4u o;
                o.x = pk2(bflo(u.x) * bflo(m.x), bfhi(u.x) * bfhi(m.x)); o.y = pk2(bflo(u.y) * bflo(m.y), bfhi(u.y) * bfhi(m.y));
                o.z = pk2(bflo(u.z) * bflo(m.z), bfhi(u.z) * bfhi(m.z)); o.w = pk2(bflo(u.w) * bflo(m.w), bfhi(u.w) * bfhi(m.w));
                *(v4u*)(YA + (row0 + p) * 1024 + cbase + c8) = o; } }
        LDS_WAIT(); asm volatile("" ::: "memory");
    }
    __syncthreads();
}

__device__ __forceinline__ void phase_post(const float* ATTO, const float* MLH, const bf16* Z, const float* dng, const float* mng, float lam, float linit, bf16* YB, bf16* YC, int bid, int G, int tid) {
    asm volatile("" : "+v"(tid));
    const int wave = tid >> 6, lane = tid & 63, head = lane >> 4, e0 = (lane & 15) * 16;
    for (int row = bid * NWAVES + wave; row < MT; row += G * NWAVES) {
        const size_t off = (size_t)row * 1024 + head * 256 + e0;
        {
            const f32x4* a0 = (const f32x4*)(ATTO + off); const f32x4* a1 = (const f32x4*)(ATTO + (size_t)MT * 1024 + off);
            float o[16]; float ss = 0.f;
#pragma unroll
            for (int k = 0; k < 4; ++k) { const f32x4 p = a0[k], q = a1[k];
                o[4 * k + 0] = p.x - lam * q.x; o[4 * k + 1] = p.y - lam * q.y; o[4 * k + 2] = p.z - lam * q.z; o[4 * k + 3] = p.w - lam * q.w; }
#pragma unroll
            for (int k = 0; k < 16; ++k) ss += o[k] * o[k];
            ss += shfl_xor_f(ss, 1); ss += shfl_xor_f(ss, 2); ss += shfl_xor_f(ss, 4); ss += shfl_xor_f(ss, 8);
            const float rstd = 1.f / sqrtf(ss * (1.f / 256.f) + EPS) * (1.f - linit);
            v4u w0, w1;
            w0.x = pk2(o[0] * rstd * dng[e0 + 0], o[1] * rstd * dng[e0 + 1]); w0.y = pk2(o[2] * rstd * dng[e0 + 2], o[3] * rstd * dng[e0 + 3]);
            w0.z = pk2(o[4] * rstd * dng[e0 + 4], o[5] * rstd * dng[e0 + 5]); w0.w = pk2(o[6] * rstd * dng[e0 + 6], o[7] * rstd * dng[e0 + 7]);
            w1.x = pk2(o[8] * rstd * dng[e0 + 8], o[9] * rstd * dng[e0 + 9]); w1.y = pk2(o[10] * rstd * dng[e0 + 10], o[11] * rstd * dng[e0 + 11]);
            w1.z = pk2(o[12] * rstd * dng[e0 + 12], o[13] * rstd * dng[e0 + 13]); w1.w = pk2(o[14] * rstd * dng[e0 + 14], o[15] * rstd * dng[e0 + 15]);
            v4u* yp = (v4u*)(YC + off); yp[0] = w0; yp[1] = w1;
        }
    }
}

struct Args { const float* in[21]; float* out; unsigned char* ws; int ph_lo, ph_hi; };
static_assert(sizeof(Args) == 21 * 8 + 8 + 8 + 8, "Args has no padding");

constexpr int T_ALL = -1, T_PRO0 = 0, T_PRO1 = 1, T_NORM = 2, T_W13 = 3, T_W2 = 4, T_N2 = 5, T_WIN = 6, T_ROPE = 7, T_MLSTM = 8, T_POST = 9, T_MERGE0 = 10, T_WOUT = 11, T_FINAL = 12, T_ATTN = 13, T_GMLP = 14, T_MERGE1 = 15, T_MERGE2 = 16, T_M3 = 17, NTYPES = 18;
#define SELD(t) (SEL == T_ALL || SEL == (t))
template <int SEL> __global__ void __launch_bounds__(NTHR, 2) mk_fwd(Args args) {
    extern __shared__ __attribute__((aligned(16))) unsigned char lds_raw[];
    LAS unsigned char* lds = (LAS unsigned char*)lds_raw;
    volatile LAS unsigned* MISC = (volatile LAS unsigned*)(lds + MISC_OFF);
    const int wave_s = __builtin_amdgcn_readfirstlane((int)threadIdx.x >> 6), bid_k = blockIdx.x, G = gridDim.x;
#define tid MK_TID(wave_s)
#define KARGS ((const __attribute__((address_space(4))) Args*)ka_)
#define PHASE_BEGIN const __attribute__((address_space(4))) void* ka_ = (const __attribute__((address_space(4))) void*)__builtin_amdgcn_kernarg_segment_ptr(); asm volatile("" : "+s"(ka_)); unsigned char* const ws = KARGS->ws; (void)ws; int bid = bid_k; asm volatile("" : "+s"(bid))
#define PIN(i) (KARGS->in[i])
#define XR ((float*)(ws + WS_XR))
#define H ((bf16*)(ws + WS_H))
#define GB ((bf16*)(ws + WS_GB))
#define Z ((bf16*)(ws + WS_Z))
#define ATTO ((float*)(ws + WS_ATTO))
#define MLH ((float*)(ws + WS_MLH))
#define DCT ((float*)(ws + WS_MLH))
#define YA ((bf16*)(ws + WS_YA))
#define YB ((bf16*)(ws + WS_YB))
#define YC ((bf16*)(ws + WS_YC))
#define SLAB ((float*)(ws + WS_SLAB))
#define YACC ((float*)(ws + WS_YACC))
#define Y ((bf16*)(ws + WS_Y))
#define G16 ((float*)(ws + WS_G16))
#define MOD ((const float*)(ws + WS_MOD))
#define CTS ((bf16*)(ws + WS_CT))
#define DNS ((float*)(ws + WS_MSM))
#define NSS (DNS + 8 * 66 * 128)
#define CHS (NSS + 8 * 66 * 128)
#define MSS (CHS + 8 * 66 * 2)
#define modl (MOD + (size_t)(l * 2 + 0) * NMOD)
#define modc (MOD + (size_t)(l * 2 + 1) * NMOD)
#define W13T0 ((const bf16*)(ws + WS_W13T) + (size_t)(l * 2 + 0) * 8192 * 4096)
#define W13T1 (W13T0 + (size_t)8192 * 4096)
#define W2T0 ((const bf16*)(ws + WS_W2T) + (size_t)(l * 2 + 0) * 4096 * 4096)
#define W2T1 (W2T0 + (size_t)4096 * 4096)
#define WINT ((const bf16*)(ws + WS_WINT) + (size_t)l * NZ * 4096)
#define WBT ((const bf16*)(ws + WS_WBT) + (size_t)(l * 3) * 4096 * 1024)
#define WOT ((const bf16*)(ws + WS_WOT) + (size_t)l * 4096 * 4096)
#define MKP() Ptrs P; P.x = PIN(0); P.c = PIN(1); P.ctx = PIN(2); P.c_ctx = PIN(3); P.ada_down = PIN(4); P.ada_up = PIN(5); P.ada_bias = PIN(6); P.norm_g = PIN(7); \
    P.w13 = PIN(8); P.w2 = PIN(9); P.w_in = PIN(10); P.gmlp_norm_g = PIN(11); P.gmlp_ws = PIN(12); P.gmlp_bs = PIN(13); P.gate_b = PIN(14); \
    P.mlstm_norm_g = PIN(15); P.diff_lambda = PIN(16); P.diff_norm_g = PIN(17); P.w_branch = PIN(18); P.w_out = PIN(19); P.final_g = PIN(20); P.out = KARGS->out; P.ws = KARGS->ws
    for (int u = tid; u < (LDS_BYTES - LDSCTL_OFF) / 4; u += NTHR) ((LAS unsigned*)(lds + LDSCTL_OFF))[u] = 0u;
    __syncthreads();
#if MK_ONE_LAUNCH
    XcdBarrier bar = xcd_barrier_post((unsigned*)((gu32*)(args.ws + WS_CTL) + CW_BAR), MISC + 8, tid);
#define GRID_BAR() do { XcdBarrier b2_ = bar; asm volatile("" : "+s"(b2_.bar)); xcd_barrier(b2_, tid); } while (0)
#else
#define GRID_BAR() do {} while (0)
#endif
    const int lo = args.ph_lo, hi = args.ph_hi;
#define IN(k) (lo <= (k) && (k) < hi)
#define SEAM(k) do { if (IN(k) && IN((k) + 1)) GRID_BAR(); } while (0)

    if (IN(P_PRO0)) { PHASE_BEGIN; MKP(); for (int rep_ = 0; rep_ < DBL_PRO; ++rep_) pro0(P, lds, bid, G, tid); SEAM(P_PRO0); }
    if (IN(P_PRO1)) { PHASE_BEGIN; MKP(); pro1(P, lds, bid, G, tid); SEAM(P_PRO1); }

    for (int l = 0; l < DEPTH; ++l) {
        const int pb = P_LAYER0 + l * NPL;
        if (hi <= pb || lo >= pb + NPL) continue;
#define GEMM_RESID_SPLIT2(Aptr, Bptr, gate_l, fac, ms3, yc, nctx_) do { \
            { pg8::Gemm g{(Aptr) + (size_t)CTXL * DM, (Bptr), SEQ, DM, DM, DM}; pg8::StaticOrder S; S.init(SEQ, DM, G, bid); pg8::EpiResid E{XR + (size_t)CTXL * DM, (gate_l), (gate_l), XR + (size_t)CTXL * DM, (fac)}; \
              pg8::gemm_phase<pg8::EpiResid, pg8::StaticOrder, true, true>(lds + RING_OFF, g, S, E, wave_s); } \
            { pg8::Gemm g{(Aptr), (Bptr), CTXL, DM, 256, DM}; pg8::CtxSplitOrder S{bid, G, (nctx_), (ms3), (yc), wave_s}; pg8::EpiSlab E{SLAB}; \
              pg8::gemm_phase<pg8::EpiSlab, pg8::CtxSplitOrder, true, true>(lds + RING_OFF, g, S, E, wave_s); } } while (0)
#define GEMM_RESID_SPLIT(Aptr, Bptr, gate_l, fac, ms3, yc, nctx_, xb_) do { \
            pg8::Gemm g{(Aptr), (Bptr), MT, DM, DM, DM}; pg8::ResidOrder S; S.lat.init(SEQ, DM, G, bid); S.c = bid; S.G = G; S.n = (nctx_); \
            pg8::EpiResidSlab E{ws, (gate_l), (xb_), (fac)}; \
            pg8::gemm_phase<pg8::EpiResidSlab, pg8::ResidOrder, true, true>(lds + RING_OFF, g, S, E, wave_s); } while (0)
#define GL (G >= 128 ? G - (G >> 4) : G)
#define NC (G - GL)
#define GEMM_LAT(EPI, GW_, Aptr, Bptr, Ncols, Kdim, ...) do { pg8::Gemm g{(Aptr), (Bptr), MT, (Ncols), (Kdim), (Kdim)}; pg8::StaticOrder S; S.init(MT, (Ncols), (GW_), bid); EPI E{__VA_ARGS__}; \
            pg8::gemm_phase<EPI, pg8::StaticOrder, true, true>(lds + RING_OFF, g, S, E, wave_s); } while (0)

        if (IN(pb + L_N1)) { PHASE_BEGIN; MKP(); phase_norm(XR, l == 0 ? P.x - (size_t)CTXL * DM : (const float*)XR, l == 0 ? P.ctx : (const float*)XR, XR, P.norm_g + (size_t)(l * 3 + 0) * DM, modl + 0 * 3 * DM, modc + 0 * 3 * DM, H, l > 0 ? SLAB : nullptr, modc - (size_t)2 * NMOD + 2 * 3 * DM + 2 * DM, 0.5f, lds, bid, G, tid); SEAM(pb + L_N1); }
        if (IN(pb + L_W13A)) { PHASE_BEGIN; MKP();
            if (bid < GL) { GEMM_LAT(pg8::EpiSwiglu, GL, H, W13T0, 8192, DM, GB, FFND);
                            convert_idle(P, l, 1, CVD, CVS, (MT / 256 * 32) % GL, GL, lds, bid, tid); }
            if (NC == 0 || bid >= GL) convert_part(P, l, 1, 0, CVD, NC ? bid - GL : bid, NC ? NC : G, lds, tid);
            SEAM(pb + L_W13A); }
        if (IN(pb + L_W2A)) { PHASE_BEGIN; MKP();
            GEMM_RESID_SPLIT(GB, W2T0, modl + 0 * 3 * DM + 2 * DM, 0.5f, (const float*)nullptr, (bf16*)nullptr, 256, l == 0 ? P.x - (size_t)CTXL * DM : (const float*)XR);
            SEAM(pb + L_W2A); }
        if (IN(pb + L_N2)) { PHASE_BEGIN; MKP(); phase_norm(XR, XR, XR, l == 0 ? P.ctx : (const float*)XR, P.norm_g + (size_t)(l * 3 + 1) * DM, modl + 1 * 3 * DM, modc + 1 * 3 * DM, H, SLAB, modc + 0 * 3 * DM + 2 * DM, 0.5f, lds, bid, G, tid); SEAM(pb + L_N2); }
        if (IN(pb + L_WIN)) { PHASE_BEGIN; MKP();
            if (bid < GL) { GEMM_LAT(pg8::EpiWin, GL, H, WINT, NZ, DM, Z, (const float*)(ws + WS_ROPE), (const float*)(ws + WS_ROPE) + SEQ * 64); }
            if (NC == 0 || bid >= GL) { convert_part(P, l, 1, CVS, NL, NC ? bid - GL : bid, NC ? NC : G, lds, tid);
                for (int u = NC ? bid - GL : bid; u < 66; u += (NC ? NC : G)) gates_unit(H, (const bf16*)(ws + WS_WG16) + (size_t)l * 16 * DM, G16, u, tid); }
            SEAM(pb + L_WIN); }
        if (IN(pb + L_MIX1)) { PHASE_BEGIN; MKP();
            for (int rep_ = 0; rep_ < DBL_M1; ++rep_) for (int u = (bid + G - (100 % G)) % G; u < 264; u += G) mlstm_m1_unit(Z, G16, P.gate_b + (size_t)l * 16, DCT, DNS, CHS, u >> 2, u & 3, lds, tid);
            for (int rep_ = 0; rep_ < DBL_ATTN; ++rep_) for (int u = bid; u < (l < DEPTH - 1 ? 264 : 256); u += G) {
                int hm, qb, seq; if (u < 256) { hm = u & 7; qb = 1 + (u >> 3); seq = MT; } else { hm = u - 256; qb = 0; seq = CTXL; }
                const int h = hm >> 1, mm = hm & 1;
                const attn128::bf16* Zb = (const attn128::bf16*)Z;
                attn256::attn_o256_body(Zb + (size_t)MT * ZC_AQ + (size_t)(qb * 256) * 1024 + h * 256 + mm * 128, Zb + (size_t)MT * ZC_AK + h * 256 + mm * 128, Zb + (size_t)MT * ZC_AV + h * 256,
                                        ATTO + (size_t)mm * MT * 1024 + (size_t)(qb * 256) * 1024 + h * 256, seq, (char*)lds_raw, wave_s);
                __syncthreads();
            }
            SEAM(pb + L_MIX1);
        }
        if (IN(pb + L_POST)) { PHASE_BEGIN; MKP();
            for (int rep_ = 0; rep_ < DBL_POST; ++rep_) { mlstm_m2(DCT, DNS, CHS, CTS, NSS, MSS, lds, bid, G, tid); } SEAM(pb + L_POST); }
        if (IN(pb + L_M3)) { PHASE_BEGIN; MKP();
            { const int u0 = (l < DEPTH - 1) ? 0 : 8, nsec = (l < DEPTH - 1) ? (264 - G > 0 ? 264 - G : 0) : 0;
              for (int rep_ = 0; rep_ < DBL_M3; ++rep_) for (int u = u0 + bid; u < 264; u += G) mlstm_m3_unit(Z, G16, P.gate_b + (size_t)l * 16, CTS, NSS, MSS, P.mlstm_norm_g + (size_t)l * 1024, YB, u >> 2, u & 3, lds, tid);
              const int ngm = (G >= 66 + nsec + 8) ? 66 : 0;
              for (int rep_ = 0; rep_ < DBL_GMLP; ++rep_) for (int u = G - 1 - bid; u < 66; u += G) gmlp_unit_mfma(Z, P.gmlp_norm_g + (size_t)l * 1024, (const bf16*)(ws + WS_GWSB) + (size_t)l * 8 * 128 * 128, P.gmlp_bs + (size_t)l * 8 * 128, YA, u, lds, tid);
              if (bid >= nsec && bid < G - ngm) phase_post(ATTO, MLH, Z, P.diff_norm_g + (size_t)l * 256, P.mlstm_norm_g + (size_t)l * 1024, ((const float*)(ws + WS_LAM))[l], lambda_init_f(l), YB, YC, bid - nsec, G - ngm - nsec, tid); }
            SEAM(pb + L_M3); }
        if (IN(pb + L_MERGE)) { PHASE_BEGIN; MKP();
            { pg8::Gemm g{YA, WBT, MT, DM, 1024, 1024}; pg8::MergeOrder S; S.lat.init(SEQ, DM, G, bid); S.c = bid; S.G = G; S.nctx = (l < DEPTH - 1) ? 48 : 0; pg8::EpiMergeSeg E{Z, Y, (float*)(ws + WS_MS3)};
              pg8::gemm_phase<pg8::EpiMergeSeg, pg8::MergeOrder, true, true>(lds + RING_OFF, g, S, E, wave_s); }
            SEAM(pb + L_MERGE); }
        if (IN(pb + L_WOUT)) { PHASE_BEGIN; MKP();
            GEMM_RESID_SPLIT2(Y, WOT, modl + 1 * 3 * DM + 2 * DM, 1.f, (const float*)(ws + WS_MS3), Y, (l < DEPTH - 1) ? 256 : 0);
            SEAM(pb + L_WOUT); }
        if (IN(pb + L_N3)) { PHASE_BEGIN; MKP(); phase_norm(XR, XR, XR, XR, P.norm_g + (size_t)(l * 3 + 2) * DM, modl + 2 * 3 * DM, modc + 2 * 3 * DM, H, SLAB, modc + 1 * 3 * DM + 2 * DM, 1.f, lds, bid, G, tid); SEAM(pb + L_N3); }
        if (IN(pb + L_W13B)) { PHASE_BEGIN; MKP();
            { const int skip = (l < DEPTH - 1) ? 0 : CTXL;
              const int GLb = (l < DEPTH - 1) ? GL : G;
              if (bid < GLb) { pg8::Gemm g{H + (size_t)skip * DM, W13T1, MT - skip, 8192, DM, DM}; pg8::StaticOrder S; S.init(MT - skip, 8192, GLb, bid); pg8::EpiSwiglu E{GB + (size_t)skip * FFND, FFND};
                  pg8::gemm_phase<pg8::EpiSwiglu, pg8::StaticOrder, true, true>(lds + RING_OFF, g, S, E, wave_s);
                  convert_idle(P, l + 1, 0, CVD, CVS, (MT / 256 * 32) % GL, GL, lds, bid, tid); }
              if (NC == 0 || bid >= GL) convert_part(P, l + 1, 0, 0, CVD, NC ? bid - GL : bid, NC ? NC : G, lds, tid); }
            SEAM(pb + L_W13B); }
        if (IN(pb + L_W2B)) { PHASE_BEGIN; MKP();
            GEMM_RESID_SPLIT(GB, W2T1, modl + 2 * 3 * DM + 2 * DM, 0.5f, (const float*)nullptr, (bf16*)nullptr, (l < DEPTH - 1) ? 256 : 0, (const float*)XR);
            SEAM(pb + L_W2B); }
#undef GEMM_LAT
#undef GL
#undef NC
#undef GEMM_RESID_SPLIT
#undef GEMM_RESID_SPLIT2
    }
    if (IN(P_FINAL)) { PHASE_BEGIN; MKP(); phase_final(XR, P.final_g, P.out, bid, G, tid); }
#undef IN
#undef SEAM
#undef tid
#undef XR
#undef H
#undef GB
#undef Z
#undef ATTO
#undef MLH
#undef DCT
#undef YA
#undef YB
#undef YC
#undef SLAB
#undef YACC
#undef Y
#undef G16
#undef MOD
#undef CTS
#undef DNS
#undef NSS
#undef CHS
#undef MSS
#undef modl
#undef modc
#undef W13T0
#undef W13T1
#undef W2T0
#undef W2T1
#undef WINT
#undef WBT
#undef WOT
}

extern "C" void kernel_launch(void* const* d_in, const int* in_sizes, int n_in, void* d_out, int out_size, void* d_ws, size_t ws_size, hipStream_t stream) {
    static int grid = 0;
    if (grid == 0) {
        if (n_in != 21 || in_sizes[0] != SEQ * DM || out_size != SEQ * DM || ws_size < WS_END) {
            fprintf(stderr, "kernel_launch: unexpected shapes: n_in %d in0 %d out %d ws %zu (need %zu)\n", n_in, n_in > 0 ? in_sizes[0] : -1, out_size, ws_size, (size_t)WS_END); grid = -1; return; }
        int dev = 0, cus = 0;
        if (hipGetDevice(&dev) != hipSuccess || hipDeviceGetAttribute(&cus, hipDeviceAttributeMultiprocessorCount, dev) != hipSuccess) { grid = -1; return; }
        if (hipFuncSetAttribute((const void*)mk_fwd<T_ALL>, hipFuncAttributeMaxDynamicSharedMemorySize, LDS_BYTES) != hipSuccess) { fprintf(stderr, "kernel_launch: hipFuncSetAttribute failed\n"); grid = -1; return; }
        (void)hipGetLastError();
        grid = cus;
    }
    if (grid < 0) return;
    (void)hipMemsetAsync((char*)d_ws + WS_CTL, 0, CTL_ZERO_BYTES, stream);
    Args a{};
    for (int i = 0; i < 21; ++i) a.in[i] = (const float*)d_in[i];
    a.out = (float*)d_out; a.ws = (unsigned char*)d_ws;
#if MK_ONE_LAUNCH
    a.ph_lo = 0; a.ph_hi = NPH;
    hipLaunchKernelGGL(mk_fwd<T_ALL>, dim3(grid), dim3(NTHR), LDS_BYTES, stream, a);
#else
    for (int p = 0; p < NPH; ++p) { a.ph_lo = p; a.ph_hi = p + 1; hipLaunchKernelGGL(mk_fwd<T_ALL>, dim3(grid), dim3(NTHR), LDS_BYTES, stream, a); }
#endif
    const hipError_t le = hipPeekAtLastError();
    if (le != hipSuccess) fprintf(stderr, "kernel_launch: launch failed: %s\n", hipGetErrorName(le));
}
```
